# Optimizing an MI355X kernel written in HIP

```python
import math
import jax, jax.numpy as jnp
from jax import lax
import numpy as np

D_MODEL = 1024
BATCH = 8
SEQ = 2048
DEPTH = 4

GRID_W = 64
CTX_LEN = 256

CHUNK = 128
GM_WIDTH = D_MODEL
GM_GROUPS = 8
GM_GROUP_DIM = GM_WIDTH // GM_GROUPS
DA_HEADS = 8
DA_HEAD_DIM = 64
DA_V_DIM = 2 * DA_HEAD_DIM
DA_QK_WIDTH = DA_HEADS * 2 * DA_HEAD_DIM
DA_V_WIDTH = DA_HEADS * DA_V_DIM
ATTN_BLOCK = 128
ROPE_BASE = 10000.0
RW_HEAD = 64
RW_WIDTH = D_MODEL
RW_HEADS = RW_WIDTH // RW_HEAD
DECAY_LORA = 64
AAA_LORA = 64
GATE_LORA = 160
N_BRANCH = 3
D_FF = ((8 * D_MODEL + 3 * 256 - 1) // (3 * 256)) * 256

RMS_EPS = 1e-6
GN_EPS = 64e-5

GM_COLS = 2 * GM_WIDTH
DA_COLS = 2 * DA_QK_WIDTH + DA_V_WIDTH
RW_COLS = 3 * RW_WIDTH + 2 * DECAY_LORA + 2 * AAA_LORA + GATE_LORA
GATE_COLS = N_BRANCH * D_MODEL
P_TOTAL = GM_COLS + DA_COLS + RW_COLS + GATE_COLS
P_SPLITS = [GM_COLS, GM_COLS + DA_COLS, GM_COLS + DA_COLS + RW_COLS]
RW_SPLITS = [RW_WIDTH, 2 * RW_WIDTH, 3 * RW_WIDTH, 3 * RW_WIDTH + 2 * DECAY_LORA,
             3 * RW_WIDTH + 2 * DECAY_LORA + 2 * AAA_LORA]

kernel_name = 'hybrid_gmlp_diffattn_rwkv7_dit_block'


def rms_norm(x, g):
    xf = x.astype(jnp.float32)
    y = xf * lax.rsqrt(jnp.mean(xf * xf, axis=-1, keepdims=True) + RMS_EPS)
    return (y * g.astype(jnp.float32)).astype(x.dtype)


def axial_rope_tables(n_rows):
    row = jnp.repeat(jnp.arange(n_rows), GRID_W).astype(jnp.float32)
    col = jnp.tile(jnp.arange(GRID_W), n_rows).astype(jnp.float32)
    axis_dim = DA_HEAD_DIM // 2
    inv_freq = ROPE_BASE ** (-jnp.arange(0, axis_dim, 2, dtype=jnp.float32) / axis_dim)
    ang = jnp.concatenate([row[:, None] * inv_freq, col[:, None] * inv_freq], axis=-1)
    ang = jnp.concatenate([ang, ang], axis=-1)
    return jnp.cos(ang), jnp.sin(ang)


def apply_rope(t, cos, sin):
    half = DA_HEAD_DIM // 2
    rot = jnp.concatenate([-t[..., half:], t[..., :half]], axis=-1)
    cs = cos[None, :, None, None, :]
    sn = sin[None, :, None, None, :]
    return (t * cs + rot * sn).astype(t.dtype)


def centred_shift(p):
    prev = jnp.pad(p[:, :-1], ((0, 0), (1, 0), (0, 0)))
    nxt = jnp.pad(p[:, 1:], ((0, 0), (0, 1), (0, 0)))
    return 0.5 * (prev + nxt)


def chunk_gmlp(p_gm, v_g, w_s, b_s):
    B, T, _ = p_gm.shape
    u = jax.nn.gelu(p_gm[..., :GM_WIDTH], approximate=False)
    v = rms_norm(jax.nn.gelu(p_gm[..., GM_WIDTH:], approximate=False), v_g)
    v = v.reshape(B, T // CHUNK, CHUNK, GM_GROUPS, GM_GROUP_DIM)
    f = jnp.einsum('gts,bnsgc->bntgc', w_s, v) + b_s.T[None, None, :, :, None]
    return u * f.reshape(B, T, GM_WIDTH)


def qk_heads(p, g):
    return rms_norm(p.reshape(p.shape[0], p.shape[1], DA_HEADS, 2, DA_HEAD_DIM), g)


def diff_attend(q, k, v, lam):
    s = jnp.einsum('bqhcd,bkhcd->bhcqk', q, k).astype(jnp.float32) * (DA_HEAD_DIM ** -0.5)
    p = jax.nn.softmax(s, axis=-1)
    pd = (p[:, :, 0] - lam * p[:, :, 1]).astype(v.dtype)
    return jnp.einsum('bhqk,bkhe->bqhe', pd, v)


def diff_out(o, subln_g, lam_init):
    o = rms_norm(o, subln_g) * (1.0 - lam_init)
    return o.reshape(o.shape[0], o.shape[1], DA_V_WIDTH)


def rwkv_prep(p_rw, lp):
    B, T, _ = p_rw.shape
    z = p_rw + lp['rw_mu'] * (centred_shift(p_rw) - p_rw)
    zr, zk, zv, zw, za, zg = jnp.split(z, RW_SPLITS, axis=-1)
    zw = zw.reshape(B, T, 2, DECAY_LORA)
    za = za.reshape(B, T, 2, AAA_LORA)
    w_log = -jax.nn.softplus(-(lp['rw_w0'] + jnp.einsum('btdr,drc->btdc', jnp.tanh(zw), lp['rw_w2']))) - 0.5
    decay = jnp.exp(-jnp.exp(w_log.astype(jnp.float32)))
    a = jax.nn.sigmoid((lp['rw_a0'] + jnp.einsum('btdr,drc->btdc', za, lp['rw_a2'])).astype(jnp.float32))
    kk = (zk * lp['rw_kk']).astype(jnp.float32).reshape(B, T, RW_HEADS, RW_HEAD)
    kk = kk / jnp.maximum(jnp.sqrt(jnp.sum(kk * kk, axis=-1, keepdims=True)), 1e-12)
    kd = zk.astype(jnp.float32)[:, :, None, :] * (1.0 + (a - 1.0) * lp['rw_ka'].astype(jnp.float32))
    heads = lambda t: t.reshape(t.shape[:-1] + (RW_HEADS, RW_HEAD))
    return dict(r=heads(zr.astype(jnp.float32)), v=heads(zv.astype(jnp.float32)), kk=kk,
                decay=heads(decay), kd=heads(kd), a=heads(a), zg=zg)


def rwkv_scan(w, k, v, a_vec, b_vec, r, state0, reverse, with_outputs):
    xs = (w, k, v, a_vec, b_vec) + ((r,) if with_outputs else ())
    xs = tuple(jnp.moveaxis(t, 1, 0) for t in xs)

    def step(S, inp):
        w_t, k_t, v_t, a_t, b_t = inp[:5]
        sa = jnp.einsum('bhij,bhj->bhi', S, a_t)
        S = S * w_t[:, :, None, :] + sa[..., None] * b_t[:, :, None, :] + v_t[..., None] * k_t[:, :, None, :]
        y = jnp.einsum('bhij,bhj->bhi', S, inp[5]) if with_outputs else None
        return S, y

    S, ys = lax.scan(step, state0, xs, reverse=reverse)
    return S, (jnp.moveaxis(ys, 0, 1) if with_outputs else None)


def rwkv_run(pr, states0, with_outputs):
    finals, ys = [], []
    for d in range(2):
        S, y = rwkv_scan(pr['decay'][:, :, d], pr['kd'][:, :, d], pr['v'], -pr['kk'],
                         pr['kk'] * pr['a'][:, :, d], pr['r'], states0[d], d == 1, with_outputs)
        finals.append(S)
        ys.append(y)
    return finals, (ys[0] + ys[1] if with_outputs else None)


def rwkv_out(pr, y, lp, dtype):
    B, T = y.shape[0], y.shape[1]
    mean = jnp.mean(y, axis=-1, keepdims=True)
    var = jnp.mean(jnp.square(y - mean), axis=-1, keepdims=True)
    yn = ((y - mean) * lax.rsqrt(var + GN_EPS)).reshape(B, T, RW_WIDTH) * lp['rw_ln_w'] + lp['rw_ln_b']
    kd_sum = pr['kd'][:, :, 0] + pr['kd'][:, :, 1]
    bonus = jnp.sum(pr['r'] * kd_sum * lp['rw_rk'].astype(jnp.float32), axis=-1, keepdims=True) * pr['v']
    g = jax.nn.sigmoid(pr['zg']) @ lp['rw_g2']
    return ((yn + bonus.reshape(B, T, RW_WIDTH)) * g).astype(dtype)


def merge_branches(a, b, c, gate_p, lp):
    gates = jax.nn.sigmoid(gate_p).reshape(gate_p.shape[0], gate_p.shape[1], N_BRANCH, D_MODEL)
    m = (gates[:, :, 0] * (a @ lp['w_br_a']) + gates[:, :, 1] * (b @ lp['w_br_b'])
         + gates[:, :, 2] * (c @ lp['w_br_c']))
    return m @ lp['w_o']


def token_mixers(h_lat, h_ctx, lp, cos, sin, lam_init, ctx_out):
    B, T, _ = h_lat.shape
    gm_l, da_l, rw_l, gt_l = jnp.split(h_lat @ lp['w_in'], P_SPLITS, axis=-1)
    gm_c, da_c, rw_c, gt_c = jnp.split(h_ctx @ lp['w_in'], P_SPLITS, axis=-1)

    a_l = chunk_gmlp(gm_l, lp['gm_v_g'], lp['gm_ws'], lp['gm_bs'])

    q_l = apply_rope(qk_heads(da_l[..., :DA_QK_WIDTH], lp['da_q_g']), cos, sin)
    k_l = apply_rope(qk_heads(da_l[..., DA_QK_WIDTH:2 * DA_QK_WIDTH], lp['da_k_g']), cos, sin)
    v_l = da_l[..., 2 * DA_QK_WIDTH:].reshape(B, T, DA_HEADS, DA_V_DIM)
    k_c = qk_heads(da_c[..., DA_QK_WIDTH:2 * DA_QK_WIDTH], lp['da_k_g'])
    v_c = da_c[..., 2 * DA_QK_WIDTH:].reshape(B, -1, DA_HEADS, DA_V_DIM)
    lq1, lk1, lq2, lk2 = lp['da_lambda'].astype(jnp.float32)
    lam = jnp.exp(jnp.sum(lq1 * lk1)) - jnp.exp(jnp.sum(lq2 * lk2)) + lam_init
    k_all = jnp.concatenate([k_l, k_c], axis=1)
    v_all = jnp.concatenate([v_l, v_c], axis=1)
    n_blk = T // ATTN_BLOCK
    qb = jnp.moveaxis(q_l.reshape(B, n_blk, ATTN_BLOCK, DA_HEADS, 2, DA_HEAD_DIM), 1, 0)
    ob = lax.map(lambda qi: diff_attend(qi, k_all, v_all, lam), qb)
    o_l = jnp.moveaxis(ob, 0, 1).reshape(B, T, DA_HEADS, DA_V_DIM)
    b_l = diff_out(o_l, lp['da_subln_g'], lam_init)

    pr_c = rwkv_prep(rw_c, lp)
    zero = jnp.zeros((B, RW_HEADS, RW_HEAD, RW_HEAD), jnp.float32)
    states_c, y_c = rwkv_run(pr_c, (zero, zero), ctx_out)
    pr_l = rwkv_prep(rw_l, lp)
    _, y_l = rwkv_run(pr_l, states_c, True)
    c_l = rwkv_out(pr_l, y_l, lp, h_lat.dtype)

    out_l = merge_branches(a_l, b_l, c_l, gt_l, lp)
    if not ctx_out:
        return out_l, None

    a_c = chunk_gmlp(gm_c, lp['gm_v_g'], lp['gm_ws'], lp['gm_bs'])
    q_c = qk_heads(da_c[..., :DA_QK_WIDTH], lp['da_q_g'])
    b_c = diff_out(diff_attend(q_c, k_c, v_c, lam), lp['da_subln_g'], lam_init)
    c_c = rwkv_out(pr_c, y_c, lp, h_ctx.dtype)
    out_c = merge_branches(a_c, b_c, c_c, gt_c, lp)
    return out_l, out_c


def swiglu(h, wi, wo):
    gt, up = jnp.split(h @ wi, 2, axis=-1)
    return (jax.nn.silu(gt) * up) @ wo


def setup_inputs(seed: int = 0) -> dict:
    key = jax.random.key(seed)
    ks = iter(jax.random.split(key, 40))
    nrm = lambda shape, scale: jax.random.normal(next(ks), shape, jnp.float32) * scale
    uni = lambda shape, lo, hi: jax.random.uniform(next(ks), shape, jnp.float32, lo, hi)
    L, D = DEPTH, D_MODEL
    return {
        'x': nrm((BATCH, SEQ, D), 1.0),
        'c': nrm((BATCH, D), 1.0),
        'ctx': nrm((BATCH, CTX_LEN, D), 1.0),
        'c_ctx': nrm((D,), 1.0),
        'ada_w': nrm((L, D, 6 * D), D ** -0.5),
        'ada_b': nrm((L, 6 * D), 0.02),
        'norm1_g': 1.0 + nrm((L, D), 0.02),
        'norm2_g': 1.0 + nrm((L, D), 0.02),
        'w_in': nrm((L, D, P_TOTAL), D ** -0.5),
        'gm_v_g': 1.0 + nrm((L, GM_WIDTH), 0.02),
        'gm_ws': nrm((L, GM_GROUPS, CHUNK, CHUNK), CHUNK ** -0.5),
        'gm_bs': 1.0 + nrm((L, GM_GROUPS, CHUNK), 0.02),
        'da_q_g': 1.0 + nrm((L, DA_HEAD_DIM), 0.02),
        'da_k_g': 1.0 + nrm((L, DA_HEAD_DIM), 0.02),
        'da_lambda': nrm((L, 4, DA_HEAD_DIM), 0.1),
        'da_subln_g': 1.0 + nrm((L, DA_V_DIM), 0.02),
        'rw_mu': uni((L, RW_COLS), 0.0, 1.0),
        'rw_w0': uni((L, 2, RW_WIDTH), -5.0, 1.0),
        'rw_w2': nrm((L, 2, DECAY_LORA, RW_WIDTH), 0.1),
        'rw_a0': nrm((L, 2, RW_WIDTH), 0.1),
        'rw_a2': nrm((L, 2, AAA_LORA, RW_WIDTH), 0.5 * AAA_LORA ** -0.5),
        'rw_g2': nrm((L, GATE_LORA, RW_WIDTH), GATE_LORA ** -0.5),
        'rw_kk': 0.85 + nrm((L, RW_WIDTH), 0.02),
        'rw_ka': 1.0 + nrm((L, RW_WIDTH), 0.02),
        'rw_rk': nrm((L, RW_HEADS, RW_HEAD), 0.1),
        'rw_ln_w': 1.0 + nrm((L, RW_WIDTH), 0.02),
        'rw_ln_b': nrm((L, RW_WIDTH), 0.02),
        'w_br_a': nrm((L, GM_WIDTH, D), GM_WIDTH ** -0.5),
        'w_br_b': nrm((L, DA_V_WIDTH, D), DA_V_WIDTH ** -0.5),
        'w_br_c': nrm((L, RW_WIDTH, D), RW_WIDTH ** -0.5),
        'w_o': nrm((L, D, D), D ** -0.5),
        'ffn_wi': nrm((L, D, 2 * D_FF), D ** -0.5),
        'ffn_wo': nrm((L, D_FF, D), D_FF ** -0.5),
    }


def reference(x, c, ctx, c_ctx, ada_w, ada_b, norm1_g, norm2_g, w_in, gm_v_g, gm_ws, gm_bs,
              da_q_g, da_k_g, da_lambda, da_subln_g, rw_mu, rw_w0, rw_w2, rw_a0, rw_a2, rw_g2,
              rw_kk, rw_ka, rw_rk, rw_ln_w, rw_ln_b, w_br_a, w_br_b, w_br_c, w_o, ffn_wi, ffn_wo):
    n_rows = x.shape[1] // GRID_W
    cos, sin = axial_rope_tables(n_rows)
    xc = ctx
    for l in range(DEPTH):
        ctx_out = l < DEPTH - 1
        lam_init = 0.8 - 0.6 * math.exp(-0.3 * l)
        mod_l = jax.nn.silu(c) @ ada_w[l] + ada_b[l]
        mod_c = jax.nn.silu(c_ctx) @ ada_w[l] + ada_b[l]
        sh1, sc1, g1, sh2, sc2, g2 = jnp.split(mod_l[:, None, :], 6, axis=-1)
        csh1, csc1, cg1, csh2, csc2, cg2 = jnp.split(mod_c, 6, axis=-1)
        lp = dict(w_in=w_in[l], gm_v_g=gm_v_g[l], gm_ws=gm_ws[l], gm_bs=gm_bs[l],
                  da_q_g=da_q_g[l], da_k_g=da_k_g[l], da_lambda=da_lambda[l], da_subln_g=da_subln_g[l],
                  rw_mu=rw_mu[l], rw_w0=rw_w0[l], rw_w2=rw_w2[l], rw_a0=rw_a0[l], rw_a2=rw_a2[l],
                  rw_g2=rw_g2[l], rw_kk=rw_kk[l], rw_ka=rw_ka[l], rw_rk=rw_rk[l],
                  rw_ln_w=rw_ln_w[l], rw_ln_b=rw_ln_b[l], w_br_a=w_br_a[l], w_br_b=w_br_b[l],
                  w_br_c=w_br_c[l], w_o=w_o[l])
        h_lat = rms_norm(x, norm1_g[l]) * (1.0 + sc1) + sh1
        h_ctx = rms_norm(xc, norm1_g[l]) * (1.0 + csc1) + csh1
        mix_l, mix_c = token_mixers(h_lat, h_ctx, lp, cos, sin, lam_init, ctx_out)
        x = x + g1 * mix_l
        x = x + g2 * swiglu(rms_norm(x, norm2_g[l]) * (1.0 + sc2) + sh2, ffn_wi[l], ffn_wo[l])
        if ctx_out:
            xc = xc + cg1 * mix_c
            xc = xc + cg2 * swiglu(rms_norm(xc, norm2_g[l]) * (1.0 + csc2) + csh2, ffn_wi[l], ffn_wo[l])
    return x
```

```cpp
#include <hip/hip_runtime.h>
#include <hip/hip_cooperative_groups.h>
#include <cstdio>
#include <cstdint>
namespace cg = cooperative_groups;
namespace pg8 {
#define PG8_LAS __attribute__((address_space(3)))
typedef unsigned short bf16_t;
typedef short bf16x8 __attribute__((ext_vector_type(8)));
typedef float f32x4 __attribute__((ext_vector_type(4)));
typedef unsigned u32x4 __attribute__((ext_vector_type(4)));
constexpr int BM = 256, BK = 64, HALF = 128, HTB = HALF * BK * 2  , STAGE_BYTES = 8 * HTB, NXCD = 8, WGM = 8;

__host__ __device__ __forceinline__ int lds_byte(int r, int c) { const int st = (r >> 4) * 2 + (c >> 5), rr = r & 15, cc = c & 31, ob = rr * 64 + cc * 2; return st * 1024 + (ob ^ (((ob >> 9) & 1) << 5)); }
__host__ __device__ __forceinline__ void stage_rc(int b, int& R, int& C) { const int st = b / 1024, sb = b % 1024, swz = sb ^ (((sb >> 9) & 1) << 5); R = (st >> 1) * 16 + swz / 64; C = (st & 1) * 32 + (swz % 64) / 2; }
__host__ __device__ __forceinline__ int perm32(int rho) { const int n = rho >> 4, i = rho & 15; return 8 * (i >> 2) + 4 * n + (i & 3); }

struct Unit { int pm, pn; };
struct Gemm { const bf16_t* A; const bf16_t* Bt; int M, N, K; };

struct StaticOrder {
    int nM, nN, nwg, G, c;
    __host__ __device__ void init(int M, int N, int G_, int c_) { nM = M / BM; nN = N / BM; nwg = nM * nN; G = G_; c = c_; }
    __host__ __device__ bool next(int i, Unit& u) const {
        const long L = (long)i * G + c; if (L >= nwg) return false;
        int wgid = (int)L; { const int q = nwg / NXCD, r = nwg % NXCD, xcd = wgid % NXCD, off = wgid / NXCD; wgid = (xcd < r ? xcd * (q + 1) : r * (q + 1) + (xcd - r) * q) + off; }
        const int nig = WGM * nN, gid = wgid / nig, fm = gid * WGM, gsz = (nM - fm) < WGM ? (nM - fm) : WGM;
        u.pm = fm + ((wgid % nig) % gsz); u.pn = (wgid % nig) / gsz; return true;
    }
    __device__ __forceinline__ void a_ready(const Unit&) const {}
    __device__ __forceinline__ void done(const Unit&) const {}
};

__device__ __forceinline__ unsigned cvt_pk_bf16(float lo, float hi) { unsigned r; asm volatile("v_cvt_pk_bf16_f32 %0, %1, %2" : "=v"(r) : "v"(lo), "v"(hi)); return r; }
typedef float f32x2 __attribute__((ext_vector_type(2)));
__device__ __forceinline__ f32x2 gelu_pk(f32x2 v) {
    const f32x2 av = __builtin_elementwise_abs(v), d = av * 0.2316418882f + 1.0f;
    f32x2 t; t.x = __builtin_amdgcn_rcpf(d.x); t.y = __builtin_amdgcn_rcpf(d.y);
    f32x2 q = t * 0.5307027145f + (-0.7265760135f); q = q * t + 0.7107068705f; q = q * t + (-0.142248368f); q = q * t + 0.127414796f; q = q * t;
    const f32x2 s = (v * v) * (-0.72134752044f);
    f32x2 e; e.x = __builtin_amdgcn_exp2f(s.x); e.y = __builtin_amdgcn_exp2f(s.y);
    const f32x2 m = v * (q * e), r = v - m;
    f32x2 o; o.x = v.x < 0.f ? m.x : r.x; o.y = v.y < 0.f ? m.y : r.y; return o;
}

template <class Epi, class Sched, bool ALIGN_EPI = false, bool SP2 = false>
__device__ __forceinline__ void gemm_phase(PG8_LAS unsigned char* lds, const Gemm g, const Sched& S, const Epi& E, const int tid_in) {
    const int tid = tid_in, wid = __builtin_amdgcn_readfirstlane(tid >> 6), lane = tid & 63, wr = wid >> 2, wc = wid & 3, fr = lane & 15, fq = lane >> 4;
    const int K = g.K, nt = K / BK;
    unsigned voffA[2], voffB[2];
#pragma unroll
    for (int i = 0; i < 2; ++i) { int R, C; stage_rc(tid * 16 + i * 8192, R, C); const int Rb = Epi::PERM ? ((R & ~31) + perm32(R & 31)) : R;
        voffA[i] = (unsigned)(R * K + C) * 2u; voffB[i] = (unsigned)(Rb * K + C) * 2u; }
    const size_t kstep = (size_t)(BK * 2);
    const size_t hstep = (size_t)HALF * K * 2;
    const size_t tstep = 2 * hstep;
    const unsigned ldsw = (unsigned)wid * 1024u;
    const int aoff = lds_byte(wr * 64 + fr, fq * 8), boff = lds_byte(wc * 32 + fr, fq * 8);
#define PG8_SA(b, h) (((b) * 2 + (h)) * HTB)
#define PG8_SB(b, h) ((4 + (b) * 2 + (h)) * HTB)
#define PG8_STAGE(bufoff, gbase, voff) do { _Pragma("unroll") for (int _i = 0; _i < 2; ++_i) \
        __builtin_amdgcn_global_load_lds((const unsigned*)((const char*)(gbase) + (voff)[_i]), (PG8_LAS unsigned*)(lds + (bufoff) + ldsw + _i * 8192), 16, 0, 0); } while (0)
#define PG8_LDA(dst, b, h) do { _Pragma("unroll") for (int m = 0; m < 4; ++m) _Pragma("unroll") for (int k = 0; k < 2; ++k) dst[m][k] = *(const PG8_LAS bf16x8*)(lds + PG8_SA(b, h) + aoff + m * 2048 + k * 1024); } while (0)
#define PG8_LDB(dst, b, h) do { _Pragma("unroll") for (int n = 0; n < 2; ++n) _Pragma("unroll") for (int k = 0; k < 2; ++k) dst[n][k] = *(const PG8_LAS bf16x8*)(lds + PG8_SB(b, h) + boff + n * 2048 + k * 1024); } while (0)
#define PG8_MMA(ai, bj, At, Bt) do { __builtin_amdgcn_s_setprio(1); _Pragma("unroll") for (int m = 0; m < 4; ++m) _Pragma("unroll") for (int n = 0; n < 2; ++n) _Pragma("unroll") for (int k = 0; k < 2; ++k) \
        acc[ai][bj][m][n] = __builtin_amdgcn_mfma_f32_16x16x32_bf16(Bt[n][k], At[m][k], acc[ai][bj][m][n], 0, 0, 0); __builtin_amdgcn_s_setprio(0); } while (0)
#define PG8_WAIT_V(n) asm volatile("s_waitcnt vmcnt(" #n ")" ::: "memory")
#define PG8_WAIT_L(n) asm volatile("s_waitcnt lgkmcnt(" #n ")" ::: "memory")
#define PG8_BAR __builtin_amdgcn_s_barrier()
#define PG8_SCHED __builtin_amdgcn_sched_barrier(0)
    Unit cur, nxt; int ui = 0;
    if (!S.next(0, cur)) return;
    f32x4 acc[2][2][4][2];
#pragma unroll
    for (int a = 0; a < 2; ++a)
#pragma unroll
        for (int b = 0; b < 2; ++b)
#pragma unroll
            for (int m = 0; m < 4; ++m)
#pragma unroll
                for (int n = 0; n < 2; ++n) acc[a][b][m][n] = (f32x4){0.f, 0.f, 0.f, 0.f};
    bf16x8 At[4][2], B0[2][2], B1[2][2];
    const char* cA = (const char*)g.A + (size_t)cur.pm * tstep; const char* cB = (const char*)g.Bt + (size_t)cur.pn * tstep;
    S.a_ready(cur);
    if constexpr (SP2) {
        PG8_STAGE(PG8_SB(0, 0), cB, voffB); PG8_STAGE(PG8_SB(0, 1), cB + hstep, voffB); PG8_STAGE(PG8_SA(0, 0), cA, voffA); PG8_STAGE(PG8_SA(0, 1), cA + hstep, voffA);
        if (wr == 1) PG8_BAR;
        PG8_WAIT_V(2); PG8_BAR;
        PG8_STAGE(PG8_SB(1, 0), cB + kstep, voffB); PG8_STAGE(PG8_SA(1, 0), cA + kstep, voffA); PG8_STAGE(PG8_SB(1, 1), cB + hstep + kstep, voffB);
        PG8_WAIT_V(6); PG8_BAR;
    } else {
        PG8_STAGE(PG8_SB(0, 0), cB, voffB); PG8_STAGE(PG8_SA(0, 0), cA, voffA); PG8_STAGE(PG8_SB(0, 1), cB + hstep, voffB); PG8_STAGE(PG8_SA(0, 1), cA + hstep, voffA);
        if (wr == 1) PG8_BAR;
        PG8_WAIT_V(4); PG8_BAR;
        PG8_STAGE(PG8_SB(1, 0), cB + kstep, voffB); PG8_STAGE(PG8_SA(1, 0), cA + kstep, voffA); PG8_STAGE(PG8_SB(1, 1), cB + hstep + kstep, voffB);
        PG8_WAIT_V(6); PG8_BAR;
    }
    for (;;) {
        const bool has_next = S.next(ui + 1, nxt);
        const char* nA = has_next ? (const char*)g.A + (size_t)nxt.pm * tstep : cA; const char* nB = has_next ? (const char*)g.Bt + (size_t)nxt.pn * tstep : cB;
        for (int t = 0; t < nt; t += 2) {
            const bool last = (t == nt - 2);
            const char* a1 = cA + (size_t)(t + 1) * kstep;
            const char* a2 = last ? nA : cA + (size_t)(t + 2) * kstep; const char* b2 = last ? nB : cB + (size_t)(t + 2) * kstep;
            const char* a3 = a2 + kstep; const char* b3 = b2 + kstep;
            if (last && has_next) S.a_ready(nxt);
            if constexpr (SP2) {
            PG8_LDB(B0, 0, 0); PG8_LDB(B1, 0, 1); PG8_SCHED; PG8_LDA(At, 0, 0); PG8_STAGE(PG8_SA(1, 1), a1 + hstep, voffA);
            PG8_WAIT_V(8); PG8_WAIT_L(0); PG8_BAR; PG8_MMA(0, 0, At, B0); PG8_MMA(0, 1, At, B1); PG8_BAR; PG8_SCHED;
            PG8_LDA(At, 0, 1); PG8_STAGE(PG8_SB(0, 0), b2, voffB); PG8_STAGE(PG8_SB(0, 1), b2 + hstep, voffB); PG8_STAGE(PG8_SA(0, 0), a2, voffA);
            PG8_WAIT_V(8); PG8_WAIT_L(0); PG8_BAR; PG8_MMA(1, 0, At, B0); PG8_MMA(1, 1, At, B1); PG8_BAR; PG8_SCHED;
            PG8_LDB(B0, 1, 0); PG8_LDB(B1, 1, 1); PG8_SCHED; PG8_LDA(At, 1, 0); PG8_STAGE(PG8_SA(0, 1), a2 + hstep, voffA);
            PG8_WAIT_V(8); PG8_WAIT_L(0); PG8_BAR; PG8_MMA(0, 0, At, B0); PG8_MMA(0, 1, At, B1); PG8_BAR; PG8_SCHED;
            PG8_LDA(At, 1, 1); PG8_STAGE(PG8_SB(1, 0), b3, voffB); PG8_STAGE(PG8_SB(1, 1), b3 + hstep, voffB); PG8_STAGE(PG8_SA(1, 0), a3, voffA);
            PG8_WAIT_V(8); PG8_WAIT_L(0); PG8_BAR; PG8_MMA(1, 0, At, B0); PG8_MMA(1, 1, At, B1); PG8_BAR; PG8_SCHED;
            } else {
            PG8_LDB(B0, 0, 0); PG8_SCHED; PG8_LDA(At, 0, 0); PG8_STAGE(PG8_SA(1, 1), a1 + hstep, voffA);
            PG8_WAIT_L(8); PG8_BAR; PG8_WAIT_L(0); PG8_MMA(0, 0, At, B0); PG8_BAR; PG8_SCHED;
            PG8_LDB(B1, 0, 1); PG8_STAGE(PG8_SB(0, 0), b2, voffB);
            PG8_BAR; PG8_WAIT_L(0); PG8_MMA(0, 1, At, B1); PG8_BAR;
            PG8_LDA(At, 0, 1); PG8_STAGE(PG8_SA(0, 0), a2, voffA);
            PG8_BAR; PG8_WAIT_L(0); PG8_MMA(1, 0, At, B0); PG8_BAR; PG8_SCHED;
            PG8_STAGE(PG8_SB(0, 1), b2 + hstep, voffB);
            PG8_WAIT_V(6); PG8_BAR; PG8_MMA(1, 1, At, B1); PG8_BAR;
            PG8_LDB(B0, 1, 0); PG8_SCHED; PG8_LDA(At, 1, 0); PG8_STAGE(PG8_SA(0, 1), a2 + hstep, voffA);
            PG8_WAIT_L(8); PG8_BAR; PG8_WAIT_L(0); PG8_MMA(0, 0, At, B0); PG8_BAR; PG8_SCHED;
            PG8_LDB(B1, 1, 1); PG8_STAGE(PG8_SB(1, 0), b3, voffB);
            PG8_BAR; PG8_WAIT_L(0); PG8_MMA(0, 1, At, B1); PG8_BAR;
            PG8_LDA(At, 1, 1); PG8_STAGE(PG8_SA(1, 0), a3, voffA);
            PG8_BAR; PG8_WAIT_L(0); PG8_MMA(1, 0, At, B0); PG8_BAR; PG8_SCHED;
            PG8_STAGE(PG8_SB(1, 1), b3 + hstep, voffB);
            PG8_WAIT_V(6); PG8_BAR; PG8_MMA(1, 1, At, B1); PG8_BAR;
            }
        }
        if constexpr (ALIGN_EPI) { if (wr == 0) PG8_BAR; }
        if constexpr (!Epi::AFTER_DRAIN) { E(acc, cur, wr, wc, fr, fq); S.done(cur); }
        if (!has_next) break;
#pragma unroll
        for (int a = 0; a < 2; ++a)
#pragma unroll
            for (int b = 0; b < 2; ++b)
#pragma unroll
                for (int m = 0; m < 4; ++m)
#pragma unroll
                    for (int n = 0; n < 2; ++n) acc[a][b][m][n] = (f32x4){0.f, 0.f, 0.f, 0.f};
        cur = nxt; cA = nA; cB = nB; ++ui;
        if constexpr (ALIGN_EPI) { if (wr == 1) PG8_BAR; }
    }
    PG8_WAIT_V(0);
    if constexpr (!ALIGN_EPI) { if (wr == 0) PG8_BAR; }
    PG8_BAR;
    if constexpr (Epi::AFTER_DRAIN) { E.fused(acc, cur, wr, wc, fr, fq, lds, wid, lane); S.done(cur); }
#undef PG8_SA
#undef PG8_SB
#undef PG8_STAGE
#undef PG8_LDA
#undef PG8_LDB
#undef PG8_MMA
#undef PG8_WAIT_V
#undef PG8_WAIT_L
#undef PG8_BAR
#undef PG8_SCHED
}
}

#define LAS __attribute__((address_space(3)))
typedef unsigned short bf16_t;
typedef float f32x2 __attribute__((ext_vector_type(2)));
typedef float f32x4 __attribute__((ext_vector_type(4)));
typedef float f32x16 __attribute__((ext_vector_type(16)));
typedef short bf16x8 __attribute__((ext_vector_type(8)));
typedef short s16x4 __attribute__((ext_vector_type(4)));
typedef unsigned u32x4 __attribute__((ext_vector_type(4)));
typedef unsigned u32x2 __attribute__((ext_vector_type(2)));
typedef __bf16 bf16x2v __attribute__((ext_vector_type(2)));
#define MFMA32(a, b, c) __builtin_amdgcn_mfma_f32_32x32x16_bf16((a), (b), (c), 0, 0, 0)

constexpr int D = 1024, NB = 8, TL = 2048, TCX = 256, DEPTH = 4;
constexpr int ML = NB * TL, MC = NB * TCX, M = ML + MC;
constexpr int PPAD = 11776, RWP = 3584, DFF = 2816;
constexpr int NPH = 11, NPHASES = 1 + DEPTH * NPH;
constexpr size_t MiB = 1u << 20;
constexpr size_t WS_MOD = 0, WS_WIN = 1 * MiB, WS_WA = 24 * MiB, WS_WB = 26 * MiB, WS_WC = 28 * MiB, WS_WO = 30 * MiB, WS_WI = 32 * MiB, WS_WO2 = 43 * MiB,
                 WS_LWT = 48 * MiB + MiB / 2, WS_LAT = 49 * MiB, WS_LGT = 49 * MiB + MiB / 2, WS_H = 50 * MiB, WS_XC = 86 * MiB, WS_GU = 94 * MiB, WS_GV = 130 * MiB,
                 WS_Q = 166 * MiB, WS_K = 202 * MiB, WS_V = 238 * MiB, WS_RW = 274 * MiB, WS_GT = 400 * MiB, WS_LIW = 508 * MiB, WS_LIA = 512 * MiB + MiB / 2,
                 WS_LIG = 517 * MiB, WS_DEC1 = 526 * MiB, WS_AA0 = 562 * MiB, WS_AA1 = 598 * MiB, WS_G = 634 * MiB, WS_Y1 = 670 * MiB, WS_END = 706 * MiB;
constexpr int LDS_BYTES = 131072 + 1024;
constexpr float QSCALE = 0.125f * 1.4426950408889634f;

struct Args { const float* in[33]; float* out; unsigned char* ws; int lo, hi; };
typedef const __attribute__((address_space(4))) Args CArgs;
struct TI { int tid, bid, nblk; };

__device__ __forceinline__ float bf2f(unsigned v) { return __uint_as_float(v << 16); }
__device__ __forceinline__ unsigned pkbf(float lo, float hi) { f32x2 v = {lo, hi}; bf16x2v b = __builtin_convertvector(v, bf16x2v); return __builtin_bit_cast(unsigned, b); }
__device__ __forceinline__ bf16_t f2bf(float f) { return (bf16_t)(pkbf(f, 0.f) & 0xffffu); }
__device__ __forceinline__ float wave_sum(float v) {
#pragma unroll
    for (int o = 1; o < 64; o <<= 1) v += __shfl_xor(v, o);
    return v;
}
__device__ __forceinline__ float sigmoidf_(float x) { return 1.f / (1.f + __expf(-x)); }

template <class Op> struct EpiT {
    static constexpr bool PERM = true, AFTER_DRAIN = false;
    Op op;
    __device__ __forceinline__ void operator()(const pg8::f32x4 (&acc)[2][2][4][2], const pg8::Unit& u, int wr, int wc, int fr, int fq) const {
        const int row0 = u.pm * 256 + wr * 64 + fr, col0 = u.pn * 256 + wc * 32 + 8 * fq;
#pragma unroll
        for (int ai = 0; ai < 2; ++ai)
#pragma unroll
            for (int m = 0; m < 4; ++m)
#pragma unroll
                for (int bj = 0; bj < 2; ++bj) op(row0 + ai * 128 + m * 16, col0 + bj * 128, acc[ai][bj][m][0], acc[ai][bj][m][1]);
    }
};
__device__ __forceinline__ u32x4 pack8(f32x4 v0, f32x4 v1) { u32x4 o; o.x = pkbf(v0.x, v0.y); o.y = pkbf(v0.z, v0.w); o.z = pkbf(v1.x, v1.y); o.w = pkbf(v1.z, v1.w); return o; }
__device__ __forceinline__ void unpack8(u32x4 x, f32x4& v0, f32x4& v1) {
    v0.x = bf2f(x.x & 0xffffu); v0.y = bf2f(x.x >> 16); v0.z = bf2f(x.y & 0xffffu); v0.w = bf2f(x.y >> 16);
    v1.x = bf2f(x.z & 0xffffu); v1.y = bf2f(x.z >> 16); v1.z = bf2f(x.w & 0xffffu); v1.w = bf2f(x.w >> 16);
}
__device__ __forceinline__ f32x4 gelu4(f32x4 v) { pg8::f32x2 a = pg8::gelu_pk((pg8::f32x2){v.x, v.y}), b = pg8::gelu_pk((pg8::f32x2){v.z, v.w}); return (f32x4){a.x, a.y, b.x, b.y}; }
__device__ __forceinline__ f32x4 sig4(f32x4 v) { return (f32x4){sigmoidf_(v.x), sigmoidf_(v.y), sigmoidf_(v.z), sigmoidf_(v.w)}; }

struct OpIn {
    bf16_t *GU, *GV, *Q, *RW, *GT;
    __device__ __forceinline__ void operator()(int row, int col, f32x4 v0, f32x4 v1) const {
        bf16_t* dst;
        if (col < 2048) { v0 = gelu4(v0); v1 = gelu4(v1); dst = (col < 1024 ? GU : GV) + (size_t)row * 1024 + (col & 1023); }
        else if (col < 5120) { const int q = col - 2048; dst = Q + (size_t)(q >> 10) * (size_t)(18 * MiB) + (size_t)row * 1024 + (q & 1023); }
        else if (col < 8704) { dst = RW + (size_t)row * RWP + (col - 5120); }
        else { v0 = sig4(v0); v1 = sig4(v1); dst = GT + (size_t)row * 3072 + (col - 8704); }
        *(u32x4*)dst = pack8(v0, v1);
    }
};
struct OpDec {
    bf16_t *D0, *D1; const float* w0;
    __device__ __forceinline__ float f(float x) const { const float y = -x; const float sp = y > 20.f ? y : __logf(1.f + __expf(y)); return -__expf(-sp - 0.5f); }
    __device__ __forceinline__ void operator()(int row, int col, f32x4 v0, f32x4 v1) const {
        const f32x4 b0 = *(const f32x4*)(w0 + col), b1 = *(const f32x4*)(w0 + col + 4);
        v0 += b0; v1 += b1;
        v0 = (f32x4){f(v0.x), f(v0.y), f(v0.z), f(v0.w)}; v1 = (f32x4){f(v1.x), f(v1.y), f(v1.z), f(v1.w)};
        bf16_t* dst = (col < 1024 ? D0 : D1) + (size_t)row * 1024 + (col & 1023);
        *(u32x4*)dst = pack8(v0, v1);
    }
};
struct OpAA {
    bf16_t *A0, *A1; const float* a0;
    __device__ __forceinline__ void operator()(int row, int col, f32x4 v0, f32x4 v1) const {
        const f32x4 b0 = *(const f32x4*)(a0 + col), b1 = *(const f32x4*)(a0 + col + 4);
        v0 = sig4(v0 + b0); v1 = sig4(v1 + b1);
        bf16_t* dst = (col < 1024 ? A0 : A1) + (size_t)row * 1024 + (col & 1023);
        *(u32x4*)dst = pack8(v0, v1);
    }
};
struct OpG {
    bf16_t* G;
    __device__ __forceinline__ void operator()(int row, int col, f32x4 v0, f32x4 v1) const { *(u32x4*)(G + (size_t)row * 1024 + col) = pack8(v0, v1); }
};
template <int KB> struct OpMerge {
    const bf16_t* GT; float* MF; bf16_t* MB;
    __device__ __forceinline__ void operator()(int row, int col, f32x4 v0, f32x4 v1) const {
        f32x4 g0, g1; unpack8(*(const u32x4*)(GT + (size_t)row * 3072 + KB * 1024 + col), g0, g1);
        float* mf = MF + (size_t)row * 1024 + col;
        f32x4 r0 = g0 * v0, r1 = g1 * v1;
        if (KB > 0) { r0 += *(const f32x4*)mf; r1 += *(const f32x4*)(mf + 4); }
        if (KB < 2) { *(f32x4*)mf = r0; *(f32x4*)(mf + 4) = r1; }
        else *(u32x4*)(MB + (size_t)row * 1024 + col) = pack8(r0, r1);
    }
};
struct OpResid {
    const float *xl, *xc; float *ol, *oc; const float* mod; int gi;
    __device__ __forceinline__ void operator()(int row, int col, f32x4 v0, f32x4 v1) const {
        const float* xi; float* xo; const float* g;
        if (row < ML) { xi = xl + (size_t)row * 1024 + col; xo = ol + (size_t)row * 1024 + col; g = mod + (size_t)(row >> 11) * 6144 + gi * 1024 + col; }
        else { const size_t rr = (size_t)(row - ML) * 1024 + col; xi = xc + rr; xo = oc + rr; g = mod + (size_t)8 * 6144 + gi * 1024 + col; }
        const f32x4 x0 = *(const f32x4*)xi, x1 = *(const f32x4*)(xi + 4), g0 = *(const f32x4*)g, g1 = *(const f32x4*)(g + 4);
        *(f32x4*)xo = x0 + g0 * v0; *(f32x4*)(xo + 4) = x1 + g1 * v1;
    }
};
struct OpSwiglu {
    bf16_t* HID;
    __device__ __forceinline__ void operator()(int row, int col, f32x4 v0, f32x4 v1) const {
        const float h0 = v0.x * sigmoidf_(v0.x) * v0.y, h1 = v0.z * sigmoidf_(v0.z) * v0.w, h2 = v1.x * sigmoidf_(v1.x) * v1.y, h3 = v1.z * sigmoidf_(v1.z) * v1.w;
        u32x2 o; o.x = pkbf(h0, h1); o.y = pkbf(h2, h3);
        *(u32x2*)(HID + (size_t)row * DFF + (col >> 1)) = o;
    }
};
template <class Op> __device__ __forceinline__ void run_gemm(const TI ti, unsigned char* lds, const bf16_t* A, const bf16_t* Bt, int Mr, int N, int K, const Op& op) {
    int Kv = K; asm volatile("" : "+s"(Kv));
    pg8::Gemm g{A, Bt, Mr, N, Kv}; pg8::StaticOrder S; S.init(Mr, N, ti.nblk, ti.bid);
    EpiT<Op> E{op};
    pg8::gemm_phase<EpiT<Op>, pg8::StaticOrder, true, true>((PG8_LAS unsigned char*)lds, g, S, E, ti.tid);
}

__device__ __forceinline__ void ph_mods(const TI ti, CArgs& a, unsigned char* ldsg) {
    float* sc = (float*)ldsg; float* part = sc + 9 * 1024;
    const int tid = ti.tid, lane = tid & 63, w = tid >> 6;
    for (int i = tid; i < 9 * 1024; i += 512) { const float v = (i < 8192) ? a.in[1][i] : a.in[3][i - 8192]; sc[i] = v / (1.f + expf(-v)); }
    __syncthreads();
    float* MOD = (float*)(a.ws + WS_MOD);
    for (int item = ti.bid; item < DEPTH * 96; item += ti.nblk) {
        const int l = item / 96, n0 = (item % 96) * 64;
        const float* W = a.in[4] + (size_t)l * 1024 * 6144 + n0 + lane;
        float acc[9];
#pragma unroll
        for (int r = 0; r < 9; ++r) acc[r] = 0.f;
        for (int k = w * 128; k < w * 128 + 128; ++k) {
            const float wv = W[(size_t)k * 6144];
#pragma unroll
            for (int r = 0; r < 9; ++r) acc[r] += sc[r * 1024 + k] * wv;
        }
#pragma unroll
        for (int r = 0; r < 9; ++r) part[(w * 9 + r) * 64 + lane] = acc[r];
        __syncthreads();
        for (int idx = tid; idx < 576; idx += 512) {
            const int r = idx >> 6, ln = idx & 63; float s = a.in[5][l * 6144 + n0 + ln];
            for (int ww = 0; ww < 8; ++ww) s += part[(ww * 9 + r) * 64 + ln];
            MOD[((size_t)l * 9 + r) * 6144 + n0 + ln] = s;
        }
        __syncthreads();
    }
}

__device__ __forceinline__ void norm_rows(const float* xl, const float* xc, const float* g, const float* modl, int shi, int sci, bf16_t* H, int nrows, int gw, int ngw, int lane) {
    for (int row = gw; row < nrows; row += ngw) {
        const float* src; int r;
        if (row < ML) { src = xl + (size_t)row * D; r = row >> 11; } else { src = xc + (size_t)(row - ML) * D; r = 8; }
        const float* md = modl + (size_t)r * 6144;
        f32x4 v[4]; float ss = 0.f;
#pragma unroll
        for (int j = 0; j < 4; ++j) { v[j] = *(const f32x4*)(src + 4 * lane + 256 * j); ss += (v[j].x * v[j].x + v[j].y * v[j].y) + (v[j].z * v[j].z + v[j].w * v[j].w); }
        ss = wave_sum(ss);
        const float rstd = rsqrtf(ss * (1.f / 1024.f) + 1e-6f);
#pragma unroll
        for (int j = 0; j < 4; ++j) {
            const int c = 4 * lane + 256 * j;
            const f32x4 gg = *(const f32x4*)(g + c), scv = *(const f32x4*)(md + sci * 1024 + c), shv = *(const f32x4*)(md + shi * 1024 + c);
            const f32x4 o = v[j] * rstd * gg * (1.f + scv) + shv;
            u32x2 p; p.x = pkbf(o.x, o.y); p.y = pkbf(o.z, o.w);
            *(u32x2*)(H + (size_t)row * D + c) = p;
        }
    }
}

template <int MODE> __device__ __forceinline__ void transpose_item(const float* W, int K, int N, bf16_t* WT, LAS float* scr, int item, int lane) {
    const int nblk = N / 32, kb = item / nblk, nb = item % nblk, k0 = 64 * kb, n0 = 32 * nb;
#pragma unroll 8
    for (int i = 0; i < 32; ++i) { const int kk = 2 * i + (lane >> 5); scr[kk * 33 + (lane & 31)] = W[(size_t)(k0 + kk) * N + n0 + (lane & 31)]; }
    asm volatile("s_waitcnt lgkmcnt(0)" ::: "memory");
    const int c = lane & 7;
#pragma unroll
    for (int j = 0; j < 4; ++j) {
        const int n = (lane >> 3) + 8 * j, gn = n0 + n; const LAS float* s = scr + (8 * c) * 33 + n;
        const int drow = MODE == 0 ? gn : (MODE == 1 ? (gn >= 8608 ? gn + 96 : gn) : (gn < DFF ? 2 * gn : 2 * (gn - DFF) + 1));
        u32x4 o; o.x = pkbf(s[0 * 33], s[1 * 33]); o.y = pkbf(s[2 * 33], s[3 * 33]); o.z = pkbf(s[4 * 33], s[5 * 33]); o.w = pkbf(s[6 * 33], s[7 * 33]);
        *(u32x4*)(WT + (size_t)drow * K + k0 + 8 * c) = o;
    }
    asm volatile("s_waitcnt lgkmcnt(0)" ::: "memory");
}
__device__ __forceinline__ void ph_wconv(CArgs& a, int l, unsigned char* ldsg, int gw, int ngw, int lane, int wv) {
    LAS float* scr = (LAS float*)(ldsg + wv * 8704);
    unsigned char* ws = a.ws;
    constexpr int I_IN = 16 * 365, I_SQ = 16 * 32, I_WI = 16 * 176, I_WO = 44 * 32, NIT = I_IN + 4 * I_SQ + I_WI + I_WO;
    for (int it = gw; it < NIT; it += ngw) {
        int r = it;
        if (r < I_IN) { transpose_item<1>(a.in[8] + (size_t)l * 1024 * 11680, 1024, 11680, (bf16_t*)(ws + WS_WIN), scr, r, lane); continue; } r -= I_IN;
        if (r < I_SQ) { transpose_item<0>(a.in[27] + (size_t)l * 1048576, 1024, 1024, (bf16_t*)(ws + WS_WA), scr, r, lane); continue; } r -= I_SQ;
        if (r < I_SQ) { transpose_item<0>(a.in[28] + (size_t)l * 1048576, 1024, 1024, (bf16_t*)(ws + WS_WB), scr, r, lane); continue; } r -= I_SQ;
        if (r < I_SQ) { transpose_item<0>(a.in[29] + (size_t)l * 1048576, 1024, 1024, (bf16_t*)(ws + WS_WC), scr, r, lane); continue; } r -= I_SQ;
        if (r < I_SQ) { transpose_item<0>(a.in[30] + (size_t)l * 1048576, 1024, 1024, (bf16_t*)(ws + WS_WO), scr, r, lane); continue; } r -= I_SQ;
        if (r < I_WI) { transpose_item<2>(a.in[31] + (size_t)l * 1024 * 5632, 1024, 5632, (bf16_t*)(ws + WS_WI), scr, r, lane); continue; } r -= I_WI;
        transpose_item<0>(a.in[32] + (size_t)l * DFF * 1024, DFF, 1024, (bf16_t*)(ws + WS_WO2), scr, r, lane);
    }
    const int gt = gw * 64 + lane, ngt = ngw * 64;
    bf16_t* LWT = (bf16_t*)(ws + WS_LWT); bf16_t* LAT = (bf16_t*)(ws + WS_LAT); bf16_t* LGT = (bf16_t*)(ws + WS_LGT);
    const float* w2 = a.in[18] + (size_t)l * 2 * 64 * 1024; const float* a2 = a.in[20] + (size_t)l * 2 * 64 * 1024; const float* g2 = a.in[21] + (size_t)l * 160 * 1024;
    for (int i = gt; i < 2048 * 128; i += ngt) {
        const int n = i >> 7, k = i & 127, d = n >> 10, c = n & 1023, kk = k - d * 64;
        const bool in = (kk >= 0 && kk < 64);
        LWT[i] = in ? f2bf(w2[((size_t)d * 64 + kk) * 1024 + c]) : (bf16_t)0;
        LAT[i] = in ? f2bf(a2[((size_t)d * 64 + kk) * 1024 + c]) : (bf16_t)0;
    }
    for (int i = gt; i < 1024 * 256; i += ngt) { const int n = i >> 8, k = i & 255; LGT[i] = k < 160 ? f2bf(g2[(size_t)k * 1024 + n]) : (bf16_t)0; }
    bf16_t* WIN = (bf16_t*)(ws + WS_WIN);
    for (int i = gt; i < 96 * 1024; i += ngt) WIN[(size_t)8608 * 1024 + i] = 0;
}

__device__ __forceinline__ void gmlp_unit(const TI ti, CArgs& a, int l, int u, unsigned char* ldsg) {
    float* rstd = (float*)ldsg; bf16_t* VNT = (bf16_t*)(ldsg + 512);
    const int tid = ti.tid, lane = tid & 63, w = tid >> 6, r = lane & 31, h = lane >> 5;
    bf16_t* GU = (bf16_t*)(a.ws + WS_GU); const bf16_t* GV = (const bf16_t*)(a.ws + WS_GV);
    const size_t R0 = (size_t)u * 128;
    for (int i = 0; i < 16; ++i) {
        const int tok = w * 16 + i; const bf16_t* p = GV + (R0 + tok) * 1024 + lane * 16;
        f32x4 x0, x1, x2, x3; unpack8(*(const u32x4*)p, x0, x1); unpack8(*(const u32x4*)(p + 8), x2, x3);
        float ss = (x0.x * x0.x + x0.y * x0.y + x0.z * x0.z + x0.w * x0.w) + (x1.x * x1.x + x1.y * x1.y + x1.z * x1.z + x1.w * x1.w)
                 + (x2.x * x2.x + x2.y * x2.y + x2.z * x2.z + x2.w * x2.w) + (x3.x * x3.x + x3.y * x3.y + x3.z * x3.z + x3.w * x3.w);
        ss = wave_sum(ss);
        if (lane == 0) rstd[tok] = rsqrtf(ss * (1.f / 1024.f) + 1e-6f);
    }
    __syncthreads();
    const float* gvg = a.in[9] + l * 1024; const float* wsp = a.in[10] + (size_t)l * 8 * 128 * 128; const float* bsp = a.in[11] + l * 8 * 128;
    const int tt = w & 3, chh = w >> 2;
    for (int g = 0; g < 8; ++g) {
        {
            const int s = tid & 127, cc = tid >> 7; const float rs = rstd[s]; const bf16_t* p = GV + (R0 + s) * 1024 + g * 128 + cc * 32;
#pragma unroll
            for (int q = 0; q < 4; ++q) {
                f32x4 x0, x1; unpack8(*(const u32x4*)(p + 8 * q), x0, x1);
                const float* gp = gvg + g * 128 + cc * 32 + 8 * q; const int c0 = cc * 32 + 8 * q;
                VNT[(c0 + 0) * 136 + s] = f2bf(x0.x * rs * gp[0]); VNT[(c0 + 1) * 136 + s] = f2bf(x0.y * rs * gp[1]);
                VNT[(c0 + 2) * 136 + s] = f2bf(x0.z * rs * gp[2]); VNT[(c0 + 3) * 136 + s] = f2bf(x0.w * rs * gp[3]);
                VNT[(c0 + 4) * 136 + s] = f2bf(x1.x * rs * gp[4]); VNT[(c0 + 5) * 136 + s] = f2bf(x1.y * rs * gp[5]);
                VNT[(c0 + 6) * 136 + s] = f2bf(x1.z * rs * gp[6]); VNT[(c0 + 7) * 136 + s] = f2bf(x1.w * rs * gp[7]);
            }
        }
        __syncthreads();
        f32x16 acc0, acc1;
#pragma unroll
        for (int i = 0; i < 16; ++i) { acc0[i] = 0.f; acc1[i] = 0.f; }
        const float* wrow = wsp + ((size_t)g * 128 + tt * 32 + r) * 128;
#pragma unroll
        for (int ks = 0; ks < 8; ++ks) {
            const f32x4 a0 = *(const f32x4*)(wrow + 16 * ks + 8 * h), a1 = *(const f32x4*)(wrow + 16 * ks + 8 * h + 4);
            const bf16x8 af = __builtin_bit_cast(bf16x8, pack8(a0, a1));
            const bf16x8 b0 = *(const bf16x8*)(VNT + (chh * 64 + r) * 136 + 16 * ks + 8 * h);
            const bf16x8 b1 = *(const bf16x8*)(VNT + (chh * 64 + 32 + r) * 136 + 16 * ks + 8 * h);
            acc0 = MFMA32(af, b0, acc0); acc1 = MFMA32(af, b1, acc1);
        }
#pragma unroll
        for (int reg = 0; reg < 16; ++reg) {
            const int t = tt * 32 + (reg & 3) + 8 * (reg >> 2) + 4 * h; const float bias = bsp[g * 128 + t];
            const size_t i0 = (R0 + t) * 1024 + g * 128 + chh * 64 + r;
            GU[i0] = f2bf(bf2f(GU[i0]) * (acc0[reg] + bias));
            GU[i0 + 32] = f2bf(bf2f(GU[i0 + 32]) * (acc1[reg] + bias));
        }
        __syncthreads();
    }
}
__device__ __forceinline__ void qk_rows(CArgs& a, int l, int gw, int ngw, int lane) {
    bf16_t* Q = (bf16_t*)(a.ws + WS_Q); bf16_t* K = (bf16_t*)(a.ws + WS_K);
    const float gq = a.in[12][l * 64 + lane], gk = a.in[13][l * 64 + lane];
    const float inv = exp2f(-(float)(lane & 15) * (13.287712379549449f / 16.f));
    for (int row = gw; row < M; row += ngw) {
        float cs = 1.f, sn = 0.f;
        if (row < ML) { const int t = row & 2047; const float pos = ((lane & 31) < 16) ? (float)(t >> 6) : (float)(t & 63); const float ang = pos * inv; sn = sinf(ang); cs = cosf(ang); }
        for (int hc = 0; hc < 16; ++hc) {
            const size_t idx = (size_t)row * 1024 + hc * 64 + lane;
            { const float x = bf2f(Q[idx]); const float ss = wave_sum(x * x); const float y = x * rsqrtf(ss * (1.f / 64.f) + 1e-6f) * gq;
              const float pr = __shfl_xor(y, 32); const float rot = lane < 32 ? -pr : pr; Q[idx] = f2bf((y * cs + rot * sn) * QSCALE); }
            { const float x = bf2f(K[idx]); const float ss = wave_sum(x * x); const float y = x * rsqrtf(ss * (1.f / 64.f) + 1e-6f) * gk;
              const float pr = __shfl_xor(y, 32); const float rot = lane < 32 ? -pr : pr; K[idx] = f2bf(y * cs + rot * sn); }
        }
    }
}
__device__ __forceinline__ void lora_in_rows(CArgs& a, int l, int gw, int ngw, int lane) {
    const bf16_t* RW = (const bf16_t*)(a.ws + WS_RW); bf16_t* LW = (bf16_t*)(a.ws + WS_LIW); bf16_t* LA = (bf16_t*)(a.ws + WS_LIA); bf16_t* LG = (bf16_t*)(a.ws + WS_LIG);
    const float* mu = a.in[16] + l * 3488 + 3072;
    for (int row = gw; row < M; row += ngw) {
        int t, Tn; if (row < ML) { t = row & 2047; Tn = 2048; } else { t = (row - ML) & 255; Tn = 256; }
        const bool hp = t > 0, hn = t < Tn - 1;
        const bf16_t* p = RW + (size_t)row * RWP + 3072;
        for (int i = 0; i < 7; ++i) {
            const int j = lane + 64 * i;
            if (j < 416) {
                const float x = bf2f(p[j]); const float xp = hp ? bf2f(p[j - RWP]) : 0.f; const float xn = hn ? bf2f(p[j + RWP]) : 0.f;
                const float z = x + mu[j] * (0.5f * (xp + xn) - x);
                if (j < 128) LW[(size_t)row * 128 + j] = f2bf(tanhf(z));
                else if (j < 256) LA[(size_t)row * 128 + j - 128] = f2bf(z);
                else LG[(size_t)row * 256 + j - 256] = f2bf(sigmoidf_(z));
            }
        }
        for (int j = 160 + lane; j < 256; j += 64) LG[(size_t)row * 256 + j] = 0;
    }
}

__device__ __forceinline__ void scan_unit(const TI ti, CArgs& a, int l, int u, bool ctx_out, unsigned char* ldsg) {
    const int tid = ti.tid, lane = tid & 63, w = tid >> 6;
    const int b = u >> 5, hh = (u >> 1) & 15, d = u & 1;
    const int si = tid >> 3, jq = tid & 7;
    LAS float* L = (LAS float*)ldsg;
    const bf16_t* RW = (const bf16_t*)(a.ws + WS_RW);
    const bf16_t* DEC = (const bf16_t*)(a.ws + (d ? WS_DEC1 : WS_GV));
    const bf16_t* AA = (const bf16_t*)(a.ws + (d ? WS_AA1 : WS_AA0));
    bf16_t* Y = (bf16_t*)(a.ws + (d ? WS_Y1 : WS_H));
    const int ch = hh * 64 + lane;
    const float* mu = a.in[16] + l * 3488;
    const float mur = mu[ch], muk = mu[1024 + ch], muv = mu[2048 + ch], kkg = a.in[22][l * 1024 + ch], kag = a.in[23][l * 1024 + ch];
    float S[8];
#pragma unroll
    for (int j = 0; j < 8; ++j) S[j] = 0.f;
    unsigned raw[4][9]; unsigned dcr[4], aar[4];
    constexpr int NC = 72;
#define SCAN_CHUNK(n, base, Tn, t0, wy) int base, Tn, t0; bool wy; { int ci; if ((n) < 8) { base = ML + b * 256; Tn = 256; ci = d ? 7 - (n) : (n); wy = ctx_out; } else { base = b * 2048; Tn = 2048; ci = d ? 71 - (n) : (n) - 8; wy = true; } t0 = ci * 32; }
#define SCAN_LOAD(n) do { SCAN_CHUNK(n, base_, Tn_, t0_, wy_); (void)wy_; _Pragma("unroll") for (int i4 = 0; i4 < 4; ++i4) { const int t = t0_ + w + 8 * i4; const size_t row = (size_t)(base_ + t); \
        const bf16_t* p = RW + row * RWP + ch; const bool hp = t > 0, hn = t < Tn_ - 1; \
        _Pragma("unroll") for (int X = 0; X < 3; ++X) { raw[i4][3 * X + 0] = hp ? (unsigned)p[X * 1024 - RWP] : 0u; raw[i4][3 * X + 1] = (unsigned)p[X * 1024]; raw[i4][3 * X + 2] = hn ? (unsigned)p[X * 1024 + RWP] : 0u; } \
        dcr[i4] = (unsigned)DEC[row * 1024 + ch]; aar[i4] = (unsigned)AA[row * 1024 + ch]; } } while (0)
#define SCAN_STORE(n) do { LAS float* Bf = L + ((n) & 1) * 12288; _Pragma("unroll") for (int i4 = 0; i4 < 4; ++i4) { const int tk = w + 8 * i4; \
        const float xr = bf2f(raw[i4][1]), xk = bf2f(raw[i4][4]), xv = bf2f(raw[i4][7]); \
        const float zr = xr + mur * (0.5f * (bf2f(raw[i4][0]) + bf2f(raw[i4][2])) - xr); \
        const float zk = xk + muk * (0.5f * (bf2f(raw[i4][3]) + bf2f(raw[i4][5])) - xk); \
        const float zv = xv + muv * (0.5f * (bf2f(raw[i4][6]) + bf2f(raw[i4][8])) - xv); \
        const float kkv = zk * kkg; const float ssq = wave_sum(kkv * kkv); const float kkn = kkv / fmaxf(sqrtf(ssq), 1e-12f); \
        const float ad = bf2f(aar[i4]); const float wv_ = __expf(bf2f(dcr[i4])); const float kd = zk * (1.f + (ad - 1.f) * kag); \
        Bf[0 * 2048 + tk * 64 + lane] = wv_; Bf[1 * 2048 + tk * 64 + lane] = kd; Bf[2 * 2048 + tk * 64 + lane] = -kkn; \
        Bf[3 * 2048 + tk * 64 + lane] = kkn * ad; Bf[4 * 2048 + tk * 64 + lane] = zr; Bf[5 * 2048 + tk * 64 + lane] = zv; } } while (0)
    SCAN_LOAD(0); SCAN_STORE(0);
    __syncthreads();
    for (int n = 0; n < NC; ++n) {
        if (n + 1 < NC) SCAN_LOAD(n + 1);
        LAS const float* Bf = L + (n & 1) * 12288; LAS float* Yb = L + 24576 + (n & 1) * 2048;
#pragma unroll 2
        for (int ss = 0; ss < 32; ++ss) {
            const int s = d ? 31 - ss : ss;
            LAS const float* q = Bf + s * 64 + 8 * jq;
            const f32x4 w0 = *(LAS const f32x4*)(q), w1 = *(LAS const f32x4*)(q + 4);
            const f32x4 k0 = *(LAS const f32x4*)(q + 2048), k1 = *(LAS const f32x4*)(q + 2048 + 4);
            const f32x4 a0 = *(LAS const f32x4*)(q + 4096), a1 = *(LAS const f32x4*)(q + 4096 + 4);
            const f32x4 b0 = *(LAS const f32x4*)(q + 6144), b1 = *(LAS const f32x4*)(q + 6144 + 4);
            const f32x4 r0 = *(LAS const f32x4*)(q + 8192), r1 = *(LAS const f32x4*)(q + 8192 + 4);
            const float vi = Bf[5 * 2048 + s * 64 + si];
            float sa = (S[0] * a0.x + S[1] * a0.y) + (S[2] * a0.z + S[3] * a0.w) + (S[4] * a1.x + S[5] * a1.y) + (S[6] * a1.z + S[7] * a1.w);
            sa += __shfl_xor(sa, 1); sa += __shfl_xor(sa, 2); sa += __shfl_xor(sa, 4);
            S[0] = S[0] * w0.x + (sa * b0.x + vi * k0.x); S[1] = S[1] * w0.y + (sa * b0.y + vi * k0.y);
            S[2] = S[2] * w0.z + (sa * b0.z + vi * k0.z); S[3] = S[3] * w0.w + (sa * b0.w + vi * k0.w);
            S[4] = S[4] * w1.x + (sa * b1.x + vi * k1.x); S[5] = S[5] * w1.y + (sa * b1.y + vi * k1.y);
            S[6] = S[6] * w1.z + (sa * b1.z + vi * k1.z); S[7] = S[7] * w1.w + (sa * b1.w + vi * k1.w);
            float y = (S[0] * r0.x + S[1] * r0.y) + (S[2] * r0.z + S[3] * r0.w) + (S[4] * r1.x + S[5] * r1.y) + (S[6] * r1.z + S[7] * r1.w);
            y += __shfl_xor(y, 1); y += __shfl_xor(y, 2); y += __shfl_xor(y, 4);
            if (jq == 0) Yb[s * 64 + si] = y;
        }
        if (n + 1 < NC) SCAN_STORE(n + 1);
        __syncthreads();
        {
            SCAN_CHUNK(n, base_, Tn_, t0_, wy_); (void)Tn_;
            if (wy_) {
#pragma unroll
                for (int i4 = 0; i4 < 4; ++i4) { const int tk = w + 8 * i4; Y[(size_t)(base_ + t0_ + tk) * 1024 + ch] = f2bf(Yb[tk * 64 + lane]); }
            }
        }
    }
    __syncthreads();
#undef SCAN_CHUNK
#undef SCAN_LOAD
#undef SCAN_STORE
}

__device__ __forceinline__ void attn_unit(const TI ti, CArgs& a, int b, int hd, int qrow0, int st_lo, int st_hi, float mfix, float lam, float lam_init, const float* subg, unsigned char* ldsg) {
    const int tid = ti.tid, lane = tid & 63, w = tid >> 6, r = lane & 31, h = lane >> 5, qt = w >> 1, c = w & 1;
    bf16_t* Qb = (bf16_t*)(a.ws + WS_Q); const bf16_t* Kb = (const bf16_t*)(a.ws + WS_K); const bf16_t* Vb = (const bf16_t*)(a.ws + WS_V);
    LAS unsigned char* L = (LAS unsigned char*)ldsg;
    constexpr int KOFF = 0, VOFF = 17408, BUFB = 35840;
    bf16x8 qf[4];
    { const bf16_t* qp = Qb + (size_t)(qrow0 + qt * 32 + r) * 1024 + hd * 128 + c * 64 + 8 * h;
#pragma unroll
      for (int ks = 0; ks < 4; ++ks) qf[ks] = *(const bf16x8*)(qp + 16 * ks); }
    f32x16 O[4];
#pragma unroll
    for (int e = 0; e < 4; ++e)
#pragma unroll
        for (int i = 0; i < 16; ++i) O[e][i] = 0.f;
    float lsum = 0.f;
    u32x4 kreg[2], vreg[2];
#define ATT_KROW(kk) ((kk) < 2048 ? (size_t)(b * 2048 + (kk)) : (size_t)(ML + b * 256 + (kk) - 2048))
#define ATT_LOAD(st) do { _Pragma("unroll") for (int i = 0; i < 2; ++i) { const int p = tid + 512 * i, key = p >> 4, dc = p & 15; kreg[i] = *(const u32x4*)(Kb + ATT_KROW((st) * 64 + key) * 1024 + hd * 128 + dc * 8); } \
        const bf16_t* vp = Vb + ATT_KROW((st) * 64 + lane) * 1024 + hd * 128 + w * 16; vreg[0] = *(const u32x4*)vp; vreg[1] = *(const u32x4*)(vp + 8); } while (0)
#define ATT_STORE(bufi) do { LAS unsigned char* Bb = L + (bufi) * BUFB; _Pragma("unroll") for (int i = 0; i < 2; ++i) { const int p = tid + 512 * i, key = p >> 4, dc = p & 15; *(LAS u32x4*)(Bb + KOFF + key * 272 + dc * 16) = kreg[i]; } \
        LAS bf16_t* vt = (LAS bf16_t*)(Bb + VOFF) + (w * 16) * 72 + lane; \
        _Pragma("unroll") for (int e = 0; e < 4; ++e) { vt[(2 * e) * 72] = (bf16_t)(vreg[0][e] & 0xffffu); vt[(2 * e + 1) * 72] = (bf16_t)(vreg[0][e] >> 16); \
            vt[(8 + 2 * e) * 72] = (bf16_t)(vreg[1][e] & 0xffffu); vt[(8 + 2 * e + 1) * 72] = (bf16_t)(vreg[1][e] >> 16); } } while (0)
    ATT_LOAD(st_lo); ATT_STORE(0);
    __syncthreads();
    for (int st = st_lo; st < st_hi; ++st) {
        const int bi = (st - st_lo) & 1;
        if (st + 1 < st_hi) ATT_LOAD(st + 1);
        LAS const unsigned char* Bb = L + bi * BUFB;
#pragma unroll
        for (int sub = 0; sub < 2; ++sub) {
            f32x16 Sx;
#pragma unroll
            for (int i = 0; i < 16; ++i) Sx[i] = 0.f;
#pragma unroll
            for (int ks = 0; ks < 4; ++ks) {
                const bf16x8 kf = *(LAS const bf16x8*)(Bb + KOFF + (sub * 32 + r) * 272 + (c * 64 + 16 * ks + 8 * h) * 2);
                Sx = MFMA32(kf, qf[ks], Sx);
            }
            float p[16];
#pragma unroll
            for (int i = 0; i < 16; ++i) { p[i] = __builtin_amdgcn_exp2f(Sx[i] - mfix); lsum += p[i]; }
            u32x4 pw0, pw1;
            pw0.x = pkbf(p[0], p[1]); pw0.y = pkbf(p[2], p[3]); pw0.z = pkbf(p[4], p[5]); pw0.w = pkbf(p[6], p[7]);
            pw1.x = pkbf(p[8], p[9]); pw1.y = pkbf(p[10], p[11]); pw1.z = pkbf(p[12], p[13]); pw1.w = pkbf(p[14], p[15]);
            const bf16x8 pb0 = __builtin_bit_cast(bf16x8, pw0), pb1 = __builtin_bit_cast(bf16x8, pw1);
#pragma unroll
            for (int et = 0; et < 4; ++et) {
#pragma unroll
                for (int s = 0; s < 2; ++s) {
                    LAS const unsigned char* va = Bb + VOFF + (et * 32 + r) * 144 + (sub * 32 + 16 * s + 4 * h) * 2;
                    const s16x4 lo = *(LAS const s16x4*)va, hi = *(LAS const s16x4*)(va + 16);
                    const bf16x8 vf = __builtin_shufflevector(lo, hi, 0, 1, 2, 3, 4, 5, 6, 7);
                    O[et] = MFMA32(vf, s ? pb1 : pb0, O[et]);
                }
            }
        }
        if (st + 1 < st_hi) ATT_STORE(bi ^ 1);
        __syncthreads();
    }
#undef ATT_KROW
#undef ATT_LOAD
#undef ATT_STORE
    const float ltot = lsum + __shfl_xor(lsum, 32);
    const float linv = 1.f / ltot;
    LAS float* X = (LAS float*)L + qt * 4096;
    if (c == 1) {
#pragma unroll
        for (int e = 0; e < 4; ++e)
#pragma unroll
            for (int i = 0; i < 16; ++i) X[(e * 16 + i) * 64 + lane] = O[e][i] * linv;
    }
    __syncthreads();
    if (c == 0) {
        float ssq = 0.f;
#pragma unroll
        for (int e = 0; e < 4; ++e)
#pragma unroll
            for (int i = 0; i < 16; ++i) { const float o = O[e][i] * linv - lam * X[(e * 16 + i) * 64 + lane]; O[e][i] = o; ssq += o * o; }
        ssq += __shfl_xor(ssq, 32);
        const float sc = rsqrtf(ssq * (1.f / 128.f) + 1e-6f) * (1.f - lam_init);
        bf16_t* op = Qb + (size_t)(qrow0 + qt * 32 + r) * 1024 + hd * 128;
#pragma unroll
        for (int e = 0; e < 4; ++e)
#pragma unroll
            for (int g4 = 0; g4 < 4; ++g4) {
                const int e0 = e * 32 + 8 * g4 + 4 * h; const f32x4 sg = *(const f32x4*)(subg + e0);
                u32x2 o; o.x = pkbf(O[e][4 * g4 + 0] * sc * sg.x, O[e][4 * g4 + 1] * sc * sg.y); o.y = pkbf(O[e][4 * g4 + 2] * sc * sg.z, O[e][4 * g4 + 3] * sc * sg.w);
                *(u32x2*)(op + e0) = o;
            }
    }
    __syncthreads();
}
__device__ __forceinline__ void ph_attn(const TI ti, CArgs& a, int l, bool ctx_out, unsigned char* ldsg) {
    const int lane = ti.tid & 63;
    const float gqm = fabsf(a.in[12][l * 64 + lane]), gkm = fabsf(a.in[13][l * 64 + lane]);
    float mq = gqm, mk = gkm;
#pragma unroll
    for (int o = 1; o < 64; o <<= 1) { mq = fmaxf(mq, __shfl_xor(mq, o)); mk = fmaxf(mk, __shfl_xor(mk, o)); }
    const float mfix = 8.f * mq * mk * 1.4426950408889634f * 1.03f;
    const float* lp = a.in[14] + l * 256;
    const float s1 = wave_sum(lp[lane] * lp[64 + lane]), s2 = wave_sum(lp[128 + lane] * lp[192 + lane]);
    const float lam_init = 0.8f - 0.6f * expf(-0.3f * (float)l);
    const float lam = expf(s1) - expf(s2) + lam_init;
    const float* subg = a.in[15] + l * 128;
    const int nun = 1024 + (ctx_out ? 128 : 0);
    for (int u = ti.bid; u < nun; u += ti.nblk) {
        if (u < 1024) { const int bh = u >> 4, qb = u & 15; attn_unit(ti, a, bh >> 3, bh & 7, (bh >> 3) * 2048 + qb * 128, 0, 36, mfix, lam, lam_init, subg, ldsg); }
        else { const int v = u - 1024, bh = v >> 1, qb = v & 1; attn_unit(ti, a, bh >> 3, bh & 7, ML + (bh >> 3) * 256 + qb * 128, 32, 36, mfix, lam, lam_init, subg, ldsg); }
    }
}

__device__ __forceinline__ void rwkv_out_rows(CArgs& a, int l, int nrows, int gw, int ngw, int lane) {
    const bf16_t* RW = (const bf16_t*)(a.ws + WS_RW); const bf16_t* Y0 = (const bf16_t*)(a.ws + WS_H); bf16_t* Y1 = (bf16_t*)(a.ws + WS_Y1);
    const bf16_t* A0 = (const bf16_t*)(a.ws + WS_AA0); const bf16_t* A1 = (const bf16_t*)(a.ws + WS_AA1); const bf16_t* G = (const bf16_t*)(a.ws + WS_G);
    const float* mu = a.in[16] + l * 3488;
    for (int row = gw; row < nrows; row += ngw) {
        int t, Tn; if (row < ML) { t = row & 2047; Tn = 2048; } else { t = (row - ML) & 255; Tn = 256; }
        const bool hp = t > 0, hn = t < Tn - 1;
        for (int hh = 0; hh < 16; ++hh) {
            const int ch = hh * 64 + lane; const size_t idx = (size_t)row * 1024 + ch;
            const float y = bf2f(Y0[idx]) + bf2f(Y1[idx]);
            const float mean = wave_sum(y) * (1.f / 64.f); const float dv = y - mean; const float var = wave_sum(dv * dv) * (1.f / 64.f);
            const float yn = dv * rsqrtf(var + 64e-5f) * a.in[25][l * 1024 + ch] + a.in[26][l * 1024 + ch];
            const bf16_t* p = RW + (size_t)row * RWP + ch;
            float z[3];
#pragma unroll
            for (int X = 0; X < 3; ++X) { const float x = bf2f(p[X * 1024]); const float xp = hp ? bf2f(p[X * 1024 - RWP]) : 0.f; const float xn = hn ? bf2f(p[X * 1024 + RWP]) : 0.f;
                z[X] = x + mu[X * 1024 + ch] * (0.5f * (xp + xn) - x); }
            const float ka = a.in[23][l * 1024 + ch];
            const float kds = z[1] * (1.f + (bf2f(A0[idx]) - 1.f) * ka) + z[1] * (1.f + (bf2f(A1[idx]) - 1.f) * ka);
            const float bonus = wave_sum(z[0] * kds * a.in[24][l * 1024 + ch]) * z[2];
            Y1[idx] = f2bf((yn + bonus) * bf2f(G[idx]));
        }
    }
}

#ifndef ONLY_PH
#define ONLY_PH -1
#endif
#ifndef SKIP_PH
#define SKIP_PH -2
#endif
#define PH_ON(k) ((ONLY_PH < 0 || ONLY_PH == (k)) && (k) != SKIP_PH)
__global__ void __launch_bounds__(512, 2) mega_fwd(Args a_) {
    extern __shared__ __attribute__((aligned(16))) unsigned char lds[];
    cg::grid_group grid = cg::this_grid();
    const int ph_lo = a_.lo, ph_hi = a_.hi;
#pragma nounroll
    for (int ph = ph_lo; ph < ph_hi; ++ph) {
        CArgs* ap = (CArgs*)__builtin_amdgcn_kernarg_segment_ptr(); asm volatile("" : "+s"(ap));
        CArgs& a = *ap;
        unsigned char* ws = a.ws;
        float* XC = (float*)(ws + WS_XC);
        TI ti; ti.tid = threadIdx.x; ti.bid = blockIdx.x; ti.nblk = gridDim.x;
        asm volatile("" : "+v"(ti.tid)); asm volatile("" : "+s"(ti.bid)); asm volatile("" : "+s"(ti.nblk));
        const int tid = ti.tid, lane = tid & 63, wv = __builtin_amdgcn_readfirstlane(tid >> 6);
        const int gw = ti.bid * 8 + wv, ngw = ti.nblk * 8;
        if (ph == 0) { if constexpr (PH_ON(100)) ph_mods(ti, a, lds); }
        else {
            const int l = (ph - 1) / NPH, k = (ph - 1) % NPH;
            const bool ctx_out = l < DEPTH - 1;
            const int Mr = ctx_out ? M : ML;
            const float* modl = (const float*)(ws + WS_MOD) + (size_t)l * 9 * 6144;
            const float* xl_in = l == 0 ? a.in[0] : a.out; const float* xc_in = l == 0 ? a.in[2] : XC;
            bf16_t* H = (bf16_t*)(ws + WS_H);
            switch (k) {
            case 0: if constexpr (PH_ON(0)) {
                norm_rows(xl_in, xc_in, a.in[6] + l * 1024, modl, 0, 1, H, M, gw, ngw, lane);
                ph_wconv(a, l, lds, gw, ngw, lane, wv);
                } break;
            case 1: if constexpr (PH_ON(1)) {
                OpIn op{(bf16_t*)(ws + WS_GU), (bf16_t*)(ws + WS_GV), (bf16_t*)(ws + WS_Q), (bf16_t*)(ws + WS_RW), (bf16_t*)(ws + WS_GT)};
                run_gemm(ti, lds, H, (const bf16_t*)(ws + WS_WIN), M, PPAD, 1024, op);
            } break;
            case 2: if constexpr (PH_ON(2)) {
                for (int u = ti.bid; u < Mr / 128; u += ti.nblk) gmlp_unit(ti, a, l, u, lds);
                qk_rows(a, l, gw, ngw, lane);
                lora_in_rows(a, l, gw, ngw, lane);
                } break;
            case 3: if constexpr (PH_ON(3)) {
                OpDec o1{(bf16_t*)(ws + WS_GV), (bf16_t*)(ws + WS_DEC1), a.in[17] + l * 2048};
                run_gemm(ti, lds, (const bf16_t*)(ws + WS_LIW), (const bf16_t*)(ws + WS_LWT), M, 2048, 128, o1);
                OpAA o2{(bf16_t*)(ws + WS_AA0), (bf16_t*)(ws + WS_AA1), a.in[19] + l * 2048};
                run_gemm(ti, lds, (const bf16_t*)(ws + WS_LIA), (const bf16_t*)(ws + WS_LAT), M, 2048, 128, o2);
                OpG o3{(bf16_t*)(ws + WS_G)};
                run_gemm(ti, lds, (const bf16_t*)(ws + WS_LIG), (const bf16_t*)(ws + WS_LGT), M, 1024, 256, o3);
            } break;
            case 4:
                if constexpr (PH_ON(4)) { for (int u = ti.bid; u < 256; u += ti.nblk) scan_unit(ti, a, l, u, ctx_out, lds); }
                if constexpr (PH_ON(40)) ph_attn(ti, a, l, ctx_out, lds);
                break;
            case 5: if constexpr (PH_ON(5)) {
                rwkv_out_rows(a, l, Mr, gw, ngw, lane);
                } break;
            case 6: if constexpr (PH_ON(6)) {
                const bf16_t* GT = (const bf16_t*)(ws + WS_GT); float* MF = (float*)(ws + WS_K);
                OpMerge<0> o0{GT, MF, H}; run_gemm(ti, lds, (const bf16_t*)(ws + WS_GU), (const bf16_t*)(ws + WS_WA), Mr, 1024, 1024, o0);
                OpMerge<1> o1{GT, MF, H}; run_gemm(ti, lds, (const bf16_t*)(ws + WS_Q), (const bf16_t*)(ws + WS_WB), Mr, 1024, 1024, o1);
                OpMerge<2> o2{GT, MF, H}; run_gemm(ti, lds, (const bf16_t*)(ws + WS_Y1), (const bf16_t*)(ws + WS_WC), Mr, 1024, 1024, o2);
            } break;
            case 7: if constexpr (PH_ON(7)) {
                OpResid op{xl_in, xc_in, a.out, XC, modl, 2};
                run_gemm(ti, lds, H, (const bf16_t*)(ws + WS_WO), Mr, 1024, 1024, op);
            } break;
            case 8: if constexpr (PH_ON(8)) {
                norm_rows(a.out, XC, a.in[7] + l * 1024, modl, 3, 4, H, Mr, gw, ngw, lane);
                } break;
            case 9: if constexpr (PH_ON(9)) {
                OpSwiglu op{(bf16_t*)(ws + WS_RW)};
                run_gemm(ti, lds, H, (const bf16_t*)(ws + WS_WI), Mr, 2 * DFF, 1024, op);
            } break;
            default: if constexpr (PH_ON(10)) {
                OpResid op{a.out, XC, a.out, XC, modl, 5};
                run_gemm(ti, lds, (const bf16_t*)(ws + WS_RW), (const bf16_t*)(ws + WS_WO2), Mr, 1024, DFF, op);
            } break;
            }
        }
        if (ph + 1 < ph_hi) grid.sync();
    }
}

extern "C" void kernel_launch(void* const* d_in, const int* in_sizes, int n_in, void* d_out, int out_size, void* d_ws, size_t ws_size, hipStream_t stream) {
    static int grid = 0;
    if (grid == 0) {
        if (n_in != 33 || out_size != ML * D || ws_size < WS_END) { fprintf(stderr, "kernel_launch: unexpected shapes / workspace (%d inputs, out %d, ws %zu, need %zu)\n", n_in, out_size, ws_size, (size_t)WS_END); grid = -1; return; }
        int dev = 0, cus = 0, per_cu = 0;
        hipGetDevice(&dev); hipDeviceGetAttribute(&cus, hipDeviceAttributeMultiprocessorCount, dev);
        if (hipFuncSetAttribute((const void*)mega_fwd, hipFuncAttributeMaxDynamicSharedMemorySize, LDS_BYTES) != hipSuccess) { fprintf(stderr, "kernel_launch: hipFuncSetAttribute failed\n"); grid = -1; return; }
        if (hipOccupancyMaxActiveBlocksPerMultiprocessor(&per_cu, (const void*)mega_fwd, 512, LDS_BYTES) != hipSuccess || per_cu < 1) per_cu = 1;
        (void)hipGetLastError();
        grid = cus * 1;
    }
    if (grid < 0) return;
    Args a{};
    for (int i = 0; i < 33; ++i) a.in[i] = (const float*)d_in[i];
    a.out = (float*)d_out; a.ws = (unsigned char*)d_ws; a.lo = 0; a.hi = NPHASES;
    void* args[] = {&a};
    hipError_t e = hipLaunchCooperativeKernel((const void*)mega_fwd, dim3(grid), dim3(512), args, LDS_BYTES, stream);
    if (e != hipSuccess) fprintf(stderr, "kernel_launch: cooperative launch failed: %s (grid %d)\n", hipGetErrorString(e), grid);
}
```

```cpp
#include <hip/hip_runtime.h>
#include <hip/hip_cooperative_groups.h>
#include <cstdio>
#include <cstdint>
namespace cg = cooperative_groups;
namespace pg8 {
#define PG8_LAS __attribute__((address_space(3)))
typedef unsigned short bf16_t;
typedef short bf16x8 __attribute__((ext_vector_type(8)));
typedef float f32x4 __attribute__((ext_vector_type(4)));
typedef unsigned u32x4 __attribute__((ext_vector_type(4)));
constexpr int BM = 256, BK = 64, HALF = 128, HTB = HALF * BK * 2  , STAGE_BYTES = 8 * HTB, NXCD = 8, WGM = 8;

__host__ __device__ __forceinline__ int lds_byte(int r, int c) { const int st = (r >> 4) * 2 + (c >> 5), rr = r & 15, cc = c & 31, ob = rr * 64 + cc * 2; return st * 1024 + (ob ^ (((ob >> 9) & 1) << 5)); }
__host__ __device__ __forceinline__ void stage_rc(int b, int& R, int& C) { const int st = b / 1024, sb = b % 1024, swz = sb ^ (((sb >> 9) & 1) << 5); R = (st >> 1) * 16 + swz / 64; C = (st & 1) * 32 + (swz % 64) / 2; }
__host__ __device__ __forceinline__ int perm32(int rho) { const int n = rho >> 4, i = rho & 15; return 8 * (i >> 2) + 4 * n + (i & 3); }

struct Unit { int pm, pn; };
struct Gemm { const bf16_t* A; const bf16_t* Bt; int M, N, K; };

struct StaticOrder {
    int nM, nN, nwg, G, c;
    __host__ __device__ void init(int M, int N, int G_, int c_) { nM = M / BM; nN = N / BM; nwg = nM * nN; G = G_; c = c_; }
    __host__ __device__ bool next(int i, Unit& u) const {
        const long L = (long)i * G + c; if (L >= nwg) return false;
        int wgid = (int)L; { const int q = nwg / NXCD, r = nwg % NXCD, xcd = wgid % NXCD, off = wgid / NXCD; wgid = (xcd < r ? xcd * (q + 1) : r * (q + 1) + (xcd - r) * q) + off; }
        const int nig = WGM * nN, gid = wgid / nig, fm = gid * WGM, gsz = (nM - fm) < WGM ? (nM - fm) : WGM;
        u.pm = fm + ((wgid % nig) % gsz); u.pn = (wgid % nig) / gsz; return true;
    }
    __device__ __forceinline__ void a_ready(const Unit&) const {}
    __device__ __forceinline__ void done(const Unit&) const {}
};

__device__ __forceinline__ unsigned cvt_pk_bf16(float lo, float hi) { unsigned r; asm volatile("v_cvt_pk_bf16_f32 %0, %1, %2" : "=v"(r) : "v"(lo), "v"(hi)); return r; }
typedef float f32x2 __attribute__((ext_vector_type(2)));
__device__ __forceinline__ f32x2 gelu_pk(f32x2 v) {
    const f32x2 av = __builtin_elementwise_abs(v), d = av * 0.2316418882f + 1.0f;
    f32x2 t; t.x = __builtin_amdgcn_rcpf(d.x); t.y = __builtin_amdgcn_rcpf(d.y);
    f32x2 q = t * 0.5307027145f + (-0.7265760135f); q = q * t + 0.7107068705f; q = q * t + (-0.142248368f); q = q * t + 0.127414796f; q = q * t;
    const f32x2 s = (v * v) * (-0.72134752044f);
    f32x2 e; e.x = __builtin_amdgcn_exp2f(s.x); e.y = __builtin_amdgcn_exp2f(s.y);
    const f32x2 m = v * (q * e), r = v - m;
    f32x2 o; o.x = v.x < 0.f ? m.x : r.x; o.y = v.y < 0.f ? m.y : r.y; return o;
}

template <class Epi, class Sched, bool ALIGN_EPI = false, bool SP2 = false>
__device__ __forceinline__ void gemm_phase(PG8_LAS unsigned char* lds, const Gemm g, const Sched& S, const Epi& E, const int tid_in) {
    const int tid = tid_in, wid = __builtin_amdgcn_readfirstlane(tid >> 6), lane = tid & 63, wr = wid >> 2, wc = wid & 3, fr = lane & 15, fq = lane >> 4;
    const int K = g.K, nt = K / BK;
    unsigned voffA[2], voffB[2];
#pragma unroll
    for (int i = 0; i < 2; ++i) { int R, C; stage_rc(tid * 16 + i * 8192, R, C); const int Rb = Epi::PERM ? ((R & ~31) + perm32(R & 31)) : R;
        voffA[i] = (unsigned)(R * K + C) * 2u; voffB[i] = (unsigned)(Rb * K + C) * 2u; }
    const size_t kstep = (size_t)(BK * 2);
    const size_t hstep = (size_t)HALF * K * 2;
    const size_t tstep = 2 * hstep;
    const unsigned ldsw = (unsigned)wid * 1024u;
    const int aoff = lds_byte(wr * 64 + fr, fq * 8), boff = lds_byte(wc * 32 + fr, fq * 8);
#define PG8_SA(b, h) (((b) * 2 + (h)) * HTB)
#define PG8_SB(b, h) ((4 + (b) * 2 + (h)) * HTB)
#define PG8_STAGE(bufoff, gbase, voff) do { _Pragma("unroll") for (int _i = 0; _i < 2; ++_i) \
        __builtin_amdgcn_global_load_lds((const unsigned*)((const char*)(gbase) + (voff)[_i]), (PG8_LAS unsigned*)(lds + (bufoff) + ldsw + _i * 8192), 16, 0, 0); } while (0)
#define PG8_LDA(dst, b, h) do { _Pragma("unroll") for (int m = 0; m < 4; ++m) _Pragma("unroll") for (int k = 0; k < 2; ++k) dst[m][k] = *(const PG8_LAS bf16x8*)(lds + PG8_SA(b, h) + aoff + m * 2048 + k * 1024); } while (0)
#define PG8_LDB(dst, b, h) do { _Pragma("unroll") for (int n = 0; n < 2; ++n) _Pragma("unroll") for (int k = 0; k < 2; ++k) dst[n][k] = *(const PG8_LAS bf16x8*)(lds + PG8_SB(b, h) + boff + n * 2048 + k * 1024); } while (0)
#define PG8_MMA(ai, bj, At, Bt) do { __builtin_amdgcn_s_setprio(1); _Pragma("unroll") for (int m = 0; m < 4; ++m) _Pragma("unroll") for (int n = 0; n < 2; ++n) _Pragma("unroll") for (int k = 0; k < 2; ++k) \
        acc[ai][bj][m][n] = __builtin_amdgcn_mfma_f32_16x16x32_bf16(Bt[n][k], At[m][k], acc[ai][bj][m][n], 0, 0, 0); __builtin_amdgcn_s_setprio(0); } while (0)
#define PG8_WAIT_V(n) asm volatile("s_waitcnt vmcnt(" #n ")" ::: "memory")
#define PG8_WAIT_L(n) asm volatile("s_waitcnt lgkmcnt(" #n ")" ::: "memory")
#define PG8_BAR __builtin_amdgcn_s_barrier()
#define PG8_SCHED __builtin_amdgcn_sched_barrier(0)
    Unit cur, nxt; int ui = 0;
    if (!S.next(0, cur)) return;
    f32x4 acc[2][2][4][2];
#pragma unroll
    for (int a = 0; a < 2; ++a)
#pragma unroll
        for (int b = 0; b < 2; ++b)
#pragma unroll
            for (int m = 0; m < 4; ++m)
#pragma unroll
                for (int n = 0; n < 2; ++n) acc[a][b][m][n] = (f32x4){0.f, 0.f, 0.f, 0.f};
    bf16x8 At[4][2], B0[2][2], B1[2][2];
    const char* cA = (const char*)g.A + (size_t)cur.pm * tstep; const char* cB = (const char*)g.Bt + (size_t)cur.pn * tstep;
    S.a_ready(cur);
    if constexpr (SP2) {
        PG8_STAGE(PG8_SB(0, 0), cB, voffB); PG8_STAGE(PG8_SB(0, 1), cB + hstep, voffB); PG8_STAGE(PG8_SA(0, 0), cA, voffA); PG8_STAGE(PG8_SA(0, 1), cA + hstep, voffA);
        if (wr == 1) PG8_BAR;
        PG8_WAIT_V(2); PG8_BAR;
        PG8_STAGE(PG8_SB(1, 0), cB + kstep, voffB); PG8_STAGE(PG8_SA(1, 0), cA + kstep, voffA); PG8_STAGE(PG8_SB(1, 1), cB + hstep + kstep, voffB);
        PG8_WAIT_V(6); PG8_BAR;
    } else {
        PG8_STAGE(PG8_SB(0, 0), cB, voffB); PG8_STAGE(PG8_SA(0, 0), cA, voffA); PG8_STAGE(PG8_SB(0, 1), cB + hstep, voffB); PG8_STAGE(PG8_SA(0, 1), cA + hstep, voffA);
        if (wr == 1) PG8_BAR;
        PG8_WAIT_V(4); PG8_BAR;
        PG8_STAGE(PG8_SB(1, 0), cB + kstep, voffB); PG8_STAGE(PG8_SA(1, 0), cA + kstep, voffA); PG8_STAGE(PG8_SB(1, 1), cB + hstep + kstep, voffB);
        PG8_WAIT_V(6); PG8_BAR;
    }
    for (;;) {
        const bool has_next = S.next(ui + 1, nxt);
        const char* nA = has_next ? (const char*)g.A + (size_t)nxt.pm * tstep : cA; const char* nB = has_next ? (const char*)g.Bt + (size_t)nxt.pn * tstep : cB;
        for (int t = 0; t < nt; t += 2) {
            const bool last = (t == nt - 2);
            const char* a1 = cA + (size_t)(t + 1) * kstep;
            const char* a2 = last ? nA : cA + (size_t)(t + 2) * kstep; const char* b2 = last ? nB : cB + (size_t)(t + 2) * kstep;
            const char* a3 = a2 + kstep; const char* b3 = b2 + kstep;
            if (last && has_next) S.a_ready(nxt);
            if constexpr (SP2) {
            PG8_LDB(B0, 0, 0); PG8_LDB(B1, 0, 1); PG8_SCHED; PG8_LDA(At, 0, 0); PG8_STAGE(PG8_SA(1, 1), a1 + hstep, voffA);
            PG8_WAIT_V(8); PG8_WAIT_L(0); PG8_BAR; PG8_MMA(0, 0, At, B0); PG8_MMA(0, 1, At, B1); PG8_BAR; PG8_SCHED;
            PG8_LDA(At, 0, 1); PG8_STAGE(PG8_SB(0, 0), b2, voffB); PG8_STAGE(PG8_SB(0, 1), b2 + hstep, voffB); PG8_STAGE(PG8_SA(0, 0), a2, voffA);
            PG8_WAIT_V(8); PG8_WAIT_L(0); PG8_BAR; PG8_MMA(1, 0, At, B0); PG8_MMA(1, 1, At, B1); PG8_BAR; PG8_SCHED;
            PG8_LDB(B0, 1, 0); PG8_LDB(B1, 1, 1); PG8_SCHED; PG8_LDA(At, 1, 0); PG8_STAGE(PG8_SA(0, 1), a2 + hstep, voffA);
            PG8_WAIT_V(8); PG8_WAIT_L(0); PG8_BAR; PG8_MMA(0, 0, At, B0); PG8_MMA(0, 1, At, B1); PG8_BAR; PG8_SCHED;
            PG8_LDA(At, 1, 1); PG8_STAGE(PG8_SB(1, 0), b3, voffB); PG8_STAGE(PG8_SB(1, 1), b3 + hstep, voffB); PG8_STAGE(PG8_SA(1, 0), a3, voffA);
            PG8_WAIT_V(8); PG8_WAIT_L(0); PG8_BAR; PG8_MMA(1, 0, At, B0); PG8_MMA(1, 1, At, B1); PG8_BAR; PG8_SCHED;
            } else {
            PG8_LDB(B0, 0, 0); PG8_SCHED; PG8_LDA(At, 0, 0); PG8_STAGE(PG8_SA(1, 1), a1 + hstep, voffA);
            PG8_WAIT_L(8); PG8_BAR; PG8_WAIT_L(0); PG8_MMA(0, 0, At, B0); PG8_BAR; PG8_SCHED;
            PG8_LDB(B1, 0, 1); PG8_STAGE(PG8_SB(0, 0), b2, voffB);
            PG8_BAR; PG8_WAIT_L(0); PG8_MMA(0, 1, At, B1); PG8_BAR;
            PG8_LDA(At, 0, 1); PG8_STAGE(PG8_SA(0, 0), a2, voffA);
            PG8_BAR; PG8_WAIT_L(0); PG8_MMA(1, 0, At, B0); PG8_BAR; PG8_SCHED;
            PG8_STAGE(PG8_SB(0, 1), b2 + hstep, voffB);
            PG8_WAIT_V(6); PG8_BAR; PG8_MMA(1, 1, At, B1); PG8_BAR;
            PG8_LDB(B0, 1, 0); PG8_SCHED; PG8_LDA(At, 1, 0); PG8_STAGE(PG8_SA(0, 1), a2 + hstep, voffA);
            PG8_WAIT_L(8); PG8_BAR; PG8_WAIT_L(0); PG8_MMA(0, 0, At, B0); PG8_BAR; PG8_SCHED;
            PG8_LDB(B1, 1, 1); PG8_STAGE(PG8_SB(1, 0), b3, voffB);
            PG8_BAR; PG8_WAIT_L(0); PG8_MMA(0, 1, At, B1); PG8_BAR;
            PG8_LDA(At, 1, 1); PG8_STAGE(PG8_SA(1, 0), a3, voffA);
            PG8_BAR; PG8_WAIT_L(0); PG8_MMA(1, 0, At, B0); PG8_BAR; PG8_SCHED;
            PG8_STAGE(PG8_SB(1, 1), b3 + hstep, voffB);
            PG8_WAIT_V(6); PG8_BAR; PG8_MMA(1, 1, At, B1); PG8_BAR;
            }
        }
        if constexpr (ALIGN_EPI) { if (wr == 0) PG8_BAR; }
        if constexpr (!Epi::AFTER_DRAIN) { E(acc, cur, wr, wc, fr, fq); S.done(cur); }
        if (!has_next) break;
#pragma unroll
        for (int a = 0; a < 2; ++a)
#pragma unroll
            for (int b = 0; b < 2; ++b)
#pragma unroll
                for (int m = 0; m < 4; ++m)
#pragma unroll
                    for (int n = 0; n < 2; ++n) acc[a][b][m][n] = (f32x4){0.f, 0.f, 0.f, 0.f};
        cur = nxt; cA = nA; cB = nB; ++ui;
        if constexpr (ALIGN_EPI) { if (wr == 1) PG8_BAR; }
    }
    PG8_WAIT_V(0);
    if constexpr (!ALIGN_EPI) { if (wr == 0) PG8_BAR; }
    PG8_BAR;
    if constexpr (Epi::AFTER_DRAIN) { E.fused(acc, cur, wr, wc, fr, fq, lds, wid, lane); S.done(cur); }
#undef PG8_SA
#undef PG8_SB
#undef PG8_STAGE
#undef PG8_LDA
#undef PG8_LDB
#undef PG8_MMA
#undef PG8_WAIT_V
#undef PG8_WAIT_L
#undef PG8_BAR
#undef PG8_SCHED
}
}

#define LAS __attribute__((address_space(3)))
typedef unsigned short bf16_t;
typedef float f32x2 __attribute__((ext_vector_type(2)));
typedef float f32x4 __attribute__((ext_vector_type(4)));
typedef float f32x16 __attribute__((ext_vector_type(16)));
typedef short bf16x8 __attribute__((ext_vector_type(8)));
typedef short s16x4 __attribute__((ext_vector_type(4)));
typedef unsigned u32x4 __attribute__((ext_vector_type(4)));
typedef unsigned u32x2 __attribute__((ext_vector_type(2)));
typedef __bf16 bf16x2v __attribute__((ext_vector_type(2)));
#define MFMA32(a, b, c) __builtin_amdgcn_mfma_f32_32x32x16_bf16((a), (b), (c), 0, 0, 0)

constexpr int D = 1024, NB = 8, TL = 2048, TCX = 256, DEPTH = 4;
constexpr int ML = NB * TL, MC = NB * TCX, M = ML + MC;
constexpr int PPAD = 11776, RWP = 3584, DFF = 2816;
constexpr int NPH = 11, NPHASES = 1 + DEPTH * NPH;
constexpr size_t MiB = 1u << 20;
constexpr size_t WS_MOD = 0, WS_WIN = 1 * MiB, WS_WA = 24 * MiB, WS_WB = 26 * MiB, WS_WC = 28 * MiB, WS_WO = 30 * MiB, WS_WI = 32 * MiB, WS_WO2 = 43 * MiB,
                 WS_LWT = 48 * MiB + MiB / 2, WS_LAT = 49 * MiB, WS_LGT = 49 * MiB + MiB / 2, WS_H = 50 * MiB, WS_XC = 86 * MiB, WS_GU = 94 * MiB, WS_GV = 130 * MiB,
                 WS_Q = 166 * MiB, WS_K = 202 * MiB, WS_V = 238 * MiB, WS_RW = 274 * MiB, WS_GT = 400 * MiB, WS_LIW = 508 * MiB, WS_LIA = 512 * MiB + MiB / 2,
                 WS_LIG = 517 * MiB, WS_DEC1 = 526 * MiB, WS_AA0 = 562 * MiB, WS_AA1 = 598 * MiB, WS_G = 634 * MiB, WS_Y1 = 670 * MiB, WS_END = 706 * MiB;
constexpr int LDS_BYTES = 131072 + 1024;
constexpr size_t WS_BAR = 917504, BAR_BYTES = 16384;
constexpr float QSCALE = 0.125f * 1.4426950408889634f;

struct Args { const float* in[33]; float* out; unsigned char* ws; int lo, hi; };
typedef const __attribute__((address_space(4))) Args CArgs;
struct TI { int tid, bid, nblk; };

__device__ __forceinline__ float bf2f(unsigned v) { return __uint_as_float(v << 16); }
__device__ __forceinline__ unsigned pkbf(float lo, float hi) { f32x2 v = {lo, hi}; bf16x2v b = __builtin_convertvector(v, bf16x2v); return __builtin_bit_cast(unsigned, b); }
__device__ __forceinline__ bf16_t f2bf(float f) { return (bf16_t)(pkbf(f, 0.f) & 0xffffu); }
__device__ __forceinline__ float wave_sum(float v) {
#pragma unroll
    for (int o = 1; o < 64; o <<= 1) v += __shfl_xor(v, o);
    return v;
}
__device__ __forceinline__ float dpp_sum8(float x) {
    x += __builtin_bit_cast(float, __builtin_amdgcn_update_dpp(0, __builtin_bit_cast(int, x), 0xB1, 0xf, 0xf, true));
    x += __builtin_bit_cast(float, __builtin_amdgcn_update_dpp(0, __builtin_bit_cast(int, x), 0x4E, 0xf, 0xf, true));
    x += __builtin_bit_cast(float, __builtin_amdgcn_update_dpp(0, __builtin_bit_cast(int, x), 0x141, 0xf, 0xf, true));
    return x;
}
__device__ __forceinline__ float sigmoidf_(float x) { return 1.f / (1.f + __expf(-x)); }

template <class Op> struct EpiT {
    static constexpr bool PERM = true, AFTER_DRAIN = false;
    Op op;
    __device__ __forceinline__ void operator()(const pg8::f32x4 (&acc)[2][2][4][2], const pg8::Unit& u, int wr, int wc, int fr, int fq) const {
        const int row0 = u.pm * 256 + wr * 64 + fr, col0 = u.pn * 256 + wc * 32 + 8 * fq;
#pragma unroll
        for (int ai = 0; ai < 2; ++ai)
#pragma unroll
            for (int m = 0; m < 4; ++m)
#pragma unroll
                for (int bj = 0; bj < 2; ++bj) op(row0 + ai * 128 + m * 16, col0 + bj * 128, acc[ai][bj][m][0], acc[ai][bj][m][1]);
    }
};
__device__ __forceinline__ u32x4 pack8(f32x4 v0, f32x4 v1) { u32x4 o; o.x = pkbf(v0.x, v0.y); o.y = pkbf(v0.z, v0.w); o.z = pkbf(v1.x, v1.y); o.w = pkbf(v1.z, v1.w); return o; }
__device__ __forceinline__ void unpack8(u32x4 x, f32x4& v0, f32x4& v1) {
    v0.x = bf2f(x.x & 0xffffu); v0.y = bf2f(x.x >> 16); v0.z = bf2f(x.y & 0xffffu); v0.w = bf2f(x.y >> 16);
    v1.x = bf2f(x.z & 0xffffu); v1.y = bf2f(x.z >> 16); v1.z = bf2f(x.w & 0xffffu); v1.w = bf2f(x.w >> 16);
}
__device__ __forceinline__ f32x4 gelu4(f32x4 v) { pg8::f32x2 a = pg8::gelu_pk((pg8::f32x2){v.x, v.y}), b = pg8::gelu_pk((pg8::f32x2){v.z, v.w}); return (f32x4){a.x, a.y, b.x, b.y}; }
__device__ __forceinline__ f32x4 sig4(f32x4 v) { return (f32x4){sigmoidf_(v.x), sigmoidf_(v.y), sigmoidf_(v.z), sigmoidf_(v.w)}; }

struct OpIn {
    bf16_t *GU, *GV, *Q, *RW, *GT;
    __device__ __forceinline__ void operator()(int row, int col, f32x4 v0, f32x4 v1) const {
        bf16_t* dst;
        if (col < 2048) { v0 = gelu4(v0); v1 = gelu4(v1); dst = (col < 1024 ? GU : GV) + (size_t)row * 1024 + (col & 1023); }
        else if (col < 5120) { const int q = col - 2048; dst = Q + (size_t)(q >> 10) * (size_t)(18 * MiB) + (size_t)row * 1024 + (q & 1023); }
        else if (col < 8704) { dst = RW + (size_t)row * RWP + (col - 5120); }
        else { v0 = sig4(v0); v1 = sig4(v1); dst = GT + (size_t)row * 3072 + (col - 8704); }
        *(u32x4*)dst = pack8(v0, v1);
    }
};
struct OpDec {
    bf16_t *D0, *D1; const float* w0;
    __device__ __forceinline__ float f(float x) const { const float y = -x; const float sp = y > 20.f ? y : __logf(1.f + __expf(y)); return -__expf(-sp - 0.5f); }
    __device__ __forceinline__ void operator()(int row, int col, f32x4 v0, f32x4 v1) const {
        const f32x4 b0 = *(const f32x4*)(w0 + col), b1 = *(const f32x4*)(w0 + col + 4);
        v0 += b0; v1 += b1;
        v0 = (f32x4){f(v0.x), f(v0.y), f(v0.z), f(v0.w)}; v1 = (f32x4){f(v1.x), f(v1.y), f(v1.z), f(v1.w)};
        bf16_t* dst = (col < 1024 ? D0 : D1) + (size_t)row * 1024 + (col & 1023);
        *(u32x4*)dst = pack8(v0, v1);
    }
};
struct OpAA {
    bf16_t *A0, *A1; const float* a0;
    __device__ __forceinline__ void operator()(int row, int col, f32x4 v0, f32x4 v1) const {
        const f32x4 b0 = *(const f32x4*)(a0 + col), b1 = *(const f32x4*)(a0 + col + 4);
        v0 = sig4(v0 + b0); v1 = sig4(v1 + b1);
        bf16_t* dst = (col < 1024 ? A0 : A1) + (size_t)row * 1024 + (col & 1023);
        *(u32x4*)dst = pack8(v0, v1);
    }
};
struct OpG {
    bf16_t* G;
    __device__ __forceinline__ void operator()(int row, int col, f32x4 v0, f32x4 v1) const { *(u32x4*)(G + (size_t)row * 1024 + col) = pack8(v0, v1); }
};
template <int KB> struct OpMerge {
    const bf16_t* GT; float* MF; bf16_t* MB;
    __device__ __forceinline__ void operator()(int row, int col, f32x4 v0, f32x4 v1) const {
        f32x4 g0, g1; unpack8(*(const u32x4*)(GT + (size_t)row * 3072 + KB * 1024 + col), g0, g1);
        float* mf = MF + (size_t)row * 1024 + col;
        f32x4 r0 = g0 * v0, r1 = g1 * v1;
        if (KB > 0) { r0 += *(const f32x4*)mf; r1 += *(const f32x4*)(mf + 4); }
        if (KB < 2) { *(f32x4*)mf = r0; *(f32x4*)(mf + 4) = r1; }
        else *(u32x4*)(MB + (size_t)row * 1024 + col) = pack8(r0, r1);
    }
};
struct OpResid {
    const float *xl, *xc; float *ol, *oc; const float* mod; int gi;
    __device__ __forceinline__ void operator()(int row, int col, f32x4 v0, f32x4 v1) const {
        const float* xi; float* xo; const float* g;
        if (row < ML) { xi = xl + (size_t)row * 1024 + col; xo = ol + (size_t)row * 1024 + col; g = mod + (size_t)(row >> 11) * 6144 + gi * 1024 + col; }
        else { const size_t rr = (size_t)(row - ML) * 1024 + col; xi = xc + rr; xo = oc + rr; g = mod + (size_t)8 * 6144 + gi * 1024 + col; }
        const f32x4 x0 = *(const f32x4*)xi, x1 = *(const f32x4*)(xi + 4), g0 = *(const f32x4*)g, g1 = *(const f32x4*)(g + 4);
        *(f32x4*)xo = x0 + g0 * v0; *(f32x4*)(xo + 4) = x1 + g1 * v1;
    }
};
struct OpSwiglu {
    bf16_t* HID;
    __device__ __forceinline__ void operator()(int row, int col, f32x4 v0, f32x4 v1) const {
        const float h0 = v0.x * sigmoidf_(v0.x) * v0.y, h1 = v0.z * sigmoidf_(v0.z) * v0.w, h2 = v1.x * sigmoidf_(v1.x) * v1.y, h3 = v1.z * sigmoidf_(v1.z) * v1.w;
        u32x2 o; o.x = pkbf(h0, h1); o.y = pkbf(h2, h3);
        *(u32x2*)(HID + (size_t)row * DFF + (col >> 1)) = o;
    }
};
template <class Op> __device__ __forceinline__ void run_gemm(const TI ti, unsigned char* lds, const bf16_t* A, const bf16_t* Bt, int Mr, int N, int K, const Op& op) {
    int Kv = K; asm volatile("" : "+s"(Kv));
    pg8::Gemm g{A, Bt, Mr, N, Kv}; pg8::StaticOrder S; S.init(Mr, N, ti.nblk, ti.bid);
    EpiT<Op> E{op};
    pg8::gemm_phase<EpiT<Op>, pg8::StaticOrder, true, true>((PG8_LAS unsigned char*)lds, g, S, E, ti.tid);
}

__device__ __forceinline__ void ph_mods(const TI ti, CArgs& a, unsigned char* ldsg) {
    float* sc = (float*)ldsg; float* part = sc + 9 * 1024;
    const int tid = ti.tid, lane = tid & 63, w = tid >> 6;
    for (int i = tid; i < 9 * 1024; i += 512) { const float v = (i < 8192) ? a.in[1][i] : a.in[3][i - 8192]; sc[i] = v / (1.f + expf(-v)); }
    __syncthreads();
    float* MOD = (float*)(a.ws + WS_MOD);
    for (int item = ti.bid; item < DEPTH * 96; item += ti.nblk) {
        const int l = item / 96, n0 = (item % 96) * 64;
        const float* W = a.in[4] + (size_t)l * 1024 * 6144 + n0 + lane;
        float acc[9];
#pragma unroll
        for (int r = 0; r < 9; ++r) acc[r] = 0.f;
        for (int k = w * 128; k < w * 128 + 128; ++k) {
            const float wv = W[(size_t)k * 6144];
#pragma unroll
            for (int r = 0; r < 9; ++r) acc[r] += sc[r * 1024 + k] * wv;
        }
#pragma unroll
        for (int r = 0; r < 9; ++r) part[(w * 9 + r) * 64 + lane] = acc[r];
        __syncthreads();
        for (int idx = tid; idx < 576; idx += 512) {
            const int r = idx >> 6, ln = idx & 63; float s = a.in[5][l * 6144 + n0 + ln];
            for (int ww = 0; ww < 8; ++ww) s += part[(ww * 9 + r) * 64 + ln];
            MOD[((size_t)l * 9 + r) * 6144 + n0 + ln] = s;
        }
        __syncthreads();
    }
}

__device__ __forceinline__ void norm_rows(const float* xl, const float* xc, const float* g, const float* modl, int shi, int sci, bf16_t* H, int nrows, int gw, int ngw, int lane) {
    for (int row = gw; row < nrows; row += ngw) {
        const float* src; int r;
        if (row < ML) { src = xl + (size_t)row * D; r = row >> 11; } else { src = xc + (size_t)(row - ML) * D; r = 8; }
        const float* md = modl + (size_t)r * 6144;
        f32x4 v[4]; float ss = 0.f;
#pragma unroll
        for (int j = 0; j < 4; ++j) { v[j] = *(const f32x4*)(src + 4 * lane + 256 * j); ss += (v[j].x * v[j].x + v[j].y * v[j].y) + (v[j].z * v[j].z + v[j].w * v[j].w); }
        ss = wave_sum(ss);
        const float rstd = rsqrtf(ss * (1.f / 1024.f) + 1e-6f);
#pragma unroll
        for (int j = 0; j < 4; ++j) {
            const int c = 4 * lane + 256 * j;
            const f32x4 gg = *(const f32x4*)(g + c), scv = *(const f32x4*)(md + sci * 1024 + c), shv = *(const f32x4*)(md + shi * 1024 + c);
            const f32x4 o = v[j] * rstd * gg * (1.f + scv) + shv;
            u32x2 p; p.x = pkbf(o.x, o.y); p.y = pkbf(o.z, o.w);
            *(u32x2*)(H + (size_t)row * D + c) = p;
        }
    }
}

template <int MODE> __device__ __forceinline__ void transpose_item(const float* W, int K, int N, bf16_t* WT, LAS float* scr, int item, int lane) {
    const int nblk = N / 32, kb = item / nblk, nb = item % nblk, k0 = 64 * kb, n0 = 32 * nb;
#pragma unroll 8
    for (int i = 0; i < 32; ++i) { const int kk = 2 * i + (lane >> 5); scr[kk * 33 + (lane & 31)] = W[(size_t)(k0 + kk) * N + n0 + (lane & 31)]; }
    asm volatile("s_waitcnt lgkmcnt(0)" ::: "memory");
    const int c = lane & 7;
#pragma unroll
    for (int j = 0; j < 4; ++j) {
        const int n = (lane >> 3) + 8 * j, gn = n0 + n; const LAS float* s = scr + (8 * c) * 33 + n;
        const int drow = MODE == 0 ? gn : (MODE == 1 ? (gn >= 8608 ? gn + 96 : gn) : (gn < DFF ? 2 * gn : 2 * (gn - DFF) + 1));
        u32x4 o; o.x = pkbf(s[0 * 33], s[1 * 33]); o.y = pkbf(s[2 * 33], s[3 * 33]); o.z = pkbf(s[4 * 33], s[5 * 33]); o.w = pkbf(s[6 * 33], s[7 * 33]);
        *(u32x4*)(WT + (size_t)drow * K + k0 + 8 * c) = o;
    }
    asm volatile("s_waitcnt lgkmcnt(0)" ::: "memory");
}
__device__ __forceinline__ void ph_wconv(CArgs& a, int l, unsigned char* ldsg, int gw, int ngw, int lane, int wv) {
    LAS float* scr = (LAS float*)(ldsg + wv * 8704);
    unsigned char* ws = a.ws;
    constexpr int I_IN = 16 * 365, I_SQ = 16 * 32, I_WI = 16 * 176, I_WO = 44 * 32, NIT = I_IN + 4 * I_SQ + I_WI + I_WO;
    for (int it = gw; it < NIT; it += ngw) {
        int r = it;
        if (r < I_IN) { transpose_item<1>(a.in[8] + (size_t)l * 1024 * 11680, 1024, 11680, (bf16_t*)(ws + WS_WIN), scr, r, lane); continue; } r -= I_IN;
        if (r < I_SQ) { transpose_item<0>(a.in[27] + (size_t)l * 1048576, 1024, 1024, (bf16_t*)(ws + WS_WA), scr, r, lane); continue; } r -= I_SQ;
        if (r < I_SQ) { transpose_item<0>(a.in[28] + (size_t)l * 1048576, 1024, 1024, (bf16_t*)(ws + WS_WB), scr, r, lane); continue; } r -= I_SQ;
        if (r < I_SQ) { transpose_item<0>(a.in[29] + (size_t)l * 1048576, 1024, 1024, (bf16_t*)(ws + WS_WC), scr, r, lane); continue; } r -= I_SQ;
        if (r < I_SQ) { transpose_item<0>(a.in[30] + (size_t)l * 1048576, 1024, 1024, (bf16_t*)(ws + WS_WO), scr, r, lane); continue; } r -= I_SQ;
        if (r < I_WI) { transpose_item<2>(a.in[31] + (size_t)l * 1024 * 5632, 1024, 5632, (bf16_t*)(ws + WS_WI), scr, r, lane); continue; } r -= I_WI;
        transpose_item<0>(a.in[32] + (size_t)l * DFF * 1024, DFF, 1024, (bf16_t*)(ws + WS_WO2), scr, r, lane);
    }
    const int gt = gw * 64 + lane, ngt = ngw * 64;
    bf16_t* LWT = (bf16_t*)(ws + WS_LWT); bf16_t* LAT = (bf16_t*)(ws + WS_LAT); bf16_t* LGT = (bf16_t*)(ws + WS_LGT);
    const float* w2 = a.in[18] + (size_t)l * 2 * 64 * 1024; const float* a2 = a.in[20] + (size_t)l * 2 * 64 * 1024; const float* g2 = a.in[21] + (size_t)l * 160 * 1024;
    for (int i = gt; i < 2048 * 128; i += ngt) {
        const int n = i >> 7, k = i & 127, d = n >> 10, c = n & 1023, kk = k - d * 64;
        const bool in = (kk >= 0 && kk < 64);
        LWT[i] = in ? f2bf(w2[((size_t)d * 64 + kk) * 1024 + c]) : (bf16_t)0;
        LAT[i] = in ? f2bf(a2[((size_t)d * 64 + kk) * 1024 + c]) : (bf16_t)0;
    }
    for (int i = gt; i < 1024 * 256; i += ngt) { const int n = i >> 8, k = i & 255; LGT[i] = k < 160 ? f2bf(g2[(size_t)k * 1024 + n]) : (bf16_t)0; }
    bf16_t* WIN = (bf16_t*)(ws + WS_WIN);
    for (int i = gt; i < 96 * 1024; i += ngt) WIN[(size_t)8608 * 1024 + i] = 0;
}

__device__ __forceinline__ void gmlp_unit(const TI ti, CArgs& a, int l, int u, unsigned char* ldsg) {
    float* rstd = (float*)ldsg; bf16_t* VNT = (bf16_t*)(ldsg + 512);
    const int tid = ti.tid, lane = tid & 63, w = tid >> 6, r = lane & 31, h = lane >> 5;
    bf16_t* GU = (bf16_t*)(a.ws + WS_GU); const bf16_t* GV = (const bf16_t*)(a.ws + WS_GV);
    const size_t R0 = (size_t)u * 128;
    for (int i = 0; i < 16; ++i) {
        const int tok = w * 16 + i; const bf16_t* p = GV + (R0 + tok) * 1024 + lane * 16;
        f32x4 x0, x1, x2, x3; unpack8(*(const u32x4*)p, x0, x1); unpack8(*(const u32x4*)(p + 8), x2, x3);
        float ss = (x0.x * x0.x + x0.y * x0.y + x0.z * x0.z + x0.w * x0.w) + (x1.x * x1.x + x1.y * x1.y + x1.z * x1.z + x1.w * x1.w)
                 + (x2.x * x2.x + x2.y * x2.y + x2.z * x2.z + x2.w * x2.w) + (x3.x * x3.x + x3.y * x3.y + x3.z * x3.z + x3.w * x3.w);
        ss = wave_sum(ss);
        if (lane == 0) rstd[tok] = rsqrtf(ss * (1.f / 1024.f) + 1e-6f);
    }
    __syncthreads();
    const float* gvg = a.in[9] + l * 1024; const float* wsp = a.in[10] + (size_t)l * 8 * 128 * 128; const float* bsp = a.in[11] + l * 8 * 128;
    const int tt = w & 3, chh = w >> 2;
    for (int g = 0; g < 8; ++g) {
        {
            const int s = tid & 127, cc = tid >> 7; const float rs = rstd[s]; const bf16_t* p = GV + (R0 + s) * 1024 + g * 128 + cc * 32;
#pragma unroll
            for (int q = 0; q < 4; ++q) {
                f32x4 x0, x1; unpack8(*(const u32x4*)(p + 8 * q), x0, x1);
                const float* gp = gvg + g * 128 + cc * 32 + 8 * q; const int c0 = cc * 32 + 8 * q;
                VNT[(c0 + 0) * 136 + s] = f2bf(x0.x * rs * gp[0]); VNT[(c0 + 1) * 136 + s] = f2bf(x0.y * rs * gp[1]);
                VNT[(c0 + 2) * 136 + s] = f2bf(x0.z * rs * gp[2]); VNT[(c0 + 3) * 136 + s] = f2bf(x0.w * rs * gp[3]);
                VNT[(c0 + 4) * 136 + s] = f2bf(x1.x * rs * gp[4]); VNT[(c0 + 5) * 136 + s] = f2bf(x1.y * rs * gp[5]);
                VNT[(c0 + 6) * 136 + s] = f2bf(x1.z * rs * gp[6]); VNT[(c0 + 7) * 136 + s] = f2bf(x1.w * rs * gp[7]);
            }
        }
        __syncthreads();
        f32x16 acc0, acc1;
#pragma unroll
        for (int i = 0; i < 16; ++i) { acc0[i] = 0.f; acc1[i] = 0.f; }
        const float* wrow = wsp + ((size_t)g * 128 + tt * 32 + r) * 128;
#pragma unroll
        for (int ks = 0; ks < 8; ++ks) {
            const f32x4 a0 = *(const f32x4*)(wrow + 16 * ks + 8 * h), a1 = *(const f32x4*)(wrow + 16 * ks + 8 * h + 4);
            const bf16x8 af = __builtin_bit_cast(bf16x8, pack8(a0, a1));
            const bf16x8 b0 = *(const bf16x8*)(VNT + (chh * 64 + r) * 136 + 16 * ks + 8 * h);
            const bf16x8 b1 = *(const bf16x8*)(VNT + (chh * 64 + 32 + r) * 136 + 16 * ks + 8 * h);
            acc0 = MFMA32(af, b0, acc0); acc1 = MFMA32(af, b1, acc1);
        }
#pragma unroll
        for (int reg = 0; reg < 16; ++reg) {
            const int t = tt * 32 + (reg & 3) + 8 * (reg >> 2) + 4 * h; const float bias = bsp[g * 128 + t];
            const size_t i0 = (R0 + t) * 1024 + g * 128 + chh * 64 + r;
            GU[i0] = f2bf(bf2f(GU[i0]) * (acc0[reg] + bias));
            GU[i0 + 32] = f2bf(bf2f(GU[i0 + 32]) * (acc1[reg] + bias));
        }
        __syncthreads();
    }
}
__device__ __forceinline__ void qk_rows(CArgs& a, int l, int gw, int ngw, int lane) {
    bf16_t* Q = (bf16_t*)(a.ws + WS_Q); bf16_t* K = (bf16_t*)(a.ws + WS_K);
    const float gq = a.in[12][l * 64 + lane], gk = a.in[13][l * 64 + lane];
    const float inv = exp2f(-(float)(lane & 15) * (13.287712379549449f / 16.f));
    for (int row = gw; row < M; row += ngw) {
        float cs = 1.f, sn = 0.f;
        if (row < ML) { const int t = row & 2047; const float pos = ((lane & 31) < 16) ? (float)(t >> 6) : (float)(t & 63); const float ang = pos * inv; sn = sinf(ang); cs = cosf(ang); }
        for (int hc = 0; hc < 16; ++hc) {
            const size_t idx = (size_t)row * 1024 + hc * 64 + lane;
            { const float x = bf2f(Q[idx]); const float ss = wave_sum(x * x); const float y = x * rsqrtf(ss * (1.f / 64.f) + 1e-6f) * gq;
              const float pr = __shfl_xor(y, 32); const float rot = lane < 32 ? -pr : pr; Q[idx] = f2bf((y * cs + rot * sn) * QSCALE); }
            { const float x = bf2f(K[idx]); const float ss = wave_sum(x * x); const float y = x * rsqrtf(ss * (1.f / 64.f) + 1e-6f) * gk;
              const float pr = __shfl_xor(y, 32); const float rot = lane < 32 ? -pr : pr; K[idx] = f2bf(y * cs + rot * sn); }
        }
    }
}
__device__ __forceinline__ void lora_in_rows(CArgs& a, int l, int gw, int ngw, int lane) {
    const bf16_t* RW = (const bf16_t*)(a.ws + WS_RW); bf16_t* LW = (bf16_t*)(a.ws + WS_LIW); bf16_t* LA = (bf16_t*)(a.ws + WS_LIA); bf16_t* LG = (bf16_t*)(a.ws + WS_LIG);
    const float* mu = a.in[16] + l * 3488 + 3072;
    for (int row = gw; row < M; row += ngw) {
        int t, Tn; if (row < ML) { t = row & 2047; Tn = 2048; } else { t = (row - ML) & 255; Tn = 256; }
        const bool hp = t > 0, hn = t < Tn - 1;
        const bf16_t* p = RW + (size_t)row * RWP + 3072;
        for (int i = 0; i < 7; ++i) {
            const int j = lane + 64 * i;
            if (j < 416) {
                const float x = bf2f(p[j]); const float xp = hp ? bf2f(p[j - RWP]) : 0.f; const float xn = hn ? bf2f(p[j + RWP]) : 0.f;
                const float z = x + mu[j] * (0.5f * (xp + xn) - x);
                if (j < 128) LW[(size_t)row * 128 + j] = f2bf(tanhf(z));
                else if (j < 256) LA[(size_t)row * 128 + j - 128] = f2bf(z);
                else LG[(size_t)row * 256 + j - 256] = f2bf(sigmoidf_(z));
            }
        }
        for (int j = 160 + lane; j < 256; j += 64) LG[(size_t)row * 256 + j] = 0;
    }
}

__device__ __forceinline__ void scan_unit(const TI ti, CArgs& a, int l, int u, bool ctx_out, unsigned char* ldsg) {
    const int tid = ti.tid, lane = tid & 63, w = tid >> 6;
    const int b = u >> 5, hh = (u >> 1) & 15, d = u & 1;
    const int si = tid >> 3, jq = tid & 7;
    LAS float* L = (LAS float*)ldsg;
    const bf16_t* RW = (const bf16_t*)(a.ws + WS_RW);
    const bf16_t* DEC = (const bf16_t*)(a.ws + (d ? WS_DEC1 : WS_GV));
    const bf16_t* AA = (const bf16_t*)(a.ws + (d ? WS_AA1 : WS_AA0));
    bf16_t* Y = (bf16_t*)(a.ws + (d ? WS_Y1 : WS_H));
    const int ch = hh * 64 + lane;
    const float* mu = a.in[16] + l * 3488;
    const float mur = mu[ch], muk = mu[1024 + ch], muv = mu[2048 + ch], kkg = a.in[22][l * 1024 + ch], kag = a.in[23][l * 1024 + ch];
    f32x4 S0 = {0.f, 0.f, 0.f, 0.f}, S1 = {0.f, 0.f, 0.f, 0.f};
    unsigned raw[4][9]; unsigned dcr[4], aar[4];
    constexpr int NC = 72;
#define SCAN_CHUNK(n, base, Tn, t0, wy) int base, Tn, t0; bool wy; { int ci; if ((n) < 8) { base = ML + b * 256; Tn = 256; ci = d ? 7 - (n) : (n); wy = ctx_out; } else { base = b * 2048; Tn = 2048; ci = d ? 71 - (n) : (n) - 8; wy = true; } t0 = ci * 32; }
#define SCAN_LOAD(n) do { SCAN_CHUNK(n, base_, Tn_, t0_, wy_); (void)wy_; _Pragma("unroll") for (int i4 = 0; i4 < 4; ++i4) { const int t = t0_ + w + 8 * i4; const size_t row = (size_t)(base_ + t); \
        const bf16_t* p = RW + row * RWP + ch; const bool hp = t > 0, hn = t < Tn_ - 1; \
        _Pragma("unroll") for (int X = 0; X < 3; ++X) { raw[i4][3 * X + 0] = hp ? (unsigned)p[X * 1024 - RWP] : 0u; raw[i4][3 * X + 1] = (unsigned)p[X * 1024]; raw[i4][3 * X + 2] = hn ? (unsigned)p[X * 1024 + RWP] : 0u; } \
        dcr[i4] = (unsigned)DEC[row * 1024 + ch]; aar[i4] = (unsigned)AA[row * 1024 + ch]; } } while (0)
#define SCAN_STORE(n) do { LAS float* Bf = L + ((n) & 1) * 12288; _Pragma("unroll") for (int i4 = 0; i4 < 4; ++i4) { const int tk = w + 8 * i4; \
        const float xr = bf2f(raw[i4][1]), xk = bf2f(raw[i4][4]), xv = bf2f(raw[i4][7]); \
        const float zr = xr + mur * (0.5f * (bf2f(raw[i4][0]) + bf2f(raw[i4][2])) - xr); \
        const float zk = xk + muk * (0.5f * (bf2f(raw[i4][3]) + bf2f(raw[i4][5])) - xk); \
        const float zv = xv + muv * (0.5f * (bf2f(raw[i4][6]) + bf2f(raw[i4][8])) - xv); \
        const float kkv = zk * kkg; const float ssq = wave_sum(kkv * kkv); const float kkn = kkv / fmaxf(sqrtf(ssq), 1e-12f); \
        const float ad = bf2f(aar[i4]); const float wv_ = __expf(bf2f(dcr[i4])); const float kd = zk * (1.f + (ad - 1.f) * kag); \
        Bf[0 * 2048 + tk * 64 + lane] = wv_; Bf[1 * 2048 + tk * 64 + lane] = kd; Bf[2 * 2048 + tk * 64 + lane] = -kkn; \
        Bf[3 * 2048 + tk * 64 + lane] = kkn * ad; Bf[4 * 2048 + tk * 64 + lane] = zr; Bf[5 * 2048 + tk * 64 + lane] = zv; } } while (0)
    SCAN_LOAD(0); SCAN_STORE(0);
    __syncthreads();
    for (int n = 0; n < NC; ++n) {
        if (n + 1 < NC) SCAN_LOAD(n + 1);
        LAS const float* Bf = L + (n & 1) * 12288; LAS float* Yb = L + 24576 + (n & 1) * 2048;
#pragma unroll 2
        for (int ss = 0; ss < 32; ++ss) {
            const int s = d ? 31 - ss : ss;
            LAS const float* q = Bf + s * 64 + 8 * jq;
            const f32x4 w0 = *(LAS const f32x4*)(q), w1 = *(LAS const f32x4*)(q + 4);
            const f32x4 k0 = *(LAS const f32x4*)(q + 2048), k1 = *(LAS const f32x4*)(q + 2048 + 4);
            const f32x4 a0 = *(LAS const f32x4*)(q + 4096), a1 = *(LAS const f32x4*)(q + 4096 + 4);
            const f32x4 b0 = *(LAS const f32x4*)(q + 6144), b1 = *(LAS const f32x4*)(q + 6144 + 4);
            const f32x4 r0 = *(LAS const f32x4*)(q + 8192), r1 = *(LAS const f32x4*)(q + 8192 + 4);
            const float vi = Bf[5 * 2048 + s * 64 + si];
            const f32x4 ta = S0 * a0 + S1 * a1;
            const float sa = dpp_sum8((ta.x + ta.y) + (ta.z + ta.w));
            S0 = S0 * w0 + (sa * b0 + vi * k0);
            S1 = S1 * w1 + (sa * b1 + vi * k1);
            const f32x4 ty = S0 * r0 + S1 * r1;
            const float y = dpp_sum8((ty.x + ty.y) + (ty.z + ty.w));
            if (jq == 0) Yb[s * 64 + si] = y;
        }
        if (n + 1 < NC) SCAN_STORE(n + 1);
        __syncthreads();
        {
            SCAN_CHUNK(n, base_, Tn_, t0_, wy_); (void)Tn_;
            if (wy_) {
#pragma unroll
                for (int i4 = 0; i4 < 4; ++i4) { const int tk = w + 8 * i4; Y[(size_t)(base_ + t0_ + tk) * 1024 + ch] = f2bf(Yb[tk * 64 + lane]); }
            }
        }
    }
    __syncthreads();
#undef SCAN_CHUNK
#undef SCAN_LOAD
#undef SCAN_STORE
}

__device__ __forceinline__ void attn_unit(const TI ti, CArgs& a, int b, int hd, int qrow0, int st_lo, int st_hi, float mfix, float lam, float lam_init, const float* subg, unsigned char* ldsg) {
    const int tid = ti.tid, lane = tid & 63, w = tid >> 6, r = lane & 31, h = lane >> 5, qt = w >> 1, c = w & 1;
    bf16_t* Qb = (bf16_t*)(a.ws + WS_Q); const bf16_t* Kb = (const bf16_t*)(a.ws + WS_K); const bf16_t* Vb = (const bf16_t*)(a.ws + WS_V);
    LAS unsigned char* L = (LAS unsigned char*)ldsg;
    constexpr int KOFF = 0, VOFF = 17408, BUFB = 35840;
    bf16x8 qf[4];
    { const bf16_t* qp = Qb + (size_t)(qrow0 + qt * 32 + r) * 1024 + hd * 128 + c * 64 + 8 * h;
#pragma unroll
      for (int ks = 0; ks < 4; ++ks) qf[ks] = *(const bf16x8*)(qp + 16 * ks); }
    f32x16 O[4];
#pragma unroll
    for (int e = 0; e < 4; ++e)
#pragma unroll
        for (int i = 0; i < 16; ++i) O[e][i] = 0.f;
    float lsum = 0.f;
    u32x4 kreg[2], vreg[2];
#define ATT_KROW(kk) ((kk) < 2048 ? (size_t)(b * 2048 + (kk)) : (size_t)(ML + b * 256 + (kk) - 2048))
#define ATT_LOAD(st) do { _Pragma("unroll") for (int i = 0; i < 2; ++i) { const int p = tid + 512 * i, key = p >> 4, dc = p & 15; kreg[i] = *(const u32x4*)(Kb + ATT_KROW((st) * 64 + key) * 1024 + hd * 128 + dc * 8); } \
        const bf16_t* vp = Vb + ATT_KROW((st) * 64 + lane) * 1024 + hd * 128 + w * 16; vreg[0] = *(const u32x4*)vp; vreg[1] = *(const u32x4*)(vp + 8); } while (0)
#define ATT_STORE(bufi) do { LAS unsigned char* Bb = L + (bufi) * BUFB; _Pragma("unroll") for (int i = 0; i < 2; ++i) { const int p = tid + 512 * i, key = p >> 4, dc = p & 15; *(LAS u32x4*)(Bb + KOFF + key * 272 + dc * 16) = kreg[i]; } \
        LAS bf16_t* vt = (LAS bf16_t*)(Bb + VOFF) + (w * 16) * 72 + lane; \
        _Pragma("unroll") for (int e = 0; e < 4; ++e) { vt[(2 * e) * 72] = (bf16_t)(vreg[0][e] & 0xffffu); vt[(2 * e + 1) * 72] = (bf16_t)(vreg[0][e] >> 16); \
            vt[(8 + 2 * e) * 72] = (bf16_t)(vreg[1][e] & 0xffffu); vt[(8 + 2 * e + 1) * 72] = (bf16_t)(vreg[1][e] >> 16); } } while (0)
    ATT_LOAD(st_lo); ATT_STORE(0);
    __syncthreads();
    for (int st = st_lo; st < st_hi; ++st) {
        const int bi = (st - st_lo) & 1;
        if (st + 1 < st_hi) ATT_LOAD(st + 1);
        LAS const unsigned char* Bb = L + bi * BUFB;
#pragma unroll
        for (int sub = 0; sub < 2; ++sub) {
            f32x16 Sx;
#pragma unroll
            for (int i = 0; i < 16; ++i) Sx[i] = 0.f;
#pragma unroll
            for (int ks = 0; ks < 4; ++ks) {
                const bf16x8 kf = *(LAS const bf16x8*)(Bb + KOFF + (sub * 32 + r) * 272 + (c * 64 + 16 * ks + 8 * h) * 2);
                Sx = MFMA32(kf, qf[ks], Sx);
            }
            float p[16];
#pragma unroll
            for (int i = 0; i < 16; ++i) { p[i] = __builtin_amdgcn_exp2f(Sx[i] - mfix); lsum += p[i]; }
            u32x4 pw0, pw1;
            pw0.x = pkbf(p[0], p[1]); pw0.y = pkbf(p[2], p[3]); pw0.z = pkbf(p[4], p[5]); pw0.w = pkbf(p[6], p[7]);
            pw1.x = pkbf(p[8], p[9]); pw1.y = pkbf(p[10], p[11]); pw1.z = pkbf(p[12], p[13]); pw1.w = pkbf(p[14], p[15]);
            const bf16x8 pb0 = __builtin_bit_cast(bf16x8, pw0), pb1 = __builtin_bit_cast(bf16x8, pw1);
#pragma unroll
            for (int et = 0; et < 4; ++et) {
#pragma unroll
                for (int s = 0; s < 2; ++s) {
                    LAS const unsigned char* va = Bb + VOFF + (et * 32 + r) * 144 + (sub * 32 + 16 * s + 4 * h) * 2;
                    const s16x4 lo = *(LAS const s16x4*)va, hi = *(LAS const s16x4*)(va + 16);
                    const bf16x8 vf = __builtin_shufflevector(lo, hi, 0, 1, 2, 3, 4, 5, 6, 7);
                    O[et] = MFMA32(vf, s ? pb1 : pb0, O[et]);
                }
            }
        }
        if (st + 1 < st_hi) ATT_STORE(bi ^ 1);
        __syncthreads();
    }
#undef ATT_KROW
#undef ATT_LOAD
#undef ATT_STORE
    const float ltot = lsum + __shfl_xor(lsum, 32);
    const float linv = 1.f / ltot;
    LAS float* X = (LAS float*)L + qt * 4096;
    if (c == 1) {
#pragma unroll
        for (int e = 0; e < 4; ++e)
#pragma unroll
            for (int i = 0; i < 16; ++i) X[(e * 16 + i) * 64 + lane] = O[e][i] * linv;
    }
    __syncthreads();
    if (c == 0) {
        float ssq = 0.f;
#pragma unroll
        for (int e = 0; e < 4; ++e)
#pragma unroll
            for (int i = 0; i < 16; ++i) { const float o = O[e][i] * linv - lam * X[(e * 16 + i) * 64 + lane]; O[e][i] = o; ssq += o * o; }
        ssq += __shfl_xor(ssq, 32);
        const float sc = rsqrtf(ssq * (1.f / 128.f) + 1e-6f) * (1.f - lam_init);
        bf16_t* op = Qb + (size_t)(qrow0 + qt * 32 + r) * 1024 + hd * 128;
#pragma unroll
        for (int e = 0; e < 4; ++e)
#pragma unroll
            for (int g4 = 0; g4 < 4; ++g4) {
                const int e0 = e * 32 + 8 * g4 + 4 * h; const f32x4 sg = *(const f32x4*)(subg + e0);
                u32x2 o; o.x = pkbf(O[e][4 * g4 + 0] * sc * sg.x, O[e][4 * g4 + 1] * sc * sg.y); o.y = pkbf(O[e][4 * g4 + 2] * sc * sg.z, O[e][4 * g4 + 3] * sc * sg.w);
                *(u32x2*)(op + e0) = o;
            }
    }
    __syncthreads();
}
__device__ __forceinline__ void ph_attn(const TI ti, CArgs& a, int l, bool ctx_out, unsigned char* ldsg) {
    const int lane = ti.tid & 63;
    const float gqm = fabsf(a.in[12][l * 64 + lane]), gkm = fabsf(a.in[13][l * 64 + lane]);
    float mq = gqm, mk = gkm;
#pragma unroll
    for (int o = 1; o < 64; o <<= 1) { mq = fmaxf(mq, __shfl_xor(mq, o)); mk = fmaxf(mk, __shfl_xor(mk, o)); }
    const float mfix = 8.f * mq * mk * 1.4426950408889634f * 1.03f;
    const float* lp = a.in[14] + l * 256;
    const float s1 = wave_sum(lp[lane] * lp[64 + lane]), s2 = wave_sum(lp[128 + lane] * lp[192 + lane]);
    const float lam_init = 0.8f - 0.6f * expf(-0.3f * (float)l);
    const float lam = expf(s1) - expf(s2) + lam_init;
    const float* subg = a.in[15] + l * 128;
    const int nun = 1024 + (ctx_out ? 128 : 0);
    for (int u = ti.bid; u < nun; u += ti.nblk) {
        if (u < 1024) { const int bh = u >> 4, qb = u & 15; attn_unit(ti, a, bh >> 3, bh & 7, (bh >> 3) * 2048 + qb * 128, 0, 36, mfix, lam, lam_init, subg, ldsg); }
        else { const int v = u - 1024, bh = v >> 1, qb = v & 1; attn_unit(ti, a, bh >> 3, bh & 7, ML + (bh >> 3) * 256 + qb * 128, 32, 36, mfix, lam, lam_init, subg, ldsg); }
    }
}

__device__ __forceinline__ void rwkv_out_rows(CArgs& a, int l, int nrows, int gw, int ngw, int lane) {
    const bf16_t* RW = (const bf16_t*)(a.ws + WS_RW); const bf16_t* Y0 = (const bf16_t*)(a.ws + WS_H); bf16_t* Y1 = (bf16_t*)(a.ws + WS_Y1);
    const bf16_t* A0 = (const bf16_t*)(a.ws + WS_AA0); const bf16_t* A1 = (const bf16_t*)(a.ws + WS_AA1); const bf16_t* G = (const bf16_t*)(a.ws + WS_G);
    const float* mu = a.in[16] + l * 3488;
    for (int row = gw; row < nrows; row += ngw) {
        int t, Tn; if (row < ML) { t = row & 2047; Tn = 2048; } else { t = (row - ML) & 255; Tn = 256; }
        const bool hp = t > 0, hn = t < Tn - 1;
        for (int hh = 0; hh < 16; ++hh) {
            const int ch = hh * 64 + lane; const size_t idx = (size_t)row * 1024 + ch;
            const float y = bf2f(Y0[idx]) + bf2f(Y1[idx]);
            const float mean = wave_sum(y) * (1.f / 64.f); const float dv = y - mean; const float var = wave_sum(dv * dv) * (1.f / 64.f);
            const float yn = dv * rsqrtf(var + 64e-5f) * a.in[25][l * 1024 + ch] + a.in[26][l * 1024 + ch];
            const bf16_t* p = RW + (size_t)row * RWP + ch;
            float z[3];
#pragma unroll
            for (int X = 0; X < 3; ++X) { const float x = bf2f(p[X * 1024]); const float xp = hp ? bf2f(p[X * 1024 - RWP]) : 0.f; const float xn = hn ? bf2f(p[X * 1024 + RWP]) : 0.f;
                z[X] = x + mu[X * 1024 + ch] * (0.5f * (xp + xn) - x); }
            const float ka = a.in[23][l * 1024 + ch];
            const float kds = z[1] * (1.f + (bf2f(A0[idx]) - 1.f) * ka) + z[1] * (1.f + (bf2f(A1[idx]) - 1.f) * ka);
            const float bonus = wave_sum(z[0] * kds * a.in[24][l * 1024 + ch]) * z[2];
            Y1[idx] = f2bf((yn + bonus) * bf2f(G[idx]));
        }
    }
}

#define XB_TMO      128
#define XB_XCNT(j)  (256  + 64 * (j))
#define XB_XSUB(j)  (1280 + 64 * (j))
#define XB_XGEN(j)  (2304 + 64 * (j))
#define XB_TOP      3328
#define XB_TOPGEN   3392
#define XCD_BAR_WORDS 3456
#define XB_SPIN_CAP (1u << 20)

__device__ __forceinline__ unsigned xb_ld(unsigned* p)              { return __hip_atomic_load(p, __ATOMIC_RELAXED, __HIP_MEMORY_SCOPE_AGENT); }
__device__ __forceinline__ unsigned xb_add(unsigned* p, unsigned v) { return __hip_atomic_fetch_add(p, v, __ATOMIC_RELAXED, __HIP_MEMORY_SCOPE_AGENT); }
__device__ __forceinline__ unsigned xb_xcc_id() { return (unsigned)__builtin_amdgcn_s_getreg((3 << 11) | 20) & 0xFu; }
#define XB_SPIN(cond, bar) do { unsigned _sp = 0; while (cond) { __builtin_amdgcn_s_sleep(1); \
    if ((++_sp & 255u) == 0u) { if (xb_ld(&(bar)[XB_TMO])) break; if (_sp > XB_SPIN_CAP) { atomicAdd(&(bar)[XB_TMO], 1u); break; } } } } while (0)

struct XcdBarrier {
    unsigned* bar; unsigned x;
    volatile LAS unsigned* st;
};

__device__ __forceinline__ XcdBarrier xcd_barrier_post(unsigned* bar, volatile LAS unsigned* st) {
    XcdBarrier b; b.bar = bar; b.x = xb_xcc_id(); b.st = st;
    if (threadIdx.x == 0) (void)xb_add(&bar[XB_XCNT(b.x)], 1u);
    return b;
}
__device__ __forceinline__ void xcd_barrier_complete(unsigned* bar, unsigned x, unsigned& nloc, unsigned& nx) {
    const unsigned G = gridDim.x * gridDim.y * gridDim.z;
    unsigned sum, cnt, mine, sp = 0u;
    for (;;) {
        sum = 0u; cnt = 0u; mine = 0u;
#pragma unroll
        for (unsigned j = 0; j < 16; ++j) { const unsigned c = xb_ld(&bar[XB_XCNT(j)]); sum += c; cnt += (c > 0u) ? 1u : 0u; mine = (j == x) ? c : mine; }
        if (sum == G) break;
        __builtin_amdgcn_s_sleep(1);
        if ((++sp & 255u) == 0u) { if (xb_ld(&bar[XB_TMO])) break; if (sp > XB_SPIN_CAP) { atomicAdd(&bar[XB_TMO], 1u); break; } }
    }
    nloc = mine > 0u ? mine : 1u; nx = cnt > 0u ? cnt : 1u;
}

__device__ __forceinline__ void xcd_barrier(const XcdBarrier& b) {
    asm volatile("s_waitcnt vmcnt(0)" ::: "memory");
    __syncthreads();
    if (threadIdx.x == 0) {
        unsigned* bar = b.bar;
        __builtin_amdgcn_s_waitcnt(0);
        unsigned nloc = b.st[0], nx = b.st[1];
        if (nloc == 0u) { xcd_barrier_complete(bar, b.x, nloc, nx); b.st[0] = nloc; b.st[1] = nx; }
        const unsigned old = xb_add(&bar[XB_XSUB(b.x)], 1u);
        const unsigned gen = old / nloc;
        if (old + 1u == (gen + 1u) * nloc) {
            __builtin_amdgcn_fence(__ATOMIC_RELEASE, "agent");
            asm volatile("s_waitcnt vmcnt(0)" ::: "memory");
            const unsigned og = xb_add(&bar[XB_TOP], 1u);
            const unsigned tg = og / nx;
            if (og + 1u == (tg + 1u) * nx) xb_add(&bar[XB_TOPGEN], 1u);
            else XB_SPIN(xb_ld(&bar[XB_TOPGEN]) == tg, bar);
            __builtin_amdgcn_fence(__ATOMIC_ACQUIRE, "agent");
            xb_add(&bar[XB_XGEN(b.x)], 1u);
            asm volatile("s_waitcnt vmcnt(0)" ::: "memory");
        } else {
            XB_SPIN(xb_ld(&bar[XB_XGEN(b.x)]) == gen, bar);
            __builtin_amdgcn_fence(__ATOMIC_ACQUIRE, "agent");
            asm volatile("s_waitcnt vmcnt(0)" ::: "memory");
        }
    }
    __syncthreads();
}

#ifndef ONLY_PH
#define ONLY_PH -1
#endif
#ifndef SKIP_PH
#define SKIP_PH -2
#endif
#define PH_ON(k) ((ONLY_PH < 0 || ONLY_PH == (k)) && (k) != SKIP_PH)
__global__ void __launch_bounds__(512, 2) mega_fwd(Args a_) {
    extern __shared__ __attribute__((aligned(16))) unsigned char lds[];
    cg::grid_group grid = cg::this_grid();
    const int ph_lo = a_.lo, ph_hi = a_.hi;
    volatile LAS unsigned* bst = (volatile LAS unsigned*)((LAS unsigned char*)lds + 131072);
    if (threadIdx.x < 2) bst[threadIdx.x] = 0u;
    __syncthreads();
    const XcdBarrier xbar = xcd_barrier_post((unsigned*)(a_.ws + WS_BAR), bst);
#pragma nounroll
    for (int ph = ph_lo; ph < ph_hi; ++ph) {
        CArgs* ap = (CArgs*)__builtin_amdgcn_kernarg_segment_ptr(); asm volatile("" : "+s"(ap));
        CArgs& a = *ap;
        unsigned char* ws = a.ws;
        float* XC = (float*)(ws + WS_XC);
        TI ti; ti.tid = threadIdx.x; ti.bid = blockIdx.x; ti.nblk = gridDim.x;
        asm volatile("" : "+v"(ti.tid)); asm volatile("" : "+s"(ti.bid)); asm volatile("" : "+s"(ti.nblk));
        const int tid = ti.tid, lane = tid & 63, wv = __builtin_amdgcn_readfirstlane(tid >> 6);
        const int gw = ti.bid * 8 + wv, ngw = ti.nblk * 8;
        if (ph == 0) { if constexpr (PH_ON(100)) ph_mods(ti, a, lds); }
        else {
            const int l = (ph - 1) / NPH, k = (ph - 1) % NPH;
            const bool ctx_out = l < DEPTH - 1;
            const int Mr = ctx_out ? M : ML;
            const float* modl = (const float*)(ws + WS_MOD) + (size_t)l * 9 * 6144;
            const float* xl_in = l == 0 ? a.in[0] : a.out; const float* xc_in = l == 0 ? a.in[2] : XC;
            bf16_t* H = (bf16_t*)(ws + WS_H);
            switch (k) {
            case 0: if constexpr (PH_ON(0)) {
                norm_rows(xl_in, xc_in, a.in[6] + l * 1024, modl, 0, 1, H, M, gw, ngw, lane);
                ph_wconv(a, l, lds, gw, ngw, lane, wv);
                } break;
            case 1: if constexpr (PH_ON(1)) {
                OpIn op{(bf16_t*)(ws + WS_GU), (bf16_t*)(ws + WS_GV), (bf16_t*)(ws + WS_Q), (bf16_t*)(ws + WS_RW), (bf16_t*)(ws + WS_GT)};
                run_gemm(ti, lds, H, (const bf16_t*)(ws + WS_WIN), M, PPAD, 1024, op);
            } break;
            case 2: if constexpr (PH_ON(2)) {
                for (int u = ti.bid; u < Mr / 128; u += ti.nblk) gmlp_unit(ti, a, l, u, lds);
                qk_rows(a, l, gw, ngw, lane);
                lora_in_rows(a, l, gw, ngw, lane);
                } break;
            case 3: if constexpr (PH_ON(3)) {
                OpDec o1{(bf16_t*)(ws + WS_GV), (bf16_t*)(ws + WS_DEC1), a.in[17] + l * 2048};
                run_gemm(ti, lds, (const bf16_t*)(ws + WS_LIW), (const bf16_t*)(ws + WS_LWT), M, 2048, 128, o1);
                OpAA o2{(bf16_t*)(ws + WS_AA0), (bf16_t*)(ws + WS_AA1), a.in[19] + l * 2048};
                run_gemm(ti, lds, (const bf16_t*)(ws + WS_LIA), (const bf16_t*)(ws + WS_LAT), M, 2048, 128, o2);
                OpG o3{(bf16_t*)(ws + WS_G)};
                run_gemm(ti, lds, (const bf16_t*)(ws + WS_LIG), (const bf16_t*)(ws + WS_LGT), M, 1024, 256, o3);
            } break;
            case 4:
                if constexpr (PH_ON(4)) { for (int u = ti.bid; u < 256; u += ti.nblk) scan_unit(ti, a, l, u, ctx_out, lds); }
                if constexpr (PH_ON(40)) ph_attn(ti, a, l, ctx_out, lds);
                break;
            case 5: if constexpr (PH_ON(5)) {
                rwkv_out_rows(a, l, Mr, gw, ngw, lane);
                } break;
            case 6: if constexpr (PH_ON(6)) {
                const bf16_t* GT = (const bf16_t*)(ws + WS_GT); float* MF = (float*)(ws + WS_K);
                OpMerge<0> o0{GT, MF, H}; run_gemm(ti, lds, (const bf16_t*)(ws + WS_GU), (const bf16_t*)(ws + WS_WA), Mr, 1024, 1024, o0);
                OpMerge<1> o1{GT, MF, H}; run_gemm(ti, lds, (const bf16_t*)(ws + WS_Q), (const bf16_t*)(ws + WS_WB), Mr, 1024, 1024, o1);
                OpMerge<2> o2{GT, MF, H}; run_gemm(ti, lds, (const bf16_t*)(ws + WS_Y1), (const bf16_t*)(ws + WS_WC), Mr, 1024, 1024, o2);
            } break;
            case 7: if constexpr (PH_ON(7)) {
                OpResid op{xl_in, xc_in, a.out, XC, modl, 2};
                run_gemm(ti, lds, H, (const bf16_t*)(ws + WS_WO), Mr, 1024, 1024, op);
            } break;
            case 8: if constexpr (PH_ON(8)) {
                norm_rows(a.out, XC, a.in[7] + l * 1024, modl, 3, 4, H, Mr, gw, ngw, lane);
                } break;
            case 9: if constexpr (PH_ON(9)) {
                OpSwiglu op{(bf16_t*)(ws + WS_RW)};
                run_gemm(ti, lds, H, (const bf16_t*)(ws + WS_WI), Mr, 2 * DFF, 1024, op);
            } break;
            default: if constexpr (PH_ON(10)) {
                OpResid op{a.out, XC, a.out, XC, modl, 5};
                run_gemm(ti, lds, (const bf16_t*)(ws + WS_RW), (const bf16_t*)(ws + WS_WO2), Mr, 1024, DFF, op);
            } break;
            }
        }
        if (ph + 1 < ph_hi) { if (ph == ph_lo) grid.sync(); else xcd_barrier(xbar); }
    }
}

extern "C" void kernel_launch(void* const* d_in, const int* in_sizes, int n_in, void* d_out, int out_size, void* d_ws, size_t ws_size, hipStream_t stream) {
    static int grid = 0;
    if (grid == 0) {
        if (n_in != 33 || out_size != ML * D || ws_size < WS_END) { fprintf(stderr, "kernel_launch: unexpected shapes / workspace (%d inputs, out %d, ws %zu, need %zu)\n", n_in, out_size, ws_size, (size_t)WS_END); grid = -1; return; }
        int dev = 0, cus = 0, per_cu = 0;
        hipGetDevice(&dev); hipDeviceGetAttribute(&cus, hipDeviceAttributeMultiprocessorCount, dev);
        if (hipFuncSetAttribute((const void*)mega_fwd, hipFuncAttributeMaxDynamicSharedMemorySize, LDS_BYTES) != hipSuccess) { fprintf(stderr, "kernel_launch: hipFuncSetAttribute failed\n"); grid = -1; return; }
        if (hipOccupancyMaxActiveBlocksPerMultiprocessor(&per_cu, (const void*)mega_fwd, 512, LDS_BYTES) != hipSuccess || per_cu < 1) per_cu = 1;
        (void)hipGetLastError();
        grid = cus * 1;
    }
    if (grid < 0) return;
    Args a{};
    for (int i = 0; i < 33; ++i) a.in[i] = (const float*)d_in[i];
    a.out = (float*)d_out; a.ws = (unsigned char*)d_ws; a.lo = 0; a.hi = NPHASES;
    void* args[] = {&a};
    if (hipMemsetAsync((char*)d_ws + WS_BAR, 0, BAR_BYTES, stream) != hipSuccess) { fprintf(stderr, "kernel_launch: memset of barrier words failed\n"); return; }
    hipError_t e = hipLaunchCooperativeKernel((const void*)mega_fwd, dim3(grid), dim3(512), args, LDS_BYTES, stream);
    if (e != hipSuccess) fprintf(stderr, "kernel_launch: cooperative launch failed: %s (grid %d)\n", hipGetErrorString(e), grid);
}
```

```cpp
#include <hip/hip_runtime.h>
#include <hip/hip_cooperative_groups.h>
#include <cstdio>
#include <cstdint>
namespace cg = cooperative_groups;
namespace pg8 {
#define PG8_LAS __attribute__((address_space(3)))
typedef unsigned short bf16_t;
typedef short bf16x8 __attribute__((ext_vector_type(8)));
typedef float f32x4 __attribute__((ext_vector_type(4)));
typedef unsigned u32x4 __attribute__((ext_vector_type(4)));
constexpr int BM = 256, BK = 64, HALF = 128, HTB = HALF * BK * 2  , STAGE_BYTES = 8 * HTB, NXCD = 8, WGM = 8;

__host__ __device__ __forceinline__ int lds_byte(int r, int c) { const int st = (r >> 4) * 2 + (c >> 5), rr = r & 15, cc = c & 31, ob = rr * 64 + cc * 2; return st * 1024 + (ob ^ (((ob >> 9) & 1) << 5)); }
__host__ __device__ __forceinline__ void stage_rc(int b, int& R, int& C) { const int st = b / 1024, sb = b % 1024, swz = sb ^ (((sb >> 9) & 1) << 5); R = (st >> 1) * 16 + swz / 64; C = (st & 1) * 32 + (swz % 64) / 2; }
__host__ __device__ __forceinline__ int perm32(int rho) { const int n = rho >> 4, i = rho & 15; return 8 * (i >> 2) + 4 * n + (i & 3); }

struct Unit { int pm, pn; };
struct Gemm { const bf16_t* A; const bf16_t* Bt; int M, N, K; };

struct StaticOrder {
    int nM, nN, nwg, G, c;
    __host__ __device__ void init(int M, int N, int G_, int c_) { nM = M / BM; nN = N / BM; nwg = nM * nN; G = G_; c = c_; }
    __host__ __device__ bool next(int i, Unit& u) const {
        const long L = (long)i * G + c; if (L >= nwg) return false;
        int wgid = (int)L; { const int q = nwg / NXCD, r = nwg % NXCD, xcd = wgid % NXCD, off = wgid / NXCD; wgid = (xcd < r ? xcd * (q + 1) : r * (q + 1) + (xcd - r) * q) + off; }
        const int nig = WGM * nN, gid = wgid / nig, fm = gid * WGM, gsz = (nM - fm) < WGM ? (nM - fm) : WGM;
        u.pm = fm + ((wgid % nig) % gsz); u.pn = (wgid % nig) / gsz; return true;
    }
    __device__ __forceinline__ void a_ready(const Unit&) const {}
    __device__ __forceinline__ void done(const Unit&) const {}
};

__device__ __forceinline__ unsigned cvt_pk_bf16(float lo, float hi) { unsigned r; asm volatile("v_cvt_pk_bf16_f32 %0, %1, %2" : "=v"(r) : "v"(lo), "v"(hi)); return r; }
typedef float f32x2 __attribute__((ext_vector_type(2)));
__device__ __forceinline__ f32x2 gelu_pk(f32x2 v) {
    const f32x2 av = __builtin_elementwise_abs(v), d = av * 0.2316418882f + 1.0f;
    f32x2 t; t.x = __builtin_amdgcn_rcpf(d.x); t.y = __builtin_amdgcn_rcpf(d.y);
    f32x2 q = t * 0.5307027145f + (-0.7265760135f); q = q * t + 0.7107068705f; q = q * t + (-0.142248368f); q = q * t + 0.127414796f; q = q * t;
    const f32x2 s = (v * v) * (-0.72134752044f);
    f32x2 e; e.x = __builtin_amdgcn_exp2f(s.x); e.y = __builtin_amdgcn_exp2f(s.y);
    const f32x2 m = v * (q * e), r = v - m;
    f32x2 o; o.x = v.x < 0.f ? m.x : r.x; o.y = v.y < 0.f ? m.y : r.y; return o;
}

template <class Epi, class Sched, bool ALIGN_EPI = false, bool SP2 = false>
__device__ __forceinline__ void gemm_phase(PG8_LAS unsigned char* lds, const Gemm g, const Sched& S, const Epi& E, const int tid_in) {
    const int tid = tid_in, wid = __builtin_amdgcn_readfirstlane(tid >> 6), lane = tid & 63, wr = wid >> 2, wc = wid & 3, fr = lane & 15, fq = lane >> 4;
    const int K = g.K, nt = K / BK;
    unsigned voffA[2], voffB[2];
#pragma unroll
    for (int i = 0; i < 2; ++i) { int R, C; stage_rc(tid * 16 + i * 8192, R, C); const int Rb = Epi::PERM ? ((R & ~31) + perm32(R & 31)) : R;
        voffA[i] = (unsigned)(R * K + C) * 2u; voffB[i] = (unsigned)(Rb * K + C) * 2u; }
    const size_t kstep = (size_t)(BK * 2);
    const size_t hstep = (size_t)HALF * K * 2;
    const size_t tstep = 2 * hstep;
    const unsigned ldsw = (unsigned)wid * 1024u;
    const int aoff = lds_byte(wr * 64 + fr, fq * 8), boff = lds_byte(wc * 32 + fr, fq * 8);
#define PG8_SA(b, h) (((b) * 2 + (h)) * HTB)
#define PG8_SB(b, h) ((4 + (b) * 2 + (h)) * HTB)
#define PG8_STAGE(bufoff, gbase, voff) do { _Pragma("unroll") for (int _i = 0; _i < 2; ++_i) \
        __builtin_amdgcn_global_load_lds((const unsigned*)((const char*)(gbase) + (voff)[_i]), (PG8_LAS unsigned*)(lds + (bufoff) + ldsw + _i * 8192), 16, 0, 0); } while (0)
#define PG8_LDA(dst, b, h) do { _Pragma("unroll") for (int m = 0; m < 4; ++m) _Pragma("unroll") for (int k = 0; k < 2; ++k) dst[m][k] = *(const PG8_LAS bf16x8*)(lds + PG8_SA(b, h) + aoff + m * 2048 + k * 1024); } while (0)
#define PG8_LDB(dst, b, h) do { _Pragma("unroll") for (int n = 0; n < 2; ++n) _Pragma("unroll") for (int k = 0; k < 2; ++k) dst[n][k] = *(const PG8_LAS bf16x8*)(lds + PG8_SB(b, h) + boff + n * 2048 + k * 1024); } while (0)
#define PG8_MMA(ai, bj, At, Bt) do { __builtin_amdgcn_s_setprio(1); _Pragma("unroll") for (int m = 0; m < 4; ++m) _Pragma("unroll") for (int n = 0; n < 2; ++n) _Pragma("unroll") for (int k = 0; k < 2; ++k) \
        acc[ai][bj][m][n] = __builtin_amdgcn_mfma_f32_16x16x32_bf16(Bt[n][k], At[m][k], acc[ai][bj][m][n], 0, 0, 0); __builtin_amdgcn_s_setprio(0); } while (0)
#define PG8_WAIT_V(n) asm volatile("s_waitcnt vmcnt(" #n ")" ::: "memory")
#define PG8_WAIT_L(n) asm volatile("s_waitcnt lgkmcnt(" #n ")" ::: "memory")
#define PG8_BAR __builtin_amdgcn_s_barrier()
#define PG8_SCHED __builtin_amdgcn_sched_barrier(0)
    Unit cur, nxt; int ui = 0;
    if (!S.next(0, cur)) return;
    f32x4 acc[2][2][4][2];
#pragma unroll
    for (int a = 0; a < 2; ++a)
#pragma unroll
        for (int b = 0; b < 2; ++b)
#pragma unroll
            for (int m = 0; m < 4; ++m)
#pragma unroll
                for (int n = 0; n < 2; ++n) acc[a][b][m][n] = (f32x4){0.f, 0.f, 0.f, 0.f};
    bf16x8 At[4][2], B0[2][2], B1[2][2];
    const char* cA = (const char*)g.A + (size_t)cur.pm * tstep; const char* cB = (const char*)g.Bt + (size_t)cur.pn * tstep;
    S.a_ready(cur);
    if constexpr (SP2) {
        PG8_STAGE(PG8_SB(0, 0), cB, voffB); PG8_STAGE(PG8_SB(0, 1), cB + hstep, voffB); PG8_STAGE(PG8_SA(0, 0), cA, voffA); PG8_STAGE(PG8_SA(0, 1), cA + hstep, voffA);
        if (wr == 1) PG8_BAR;
        PG8_WAIT_V(2); PG8_BAR;
        PG8_STAGE(PG8_SB(1, 0), cB + kstep, voffB); PG8_STAGE(PG8_SA(1, 0), cA + kstep, voffA); PG8_STAGE(PG8_SB(1, 1), cB + hstep + kstep, voffB);
        PG8_WAIT_V(6); PG8_BAR;
    } else {
        PG8_STAGE(PG8_SB(0, 0), cB, voffB); PG8_STAGE(PG8_SA(0, 0), cA, voffA); PG8_STAGE(PG8_SB(0, 1), cB + hstep, voffB); PG8_STAGE(PG8_SA(0, 1), cA + hstep, voffA);
        if (wr == 1) PG8_BAR;
        PG8_WAIT_V(4); PG8_BAR;
        PG8_STAGE(PG8_SB(1, 0), cB + kstep, voffB); PG8_STAGE(PG8_SA(1, 0), cA + kstep, voffA); PG8_STAGE(PG8_SB(1, 1), cB + hstep + kstep, voffB);
        PG8_WAIT_V(6); PG8_BAR;
    }
    for (;;) {
        const bool has_next = S.next(ui + 1, nxt);
        const char* nA = has_next ? (const char*)g.A + (size_t)nxt.pm * tstep : cA; const char* nB = has_next ? (const char*)g.Bt + (size_t)nxt.pn * tstep : cB;
        for (int t = 0; t < nt; t += 2) {
            const bool last = (t == nt - 2);
            const char* a1 = cA + (size_t)(t + 1) * kstep;
            const char* a2 = last ? nA : cA + (size_t)(t + 2) * kstep; const char* b2 = last ? nB : cB + (size_t)(t + 2) * kstep;
            const char* a3 = a2 + kstep; const char* b3 = b2 + kstep;
            if (last && has_next) S.a_ready(nxt);
            if constexpr (SP2) {
            PG8_LDB(B0, 0, 0); PG8_LDB(B1, 0, 1); PG8_SCHED; PG8_LDA(At, 0, 0); PG8_STAGE(PG8_SA(1, 1), a1 + hstep, voffA);
            PG8_WAIT_V(8); PG8_WAIT_L(0); PG8_BAR; PG8_MMA(0, 0, At, B0); PG8_MMA(0, 1, At, B1); PG8_BAR; PG8_SCHED;
            PG8_LDA(At, 0, 1); PG8_STAGE(PG8_SB(0, 0), b2, voffB); PG8_STAGE(PG8_SB(0, 1), b2 + hstep, voffB); PG8_STAGE(PG8_SA(0, 0), a2, voffA);
            PG8_WAIT_V(8); PG8_WAIT_L(0); PG8_BAR; PG8_MMA(1, 0, At, B0); PG8_MMA(1, 1, At, B1); PG8_BAR; PG8_SCHED;
            PG8_LDB(B0, 1, 0); PG8_LDB(B1, 1, 1); PG8_SCHED; PG8_LDA(At, 1, 0); PG8_STAGE(PG8_SA(0, 1), a2 + hstep, voffA);
            PG8_WAIT_V(8); PG8_WAIT_L(0); PG8_BAR; PG8_MMA(0, 0, At, B0); PG8_MMA(0, 1, At, B1); PG8_BAR; PG8_SCHED;
            PG8_LDA(At, 1, 1); PG8_STAGE(PG8_SB(1, 0), b3, voffB); PG8_STAGE(PG8_SB(1, 1), b3 + hstep, voffB); PG8_STAGE(PG8_SA(1, 0), a3, voffA);
            PG8_WAIT_V(8); PG8_WAIT_L(0); PG8_BAR; PG8_MMA(1, 0, At, B0); PG8_MMA(1, 1, At, B1); PG8_BAR; PG8_SCHED;
            } else {
            PG8_LDB(B0, 0, 0); PG8_SCHED; PG8_LDA(At, 0, 0); PG8_STAGE(PG8_SA(1, 1), a1 + hstep, voffA);
            PG8_WAIT_L(8); PG8_BAR; PG8_WAIT_L(0); PG8_MMA(0, 0, At, B0); PG8_BAR; PG8_SCHED;
            PG8_LDB(B1, 0, 1); PG8_STAGE(PG8_SB(0, 0), b2, voffB);
            PG8_BAR; PG8_WAIT_L(0); PG8_MMA(0, 1, At, B1); PG8_BAR;
            PG8_LDA(At, 0, 1); PG8_STAGE(PG8_SA(0, 0), a2, voffA);
            PG8_BAR; PG8_WAIT_L(0); PG8_MMA(1, 0, At, B0); PG8_BAR; PG8_SCHED;
            PG8_STAGE(PG8_SB(0, 1), b2 + hstep, voffB);
            PG8_WAIT_V(6); PG8_BAR; PG8_MMA(1, 1, At, B1); PG8_BAR;
            PG8_LDB(B0, 1, 0); PG8_SCHED; PG8_LDA(At, 1, 0); PG8_STAGE(PG8_SA(0, 1), a2 + hstep, voffA);
            PG8_WAIT_L(8); PG8_BAR; PG8_WAIT_L(0); PG8_MMA(0, 0, At, B0); PG8_BAR; PG8_SCHED;
            PG8_LDB(B1, 1, 1); PG8_STAGE(PG8_SB(1, 0), b3, voffB);
            PG8_BAR; PG8_WAIT_L(0); PG8_MMA(0, 1, At, B1); PG8_BAR;
            PG8_LDA(At, 1, 1); PG8_STAGE(PG8_SA(1, 0), a3, voffA);
            PG8_BAR; PG8_WAIT_L(0); PG8_MMA(1, 0, At, B0); PG8_BAR; PG8_SCHED;
            PG8_STAGE(PG8_SB(1, 1), b3 + hstep, voffB);
            PG8_WAIT_V(6); PG8_BAR; PG8_MMA(1, 1, At, B1); PG8_BAR;
            }
        }
        if constexpr (ALIGN_EPI) { if (wr == 0) PG8_BAR; }
        if constexpr (!Epi::AFTER_DRAIN) { E(acc, cur, wr, wc, fr, fq); S.done(cur); }
        if (!has_next) break;
#pragma unroll
        for (int a = 0; a < 2; ++a)
#pragma unroll
            for (int b = 0; b < 2; ++b)
#pragma unroll
                for (int m = 0; m < 4; ++m)
#pragma unroll
                    for (int n = 0; n < 2; ++n) acc[a][b][m][n] = (f32x4){0.f, 0.f, 0.f, 0.f};
        cur = nxt; cA = nA; cB = nB; ++ui;
        if constexpr (ALIGN_EPI) { if (wr == 1) PG8_BAR; }
    }
    PG8_WAIT_V(0);
    if constexpr (!ALIGN_EPI) { if (wr == 0) PG8_BAR; }
    PG8_BAR;
    if constexpr (Epi::AFTER_DRAIN) { E.fused(acc, cur, wr, wc, fr, fq, lds, wid, lane); S.done(cur); }
#undef PG8_SA
#undef PG8_SB
#undef PG8_STAGE
#undef PG8_LDA
#undef PG8_LDB
#undef PG8_MMA
#undef PG8_WAIT_V
#undef PG8_WAIT_L
#undef PG8_BAR
#undef PG8_SCHED
}
}

#define LAS __attribute__((address_space(3)))
typedef unsigned short bf16_t;
typedef float f32x2 __attribute__((ext_vector_type(2)));
typedef float f32x4 __attribute__((ext_vector_type(4)));
typedef float f32x16 __attribute__((ext_vector_type(16)));
typedef short bf16x8 __attribute__((ext_vector_type(8)));
typedef short s16x4 __attribute__((ext_vector_type(4)));
typedef unsigned u32x4 __attribute__((ext_vector_type(4)));
typedef unsigned u32x2 __attribute__((ext_vector_type(2)));
typedef __bf16 bf16x2v __attribute__((ext_vector_type(2)));
#define MFMA32(a, b, c) __builtin_amdgcn_mfma_f32_32x32x16_bf16((a), (b), (c), 0, 0, 0)

constexpr int D = 1024, NB = 8, TL = 2048, TCX = 256, DEPTH = 4;
constexpr int ML = NB * TL, MC = NB * TCX, M = ML + MC;
constexpr int PPAD = 11776, RWP = 3584, DFF = 2816;
constexpr int NPH = 11, NPHASES = 1 + DEPTH * NPH;
constexpr size_t MiB = 1u << 20;
constexpr size_t WS_MOD = 0, WS_WIN = 1 * MiB, WS_WA = 24 * MiB, WS_WB = 26 * MiB, WS_WC = 28 * MiB, WS_WO = 30 * MiB, WS_WI = 32 * MiB, WS_WO2 = 43 * MiB,
                 WS_LWT = 48 * MiB + MiB / 2, WS_LAT = 49 * MiB, WS_LGT = 49 * MiB + MiB / 2, WS_H = 50 * MiB, WS_XC = 86 * MiB, WS_GU = 94 * MiB, WS_GV = 130 * MiB,
                 WS_Q = 166 * MiB, WS_K = 202 * MiB, WS_V = 238 * MiB, WS_RW = 274 * MiB, WS_GT = 400 * MiB, WS_LIW = 508 * MiB, WS_LIA = 512 * MiB + MiB / 2,
                 WS_LIG = 517 * MiB, WS_DEC1 = 526 * MiB, WS_AA0 = 562 * MiB, WS_AA1 = 598 * MiB, WS_G = 634 * MiB, WS_Y1 = 670 * MiB, WS_ROPE = 706 * MiB, WS_END = 707 * MiB;
constexpr int LDS_BYTES = 131072 + 1024;
constexpr size_t WS_BAR = 917504, BAR_BYTES = 16384;
constexpr float QSCALE = 0.125f * 1.4426950408889634f;

struct Args { const float* in[33]; float* out; unsigned char* ws; int lo, hi; };
typedef const __attribute__((address_space(4))) Args CArgs;
struct TI { int tid, bid, nblk; };

__device__ __forceinline__ float bf2f(unsigned v) { return __uint_as_float(v << 16); }
__device__ __forceinline__ unsigned pkbf(float lo, float hi) { f32x2 v = {lo, hi}; bf16x2v b = __builtin_convertvector(v, bf16x2v); return __builtin_bit_cast(unsigned, b); }
__device__ __forceinline__ bf16_t f2bf(float f) { return (bf16_t)(pkbf(f, 0.f) & 0xffffu); }
#define DPP_ADD(x, ctrl) ((x) + __builtin_bit_cast(float, __builtin_amdgcn_update_dpp(0, __builtin_bit_cast(int, (x)), (ctrl), 0xf, 0xf, true)))
__device__ __forceinline__ float wave_sum(float v) {
    v = DPP_ADD(v, 0xB1); v = DPP_ADD(v, 0x4E); v = DPP_ADD(v, 0x141); v = DPP_ADD(v, 0x140);
    const int iv = __builtin_bit_cast(int, v);
    const float s0 = __builtin_bit_cast(float, __builtin_amdgcn_readlane(iv, 0)), s1 = __builtin_bit_cast(float, __builtin_amdgcn_readlane(iv, 16)),
                s2 = __builtin_bit_cast(float, __builtin_amdgcn_readlane(iv, 32)), s3 = __builtin_bit_cast(float, __builtin_amdgcn_readlane(iv, 48));
    return (s0 + s1) + (s2 + s3);
}
__device__ __forceinline__ float dpp_sum8(float x) {
    x += __builtin_bit_cast(float, __builtin_amdgcn_update_dpp(0, __builtin_bit_cast(int, x), 0xB1, 0xf, 0xf, true));
    x += __builtin_bit_cast(float, __builtin_amdgcn_update_dpp(0, __builtin_bit_cast(int, x), 0x4E, 0xf, 0xf, true));
    x += __builtin_bit_cast(float, __builtin_amdgcn_update_dpp(0, __builtin_bit_cast(int, x), 0x141, 0xf, 0xf, true));
    return x;
}
__device__ __forceinline__ float quad_sum(float x) { x = DPP_ADD(x, 0xB1); x = DPP_ADD(x, 0x4E); return x; }
__device__ __forceinline__ float quad_xor2(float x) { return __builtin_bit_cast(float, __builtin_amdgcn_update_dpp(0, __builtin_bit_cast(int, x), 0x4E, 0xf, 0xf, true)); }
__device__ __forceinline__ void unpack16(const bf16_t* p, float (&x)[16]) {
    const u32x4 a = *(const u32x4*)p, b = *(const u32x4*)(p + 8);
#pragma unroll
    for (int i = 0; i < 4; ++i) { x[2 * i] = bf2f(a[i] & 0xffffu); x[2 * i + 1] = bf2f(a[i] >> 16); x[8 + 2 * i] = bf2f(b[i] & 0xffffu); x[8 + 2 * i + 1] = bf2f(b[i] >> 16); }
}
__device__ __forceinline__ void pack16(bf16_t* p, const float (&x)[16]) {
    u32x4 a, b;
#pragma unroll
    for (int i = 0; i < 4; ++i) { a[i] = pkbf(x[2 * i], x[2 * i + 1]); b[i] = pkbf(x[8 + 2 * i], x[8 + 2 * i + 1]); }
    *(u32x4*)p = a; *(u32x4*)(p + 8) = b;
}
__device__ __forceinline__ void load16f(const float* p, float (&x)[16]) {
#pragma unroll
    for (int i = 0; i < 4; ++i) { const f32x4 v = *(const f32x4*)(p + 4 * i); x[4 * i] = v.x; x[4 * i + 1] = v.y; x[4 * i + 2] = v.z; x[4 * i + 3] = v.w; }
}
__device__ __forceinline__ float sigmoidf_(float x) { return 1.f / (1.f + __expf(-x)); }

template <class Op> struct EpiT {
    static constexpr bool PERM = true, AFTER_DRAIN = false;
    Op op;
    __device__ __forceinline__ void operator()(const pg8::f32x4 (&acc)[2][2][4][2], const pg8::Unit& u, int wr, int wc, int fr, int fq) const {
        const int row0 = u.pm * 256 + wr * 64 + fr, col0 = u.pn * 256 + wc * 32 + 8 * fq;
#pragma unroll
        for (int ai = 0; ai < 2; ++ai)
#pragma unroll
            for (int m = 0; m < 4; ++m)
#pragma unroll
                for (int bj = 0; bj < 2; ++bj) { op(row0 + ai * 128 + m * 16, col0 + bj * 128, acc[ai][bj][m][0], acc[ai][bj][m][1]); asm volatile("" ::: "memory"); }
    }
};
__device__ __forceinline__ u32x4 pack8(f32x4 v0, f32x4 v1) { u32x4 o; o.x = pkbf(v0.x, v0.y); o.y = pkbf(v0.z, v0.w); o.z = pkbf(v1.x, v1.y); o.w = pkbf(v1.z, v1.w); return o; }
__device__ __forceinline__ void unpack8(u32x4 x, f32x4& v0, f32x4& v1) {
    v0.x = bf2f(x.x & 0xffffu); v0.y = bf2f(x.x >> 16); v0.z = bf2f(x.y & 0xffffu); v0.w = bf2f(x.y >> 16);
    v1.x = bf2f(x.z & 0xffffu); v1.y = bf2f(x.z >> 16); v1.z = bf2f(x.w & 0xffffu); v1.w = bf2f(x.w >> 16);
}
__device__ __forceinline__ f32x4 gelu4(f32x4 v) { pg8::f32x2 a = pg8::gelu_pk((pg8::f32x2){v.x, v.y}), b = pg8::gelu_pk((pg8::f32x2){v.z, v.w}); return (f32x4){a.x, a.y, b.x, b.y}; }
__device__ __forceinline__ f32x4 sig4(f32x4 v) { return (f32x4){sigmoidf_(v.x), sigmoidf_(v.y), sigmoidf_(v.z), sigmoidf_(v.w)}; }

struct OpIn {
    bf16_t *GU, *GV, *Q, *RW, *GT;
    __device__ __forceinline__ void operator()(int row, int col, f32x4 v0, f32x4 v1) const {
        bf16_t* dst;
        if (col < 2048) { v0 = gelu4(v0); v1 = gelu4(v1); dst = (col < 1024 ? GU : GV) + (size_t)row * 1024 + (col & 1023); }
        else if (col < 5120) { const int q = col - 2048; dst = Q + (size_t)(q >> 10) * (size_t)(18 * MiB) + (size_t)row * 1024 + (q & 1023); }
        else if (col < 8704) { dst = RW + (size_t)row * RWP + (col - 5120); }
        else { v0 = sig4(v0); v1 = sig4(v1); dst = GT + (size_t)row * 3072 + (col - 8704); }
        *(u32x4*)dst = pack8(v0, v1);
    }
};
struct OpDec {
    bf16_t *D0, *D1; const float* w0;
    __device__ __forceinline__ float f(float x) const { const float y = -x; const float sp = y > 20.f ? y : __logf(1.f + __expf(y)); return -__expf(-sp - 0.5f); }
    __device__ __forceinline__ void operator()(int row, int col, f32x4 v0, f32x4 v1) const {
        const f32x4 b0 = *(const f32x4*)(w0 + col), b1 = *(const f32x4*)(w0 + col + 4);
        v0 += b0; v1 += b1;
        v0 = (f32x4){f(v0.x), f(v0.y), f(v0.z), f(v0.w)}; v1 = (f32x4){f(v1.x), f(v1.y), f(v1.z), f(v1.w)};
        bf16_t* dst = (col < 1024 ? D0 : D1) + (size_t)row * 1024 + (col & 1023);
        *(u32x4*)dst = pack8(v0, v1);
    }
};
struct OpAA {
    bf16_t *A0, *A1; const float* a0;
    __device__ __forceinline__ void operator()(int row, int col, f32x4 v0, f32x4 v1) const {
        const f32x4 b0 = *(const f32x4*)(a0 + col), b1 = *(const f32x4*)(a0 + col + 4);
        v0 = sig4(v0 + b0); v1 = sig4(v1 + b1);
        bf16_t* dst = (col < 1024 ? A0 : A1) + (size_t)row * 1024 + (col & 1023);
        *(u32x4*)dst = pack8(v0, v1);
    }
};
struct OpG {
    bf16_t* G;
    __device__ __forceinline__ void operator()(int row, int col, f32x4 v0, f32x4 v1) const { *(u32x4*)(G + (size_t)row * 1024 + col) = pack8(v0, v1); }
};
template <int KB> struct OpMerge {
    const bf16_t* GT; float* MF; bf16_t* MB;
    __device__ __forceinline__ void operator()(int row, int col, f32x4 v0, f32x4 v1) const {
        f32x4 g0, g1; unpack8(*(const u32x4*)(GT + (size_t)row * 3072 + KB * 1024 + col), g0, g1);
        float* mf = MF + (size_t)row * 1024 + col;
        f32x4 r0 = g0 * v0, r1 = g1 * v1;
        if (KB > 0) { r0 += *(const f32x4*)mf; r1 += *(const f32x4*)(mf + 4); }
        if (KB < 2) { *(f32x4*)mf = r0; *(f32x4*)(mf + 4) = r1; }
        else *(u32x4*)(MB + (size_t)row * 1024 + col) = pack8(r0, r1);
    }
};
struct OpResid {
    const float *xl, *xc; float *ol, *oc; const float* mod; int gi;
    __device__ __forceinline__ void operator()(int row, int col, f32x4 v0, f32x4 v1) const {
        const float* xi; float* xo; const float* g;
        if (row < ML) { xi = xl + (size_t)row * 1024 + col; xo = ol + (size_t)row * 1024 + col; g = mod + (size_t)(row >> 11) * 6144 + gi * 1024 + col; }
        else { const size_t rr = (size_t)(row - ML) * 1024 + col; xi = xc + rr; xo = oc + rr; g = mod + (size_t)8 * 6144 + gi * 1024 + col; }
        const f32x4 x0 = *(const f32x4*)xi, x1 = *(const f32x4*)(xi + 4), g0 = *(const f32x4*)g, g1 = *(const f32x4*)(g + 4);
        *(f32x4*)xo = x0 + g0 * v0; *(f32x4*)(xo + 4) = x1 + g1 * v1;
    }
};
struct OpSwiglu {
    bf16_t* HID;
    __device__ __forceinline__ void operator()(int row, int col, f32x4 v0, f32x4 v1) const {
        const float h0 = v0.x * sigmoidf_(v0.x) * v0.y, h1 = v0.z * sigmoidf_(v0.z) * v0.w, h2 = v1.x * sigmoidf_(v1.x) * v1.y, h3 = v1.z * sigmoidf_(v1.z) * v1.w;
        u32x2 o; o.x = pkbf(h0, h1); o.y = pkbf(h2, h3);
        *(u32x2*)(HID + (size_t)row * DFF + (col >> 1)) = o;
    }
};
template <class Op> __device__ __forceinline__ void run_gemm(const TI ti, unsigned char* lds, const bf16_t* A, const bf16_t* Bt, int Mr, int N, int K, const Op& op) {
    int Kv = K; asm volatile("" : "+s"(Kv));
    pg8::Gemm g{A, Bt, Mr, N, Kv}; pg8::StaticOrder S; S.init(Mr, N, ti.nblk, ti.bid);
    EpiT<Op> E{op};
    pg8::gemm_phase<EpiT<Op>, pg8::StaticOrder, true, true>((PG8_LAS unsigned char*)lds, g, S, E, ti.tid);
}

__device__ __forceinline__ void ph_mods(const TI ti, CArgs& a, unsigned char* ldsg) {
    float* sc = (float*)ldsg; float* part = sc + 9 * 1024;
    const int tid = ti.tid, lane = tid & 63, w = tid >> 6;
    for (int i = tid; i < 9 * 1024; i += 512) { const float v = (i < 8192) ? a.in[1][i] : a.in[3][i - 8192]; sc[i] = v / (1.f + expf(-v)); }
    __syncthreads();
    float* MOD = (float*)(a.ws + WS_MOD);
    for (int item = ti.bid; item < DEPTH * 96; item += ti.nblk) {
        const int l = item / 96, n0 = (item % 96) * 64;
        const float* W = a.in[4] + (size_t)l * 1024 * 6144 + n0 + lane;
        float acc[9];
#pragma unroll
        for (int r = 0; r < 9; ++r) acc[r] = 0.f;
        for (int k = w * 128; k < w * 128 + 128; ++k) {
            const float wv = W[(size_t)k * 6144];
#pragma unroll
            for (int r = 0; r < 9; ++r) acc[r] += sc[r * 1024 + k] * wv;
        }
#pragma unroll
        for (int r = 0; r < 9; ++r) part[(w * 9 + r) * 64 + lane] = acc[r];
        __syncthreads();
        for (int idx = tid; idx < 576; idx += 512) {
            const int r = idx >> 6, ln = idx & 63; float s = a.in[5][l * 6144 + n0 + ln];
            for (int ww = 0; ww < 8; ++ww) s += part[(ww * 9 + r) * 64 + ln];
            MOD[((size_t)l * 9 + r) * 6144 + n0 + ln] = s;
        }
        __syncthreads();
    }
    float* RC = (float*)(a.ws + WS_ROPE); float* RS = RC + 2048 * 32;
    for (int idx = ti.bid * 512 + tid; idx < 2048 * 32; idx += ti.nblk * 512) {
        const int t = idx >> 5, i = idx & 31; const float pos = i < 16 ? (float)(t >> 6) : (float)(t & 63);
        const float ang = pos * exp2f(-(float)(i & 15) * (13.287712379549449f / 16.f));
        RC[idx] = cosf(ang); RS[idx] = sinf(ang);
    }
}

__device__ __forceinline__ void norm_rows(const float* xl, const float* xc, const float* g, const float* modl, int shi, int sci, bf16_t* H, int nrows, int gw, int ngw, int lane) {
    for (int row = gw; row < nrows; row += ngw) {
        const float* src; int r;
        if (row < ML) { src = xl + (size_t)row * D; r = row >> 11; } else { src = xc + (size_t)(row - ML) * D; r = 8; }
        const float* md = modl + (size_t)r * 6144;
        f32x4 v[4]; float ss = 0.f;
#pragma unroll
        for (int j = 0; j < 4; ++j) { v[j] = *(const f32x4*)(src + 4 * lane + 256 * j); ss += (v[j].x * v[j].x + v[j].y * v[j].y) + (v[j].z * v[j].z + v[j].w * v[j].w); }
        ss = wave_sum(ss);
        const float rstd = rsqrtf(ss * (1.f / 1024.f) + 1e-6f);
#pragma unroll
        for (int j = 0; j < 4; ++j) {
            const int c = 4 * lane + 256 * j;
            const f32x4 gg = *(const f32x4*)(g + c), scv = *(const f32x4*)(md + sci * 1024 + c), shv = *(const f32x4*)(md + shi * 1024 + c);
            const f32x4 o = v[j] * rstd * gg * (1.f + scv) + shv;
            u32x2 p; p.x = pkbf(o.x, o.y); p.y = pkbf(o.z, o.w);
            *(u32x2*)(H + (size_t)row * D + c) = p;
        }
    }
}

template <int MODE> __device__ __forceinline__ void transpose_item(const float* W, int K, int N, bf16_t* WT, LAS float* scr, int item, int lane) {
    const int nblk = N / 32, kb = item / nblk, nb = item % nblk, k0 = 64 * kb, n0 = 32 * nb;
#pragma unroll 8
    for (int i = 0; i < 32; ++i) { const int kk = 2 * i + (lane >> 5); scr[kk * 33 + (lane & 31)] = W[(size_t)(k0 + kk) * N + n0 + (lane & 31)]; }
    asm volatile("s_waitcnt lgkmcnt(0)" ::: "memory");
    const int c = lane & 7;
#pragma unroll
    for (int j = 0; j < 4; ++j) {
        const int n = (lane >> 3) + 8 * j, gn = n0 + n; const LAS float* s = scr + (8 * c) * 33 + n;
        const int drow = MODE == 0 ? gn : (MODE == 1 ? (gn >= 8608 ? gn + 96 : gn) : (gn < DFF ? 2 * gn : 2 * (gn - DFF) + 1));
        u32x4 o; o.x = pkbf(s[0 * 33], s[1 * 33]); o.y = pkbf(s[2 * 33], s[3 * 33]); o.z = pkbf(s[4 * 33], s[5 * 33]); o.w = pkbf(s[6 * 33], s[7 * 33]);
        *(u32x4*)(WT + (size_t)drow * K + k0 + 8 * c) = o;
    }
    asm volatile("s_waitcnt lgkmcnt(0)" ::: "memory");
}
__device__ __forceinline__ void ph_wconv(CArgs& a, int l, unsigned char* ldsg, int gw, int ngw, int lane, int wv) {
    LAS float* scr = (LAS float*)(ldsg + wv * 8704);
    unsigned char* ws = a.ws;
    constexpr int I_IN = 16 * 365, I_SQ = 16 * 32, I_WI = 16 * 176, I_WO = 44 * 32, NIT = I_IN + 4 * I_SQ + I_WI + I_WO;
    for (int it = gw; it < NIT; it += ngw) {
        int r = it;
        if (r < I_IN) { transpose_item<1>(a.in[8] + (size_t)l * 1024 * 11680, 1024, 11680, (bf16_t*)(ws + WS_WIN), scr, r, lane); continue; } r -= I_IN;
        if (r < I_SQ) { transpose_item<0>(a.in[27] + (size_t)l * 1048576, 1024, 1024, (bf16_t*)(ws + WS_WA), scr, r, lane); continue; } r -= I_SQ;
        if (r < I_SQ) { transpose_item<0>(a.in[28] + (size_t)l * 1048576, 1024, 1024, (bf16_t*)(ws + WS_WB), scr, r, lane); continue; } r -= I_SQ;
        if (r < I_SQ) { transpose_item<0>(a.in[29] + (size_t)l * 1048576, 1024, 1024, (bf16_t*)(ws + WS_WC), scr, r, lane); continue; } r -= I_SQ;
        if (r < I_SQ) { transpose_item<0>(a.in[30] + (size_t)l * 1048576, 1024, 1024, (bf16_t*)(ws + WS_WO), scr, r, lane); continue; } r -= I_SQ;
        if (r < I_WI) { transpose_item<2>(a.in[31] + (size_t)l * 1024 * 5632, 1024, 5632, (bf16_t*)(ws + WS_WI), scr, r, lane); continue; } r -= I_WI;
        transpose_item<0>(a.in[32] + (size_t)l * DFF * 1024, DFF, 1024, (bf16_t*)(ws + WS_WO2), scr, r, lane);
    }
    const int gt = gw * 64 + lane, ngt = ngw * 64;
    bf16_t* LWT = (bf16_t*)(ws + WS_LWT); bf16_t* LAT = (bf16_t*)(ws + WS_LAT); bf16_t* LGT = (bf16_t*)(ws + WS_LGT);
    const float* w2 = a.in[18] + (size_t)l * 2 * 64 * 1024; const float* a2 = a.in[20] + (size_t)l * 2 * 64 * 1024; const float* g2 = a.in[21] + (size_t)l * 160 * 1024;
    for (int i = gt; i < 2048 * 128; i += ngt) {
        const int n = i >> 7, k = i & 127, d = n >> 10, c = n & 1023, kk = k - d * 64;
        const bool in = (kk >= 0 && kk < 64);
        LWT[i] = in ? f2bf(w2[((size_t)d * 64 + kk) * 1024 + c]) : (bf16_t)0;
        LAT[i] = in ? f2bf(a2[((size_t)d * 64 + kk) * 1024 + c]) : (bf16_t)0;
    }
    for (int i = gt; i < 1024 * 256; i += ngt) { const int n = i >> 8, k = i & 255; LGT[i] = k < 160 ? f2bf(g2[(size_t)k * 1024 + n]) : (bf16_t)0; }
    bf16_t* WIN = (bf16_t*)(ws + WS_WIN);
    for (int i = gt; i < 96 * 1024; i += ngt) WIN[(size_t)8608 * 1024 + i] = 0;
}

__device__ __forceinline__ void gmlp_unit(const TI ti, CArgs& a, int l, int u, unsigned char* ldsg) {
    float* rstd = (float*)ldsg; bf16_t* VNT = (bf16_t*)(ldsg + 512);
    const int tid = ti.tid, lane = tid & 63, w = tid >> 6, r = lane & 31, h = lane >> 5;
    bf16_t* GU = (bf16_t*)(a.ws + WS_GU); const bf16_t* GV = (const bf16_t*)(a.ws + WS_GV);
    const size_t R0 = (size_t)u * 128;
    for (int i = 0; i < 16; ++i) {
        const int tok = w * 16 + i; const bf16_t* p = GV + (R0 + tok) * 1024 + lane * 16;
        f32x4 x0, x1, x2, x3; unpack8(*(const u32x4*)p, x0, x1); unpack8(*(const u32x4*)(p + 8), x2, x3);
        float ss = (x0.x * x0.x + x0.y * x0.y + x0.z * x0.z + x0.w * x0.w) + (x1.x * x1.x + x1.y * x1.y + x1.z * x1.z + x1.w * x1.w)
                 + (x2.x * x2.x + x2.y * x2.y + x2.z * x2.z + x2.w * x2.w) + (x3.x * x3.x + x3.y * x3.y + x3.z * x3.z + x3.w * x3.w);
        ss = wave_sum(ss);
        if (lane == 0) rstd[tok] = rsqrtf(ss * (1.f / 1024.f) + 1e-6f);
    }
    __syncthreads();
    const float* gvg = a.in[9] + l * 1024; const float* wsp = a.in[10] + (size_t)l * 8 * 128 * 128; const float* bsp = a.in[11] + l * 8 * 128;
    const int tt = w & 3, chh = w >> 2;
    for (int g = 0; g < 8; ++g) {
        {
            const int s = tid & 127, cc = tid >> 7; const float rs = rstd[s]; const bf16_t* p = GV + (R0 + s) * 1024 + g * 128 + cc * 32;
#pragma unroll
            for (int q = 0; q < 4; ++q) {
                f32x4 x0, x1; unpack8(*(const u32x4*)(p + 8 * q), x0, x1);
                const float* gp = gvg + g * 128 + cc * 32 + 8 * q; const int c0 = cc * 32 + 8 * q;
                VNT[(c0 + 0) * 136 + s] = f2bf(x0.x * rs * gp[0]); VNT[(c0 + 1) * 136 + s] = f2bf(x0.y * rs * gp[1]);
                VNT[(c0 + 2) * 136 + s] = f2bf(x0.z * rs * gp[2]); VNT[(c0 + 3) * 136 + s] = f2bf(x0.w * rs * gp[3]);
                VNT[(c0 + 4) * 136 + s] = f2bf(x1.x * rs * gp[4]); VNT[(c0 + 5) * 136 + s] = f2bf(x1.y * rs * gp[5]);
                VNT[(c0 + 6) * 136 + s] = f2bf(x1.z * rs * gp[6]); VNT[(c0 + 7) * 136 + s] = f2bf(x1.w * rs * gp[7]);
            }
        }
        __syncthreads();
        f32x16 acc0, acc1;
#pragma unroll
        for (int i = 0; i < 16; ++i) { acc0[i] = 0.f; acc1[i] = 0.f; }
        const float* wrow = wsp + ((size_t)g * 128 + tt * 32 + r) * 128;
#pragma unroll
        for (int ks = 0; ks < 8; ++ks) {
            const f32x4 a0 = *(const f32x4*)(wrow + 16 * ks + 8 * h), a1 = *(const f32x4*)(wrow + 16 * ks + 8 * h + 4);
            const bf16x8 af = __builtin_bit_cast(bf16x8, pack8(a0, a1));
            const bf16x8 b0 = *(const bf16x8*)(VNT + (chh * 64 + r) * 136 + 16 * ks + 8 * h);
            const bf16x8 b1 = *(const bf16x8*)(VNT + (chh * 64 + 32 + r) * 136 + 16 * ks + 8 * h);
            acc0 = MFMA32(af, b0, acc0); acc1 = MFMA32(af, b1, acc1);
        }
#pragma unroll
        for (int reg = 0; reg < 16; ++reg) {
            const int t = tt * 32 + (reg & 3) + 8 * (reg >> 2) + 4 * h; const float bias = bsp[g * 128 + t];
            const size_t i0 = (R0 + t) * 1024 + g * 128 + chh * 64 + r;
            GU[i0] = f2bf(bf2f(GU[i0]) * (acc0[reg] + bias));
            GU[i0 + 32] = f2bf(bf2f(GU[i0 + 32]) * (acc1[reg] + bias));
        }
        __syncthreads();
    }
}
__device__ __forceinline__ void qk_rows(CArgs& a, int l, int gw, int ngw, int lane) {
    bf16_t* Q = (bf16_t*)(a.ws + WS_Q); bf16_t* K = (bf16_t*)(a.ws + WS_K);
    const float* RC = (const float*)(a.ws + WS_ROPE); const float* RS = RC + 2048 * 32;
    const int part = lane & 3;
    float gq[16], gk[16];
    load16f(a.in[12] + l * 64 + 16 * part, gq); load16f(a.in[13] + l * 64 + 16 * part, gk);
    for (int row = gw; row < M; row += ngw) {
        float xq[16], xk[16], cs[16], sn[16];
        unpack16(Q + (size_t)row * 1024 + 16 * lane, xq); unpack16(K + (size_t)row * 1024 + 16 * lane, xk);
        const bool lat = row < ML;
        if (lat) { const int t = row & 2047; load16f(RC + t * 32 + 16 * (part & 1), cs); load16f(RS + t * 32 + 16 * (part & 1), sn); }
        float sq = 0.f, sk = 0.f;
#pragma unroll
        for (int j = 0; j < 16; ++j) { sq += xq[j] * xq[j]; sk += xk[j] * xk[j]; }
        const float rq = rsqrtf(quad_sum(sq) * (1.f / 64.f) + 1e-6f), rk = rsqrtf(quad_sum(sk) * (1.f / 64.f) + 1e-6f);
#pragma unroll
        for (int j = 0; j < 16; ++j) { xq[j] = xq[j] * rq * gq[j]; xk[j] = xk[j] * rk * gk[j]; }
        if (lat) {
            const float sgn = part < 2 ? -1.f : 1.f;
#pragma unroll
            for (int j = 0; j < 16; ++j) {
                const float pq = quad_xor2(xq[j]), pk = quad_xor2(xk[j]);
                xq[j] = xq[j] * cs[j] + sgn * pq * sn[j]; xk[j] = xk[j] * cs[j] + sgn * pk * sn[j];
            }
        }
#pragma unroll
        for (int j = 0; j < 16; ++j) xq[j] *= QSCALE;
        pack16(Q + (size_t)row * 1024 + 16 * lane, xq); pack16(K + (size_t)row * 1024 + 16 * lane, xk);
    }
}
__device__ __forceinline__ void lora_in_rows(CArgs& a, int l, int gw, int ngw, int lane) {
    const bf16_t* RW = (const bf16_t*)(a.ws + WS_RW); bf16_t* LW = (bf16_t*)(a.ws + WS_LIW); bf16_t* LA = (bf16_t*)(a.ws + WS_LIA); bf16_t* LG = (bf16_t*)(a.ws + WS_LIG);
    const float* mu = a.in[16] + l * 3488 + 3072;
    f32x4 m0 = {0.f, 0.f, 0.f, 0.f}, m1 = m0;
    if (lane < 52) { m0 = *(const f32x4*)(mu + 8 * lane); m1 = *(const f32x4*)(mu + 8 * lane + 4); }
    for (int row = gw; row < M; row += ngw) {
        int t, Tn; if (row < ML) { t = row & 2047; Tn = 2048; } else { t = (row - ML) & 255; Tn = 256; }
        const bool hp = t > 0, hn = t < Tn - 1;
        if (lane < 52) {
            const bf16_t* p = RW + (size_t)row * RWP + 3072 + 8 * lane;
            f32x4 x0, x1, p0 = {0.f, 0.f, 0.f, 0.f}, p1 = p0, n0 = p0, n1 = p0;
            unpack8(*(const u32x4*)p, x0, x1);
            if (hp) unpack8(*(const u32x4*)(p - RWP), p0, p1);
            if (hn) unpack8(*(const u32x4*)(p + RWP), n0, n1);
            f32x4 z0 = x0 + m0 * (0.5f * (p0 + n0) - x0), z1 = x1 + m1 * (0.5f * (p1 + n1) - x1);
            const int j = 8 * lane;
            if (j < 128) { z0 = (f32x4){tanhf(z0.x), tanhf(z0.y), tanhf(z0.z), tanhf(z0.w)}; z1 = (f32x4){tanhf(z1.x), tanhf(z1.y), tanhf(z1.z), tanhf(z1.w)}; *(u32x4*)(LW + (size_t)row * 128 + j) = pack8(z0, z1); }
            else if (j < 256) { *(u32x4*)(LA + (size_t)row * 128 + j - 128) = pack8(z0, z1); }
            else { *(u32x4*)(LG + (size_t)row * 256 + j - 256) = pack8(sig4(z0), sig4(z1)); }
        } else {
            *(u32x4*)(LG + (size_t)row * 256 + 160 + (lane - 52) * 8) = (u32x4){0u, 0u, 0u, 0u};
        }
    }
}

__device__ __forceinline__ void scan_unit(const TI ti, CArgs& a, int l, int u, bool ctx_out, unsigned char* ldsg) {
    const int tid = ti.tid, lane = tid & 63, w = tid >> 6;
    const int b = u >> 5, hh = (u >> 1) & 15, d = u & 1;
    const int si = tid >> 3, jq = tid & 7;
    LAS float* L = (LAS float*)ldsg;
    const bf16_t* RW = (const bf16_t*)(a.ws + WS_RW);
    const bf16_t* DEC = (const bf16_t*)(a.ws + (d ? WS_DEC1 : WS_GV));
    const bf16_t* AA = (const bf16_t*)(a.ws + (d ? WS_AA1 : WS_AA0));
    bf16_t* Y = (bf16_t*)(a.ws + (d ? WS_Y1 : WS_H));
    const int ch = hh * 64 + lane;
    const float* mu = a.in[16] + l * 3488;
    const float mur = mu[ch], muk = mu[1024 + ch], muv = mu[2048 + ch], kkg = a.in[22][l * 1024 + ch], kag = a.in[23][l * 1024 + ch];
    f32x4 S0 = {0.f, 0.f, 0.f, 0.f}, S1 = {0.f, 0.f, 0.f, 0.f};
    unsigned raw[4][9]; unsigned dcr[4], aar[4];
    constexpr int NC = 72;
#define SCAN_CHUNK(n, base, Tn, t0, wy) int base, Tn, t0; bool wy; { int ci; if ((n) < 8) { base = ML + b * 256; Tn = 256; ci = d ? 7 - (n) : (n); wy = ctx_out; } else { base = b * 2048; Tn = 2048; ci = d ? 71 - (n) : (n) - 8; wy = true; } t0 = ci * 32; }
#define SCAN_LOAD(n) do { SCAN_CHUNK(n, base_, Tn_, t0_, wy_); (void)wy_; _Pragma("unroll") for (int i4 = 0; i4 < 4; ++i4) { const int t = t0_ + w + 8 * i4; const size_t row = (size_t)(base_ + t); \
        const bf16_t* p = RW + row * RWP + ch; const bool hp = t > 0, hn = t < Tn_ - 1; \
        _Pragma("unroll") for (int X = 0; X < 3; ++X) { raw[i4][3 * X + 0] = hp ? (unsigned)p[X * 1024 - RWP] : 0u; raw[i4][3 * X + 1] = (unsigned)p[X * 1024]; raw[i4][3 * X + 2] = hn ? (unsigned)p[X * 1024 + RWP] : 0u; } \
        dcr[i4] = (unsigned)DEC[row * 1024 + ch]; aar[i4] = (unsigned)AA[row * 1024 + ch]; } } while (0)
#define SCAN_STORE(n) do { LAS float* Bf = L + ((n) & 1) * 12288; _Pragma("unroll") for (int i4 = 0; i4 < 4; ++i4) { const int tk = w + 8 * i4; \
        const float xr = bf2f(raw[i4][1]), xk = bf2f(raw[i4][4]), xv = bf2f(raw[i4][7]); \
        const float zr = xr + mur * (0.5f * (bf2f(raw[i4][0]) + bf2f(raw[i4][2])) - xr); \
        const float zk = xk + muk * (0.5f * (bf2f(raw[i4][3]) + bf2f(raw[i4][5])) - xk); \
        const float zv = xv + muv * (0.5f * (bf2f(raw[i4][6]) + bf2f(raw[i4][8])) - xv); \
        const float kkv = zk * kkg; const float ssq = wave_sum(kkv * kkv); const float kkn = kkv / fmaxf(sqrtf(ssq), 1e-12f); \
        const float ad = bf2f(aar[i4]); const float wv_ = __expf(bf2f(dcr[i4])); const float kd = zk * (1.f + (ad - 1.f) * kag); \
        Bf[0 * 2048 + tk * 64 + lane] = wv_; Bf[1 * 2048 + tk * 64 + lane] = kd; Bf[2 * 2048 + tk * 64 + lane] = -kkn; \
        Bf[3 * 2048 + tk * 64 + lane] = kkn * ad; Bf[4 * 2048 + tk * 64 + lane] = zr; Bf[5 * 2048 + tk * 64 + lane] = zv; } } while (0)
    SCAN_LOAD(0); SCAN_STORE(0);
    __syncthreads();
    for (int n = 0; n < NC; ++n) {
        if (n + 1 < NC) SCAN_LOAD(n + 1);
        LAS const float* Bf = L + (n & 1) * 12288; LAS float* Yb = L + 24576 + (n & 1) * 2048;
#pragma unroll 2
        for (int ss = 0; ss < 32; ++ss) {
            const int s = d ? 31 - ss : ss;
            LAS const float* q = Bf + s * 64 + 8 * jq;
            const f32x4 w0 = *(LAS const f32x4*)(q), w1 = *(LAS const f32x4*)(q + 4);
            const f32x4 k0 = *(LAS const f32x4*)(q + 2048), k1 = *(LAS const f32x4*)(q + 2048 + 4);
            const f32x4 a0 = *(LAS const f32x4*)(q + 4096), a1 = *(LAS const f32x4*)(q + 4096 + 4);
            const f32x4 b0 = *(LAS const f32x4*)(q + 6144), b1 = *(LAS const f32x4*)(q + 6144 + 4);
            const f32x4 r0 = *(LAS const f32x4*)(q + 8192), r1 = *(LAS const f32x4*)(q + 8192 + 4);
            const float vi = Bf[5 * 2048 + s * 64 + si];
            const f32x4 ta = S0 * a0 + S1 * a1;
            const float sa = dpp_sum8((ta.x + ta.y) + (ta.z + ta.w));
            S0 = S0 * w0 + (sa * b0 + vi * k0);
            S1 = S1 * w1 + (sa * b1 + vi * k1);
            const f32x4 ty = S0 * r0 + S1 * r1;
            const float y = dpp_sum8((ty.x + ty.y) + (ty.z + ty.w));
            if (jq == 0) Yb[s * 64 + si] = y;
        }
        if (n + 1 < NC) SCAN_STORE(n + 1);
        __syncthreads();
        {
            SCAN_CHUNK(n, base_, Tn_, t0_, wy_); (void)Tn_;
            if (wy_) {
#pragma unroll
                for (int i4 = 0; i4 < 4; ++i4) { const int tk = w + 8 * i4; Y[(size_t)(base_ + t0_ + tk) * 1024 + ch] = f2bf(Yb[tk * 64 + lane]); }
            }
        }
    }
    __syncthreads();
#undef SCAN_CHUNK
#undef SCAN_LOAD
#undef SCAN_STORE
}

__device__ __forceinline__ void attn_unit(const TI ti, CArgs& a, int b, int hd, int qrow0, int st_lo, int st_hi, float mfix, float lam, float lam_init, const float* subg, unsigned char* ldsg) {
    const int tid = ti.tid, lane = tid & 63, w = tid >> 6, r = lane & 31, h = lane >> 5, qt = w >> 1, c = w & 1;
    bf16_t* Qb = (bf16_t*)(a.ws + WS_Q); const bf16_t* Kb = (const bf16_t*)(a.ws + WS_K); const bf16_t* Vb = (const bf16_t*)(a.ws + WS_V);
    LAS unsigned char* L = (LAS unsigned char*)ldsg;
    constexpr int KOFF = 0, VOFF = 17408, BUFB = 35840;
    bf16x8 qf[4];
    { const bf16_t* qp = Qb + (size_t)(qrow0 + qt * 32 + r) * 1024 + hd * 128 + c * 64 + 8 * h;
#pragma unroll
      for (int ks = 0; ks < 4; ++ks) qf[ks] = *(const bf16x8*)(qp + 16 * ks); }
    f32x16 O[4];
#pragma unroll
    for (int e = 0; e < 4; ++e)
#pragma unroll
        for (int i = 0; i < 16; ++i) O[e][i] = 0.f;
    float lsum = 0.f;
    u32x4 kreg[2], vreg[2];
#define ATT_KROW(kk) ((kk) < 2048 ? (size_t)(b * 2048 + (kk)) : (size_t)(ML + b * 256 + (kk) - 2048))
#define ATT_LOAD(st) do { _Pragma("unroll") for (int i = 0; i < 2; ++i) { const int p = tid + 512 * i, key = p >> 4, dc = p & 15; kreg[i] = *(const u32x4*)(Kb + ATT_KROW((st) * 64 + key) * 1024 + hd * 128 + dc * 8); } \
        const bf16_t* vp = Vb + ATT_KROW((st) * 64 + lane) * 1024 + hd * 128 + w * 16; vreg[0] = *(const u32x4*)vp; vreg[1] = *(const u32x4*)(vp + 8); } while (0)
#define ATT_STORE(bufi) do { LAS unsigned char* Bb = L + (bufi) * BUFB; _Pragma("unroll") for (int i = 0; i < 2; ++i) { const int p = tid + 512 * i, key = p >> 4, dc = p & 15; *(LAS u32x4*)(Bb + KOFF + key * 272 + dc * 16) = kreg[i]; } \
        LAS bf16_t* vt = (LAS bf16_t*)(Bb + VOFF) + (w * 16) * 72 + lane; \
        _Pragma("unroll") for (int e = 0; e < 4; ++e) { vt[(2 * e) * 72] = (bf16_t)(vreg[0][e] & 0xffffu); vt[(2 * e + 1) * 72] = (bf16_t)(vreg[0][e] >> 16); \
            vt[(8 + 2 * e) * 72] = (bf16_t)(vreg[1][e] & 0xffffu); vt[(8 + 2 * e + 1) * 72] = (bf16_t)(vreg[1][e] >> 16); } } while (0)
    ATT_LOAD(st_lo); ATT_STORE(0);
    __syncthreads();
    for (int st = st_lo; st < st_hi; ++st) {
        const int bi = (st - st_lo) & 1;
        if (st + 1 < st_hi) ATT_LOAD(st + 1);
        LAS const unsigned char* Bb = L + bi * BUFB;
#pragma unroll
        for (int sub = 0; sub < 2; ++sub) {
            f32x16 Sx;
#pragma unroll
            for (int i = 0; i < 16; ++i) Sx[i] = 0.f;
#pragma unroll
            for (int ks = 0; ks < 4; ++ks) {
                const bf16x8 kf = *(LAS const bf16x8*)(Bb + KOFF + (sub * 32 + r) * 272 + (c * 64 + 16 * ks + 8 * h) * 2);
                Sx = MFMA32(kf, qf[ks], Sx);
            }
            float p[16];
#pragma unroll
            for (int i = 0; i < 16; ++i) { p[i] = __builtin_amdgcn_exp2f(Sx[i] - mfix); lsum += p[i]; }
            u32x4 pw0, pw1;
            pw0.x = pkbf(p[0], p[1]); pw0.y = pkbf(p[2], p[3]); pw0.z = pkbf(p[4], p[5]); pw0.w = pkbf(p[6], p[7]);
            pw1.x = pkbf(p[8], p[9]); pw1.y = pkbf(p[10], p[11]); pw1.z = pkbf(p[12], p[13]); pw1.w = pkbf(p[14], p[15]);
            const bf16x8 pb0 = __builtin_bit_cast(bf16x8, pw0), pb1 = __builtin_bit_cast(bf16x8, pw1);
#pragma unroll
            for (int et = 0; et < 4; ++et) {
#pragma unroll
                for (int s = 0; s < 2; ++s) {
                    LAS const unsigned char* va = Bb + VOFF + (et * 32 + r) * 144 + (sub * 32 + 16 * s + 4 * h) * 2;
                    const s16x4 lo = *(LAS const s16x4*)va, hi = *(LAS const s16x4*)(va + 16);
                    const bf16x8 vf = __builtin_shufflevector(lo, hi, 0, 1, 2, 3, 4, 5, 6, 7);
                    O[et] = MFMA32(vf, s ? pb1 : pb0, O[et]);
                }
            }
        }
        if (st + 1 < st_hi) ATT_STORE(bi ^ 1);
        __syncthreads();
    }
#undef ATT_KROW
#undef ATT_LOAD
#undef ATT_STORE
    const float ltot = lsum + __shfl_xor(lsum, 32);
    const float linv = 1.f / ltot;
    LAS float* X = (LAS float*)L + qt * 4096;
    if (c == 1) {
#pragma unroll
        for (int e = 0; e < 4; ++e)
#pragma unroll
            for (int i = 0; i < 16; ++i) X[(e * 16 + i) * 64 + lane] = O[e][i] * linv;
    }
    __syncthreads();
    if (c == 0) {
        float ssq = 0.f;
#pragma unroll
        for (int e = 0; e < 4; ++e)
#pragma unroll
            for (int i = 0; i < 16; ++i) { const float o = O[e][i] * linv - lam * X[(e * 16 + i) * 64 + lane]; O[e][i] = o; ssq += o * o; }
        ssq += __shfl_xor(ssq, 32);
        const float sc = rsqrtf(ssq * (1.f / 128.f) + 1e-6f) * (1.f - lam_init);
        bf16_t* op = Qb + (size_t)(qrow0 + qt * 32 + r) * 1024 + hd * 128;
#pragma unroll
        for (int e = 0; e < 4; ++e)
#pragma unroll
            for (int g4 = 0; g4 < 4; ++g4) {
                const int e0 = e * 32 + 8 * g4 + 4 * h; const f32x4 sg = *(const f32x4*)(subg + e0);
                u32x2 o; o.x = pkbf(O[e][4 * g4 + 0] * sc * sg.x, O[e][4 * g4 + 1] * sc * sg.y); o.y = pkbf(O[e][4 * g4 + 2] * sc * sg.z, O[e][4 * g4 + 3] * sc * sg.w);
                *(u32x2*)(op + e0) = o;
            }
    }
    __syncthreads();
}
__device__ __forceinline__ void ph_attn(const TI ti, CArgs& a, int l, bool ctx_out, unsigned char* ldsg) {
    const int lane = ti.tid & 63;
    const float gqm = fabsf(a.in[12][l * 64 + lane]), gkm = fabsf(a.in[13][l * 64 + lane]);
    float mq = gqm, mk = gkm;
#pragma unroll
    for (int o = 1; o < 64; o <<= 1) { mq = fmaxf(mq, __shfl_xor(mq, o)); mk = fmaxf(mk, __shfl_xor(mk, o)); }
    const float mfix = 8.f * mq * mk * 1.4426950408889634f * 1.03f;
    const float* lp = a.in[14] + l * 256;
    const float s1 = wave_sum(lp[lane] * lp[64 + lane]), s2 = wave_sum(lp[128 + lane] * lp[192 + lane]);
    const float lam_init = 0.8f - 0.6f * expf(-0.3f * (float)l);
    const float lam = expf(s1) - expf(s2) + lam_init;
    const float* subg = a.in[15] + l * 128;
    const int nun = 1024 + (ctx_out ? 128 : 0);
    for (int u = ti.bid; u < nun; u += ti.nblk) {
        if (u < 1024) { const int bh = u >> 4, qb = u & 15; attn_unit(ti, a, bh >> 3, bh & 7, (bh >> 3) * 2048 + qb * 128, 0, 36, mfix, lam, lam_init, subg, ldsg); }
        else { const int v = u - 1024, bh = v >> 1, qb = v & 1; attn_unit(ti, a, bh >> 3, bh & 7, ML + (bh >> 3) * 256 + qb * 128, 32, 36, mfix, lam, lam_init, subg, ldsg); }
    }
}

__device__ __forceinline__ void up8(const bf16_t* p, float (&x)[8]) { const u32x4 v = *(const u32x4*)p;
#pragma unroll
    for (int i = 0; i < 4; ++i) { x[2 * i] = bf2f(v[i] & 0xffffu); x[2 * i + 1] = bf2f(v[i] >> 16); } }
__device__ __forceinline__ void ld8f(const float* p, float (&x)[8]) { const f32x4 u = *(const f32x4*)p, v = *(const f32x4*)(p + 4); x[0] = u.x; x[1] = u.y; x[2] = u.z; x[3] = u.w; x[4] = v.x; x[5] = v.y; x[6] = v.z; x[7] = v.w; }
__device__ __forceinline__ void shift8(const bf16_t* p, const float* mu, bool hp, bool hn, float (&z)[8]) {
    float x[8], xp[8], xn[8], m[8];
#pragma unroll
    for (int j = 0; j < 8; ++j) { xp[j] = 0.f; xn[j] = 0.f; }
    up8(p, x); if (hp) up8(p - RWP, xp); if (hn) up8(p + RWP, xn); ld8f(mu, m);
#pragma unroll
    for (int j = 0; j < 8; ++j) z[j] = x[j] + m[j] * (0.5f * (xp[j] + xn[j]) - x[j]);
}
__device__ __forceinline__ void rwkv_out_rows(CArgs& a, int l, int nrows, int gw, int ngw, int lane) {
    const bf16_t* RW = (const bf16_t*)(a.ws + WS_RW); const bf16_t* Y0 = (const bf16_t*)(a.ws + WS_H); bf16_t* Y1 = (bf16_t*)(a.ws + WS_Y1);
    const bf16_t* A0 = (const bf16_t*)(a.ws + WS_AA0); const bf16_t* A1 = (const bf16_t*)(a.ws + WS_AA1); const bf16_t* G = (const bf16_t*)(a.ws + WS_G);
    const float* mu = a.in[16] + l * 3488;
    for (int it = gw; it < 2 * nrows; it += ngw) {
        const int row = it >> 1, c0 = (it & 1) * 512 + 8 * lane;
        int t, Tn; if (row < ML) { t = row & 2047; Tn = 2048; } else { t = (row - ML) & 255; Tn = 256; }
        const bool hp = t > 0, hn = t < Tn - 1;
        const size_t idx = (size_t)row * 1024 + c0;
        float y[8], y1[8], g[8], a0[8], a1[8], zr[8], zk[8], zv[8], lnw[8], lnb[8], ka[8], rk[8];
        up8(Y0 + idx, y); up8(Y1 + idx, y1); up8(G + idx, g); up8(A0 + idx, a0); up8(A1 + idx, a1);
        const bf16_t* p = RW + (size_t)row * RWP + c0;
        shift8(p, mu + c0, hp, hn, zr); shift8(p + 1024, mu + 1024 + c0, hp, hn, zk); shift8(p + 2048, mu + 2048 + c0, hp, hn, zv);
        ld8f(a.in[25] + l * 1024 + c0, lnw); ld8f(a.in[26] + l * 1024 + c0, lnb); ld8f(a.in[23] + l * 1024 + c0, ka); ld8f(a.in[24] + l * 1024 + c0, rk);
        float sm = 0.f;
#pragma unroll
        for (int j = 0; j < 8; ++j) { y[j] += y1[j]; sm += y[j]; }
        const float mean = dpp_sum8(sm) * (1.f / 64.f);
        float sv = 0.f, sb = 0.f;
#pragma unroll
        for (int j = 0; j < 8; ++j) { y[j] -= mean; sv += y[j] * y[j]; const float kds = zk[j] * ((1.f + (a0[j] - 1.f) * ka[j]) + (1.f + (a1[j] - 1.f) * ka[j])); sb += zr[j] * kds * rk[j]; }
        const float rstd = rsqrtf(dpp_sum8(sv) * (1.f / 64.f) + 64e-5f), bsum = dpp_sum8(sb);
        u32x4 o;
#pragma unroll
        for (int j = 0; j < 4; ++j) o[j] = pkbf(((y[2 * j] * rstd * lnw[2 * j] + lnb[2 * j]) + bsum * zv[2 * j]) * g[2 * j], ((y[2 * j + 1] * rstd * lnw[2 * j + 1] + lnb[2 * j + 1]) + bsum * zv[2 * j + 1]) * g[2 * j + 1]);
        *(u32x4*)(Y1 + idx) = o;
    }
}

#define XB_TMO      128
#define XB_XCNT(j)  (256  + 64 * (j))
#define XB_XSUB(j)  (1280 + 64 * (j))
#define XB_XGEN(j)  (2304 + 64 * (j))
#define XB_TOP      3328
#define XB_TOPGEN   3392
#define XCD_BAR_WORDS 3456
#define XB_SPIN_CAP (1u << 20)

__device__ __forceinline__ unsigned xb_ld(unsigned* p)              { return __hip_atomic_load(p, __ATOMIC_RELAXED, __HIP_MEMORY_SCOPE_AGENT); }
__device__ __forceinline__ unsigned xb_add(unsigned* p, unsigned v) { return __hip_atomic_fetch_add(p, v, __ATOMIC_RELAXED, __HIP_MEMORY_SCOPE_AGENT); }
__device__ __forceinline__ unsigned xb_xcc_id() { return (unsigned)__builtin_amdgcn_s_getreg((3 << 11) | 20) & 0xFu; }
#define XB_SPIN(cond, bar) do { unsigned _sp = 0; while (cond) { __builtin_amdgcn_s_sleep(1); \
    if ((++_sp & 255u) == 0u) { if (xb_ld(&(bar)[XB_TMO])) break; if (_sp > XB_SPIN_CAP) { atomicAdd(&(bar)[XB_TMO], 1u); break; } } } } while (0)

struct XcdBarrier {
    unsigned* bar; unsigned x;
    volatile LAS unsigned* st;
};

__device__ __forceinline__ XcdBarrier xcd_barrier_post(unsigned* bar, volatile LAS unsigned* st) {
    XcdBarrier b; b.bar = bar; b.x = xb_xcc_id(); b.st = st;
    if (threadIdx.x == 0) (void)xb_add(&bar[XB_XCNT(b.x)], 1u);
    return b;
}
__device__ __forceinline__ void xcd_barrier_complete(unsigned* bar, unsigned x, unsigned& nloc, unsigned& nx) {
    const unsigned G = gridDim.x * gridDim.y * gridDim.z;
    unsigned sum, cnt, mine, sp = 0u;
    for (;;) {
        sum = 0u; cnt = 0u; mine = 0u;
#pragma unroll
        for (unsigned j = 0; j < 16; ++j) { const unsigned c = xb_ld(&bar[XB_XCNT(j)]); sum += c; cnt += (c > 0u) ? 1u : 0u; mine = (j == x) ? c : mine; }
        if (sum == G) break;
        __builtin_amdgcn_s_sleep(1);
        if ((++sp & 255u) == 0u) { if (xb_ld(&bar[XB_TMO])) break; if (sp > XB_SPIN_CAP) { atomicAdd(&bar[XB_TMO], 1u); break; } }
    }
    nloc = mine > 0u ? mine : 1u; nx = cnt > 0u ? cnt : 1u;
}

__device__ __forceinline__ void xcd_barrier(const XcdBarrier& b) {
    asm volatile("s_waitcnt vmcnt(0)" ::: "memory");
    __syncthreads();
    if (threadIdx.x == 0) {
        unsigned* bar = b.bar;
        __builtin_amdgcn_s_waitcnt(0);
        unsigned nloc = b.st[0], nx = b.st[1];
        if (nloc == 0u) { xcd_barrier_complete(bar, b.x, nloc, nx); b.st[0] = nloc; b.st[1] = nx; }
        const unsigned old = xb_add(&bar[XB_XSUB(b.x)], 1u);
        const unsigned gen = old / nloc;
        if (old + 1u == (gen + 1u) * nloc) {
            __builtin_amdgcn_fence(__ATOMIC_RELEASE, "agent");
            asm volatile("s_waitcnt vmcnt(0)" ::: "memory");
            const unsigned og = xb_add(&bar[XB_TOP], 1u);
            const unsigned tg = og / nx;
            if (og + 1u == (tg + 1u) * nx) xb_add(&bar[XB_TOPGEN], 1u);
            else XB_SPIN(xb_ld(&bar[XB_TOPGEN]) == tg, bar);
            __builtin_amdgcn_fence(__ATOMIC_ACQUIRE, "agent");
            xb_add(&bar[XB_XGEN(b.x)], 1u);
            asm volatile("s_waitcnt vmcnt(0)" ::: "memory");
        } else {
            XB_SPIN(xb_ld(&bar[XB_XGEN(b.x)]) == gen, bar);
            __builtin_amdgcn_fence(__ATOMIC_ACQUIRE, "agent");
            asm volatile("s_waitcnt vmcnt(0)" ::: "memory");
        }
    }
    __syncthreads();
}

#ifndef ONLY_PH
#define ONLY_PH -1
#endif
#ifndef SKIP_PH
#define SKIP_PH -2
#endif
#define PH_ON(k) ((ONLY_PH < 0 || ONLY_PH == (k)) && (k) != SKIP_PH)
__global__ void __launch_bounds__(512, 2) mega_fwd(Args a_) {
    extern __shared__ __attribute__((aligned(16))) unsigned char lds[];
    cg::grid_group grid = cg::this_grid();
    const int ph_lo = a_.lo, ph_hi = a_.hi;
    volatile LAS unsigned* bst = (volatile LAS unsigned*)((LAS unsigned char*)lds + 131072);
    if (threadIdx.x < 2) bst[threadIdx.x] = 0u;
    __syncthreads();
    const XcdBarrier xbar = xcd_barrier_post((unsigned*)(a_.ws + WS_BAR), bst);
    const int wave_s = __builtin_amdgcn_readfirstlane((int)threadIdx.x >> 6);
#pragma nounroll
    for (int ph = ph_lo; ph < ph_hi; ++ph) {
        CArgs* ap = (CArgs*)__builtin_amdgcn_kernarg_segment_ptr(); asm volatile("" : "+s"(ap));
        CArgs& a = *ap;
        unsigned char* ws = a.ws;
        float* XC = (float*)(ws + WS_XC);
        int wsv = wave_s; asm volatile("" : "+s"(wsv));
        TI ti; ti.tid = wsv * 64 + (int)__builtin_amdgcn_mbcnt_hi(~0u, __builtin_amdgcn_mbcnt_lo(~0u, 0u)); ti.bid = blockIdx.x; ti.nblk = gridDim.x;
        asm volatile("" : "+v"(ti.tid)); asm volatile("" : "+s"(ti.bid)); asm volatile("" : "+s"(ti.nblk));
        const int tid = ti.tid, lane = tid & 63, wv = __builtin_amdgcn_readfirstlane(tid >> 6);
        const int gw = ti.bid * 8 + wv, ngw = ti.nblk * 8;
        if (ph == 0) { if constexpr (PH_ON(100)) ph_mods(ti, a, lds); }
        else {
            const int l = (ph - 1) / NPH, k = (ph - 1) % NPH;
            const bool ctx_out = l < DEPTH - 1;
            const int Mr = ctx_out ? M : ML;
            const float* modl = (const float*)(ws + WS_MOD) + (size_t)l * 9 * 6144;
            const float* xl_in = l == 0 ? a.in[0] : a.out; const float* xc_in = l == 0 ? a.in[2] : XC;
            bf16_t* H = (bf16_t*)(ws + WS_H);
            switch (k) {
            case 0: if constexpr (PH_ON(0)) {
                norm_rows(xl_in, xc_in, a.in[6] + l * 1024, modl, 0, 1, H, M, gw, ngw, lane);
                ph_wconv(a, l, lds, gw, ngw, lane, wv);
                } break;
            case 1: if constexpr (PH_ON(1)) {
                OpIn op{(bf16_t*)(ws + WS_GU), (bf16_t*)(ws + WS_GV), (bf16_t*)(ws + WS_Q), (bf16_t*)(ws + WS_RW), (bf16_t*)(ws + WS_GT)};
                run_gemm(ti, lds, H, (const bf16_t*)(ws + WS_WIN), M, PPAD, 1024, op);
            } break;
            case 2: if constexpr (PH_ON(2)) {
                for (int u = ti.bid; u < Mr / 128; u += ti.nblk) gmlp_unit(ti, a, l, u, lds);
                qk_rows(a, l, gw, ngw, lane);
                lora_in_rows(a, l, gw, ngw, lane);
                } break;
            case 3: if constexpr (PH_ON(3)) {
                OpDec o1{(bf16_t*)(ws + WS_GV), (bf16_t*)(ws + WS_DEC1), a.in[17] + l * 2048};
                run_gemm(ti, lds, (const bf16_t*)(ws + WS_LIW), (const bf16_t*)(ws + WS_LWT), M, 2048, 128, o1);
                OpAA o2{(bf16_t*)(ws + WS_AA0), (bf16_t*)(ws + WS_AA1), a.in[19] + l * 2048};
                run_gemm(ti, lds, (const bf16_t*)(ws + WS_LIA), (const bf16_t*)(ws + WS_LAT), M, 2048, 128, o2);
                OpG o3{(bf16_t*)(ws + WS_G)};
                run_gemm(ti, lds, (const bf16_t*)(ws + WS_LIG), (const bf16_t*)(ws + WS_LGT), M, 1024, 256, o3);
            } break;
            case 4:
                if constexpr (PH_ON(4)) { for (int u = ti.bid; u < 256; u += ti.nblk) scan_unit(ti, a, l, u, ctx_out, lds); }
                if constexpr (PH_ON(40)) ph_attn(ti, a, l, ctx_out, lds);
                break;
            case 5: if constexpr (PH_ON(5)) {
                rwkv_out_rows(a, l, Mr, gw, ngw, lane);
                } break;
            case 6: if constexpr (PH_ON(6)) {
                const bf16_t* GT = (const bf16_t*)(ws + WS_GT); float* MF = (float*)(ws + WS_K);
                OpMerge<0> o0{GT, MF, H}; run_gemm(ti, lds, (const bf16_t*)(ws + WS_GU), (const bf16_t*)(ws + WS_WA), Mr, 1024, 1024, o0);
                OpMerge<1> o1{GT, MF, H}; run_gemm(ti, lds, (const bf16_t*)(ws + WS_Q), (const bf16_t*)(ws + WS_WB), Mr, 1024, 1024, o1);
                OpMerge<2> o2{GT, MF, H}; run_gemm(ti, lds, (const bf16_t*)(ws + WS_Y1), (const bf16_t*)(ws + WS_WC), Mr, 1024, 1024, o2);
            } break;
            case 7: if constexpr (PH_ON(7)) {
                OpResid op{xl_in, xc_in, a.out, XC, modl, 2};
                run_gemm(ti, lds, H, (const bf16_t*)(ws + WS_WO), Mr, 1024, 1024, op);
            } break;
            case 8: if constexpr (PH_ON(8)) {
                norm_rows(a.out, XC, a.in[7] + l * 1024, modl, 3, 4, H, Mr, gw, ngw, lane);
                } break;
            case 9: if constexpr (PH_ON(9)) {
                OpSwiglu op{(bf16_t*)(ws + WS_RW)};
                run_gemm(ti, lds, H, (const bf16_t*)(ws + WS_WI), Mr, 2 * DFF, 1024, op);
            } break;
            default: if constexpr (PH_ON(10)) {
                OpResid op{a.out, XC, a.out, XC, modl, 5};
                run_gemm(ti, lds, (const bf16_t*)(ws + WS_RW), (const bf16_t*)(ws + WS_WO2), Mr, 1024, DFF, op);
            } break;
            }
        }
        if (ph + 1 < ph_hi) { if (ph == ph_lo) grid.sync(); else xcd_barrier(xbar); }
    }
}

extern "C" void kernel_launch(void* const* d_in, const int* in_sizes, int n_in, void* d_out, int out_size, void* d_ws, size_t ws_size, hipStream_t stream) {
    static int grid = 0;
    if (grid == 0) {
        if (n_in != 33 || out_size != ML * D || ws_size < WS_END) { fprintf(stderr, "kernel_launch: unexpected shapes / workspace (%d inputs, out %d, ws %zu, need %zu)\n", n_in, out_size, ws_size, (size_t)WS_END); grid = -1; return; }
        int dev = 0, cus = 0, per_cu = 0;
        hipGetDevice(&dev); hipDeviceGetAttribute(&cus, hipDeviceAttributeMultiprocessorCount, dev);
        if (hipFuncSetAttribute((const void*)mega_fwd, hipFuncAttributeMaxDynamicSharedMemorySize, LDS_BYTES) != hipSuccess) { fprintf(stderr, "kernel_launch: hipFuncSetAttribute failed\n"); grid = -1; return; }
        if (hipOccupancyMaxActiveBlocksPerMultiprocessor(&per_cu, (const void*)mega_fwd, 512, LDS_BYTES) != hipSuccess || per_cu < 1) per_cu = 1;
        (void)hipGetLastError();
        grid = cus * 1;
    }
    if (grid < 0) return;
    Args a{};
    for (int i = 0; i < 33; ++i) a.in[i] = (const float*)d_in[i];
    a.out = (float*)d_out; a.ws = (unsigned char*)d_ws; a.lo = 0; a.hi = NPHASES;
    void* args[] = {&a};
    if (hipMemsetAsync((char*)d_ws + WS_BAR, 0, BAR_BYTES, stream) != hipSuccess) { fprintf(stderr, "kernel_launch: memset of barrier words failed\n"); return; }
    hipError_t e = hipLaunchCooperativeKernel((const void*)mega_fwd, dim3(grid), dim3(512), args, LDS_BYTES, stream);
    if (e != hipSuccess) fprintf(stderr, "kernel_launch: cooperative launch failed: %s (grid %d)\n", hipGetErrorString(e), grid);
}
```

```cpp
#include <hip/hip_runtime.h>
#include <hip/hip_cooperative_groups.h>
#include <cstdio>
#include <cstdint>
namespace cg = cooperative_groups;
namespace pg8 {
#define PG8_LAS __attribute__((address_space(3)))
typedef unsigned short bf16_t;
typedef short bf16x8 __attribute__((ext_vector_type(8)));
typedef float f32x4 __attribute__((ext_vector_type(4)));
typedef unsigned u32x4 __attribute__((ext_vector_type(4)));
constexpr int BM = 256, BK = 64, HALF = 128, HTB = HALF * BK * 2  , STAGE_BYTES = 8 * HTB, NXCD = 8, WGM = 8;

__host__ __device__ __forceinline__ int lds_byte(int r, int c) { const int st = (r >> 4) * 2 + (c >> 5), rr = r & 15, cc = c & 31, ob = rr * 64 + cc * 2; return st * 1024 + (ob ^ (((ob >> 9) & 1) << 5)); }
__host__ __device__ __forceinline__ void stage_rc(int b, int& R, int& C) { const int st = b / 1024, sb = b % 1024, swz = sb ^ (((sb >> 9) & 1) << 5); R = (st >> 1) * 16 + swz / 64; C = (st & 1) * 32 + (swz % 64) / 2; }
__host__ __device__ __forceinline__ int perm32(int rho) { const int n = rho >> 4, i = rho & 15; return 8 * (i >> 2) + 4 * n + (i & 3); }

struct Unit { int pm, pn; };
struct Gemm { const bf16_t* A; const bf16_t* Bt; int M, N, K; };

struct StaticOrder {
    int nM, nN, nwg, G, c;
    __host__ __device__ void init(int M, int N, int G_, int c_) { nM = M / BM; nN = N / BM; nwg = nM * nN; G = G_; c = c_; }
    __host__ __device__ bool next(int i, Unit& u) const {
        const long L = (long)i * G + c; if (L >= nwg) return false;
        int wgid = (int)L; { const int q = nwg / NXCD, r = nwg % NXCD, xcd = wgid % NXCD, off = wgid / NXCD; wgid = (xcd < r ? xcd * (q + 1) : r * (q + 1) + (xcd - r) * q) + off; }
        const int nig = WGM * nN, gid = wgid / nig, fm = gid * WGM, gsz = (nM - fm) < WGM ? (nM - fm) : WGM;
        u.pm = fm + ((wgid % nig) % gsz); u.pn = (wgid % nig) / gsz; return true;
    }
    __device__ __forceinline__ void a_ready(const Unit&) const {}
    __device__ __forceinline__ void done(const Unit&) const {}
};

__device__ __forceinline__ unsigned cvt_pk_bf16(float lo, float hi) { unsigned r; asm volatile("v_cvt_pk_bf16_f32 %0, %1, %2" : "=v"(r) : "v"(lo), "v"(hi)); return r; }
typedef float f32x2 __attribute__((ext_vector_type(2)));
__device__ __forceinline__ f32x2 gelu_pk(f32x2 v) {
    const f32x2 av = __builtin_elementwise_abs(v), d = av * 0.2316418882f + 1.0f;
    f32x2 t; t.x = __builtin_amdgcn_rcpf(d.x); t.y = __builtin_amdgcn_rcpf(d.y);
    f32x2 q = t * 0.5307027145f + (-0.7265760135f); q = q * t + 0.7107068705f; q = q * t + (-0.142248368f); q = q * t + 0.127414796f; q = q * t;
    const f32x2 s = (v * v) * (-0.72134752044f);
    f32x2 e; e.x = __builtin_amdgcn_exp2f(s.x); e.y = __builtin_amdgcn_exp2f(s.y);
    const f32x2 m = v * (q * e), r = v - m;
    f32x2 o; o.x = v.x < 0.f ? m.x : r.x; o.y = v.y < 0.f ? m.y : r.y; return o;
}

template <class Epi, class Sched, bool ALIGN_EPI = false, bool SP2 = false>
__device__ __forceinline__ void gemm_phase(PG8_LAS unsigned char* lds, const Gemm g, const Sched& S, const Epi& E, const int tid_in) {
    const int tid = tid_in, wid = __builtin_amdgcn_readfirstlane(tid >> 6), lane = tid & 63, wr = wid >> 2, wc = wid & 3, fr = lane & 15, fq = lane >> 4;
    const int K = g.K, nt = K / BK;
    unsigned voffA[2], voffB[2];
#pragma unroll
    for (int i = 0; i < 2; ++i) { int R, C; stage_rc(tid * 16 + i * 8192, R, C); const int Rb = Epi::PERM ? ((R & ~31) + perm32(R & 31)) : R;
        voffA[i] = (unsigned)(R * K + C) * 2u; voffB[i] = (unsigned)(Rb * K + C) * 2u; }
    const size_t kstep = (size_t)(BK * 2);
    const size_t hstep = (size_t)HALF * K * 2;
    const size_t tstep = 2 * hstep;
    const unsigned ldsw = (unsigned)wid * 1024u;
    const int aoff = lds_byte(wr * 64 + fr, fq * 8), boff = lds_byte(wc * 32 + fr, fq * 8);
#define PG8_SA(b, h) (((b) * 2 + (h)) * HTB)
#define PG8_SB(b, h) ((4 + (b) * 2 + (h)) * HTB)
#define PG8_STAGE(bufoff, gbase, voff) do { _Pragma("unroll") for (int _i = 0; _i < 2; ++_i) \
        __builtin_amdgcn_global_load_lds((const unsigned*)((const char*)(gbase) + (voff)[_i]), (PG8_LAS unsigned*)(lds + (bufoff) + ldsw + _i * 8192), 16, 0, 0); } while (0)
#define PG8_LDA(dst, b, h) do { _Pragma("unroll") for (int m = 0; m < 4; ++m) _Pragma("unroll") for (int k = 0; k < 2; ++k) dst[m][k] = *(const PG8_LAS bf16x8*)(lds + PG8_SA(b, h) + aoff + m * 2048 + k * 1024); } while (0)
#define PG8_LDB(dst, b, h) do { _Pragma("unroll") for (int n = 0; n < 2; ++n) _Pragma("unroll") for (int k = 0; k < 2; ++k) dst[n][k] = *(const PG8_LAS bf16x8*)(lds + PG8_SB(b, h) + boff + n * 2048 + k * 1024); } while (0)
#define PG8_MMA(ai, bj, At, Bt) do { __builtin_amdgcn_s_setprio(1); _Pragma("unroll") for (int m = 0; m < 4; ++m) _Pragma("unroll") for (int n = 0; n < 2; ++n) _Pragma("unroll") for (int k = 0; k < 2; ++k) \
        acc[ai][bj][m][n] = __builtin_amdgcn_mfma_f32_16x16x32_bf16(Bt[n][k], At[m][k], acc[ai][bj][m][n], 0, 0, 0); __builtin_amdgcn_s_setprio(0); } while (0)
#define PG8_WAIT_V(n) asm volatile("s_waitcnt vmcnt(" #n ")" ::: "memory")
#define PG8_WAIT_L(n) asm volatile("s_waitcnt lgkmcnt(" #n ")" ::: "memory")
#define PG8_BAR __builtin_amdgcn_s_barrier()
#define PG8_SCHED __builtin_amdgcn_sched_barrier(0)
    Unit cur, nxt; int ui = 0;
    if (!S.next(0, cur)) return;
    f32x4 acc[2][2][4][2];
#pragma unroll
    for (int a = 0; a < 2; ++a)
#pragma unroll
        for (int b = 0; b < 2; ++b)
#pragma unroll
            for (int m = 0; m < 4; ++m)
#pragma unroll
                for (int n = 0; n < 2; ++n) acc[a][b][m][n] = (f32x4){0.f, 0.f, 0.f, 0.f};
    bf16x8 At[4][2], B0[2][2], B1[2][2];
    const char* cA = (const char*)g.A + (size_t)cur.pm * tstep; const char* cB = (const char*)g.Bt + (size_t)cur.pn * tstep;
    S.a_ready(cur);
    if constexpr (SP2) {
        PG8_STAGE(PG8_SB(0, 0), cB, voffB); PG8_STAGE(PG8_SB(0, 1), cB + hstep, voffB); PG8_STAGE(PG8_SA(0, 0), cA, voffA); PG8_STAGE(PG8_SA(0, 1), cA + hstep, voffA);
        if (wr == 1) PG8_BAR;
        PG8_WAIT_V(2); PG8_BAR;
        PG8_STAGE(PG8_SB(1, 0), cB + kstep, voffB); PG8_STAGE(PG8_SA(1, 0), cA + kstep, voffA); PG8_STAGE(PG8_SB(1, 1), cB + hstep + kstep, voffB);
        PG8_WAIT_V(6); PG8_BAR;
    } else {
        PG8_STAGE(PG8_SB(0, 0), cB, voffB); PG8_STAGE(PG8_SA(0, 0), cA, voffA); PG8_STAGE(PG8_SB(0, 1), cB + hstep, voffB); PG8_STAGE(PG8_SA(0, 1), cA + hstep, voffA);
        if (wr == 1) PG8_BAR;
        PG8_WAIT_V(4); PG8_BAR;
        PG8_STAGE(PG8_SB(1, 0), cB + kstep, voffB); PG8_STAGE(PG8_SA(1, 0), cA + kstep, voffA); PG8_STAGE(PG8_SB(1, 1), cB + hstep + kstep, voffB);
        PG8_WAIT_V(6); PG8_BAR;
    }
    for (;;) {
        const bool has_next = S.next(ui + 1, nxt);
        const char* nA = has_next ? (const char*)g.A + (size_t)nxt.pm * tstep : cA; const char* nB = has_next ? (const char*)g.Bt + (size_t)nxt.pn * tstep : cB;
        for (int t = 0; t < nt; t += 2) {
            const bool last = (t == nt - 2);
            const char* a1 = cA + (size_t)(t + 1) * kstep;
            const char* a2 = last ? nA : cA + (size_t)(t + 2) * kstep; const char* b2 = last ? nB : cB + (size_t)(t + 2) * kstep;
            const char* a3 = a2 + kstep; const char* b3 = b2 + kstep;
            if (last && has_next) S.a_ready(nxt);
            if constexpr (SP2) {
            PG8_LDB(B0, 0, 0); PG8_LDB(B1, 0, 1); PG8_SCHED; PG8_LDA(At, 0, 0); PG8_STAGE(PG8_SA(1, 1), a1 + hstep, voffA);
            PG8_WAIT_V(8); PG8_WAIT_L(0); PG8_BAR; PG8_MMA(0, 0, At, B0); PG8_MMA(0, 1, At, B1); PG8_BAR; PG8_SCHED;
            PG8_LDA(At, 0, 1); PG8_STAGE(PG8_SB(0, 0), b2, voffB); PG8_STAGE(PG8_SB(0, 1), b2 + hstep, voffB); PG8_STAGE(PG8_SA(0, 0), a2, voffA);
            PG8_WAIT_V(8); PG8_WAIT_L(0); PG8_BAR; PG8_MMA(1, 0, At, B0); PG8_MMA(1, 1, At, B1); PG8_BAR; PG8_SCHED;
            PG8_LDB(B0, 1, 0); PG8_LDB(B1, 1, 1); PG8_SCHED; PG8_LDA(At, 1, 0); PG8_STAGE(PG8_SA(0, 1), a2 + hstep, voffA);
            PG8_WAIT_V(8); PG8_WAIT_L(0); PG8_BAR; PG8_MMA(0, 0, At, B0); PG8_MMA(0, 1, At, B1); PG8_BAR; PG8_SCHED;
            PG8_LDA(At, 1, 1); PG8_STAGE(PG8_SB(1, 0), b3, voffB); PG8_STAGE(PG8_SB(1, 1), b3 + hstep, voffB); PG8_STAGE(PG8_SA(1, 0), a3, voffA);
            PG8_WAIT_V(8); PG8_WAIT_L(0); PG8_BAR; PG8_MMA(1, 0, At, B0); PG8_MMA(1, 1, At, B1); PG8_BAR; PG8_SCHED;
            } else {
            PG8_LDB(B0, 0, 0); PG8_SCHED; PG8_LDA(At, 0, 0); PG8_STAGE(PG8_SA(1, 1), a1 + hstep, voffA);
            PG8_WAIT_L(8); PG8_BAR; PG8_WAIT_L(0); PG8_MMA(0, 0, At, B0); PG8_BAR; PG8_SCHED;
            PG8_LDB(B1, 0, 1); PG8_STAGE(PG8_SB(0, 0), b2, voffB);
            PG8_BAR; PG8_WAIT_L(0); PG8_MMA(0, 1, At, B1); PG8_BAR;
            PG8_LDA(At, 0, 1); PG8_STAGE(PG8_SA(0, 0), a2, voffA);
            PG8_BAR; PG8_WAIT_L(0); PG8_MMA(1, 0, At, B0); PG8_BAR; PG8_SCHED;
            PG8_STAGE(PG8_SB(0, 1), b2 + hstep, voffB);
            PG8_WAIT_V(6); PG8_BAR; PG8_MMA(1, 1, At, B1); PG8_BAR;
            PG8_LDB(B0, 1, 0); PG8_SCHED; PG8_LDA(At, 1, 0); PG8_STAGE(PG8_SA(0, 1), a2 + hstep, voffA);
            PG8_WAIT_L(8); PG8_BAR; PG8_WAIT_L(0); PG8_MMA(0, 0, At, B0); PG8_BAR; PG8_SCHED;
            PG8_LDB(B1, 1, 1); PG8_STAGE(PG8_SB(1, 0), b3, voffB);
            PG8_BAR; PG8_WAIT_L(0); PG8_MMA(0, 1, At, B1); PG8_BAR;
            PG8_LDA(At, 1, 1); PG8_STAGE(PG8_SA(1, 0), a3, voffA);
            PG8_BAR; PG8_WAIT_L(0); PG8_MMA(1, 0, At, B0); PG8_BAR; PG8_SCHED;
            PG8_STAGE(PG8_SB(1, 1), b3 + hstep, voffB);
            PG8_WAIT_V(6); PG8_BAR; PG8_MMA(1, 1, At, B1); PG8_BAR;
            }
        }
        if constexpr (ALIGN_EPI) { if (wr == 0) PG8_BAR; }
        if constexpr (!Epi::AFTER_DRAIN) { E(acc, cur, wr, wc, fr, fq); S.done(cur); }
        if (!has_next) break;
#pragma unroll
        for (int a = 0; a < 2; ++a)
#pragma unroll
            for (int b = 0; b < 2; ++b)
#pragma unroll
                for (int m = 0; m < 4; ++m)
#pragma unroll
                    for (int n = 0; n < 2; ++n) acc[a][b][m][n] = (f32x4){0.f, 0.f, 0.f, 0.f};
        cur = nxt; cA = nA; cB = nB; ++ui;
        if constexpr (ALIGN_EPI) { if (wr == 1) PG8_BAR; }
    }
    PG8_WAIT_V(0);
    if constexpr (!ALIGN_EPI) { if (wr == 0) PG8_BAR; }
    PG8_BAR;
    if constexpr (Epi::AFTER_DRAIN) { E.fused(acc, cur, wr, wc, fr, fq, lds, wid, lane); S.done(cur); }
#undef PG8_SA
#undef PG8_SB
#undef PG8_STAGE
#undef PG8_LDA
#undef PG8_LDB
#undef PG8_MMA
#undef PG8_WAIT_V
#undef PG8_WAIT_L
#undef PG8_BAR
#undef PG8_SCHED
}
}

#define LAS __attribute__((address_space(3)))
typedef unsigned short bf16_t;
typedef float f32x2 __attribute__((ext_vector_type(2)));
typedef float f32x4 __attribute__((ext_vector_type(4)));
typedef float f32x16 __attribute__((ext_vector_type(16)));
typedef short bf16x8 __attribute__((ext_vector_type(8)));
typedef short s16x4 __attribute__((ext_vector_type(4)));
typedef unsigned u32x4 __attribute__((ext_vector_type(4)));
typedef unsigned u32x2 __attribute__((ext_vector_type(2)));
typedef __bf16 bf16x2v __attribute__((ext_vector_type(2)));
#define MFMA32(a, b, c) __builtin_amdgcn_mfma_f32_32x32x16_bf16((a), (b), (c), 0, 0, 0)

constexpr int D = 1024, NB = 8, TL = 2048, TCX = 256, DEPTH = 4;
constexpr int ML = NB * TL, MC = NB * TCX, M = ML + MC;
constexpr int PPAD = 11776, RWP = 3584, DFF = 2816;
constexpr int NPH = 11, NPHASES = 1 + DEPTH * NPH;
constexpr size_t MiB = 1u << 20;
constexpr size_t WS_MOD = 0, WS_WIN = 1 * MiB, WS_WA = 24 * MiB, WS_WB = 26 * MiB, WS_WC = 28 * MiB, WS_WO = 30 * MiB, WS_WI = 32 * MiB, WS_WO2 = 43 * MiB,
                 WS_LWT = 48 * MiB + MiB / 2, WS_LAT = 49 * MiB, WS_LGT = 49 * MiB + MiB / 2, WS_H = 50 * MiB, WS_XC = 86 * MiB, WS_GU = 94 * MiB, WS_GV = 130 * MiB,
                 WS_Q = 166 * MiB, WS_K = 202 * MiB, WS_V = 238 * MiB, WS_RW = 274 * MiB, WS_GT = 400 * MiB, WS_LIW = 508 * MiB, WS_LIA = 512 * MiB + MiB / 2,
                 WS_LIG = 517 * MiB, WS_DEC1 = 526 * MiB, WS_AA0 = 562 * MiB, WS_AA1 = 598 * MiB, WS_G = 634 * MiB, WS_Y1 = 670 * MiB, WS_ROPE = 706 * MiB, WS_END = 707 * MiB;
constexpr int LDS_BYTES = 131072 + 1024;
constexpr size_t WS_BAR = 917504, BAR_BYTES = 16384;
constexpr float QSCALE = 0.125f * 1.4426950408889634f;

struct Args { const float* in[33]; float* out; unsigned char* ws; int lo, hi; };
typedef const __attribute__((address_space(4))) Args CArgs;
struct TI { int tid, bid, nblk; };

__device__ __forceinline__ float bf2f(unsigned v) { return __uint_as_float(v << 16); }
__device__ __forceinline__ unsigned pkbf(float lo, float hi) { f32x2 v = {lo, hi}; bf16x2v b = __builtin_convertvector(v, bf16x2v); return __builtin_bit_cast(unsigned, b); }
__device__ __forceinline__ bf16_t f2bf(float f) { return (bf16_t)(pkbf(f, 0.f) & 0xffffu); }
#define DPP_ADD(x, ctrl) ((x) + __builtin_bit_cast(float, __builtin_amdgcn_update_dpp(0, __builtin_bit_cast(int, (x)), (ctrl), 0xf, 0xf, true)))
__device__ __forceinline__ float wave_sum(float v) {
    v = DPP_ADD(v, 0xB1); v = DPP_ADD(v, 0x4E); v = DPP_ADD(v, 0x141); v = DPP_ADD(v, 0x140);
    const int iv = __builtin_bit_cast(int, v);
    const float s0 = __builtin_bit_cast(float, __builtin_amdgcn_readlane(iv, 0)), s1 = __builtin_bit_cast(float, __builtin_amdgcn_readlane(iv, 16)),
                s2 = __builtin_bit_cast(float, __builtin_amdgcn_readlane(iv, 32)), s3 = __builtin_bit_cast(float, __builtin_amdgcn_readlane(iv, 48));
    return (s0 + s1) + (s2 + s3);
}
__device__ __forceinline__ float dpp_sum8(float x) {
    x += __builtin_bit_cast(float, __builtin_amdgcn_update_dpp(0, __builtin_bit_cast(int, x), 0xB1, 0xf, 0xf, true));
    x += __builtin_bit_cast(float, __builtin_amdgcn_update_dpp(0, __builtin_bit_cast(int, x), 0x4E, 0xf, 0xf, true));
    x += __builtin_bit_cast(float, __builtin_amdgcn_update_dpp(0, __builtin_bit_cast(int, x), 0x141, 0xf, 0xf, true));
    return x;
}
__device__ __forceinline__ float quad_sum(float x) { x = DPP_ADD(x, 0xB1); x = DPP_ADD(x, 0x4E); return x; }
__device__ __forceinline__ float quad_xor2(float x) { return __builtin_bit_cast(float, __builtin_amdgcn_update_dpp(0, __builtin_bit_cast(int, x), 0x4E, 0xf, 0xf, true)); }
__device__ __forceinline__ void unpack16(const bf16_t* p, float (&x)[16]) {
    const u32x4 a = *(const u32x4*)p, b = *(const u32x4*)(p + 8);
#pragma unroll
    for (int i = 0; i < 4; ++i) { x[2 * i] = bf2f(a[i] & 0xffffu); x[2 * i + 1] = bf2f(a[i] >> 16); x[8 + 2 * i] = bf2f(b[i] & 0xffffu); x[8 + 2 * i + 1] = bf2f(b[i] >> 16); }
}
__device__ __forceinline__ void pack16(bf16_t* p, const float (&x)[16]) {
    u32x4 a, b;
#pragma unroll
    for (int i = 0; i < 4; ++i) { a[i] = pkbf(x[2 * i], x[2 * i + 1]); b[i] = pkbf(x[8 + 2 * i], x[8 + 2 * i + 1]); }
    *(u32x4*)p = a; *(u32x4*)(p + 8) = b;
}
__device__ __forceinline__ void load16f(const float* p, float (&x)[16]) {
#pragma unroll
    for (int i = 0; i < 4; ++i) { const f32x4 v = *(const f32x4*)(p + 4 * i); x[4 * i] = v.x; x[4 * i + 1] = v.y; x[4 * i + 2] = v.z; x[4 * i + 3] = v.w; }
}
__device__ __forceinline__ float sigmoidf_(float x) { return 1.f / (1.f + __expf(-x)); }

template <class Op> struct EpiT {
    static constexpr bool PERM = true, AFTER_DRAIN = false;
    Op op;
    __device__ __forceinline__ void operator()(const pg8::f32x4 (&acc)[2][2][4][2], const pg8::Unit& u, int wr, int wc, int fr, int fq) const {
        const int row0 = u.pm * 256 + wr * 64 + fr, col0 = u.pn * 256 + wc * 32 + 8 * fq;
#pragma unroll
        for (int ai = 0; ai < 2; ++ai)
#pragma unroll
            for (int m = 0; m < 4; ++m)
#pragma unroll
                for (int bj = 0; bj < 2; ++bj) { op(row0 + ai * 128 + m * 16, col0 + bj * 128, acc[ai][bj][m][0], acc[ai][bj][m][1]); asm volatile("" ::: "memory"); }
    }
};
__device__ __forceinline__ u32x4 pack8(f32x4 v0, f32x4 v1) { u32x4 o; o.x = pkbf(v0.x, v0.y); o.y = pkbf(v0.z, v0.w); o.z = pkbf(v1.x, v1.y); o.w = pkbf(v1.z, v1.w); return o; }
__device__ __forceinline__ void unpack8(u32x4 x, f32x4& v0, f32x4& v1) {
    v0.x = bf2f(x.x & 0xffffu); v0.y = bf2f(x.x >> 16); v0.z = bf2f(x.y & 0xffffu); v0.w = bf2f(x.y >> 16);
    v1.x = bf2f(x.z & 0xffffu); v1.y = bf2f(x.z >> 16); v1.z = bf2f(x.w & 0xffffu); v1.w = bf2f(x.w >> 16);
}
__device__ __forceinline__ f32x4 gelu4(f32x4 v) { pg8::f32x2 a = pg8::gelu_pk((pg8::f32x2){v.x, v.y}), b = pg8::gelu_pk((pg8::f32x2){v.z, v.w}); return (f32x4){a.x, a.y, b.x, b.y}; }
__device__ __forceinline__ f32x4 sig4(f32x4 v) { return (f32x4){sigmoidf_(v.x), sigmoidf_(v.y), sigmoidf_(v.z), sigmoidf_(v.w)}; }

struct OpIn {
    bf16_t *GU, *GV, *Q, *RW, *GT;
    __device__ __forceinline__ void operator()(int row, int col, f32x4 v0, f32x4 v1) const {
        bf16_t* dst;
        if (col < 2048) { v0 = gelu4(v0); v1 = gelu4(v1); dst = (col < 1024 ? GU : GV) + (size_t)row * 1024 + (col & 1023); }
        else if (col < 5120) { const int q = col - 2048; dst = Q + (size_t)(q >> 10) * (size_t)(18 * MiB) + (size_t)row * 1024 + (q & 1023); }
        else if (col < 8704) { dst = RW + (size_t)row * RWP + (col - 5120); }
        else { v0 = sig4(v0); v1 = sig4(v1); dst = GT + (size_t)row * 3072 + (col - 8704); }
        *(u32x4*)dst = pack8(v0, v1);
    }
};
struct OpDec {
    bf16_t *D0, *D1; const float* w0;
    __device__ __forceinline__ float f(float x) const { const float y = -x; const float sp = y > 20.f ? y : __logf(1.f + __expf(y)); return -__expf(-sp - 0.5f); }
    __device__ __forceinline__ void operator()(int row, int col, f32x4 v0, f32x4 v1) const {
        const f32x4 b0 = *(const f32x4*)(w0 + col), b1 = *(const f32x4*)(w0 + col + 4);
        v0 += b0; v1 += b1;
        v0 = (f32x4){f(v0.x), f(v0.y), f(v0.z), f(v0.w)}; v1 = (f32x4){f(v1.x), f(v1.y), f(v1.z), f(v1.w)};
        bf16_t* dst = (col < 1024 ? D0 : D1) + (size_t)row * 1024 + (col & 1023);
        *(u32x4*)dst = pack8(v0, v1);
    }
};
struct OpAA {
    bf16_t *A0, *A1; const float* a0;
    __device__ __forceinline__ void operator()(int row, int col, f32x4 v0, f32x4 v1) const {
        const f32x4 b0 = *(const f32x4*)(a0 + col), b1 = *(const f32x4*)(a0 + col + 4);
        v0 = sig4(v0 + b0); v1 = sig4(v1 + b1);
        bf16_t* dst = (col < 1024 ? A0 : A1) + (size_t)row * 1024 + (col & 1023);
        *(u32x4*)dst = pack8(v0, v1);
    }
};
struct OpG {
    bf16_t* G;
    __device__ __forceinline__ void operator()(int row, int col, f32x4 v0, f32x4 v1) const { *(u32x4*)(G + (size_t)row * 1024 + col) = pack8(v0, v1); }
};
template <int KB> struct OpMerge {
    const bf16_t* GT; float* MF; bf16_t* MB;
    __device__ __forceinline__ void operator()(int row, int col, f32x4 v0, f32x4 v1) const {
        f32x4 g0, g1; unpack8(*(const u32x4*)(GT + (size_t)row * 3072 + KB * 1024 + col), g0, g1);
        float* mf = MF + (size_t)row * 1024 + col;
        f32x4 r0 = g0 * v0, r1 = g1 * v1;
        if (KB > 0) { r0 += *(const f32x4*)mf; r1 += *(const f32x4*)(mf + 4); }
        if (KB < 2) { *(f32x4*)mf = r0; *(f32x4*)(mf + 4) = r1; }
        else *(u32x4*)(MB + (size_t)row * 1024 + col) = pack8(r0, r1);
    }
};
struct OpResid {
    const float *xl, *xc; float *ol, *oc; const float* mod; int gi;
    __device__ __forceinline__ void operator()(int row, int col, f32x4 v0, f32x4 v1) const {
        const float* xi; float* xo; const float* g;
        if (row < ML) { xi = xl + (size_t)row * 1024 + col; xo = ol + (size_t)row * 1024 + col; g = mod + (size_t)(row >> 11) * 6144 + gi * 1024 + col; }
        else { const size_t rr = (size_t)(row - ML) * 1024 + col; xi = xc + rr; xo = oc + rr; g = mod + (size_t)8 * 6144 + gi * 1024 + col; }
        const f32x4 x0 = *(const f32x4*)xi, x1 = *(const f32x4*)(xi + 4), g0 = *(const f32x4*)g, g1 = *(const f32x4*)(g + 4);
        *(f32x4*)xo = x0 + g0 * v0; *(f32x4*)(xo + 4) = x1 + g1 * v1;
    }
};
struct OpSwiglu {
    bf16_t* HID;
    __device__ __forceinline__ void operator()(int row, int col, f32x4 v0, f32x4 v1) const {
        const float h0 = v0.x * sigmoidf_(v0.x) * v0.y, h1 = v0.z * sigmoidf_(v0.z) * v0.w, h2 = v1.x * sigmoidf_(v1.x) * v1.y, h3 = v1.z * sigmoidf_(v1.z) * v1.w;
        u32x2 o; o.x = pkbf(h0, h1); o.y = pkbf(h2, h3);
        *(u32x2*)(HID + (size_t)row * DFF + (col >> 1)) = o;
    }
};
template <class Op> __device__ __forceinline__ void run_gemm(const TI ti, unsigned char* lds, const bf16_t* A, const bf16_t* Bt, int Mr, int N, int K, const Op& op) {
    int Kv = K; asm volatile("" : "+s"(Kv));
    pg8::Gemm g{A, Bt, Mr, N, Kv}; pg8::StaticOrder S; S.init(Mr, N, ti.nblk, ti.bid);
    EpiT<Op> E{op};
    pg8::gemm_phase<EpiT<Op>, pg8::StaticOrder, true, true>((PG8_LAS unsigned char*)lds, g, S, E, ti.tid);
}

__device__ __forceinline__ void ph_mods(const TI ti, CArgs& a, unsigned char* ldsg) {
    float* sc = (float*)ldsg; float* part = sc + 9 * 1024;
    const int tid = ti.tid, lane = tid & 63, w = tid >> 6;
    for (int i = tid; i < 9 * 1024; i += 512) { const float v = (i < 8192) ? a.in[1][i] : a.in[3][i - 8192]; sc[i] = v / (1.f + expf(-v)); }
    __syncthreads();
    float* MOD = (float*)(a.ws + WS_MOD);
    for (int item = ti.bid; item < DEPTH * 96; item += ti.nblk) {
        const int l = item / 96, n0 = (item % 96) * 64;
        const float* W = a.in[4] + (size_t)l * 1024 * 6144 + n0 + lane;
        float acc[9];
#pragma unroll
        for (int r = 0; r < 9; ++r) acc[r] = 0.f;
#pragma unroll 8
        for (int k = w * 128; k < w * 128 + 128; ++k) {
            const float wv = W[(size_t)k * 6144];
#pragma unroll
            for (int r = 0; r < 9; ++r) acc[r] += sc[r * 1024 + k] * wv;
        }
#pragma unroll
        for (int r = 0; r < 9; ++r) part[(w * 9 + r) * 64 + lane] = acc[r];
        __syncthreads();
        for (int idx = tid; idx < 576; idx += 512) {
            const int r = idx >> 6, ln = idx & 63; float s = a.in[5][l * 6144 + n0 + ln];
            for (int ww = 0; ww < 8; ++ww) s += part[(ww * 9 + r) * 64 + ln];
            MOD[((size_t)l * 9 + r) * 6144 + n0 + ln] = s;
        }
        __syncthreads();
    }
    float* RC = (float*)(a.ws + WS_ROPE); float* RS = RC + 2048 * 32;
    for (int idx = ti.bid * 512 + tid; idx < 2048 * 32; idx += ti.nblk * 512) {
        const int t = idx >> 5, i = idx & 31; const float pos = i < 16 ? (float)(t >> 6) : (float)(t & 63);
        const float ang = pos * exp2f(-(float)(i & 15) * (13.287712379549449f / 16.f));
        RC[idx] = cosf(ang); RS[idx] = sinf(ang);
    }
}

__device__ __forceinline__ void norm_rows(const float* xl, const float* xc, const float* g, const float* modl, int shi, int sci, bf16_t* H, int nrows, int gw, int ngw, int lane) {
    for (int row = gw; row < nrows; row += ngw) {
        const float* src; int r;
        if (row < ML) { src = xl + (size_t)row * D; r = row >> 11; } else { src = xc + (size_t)(row - ML) * D; r = 8; }
        const float* md = modl + (size_t)r * 6144;
        f32x4 v[4]; float ss = 0.f;
#pragma unroll
        for (int j = 0; j < 4; ++j) { v[j] = *(const f32x4*)(src + 4 * lane + 256 * j); ss += (v[j].x * v[j].x + v[j].y * v[j].y) + (v[j].z * v[j].z + v[j].w * v[j].w); }
        ss = wave_sum(ss);
        const float rstd = rsqrtf(ss * (1.f / 1024.f) + 1e-6f);
#pragma unroll
        for (int j = 0; j < 4; ++j) {
            const int c = 4 * lane + 256 * j;
            const f32x4 gg = *(const f32x4*)(g + c), scv = *(const f32x4*)(md + sci * 1024 + c), shv = *(const f32x4*)(md + shi * 1024 + c);
            const f32x4 o = v[j] * rstd * gg * (1.f + scv) + shv;
            u32x2 p; p.x = pkbf(o.x, o.y); p.y = pkbf(o.z, o.w);
            *(u32x2*)(H + (size_t)row * D + c) = p;
        }
    }
}

template <int MODE> __device__ __forceinline__ void transpose_item(const float* W, int K, int N, bf16_t* WT, LAS float* scr, int item, int lane) {
    const int nblk = N / 32, kb = item / nblk, nb = item % nblk, k0 = 64 * kb, n0 = 32 * nb;
#pragma unroll 8
    for (int i = 0; i < 32; ++i) { const int kk = 2 * i + (lane >> 5); scr[kk * 33 + (lane & 31)] = W[(size_t)(k0 + kk) * N + n0 + (lane & 31)]; }
    asm volatile("s_waitcnt lgkmcnt(0)" ::: "memory");
    const int c = lane & 7;
#pragma unroll
    for (int j = 0; j < 4; ++j) {
        const int n = (lane >> 3) + 8 * j, gn = n0 + n; const LAS float* s = scr + (8 * c) * 33 + n;
        const int drow = MODE == 0 ? gn : (MODE == 1 ? (gn >= 8608 ? gn + 96 : gn) : (gn < DFF ? 2 * gn : 2 * (gn - DFF) + 1));
        u32x4 o; o.x = pkbf(s[0 * 33], s[1 * 33]); o.y = pkbf(s[2 * 33], s[3 * 33]); o.z = pkbf(s[4 * 33], s[5 * 33]); o.w = pkbf(s[6 * 33], s[7 * 33]);
        *(u32x4*)(WT + (size_t)drow * K + k0 + 8 * c) = o;
    }
    asm volatile("s_waitcnt lgkmcnt(0)" ::: "memory");
}
__device__ __forceinline__ void ph_wconv(CArgs& a, int l, unsigned char* ldsg, int gw, int ngw, int lane, int wv) {
    LAS float* scr = (LAS float*)(ldsg + wv * 8704);
    unsigned char* ws = a.ws;
    constexpr int I_IN = 16 * 365, I_SQ = 16 * 32, I_WI = 16 * 176, I_WO = 44 * 32, NIT = I_IN + 4 * I_SQ + I_WI + I_WO;
    for (int it = gw; it < NIT; it += ngw) {
        int r = it;
        if (r < I_IN) { transpose_item<1>(a.in[8] + (size_t)l * 1024 * 11680, 1024, 11680, (bf16_t*)(ws + WS_WIN), scr, r, lane); continue; } r -= I_IN;
        if (r < I_SQ) { transpose_item<0>(a.in[27] + (size_t)l * 1048576, 1024, 1024, (bf16_t*)(ws + WS_WA), scr, r, lane); continue; } r -= I_SQ;
        if (r < I_SQ) { transpose_item<0>(a.in[28] + (size_t)l * 1048576, 1024, 1024, (bf16_t*)(ws + WS_WB), scr, r, lane); continue; } r -= I_SQ;
        if (r < I_SQ) { transpose_item<0>(a.in[29] + (size_t)l * 1048576, 1024, 1024, (bf16_t*)(ws + WS_WC), scr, r, lane); continue; } r -= I_SQ;
        if (r < I_SQ) { transpose_item<0>(a.in[30] + (size_t)l * 1048576, 1024, 1024, (bf16_t*)(ws + WS_WO), scr, r, lane); continue; } r -= I_SQ;
        if (r < I_WI) { transpose_item<2>(a.in[31] + (size_t)l * 1024 * 5632, 1024, 5632, (bf16_t*)(ws + WS_WI), scr, r, lane); continue; } r -= I_WI;
        transpose_item<0>(a.in[32] + (size_t)l * DFF * 1024, DFF, 1024, (bf16_t*)(ws + WS_WO2), scr, r, lane);
    }
    const int gt = gw * 64 + lane, ngt = ngw * 64;
    bf16_t* LWT = (bf16_t*)(ws + WS_LWT); bf16_t* LAT = (bf16_t*)(ws + WS_LAT); bf16_t* LGT = (bf16_t*)(ws + WS_LGT);
    const float* w2 = a.in[18] + (size_t)l * 2 * 64 * 1024; const float* a2 = a.in[20] + (size_t)l * 2 * 64 * 1024; const float* g2 = a.in[21] + (size_t)l * 160 * 1024;
    for (int i = gt; i < 2048 * 128; i += ngt) {
        const int n = i >> 7, k = i & 127, d = n >> 10, c = n & 1023, kk = k - d * 64;
        const bool in = (kk >= 0 && kk < 64);
        LWT[i] = in ? f2bf(w2[((size_t)d * 64 + kk) * 1024 + c]) : (bf16_t)0;
        LAT[i] = in ? f2bf(a2[((size_t)d * 64 + kk) * 1024 + c]) : (bf16_t)0;
    }
    for (int i = gt; i < 1024 * 256; i += ngt) { const int n = i >> 8, k = i & 255; LGT[i] = k < 160 ? f2bf(g2[(size_t)k * 1024 + n]) : (bf16_t)0; }
    bf16_t* WIN = (bf16_t*)(ws + WS_WIN);
    for (int i = gt; i < 96 * 1024; i += ngt) WIN[(size_t)8608 * 1024 + i] = 0;
}

__device__ __forceinline__ void gmlp_unit(const TI ti, CArgs& a, int l, int u, unsigned char* ldsg) {
    float* rstd = (float*)ldsg; bf16_t* VNT = (bf16_t*)(ldsg + 512);
    const int tid = ti.tid, lane = tid & 63, w = tid >> 6, r = lane & 31, h = lane >> 5;
    bf16_t* GU = (bf16_t*)(a.ws + WS_GU); const bf16_t* GV = (const bf16_t*)(a.ws + WS_GV);
    const size_t R0 = (size_t)u * 128;
#pragma unroll 4
    for (int i = 0; i < 16; ++i) {
        const int tok = w * 16 + i; const bf16_t* p = GV + (R0 + tok) * 1024 + lane * 16;
        f32x4 x0, x1, x2, x3; unpack8(*(const u32x4*)p, x0, x1); unpack8(*(const u32x4*)(p + 8), x2, x3);
        float ss = (x0.x * x0.x + x0.y * x0.y + x0.z * x0.z + x0.w * x0.w) + (x1.x * x1.x + x1.y * x1.y + x1.z * x1.z + x1.w * x1.w)
                 + (x2.x * x2.x + x2.y * x2.y + x2.z * x2.z + x2.w * x2.w) + (x3.x * x3.x + x3.y * x3.y + x3.z * x3.z + x3.w * x3.w);
        ss = wave_sum(ss);
        if (lane == 0) rstd[tok] = rsqrtf(ss * (1.f / 1024.f) + 1e-6f);
    }
    __syncthreads();
    const float* gvg = a.in[9] + l * 1024; const float* wsp = a.in[10] + (size_t)l * 8 * 128 * 128; const float* bsp = a.in[11] + l * 8 * 128;
    const int tt = w & 3, chh = w >> 2;
    for (int g = 0; g < 8; ++g) {
        {
            const int s = tid & 127, cc = tid >> 7; const float rs = rstd[s]; const bf16_t* p = GV + (R0 + s) * 1024 + g * 128 + cc * 32;
#pragma unroll
            for (int q = 0; q < 4; ++q) {
                f32x4 x0, x1; unpack8(*(const u32x4*)(p + 8 * q), x0, x1);
                const float* gp = gvg + g * 128 + cc * 32 + 8 * q; const int c0 = cc * 32 + 8 * q;
                VNT[(c0 + 0) * 136 + s] = f2bf(x0.x * rs * gp[0]); VNT[(c0 + 1) * 136 + s] = f2bf(x0.y * rs * gp[1]);
                VNT[(c0 + 2) * 136 + s] = f2bf(x0.z * rs * gp[2]); VNT[(c0 + 3) * 136 + s] = f2bf(x0.w * rs * gp[3]);
                VNT[(c0 + 4) * 136 + s] = f2bf(x1.x * rs * gp[4]); VNT[(c0 + 5) * 136 + s] = f2bf(x1.y * rs * gp[5]);
                VNT[(c0 + 6) * 136 + s] = f2bf(x1.z * rs * gp[6]); VNT[(c0 + 7) * 136 + s] = f2bf(x1.w * rs * gp[7]);
            }
        }
        __syncthreads();
        f32x16 acc0, acc1;
#pragma unroll
        for (int i = 0; i < 16; ++i) { acc0[i] = 0.f; acc1[i] = 0.f; }
        const float* wrow = wsp + ((size_t)g * 128 + tt * 32 + r) * 128;
#pragma unroll
        for (int ks = 0; ks < 8; ++ks) {
            const f32x4 a0 = *(const f32x4*)(wrow + 16 * ks + 8 * h), a1 = *(const f32x4*)(wrow + 16 * ks + 8 * h + 4);
            const bf16x8 af = __builtin_bit_cast(bf16x8, pack8(a0, a1));
            const bf16x8 b0 = *(const bf16x8*)(VNT + (chh * 64 + r) * 136 + 16 * ks + 8 * h);
            const bf16x8 b1 = *(const bf16x8*)(VNT + (chh * 64 + 32 + r) * 136 + 16 * ks + 8 * h);
            acc0 = MFMA32(af, b0, acc0); acc1 = MFMA32(af, b1, acc1);
        }
        {
            const bf16_t* GUr = GU; float uu0[16], uu1[16], bb[16];
#pragma unroll
            for (int reg = 0; reg < 16; ++reg) {
                const int t = tt * 32 + (reg & 3) + 8 * (reg >> 2) + 4 * h; const size_t i0 = (R0 + t) * 1024 + g * 128 + chh * 64 + r;
                bb[reg] = bsp[g * 128 + t]; uu0[reg] = bf2f(GUr[i0]); uu1[reg] = bf2f(GUr[i0 + 32]);
            }
            asm volatile("" ::: "memory");
#pragma unroll
            for (int reg = 0; reg < 16; ++reg) {
                const int t = tt * 32 + (reg & 3) + 8 * (reg >> 2) + 4 * h; const size_t i0 = (R0 + t) * 1024 + g * 128 + chh * 64 + r;
                GU[i0] = f2bf(uu0[reg] * (acc0[reg] + bb[reg])); GU[i0 + 32] = f2bf(uu1[reg] * (acc1[reg] + bb[reg]));
            }
        }
        __syncthreads();
    }
}
__device__ __forceinline__ void qk_rows(CArgs& a, int l, int gw, int ngw, int lane) {
    bf16_t* Q = (bf16_t*)(a.ws + WS_Q); bf16_t* K = (bf16_t*)(a.ws + WS_K);
    const float* RC = (const float*)(a.ws + WS_ROPE); const float* RS = RC + 2048 * 32;
    const int part = lane & 3;
    float gq[16], gk[16];
    load16f(a.in[12] + l * 64 + 16 * part, gq); load16f(a.in[13] + l * 64 + 16 * part, gk);
    for (int row = gw; row < M; row += ngw) {
        float xq[16], xk[16], cs[16], sn[16];
        unpack16(Q + (size_t)row * 1024 + 16 * lane, xq); unpack16(K + (size_t)row * 1024 + 16 * lane, xk);
        const bool lat = row < ML;
        if (lat) { const int t = row & 2047; load16f(RC + t * 32 + 16 * (part & 1), cs); load16f(RS + t * 32 + 16 * (part & 1), sn); }
        float sq = 0.f, sk = 0.f;
#pragma unroll
        for (int j = 0; j < 16; ++j) { sq += xq[j] * xq[j]; sk += xk[j] * xk[j]; }
        const float rq = rsqrtf(quad_sum(sq) * (1.f / 64.f) + 1e-6f), rk = rsqrtf(quad_sum(sk) * (1.f / 64.f) + 1e-6f);
#pragma unroll
        for (int j = 0; j < 16; ++j) { xq[j] = xq[j] * rq * gq[j]; xk[j] = xk[j] * rk * gk[j]; }
        if (lat) {
            const float sgn = part < 2 ? -1.f : 1.f;
#pragma unroll
            for (int j = 0; j < 16; ++j) {
                const float pq = quad_xor2(xq[j]), pk = quad_xor2(xk[j]);
                xq[j] = xq[j] * cs[j] + sgn * pq * sn[j]; xk[j] = xk[j] * cs[j] + sgn * pk * sn[j];
            }
        }
#pragma unroll
        for (int j = 0; j < 16; ++j) xq[j] *= QSCALE;
        pack16(Q + (size_t)row * 1024 + 16 * lane, xq); pack16(K + (size_t)row * 1024 + 16 * lane, xk);
    }
}
__device__ __forceinline__ void lora_in_rows(CArgs& a, int l, int gw, int ngw, int lane) {
    const bf16_t* RW = (const bf16_t*)(a.ws + WS_RW); bf16_t* LW = (bf16_t*)(a.ws + WS_LIW); bf16_t* LA = (bf16_t*)(a.ws + WS_LIA); bf16_t* LG = (bf16_t*)(a.ws + WS_LIG);
    const float* mu = a.in[16] + l * 3488 + 3072;
    f32x4 m0 = {0.f, 0.f, 0.f, 0.f}, m1 = m0;
    if (lane < 52) { m0 = *(const f32x4*)(mu + 8 * lane); m1 = *(const f32x4*)(mu + 8 * lane + 4); }
    for (int row = gw; row < M; row += ngw) {
        int t, Tn; if (row < ML) { t = row & 2047; Tn = 2048; } else { t = (row - ML) & 255; Tn = 256; }
        const bool hp = t > 0, hn = t < Tn - 1;
        if (lane < 52) {
            const bf16_t* p = RW + (size_t)row * RWP + 3072 + 8 * lane;
            f32x4 x0, x1, p0 = {0.f, 0.f, 0.f, 0.f}, p1 = p0, n0 = p0, n1 = p0;
            unpack8(*(const u32x4*)p, x0, x1);
            if (hp) unpack8(*(const u32x4*)(p - RWP), p0, p1);
            if (hn) unpack8(*(const u32x4*)(p + RWP), n0, n1);
            f32x4 z0 = x0 + m0 * (0.5f * (p0 + n0) - x0), z1 = x1 + m1 * (0.5f * (p1 + n1) - x1);
            const int j = 8 * lane;
            if (j < 128) { z0 = (f32x4){tanhf(z0.x), tanhf(z0.y), tanhf(z0.z), tanhf(z0.w)}; z1 = (f32x4){tanhf(z1.x), tanhf(z1.y), tanhf(z1.z), tanhf(z1.w)}; *(u32x4*)(LW + (size_t)row * 128 + j) = pack8(z0, z1); }
            else if (j < 256) { *(u32x4*)(LA + (size_t)row * 128 + j - 128) = pack8(z0, z1); }
            else { *(u32x4*)(LG + (size_t)row * 256 + j - 256) = pack8(sig4(z0), sig4(z1)); }
        } else {
            *(u32x4*)(LG + (size_t)row * 256 + 160 + (lane - 52) * 8) = (u32x4){0u, 0u, 0u, 0u};
        }
    }
}

__device__ __forceinline__ void scan_unit(const TI ti, CArgs& a, int l, int u, bool ctx_out, unsigned char* ldsg) {
    const int tid = ti.tid, lane = tid & 63, w = tid >> 6;
    const int b = u >> 5, hh = (u >> 1) & 15, d = u & 1;
    const int si = tid >> 3, jq = tid & 7;
    LAS float* L = (LAS float*)ldsg;
    const bf16_t* RW = (const bf16_t*)(a.ws + WS_RW);
    const bf16_t* DEC = (const bf16_t*)(a.ws + (d ? WS_DEC1 : WS_GV));
    const bf16_t* AA = (const bf16_t*)(a.ws + (d ? WS_AA1 : WS_AA0));
    bf16_t* Y = (bf16_t*)(a.ws + (d ? WS_Y1 : WS_H));
    const int ch = hh * 64 + lane;
    const float* mu = a.in[16] + l * 3488;
    const float mur = mu[ch], muk = mu[1024 + ch], muv = mu[2048 + ch], kkg = a.in[22][l * 1024 + ch], kag = a.in[23][l * 1024 + ch];
    f32x4 S0 = {0.f, 0.f, 0.f, 0.f}, S1 = {0.f, 0.f, 0.f, 0.f};
    unsigned raw[4][9]; unsigned dcr[4], aar[4];
    constexpr int NC = 72;
#define SCAN_CHUNK(n, base, Tn, t0, wy) int base, Tn, t0; bool wy; { int ci; if ((n) < 8) { base = ML + b * 256; Tn = 256; ci = d ? 7 - (n) : (n); wy = ctx_out; } else { base = b * 2048; Tn = 2048; ci = d ? 71 - (n) : (n) - 8; wy = true; } t0 = ci * 32; }
#define SCAN_LOAD(n) do { SCAN_CHUNK(n, base_, Tn_, t0_, wy_); (void)wy_; _Pragma("unroll") for (int i4 = 0; i4 < 4; ++i4) { const int t = t0_ + w + 8 * i4; const size_t row = (size_t)(base_ + t); \
        const bf16_t* p = RW + row * RWP + ch; const bool hp = t > 0, hn = t < Tn_ - 1; \
        _Pragma("unroll") for (int X = 0; X < 3; ++X) { raw[i4][3 * X + 0] = hp ? (unsigned)p[X * 1024 - RWP] : 0u; raw[i4][3 * X + 1] = (unsigned)p[X * 1024]; raw[i4][3 * X + 2] = hn ? (unsigned)p[X * 1024 + RWP] : 0u; } \
        dcr[i4] = (unsigned)DEC[row * 1024 + ch]; aar[i4] = (unsigned)AA[row * 1024 + ch]; } } while (0)
#define SCAN_STORE(n) do { LAS float* Bf = L + ((n) & 1) * 12288; _Pragma("unroll") for (int i4 = 0; i4 < 4; ++i4) { const int tk = w + 8 * i4; \
        const float xr = bf2f(raw[i4][1]), xk = bf2f(raw[i4][4]), xv = bf2f(raw[i4][7]); \
        const float zr = xr + mur * (0.5f * (bf2f(raw[i4][0]) + bf2f(raw[i4][2])) - xr); \
        const float zk = xk + muk * (0.5f * (bf2f(raw[i4][3]) + bf2f(raw[i4][5])) - xk); \
        const float zv = xv + muv * (0.5f * (bf2f(raw[i4][6]) + bf2f(raw[i4][8])) - xv); \
        const float kkv = zk * kkg; const float ssq = wave_sum(kkv * kkv); const float kkn = kkv / fmaxf(sqrtf(ssq), 1e-12f); \
        const float ad = bf2f(aar[i4]); const float wv_ = __expf(bf2f(dcr[i4])); const float kd = zk * (1.f + (ad - 1.f) * kag); \
        Bf[0 * 2048 + tk * 64 + lane] = wv_; Bf[1 * 2048 + tk * 64 + lane] = kd; Bf[2 * 2048 + tk * 64 + lane] = -kkn; \
        Bf[3 * 2048 + tk * 64 + lane] = kkn * ad; Bf[4 * 2048 + tk * 64 + lane] = zr; Bf[5 * 2048 + tk * 64 + lane] = zv; } } while (0)
    SCAN_LOAD(0); SCAN_STORE(0);
    __syncthreads();
    for (int n = 0; n < NC; ++n) {
        if (n + 1 < NC) SCAN_LOAD(n + 1);
        LAS const float* Bf = L + (n & 1) * 12288; LAS float* Yb = L + 24576 + (n & 1) * 2048;
#define STEP_LOAD(P, sidx) LAS const float* q##P = Bf + (sidx) * 64 + 8 * jq; \
            const f32x4 w0##P = *(LAS const f32x4*)(q##P), w1##P = *(LAS const f32x4*)(q##P + 4), k0##P = *(LAS const f32x4*)(q##P + 2048), k1##P = *(LAS const f32x4*)(q##P + 2048 + 4), \
                        a0##P = *(LAS const f32x4*)(q##P + 4096), a1##P = *(LAS const f32x4*)(q##P + 4096 + 4), b0##P = *(LAS const f32x4*)(q##P + 6144), b1##P = *(LAS const f32x4*)(q##P + 6144 + 4), \
                        r0##P = *(LAS const f32x4*)(q##P + 8192), r1##P = *(LAS const f32x4*)(q##P + 8192 + 4); const float vi##P = Bf[5 * 2048 + (sidx) * 64 + si];
#define STEP_MATH(P, sidx) { const f32x4 ta = S0 * a0##P + S1 * a1##P; const float sa = dpp_sum8((ta.x + ta.y) + (ta.z + ta.w)); \
            S0 = S0 * w0##P + (sa * b0##P + vi##P * k0##P); S1 = S1 * w1##P + (sa * b1##P + vi##P * k1##P); \
            const f32x4 ty = S0 * r0##P + S1 * r1##P; const float y = dpp_sum8((ty.x + ty.y) + (ty.z + ty.w)); if (jq == 0) Yb[(sidx) * 64 + si] = y; }
        const int sdir = d ? -1 : 1; int sc = d ? 31 : 0;
        f32x4 cw0, cw1, ck0, ck1, ca0, ca1, cb0, cb1, cr0, cr1; float cvi;
        { STEP_LOAD(X, sc); cw0 = w0X; cw1 = w1X; ck0 = k0X; ck1 = k1X; ca0 = a0X; ca1 = a1X; cb0 = b0X; cb1 = b1X; cr0 = r0X; cr1 = r1X; cvi = viX; }
        for (int ss = 0; ss < 32; ss += 2) {
            const int s0i = sc, s1i = sc + sdir; int s2i = sc + 2 * sdir; s2i = (ss + 2 < 32) ? s2i : s1i;
            STEP_LOAD(B, s1i);
            { const f32x4 w0A = cw0, w1A = cw1, k0A = ck0, k1A = ck1, a0A = ca0, a1A = ca1, b0A = cb0, b1A = cb1, r0A = cr0, r1A = cr1; const float viA = cvi; STEP_MATH(A, s0i); }
            STEP_LOAD(C, s2i);
            STEP_MATH(B, s1i);
            cw0 = w0C; cw1 = w1C; ck0 = k0C; ck1 = k1C; ca0 = a0C; ca1 = a1C; cb0 = b0C; cb1 = b1C; cr0 = r0C; cr1 = r1C; cvi = viC;
            sc += 2 * sdir;
        }
#undef STEP_LOAD
#undef STEP_MATH
        if (n + 1 < NC) SCAN_STORE(n + 1);
        __syncthreads();
        {
            SCAN_CHUNK(n, base_, Tn_, t0_, wy_); (void)Tn_;
            if (wy_) {
#pragma unroll
                for (int i4 = 0; i4 < 4; ++i4) { const int tk = w + 8 * i4; Y[(size_t)(base_ + t0_ + tk) * 1024 + ch] = f2bf(Yb[tk * 64 + lane]); }
            }
        }
    }
    __syncthreads();
#undef SCAN_CHUNK
#undef SCAN_LOAD
#undef SCAN_STORE
}

__device__ __forceinline__ void attn_unit(const TI ti, CArgs& a, int b, int hd, int qrow0, int st_lo, int st_hi, float mfix, float lam, float lam_init, const float* subg, unsigned char* ldsg) {
    const int tid = ti.tid, lane = tid & 63, w = tid >> 6, r = lane & 31, h = lane >> 5, qt = w >> 1, c = w & 1;
    bf16_t* Qb = (bf16_t*)(a.ws + WS_Q); const bf16_t* Kb = (const bf16_t*)(a.ws + WS_K); const bf16_t* Vb = (const bf16_t*)(a.ws + WS_V);
    LAS unsigned char* L = (LAS unsigned char*)ldsg;
    constexpr int KOFF = 0, VOFF = 17408, BUFB = 35840;
    bf16x8 qf[4];
    { const bf16_t* qp = Qb + (size_t)(qrow0 + qt * 32 + r) * 1024 + hd * 128 + c * 64 + 8 * h;
#pragma unroll
      for (int ks = 0; ks < 4; ++ks) qf[ks] = *(const bf16x8*)(qp + 16 * ks); }
    f32x16 O[4];
#pragma unroll
    for (int e = 0; e < 4; ++e)
#pragma unroll
        for (int i = 0; i < 16; ++i) O[e][i] = 0.f;
    float lsum = 0.f;
    u32x4 kreg[2], vreg[2];
#define ATT_KROW(kk) ((kk) < 2048 ? (size_t)(b * 2048 + (kk)) : (size_t)(ML + b * 256 + (kk) - 2048))
#define ATT_LOAD(st) do { _Pragma("unroll") for (int i = 0; i < 2; ++i) { const int p = tid + 512 * i, key = p >> 4, dc = p & 15; kreg[i] = *(const u32x4*)(Kb + ATT_KROW((st) * 64 + key) * 1024 + hd * 128 + dc * 8); } \
        const bf16_t* vp = Vb + ATT_KROW((st) * 64 + lane) * 1024 + hd * 128 + w * 16; vreg[0] = *(const u32x4*)vp; vreg[1] = *(const u32x4*)(vp + 8); } while (0)
#define ATT_STORE(bufi) do { LAS unsigned char* Bb = L + (bufi) * BUFB; _Pragma("unroll") for (int i = 0; i < 2; ++i) { const int p = tid + 512 * i, key = p >> 4, dc = p & 15; *(LAS u32x4*)(Bb + KOFF + key * 272 + dc * 16) = kreg[i]; } \
        LAS bf16_t* vt = (LAS bf16_t*)(Bb + VOFF) + (w * 16) * 72 + lane; \
        _Pragma("unroll") for (int e = 0; e < 4; ++e) { vt[(2 * e) * 72] = (bf16_t)(vreg[0][e] & 0xffffu); vt[(2 * e + 1) * 72] = (bf16_t)(vreg[0][e] >> 16); \
            vt[(8 + 2 * e) * 72] = (bf16_t)(vreg[1][e] & 0xffffu); vt[(8 + 2 * e + 1) * 72] = (bf16_t)(vreg[1][e] >> 16); } } while (0)
    ATT_LOAD(st_lo); ATT_STORE(0);
    __syncthreads();
    for (int st = st_lo; st < st_hi; ++st) {
        const int bi = (st - st_lo) & 1;
        if (st + 1 < st_hi) ATT_LOAD(st + 1);
        LAS const unsigned char* Bb = L + bi * BUFB;
#pragma unroll
        for (int sub = 0; sub < 2; ++sub) {
            f32x16 Sx;
#pragma unroll
            for (int i = 0; i < 16; ++i) Sx[i] = 0.f;
#pragma unroll
            for (int ks = 0; ks < 4; ++ks) {
                const bf16x8 kf = *(LAS const bf16x8*)(Bb + KOFF + (sub * 32 + r) * 272 + (c * 64 + 16 * ks + 8 * h) * 2);
                Sx = MFMA32(kf, qf[ks], Sx);
            }
            float p[16];
#pragma unroll
            for (int i = 0; i < 16; ++i) { p[i] = __builtin_amdgcn_exp2f(Sx[i] - mfix); lsum += p[i]; }
            u32x4 pw0, pw1;
            pw0.x = pkbf(p[0], p[1]); pw0.y = pkbf(p[2], p[3]); pw0.z = pkbf(p[4], p[5]); pw0.w = pkbf(p[6], p[7]);
            pw1.x = pkbf(p[8], p[9]); pw1.y = pkbf(p[10], p[11]); pw1.z = pkbf(p[12], p[13]); pw1.w = pkbf(p[14], p[15]);
            const bf16x8 pb0 = __builtin_bit_cast(bf16x8, pw0), pb1 = __builtin_bit_cast(bf16x8, pw1);
#pragma unroll
            for (int et = 0; et < 4; ++et) {
#pragma unroll
                for (int s = 0; s < 2; ++s) {
                    LAS const unsigned char* va = Bb + VOFF + (et * 32 + r) * 144 + (sub * 32 + 16 * s + 4 * h) * 2;
                    const s16x4 lo = *(LAS const s16x4*)va, hi = *(LAS const s16x4*)(va + 16);
                    const bf16x8 vf = __builtin_shufflevector(lo, hi, 0, 1, 2, 3, 4, 5, 6, 7);
                    O[et] = MFMA32(vf, s ? pb1 : pb0, O[et]);
                }
            }
        }
        if (st + 1 < st_hi) ATT_STORE(bi ^ 1);
        __syncthreads();
    }
#undef ATT_KROW
#undef ATT_LOAD
#undef ATT_STORE
    const float ltot = lsum + __shfl_xor(lsum, 32);
    const float linv = 1.f / ltot;
    LAS float* X = (LAS float*)L + qt * 4096;
    if (c == 1) {
#pragma unroll
        for (int e = 0; e < 4; ++e)
#pragma unroll
            for (int i = 0; i < 16; ++i) X[(e * 16 + i) * 64 + lane] = O[e][i] * linv;
    }
    __syncthreads();
    if (c == 0) {
        float ssq = 0.f;
#pragma unroll
        for (int e = 0; e < 4; ++e)
#pragma unroll
            for (int i = 0; i < 16; ++i) { const float o = O[e][i] * linv - lam * X[(e * 16 + i) * 64 + lane]; O[e][i] = o; ssq += o * o; }
        ssq += __shfl_xor(ssq, 32);
        const float sc = rsqrtf(ssq * (1.f / 128.f) + 1e-6f) * (1.f - lam_init);
        bf16_t* op = Qb + (size_t)(qrow0 + qt * 32 + r) * 1024 + hd * 128;
#pragma unroll
        for (int e = 0; e < 4; ++e)
#pragma unroll
            for (int g4 = 0; g4 < 4; ++g4) {
                const int e0 = e * 32 + 8 * g4 + 4 * h; const f32x4 sg = *(const f32x4*)(subg + e0);
                u32x2 o; o.x = pkbf(O[e][4 * g4 + 0] * sc * sg.x, O[e][4 * g4 + 1] * sc * sg.y); o.y = pkbf(O[e][4 * g4 + 2] * sc * sg.z, O[e][4 * g4 + 3] * sc * sg.w);
                *(u32x2*)(op + e0) = o;
            }
    }
    __syncthreads();
}
__device__ __forceinline__ void ph_attn(const TI ti, CArgs& a, int l, bool ctx_out, unsigned char* ldsg) {
    const int lane = ti.tid & 63;
    const float gqm = fabsf(a.in[12][l * 64 + lane]), gkm = fabsf(a.in[13][l * 64 + lane]);
    float mq = gqm, mk = gkm;
#pragma unroll
    for (int o = 1; o < 64; o <<= 1) { mq = fmaxf(mq, __shfl_xor(mq, o)); mk = fmaxf(mk, __shfl_xor(mk, o)); }
    const float mfix = 8.f * mq * mk * 1.4426950408889634f * 1.03f;
    const float* lp = a.in[14] + l * 256;
    const float s1 = wave_sum(lp[lane] * lp[64 + lane]), s2 = wave_sum(lp[128 + lane] * lp[192 + lane]);
    const float lam_init = 0.8f - 0.6f * expf(-0.3f * (float)l);
    const float lam = expf(s1) - expf(s2) + lam_init;
    const float* subg = a.in[15] + l * 128;
    const int nun = 1024 + (ctx_out ? 128 : 0);
    for (int u = ti.bid; u < nun; u += ti.nblk) {
        if (u < 1024) { const int bh = u >> 4, qb = u & 15; attn_unit(ti, a, bh >> 3, bh & 7, (bh >> 3) * 2048 + qb * 128, 0, 36, mfix, lam, lam_init, subg, ldsg); }
        else { const int v = u - 1024, bh = v >> 1, qb = v & 1; attn_unit(ti, a, bh >> 3, bh & 7, ML + (bh >> 3) * 256 + qb * 128, 32, 36, mfix, lam, lam_init, subg, ldsg); }
    }
}

__device__ __forceinline__ void up8(const bf16_t* p, float (&x)[8]) { const u32x4 v = *(const u32x4*)p;
#pragma unroll
    for (int i = 0; i < 4; ++i) { x[2 * i] = bf2f(v[i] & 0xffffu); x[2 * i + 1] = bf2f(v[i] >> 16); } }
__device__ __forceinline__ void ld8f(const float* p, float (&x)[8]) { const f32x4 u = *(const f32x4*)p, v = *(const f32x4*)(p + 4); x[0] = u.x; x[1] = u.y; x[2] = u.z; x[3] = u.w; x[4] = v.x; x[5] = v.y; x[6] = v.z; x[7] = v.w; }
__device__ __forceinline__ void shift8(const bf16_t* p, const float* mu, bool hp, bool hn, float (&z)[8]) {
    float x[8], xp[8], xn[8], m[8];
#pragma unroll
    for (int j = 0; j < 8; ++j) { xp[j] = 0.f; xn[j] = 0.f; }
    up8(p, x); if (hp) up8(p - RWP, xp); if (hn) up8(p + RWP, xn); ld8f(mu, m);
#pragma unroll
    for (int j = 0; j < 8; ++j) z[j] = x[j] + m[j] * (0.5f * (xp[j] + xn[j]) - x[j]);
}
__device__ __forceinline__ void rwkv_out_rows(CArgs& a, int l, int nrows, int gw, int ngw, int lane) {
    const bf16_t* RW = (const bf16_t*)(a.ws + WS_RW); const bf16_t* Y0 = (const bf16_t*)(a.ws + WS_H); bf16_t* Y1 = (bf16_t*)(a.ws + WS_Y1);
    const bf16_t* A0 = (const bf16_t*)(a.ws + WS_AA0); const bf16_t* A1 = (const bf16_t*)(a.ws + WS_AA1); const bf16_t* G = (const bf16_t*)(a.ws + WS_G);
    const float* mu = a.in[16] + l * 3488;
    for (int it = gw; it < 2 * nrows; it += ngw) {
        const int row = it >> 1, c0 = (it & 1) * 512 + 8 * lane;
        int t, Tn; if (row < ML) { t = row & 2047; Tn = 2048; } else { t = (row - ML) & 255; Tn = 256; }
        const bool hp = t > 0, hn = t < Tn - 1;
        const size_t idx = (size_t)row * 1024 + c0;
        float y[8], y1[8], g[8], a0[8], a1[8], zr[8], zk[8], zv[8], lnw[8], lnb[8], ka[8], rk[8];
        up8(Y0 + idx, y); up8(Y1 + idx, y1); up8(G + idx, g); up8(A0 + idx, a0); up8(A1 + idx, a1);
        const bf16_t* p = RW + (size_t)row * RWP + c0;
        shift8(p, mu + c0, hp, hn, zr); shift8(p + 1024, mu + 1024 + c0, hp, hn, zk); shift8(p + 2048, mu + 2048 + c0, hp, hn, zv);
        ld8f(a.in[25] + l * 1024 + c0, lnw); ld8f(a.in[26] + l * 1024 + c0, lnb); ld8f(a.in[23] + l * 1024 + c0, ka); ld8f(a.in[24] + l * 1024 + c0, rk);
        float sm = 0.f;
#pragma unroll
        for (int j = 0; j < 8; ++j) { y[j] += y1[j]; sm += y[j]; }
        const float mean = dpp_sum8(sm) * (1.f / 64.f);
        float sv = 0.f, sb = 0.f;
#pragma unroll
        for (int j = 0; j < 8; ++j) { y[j] -= mean; sv += y[j] * y[j]; const float kds = zk[j] * ((1.f + (a0[j] - 1.f) * ka[j]) + (1.f + (a1[j] - 1.f) * ka[j])); sb += zr[j] * kds * rk[j]; }
        const float rstd = rsqrtf(dpp_sum8(sv) * (1.f / 64.f) + 64e-5f), bsum = dpp_sum8(sb);
        u32x4 o;
#pragma unroll
        for (int j = 0; j < 4; ++j) o[j] = pkbf(((y[2 * j] * rstd * lnw[2 * j] + lnb[2 * j]) + bsum * zv[2 * j]) * g[2 * j], ((y[2 * j + 1] * rstd * lnw[2 * j + 1] + lnb[2 * j + 1]) + bsum * zv[2 * j + 1]) * g[2 * j + 1]);
        *(u32x4*)(Y1 + idx) = o;
    }
}

#define XB_TMO      128
#define XB_XCNT(j)  (256  + 64 * (j))
#define XB_XSUB(j)  (1280 + 64 * (j))
#define XB_XGEN(j)  (2304 + 64 * (j))
#define XB_TOP      3328
#define XB_TOPGEN   3392
#define XCD_BAR_WORDS 3456
#define XB_SPIN_CAP (1u << 20)

__device__ __forceinline__ unsigned xb_ld(unsigned* p)              { return __hip_atomic_load(p, __ATOMIC_RELAXED, __HIP_MEMORY_SCOPE_AGENT); }
__device__ __forceinline__ unsigned xb_add(unsigned* p, unsigned v) { return __hip_atomic_fetch_add(p, v, __ATOMIC_RELAXED, __HIP_MEMORY_SCOPE_AGENT); }
__device__ __forceinline__ unsigned xb_xcc_id() { return (unsigned)__builtin_amdgcn_s_getreg((3 << 11) | 20) & 0xFu; }
#define XB_SPIN(cond, bar) do { unsigned _sp = 0; while (cond) { __builtin_amdgcn_s_sleep(1); \
    if ((++_sp & 255u) == 0u) { if (xb_ld(&(bar)[XB_TMO])) break; if (_sp > XB_SPIN_CAP) { atomicAdd(&(bar)[XB_TMO], 1u); break; } } } } while (0)

struct XcdBarrier {
    unsigned* bar; unsigned x;
    volatile LAS unsigned* st;
};

__device__ __forceinline__ XcdBarrier xcd_barrier_post(unsigned* bar, volatile LAS unsigned* st) {
    XcdBarrier b; b.bar = bar; b.x = xb_xcc_id(); b.st = st;
    if (threadIdx.x == 0) (void)xb_add(&bar[XB_XCNT(b.x)], 1u);
    return b;
}
__device__ __forceinline__ void xcd_barrier_complete(unsigned* bar, unsigned x, unsigned& nloc, unsigned& nx) {
    const unsigned G = gridDim.x * gridDim.y * gridDim.z;
    unsigned sum, cnt, mine, sp = 0u;
    for (;;) {
        sum = 0u; cnt = 0u; mine = 0u;
#pragma unroll
        for (unsigned j = 0; j < 16; ++j) { const unsigned c = xb_ld(&bar[XB_XCNT(j)]); sum += c; cnt += (c > 0u) ? 1u : 0u; mine = (j == x) ? c : mine; }
        if (sum == G) break;
        __builtin_amdgcn_s_sleep(1);
        if ((++sp & 255u) == 0u) { if (xb_ld(&bar[XB_TMO])) break; if (sp > XB_SPIN_CAP) { atomicAdd(&bar[XB_TMO], 1u); break; } }
    }
    nloc = mine > 0u ? mine : 1u; nx = cnt > 0u ? cnt : 1u;
}

__device__ __forceinline__ void xcd_barrier(const XcdBarrier& b) {
    asm volatile("s_waitcnt vmcnt(0)" ::: "memory");
    __syncthreads();
    if (threadIdx.x == 0) {
        unsigned* bar = b.bar;
        __builtin_amdgcn_s_waitcnt(0);
        unsigned nloc = b.st[0], nx = b.st[1];
        if (nloc == 0u) { xcd_barrier_complete(bar, b.x, nloc, nx); b.st[0] = nloc; b.st[1] = nx; }
        const unsigned old = xb_add(&bar[XB_XSUB(b.x)], 1u);
        const unsigned gen = old / nloc;
        if (old + 1u == (gen + 1u) * nloc) {
            __builtin_amdgcn_fence(__ATOMIC_RELEASE, "agent");
            asm volatile("s_waitcnt vmcnt(0)" ::: "memory");
            const unsigned og = xb_add(&bar[XB_TOP], 1u);
            const unsigned tg = og / nx;
            if (og + 1u == (tg + 1u) * nx) xb_add(&bar[XB_TOPGEN], 1u);
            else XB_SPIN(xb_ld(&bar[XB_TOPGEN]) == tg, bar);
            __builtin_amdgcn_fence(__ATOMIC_ACQUIRE, "agent");
            xb_add(&bar[XB_XGEN(b.x)], 1u);
            asm volatile("s_waitcnt vmcnt(0)" ::: "memory");
        } else {
            XB_SPIN(xb_ld(&bar[XB_XGEN(b.x)]) == gen, bar);
            __builtin_amdgcn_fence(__ATOMIC_ACQUIRE, "agent");
            asm volatile("s_waitcnt vmcnt(0)" ::: "memory");
        }
    }
    __syncthreads();
}

#ifndef ONLY_PH
#define ONLY_PH -1
#endif
#ifndef SKIP_PH
#define SKIP_PH -2
#endif
#define PH_ON(k) ((ONLY_PH < 0 || ONLY_PH == (k)) && (k) != SKIP_PH)
__global__ void __launch_bounds__(512, 2) mega_fwd(Args a_) {
    extern __shared__ __attribute__((aligned(16))) unsigned char lds[];
    cg::grid_group grid = cg::this_grid();
    const int ph_lo = a_.lo, ph_hi = a_.hi;
    volatile LAS unsigned* bst = (volatile LAS unsigned*)((LAS unsigned char*)lds + 131072);
    if (threadIdx.x < 2) bst[threadIdx.x] = 0u;
    __syncthreads();
    const XcdBarrier xbar = xcd_barrier_post((unsigned*)(a_.ws + WS_BAR), bst);
    const int wave_s = __builtin_amdgcn_readfirstlane((int)threadIdx.x >> 6);
#pragma nounroll
    for (int ph = ph_lo; ph < ph_hi; ++ph) {
        CArgs* ap = (CArgs*)__builtin_amdgcn_kernarg_segment_ptr(); asm volatile("" : "+s"(ap));
        CArgs& a = *ap;
        unsigned char* ws = a.ws;
        float* XC = (float*)(ws + WS_XC);
        int wsv = wave_s; asm volatile("" : "+s"(wsv));
        TI ti; ti.tid = wsv * 64 + (int)__builtin_amdgcn_mbcnt_hi(~0u, __builtin_amdgcn_mbcnt_lo(~0u, 0u)); ti.bid = blockIdx.x; ti.nblk = gridDim.x;
        asm volatile("" : "+v"(ti.tid)); asm volatile("" : "+s"(ti.bid)); asm volatile("" : "+s"(ti.nblk));
        const int tid = ti.tid, lane = tid & 63, wv = __builtin_amdgcn_readfirstlane(tid >> 6);
        const int gw = ti.bid * 8 + wv, ngw = ti.nblk * 8;
        if (ph == 0) { if constexpr (PH_ON(100)) ph_mods(ti, a, lds); }
        else {
            const int l = (ph - 1) / NPH, k = (ph - 1) % NPH;
            const bool ctx_out = l < DEPTH - 1;
            const int Mr = ctx_out ? M : ML;
            const float* modl = (const float*)(ws + WS_MOD) + (size_t)l * 9 * 6144;
            const float* xl_in = l == 0 ? a.in[0] : a.out; const float* xc_in = l == 0 ? a.in[2] : XC;
            bf16_t* H = (bf16_t*)(ws + WS_H);
            switch (k) {
            case 0: if constexpr (PH_ON(0)) {
                norm_rows(xl_in, xc_in, a.in[6] + l * 1024, modl, 0, 1, H, M, gw, ngw, lane);
                ph_wconv(a, l, lds, gw, ngw, lane, wv);
                } break;
            case 1: if constexpr (PH_ON(1)) {
                OpIn op{(bf16_t*)(ws + WS_GU), (bf16_t*)(ws + WS_GV), (bf16_t*)(ws + WS_Q), (bf16_t*)(ws + WS_RW), (bf16_t*)(ws + WS_GT)};
                run_gemm(ti, lds, H, (const bf16_t*)(ws + WS_WIN), M, PPAD, 1024, op);
            } break;
            case 2: if constexpr (PH_ON(2)) {
                for (int u = ti.bid; u < Mr / 128; u += ti.nblk) gmlp_unit(ti, a, l, u, lds);
                qk_rows(a, l, gw, ngw, lane);
                lora_in_rows(a, l, gw, ngw, lane);
                } break;
            case 3: if constexpr (PH_ON(3)) {
                OpDec o1{(bf16_t*)(ws + WS_GV), (bf16_t*)(ws + WS_DEC1), a.in[17] + l * 2048};
                run_gemm(ti, lds, (const bf16_t*)(ws + WS_LIW), (const bf16_t*)(ws + WS_LWT), M, 2048, 128, o1);
                OpAA o2{(bf16_t*)(ws + WS_AA0), (bf16_t*)(ws + WS_AA1), a.in[19] + l * 2048};
                run_gemm(ti, lds, (const bf16_t*)(ws + WS_LIA), (const bf16_t*)(ws + WS_LAT), M, 2048, 128, o2);
                OpG o3{(bf16_t*)(ws + WS_G)};
                run_gemm(ti, lds, (const bf16_t*)(ws + WS_LIG), (const bf16_t*)(ws + WS_LGT), M, 1024, 256, o3);
            } break;
            case 4:
                if constexpr (PH_ON(4)) { for (int u = ti.bid; u < 256; u += ti.nblk) scan_unit(ti, a, l, u, ctx_out, lds); }
                if constexpr (PH_ON(40)) ph_attn(ti, a, l, ctx_out, lds);
                break;
            case 5: if constexpr (PH_ON(5)) {
                rwkv_out_rows(a, l, Mr, gw, ngw, lane);
                } break;
            case 6: if constexpr (PH_ON(6)) {
                const bf16_t* GT = (const bf16_t*)(ws + WS_GT); float* MF = (float*)(ws + WS_K);
                OpMerge<0> o0{GT, MF, H}; run_gemm(ti, lds, (const bf16_t*)(ws + WS_GU), (const bf16_t*)(ws + WS_WA), Mr, 1024, 1024, o0);
                OpMerge<1> o1{GT, MF, H}; run_gemm(ti, lds, (const bf16_t*)(ws + WS_Q), (const bf16_t*)(ws + WS_WB), Mr, 1024, 1024, o1);
                OpMerge<2> o2{GT, MF, H}; run_gemm(ti, lds, (const bf16_t*)(ws + WS_Y1), (const bf16_t*)(ws + WS_WC), Mr, 1024, 1024, o2);
            } break;
            case 7: if constexpr (PH_ON(7)) {
                OpResid op{xl_in, xc_in, a.out, XC, modl, 2};
                run_gemm(ti, lds, H, (const bf16_t*)(ws + WS_WO), Mr, 1024, 1024, op);
            } break;
            case 8: if constexpr (PH_ON(8)) {
                norm_rows(a.out, XC, a.in[7] + l * 1024, modl, 3, 4, H, Mr, gw, ngw, lane);
                } break;
            case 9: if constexpr (PH_ON(9)) {
                OpSwiglu op{(bf16_t*)(ws + WS_RW)};
                run_gemm(ti, lds, H, (const bf16_t*)(ws + WS_WI), Mr, 2 * DFF, 1024, op);
            } break;
            default: if constexpr (PH_ON(10)) {
                OpResid op{a.out, XC, a.out, XC, modl, 5};
                run_gemm(ti, lds, (const bf16_t*)(ws + WS_RW), (const bf16_t*)(ws + WS_WO2), Mr, 1024, DFF, op);
            } break;
            }
        }
        if (ph + 1 < ph_hi) { if (ph == ph_lo) grid.sync(); else xcd_barrier(xbar); }
    }
}

extern "C" void kernel_launch(void* const* d_in, const int* in_sizes, int n_in, void* d_out, int out_size, void* d_ws, size_t ws_size, hipStream_t stream) {
    static int grid = 0;
    if (grid == 0) {
        if (n_in != 33 || out_size != ML * D || ws_size < WS_END) { fprintf(stderr, "kernel_launch: unexpected shapes / workspace (%d inputs, out %d, ws %zu, need %zu)\n", n_in, out_size, ws_size, (size_t)WS_END); grid = -1; return; }
        int dev = 0, cus = 0, per_cu = 0;
        hipGetDevice(&dev); hipDeviceGetAttribute(&cus, hipDeviceAttributeMultiprocessorCount, dev);
        if (hipFuncSetAttribute((const void*)mega_fwd, hipFuncAttributeMaxDynamicSharedMemorySize, LDS_BYTES) != hipSuccess) { fprintf(stderr, "kernel_launch: hipFuncSetAttribute failed\n"); grid = -1; return; }
        if (hipOccupancyMaxActiveBlocksPerMultiprocessor(&per_cu, (const void*)mega_fwd, 512, LDS_BYTES) != hipSuccess || per_cu < 1) per_cu = 1;
        (void)hipGetLastError();
        grid = cus * 1;
    }
    if (grid < 0) return;
    Args a{};
    for (int i = 0; i < 33; ++i) a.in[i] = (const float*)d_in[i];
    a.out = (float*)d_out; a.ws = (unsigned char*)d_ws; a.lo = 0; a.hi = NPHASES;
    void* args[] = {&a};
    if (hipMemsetAsync((char*)d_ws + WS_BAR, 0, BAR_BYTES, stream) != hipSuccess) { fprintf(stderr, "kernel_launch: memset of barrier words failed\n"); return; }
    hipError_t e = hipLaunchCooperativeKernel((const void*)mega_fwd, dim3(grid), dim3(512), args, LDS_BYTES, stream);
    if (e != hipSuccess) fprintf(stderr, "kernel_launch: cooperative launch failed: %s (grid %d)\n", hipGetErrorString(e), grid);
}
```

```cpp
#include <hip/hip_runtime.h>
#include <hip/hip_cooperative_groups.h>
#include <cstdio>
#include <cstdint>
namespace cg = cooperative_groups;
namespace pg8 {
#define PG8_LAS __attribute__((address_space(3)))
typedef unsigned short bf16_t;
typedef short bf16x8 __attribute__((ext_vector_type(8)));
typedef float f32x4 __attribute__((ext_vector_type(4)));
typedef unsigned u32x4 __attribute__((ext_vector_type(4)));
constexpr int BM = 256, BK = 64, HALF = 128, HTB = HALF * BK * 2  , STAGE_BYTES = 8 * HTB, NXCD = 8, WGM = 8;

__host__ __device__ __forceinline__ int lds_byte(int r, int c) { const int st = (r >> 4) * 2 + (c >> 5), rr = r & 15, cc = c & 31, ob = rr * 64 + cc * 2; return st * 1024 + (ob ^ (((ob >> 9) & 1) << 5)); }
__host__ __device__ __forceinline__ void stage_rc(int b, int& R, int& C) { const int st = b / 1024, sb = b % 1024, swz = sb ^ (((sb >> 9) & 1) << 5); R = (st >> 1) * 16 + swz / 64; C = (st & 1) * 32 + (swz % 64) / 2; }
__host__ __device__ __forceinline__ int perm32(int rho) { const int n = rho >> 4, i = rho & 15; return 8 * (i >> 2) + 4 * n + (i & 3); }

struct Unit { int pm, pn; };
struct Gemm { const bf16_t* A; const bf16_t* Bt; int M, N, K; };

struct StaticOrder {
    int nM, nN, nwg, G, c;
    __host__ __device__ void init(int M, int N, int G_, int c_) { nM = M / BM; nN = N / BM; nwg = nM * nN; G = G_; c = c_; }
    __host__ __device__ bool next(int i, Unit& u) const {
        const long L = (long)i * G + c; if (L >= nwg) return false;
        int wgid = (int)L; { const int q = nwg / NXCD, r = nwg % NXCD, xcd = wgid % NXCD, off = wgid / NXCD; wgid = (xcd < r ? xcd * (q + 1) : r * (q + 1) + (xcd - r) * q) + off; }
        const int nig = WGM * nN, gid = wgid / nig, fm = gid * WGM, gsz = (nM - fm) < WGM ? (nM - fm) : WGM;
        u.pm = fm + ((wgid % nig) % gsz); u.pn = (wgid % nig) / gsz; return true;
    }
    __device__ __forceinline__ void a_ready(const Unit&) const {}
    __device__ __forceinline__ void done(const Unit&) const {}
};

__device__ __forceinline__ unsigned cvt_pk_bf16(float lo, float hi) { unsigned r; asm volatile("v_cvt_pk_bf16_f32 %0, %1, %2" : "=v"(r) : "v"(lo), "v"(hi)); return r; }
typedef float f32x2 __attribute__((ext_vector_type(2)));
__device__ __forceinline__ f32x2 gelu_pk(f32x2 v) {
    const f32x2 av = __builtin_elementwise_abs(v), d = av * 0.2316418882f + 1.0f;
    f32x2 t; t.x = __builtin_amdgcn_rcpf(d.x); t.y = __builtin_amdgcn_rcpf(d.y);
    f32x2 q = t * 0.5307027145f + (-0.7265760135f); q = q * t + 0.7107068705f; q = q * t + (-0.142248368f); q = q * t + 0.127414796f; q = q * t;
    const f32x2 s = (v * v) * (-0.72134752044f);
    f32x2 e; e.x = __builtin_amdgcn_exp2f(s.x); e.y = __builtin_amdgcn_exp2f(s.y);
    const f32x2 m = v * (q * e), r = v - m;
    f32x2 o; o.x = v.x < 0.f ? m.x : r.x; o.y = v.y < 0.f ? m.y : r.y; return o;
}

template <class Epi, class Sched, bool ALIGN_EPI = false, bool SP2 = false>
__device__ __forceinline__ void gemm_phase(PG8_LAS unsigned char* lds, const Gemm g, const Sched& S, const Epi& E, const int tid_in) {
    const int tid = tid_in, wid = __builtin_amdgcn_readfirstlane(tid >> 6), lane = tid & 63, wr = wid >> 2, wc = wid & 3, fr = lane & 15, fq = lane >> 4;
    const int K = g.K, nt = K / BK;
    unsigned voffA[2], voffB[2];
#pragma unroll
    for (int i = 0; i < 2; ++i) { int R, C; stage_rc(tid * 16 + i * 8192, R, C); const int Rb = Epi::PERM ? ((R & ~31) + perm32(R & 31)) : R;
        voffA[i] = (unsigned)(R * K + C) * 2u; voffB[i] = (unsigned)(Rb * K + C) * 2u; }
    const size_t kstep = (size_t)(BK * 2);
    const size_t hstep = (size_t)HALF * K * 2;
    const size_t tstep = 2 * hstep;
    const unsigned ldsw = (unsigned)wid * 1024u;
    const int aoff = lds_byte(wr * 64 + fr, fq * 8), boff = lds_byte(wc * 32 + fr, fq * 8);
#define PG8_SA(b, h) (((b) * 2 + (h)) * HTB)
#define PG8_SB(b, h) ((4 + (b) * 2 + (h)) * HTB)
#define PG8_STAGE(bufoff, gbase, voff) do { _Pragma("unroll") for (int _i = 0; _i < 2; ++_i) \
        __builtin_amdgcn_global_load_lds((const unsigned*)((const char*)(gbase) + (voff)[_i]), (PG8_LAS unsigned*)(lds + (bufoff) + ldsw + _i * 8192), 16, 0, 0); } while (0)
#define PG8_LDA(dst, b, h) do { _Pragma("unroll") for (int m = 0; m < 4; ++m) _Pragma("unroll") for (int k = 0; k < 2; ++k) dst[m][k] = *(const PG8_LAS bf16x8*)(lds + PG8_SA(b, h) + aoff + m * 2048 + k * 1024); } while (0)
#define PG8_LDB(dst, b, h) do { _Pragma("unroll") for (int n = 0; n < 2; ++n) _Pragma("unroll") for (int k = 0; k < 2; ++k) dst[n][k] = *(const PG8_LAS bf16x8*)(lds + PG8_SB(b, h) + boff + n * 2048 + k * 1024); } while (0)
#define PG8_MMA(ai, bj, At, Bt) do { __builtin_amdgcn_s_setprio(1); _Pragma("unroll") for (int m = 0; m < 4; ++m) _Pragma("unroll") for (int n = 0; n < 2; ++n) _Pragma("unroll") for (int k = 0; k < 2; ++k) \
        acc[ai][bj][m][n] = __builtin_amdgcn_mfma_f32_16x16x32_bf16(Bt[n][k], At[m][k], acc[ai][bj][m][n], 0, 0, 0); __builtin_amdgcn_s_setprio(0); } while (0)
#define PG8_WAIT_V(n) asm volatile("s_waitcnt vmcnt(" #n ")" ::: "memory")
#define PG8_WAIT_L(n) asm volatile("s_waitcnt lgkmcnt(" #n ")" ::: "memory")
#define PG8_BAR __builtin_amdgcn_s_barrier()
#define PG8_SCHED __builtin_amdgcn_sched_barrier(0)
    Unit cur, nxt; int ui = 0;
    if (!S.next(0, cur)) return;
    f32x4 acc[2][2][4][2];
#pragma unroll
    for (int a = 0; a < 2; ++a)
#pragma unroll
        for (int b = 0; b < 2; ++b)
#pragma unroll
            for (int m = 0; m < 4; ++m)
#pragma unroll
                for (int n = 0; n < 2; ++n) acc[a][b][m][n] = (f32x4){0.f, 0.f, 0.f, 0.f};
    bf16x8 At[4][2], B0[2][2], B1[2][2];
    const char* cA = (const char*)g.A + (size_t)cur.pm * tstep; const char* cB = (const char*)g.Bt + (size_t)cur.pn * tstep;
    S.a_ready(cur);
    if constexpr (SP2) {
        PG8_STAGE(PG8_SB(0, 0), cB, voffB); PG8_STAGE(PG8_SB(0, 1), cB + hstep, voffB); PG8_STAGE(PG8_SA(0, 0), cA, voffA); PG8_STAGE(PG8_SA(0, 1), cA + hstep, voffA);
        if (wr == 1) PG8_BAR;
        PG8_WAIT_V(2); PG8_BAR;
        PG8_STAGE(PG8_SB(1, 0), cB + kstep, voffB); PG8_STAGE(PG8_SA(1, 0), cA + kstep, voffA); PG8_STAGE(PG8_SB(1, 1), cB + hstep + kstep, voffB);
        PG8_WAIT_V(6); PG8_BAR;
    } else {
        PG8_STAGE(PG8_SB(0, 0), cB, voffB); PG8_STAGE(PG8_SA(0, 0), cA, voffA); PG8_STAGE(PG8_SB(0, 1), cB + hstep, voffB); PG8_STAGE(PG8_SA(0, 1), cA + hstep, voffA);
        if (wr == 1) PG8_BAR;
        PG8_WAIT_V(4); PG8_BAR;
        PG8_STAGE(PG8_SB(1, 0), cB + kstep, voffB); PG8_STAGE(PG8_SA(1, 0), cA + kstep, voffA); PG8_STAGE(PG8_SB(1, 1), cB + hstep + kstep, voffB);
        PG8_WAIT_V(6); PG8_BAR;
    }
    for (;;) {
        const bool has_next = S.next(ui + 1, nxt);
        const char* nA = has_next ? (const char*)g.A + (size_t)nxt.pm * tstep : cA; const char* nB = has_next ? (const char*)g.Bt + (size_t)nxt.pn * tstep : cB;
        for (int t = 0; t < nt; t += 2) {
            const bool last = (t == nt - 2);
            const char* a1 = cA + (size_t)(t + 1) * kstep;
            const char* a2 = last ? nA : cA + (size_t)(t + 2) * kstep; const char* b2 = last ? nB : cB + (size_t)(t + 2) * kstep;
            const char* a3 = a2 + kstep; const char* b3 = b2 + kstep;
            if (last && has_next) S.a_ready(nxt);
            if constexpr (SP2) {
            PG8_LDB(B0, 0, 0); PG8_LDB(B1, 0, 1); PG8_SCHED; PG8_LDA(At, 0, 0); PG8_STAGE(PG8_SA(1, 1), a1 + hstep, voffA);
            PG8_WAIT_V(8); PG8_WAIT_L(0); PG8_BAR; PG8_MMA(0, 0, At, B0); PG8_MMA(0, 1, At, B1); PG8_BAR; PG8_SCHED;
            PG8_LDA(At, 0, 1); PG8_STAGE(PG8_SB(0, 0), b2, voffB); PG8_STAGE(PG8_SB(0, 1), b2 + hstep, voffB); PG8_STAGE(PG8_SA(0, 0), a2, voffA);
            PG8_WAIT_V(8); PG8_WAIT_L(0); PG8_BAR; PG8_MMA(1, 0, At, B0); PG8_MMA(1, 1, At, B1); PG8_BAR; PG8_SCHED;
            PG8_LDB(B0, 1, 0); PG8_LDB(B1, 1, 1); PG8_SCHED; PG8_LDA(At, 1, 0); PG8_STAGE(PG8_SA(0, 1), a2 + hstep, voffA);
            PG8_WAIT_V(8); PG8_WAIT_L(0); PG8_BAR; PG8_MMA(0, 0, At, B0); PG8_MMA(0, 1, At, B1); PG8_BAR; PG8_SCHED;
            PG8_LDA(At, 1, 1); PG8_STAGE(PG8_SB(1, 0), b3, voffB); PG8_STAGE(PG8_SB(1, 1), b3 + hstep, voffB); PG8_STAGE(PG8_SA(1, 0), a3, voffA);
            PG8_WAIT_V(8); PG8_WAIT_L(0); PG8_BAR; PG8_MMA(1, 0, At, B0); PG8_MMA(1, 1, At, B1); PG8_BAR; PG8_SCHED;
            } else {
            PG8_LDB(B0, 0, 0); PG8_SCHED; PG8_LDA(At, 0, 0); PG8_STAGE(PG8_SA(1, 1), a1 + hstep, voffA);
            PG8_WAIT_L(8); PG8_BAR; PG8_WAIT_L(0); PG8_MMA(0, 0, At, B0); PG8_BAR; PG8_SCHED;
            PG8_LDB(B1, 0, 1); PG8_STAGE(PG8_SB(0, 0), b2, voffB);
            PG8_BAR; PG8_WAIT_L(0); PG8_MMA(0, 1, At, B1); PG8_BAR;
            PG8_LDA(At, 0, 1); PG8_STAGE(PG8_SA(0, 0), a2, voffA);
            PG8_BAR; PG8_WAIT_L(0); PG8_MMA(1, 0, At, B0); PG8_BAR; PG8_SCHED;
            PG8_STAGE(PG8_SB(0, 1), b2 + hstep, voffB);
            PG8_WAIT_V(6); PG8_BAR; PG8_MMA(1, 1, At, B1); PG8_BAR;
            PG8_LDB(B0, 1, 0); PG8_SCHED; PG8_LDA(At, 1, 0); PG8_STAGE(PG8_SA(0, 1), a2 + hstep, voffA);
            PG8_WAIT_L(8); PG8_BAR; PG8_WAIT_L(0); PG8_MMA(0, 0, At, B0); PG8_BAR; PG8_SCHED;
            PG8_LDB(B1, 1, 1); PG8_STAGE(PG8_SB(1, 0), b3, voffB);
            PG8_BAR; PG8_WAIT_L(0); PG8_MMA(0, 1, At, B1); PG8_BAR;
            PG8_LDA(At, 1, 1); PG8_STAGE(PG8_SA(1, 0), a3, voffA);
            PG8_BAR; PG8_WAIT_L(0); PG8_MMA(1, 0, At, B0); PG8_BAR; PG8_SCHED;
            PG8_STAGE(PG8_SB(1, 1), b3 + hstep, voffB);
            PG8_WAIT_V(6); PG8_BAR; PG8_MMA(1, 1, At, B1); PG8_BAR;
            }
        }
        if constexpr (ALIGN_EPI) { if (wr == 0) PG8_BAR; }
        if constexpr (!Epi::AFTER_DRAIN) { E(acc, cur, wr, wc, fr, fq); S.done(cur); }
        if (!has_next) break;
#pragma unroll
        for (int a = 0; a < 2; ++a)
#pragma unroll
            for (int b = 0; b < 2; ++b)
#pragma unroll
                for (int m = 0; m < 4; ++m)
#pragma unroll
                    for (int n = 0; n < 2; ++n) acc[a][b][m][n] = (f32x4){0.f, 0.f, 0.f, 0.f};
        cur = nxt; cA = nA; cB = nB; ++ui;
        if constexpr (ALIGN_EPI) { if (wr == 1) PG8_BAR; }
    }
    PG8_WAIT_V(0);
    if constexpr (!ALIGN_EPI) { if (wr == 0) PG8_BAR; }
    PG8_BAR;
    if constexpr (Epi::AFTER_DRAIN) { E.fused(acc, cur, wr, wc, fr, fq, lds, wid, lane); S.done(cur); }
#undef PG8_SA
#undef PG8_SB
#undef PG8_STAGE
#undef PG8_LDA
#undef PG8_LDB
#undef PG8_MMA
#undef PG8_WAIT_V
#undef PG8_WAIT_L
#undef PG8_BAR
#undef PG8_SCHED
}
}

#define LAS __attribute__((address_space(3)))
typedef unsigned short bf16_t;
typedef float f32x2 __attribute__((ext_vector_type(2)));
typedef float f32x4 __attribute__((ext_vector_type(4)));
typedef float f32x16 __attribute__((ext_vector_type(16)));
typedef short bf16x8 __attribute__((ext_vector_type(8)));
typedef short s16x4 __attribute__((ext_vector_type(4)));
typedef unsigned u32x4 __attribute__((ext_vector_type(4)));
typedef unsigned u32x2 __attribute__((ext_vector_type(2)));
typedef __bf16 bf16x2v __attribute__((ext_vector_type(2)));
#define MFMA32(a, b, c) __builtin_amdgcn_mfma_f32_32x32x16_bf16((a), (b), (c), 0, 0, 0)

constexpr int D = 1024, NB = 8, TL = 2048, TCX = 256, DEPTH = 4;
constexpr int ML = NB * TL, MC = NB * TCX, M = ML + MC;
constexpr int PPAD = 11776, RWP = 3584, DFF = 2816;
constexpr int NPH = 11, NPHASES = 1 + DEPTH * NPH;
constexpr size_t MiB = 1u << 20;
constexpr size_t WS_MOD = 0, WS_WIN = 1 * MiB, WS_WA = 24 * MiB, WS_WB = 26 * MiB, WS_WC = 28 * MiB, WS_WO = 30 * MiB, WS_WI = 32 * MiB, WS_WO2 = 43 * MiB,
                 WS_LWT = 48 * MiB + MiB / 2, WS_LAT = 49 * MiB, WS_LGT = 49 * MiB + MiB / 2, WS_H = 50 * MiB, WS_XC = 86 * MiB, WS_GU = 94 * MiB, WS_GV = 130 * MiB,
                 WS_Q = 166 * MiB, WS_K = 202 * MiB, WS_V = 238 * MiB, WS_RW = 274 * MiB, WS_GT = 400 * MiB, WS_LIW = 508 * MiB, WS_LIA = 512 * MiB + MiB / 2,
                 WS_LIG = 517 * MiB, WS_DEC1 = 526 * MiB, WS_AA0 = 562 * MiB, WS_AA1 = 598 * MiB, WS_G = 634 * MiB, WS_Y1 = 670 * MiB, WS_ROPE = 706 * MiB, WS_END = 707 * MiB;
constexpr int LDS_BYTES = 131072 + 1024;
constexpr size_t WS_BAR = 917504, BAR_BYTES = 16384;
constexpr float QSCALE = 0.125f * 1.4426950408889634f;

struct Args { const float* in[33]; float* out; unsigned char* ws; int lo, hi; };
typedef const __attribute__((address_space(4))) Args CArgs;
struct TI { int tid, bid, nblk; };

__device__ __forceinline__ float bf2f(unsigned v) { return __uint_as_float(v << 16); }
__device__ __forceinline__ unsigned pkbf(float lo, float hi) { f32x2 v = {lo, hi}; bf16x2v b = __builtin_convertvector(v, bf16x2v); return __builtin_bit_cast(unsigned, b); }
__device__ __forceinline__ bf16_t f2bf(float f) { return (bf16_t)(pkbf(f, 0.f) & 0xffffu); }
#define DPP_ADD(x, ctrl) ((x) + __builtin_bit_cast(float, __builtin_amdgcn_update_dpp(0, __builtin_bit_cast(int, (x)), (ctrl), 0xf, 0xf, true)))
__device__ __forceinline__ float wave_sum(float v) {
    v = DPP_ADD(v, 0xB1); v = DPP_ADD(v, 0x4E); v = DPP_ADD(v, 0x141); v = DPP_ADD(v, 0x140);
    const int iv = __builtin_bit_cast(int, v);
    const float s0 = __builtin_bit_cast(float, __builtin_amdgcn_readlane(iv, 0)), s1 = __builtin_bit_cast(float, __builtin_amdgcn_readlane(iv, 16)),
                s2 = __builtin_bit_cast(float, __builtin_amdgcn_readlane(iv, 32)), s3 = __builtin_bit_cast(float, __builtin_amdgcn_readlane(iv, 48));
    return (s0 + s1) + (s2 + s3);
}
__device__ __forceinline__ float dpp_sum8(float x) {
    x += __builtin_bit_cast(float, __builtin_amdgcn_update_dpp(0, __builtin_bit_cast(int, x), 0xB1, 0xf, 0xf, true));
    x += __builtin_bit_cast(float, __builtin_amdgcn_update_dpp(0, __builtin_bit_cast(int, x), 0x4E, 0xf, 0xf, true));
    x += __builtin_bit_cast(float, __builtin_amdgcn_update_dpp(0, __builtin_bit_cast(int, x), 0x141, 0xf, 0xf, true));
    return x;
}
__device__ __forceinline__ float quad_sum(float x) { x = DPP_ADD(x, 0xB1); x = DPP_ADD(x, 0x4E); return x; }
__device__ __forceinline__ float quad_xor2(float x) { return __builtin_bit_cast(float, __builtin_amdgcn_update_dpp(0, __builtin_bit_cast(int, x), 0x4E, 0xf, 0xf, true)); }
__device__ __forceinline__ void unpack16(const bf16_t* p, float (&x)[16]) {
    const u32x4 a = *(const u32x4*)p, b = *(const u32x4*)(p + 8);
#pragma unroll
    for (int i = 0; i < 4; ++i) { x[2 * i] = bf2f(a[i] & 0xffffu); x[2 * i + 1] = bf2f(a[i] >> 16); x[8 + 2 * i] = bf2f(b[i] & 0xffffu); x[8 + 2 * i + 1] = bf2f(b[i] >> 16); }
}
__device__ __forceinline__ void pack16(bf16_t* p, const float (&x)[16]) {
    u32x4 a, b;
#pragma unroll
    for (int i = 0; i < 4; ++i) { a[i] = pkbf(x[2 * i], x[2 * i + 1]); b[i] = pkbf(x[8 + 2 * i], x[8 + 2 * i + 1]); }
    *(u32x4*)p = a; *(u32x4*)(p + 8) = b;
}
__device__ __forceinline__ void load16f(const float* p, float (&x)[16]) {
#pragma unroll
    for (int i = 0; i < 4; ++i) { const f32x4 v = *(const f32x4*)(p + 4 * i); x[4 * i] = v.x; x[4 * i + 1] = v.y; x[4 * i + 2] = v.z; x[4 * i + 3] = v.w; }
}
__device__ __forceinline__ float sigmoidf_(float x) { return 1.f / (1.f + __expf(-x)); }

template <class Op> struct EpiT {
    static constexpr bool PERM = true, AFTER_DRAIN = false;
    Op op;
    __device__ __forceinline__ void operator()(const pg8::f32x4 (&acc)[2][2][4][2], const pg8::Unit& u, int wr, int wc, int fr, int fq) const {
        const int row0 = u.pm * 256 + wr * 64 + fr, col0 = u.pn * 256 + wc * 32 + 8 * fq;
#pragma unroll
        for (int ai = 0; ai < 2; ++ai)
#pragma unroll
            for (int m = 0; m < 4; ++m)
#pragma unroll
                for (int bj = 0; bj < 2; ++bj) { op(row0 + ai * 128 + m * 16, col0 + bj * 128, acc[ai][bj][m][0], acc[ai][bj][m][1]); asm volatile("" ::: "memory"); }
    }
};
__device__ __forceinline__ u32x4 pack8(f32x4 v0, f32x4 v1) { u32x4 o; o.x = pkbf(v0.x, v0.y); o.y = pkbf(v0.z, v0.w); o.z = pkbf(v1.x, v1.y); o.w = pkbf(v1.z, v1.w); return o; }
__device__ __forceinline__ void unpack8(u32x4 x, f32x4& v0, f32x4& v1) {
    v0.x = bf2f(x.x & 0xffffu); v0.y = bf2f(x.x >> 16); v0.z = bf2f(x.y & 0xffffu); v0.w = bf2f(x.y >> 16);
    v1.x = bf2f(x.z & 0xffffu); v1.y = bf2f(x.z >> 16); v1.z = bf2f(x.w & 0xffffu); v1.w = bf2f(x.w >> 16);
}
__device__ __forceinline__ f32x4 gelu4(f32x4 v) { pg8::f32x2 a = pg8::gelu_pk((pg8::f32x2){v.x, v.y}), b = pg8::gelu_pk((pg8::f32x2){v.z, v.w}); return (f32x4){a.x, a.y, b.x, b.y}; }
__device__ __forceinline__ f32x4 sig4(f32x4 v) { return (f32x4){sigmoidf_(v.x), sigmoidf_(v.y), sigmoidf_(v.z), sigmoidf_(v.w)}; }

struct OpIn {
    bf16_t *GU, *GV, *Q, *RW, *GT;
    __device__ __forceinline__ void operator()(int row, int col, f32x4 v0, f32x4 v1) const {
        bf16_t* dst;
        if (col < 2048) { v0 = gelu4(v0); v1 = gelu4(v1); dst = (col < 1024 ? GU : GV) + (size_t)row * 1024 + (col & 1023); }
        else if (col < 5120) { const int q = col - 2048; dst = Q + (size_t)(q >> 10) * (size_t)(18 * MiB) + (size_t)row * 1024 + (q & 1023); }
        else if (col < 8704) { dst = RW + (size_t)row * RWP + (col - 5120); }
        else { v0 = sig4(v0); v1 = sig4(v1); dst = GT + (size_t)row * 3072 + (col - 8704); }
        *(u32x4*)dst = pack8(v0, v1);
    }
};
struct OpDec {
    bf16_t *D0, *D1; const float* w0;
    __device__ __forceinline__ float f(float x) const { const float y = -x; const float sp = y > 20.f ? y : __logf(1.f + __expf(y)); return -__expf(-sp - 0.5f); }
    __device__ __forceinline__ void operator()(int row, int col, f32x4 v0, f32x4 v1) const {
        const f32x4 b0 = *(const f32x4*)(w0 + col), b1 = *(const f32x4*)(w0 + col + 4);
        v0 += b0; v1 += b1;
        v0 = (f32x4){f(v0.x), f(v0.y), f(v0.z), f(v0.w)}; v1 = (f32x4){f(v1.x), f(v1.y), f(v1.z), f(v1.w)};
        bf16_t* dst = (col < 1024 ? D0 : D1) + (size_t)row * 1024 + (col & 1023);
        *(u32x4*)dst = pack8(v0, v1);
    }
};
struct OpAA {
    bf16_t *A0, *A1; const float* a0;
    __device__ __forceinline__ void operator()(int row, int col, f32x4 v0, f32x4 v1) const {
        const f32x4 b0 = *(const f32x4*)(a0 + col), b1 = *(const f32x4*)(a0 + col + 4);
        v0 = sig4(v0 + b0); v1 = sig4(v1 + b1);
        bf16_t* dst = (col < 1024 ? A0 : A1) + (size_t)row * 1024 + (col & 1023);
        *(u32x4*)dst = pack8(v0, v1);
    }
};
struct OpG {
    bf16_t* G;
    __device__ __forceinline__ void operator()(int row, int col, f32x4 v0, f32x4 v1) const { *(u32x4*)(G + (size_t)row * 1024 + col) = pack8(v0, v1); }
};
template <int KB> struct OpMerge {
    const bf16_t* GT; float* MF; bf16_t* MB;
    __device__ __forceinline__ void operator()(int row, int col, f32x4 v0, f32x4 v1) const {
        f32x4 g0, g1; unpack8(*(const u32x4*)(GT + (size_t)row * 3072 + KB * 1024 + col), g0, g1);
        float* mf = MF + (size_t)row * 1024 + col;
        f32x4 r0 = g0 * v0, r1 = g1 * v1;
        if (KB > 0) { r0 += *(const f32x4*)mf; r1 += *(const f32x4*)(mf + 4); }
        if (KB < 2) { *(f32x4*)mf = r0; *(f32x4*)(mf + 4) = r1; }
        else *(u32x4*)(MB + (size_t)row * 1024 + col) = pack8(r0, r1);
    }
};
struct OpResid {
    const float *xl, *xc; float *ol, *oc; const float* mod; int gi;
    __device__ __forceinline__ void operator()(int row, int col, f32x4 v0, f32x4 v1) const {
        const float* xi; float* xo; const float* g;
        if (row < ML) { xi = xl + (size_t)row * 1024 + col; xo = ol + (size_t)row * 1024 + col; g = mod + (size_t)(row >> 11) * 6144 + gi * 1024 + col; }
        else { const size_t rr = (size_t)(row - ML) * 1024 + col; xi = xc + rr; xo = oc + rr; g = mod + (size_t)8 * 6144 + gi * 1024 + col; }
        const f32x4 x0 = *(const f32x4*)xi, x1 = *(const f32x4*)(xi + 4), g0 = *(const f32x4*)g, g1 = *(const f32x4*)(g + 4);
        *(f32x4*)xo = x0 + g0 * v0; *(f32x4*)(xo + 4) = x1 + g1 * v1;
    }
};
struct OpSwiglu {
    bf16_t* HID;
    __device__ __forceinline__ void operator()(int row, int col, f32x4 v0, f32x4 v1) const {
        const float h0 = v0.x * sigmoidf_(v0.x) * v0.y, h1 = v0.z * sigmoidf_(v0.z) * v0.w, h2 = v1.x * sigmoidf_(v1.x) * v1.y, h3 = v1.z * sigmoidf_(v1.z) * v1.w;
        u32x2 o; o.x = pkbf(h0, h1); o.y = pkbf(h2, h3);
        *(u32x2*)(HID + (size_t)row * DFF + (col >> 1)) = o;
    }
};
template <class Op> __device__ __forceinline__ void run_gemm(const TI ti, unsigned char* lds, const bf16_t* A, const bf16_t* Bt, int Mr, int N, int K, const Op& op) {
    int Kv = K; asm volatile("" : "+s"(Kv));
    pg8::Gemm g{A, Bt, Mr, N, Kv}; pg8::StaticOrder S; S.init(Mr, N, ti.nblk, ti.bid);
    EpiT<Op> E{op};
    pg8::gemm_phase<EpiT<Op>, pg8::StaticOrder, true, true>((PG8_LAS unsigned char*)lds, g, S, E, ti.tid);
}

__device__ __forceinline__ void ph_mods(const TI ti, CArgs& a, unsigned char* ldsg) {
    float* sc = (float*)ldsg; float* part = sc + 9 * 1024;
    const int tid = ti.tid, lane = tid & 63, w = tid >> 6;
    for (int i = tid; i < 9 * 1024; i += 512) { const float v = (i < 8192) ? a.in[1][i] : a.in[3][i - 8192]; sc[i] = v / (1.f + expf(-v)); }
    __syncthreads();
    float* MOD = (float*)(a.ws + WS_MOD);
    for (int item = ti.bid; item < DEPTH * 96; item += ti.nblk) {
        const int l = item / 96, n0 = (item % 96) * 64;
        const float* W = a.in[4] + (size_t)l * 1024 * 6144 + n0 + lane;
        float acc[9];
#pragma unroll
        for (int r = 0; r < 9; ++r) acc[r] = 0.f;
#pragma unroll 8
        for (int k = w * 128; k < w * 128 + 128; ++k) {
            const float wv = W[(size_t)k * 6144];
#pragma unroll
            for (int r = 0; r < 9; ++r) acc[r] += sc[r * 1024 + k] * wv;
        }
#pragma unroll
        for (int r = 0; r < 9; ++r) part[(w * 9 + r) * 64 + lane] = acc[r];
        __syncthreads();
        for (int idx = tid; idx < 576; idx += 512) {
            const int r = idx >> 6, ln = idx & 63; float s = a.in[5][l * 6144 + n0 + ln];
            for (int ww = 0; ww < 8; ++ww) s += part[(ww * 9 + r) * 64 + ln];
            MOD[((size_t)l * 9 + r) * 6144 + n0 + ln] = s;
        }
        __syncthreads();
    }
    float* RC = (float*)(a.ws + WS_ROPE); float* RS = RC + 2048 * 32;
    for (int idx = ti.bid * 512 + tid; idx < 2048 * 32; idx += ti.nblk * 512) {
        const int t = idx >> 5, i = idx & 31; const float pos = i < 16 ? (float)(t >> 6) : (float)(t & 63);
        const float ang = pos * exp2f(-(float)(i & 15) * (13.287712379549449f / 16.f));
        RC[idx] = cosf(ang); RS[idx] = sinf(ang);
    }
}

__device__ __forceinline__ void norm_rows(const float* xl, const float* xc, const float* g, const float* modl, int shi, int sci, bf16_t* H, int nrows, int gw, int ngw, int lane) {
    for (int row = gw; row < nrows; row += ngw) {
        const float* src; int r;
        if (row < ML) { src = xl + (size_t)row * D; r = row >> 11; } else { src = xc + (size_t)(row - ML) * D; r = 8; }
        const float* md = modl + (size_t)r * 6144;
        f32x4 v[4]; float ss = 0.f;
#pragma unroll
        for (int j = 0; j < 4; ++j) { v[j] = *(const f32x4*)(src + 4 * lane + 256 * j); ss += (v[j].x * v[j].x + v[j].y * v[j].y) + (v[j].z * v[j].z + v[j].w * v[j].w); }
        ss = wave_sum(ss);
        const float rstd = rsqrtf(ss * (1.f / 1024.f) + 1e-6f);
#pragma unroll
        for (int j = 0; j < 4; ++j) {
            const int c = 4 * lane + 256 * j;
            const f32x4 gg = *(const f32x4*)(g + c), scv = *(const f32x4*)(md + sci * 1024 + c), shv = *(const f32x4*)(md + shi * 1024 + c);
            const f32x4 o = v[j] * rstd * gg * (1.f + scv) + shv;
            u32x2 p; p.x = pkbf(o.x, o.y); p.y = pkbf(o.z, o.w);
            *(u32x2*)(H + (size_t)row * D + c) = p;
        }
    }
}

template <int MODE> __device__ __forceinline__ void transpose_item(const float* W, int K, int N, bf16_t* WT, LAS float* scr, int item, int lane) {
    const int nblk = N / 32, kb = item / nblk, nb = item % nblk, k0 = 64 * kb, n0 = 32 * nb;
#pragma unroll 8
    for (int i = 0; i < 32; ++i) { const int kk = 2 * i + (lane >> 5); scr[kk * 33 + (lane & 31)] = W[(size_t)(k0 + kk) * N + n0 + (lane & 31)]; }
    asm volatile("s_waitcnt lgkmcnt(0)" ::: "memory");
    const int c = lane & 7;
#pragma unroll
    for (int j = 0; j < 4; ++j) {
        const int n = (lane >> 3) + 8 * j, gn = n0 + n; const LAS float* s = scr + (8 * c) * 33 + n;
        const int drow = MODE == 0 ? gn : (MODE == 1 ? (gn >= 8608 ? gn + 96 : gn) : (gn < DFF ? 2 * gn : 2 * (gn - DFF) + 1));
        u32x4 o; o.x = pkbf(s[0 * 33], s[1 * 33]); o.y = pkbf(s[2 * 33], s[3 * 33]); o.z = pkbf(s[4 * 33], s[5 * 33]); o.w = pkbf(s[6 * 33], s[7 * 33]);
        *(u32x4*)(WT + (size_t)drow * K + k0 + 8 * c) = o;
    }
    asm volatile("s_waitcnt lgkmcnt(0)" ::: "memory");
}
__device__ __forceinline__ void ph_wconv(CArgs& a, int l, unsigned char* ldsg, int gw, int ngw, int lane, int wv) {
    LAS float* scr = (LAS float*)(ldsg + wv * 8704);
    unsigned char* ws = a.ws;
    constexpr int I_IN = 16 * 365, I_SQ = 16 * 32, I_WI = 16 * 176, I_WO = 44 * 32, NIT = I_IN + 4 * I_SQ + I_WI + I_WO;
    for (int it = gw; it < NIT; it += ngw) {
        int r = it;
        if (r < I_IN) { transpose_item<1>(a.in[8] + (size_t)l * 1024 * 11680, 1024, 11680, (bf16_t*)(ws + WS_WIN), scr, r, lane); continue; } r -= I_IN;
        if (r < I_SQ) { transpose_item<0>(a.in[27] + (size_t)l * 1048576, 1024, 1024, (bf16_t*)(ws + WS_WA), scr, r, lane); continue; } r -= I_SQ;
        if (r < I_SQ) { transpose_item<0>(a.in[28] + (size_t)l * 1048576, 1024, 1024, (bf16_t*)(ws + WS_WB), scr, r, lane); continue; } r -= I_SQ;
        if (r < I_SQ) { transpose_item<0>(a.in[29] + (size_t)l * 1048576, 1024, 1024, (bf16_t*)(ws + WS_WC), scr, r, lane); continue; } r -= I_SQ;
        if (r < I_SQ) { transpose_item<0>(a.in[30] + (size_t)l * 1048576, 1024, 1024, (bf16_t*)(ws + WS_WO), scr, r, lane); continue; } r -= I_SQ;
        if (r < I_WI) { transpose_item<2>(a.in[31] + (size_t)l * 1024 * 5632, 1024, 5632, (bf16_t*)(ws + WS_WI), scr, r, lane); continue; } r -= I_WI;
        transpose_item<0>(a.in[32] + (size_t)l * DFF * 1024, DFF, 1024, (bf16_t*)(ws + WS_WO2), scr, r, lane);
    }
    const int gt = gw * 64 + lane, ngt = ngw * 64;
    bf16_t* LWT = (bf16_t*)(ws + WS_LWT); bf16_t* LAT = (bf16_t*)(ws + WS_LAT); bf16_t* LGT = (bf16_t*)(ws + WS_LGT);
    const float* w2 = a.in[18] + (size_t)l * 2 * 64 * 1024; const float* a2 = a.in[20] + (size_t)l * 2 * 64 * 1024; const float* g2 = a.in[21] + (size_t)l * 160 * 1024;
    for (int i = gt; i < 2048 * 128; i += ngt) {
        const int n = i >> 7, k = i & 127, d = n >> 10, c = n & 1023, kk = k - d * 64;
        const bool in = (kk >= 0 && kk < 64);
        LWT[i] = in ? f2bf(w2[((size_t)d * 64 + kk) * 1024 + c]) : (bf16_t)0;
        LAT[i] = in ? f2bf(a2[((size_t)d * 64 + kk) * 1024 + c]) : (bf16_t)0;
    }
    for (int i = gt; i < 1024 * 256; i += ngt) { const int n = i >> 8, k = i & 255; LGT[i] = k < 160 ? f2bf(g2[(size_t)k * 1024 + n]) : (bf16_t)0; }
    bf16_t* WIN = (bf16_t*)(ws + WS_WIN);
    for (int i = gt; i < 96 * 1024; i += ngt) WIN[(size_t)8608 * 1024 + i] = 0;
}

__device__ __forceinline__ void gmlp_unit(const TI ti, CArgs& a, int l, int u, unsigned char* ldsg) {
    float* rstd = (float*)ldsg; bf16_t* VNT = (bf16_t*)(ldsg + 512);
    const int tid = ti.tid, lane = tid & 63, w = tid >> 6, r = lane & 31, h = lane >> 5;
    bf16_t* GU = (bf16_t*)(a.ws + WS_GU); const bf16_t* GV = (const bf16_t*)(a.ws + WS_GV);
    const size_t R0 = (size_t)u * 128;
#pragma unroll 4
    for (int i = 0; i < 16; ++i) {
        const int tok = w * 16 + i; const bf16_t* p = GV + (R0 + tok) * 1024 + lane * 16;
        f32x4 x0, x1, x2, x3; unpack8(*(const u32x4*)p, x0, x1); unpack8(*(const u32x4*)(p + 8), x2, x3);
        float ss = (x0.x * x0.x + x0.y * x0.y + x0.z * x0.z + x0.w * x0.w) + (x1.x * x1.x + x1.y * x1.y + x1.z * x1.z + x1.w * x1.w)
                 + (x2.x * x2.x + x2.y * x2.y + x2.z * x2.z + x2.w * x2.w) + (x3.x * x3.x + x3.y * x3.y + x3.z * x3.z + x3.w * x3.w);
        ss = wave_sum(ss);
        if (lane == 0) rstd[tok] = rsqrtf(ss * (1.f / 1024.f) + 1e-6f);
    }
    __syncthreads();
    const float* gvg = a.in[9] + l * 1024; const float* wsp = a.in[10] + (size_t)l * 8 * 128 * 128; const float* bsp = a.in[11] + l * 8 * 128;
    const int tt = w & 3, chh = w >> 2;
    for (int g = 0; g < 8; ++g) {
        {
            const int s = tid & 127, cc = tid >> 7; const float rs = rstd[s]; const bf16_t* p = GV + (R0 + s) * 1024 + g * 128 + cc * 32;
#pragma unroll
            for (int q = 0; q < 4; ++q) {
                f32x4 x0, x1; unpack8(*(const u32x4*)(p + 8 * q), x0, x1);
                const float* gp = gvg + g * 128 + cc * 32 + 8 * q; const int c0 = cc * 32 + 8 * q;
                VNT[(c0 + 0) * 136 + s] = f2bf(x0.x * rs * gp[0]); VNT[(c0 + 1) * 136 + s] = f2bf(x0.y * rs * gp[1]);
                VNT[(c0 + 2) * 136 + s] = f2bf(x0.z * rs * gp[2]); VNT[(c0 + 3) * 136 + s] = f2bf(x0.w * rs * gp[3]);
                VNT[(c0 + 4) * 136 + s] = f2bf(x1.x * rs * gp[4]); VNT[(c0 + 5) * 136 + s] = f2bf(x1.y * rs * gp[5]);
                VNT[(c0 + 6) * 136 + s] = f2bf(x1.z * rs * gp[6]); VNT[(c0 + 7) * 136 + s] = f2bf(x1.w * rs * gp[7]);
            }
        }
        __syncthreads();
        f32x16 acc0, acc1;
#pragma unroll
        for (int i = 0; i < 16; ++i) { acc0[i] = 0.f; acc1[i] = 0.f; }
        const float* wrow = wsp + ((size_t)g * 128 + tt * 32 + r) * 128;
#pragma unroll
        for (int ks = 0; ks < 8; ++ks) {
            const f32x4 a0 = *(const f32x4*)(wrow + 16 * ks + 8 * h), a1 = *(const f32x4*)(wrow + 16 * ks + 8 * h + 4);
            const bf16x8 af = __builtin_bit_cast(bf16x8, pack8(a0, a1));
            const bf16x8 b0 = *(const bf16x8*)(VNT + (chh * 64 + r) * 136 + 16 * ks + 8 * h);
            const bf16x8 b1 = *(const bf16x8*)(VNT + (chh * 64 + 32 + r) * 136 + 16 * ks + 8 * h);
            acc0 = MFMA32(af, b0, acc0); acc1 = MFMA32(af, b1, acc1);
        }
        {
            const bf16_t* GUr = GU; float uu0[16], uu1[16], bb[16];
#pragma unroll
            for (int reg = 0; reg < 16; ++reg) {
                const int t = tt * 32 + (reg & 3) + 8 * (reg >> 2) + 4 * h; const size_t i0 = (R0 + t) * 1024 + g * 128 + chh * 64 + r;
                bb[reg] = bsp[g * 128 + t]; uu0[reg] = bf2f(GUr[i0]); uu1[reg] = bf2f(GUr[i0 + 32]);
            }
            asm volatile("" ::: "memory");
#pragma unroll
            for (int reg = 0; reg < 16; ++reg) {
                const int t = tt * 32 + (reg & 3) + 8 * (reg >> 2) + 4 * h; const size_t i0 = (R0 + t) * 1024 + g * 128 + chh * 64 + r;
                GU[i0] = f2bf(uu0[reg] * (acc0[reg] + bb[reg])); GU[i0 + 32] = f2bf(uu1[reg] * (acc1[reg] + bb[reg]));
            }
        }
        __syncthreads();
    }
}
__device__ __forceinline__ void qk_rows(CArgs& a, int l, int gw, int ngw, int lane) {
    bf16_t* Q = (bf16_t*)(a.ws + WS_Q); bf16_t* K = (bf16_t*)(a.ws + WS_K);
    const float* RC = (const float*)(a.ws + WS_ROPE); const float* RS = RC + 2048 * 32;
    const int part = lane & 3;
    float gq[16], gk[16];
    load16f(a.in[12] + l * 64 + 16 * part, gq); load16f(a.in[13] + l * 64 + 16 * part, gk);
    for (int row = gw; row < M; row += ngw) {
        float xq[16], xk[16], cs[16], sn[16];
        unpack16(Q + (size_t)row * 1024 + 16 * lane, xq); unpack16(K + (size_t)row * 1024 + 16 * lane, xk);
        const bool lat = row < ML;
        if (lat) { const int t = row & 2047; load16f(RC + t * 32 + 16 * (part & 1), cs); load16f(RS + t * 32 + 16 * (part & 1), sn); }
        float sq = 0.f, sk = 0.f;
#pragma unroll
        for (int j = 0; j < 16; ++j) { sq += xq[j] * xq[j]; sk += xk[j] * xk[j]; }
        const float rq = rsqrtf(quad_sum(sq) * (1.f / 64.f) + 1e-6f), rk = rsqrtf(quad_sum(sk) * (1.f / 64.f) + 1e-6f);
#pragma unroll
        for (int j = 0; j < 16; ++j) { xq[j] = xq[j] * rq * gq[j]; xk[j] = xk[j] * rk * gk[j]; }
        if (lat) {
            const float sgn = part < 2 ? -1.f : 1.f;
#pragma unroll
            for (int j = 0; j < 16; ++j) {
                const float pq = quad_xor2(xq[j]), pk = quad_xor2(xk[j]);
                xq[j] = xq[j] * cs[j] + sgn * pq * sn[j]; xk[j] = xk[j] * cs[j] + sgn * pk * sn[j];
            }
        }
#pragma unroll
        for (int j = 0; j < 16; ++j) xq[j] *= QSCALE;
        pack16(Q + (size_t)row * 1024 + 16 * lane, xq); pack16(K + (size_t)row * 1024 + 16 * lane, xk);
    }
}
__device__ __forceinline__ void lora_in_rows(CArgs& a, int l, int gw, int ngw, int lane) {
    const bf16_t* RW = (const bf16_t*)(a.ws + WS_RW); bf16_t* LW = (bf16_t*)(a.ws + WS_LIW); bf16_t* LA = (bf16_t*)(a.ws + WS_LIA); bf16_t* LG = (bf16_t*)(a.ws + WS_LIG);
    const float* mu = a.in[16] + l * 3488 + 3072;
    f32x4 m0 = {0.f, 0.f, 0.f, 0.f}, m1 = m0;
    if (lane < 52) { m0 = *(const f32x4*)(mu + 8 * lane); m1 = *(const f32x4*)(mu + 8 * lane + 4); }
    for (int row = gw; row < M; row += ngw) {
        int t, Tn; if (row < ML) { t = row & 2047; Tn = 2048; } else { t = (row - ML) & 255; Tn = 256; }
        const bool hp = t > 0, hn = t < Tn - 1;
        if (lane < 52) {
            const bf16_t* p = RW + (size_t)row * RWP + 3072 + 8 * lane;
            f32x4 x0, x1, p0 = {0.f, 0.f, 0.f, 0.f}, p1 = p0, n0 = p0, n1 = p0;
            unpack8(*(const u32x4*)p, x0, x1);
            if (hp) unpack8(*(const u32x4*)(p - RWP), p0, p1);
            if (hn) unpack8(*(const u32x4*)(p + RWP), n0, n1);
            f32x4 z0 = x0 + m0 * (0.5f * (p0 + n0) - x0), z1 = x1 + m1 * (0.5f * (p1 + n1) - x1);
            const int j = 8 * lane;
            if (j < 128) { z0 = (f32x4){tanhf(z0.x), tanhf(z0.y), tanhf(z0.z), tanhf(z0.w)}; z1 = (f32x4){tanhf(z1.x), tanhf(z1.y), tanhf(z1.z), tanhf(z1.w)}; *(u32x4*)(LW + (size_t)row * 128 + j) = pack8(z0, z1); }
            else if (j < 256) { *(u32x4*)(LA + (size_t)row * 128 + j - 128) = pack8(z0, z1); }
            else { *(u32x4*)(LG + (size_t)row * 256 + j - 256) = pack8(sig4(z0), sig4(z1)); }
        } else {
            unsigned z_ = 0u; asm volatile("" : "+v"(z_)); *(u32x4*)(LG + (size_t)row * 256 + 160 + (lane - 52) * 8) = (u32x4){z_, z_, z_, z_};
        }
    }
}

__device__ __forceinline__ void scan_unit(const TI ti, CArgs& a, int l, int u, bool ctx_out, unsigned char* ldsg) {
    const int tid = ti.tid, lane = tid & 63, w = tid >> 6;
    const int b = u >> 5, hh = (u >> 1) & 15, d = u & 1;
    const int si = tid >> 3, jq = tid & 7;
    LAS float* L = (LAS float*)ldsg;
    const bf16_t* RW = (const bf16_t*)(a.ws + WS_RW);
    const bf16_t* DEC = (const bf16_t*)(a.ws + (d ? WS_DEC1 : WS_GV));
    const bf16_t* AA = (const bf16_t*)(a.ws + (d ? WS_AA1 : WS_AA0));
    bf16_t* Y = (bf16_t*)(a.ws + (d ? WS_Y1 : WS_H));
    const int ch = hh * 64 + lane;
    const float* mu = a.in[16] + l * 3488;
    const float mur = mu[ch], muk = mu[1024 + ch], muv = mu[2048 + ch], kkg = a.in[22][l * 1024 + ch], kag = a.in[23][l * 1024 + ch];
    f32x4 S0 = {0.f, 0.f, 0.f, 0.f}, S1 = {0.f, 0.f, 0.f, 0.f};
    unsigned raw[4][9]; unsigned dcr[4], aar[4];
    constexpr int NC = 72;
#define SCAN_CHUNK(n, base, Tn, t0, wy) int base, Tn, t0; bool wy; { int ci; if ((n) < 8) { base = ML + b * 256; Tn = 256; ci = d ? 7 - (n) : (n); wy = ctx_out; } else { base = b * 2048; Tn = 2048; ci = d ? 71 - (n) : (n) - 8; wy = true; } t0 = ci * 32; }
#define SCAN_LOAD(n) do { SCAN_CHUNK(n, base_, Tn_, t0_, wy_); (void)wy_; _Pragma("unroll") for (int i4 = 0; i4 < 4; ++i4) { const int t = t0_ + w + 8 * i4; const size_t row = (size_t)(base_ + t); \
        const bf16_t* p = RW + row * RWP + ch; const bool hp = t > 0, hn = t < Tn_ - 1; \
        const int op_ = hp ? -RWP : 0, on_ = hn ? RWP : 0;     \
        _Pragma("unroll") for (int X = 0; X < 3; ++X) { raw[i4][3 * X + 0] = (unsigned)p[X * 1024 + op_]; raw[i4][3 * X + 1] = (unsigned)p[X * 1024]; raw[i4][3 * X + 2] = (unsigned)p[X * 1024 + on_]; } \
        dcr[i4] = (unsigned)DEC[row * 1024 + ch]; aar[i4] = (unsigned)AA[row * 1024 + ch]; } } while (0)
#define SCAN_STORE(n) do { LAS float* Bf = L + ((n) & 1) * 12288; SCAN_CHUNK(n, base_, Tn_, t0_, wy_); (void)wy_; (void)base_; _Pragma("unroll") for (int i4 = 0; i4 < 4; ++i4) { const int tk = w + 8 * i4; \
        const float mp_ = (t0_ + tk > 0) ? 0.5f : 0.f, mn_ = (t0_ + tk < Tn_ - 1) ? 0.5f : 0.f; \
        const float xr = bf2f(raw[i4][1]), xk = bf2f(raw[i4][4]), xv = bf2f(raw[i4][7]); \
        const float zr = xr + mur * ((mp_ * bf2f(raw[i4][0]) + mn_ * bf2f(raw[i4][2])) - xr); \
        const float zk = xk + muk * ((mp_ * bf2f(raw[i4][3]) + mn_ * bf2f(raw[i4][5])) - xk); \
        const float zv = xv + muv * ((mp_ * bf2f(raw[i4][6]) + mn_ * bf2f(raw[i4][8])) - xv); \
        const float kkv = zk * kkg; const float ssq = wave_sum(kkv * kkv); const float kkn = kkv / fmaxf(sqrtf(ssq), 1e-12f); \
        const float ad = bf2f(aar[i4]); const float wv_ = __expf(bf2f(dcr[i4])); const float kd = zk * (1.f + (ad - 1.f) * kag); \
        Bf[0 * 2048 + tk * 64 + lane] = wv_; Bf[1 * 2048 + tk * 64 + lane] = kd; Bf[2 * 2048 + tk * 64 + lane] = -kkn; \
        Bf[3 * 2048 + tk * 64 + lane] = kkn * ad; Bf[4 * 2048 + tk * 64 + lane] = zr; Bf[5 * 2048 + tk * 64 + lane] = zv; } } while (0)
    SCAN_LOAD(0); SCAN_STORE(0);
    __syncthreads();
    for (int n = 0; n < NC; ++n) {
        if (n + 1 < NC) SCAN_LOAD(n + 1);
        LAS const float* Bf = L + (n & 1) * 12288; LAS float* Yb = L + 24576 + (n & 1) * 2048;
#define STEP_LOAD(P, sidx) LAS const float* q##P = Bf + (sidx) * 64 + 8 * jq + hoff; \
            const f32x4 w0##P = *(LAS const f32x4*)(q##P), w1##P = *(LAS const f32x4*)(q##P + hdq), k0##P = *(LAS const f32x4*)(q##P + 2048), k1##P = *(LAS const f32x4*)(q##P + 2048 + hdq), \
                        a0##P = *(LAS const f32x4*)(q##P + 4096), a1##P = *(LAS const f32x4*)(q##P + 4096 + hdq), b0##P = *(LAS const f32x4*)(q##P + 6144), b1##P = *(LAS const f32x4*)(q##P + 6144 + hdq), \
                        r0##P = *(LAS const f32x4*)(q##P + 8192), r1##P = *(LAS const f32x4*)(q##P + 8192 + hdq); const float vi##P = Bf[5 * 2048 + (sidx) * 64 + si];
#define STEP_MATH(P, sidx) { const f32x4 ta = S0 * a0##P + S1 * a1##P; const float sa = dpp_sum8((ta.x + ta.y) + (ta.z + ta.w)); \
            S0 = S0 * w0##P + (sa * b0##P + vi##P * k0##P); S1 = S1 * w1##P + (sa * b1##P + vi##P * k1##P); \
            const f32x4 ty = S0 * r0##P + S1 * r1##P; const float y = dpp_sum8((ty.x + ty.y) + (ty.z + ty.w)); if (jq == 0) Yb[(sidx) * 64 + si] = y; }
        const int hoff = (si & 1) * 4, hdq = 4 - 2 * hoff;
        const int sdir = d ? -1 : 1; int sc = d ? 31 : 0;
        f32x4 cw0, cw1, ck0, ck1, ca0, ca1, cb0, cb1, cr0, cr1; float cvi;
        { STEP_LOAD(X, sc); cw0 = w0X; cw1 = w1X; ck0 = k0X; ck1 = k1X; ca0 = a0X; ca1 = a1X; cb0 = b0X; cb1 = b1X; cr0 = r0X; cr1 = r1X; cvi = viX; }
        for (int ss = 0; ss < 32; ss += 2) {
            const int s0i = sc, s1i = sc + sdir; int s2i = sc + 2 * sdir; s2i = (ss + 2 < 32) ? s2i : s1i;
            STEP_LOAD(B, s1i);
            { const f32x4 w0A = cw0, w1A = cw1, k0A = ck0, k1A = ck1, a0A = ca0, a1A = ca1, b0A = cb0, b1A = cb1, r0A = cr0, r1A = cr1; const float viA = cvi; STEP_MATH(A, s0i); }
            STEP_LOAD(C, s2i);
            STEP_MATH(B, s1i);
            cw0 = w0C; cw1 = w1C; ck0 = k0C; ck1 = k1C; ca0 = a0C; ca1 = a1C; cb0 = b0C; cb1 = b1C; cr0 = r0C; cr1 = r1C; cvi = viC;
            sc += 2 * sdir;
        }
#undef STEP_LOAD
#undef STEP_MATH
        if (n + 1 < NC) SCAN_STORE(n + 1);
        __syncthreads();
        {
            SCAN_CHUNK(n, base_, Tn_, t0_, wy_); (void)Tn_;
            if (wy_) {
#pragma unroll
                for (int i4 = 0; i4 < 4; ++i4) { const int tk = w + 8 * i4; Y[(size_t)(base_ + t0_ + tk) * 1024 + ch] = f2bf(Yb[tk * 64 + lane]); }
            }
        }
    }
    __syncthreads();
#undef SCAN_CHUNK
#undef SCAN_LOAD
#undef SCAN_STORE
}

__device__ __forceinline__ void attn_unit(const TI ti, CArgs& a, int b, int hd, int qrow0, int st_lo, int st_hi, float mfix, float lam, float lam_init, const float* subg, unsigned char* ldsg) {
    const int tid = ti.tid, lane = tid & 63, w = tid >> 6, r = lane & 31, h = lane >> 5, qt = w >> 1, c = w & 1;
    bf16_t* Qb = (bf16_t*)(a.ws + WS_Q); const bf16_t* Kb = (const bf16_t*)(a.ws + WS_K); const bf16_t* Vb = (const bf16_t*)(a.ws + WS_V);
    LAS unsigned char* L = (LAS unsigned char*)ldsg;
    constexpr int KOFF = 0, VOFF = 17408, BUFB = 35840;
    bf16x8 qf[4];
    { const bf16_t* qp = Qb + (size_t)(qrow0 + qt * 32 + r) * 1024 + hd * 128 + c * 64 + 8 * h;
#pragma unroll
      for (int ks = 0; ks < 4; ++ks) qf[ks] = *(const bf16x8*)(qp + 16 * ks); }
    f32x16 O[4];
#pragma unroll
    for (int e = 0; e < 4; ++e)
#pragma unroll
        for (int i = 0; i < 16; ++i) O[e][i] = 0.f;
    float lsum = 0.f;
    u32x4 kreg[2], vreg[2];
#define ATT_KROW(kk) ((kk) < 2048 ? (size_t)(b * 2048 + (kk)) : (size_t)(ML + b * 256 + (kk) - 2048))
#define ATT_LOAD(st) do { _Pragma("unroll") for (int i = 0; i < 2; ++i) { const int p = tid + 512 * i, key = p >> 4, dc = p & 15; kreg[i] = *(const u32x4*)(Kb + ATT_KROW((st) * 64 + key) * 1024 + hd * 128 + dc * 8); } \
        const bf16_t* vp = Vb + ATT_KROW((st) * 64 + lane) * 1024 + hd * 128 + w * 16; vreg[0] = *(const u32x4*)vp; vreg[1] = *(const u32x4*)(vp + 8); } while (0)
#define ATT_STORE(bufi) do { LAS unsigned char* Bb = L + (bufi) * BUFB; _Pragma("unroll") for (int i = 0; i < 2; ++i) { const int p = tid + 512 * i, key = p >> 4, dc = p & 15; *(LAS u32x4*)(Bb + KOFF + key * 272 + dc * 16) = kreg[i]; } \
        LAS bf16_t* vt = (LAS bf16_t*)(Bb + VOFF) + (w * 16) * 72 + lane; \
        _Pragma("unroll") for (int e = 0; e < 4; ++e) { vt[(2 * e) * 72] = (bf16_t)(vreg[0][e] & 0xffffu); vt[(2 * e + 1) * 72] = (bf16_t)(vreg[0][e] >> 16); \
            vt[(8 + 2 * e) * 72] = (bf16_t)(vreg[1][e] & 0xffffu); vt[(8 + 2 * e + 1) * 72] = (bf16_t)(vreg[1][e] >> 16); } } while (0)
    ATT_LOAD(st_lo); ATT_STORE(0);
    __syncthreads();
    for (int st = st_lo; st < st_hi; ++st) {
        const int bi = (st - st_lo) & 1;
        if (st + 1 < st_hi) ATT_LOAD(st + 1);
        LAS const unsigned char* Bb = L + bi * BUFB;
#pragma unroll
        for (int sub = 0; sub < 2; ++sub) {
            f32x16 Sx;
#pragma unroll
            for (int i = 0; i < 16; ++i) Sx[i] = 0.f;
#pragma unroll
            for (int ks = 0; ks < 4; ++ks) {
                const bf16x8 kf = *(LAS const bf16x8*)(Bb + KOFF + (sub * 32 + r) * 272 + (c * 64 + 16 * ks + 8 * h) * 2);
                Sx = MFMA32(kf, qf[ks], Sx);
            }
            float p[16];
#pragma unroll
            for (int i = 0; i < 16; ++i) { p[i] = __builtin_amdgcn_exp2f(Sx[i] - mfix); lsum += p[i]; }
            u32x4 pw0, pw1;
            pw0.x = pkbf(p[0], p[1]); pw0.y = pkbf(p[2], p[3]); pw0.z = pkbf(p[4], p[5]); pw0.w = pkbf(p[6], p[7]);
            pw1.x = pkbf(p[8], p[9]); pw1.y = pkbf(p[10], p[11]); pw1.z = pkbf(p[12], p[13]); pw1.w = pkbf(p[14], p[15]);
            const bf16x8 pb0 = __builtin_bit_cast(bf16x8, pw0), pb1 = __builtin_bit_cast(bf16x8, pw1);
#pragma unroll
            for (int et = 0; et < 4; ++et) {
#pragma unroll
                for (int s = 0; s < 2; ++s) {
                    LAS const unsigned char* va = Bb + VOFF + (et * 32 + r) * 144 + (sub * 32 + 16 * s + 4 * h) * 2;
                    const s16x4 lo = *(LAS const s16x4*)va, hi = *(LAS const s16x4*)(va + 16);
                    const bf16x8 vf = __builtin_shufflevector(lo, hi, 0, 1, 2, 3, 4, 5, 6, 7);
                    O[et] = MFMA32(vf, s ? pb1 : pb0, O[et]);
                }
            }
        }
        if (st + 1 < st_hi) ATT_STORE(bi ^ 1);
        __syncthreads();
    }
#undef ATT_KROW
#undef ATT_LOAD
#undef ATT_STORE
    const float ltot = lsum + __shfl_xor(lsum, 32);
    const float linv = 1.f / ltot;
    LAS float* X = (LAS float*)L + qt * 4096;
    if (c == 1) {
#pragma unroll
        for (int e = 0; e < 4; ++e)
#pragma unroll
            for (int i = 0; i < 16; ++i) X[(e * 16 + i) * 64 + lane] = O[e][i] * linv;
    }
    __syncthreads();
    if (c == 0) {
        float ssq = 0.f;
#pragma unroll
        for (int e = 0; e < 4; ++e)
#pragma unroll
            for (int i = 0; i < 16; ++i) { const float o = O[e][i] * linv - lam * X[(e * 16 + i) * 64 + lane]; O[e][i] = o; ssq += o * o; }
        ssq += __shfl_xor(ssq, 32);
        const float sc = rsqrtf(ssq * (1.f / 128.f) + 1e-6f) * (1.f - lam_init);
        bf16_t* op = Qb + (size_t)(qrow0 + qt * 32 + r) * 1024 + hd * 128;
#pragma unroll
        for (int e = 0; e < 4; ++e)
#pragma unroll
            for (int g4 = 0; g4 < 4; ++g4) {
                const int e0 = e * 32 + 8 * g4 + 4 * h; const f32x4 sg = *(const f32x4*)(subg + e0);
                u32x2 o; o.x = pkbf(O[e][4 * g4 + 0] * sc * sg.x, O[e][4 * g4 + 1] * sc * sg.y); o.y = pkbf(O[e][4 * g4 + 2] * sc * sg.z, O[e][4 * g4 + 3] * sc * sg.w);
                *(u32x2*)(op + e0) = o;
            }
    }
    __syncthreads();
}
__device__ __forceinline__ void ph_attn(const TI ti, CArgs& a, int l, bool ctx_out, unsigned char* ldsg) {
    const int lane = ti.tid & 63;
    const float gqm = fabsf(a.in[12][l * 64 + lane]), gkm = fabsf(a.in[13][l * 64 + lane]);
    float mq = gqm, mk = gkm;
#pragma unroll
    for (int o = 1; o < 64; o <<= 1) { mq = fmaxf(mq, __shfl_xor(mq, o)); mk = fmaxf(mk, __shfl_xor(mk, o)); }
    const float mfix = 8.f * mq * mk * 1.4426950408889634f * 1.03f;
    const float* lp = a.in[14] + l * 256;
    const float s1 = wave_sum(lp[lane] * lp[64 + lane]), s2 = wave_sum(lp[128 + lane] * lp[192 + lane]);
    const float lam_init = 0.8f - 0.6f * expf(-0.3f * (float)l);
    const float lam = expf(s1) - expf(s2) + lam_init;
    const float* subg = a.in[15] + l * 128;
    const int nun = 1024 + (ctx_out ? 128 : 0);
    for (int u = ti.bid; u < nun; u += ti.nblk) {
        if (u < 1024) { const int bh = u >> 4, qb = u & 15; attn_unit(ti, a, bh >> 3, bh & 7, (bh >> 3) * 2048 + qb * 128, 0, 36, mfix, lam, lam_init, subg, ldsg); }
        else { const int v = u - 1024, bh = v >> 1, qb = v & 1; attn_unit(ti, a, bh >> 3, bh & 7, ML + (bh >> 3) * 256 + qb * 128, 32, 36, mfix, lam, lam_init, subg, ldsg); }
    }
}

__device__ __forceinline__ void up8(const bf16_t* p, float (&x)[8]) { const u32x4 v = *(const u32x4*)p;
#pragma unroll
    for (int i = 0; i < 4; ++i) { x[2 * i] = bf2f(v[i] & 0xffffu); x[2 * i + 1] = bf2f(v[i] >> 16); } }
__device__ __forceinline__ void ld8f(const float* p, float (&x)[8]) { const f32x4 u = *(const f32x4*)p, v = *(const f32x4*)(p + 4); x[0] = u.x; x[1] = u.y; x[2] = u.z; x[3] = u.w; x[4] = v.x; x[5] = v.y; x[6] = v.z; x[7] = v.w; }
__device__ __forceinline__ void shift8(const bf16_t* p, const float* mu, bool hp, bool hn, float (&z)[8]) {
    float x[8], xp[8], xn[8], m[8];
#pragma unroll
    for (int j = 0; j < 8; ++j) { xp[j] = 0.f; xn[j] = 0.f; }
    up8(p, x); if (hp) up8(p - RWP, xp); if (hn) up8(p + RWP, xn); ld8f(mu, m);
#pragma unroll
    for (int j = 0; j < 8; ++j) z[j] = x[j] + m[j] * (0.5f * (xp[j] + xn[j]) - x[j]);
}
__device__ __forceinline__ void rwkv_out_rows(CArgs& a, int l, int nrows, int gw, int ngw, int lane) {
    const bf16_t* RW = (const bf16_t*)(a.ws + WS_RW); const bf16_t* Y0 = (const bf16_t*)(a.ws + WS_H); bf16_t* Y1 = (bf16_t*)(a.ws + WS_Y1);
    const bf16_t* A0 = (const bf16_t*)(a.ws + WS_AA0); const bf16_t* A1 = (const bf16_t*)(a.ws + WS_AA1); const bf16_t* G = (const bf16_t*)(a.ws + WS_G);
    const float* mu = a.in[16] + l * 3488;
    for (int it = gw; it < 2 * nrows; it += ngw) {
        const int row = it >> 1, c0 = (it & 1) * 512 + 8 * lane;
        int t, Tn; if (row < ML) { t = row & 2047; Tn = 2048; } else { t = (row - ML) & 255; Tn = 256; }
        const bool hp = t > 0, hn = t < Tn - 1;
        const size_t idx = (size_t)row * 1024 + c0;
        float y[8], y1[8], g[8], a0[8], a1[8], zr[8], zk[8], zv[8], lnw[8], lnb[8], ka[8], rk[8];
        up8(Y0 + idx, y); up8(Y1 + idx, y1); up8(G + idx, g); up8(A0 + idx, a0); up8(A1 + idx, a1);
        const bf16_t* p = RW + (size_t)row * RWP + c0;
        shift8(p, mu + c0, hp, hn, zr); shift8(p + 1024, mu + 1024 + c0, hp, hn, zk); shift8(p + 2048, mu + 2048 + c0, hp, hn, zv);
        ld8f(a.in[25] + l * 1024 + c0, lnw); ld8f(a.in[26] + l * 1024 + c0, lnb); ld8f(a.in[23] + l * 1024 + c0, ka); ld8f(a.in[24] + l * 1024 + c0, rk);
        float sm = 0.f;
#pragma unroll
        for (int j = 0; j < 8; ++j) { y[j] += y1[j]; sm += y[j]; }
        const float mean = dpp_sum8(sm) * (1.f / 64.f);
        float sv = 0.f, sb = 0.f;
#pragma unroll
        for (int j = 0; j < 8; ++j) { y[j] -= mean; sv += y[j] * y[j]; const float kds = zk[j] * ((1.f + (a0[j] - 1.f) * ka[j]) + (1.f + (a1[j] - 1.f) * ka[j])); sb += zr[j] * kds * rk[j]; }
        const float rstd = rsqrtf(dpp_sum8(sv) * (1.f / 64.f) + 64e-5f), bsum = dpp_sum8(sb);
        u32x4 o;
#pragma unroll
        for (int j = 0; j < 4; ++j) o[j] = pkbf(((y[2 * j] * rstd * lnw[2 * j] + lnb[2 * j]) + bsum * zv[2 * j]) * g[2 * j], ((y[2 * j + 1] * rstd * lnw[2 * j + 1] + lnb[2 * j + 1]) + bsum * zv[2 * j + 1]) * g[2 * j + 1]);
        *(u32x4*)(Y1 + idx) = o;
    }
}

#define XB_TMO      128
#define XB_XCNT(j)  (256  + 64 * (j))
#define XB_XSUB(j)  (1280 + 64 * (j))
#define XB_XGEN(j)  (2304 + 64 * (j))
#define XB_TOP      3328
#define XB_TOPGEN   3392
#define XCD_BAR_WORDS 3456
#define XB_SPIN_CAP (1u << 20)

__device__ __forceinline__ unsigned xb_ld(unsigned* p)              { return __hip_atomic_load(p, __ATOMIC_RELAXED, __HIP_MEMORY_SCOPE_AGENT); }
__device__ __forceinline__ unsigned xb_add(unsigned* p, unsigned v) { return __hip_atomic_fetch_add(p, v, __ATOMIC_RELAXED, __HIP_MEMORY_SCOPE_AGENT); }
__device__ __forceinline__ unsigned xb_xcc_id() { return (unsigned)__builtin_amdgcn_s_getreg((3 << 11) | 20) & 0xFu; }
#define XB_SPIN(cond, bar) do { unsigned _sp = 0; while (cond) { __builtin_amdgcn_s_sleep(1); \
    if ((++_sp & 255u) == 0u) { if (xb_ld(&(bar)[XB_TMO])) break; if (_sp > XB_SPIN_CAP) { atomicAdd(&(bar)[XB_TMO], 1u); break; } } } } while (0)

struct XcdBarrier {
    unsigned* bar; unsigned x;
    volatile LAS unsigned* st;
};

__device__ __forceinline__ XcdBarrier xcd_barrier_post(unsigned* bar, volatile LAS unsigned* st) {
    XcdBarrier b; b.bar = bar; b.x = xb_xcc_id(); b.st = st;
    if (threadIdx.x == 0) (void)xb_add(&bar[XB_XCNT(b.x)], 1u);
    return b;
}
__device__ __forceinline__ void xcd_barrier_complete(unsigned* bar, unsigned x, unsigned& nloc, unsigned& nx) {
    const unsigned G = gridDim.x * gridDim.y * gridDim.z;
    unsigned sum, cnt, mine, sp = 0u;
    for (;;) {
        sum = 0u; cnt = 0u; mine = 0u;
#pragma unroll
        for (unsigned j = 0; j < 16; ++j) { const unsigned c = xb_ld(&bar[XB_XCNT(j)]); sum += c; cnt += (c > 0u) ? 1u : 0u; mine = (j == x) ? c : mine; }
        if (sum == G) break;
        __builtin_amdgcn_s_sleep(1);
        if ((++sp & 255u) == 0u) { if (xb_ld(&bar[XB_TMO])) break; if (sp > XB_SPIN_CAP) { atomicAdd(&bar[XB_TMO], 1u); break; } }
    }
    nloc = mine > 0u ? mine : 1u; nx = cnt > 0u ? cnt : 1u;
}

__device__ __forceinline__ void xcd_barrier(const XcdBarrier& b) {
    asm volatile("s_waitcnt vmcnt(0)" ::: "memory");
    __syncthreads();
    if (threadIdx.x == 0) {
        unsigned* bar = b.bar;
        __builtin_amdgcn_s_waitcnt(0);
        unsigned nloc = b.st[0], nx = b.st[1];
        if (nloc == 0u) { xcd_barrier_complete(bar, b.x, nloc, nx); b.st[0] = nloc; b.st[1] = nx; }
        const unsigned old = xb_add(&bar[XB_XSUB(b.x)], 1u);
        const unsigned gen = old / nloc;
        if (old + 1u == (gen + 1u) * nloc) {
            __builtin_amdgcn_fence(__ATOMIC_RELEASE, "agent");
            asm volatile("s_waitcnt vmcnt(0)" ::: "memory");
            const unsigned og = xb_add(&bar[XB_TOP], 1u);
            const unsigned tg = og / nx;
            if (og + 1u == (tg + 1u) * nx) xb_add(&bar[XB_TOPGEN], 1u);
            else XB_SPIN(xb_ld(&bar[XB_TOPGEN]) == tg, bar);
            __builtin_amdgcn_fence(__ATOMIC_ACQUIRE, "agent");
            xb_add(&bar[XB_XGEN(b.x)], 1u);
            asm volatile("s_waitcnt vmcnt(0)" ::: "memory");
        } else {
            XB_SPIN(xb_ld(&bar[XB_XGEN(b.x)]) == gen, bar);
            __builtin_amdgcn_fence(__ATOMIC_ACQUIRE, "agent");
            asm volatile("s_waitcnt vmcnt(0)" ::: "memory");
        }
    }
    __syncthreads();
}

#ifndef ONLY_PH
#define ONLY_PH -1
#endif
#ifndef SKIP_PH
#define SKIP_PH -2
#endif
#define PH_ON(k) ((ONLY_PH < 0 || ONLY_PH == (k)) && (k) != SKIP_PH)
__global__ void __launch_bounds__(512, 2) mega_fwd(Args a_) {
    extern __shared__ __attribute__((aligned(16))) unsigned char lds[];
    cg::grid_group grid = cg::this_grid();
    const int ph_lo = a_.lo, ph_hi = a_.hi;
    volatile LAS unsigned* bst = (volatile LAS unsigned*)((LAS unsigned char*)lds + 131072);
    if (threadIdx.x < 2) bst[threadIdx.x] = 0u;
    __syncthreads();
    const XcdBarrier xbar = xcd_barrier_post((unsigned*)(a_.ws + WS_BAR), bst);
    const int wave_s = __builtin_amdgcn_readfirstlane((int)threadIdx.x >> 6);
#pragma nounroll
    for (int ph = ph_lo; ph < ph_hi; ++ph) {
        CArgs* ap = (CArgs*)__builtin_amdgcn_kernarg_segment_ptr(); asm volatile("" : "+s"(ap));
        CArgs& a = *ap;
        unsigned char* ws = a.ws;
        float* XC = (float*)(ws + WS_XC);
        int wsv = wave_s; asm volatile("" : "+s"(wsv));
        TI ti; ti.tid = wsv * 64 + (int)__builtin_amdgcn_mbcnt_hi(~0u, __builtin_amdgcn_mbcnt_lo(~0u, 0u)); ti.bid = blockIdx.x; ti.nblk = gridDim.x;
        asm volatile("" : "+v"(ti.tid)); asm volatile("" : "+s"(ti.bid)); asm volatile("" : "+s"(ti.nblk));
        const int tid = ti.tid, lane = tid & 63, wv = __builtin_amdgcn_readfirstlane(tid >> 6);
        const int gw = ti.bid * 8 + wv, ngw = ti.nblk * 8;
        if (ph == 0) { if constexpr (PH_ON(100)) ph_mods(ti, a, lds); }
        else {
            const int l = (ph - 1) / NPH, k = (ph - 1) % NPH;
            const bool ctx_out = l < DEPTH - 1;
            const int Mr = ctx_out ? M : ML;
            const float* modl = (const float*)(ws + WS_MOD) + (size_t)l * 9 * 6144;
            const float* xl_in = l == 0 ? a.in[0] : a.out; const float* xc_in = l == 0 ? a.in[2] : XC;
            bf16_t* H = (bf16_t*)(ws + WS_H);
            switch (k) {
            case 0: if constexpr (PH_ON(0)) {
                norm_rows(xl_in, xc_in, a.in[6] + l * 1024, modl, 0, 1, H, M, gw, ngw, lane);
                ph_wconv(a, l, lds, gw, ngw, lane, wv);
                } break;
            case 1: if constexpr (PH_ON(1)) {
                OpIn op{(bf16_t*)(ws + WS_GU), (bf16_t*)(ws + WS_GV), (bf16_t*)(ws + WS_Q), (bf16_t*)(ws + WS_RW), (bf16_t*)(ws + WS_GT)};
                run_gemm(ti, lds, H, (const bf16_t*)(ws + WS_WIN), M, PPAD, 1024, op);
            } break;
            case 2: if constexpr (PH_ON(2)) {
                for (int u = ti.bid; u < Mr / 128; u += ti.nblk) gmlp_unit(ti, a, l, u, lds);
                qk_rows(a, l, gw, ngw, lane);
                lora_in_rows(a, l, gw, ngw, lane);
                } break;
            case 3: if constexpr (PH_ON(3)) {
                OpDec o1{(bf16_t*)(ws + WS_GV), (bf16_t*)(ws + WS_DEC1), a.in[17] + l * 2048};
                run_gemm(ti, lds, (const bf16_t*)(ws + WS_LIW), (const bf16_t*)(ws + WS_LWT), M, 2048, 128, o1);
                OpAA o2{(bf16_t*)(ws + WS_AA0), (bf16_t*)(ws + WS_AA1), a.in[19] + l * 2048};
                run_gemm(ti, lds, (const bf16_t*)(ws + WS_LIA), (const bf16_t*)(ws + WS_LAT), M, 2048, 128, o2);
                OpG o3{(bf16_t*)(ws + WS_G)};
                run_gemm(ti, lds, (const bf16_t*)(ws + WS_LIG), (const bf16_t*)(ws + WS_LGT), M, 1024, 256, o3);
            } break;
            case 4:
                if constexpr (PH_ON(4)) { for (int u = ti.bid; u < 256; u += ti.nblk) scan_unit(ti, a, l, u, ctx_out, lds); }
                if constexpr (PH_ON(40)) ph_attn(ti, a, l, ctx_out, lds);
                break;
            case 5: if constexpr (PH_ON(5)) {
                rwkv_out_rows(a, l, Mr, gw, ngw, lane);
                } break;
            case 6: if constexpr (PH_ON(6)) {
                const bf16_t* GT = (const bf16_t*)(ws + WS_GT); float* MF = (float*)(ws + WS_K);
                OpMerge<0> o0{GT, MF, H}; run_gemm(ti, lds, (const bf16_t*)(ws + WS_GU), (const bf16_t*)(ws + WS_WA), Mr, 1024, 1024, o0);
                OpMerge<1> o1{GT, MF, H}; run_gemm(ti, lds, (const bf16_t*)(ws + WS_Q), (const bf16_t*)(ws + WS_WB), Mr, 1024, 1024, o1);
                OpMerge<2> o2{GT, MF, H}; run_gemm(ti, lds, (const bf16_t*)(ws + WS_Y1), (const bf16_t*)(ws + WS_WC), Mr, 1024, 1024, o2);
            } break;
            case 7: if constexpr (PH_ON(7)) {
                OpResid op{xl_in, xc_in, a.out, XC, modl, 2};
                run_gemm(ti, lds, H, (const bf16_t*)(ws + WS_WO), Mr, 1024, 1024, op);
            } break;
            case 8: if constexpr (PH_ON(8)) {
                norm_rows(a.out, XC, a.in[7] + l * 1024, modl, 3, 4, H, Mr, gw, ngw, lane);
                } break;
            case 9: if constexpr (PH_ON(9)) {
                OpSwiglu op{(bf16_t*)(ws + WS_RW)};
                run_gemm(ti, lds, H, (const bf16_t*)(ws + WS_WI), Mr, 2 * DFF, 1024, op);
            } break;
            default: if constexpr (PH_ON(10)) {
                OpResid op{a.out, XC, a.out, XC, modl, 5};
                run_gemm(ti, lds, (const bf16_t*)(ws + WS_RW), (const bf16_t*)(ws + WS_WO2), Mr, 1024, DFF, op);
            } break;
            }
        }
        if (ph + 1 < ph_hi) { if (ph == ph_lo) grid.sync(); else xcd_barrier(xbar); }
    }
}

extern "C" void kernel_launch(void* const* d_in, const int* in_sizes, int n_in, void* d_out, int out_size, void* d_ws, size_t ws_size, hipStream_t stream) {
    static int grid = 0;
    if (grid == 0) {
        if (n_in != 33 || out_size != ML * D || ws_size < WS_END) { fprintf(stderr, "kernel_launch: unexpected shapes / workspace (%d inputs, out %d, ws %zu, need %zu)\n", n_in, out_size, ws_size, (size_t)WS_END); grid = -1; return; }
        int dev = 0, cus = 0, per_cu = 0;
        hipGetDevice(&dev); hipDeviceGetAttribute(&cus, hipDeviceAttributeMultiprocessorCount, dev);
        if (hipFuncSetAttribute((const void*)mega_fwd, hipFuncAttributeMaxDynamicSharedMemorySize, LDS_BYTES) != hipSuccess) { fprintf(stderr, "kernel_launch: hipFuncSetAttribute failed\n"); grid = -1; return; }
        if (hipOccupancyMaxActiveBlocksPerMultiprocessor(&per_cu, (const void*)mega_fwd, 512, LDS_BYTES) != hipSuccess || per_cu < 1) per_cu = 1;
        (void)hipGetLastError();
        grid = cus * 1;
    }
    if (grid < 0) return;
    Args a{};
    for (int i = 0; i < 33; ++i) a.in[i] = (const float*)d_in[i];
    a.out = (float*)d_out; a.ws = (unsigned char*)d_ws; a.lo = 0; a.hi = NPHASES;
    void* args[] = {&a};
    if (hipMemsetAsync((char*)d_ws + WS_BAR, 0, BAR_BYTES, stream) != hipSuccess) { fprintf(stderr, "kernel_launch: memset of barrier words failed\n"); return; }
    hipError_t e = hipLaunchCooperativeKernel((const void*)mega_fwd, dim3(grid), dim3(512), args, LDS_BYTES, stream);
    if (e != hipSuccess) fprintf(stderr, "kernel_launch: cooperative launch failed: %s (grid %d)\n", hipGetErrorString(e), grid);
}
```

```cpp
#include <hip/hip_runtime.h>
#include <hip/hip_cooperative_groups.h>
#include <cstdio>
#include <cstdint>
namespace cg = cooperative_groups;
namespace pg8 {
#define PG8_LAS __attribute__((address_space(3)))
typedef unsigned short bf16_t;
typedef short bf16x8 __attribute__((ext_vector_type(8)));
typedef float f32x4 __attribute__((ext_vector_type(4)));
typedef unsigned u32x4 __attribute__((ext_vector_type(4)));
constexpr int BM = 256, BK = 64, HALF = 128, HTB = HALF * BK * 2  , STAGE_BYTES = 8 * HTB, NXCD = 8, WGM = 8;

__host__ __device__ __forceinline__ int lds_byte(int r, int c) { const int st = (r >> 4) * 2 + (c >> 5), rr = r & 15, cc = c & 31, ob = rr * 64 + cc * 2; return st * 1024 + (ob ^ (((ob >> 9) & 1) << 5)); }
__host__ __device__ __forceinline__ void stage_rc(int b, int& R, int& C) { const int st = b / 1024, sb = b % 1024, swz = sb ^ (((sb >> 9) & 1) << 5); R = (st >> 1) * 16 + swz / 64; C = (st & 1) * 32 + (swz % 64) / 2; }
__host__ __device__ __forceinline__ int perm32(int rho) { const int n = rho >> 4, i = rho & 15; return 8 * (i >> 2) + 4 * n + (i & 3); }

struct Unit { int pm, pn; };
struct Gemm { const bf16_t* A; const bf16_t* Bt; int M, N, K; };

struct StaticOrder {
    int nM, nN, nwg, G, c;
    __host__ __device__ void init(int M, int N, int G_, int c_) { nM = M / BM; nN = N / BM; nwg = nM * nN; G = G_; c = c_; }
    __host__ __device__ bool next(int i, Unit& u) const {
        const long L = (long)i * G + c; if (L >= nwg) return false;
        int wgid = (int)L; { const int q = nwg / NXCD, r = nwg % NXCD, xcd = wgid % NXCD, off = wgid / NXCD; wgid = (xcd < r ? xcd * (q + 1) : r * (q + 1) + (xcd - r) * q) + off; }
        const int nig = WGM * nN, gid = wgid / nig, fm = gid * WGM, gsz = (nM - fm) < WGM ? (nM - fm) : WGM;
        u.pm = fm + ((wgid % nig) % gsz); u.pn = (wgid % nig) / gsz; return true;
    }
    __device__ __forceinline__ void a_ready(const Unit&) const {}
    __device__ __forceinline__ void done(const Unit&) const {}
};

__device__ __forceinline__ unsigned cvt_pk_bf16(float lo, float hi) { unsigned r; asm volatile("v_cvt_pk_bf16_f32 %0, %1, %2" : "=v"(r) : "v"(lo), "v"(hi)); return r; }
typedef float f32x2 __attribute__((ext_vector_type(2)));
__device__ __forceinline__ f32x2 gelu_pk(f32x2 v) {
    const f32x2 av = __builtin_elementwise_abs(v), d = av * 0.2316418882f + 1.0f;
    f32x2 t; t.x = __builtin_amdgcn_rcpf(d.x); t.y = __builtin_amdgcn_rcpf(d.y);
    f32x2 q = t * 0.5307027145f + (-0.7265760135f); q = q * t + 0.7107068705f; q = q * t + (-0.142248368f); q = q * t + 0.127414796f; q = q * t;
    const f32x2 s = (v * v) * (-0.72134752044f);
    f32x2 e; e.x = __builtin_amdgcn_exp2f(s.x); e.y = __builtin_amdgcn_exp2f(s.y);
    const f32x2 m = v * (q * e), r = v - m;
    f32x2 o; o.x = v.x < 0.f ? m.x : r.x; o.y = v.y < 0.f ? m.y : r.y; return o;
}

template <class Epi, class Sched, bool ALIGN_EPI = false, bool SP2 = false>
__device__ __forceinline__ void gemm_phase(PG8_LAS unsigned char* lds, const Gemm g, const Sched& S, const Epi& E, const int tid_in) {
    const int tid = tid_in, wid = __builtin_amdgcn_readfirstlane(tid >> 6), lane = tid & 63, wr = wid >> 2, wc = wid & 3, fr = lane & 15, fq = lane >> 4;
    const int K = g.K, nt = K / BK;
    unsigned voffA[2], voffB[2];
#pragma unroll
    for (int i = 0; i < 2; ++i) { int R, C; stage_rc(tid * 16 + i * 8192, R, C); const int Rb = Epi::PERM ? ((R & ~31) + perm32(R & 31)) : R;
        voffA[i] = (unsigned)(R * K + C) * 2u; voffB[i] = (unsigned)(Rb * K + C) * 2u; }
    const size_t kstep = (size_t)(BK * 2);
    const size_t hstep = (size_t)HALF * K * 2;
    const size_t tstep = 2 * hstep;
    const unsigned ldsw = (unsigned)wid * 1024u;
    const int aoff = lds_byte(wr * 64 + fr, fq * 8), boff = lds_byte(wc * 32 + fr, fq * 8);
#define PG8_SA(b, h) (((b) * 2 + (h)) * HTB)
#define PG8_SB(b, h) ((4 + (b) * 2 + (h)) * HTB)
#define PG8_STAGE(bufoff, gbase, voff) do { _Pragma("unroll") for (int _i = 0; _i < 2; ++_i) \
        __builtin_amdgcn_global_load_lds((const unsigned*)((const char*)(gbase) + (voff)[_i]), (PG8_LAS unsigned*)(lds + (bufoff) + ldsw + _i * 8192), 16, 0, 0); } while (0)
#define PG8_LDA(dst, b, h) do { _Pragma("unroll") for (int m = 0; m < 4; ++m) _Pragma("unroll") for (int k = 0; k < 2; ++k) dst[m][k] = *(const PG8_LAS bf16x8*)(lds + PG8_SA(b, h) + aoff + m * 2048 + k * 1024); } while (0)
#define PG8_LDB(dst, b, h) do { _Pragma("unroll") for (int n = 0; n < 2; ++n) _Pragma("unroll") for (int k = 0; k < 2; ++k) dst[n][k] = *(const PG8_LAS bf16x8*)(lds + PG8_SB(b, h) + boff + n * 2048 + k * 1024); } while (0)
#define PG8_MMA(ai, bj, At, Bt) do { __builtin_amdgcn_s_setprio(1); _Pragma("unroll") for (int m = 0; m < 4; ++m) _Pragma("unroll") for (int n = 0; n < 2; ++n) _Pragma("unroll") for (int k = 0; k < 2; ++k) \
        acc[ai][bj][m][n] = __builtin_amdgcn_mfma_f32_16x16x32_bf16(Bt[n][k], At[m][k], acc[ai][bj][m][n], 0, 0, 0); __builtin_amdgcn_s_setprio(0); } while (0)
#define PG8_WAIT_V(n) asm volatile("s_waitcnt vmcnt(" #n ")" ::: "memory")
#define PG8_WAIT_L(n) asm volatile("s_waitcnt lgkmcnt(" #n ")" ::: "memory")
#define PG8_BAR __builtin_amdgcn_s_barrier()
#define PG8_SCHED __builtin_amdgcn_sched_barrier(0)
    Unit cur, nxt; int ui = 0;
    if (!S.next(0, cur)) return;
    f32x4 acc[2][2][4][2];
#pragma unroll
    for (int a = 0; a < 2; ++a)
#pragma unroll
        for (int b = 0; b < 2; ++b)
#pragma unroll
            for (int m = 0; m < 4; ++m)
#pragma unroll
                for (int n = 0; n < 2; ++n) acc[a][b][m][n] = (f32x4){0.f, 0.f, 0.f, 0.f};
    bf16x8 At[4][2], B0[2][2], B1[2][2];
    const char* cA = (const char*)g.A + (size_t)cur.pm * tstep; const char* cB = (const char*)g.Bt + (size_t)cur.pn * tstep;
    S.a_ready(cur);
    if constexpr (SP2) {
        PG8_STAGE(PG8_SB(0, 0), cB, voffB); PG8_STAGE(PG8_SB(0, 1), cB + hstep, voffB); PG8_STAGE(PG8_SA(0, 0), cA, voffA); PG8_STAGE(PG8_SA(0, 1), cA + hstep, voffA);
        if (wr == 1) PG8_BAR;
        PG8_WAIT_V(2); PG8_BAR;
        PG8_STAGE(PG8_SB(1, 0), cB + kstep, voffB); PG8_STAGE(PG8_SA(1, 0), cA + kstep, voffA); PG8_STAGE(PG8_SB(1, 1), cB + hstep + kstep, voffB);
        PG8_WAIT_V(6); PG8_BAR;
    } else {
        PG8_STAGE(PG8_SB(0, 0), cB, voffB); PG8_STAGE(PG8_SA(0, 0), cA, voffA); PG8_STAGE(PG8_SB(0, 1), cB + hstep, voffB); PG8_STAGE(PG8_SA(0, 1), cA + hstep, voffA);
        if (wr == 1) PG8_BAR;
        PG8_WAIT_V(4); PG8_BAR;
        PG8_STAGE(PG8_SB(1, 0), cB + kstep, voffB); PG8_STAGE(PG8_SA(1, 0), cA + kstep, voffA); PG8_STAGE(PG8_SB(1, 1), cB + hstep + kstep, voffB);
        PG8_WAIT_V(6); PG8_BAR;
    }
    for (;;) {
        const bool has_next = S.next(ui + 1, nxt);
        const char* nA = has_next ? (const char*)g.A + (size_t)nxt.pm * tstep : cA; const char* nB = has_next ? (const char*)g.Bt + (size_t)nxt.pn * tstep : cB;
        for (int t = 0; t < nt; t += 2) {
            const bool last = (t == nt - 2);
            const char* a1 = cA + (size_t)(t + 1) * kstep;
            const char* a2 = last ? nA : cA + (size_t)(t + 2) * kstep; const char* b2 = last ? nB : cB + (size_t)(t + 2) * kstep;
            const char* a3 = a2 + kstep; const char* b3 = b2 + kstep;
            if (last && has_next) S.a_ready(nxt);
            if constexpr (SP2) {
            PG8_LDB(B0, 0, 0); PG8_LDB(B1, 0, 1); PG8_SCHED; PG8_LDA(At, 0, 0); PG8_STAGE(PG8_SA(1, 1), a1 + hstep, voffA);
            PG8_WAIT_V(8); PG8_WAIT_L(0); PG8_BAR; PG8_MMA(0, 0, At, B0); PG8_MMA(0, 1, At, B1); PG8_BAR; PG8_SCHED;
            PG8_LDA(At, 0, 1); PG8_STAGE(PG8_SB(0, 0), b2, voffB); PG8_STAGE(PG8_SB(0, 1), b2 + hstep, voffB); PG8_STAGE(PG8_SA(0, 0), a2, voffA);
            PG8_WAIT_V(8); PG8_WAIT_L(0); PG8_BAR; PG8_MMA(1, 0, At, B0); PG8_MMA(1, 1, At, B1); PG8_BAR; PG8_SCHED;
            PG8_LDB(B0, 1, 0); PG8_LDB(B1, 1, 1); PG8_SCHED; PG8_LDA(At, 1, 0); PG8_STAGE(PG8_SA(0, 1), a2 + hstep, voffA);
            PG8_WAIT_V(8); PG8_WAIT_L(0); PG8_BAR; PG8_MMA(0, 0, At, B0); PG8_MMA(0, 1, At, B1); PG8_BAR; PG8_SCHED;
            PG8_LDA(At, 1, 1); PG8_STAGE(PG8_SB(1, 0), b3, voffB); PG8_STAGE(PG8_SB(1, 1), b3 + hstep, voffB); PG8_STAGE(PG8_SA(1, 0), a3, voffA);
            PG8_WAIT_V(8); PG8_WAIT_L(0); PG8_BAR; PG8_MMA(1, 0, At, B0); PG8_MMA(1, 1, At, B1); PG8_BAR; PG8_SCHED;
            } else {
            PG8_LDB(B0, 0, 0); PG8_SCHED; PG8_LDA(At, 0, 0); PG8_STAGE(PG8_SA(1, 1), a1 + hstep, voffA);
            PG8_WAIT_L(8); PG8_BAR; PG8_WAIT_L(0); PG8_MMA(0, 0, At, B0); PG8_BAR; PG8_SCHED;
            PG8_LDB(B1, 0, 1); PG8_STAGE(PG8_SB(0, 0), b2, voffB);
            PG8_BAR; PG8_WAIT_L(0); PG8_MMA(0, 1, At, B1); PG8_BAR;
            PG8_LDA(At, 0, 1); PG8_STAGE(PG8_SA(0, 0), a2, voffA);
            PG8_BAR; PG8_WAIT_L(0); PG8_MMA(1, 0, At, B0); PG8_BAR; PG8_SCHED;
            PG8_STAGE(PG8_SB(0, 1), b2 + hstep, voffB);
            PG8_WAIT_V(6); PG8_BAR; PG8_MMA(1, 1, At, B1); PG8_BAR;
            PG8_LDB(B0, 1, 0); PG8_SCHED; PG8_LDA(At, 1, 0); PG8_STAGE(PG8_SA(0, 1), a2 + hstep, voffA);
            PG8_WAIT_L(8); PG8_BAR; PG8_WAIT_L(0); PG8_MMA(0, 0, At, B0); PG8_BAR; PG8_SCHED;
            PG8_LDB(B1, 1, 1); PG8_STAGE(PG8_SB(1, 0), b3, voffB);
            PG8_BAR; PG8_WAIT_L(0); PG8_MMA(0, 1, At, B1); PG8_BAR;
            PG8_LDA(At, 1, 1); PG8_STAGE(PG8_SA(1, 0), a3, voffA);
            PG8_BAR; PG8_WAIT_L(0); PG8_MMA(1, 0, At, B0); PG8_BAR; PG8_SCHED;
            PG8_STAGE(PG8_SB(1, 1), b3 + hstep, voffB);
            PG8_WAIT_V(6); PG8_BAR; PG8_MMA(1, 1, At, B1); PG8_BAR;
            }
        }
        if constexpr (ALIGN_EPI) { if (wr == 0) PG8_BAR; }
        if constexpr (!Epi::AFTER_DRAIN) { E(acc, cur, wr, wc, fr, fq); S.done(cur); }
        if (!has_next) break;
#pragma unroll
        for (int a = 0; a < 2; ++a)
#pragma unroll
            for (int b = 0; b < 2; ++b)
#pragma unroll
                for (int m = 0; m < 4; ++m)
#pragma unroll
                    for (int n = 0; n < 2; ++n) acc[a][b][m][n] = (f32x4){0.f, 0.f, 0.f, 0.f};
        cur = nxt; cA = nA; cB = nB; ++ui;
        if constexpr (ALIGN_EPI) { if (wr == 1) PG8_BAR; }
    }
    PG8_WAIT_V(0);
    if constexpr (!ALIGN_EPI) { if (wr == 0) PG8_BAR; }
    PG8_BAR;
    if constexpr (Epi::AFTER_DRAIN) { E.fused(acc, cur, wr, wc, fr, fq, lds, wid, lane); S.done(cur); }
#undef PG8_SA
#undef PG8_SB
#undef PG8_STAGE
#undef PG8_LDA
#undef PG8_LDB
#undef PG8_MMA
#undef PG8_WAIT_V
#undef PG8_WAIT_L
#undef PG8_BAR
#undef PG8_SCHED
}
}

#define LAS __attribute__((address_space(3)))
typedef unsigned short bf16_t;
typedef float f32x2 __attribute__((ext_vector_type(2)));
typedef float f32x4 __attribute__((ext_vector_type(4)));
typedef float f32x16 __attribute__((ext_vector_type(16)));
typedef short bf16x8 __attribute__((ext_vector_type(8)));
typedef short s16x4 __attribute__((ext_vector_type(4)));
typedef unsigned u32x4 __attribute__((ext_vector_type(4)));
typedef unsigned u32x2 __attribute__((ext_vector_type(2)));
typedef __bf16 bf16x2v __attribute__((ext_vector_type(2)));
#define MFMA32(a, b, c) __builtin_amdgcn_mfma_f32_32x32x16_bf16((a), (b), (c), 0, 0, 0)

constexpr int D = 1024, NB = 8, TL = 2048, TCX = 256, DEPTH = 4;
constexpr int ML = NB * TL, MC = NB * TCX, M = ML + MC;
constexpr int PPAD = 11776, RWP = 3584, DFF = 2816;
constexpr int NPH = 11, NPHASES = 1 + DEPTH * NPH;
constexpr size_t MiB = 1u << 20;
constexpr size_t WS_MOD = 0, WS_WIN = 1 * MiB, WS_WA = 24 * MiB, WS_WB = 26 * MiB, WS_WC = 28 * MiB, WS_WO = 30 * MiB, WS_WI = 32 * MiB, WS_WO2 = 43 * MiB,
                 WS_LWT = 48 * MiB + MiB / 2, WS_LAT = 49 * MiB, WS_LGT = 49 * MiB + MiB / 2, WS_H = 50 * MiB, WS_XC = 86 * MiB, WS_GU = 94 * MiB, WS_GV = 130 * MiB,
                 WS_Q = 166 * MiB, WS_K = 202 * MiB, WS_V = 238 * MiB, WS_RW = 274 * MiB, WS_GT = 400 * MiB, WS_LIW = 508 * MiB, WS_LIA = 512 * MiB + MiB / 2,
                 WS_LIG = 517 * MiB, WS_DEC1 = 526 * MiB, WS_AA0 = 562 * MiB, WS_AA1 = 598 * MiB, WS_G = 634 * MiB, WS_Y1 = 670 * MiB, WS_ROPE = 706 * MiB, WS_END = 707 * MiB;
constexpr int LDS_BYTES = 131072 + 1024;
constexpr size_t WS_BAR = 917504, BAR_BYTES = 16384;
constexpr float QSCALE = 0.125f * 1.4426950408889634f;

struct Args { const float* in[33]; float* out; unsigned char* ws; int lo, hi; };
typedef const __attribute__((address_space(4))) Args CArgs;
struct TI { int tid, bid, nblk; };

__device__ __forceinline__ float bf2f(unsigned v) { return __uint_as_float(v << 16); }
__device__ __forceinline__ unsigned pkbf(float lo, float hi) { f32x2 v = {lo, hi}; bf16x2v b = __builtin_convertvector(v, bf16x2v); return __builtin_bit_cast(unsigned, b); }
__device__ __forceinline__ bf16_t f2bf(float f) { return (bf16_t)(pkbf(f, 0.f) & 0xffffu); }
#define DPP_ADD(x, ctrl) ((x) + __builtin_bit_cast(float, __builtin_amdgcn_update_dpp(0, __builtin_bit_cast(int, (x)), (ctrl), 0xf, 0xf, true)))
__device__ __forceinline__ float wave_sum(float v) {
    v = DPP_ADD(v, 0xB1); v = DPP_ADD(v, 0x4E); v = DPP_ADD(v, 0x141); v = DPP_ADD(v, 0x140);
    const int iv = __builtin_bit_cast(int, v);
    const float s0 = __builtin_bit_cast(float, __builtin_amdgcn_readlane(iv, 0)), s1 = __builtin_bit_cast(float, __builtin_amdgcn_readlane(iv, 16)),
                s2 = __builtin_bit_cast(float, __builtin_amdgcn_readlane(iv, 32)), s3 = __builtin_bit_cast(float, __builtin_amdgcn_readlane(iv, 48));
    return (s0 + s1) + (s2 + s3);
}
__device__ __forceinline__ float dpp_sum8(float x) {
    x += __builtin_bit_cast(float, __builtin_amdgcn_update_dpp(0, __builtin_bit_cast(int, x), 0xB1, 0xf, 0xf, true));
    x += __builtin_bit_cast(float, __builtin_amdgcn_update_dpp(0, __builtin_bit_cast(int, x), 0x4E, 0xf, 0xf, true));
    x += __builtin_bit_cast(float, __builtin_amdgcn_update_dpp(0, __builtin_bit_cast(int, x), 0x141, 0xf, 0xf, true));
    return x;
}
__device__ __forceinline__ float quad_sum(float x) { x = DPP_ADD(x, 0xB1); x = DPP_ADD(x, 0x4E); return x; }
__device__ __forceinline__ float quad_xor2(float x) { return __builtin_bit_cast(float, __builtin_amdgcn_update_dpp(0, __builtin_bit_cast(int, x), 0x4E, 0xf, 0xf, true)); }
__device__ __forceinline__ void unpack16(const bf16_t* p, float (&x)[16]) {
    const u32x4 a = *(const u32x4*)p, b = *(const u32x4*)(p + 8);
#pragma unroll
    for (int i = 0; i < 4; ++i) { x[2 * i] = bf2f(a[i] & 0xffffu); x[2 * i + 1] = bf2f(a[i] >> 16); x[8 + 2 * i] = bf2f(b[i] & 0xffffu); x[8 + 2 * i + 1] = bf2f(b[i] >> 16); }
}
__device__ __forceinline__ void pack16(bf16_t* p, const float (&x)[16]) {
    u32x4 a, b;
#pragma unroll
    for (int i = 0; i < 4; ++i) { a[i] = pkbf(x[2 * i], x[2 * i + 1]); b[i] = pkbf(x[8 + 2 * i], x[8 + 2 * i + 1]); }
    *(u32x4*)p = a; *(u32x4*)(p + 8) = b;
}
__device__ __forceinline__ void load16f(const float* p, float (&x)[16]) {
#pragma unroll
    for (int i = 0; i < 4; ++i) { const f32x4 v = *(const f32x4*)(p + 4 * i); x[4 * i] = v.x; x[4 * i + 1] = v.y; x[4 * i + 2] = v.z; x[4 * i + 3] = v.w; }
}
__device__ __forceinline__ float sigmoidf_(float x) { return 1.f / (1.f + __expf(-x)); }

template <class Op> struct EpiT {
    static constexpr bool PERM = true, AFTER_DRAIN = false;
    Op op;
    __device__ __forceinline__ void operator()(const pg8::f32x4 (&acc)[2][2][4][2], const pg8::Unit& u, int wr, int wc, int fr, int fq) const {
        const int row0 = u.pm * 256 + wr * 64 + fr, col0 = u.pn * 256 + wc * 32 + 8 * fq;
#pragma unroll
        for (int ai = 0; ai < 2; ++ai)
#pragma unroll
            for (int m = 0; m < 4; ++m)
#pragma unroll
                for (int bj = 0; bj < 2; ++bj) { op(row0 + ai * 128 + m * 16, col0 + bj * 128, acc[ai][bj][m][0], acc[ai][bj][m][1]); asm volatile("" ::: "memory"); }
    }
};
__device__ __forceinline__ u32x4 pack8(f32x4 v0, f32x4 v1) { u32x4 o; o.x = pkbf(v0.x, v0.y); o.y = pkbf(v0.z, v0.w); o.z = pkbf(v1.x, v1.y); o.w = pkbf(v1.z, v1.w); return o; }
__device__ __forceinline__ void unpack8(u32x4 x, f32x4& v0, f32x4& v1) {
    v0.x = bf2f(x.x & 0xffffu); v0.y = bf2f(x.x >> 16); v0.z = bf2f(x.y & 0xffffu); v0.w = bf2f(x.y >> 16);
    v1.x = bf2f(x.z & 0xffffu); v1.y = bf2f(x.z >> 16); v1.z = bf2f(x.w & 0xffffu); v1.w = bf2f(x.w >> 16);
}
__device__ __forceinline__ f32x4 gelu4(f32x4 v) { pg8::f32x2 a = pg8::gelu_pk((pg8::f32x2){v.x, v.y}), b = pg8::gelu_pk((pg8::f32x2){v.z, v.w}); return (f32x4){a.x, a.y, b.x, b.y}; }
__device__ __forceinline__ f32x4 sig4(f32x4 v) { return (f32x4){sigmoidf_(v.x), sigmoidf_(v.y), sigmoidf_(v.z), sigmoidf_(v.w)}; }

struct OpIn {
    bf16_t *GU, *GV, *Q, *RW, *GT;
    __device__ __forceinline__ void operator()(int row, int col, f32x4 v0, f32x4 v1) const {
        bf16_t* dst;
        if (col < 2048) { v0 = gelu4(v0); v1 = gelu4(v1); dst = (col < 1024 ? GU : GV) + (size_t)row * 1024 + (col & 1023); }
        else if (col < 5120) { const int q = col - 2048; dst = Q + (size_t)(q >> 10) * (size_t)(18 * MiB) + (size_t)row * 1024 + (q & 1023); }
        else if (col < 8704) { dst = RW + (size_t)row * RWP + (col - 5120); }
        else { v0 = sig4(v0); v1 = sig4(v1); dst = GT + (size_t)row * 3072 + (col - 8704); }
        *(u32x4*)dst = pack8(v0, v1);
    }
};
struct OpDec {
    bf16_t *D0, *D1; const float* w0;
    __device__ __forceinline__ float f(float x) const { return -0.6065306597126334f * sigmoidf_(x); }
    __device__ __forceinline__ void operator()(int row, int col, f32x4 v0, f32x4 v1) const {
        const f32x4 b0 = *(const f32x4*)(w0 + col), b1 = *(const f32x4*)(w0 + col + 4);
        v0 += b0; v1 += b1;
        v0 = (f32x4){f(v0.x), f(v0.y), f(v0.z), f(v0.w)}; v1 = (f32x4){f(v1.x), f(v1.y), f(v1.z), f(v1.w)};
        bf16_t* dst = (col < 1024 ? D0 : D1) + (size_t)row * 1024 + (col & 1023);
        *(u32x4*)dst = pack8(v0, v1);
    }
};
struct OpAA {
    bf16_t *A0, *A1; const float* a0;
    __device__ __forceinline__ void operator()(int row, int col, f32x4 v0, f32x4 v1) const {
        const f32x4 b0 = *(const f32x4*)(a0 + col), b1 = *(const f32x4*)(a0 + col + 4);
        v0 = sig4(v0 + b0); v1 = sig4(v1 + b1);
        bf16_t* dst = (col < 1024 ? A0 : A1) + (size_t)row * 1024 + (col & 1023);
        *(u32x4*)dst = pack8(v0, v1);
    }
};
struct OpG {
    bf16_t* G;
    __device__ __forceinline__ void operator()(int row, int col, f32x4 v0, f32x4 v1) const { *(u32x4*)(G + (size_t)row * 1024 + col) = pack8(v0, v1); }
};
template <int KB> struct OpMerge {
    const bf16_t* GT; float* MF; bf16_t* MB;
    __device__ __forceinline__ void operator()(int row, int col, f32x4 v0, f32x4 v1) const {
        f32x4 g0, g1; unpack8(*(const u32x4*)(GT + (size_t)row * 3072 + KB * 1024 + col), g0, g1);
        float* mf = MF + (size_t)row * 1024 + col;
        f32x4 r0 = g0 * v0, r1 = g1 * v1;
        if (KB > 0) { r0 += *(const f32x4*)mf; r1 += *(const f32x4*)(mf + 4); }
        if (KB < 2) { *(f32x4*)mf = r0; *(f32x4*)(mf + 4) = r1; }
        else *(u32x4*)(MB + (size_t)row * 1024 + col) = pack8(r0, r1);
    }
};
struct OpResid {
    const float *xl, *xc; float *ol, *oc; const float* mod; int gi;
    __device__ __forceinline__ void operator()(int row, int col, f32x4 v0, f32x4 v1) const {
        const float* xi; float* xo; const float* g;
        if (row < ML) { xi = xl + (size_t)row * 1024 + col; xo = ol + (size_t)row * 1024 + col; g = mod + (size_t)(row >> 11) * 6144 + gi * 1024 + col; }
        else { const size_t rr = (size_t)(row - ML) * 1024 + col; xi = xc + rr; xo = oc + rr; g = mod + (size_t)8 * 6144 + gi * 1024 + col; }
        const f32x4 x0 = *(const f32x4*)xi, x1 = *(const f32x4*)(xi + 4), g0 = *(const f32x4*)g, g1 = *(const f32x4*)(g + 4);
        *(f32x4*)xo = x0 + g0 * v0; *(f32x4*)(xo + 4) = x1 + g1 * v1;
    }
};
struct OpSwiglu {
    bf16_t* HID;
    __device__ __forceinline__ void operator()(int row, int col, f32x4 v0, f32x4 v1) const {
        const float h0 = v0.x * sigmoidf_(v0.x) * v0.y, h1 = v0.z * sigmoidf_(v0.z) * v0.w, h2 = v1.x * sigmoidf_(v1.x) * v1.y, h3 = v1.z * sigmoidf_(v1.z) * v1.w;
        u32x2 o; o.x = pkbf(h0, h1); o.y = pkbf(h2, h3);
        *(u32x2*)(HID + (size_t)row * DFF + (col >> 1)) = o;
    }
};
template <class Op> __device__ __forceinline__ void run_gemm(const TI ti, unsigned char* lds, const bf16_t* A, const bf16_t* Bt, int Mr, int N, int K, const Op& op) {
    int Kv = K; asm volatile("" : "+s"(Kv));
    pg8::Gemm g{A, Bt, Mr, N, Kv}; pg8::StaticOrder S; S.init(Mr, N, ti.nblk, ti.bid);
    EpiT<Op> E{op};
    pg8::gemm_phase<EpiT<Op>, pg8::StaticOrder, true, true>((PG8_LAS unsigned char*)lds, g, S, E, ti.tid);
}

__device__ __forceinline__ void ph_mods(const TI ti, CArgs& a, unsigned char* ldsg) {
    float* sc = (float*)ldsg; float* part = sc + 9 * 1024;
    const int tid = ti.tid, lane = tid & 63, w = tid >> 6;
    for (int i = tid; i < 9 * 1024; i += 512) { const float v = (i < 8192) ? a.in[1][i] : a.in[3][i - 8192]; sc[i] = v / (1.f + expf(-v)); }
    __syncthreads();
    float* MOD = (float*)(a.ws + WS_MOD);
    for (int item = ti.bid; item < DEPTH * 96; item += ti.nblk) {
        const int l = item / 96, n0 = (item % 96) * 64;
        const float* W = a.in[4] + (size_t)l * 1024 * 6144 + n0 + lane;
        float acc[9];
#pragma unroll
        for (int r = 0; r < 9; ++r) acc[r] = 0.f;
#pragma unroll 8
        for (int k = w * 128; k < w * 128 + 128; ++k) {
            const float wv = W[(size_t)k * 6144];
#pragma unroll
            for (int r = 0; r < 9; ++r) acc[r] += sc[r * 1024 + k] * wv;
        }
#pragma unroll
        for (int r = 0; r < 9; ++r) part[(w * 9 + r) * 64 + lane] = acc[r];
        __syncthreads();
        for (int idx = tid; idx < 576; idx += 512) {
            const int r = idx >> 6, ln = idx & 63; float s = a.in[5][l * 6144 + n0 + ln];
            for (int ww = 0; ww < 8; ++ww) s += part[(ww * 9 + r) * 64 + ln];
            MOD[((size_t)l * 9 + r) * 6144 + n0 + ln] = s;
        }
        __syncthreads();
    }
    float* RC = (float*)(a.ws + WS_ROPE); float* RS = RC + 2048 * 32;
    for (int idx = ti.bid * 512 + tid; idx < 2048 * 32; idx += ti.nblk * 512) {
        const int t = idx >> 5, i = idx & 31; const float pos = i < 16 ? (float)(t >> 6) : (float)(t & 63);
        const float ang = pos * exp2f(-(float)(i & 15) * (13.287712379549449f / 16.f));
        RC[idx] = cosf(ang); RS[idx] = sinf(ang);
    }
}

__device__ __forceinline__ void norm_rows(const float* xl, const float* xc, const float* g, const float* modl, int shi, int sci, bf16_t* H, int nrows, int gw, int ngw, int lane) {
    for (int row = gw; row < nrows; row += ngw) {
        const float* src; int r;
        if (row < ML) { src = xl + (size_t)row * D; r = row >> 11; } else { src = xc + (size_t)(row - ML) * D; r = 8; }
        const float* md = modl + (size_t)r * 6144;
        f32x4 v[4]; float ss = 0.f;
#pragma unroll
        for (int j = 0; j < 4; ++j) { v[j] = *(const f32x4*)(src + 4 * lane + 256 * j); ss += (v[j].x * v[j].x + v[j].y * v[j].y) + (v[j].z * v[j].z + v[j].w * v[j].w); }
        ss = wave_sum(ss);
        const float rstd = rsqrtf(ss * (1.f / 1024.f) + 1e-6f);
#pragma unroll
        for (int j = 0; j < 4; ++j) {
            const int c = 4 * lane + 256 * j;
            const f32x4 gg = *(const f32x4*)(g + c), scv = *(const f32x4*)(md + sci * 1024 + c), shv = *(const f32x4*)(md + shi * 1024 + c);
            const f32x4 o = v[j] * rstd * gg * (1.f + scv) + shv;
            u32x2 p; p.x = pkbf(o.x, o.y); p.y = pkbf(o.z, o.w);
            *(u32x2*)(H + (size_t)row * D + c) = p;
        }
    }
}

template <int MODE> __device__ __forceinline__ void transpose_item(const float* W, int K, int N, bf16_t* WT, LAS float* scr, int item, int lane) {
    const int nblk = N / 32, kb = item / nblk, nb = item % nblk, k0 = 64 * kb, n0 = 32 * nb;
#pragma unroll 8
    for (int i = 0; i < 32; ++i) { const int kk = 2 * i + (lane >> 5); scr[kk * 33 + (lane & 31)] = W[(size_t)(k0 + kk) * N + n0 + (lane & 31)]; }
    asm volatile("s_waitcnt lgkmcnt(0)" ::: "memory");
    const int c = lane & 7;
#pragma unroll
    for (int j = 0; j < 4; ++j) {
        const int n = (lane >> 3) + 8 * j, gn = n0 + n; const LAS float* s = scr + (8 * c) * 33 + n;
        const int drow = MODE == 0 ? gn : (MODE == 1 ? (gn >= 8608 ? gn + 96 : gn) : (gn < DFF ? 2 * gn : 2 * (gn - DFF) + 1));
        u32x4 o; o.x = pkbf(s[0 * 33], s[1 * 33]); o.y = pkbf(s[2 * 33], s[3 * 33]); o.z = pkbf(s[4 * 33], s[5 * 33]); o.w = pkbf(s[6 * 33], s[7 * 33]);
        *(u32x4*)(WT + (size_t)drow * K + k0 + 8 * c) = o;
    }
    asm volatile("s_waitcnt lgkmcnt(0)" ::: "memory");
}
__device__ __forceinline__ void ph_wconv(CArgs& a, int l, unsigned char* ldsg, int gw, int ngw, int lane, int wv) {
    LAS float* scr = (LAS float*)(ldsg + wv * 8704);
    unsigned char* ws = a.ws;
    constexpr int I_IN = 16 * 365, I_SQ = 16 * 32, I_WI = 16 * 176, I_WO = 44 * 32, NIT = I_IN + 4 * I_SQ + I_WI + I_WO;
    for (int it = gw; it < NIT; it += ngw) {
        int r = it;
        if (r < I_IN) { transpose_item<1>(a.in[8] + (size_t)l * 1024 * 11680, 1024, 11680, (bf16_t*)(ws + WS_WIN), scr, r, lane); continue; } r -= I_IN;
        if (r < I_SQ) { transpose_item<0>(a.in[27] + (size_t)l * 1048576, 1024, 1024, (bf16_t*)(ws + WS_WA), scr, r, lane); continue; } r -= I_SQ;
        if (r < I_SQ) { transpose_item<0>(a.in[28] + (size_t)l * 1048576, 1024, 1024, (bf16_t*)(ws + WS_WB), scr, r, lane); continue; } r -= I_SQ;
        if (r < I_SQ) { transpose_item<0>(a.in[29] + (size_t)l * 1048576, 1024, 1024, (bf16_t*)(ws + WS_WC), scr, r, lane); continue; } r -= I_SQ;
        if (r < I_SQ) { transpose_item<0>(a.in[30] + (size_t)l * 1048576, 1024, 1024, (bf16_t*)(ws + WS_WO), scr, r, lane); continue; } r -= I_SQ;
        if (r < I_WI) { transpose_item<2>(a.in[31] + (size_t)l * 1024 * 5632, 1024, 5632, (bf16_t*)(ws + WS_WI), scr, r, lane); continue; } r -= I_WI;
        transpose_item<0>(a.in[32] + (size_t)l * DFF * 1024, DFF, 1024, (bf16_t*)(ws + WS_WO2), scr, r, lane);
    }
    const int gt = gw * 64 + lane, ngt = ngw * 64;
    bf16_t* LWT = (bf16_t*)(ws + WS_LWT); bf16_t* LAT = (bf16_t*)(ws + WS_LAT); bf16_t* LGT = (bf16_t*)(ws + WS_LGT);
    const float* w2 = a.in[18] + (size_t)l * 2 * 64 * 1024; const float* a2 = a.in[20] + (size_t)l * 2 * 64 * 1024; const float* g2 = a.in[21] + (size_t)l * 160 * 1024;
    for (int i = gt; i < 2048 * 128; i += ngt) {
        const int n = i >> 7, k = i & 127, d = n >> 10, c = n & 1023, kk = k - d * 64;
        const bool in = (kk >= 0 && kk < 64);
        LWT[i] = in ? f2bf(w2[((size_t)d * 64 + kk) * 1024 + c]) : (bf16_t)0;
        LAT[i] = in ? f2bf(a2[((size_t)d * 64 + kk) * 1024 + c]) : (bf16_t)0;
    }
    for (int i = gt; i < 1024 * 256; i += ngt) { const int n = i >> 8, k = i & 255; LGT[i] = k < 160 ? f2bf(g2[(size_t)k * 1024 + n]) : (bf16_t)0; }
    bf16_t* WIN = (bf16_t*)(ws + WS_WIN);
    for (int i = gt; i < 96 * 1024; i += ngt) WIN[(size_t)8608 * 1024 + i] = 0;
}

__device__ __forceinline__ void gmlp_unit(const TI ti, CArgs& a, int l, int u, unsigned char* ldsg) {
    float* rstd = (float*)ldsg; bf16_t* VNT = (bf16_t*)(ldsg + 512);
    const int tid = ti.tid, lane = tid & 63, w = tid >> 6, r = lane & 31, h = lane >> 5;
    bf16_t* GU = (bf16_t*)(a.ws + WS_GU); const bf16_t* GV = (const bf16_t*)(a.ws + WS_GV);
    const size_t R0 = (size_t)u * 128;
#pragma unroll 4
    for (int i = 0; i < 16; ++i) {
        const int tok = w * 16 + i; const bf16_t* p = GV + (R0 + tok) * 1024 + lane * 16;
        f32x4 x0, x1, x2, x3; unpack8(*(const u32x4*)p, x0, x1); unpack8(*(const u32x4*)(p + 8), x2, x3);
        float ss = (x0.x * x0.x + x0.y * x0.y + x0.z * x0.z + x0.w * x0.w) + (x1.x * x1.x + x1.y * x1.y + x1.z * x1.z + x1.w * x1.w)
                 + (x2.x * x2.x + x2.y * x2.y + x2.z * x2.z + x2.w * x2.w) + (x3.x * x3.x + x3.y * x3.y + x3.z * x3.z + x3.w * x3.w);
        ss = wave_sum(ss);
        if (lane == 0) rstd[tok] = rsqrtf(ss * (1.f / 1024.f) + 1e-6f);
    }
    __syncthreads();
    const float* gvg = a.in[9] + l * 1024; const float* wsp = a.in[10] + (size_t)l * 8 * 128 * 128; const float* bsp = a.in[11] + l * 8 * 128;
    const int tt = w & 3, chh = w >> 2;
    for (int g = 0; g < 8; ++g) {
        {
            const int s = tid & 127, cc = tid >> 7; const float rs = rstd[s]; const bf16_t* p = GV + (R0 + s) * 1024 + g * 128 + cc * 32;
#pragma unroll
            for (int q = 0; q < 4; ++q) {
                f32x4 x0, x1; unpack8(*(const u32x4*)(p + 8 * q), x0, x1);
                const float* gp = gvg + g * 128 + cc * 32 + 8 * q; const int c0 = cc * 32 + 8 * q;
                VNT[(c0 + 0) * 136 + s] = f2bf(x0.x * rs * gp[0]); VNT[(c0 + 1) * 136 + s] = f2bf(x0.y * rs * gp[1]);
                VNT[(c0 + 2) * 136 + s] = f2bf(x0.z * rs * gp[2]); VNT[(c0 + 3) * 136 + s] = f2bf(x0.w * rs * gp[3]);
                VNT[(c0 + 4) * 136 + s] = f2bf(x1.x * rs * gp[4]); VNT[(c0 + 5) * 136 + s] = f2bf(x1.y * rs * gp[5]);
                VNT[(c0 + 6) * 136 + s] = f2bf(x1.z * rs * gp[6]); VNT[(c0 + 7) * 136 + s] = f2bf(x1.w * rs * gp[7]);
            }
        }
        __syncthreads();
        f32x16 acc0, acc1;
#pragma unroll
        for (int i = 0; i < 16; ++i) { acc0[i] = 0.f; acc1[i] = 0.f; }
        const float* wrow = wsp + ((size_t)g * 128 + tt * 32 + r) * 128;
#pragma unroll
        for (int ks = 0; ks < 8; ++ks) {
            const f32x4 a0 = *(const f32x4*)(wrow + 16 * ks + 8 * h), a1 = *(const f32x4*)(wrow + 16 * ks + 8 * h + 4);
            const bf16x8 af = __builtin_bit_cast(bf16x8, pack8(a0, a1));
            const bf16x8 b0 = *(const bf16x8*)(VNT + (chh * 64 + r) * 136 + 16 * ks + 8 * h);
            const bf16x8 b1 = *(const bf16x8*)(VNT + (chh * 64 + 32 + r) * 136 + 16 * ks + 8 * h);
            acc0 = MFMA32(af, b0, acc0); acc1 = MFMA32(af, b1, acc1);
        }
        {
            const bf16_t* GUr = GU; float uu0[16], uu1[16], bb[16];
#pragma unroll
            for (int reg = 0; reg < 16; ++reg) {
                const int t = tt * 32 + (reg & 3) + 8 * (reg >> 2) + 4 * h; const size_t i0 = (R0 + t) * 1024 + g * 128 + chh * 64 + r;
                bb[reg] = bsp[g * 128 + t]; uu0[reg] = bf2f(GUr[i0]); uu1[reg] = bf2f(GUr[i0 + 32]);
            }
            asm volatile("" ::: "memory");
#pragma unroll
            for (int reg = 0; reg < 16; ++reg) {
                const int t = tt * 32 + (reg & 3) + 8 * (reg >> 2) + 4 * h; const size_t i0 = (R0 + t) * 1024 + g * 128 + chh * 64 + r;
                GU[i0] = f2bf(uu0[reg] * (acc0[reg] + bb[reg])); GU[i0 + 32] = f2bf(uu1[reg] * (acc1[reg] + bb[reg]));
            }
        }
        __syncthreads();
    }
}
__device__ __forceinline__ void qk_rows(CArgs& a, int l, int gw, int ngw, int lane) {
    bf16_t* Q = (bf16_t*)(a.ws + WS_Q); bf16_t* K = (bf16_t*)(a.ws + WS_K);
    const float* RC = (const float*)(a.ws + WS_ROPE); const float* RS = RC + 2048 * 32;
    const int part = lane & 3;
    float gq[16], gk[16];
    load16f(a.in[12] + l * 64 + 16 * part, gq); load16f(a.in[13] + l * 64 + 16 * part, gk);
    for (int row = gw; row < M; row += ngw) {
        float xq[16], xk[16], cs[16], sn[16];
        unpack16(Q + (size_t)row * 1024 + 16 * lane, xq); unpack16(K + (size_t)row * 1024 + 16 * lane, xk);
        const bool lat = row < ML;
        if (lat) { const int t = row & 2047; load16f(RC + t * 32 + 16 * (part & 1), cs); load16f(RS + t * 32 + 16 * (part & 1), sn); }
        float sq = 0.f, sk = 0.f;
#pragma unroll
        for (int j = 0; j < 16; ++j) { sq += xq[j] * xq[j]; sk += xk[j] * xk[j]; }
        const float rq = rsqrtf(quad_sum(sq) * (1.f / 64.f) + 1e-6f), rk = rsqrtf(quad_sum(sk) * (1.f / 64.f) + 1e-6f);
#pragma unroll
        for (int j = 0; j < 16; ++j) { xq[j] = xq[j] * rq * gq[j]; xk[j] = xk[j] * rk * gk[j]; }
        if (lat) {
            const float sgn = part < 2 ? -1.f : 1.f;
#pragma unroll
            for (int j = 0; j < 16; ++j) {
                const float pq = quad_xor2(xq[j]), pk = quad_xor2(xk[j]);
                xq[j] = xq[j] * cs[j] + sgn * pq * sn[j]; xk[j] = xk[j] * cs[j] + sgn * pk * sn[j];
            }
        }
#pragma unroll
        for (int j = 0; j < 16; ++j) xq[j] *= QSCALE;
        pack16(Q + (size_t)row * 1024 + 16 * lane, xq); pack16(K + (size_t)row * 1024 + 16 * lane, xk);
    }
}
__device__ __forceinline__ void lora_in_rows(CArgs& a, int l, int gw, int ngw, int lane) {
    const bf16_t* RW = (const bf16_t*)(a.ws + WS_RW); bf16_t* LW = (bf16_t*)(a.ws + WS_LIW); bf16_t* LA = (bf16_t*)(a.ws + WS_LIA); bf16_t* LG = (bf16_t*)(a.ws + WS_LIG);
    const float* mu = a.in[16] + l * 3488 + 3072;
    f32x4 m0 = {0.f, 0.f, 0.f, 0.f}, m1 = m0;
    if (lane < 52) { m0 = *(const f32x4*)(mu + 8 * lane); m1 = *(const f32x4*)(mu + 8 * lane + 4); }
    for (int row = gw; row < M; row += ngw) {
        int t, Tn; if (row < ML) { t = row & 2047; Tn = 2048; } else { t = (row - ML) & 255; Tn = 256; }
        const bool hp = t > 0, hn = t < Tn - 1;
        if (lane < 52) {
            const bf16_t* p = RW + (size_t)row * RWP + 3072 + 8 * lane;
            f32x4 x0, x1, p0 = {0.f, 0.f, 0.f, 0.f}, p1 = p0, n0 = p0, n1 = p0;
            unpack8(*(const u32x4*)p, x0, x1);
            if (hp) unpack8(*(const u32x4*)(p - RWP), p0, p1);
            if (hn) unpack8(*(const u32x4*)(p + RWP), n0, n1);
            f32x4 z0 = x0 + m0 * (0.5f * (p0 + n0) - x0), z1 = x1 + m1 * (0.5f * (p1 + n1) - x1);
            const int j = 8 * lane;
            if (j < 128) { z0 = (f32x4){tanhf(z0.x), tanhf(z0.y), tanhf(z0.z), tanhf(z0.w)}; z1 = (f32x4){tanhf(z1.x), tanhf(z1.y), tanhf(z1.z), tanhf(z1.w)}; *(u32x4*)(LW + (size_t)row * 128 + j) = pack8(z0, z1); }
            else if (j < 256) { *(u32x4*)(LA + (size_t)row * 128 + j - 128) = pack8(z0, z1); }
            else { *(u32x4*)(LG + (size_t)row * 256 + j - 256) = pack8(sig4(z0), sig4(z1)); }
        } else {
            unsigned z_ = 0u; asm volatile("" : "+v"(z_)); *(u32x4*)(LG + (size_t)row * 256 + 160 + (lane - 52) * 8) = (u32x4){z_, z_, z_, z_};
        }
    }
}

__device__ __forceinline__ void scan_unit(const TI ti, CArgs& a, int l, int u, bool ctx_out, unsigned char* ldsg) {
    const int tid = ti.tid, lane = tid & 63, w = tid >> 6;
    const int b = u >> 5, hh = (u >> 1) & 15, d = u & 1;
    const int si = tid >> 3, jq = tid & 7;
    LAS float* L = (LAS float*)ldsg;
    const bf16_t* RW = (const bf16_t*)(a.ws + WS_RW);
    const bf16_t* DEC = (const bf16_t*)(a.ws + (d ? WS_DEC1 : WS_GV));
    const bf16_t* AA = (const bf16_t*)(a.ws + (d ? WS_AA1 : WS_AA0));
    bf16_t* Y = (bf16_t*)(a.ws + (d ? WS_Y1 : WS_H));
    const int ch = hh * 64 + lane;
    const float* mu = a.in[16] + l * 3488;
    const float mur = mu[ch], muk = mu[1024 + ch], muv = mu[2048 + ch], kkg = a.in[22][l * 1024 + ch], kag = a.in[23][l * 1024 + ch];
    f32x4 S0 = {0.f, 0.f, 0.f, 0.f}, S1 = {0.f, 0.f, 0.f, 0.f};
    unsigned raw[4][9]; unsigned dcr[4], aar[4];
    constexpr int NC = 72;
#define SCAN_CHUNK(n, base, Tn, t0, wy) int base, Tn, t0; bool wy; { int ci; if ((n) < 8) { base = ML + b * 256; Tn = 256; ci = d ? 7 - (n) : (n); wy = ctx_out; } else { base = b * 2048; Tn = 2048; ci = d ? 71 - (n) : (n) - 8; wy = true; } t0 = ci * 32; }
#define SCAN_LOAD(n) do { SCAN_CHUNK(n, base_, Tn_, t0_, wy_); (void)wy_; _Pragma("unroll") for (int i4 = 0; i4 < 4; ++i4) { const int t = t0_ + w + 8 * i4; const size_t row = (size_t)(base_ + t); \
        const bf16_t* p = RW + row * RWP + ch; const bool hp = t > 0, hn = t < Tn_ - 1; \
        const int op_ = hp ? -RWP : 0, on_ = hn ? RWP : 0;     \
        _Pragma("unroll") for (int X = 0; X < 3; ++X) { raw[i4][3 * X + 0] = (unsigned)p[X * 1024 + op_]; raw[i4][3 * X + 1] = (unsigned)p[X * 1024]; raw[i4][3 * X + 2] = (unsigned)p[X * 1024 + on_]; } \
        dcr[i4] = (unsigned)DEC[row * 1024 + ch]; aar[i4] = (unsigned)AA[row * 1024 + ch]; } } while (0)
#define SCAN_STORE(n) do { LAS float* Bf = L + ((n) & 1) * 12288; SCAN_CHUNK(n, base_, Tn_, t0_, wy_); (void)wy_; (void)base_; _Pragma("unroll") for (int i4 = 0; i4 < 4; ++i4) { const int tk = w + 8 * i4; \
        const float mp_ = (t0_ + tk > 0) ? 0.5f : 0.f, mn_ = (t0_ + tk < Tn_ - 1) ? 0.5f : 0.f; \
        const float xr = bf2f(raw[i4][1]), xk = bf2f(raw[i4][4]), xv = bf2f(raw[i4][7]); \
        const float zr = xr + mur * ((mp_ * bf2f(raw[i4][0]) + mn_ * bf2f(raw[i4][2])) - xr); \
        const float zk = xk + muk * ((mp_ * bf2f(raw[i4][3]) + mn_ * bf2f(raw[i4][5])) - xk); \
        const float zv = xv + muv * ((mp_ * bf2f(raw[i4][6]) + mn_ * bf2f(raw[i4][8])) - xv); \
        const float kkv = zk * kkg; const float ssq = wave_sum(kkv * kkv); const float kkn = kkv / fmaxf(sqrtf(ssq), 1e-12f); \
        const float ad = bf2f(aar[i4]); const float wv_ = __expf(bf2f(dcr[i4])); const float kd = zk * (1.f + (ad - 1.f) * kag); \
        Bf[0 * 2048 + tk * 64 + lane] = wv_; Bf[1 * 2048 + tk * 64 + lane] = kd; Bf[2 * 2048 + tk * 64 + lane] = -kkn; \
        Bf[3 * 2048 + tk * 64 + lane] = kkn * ad; Bf[4 * 2048 + tk * 64 + lane] = zr; Bf[5 * 2048 + tk * 64 + lane] = zv; } } while (0)
    SCAN_LOAD(0); SCAN_STORE(0);
    __syncthreads();
    for (int n = 0; n < NC; ++n) {
        if (n + 1 < NC) SCAN_LOAD(n + 1);
        LAS const float* Bf = L + (n & 1) * 12288; LAS float* Yb = L + 24576 + (n & 1) * 2048;
#define STEP_LOAD(P, sidx) LAS const float* q##P = Bf + (sidx) * 64 + 8 * jq + hoff; \
            const f32x4 w0##P = *(LAS const f32x4*)(q##P), w1##P = *(LAS const f32x4*)(q##P + hdq), k0##P = *(LAS const f32x4*)(q##P + 2048), k1##P = *(LAS const f32x4*)(q##P + 2048 + hdq), \
                        a0##P = *(LAS const f32x4*)(q##P + 4096), a1##P = *(LAS const f32x4*)(q##P + 4096 + hdq), b0##P = *(LAS const f32x4*)(q##P + 6144), b1##P = *(LAS const f32x4*)(q##P + 6144 + hdq), \
                        r0##P = *(LAS const f32x4*)(q##P + 8192), r1##P = *(LAS const f32x4*)(q##P + 8192 + hdq); const float vi##P = Bf[5 * 2048 + (sidx) * 64 + si];
#define STEP_MATH(P, sidx) { const f32x4 ta = S0 * a0##P + S1 * a1##P; const float sa = dpp_sum8((ta.x + ta.y) + (ta.z + ta.w)); \
            S0 = S0 * w0##P + (sa * b0##P + vi##P * k0##P); S1 = S1 * w1##P + (sa * b1##P + vi##P * k1##P); \
            const f32x4 ty = S0 * r0##P + S1 * r1##P; const float y = dpp_sum8((ty.x + ty.y) + (ty.z + ty.w)); if (jq == 0) Yb[(sidx) * 64 + si] = y; }
        const int hoff = (si & 1) * 4, hdq = 4 - 2 * hoff;
        const int sdir = d ? -1 : 1; int sc = d ? 31 : 0;
        f32x4 cw0, cw1, ck0, ck1, ca0, ca1, cb0, cb1, cr0, cr1; float cvi;
        { STEP_LOAD(X, sc); cw0 = w0X; cw1 = w1X; ck0 = k0X; ck1 = k1X; ca0 = a0X; ca1 = a1X; cb0 = b0X; cb1 = b1X; cr0 = r0X; cr1 = r1X; cvi = viX; }
        for (int ss = 0; ss < 32; ss += 2) {
            const int s0i = sc, s1i = sc + sdir; int s2i = sc + 2 * sdir; s2i = (ss + 2 < 32) ? s2i : s1i;
            STEP_LOAD(B, s1i);
            { const f32x4 w0A = cw0, w1A = cw1, k0A = ck0, k1A = ck1, a0A = ca0, a1A = ca1, b0A = cb0, b1A = cb1, r0A = cr0, r1A = cr1; const float viA = cvi; STEP_MATH(A, s0i); }
            STEP_LOAD(C, s2i);
            STEP_MATH(B, s1i);
            cw0 = w0C; cw1 = w1C; ck0 = k0C; ck1 = k1C; ca0 = a0C; ca1 = a1C; cb0 = b0C; cb1 = b1C; cr0 = r0C; cr1 = r1C; cvi = viC;
            sc += 2 * sdir;
        }
#undef STEP_LOAD
#undef STEP_MATH
        if (n + 1 < NC) SCAN_STORE(n + 1);
        __syncthreads();
        {
            SCAN_CHUNK(n, base_, Tn_, t0_, wy_); (void)Tn_;
            if (wy_) {
#pragma unroll
                for (int i4 = 0; i4 < 4; ++i4) { const int tk = w + 8 * i4; Y[(size_t)(base_ + t0_ + tk) * 1024 + ch] = f2bf(Yb[tk * 64 + lane]); }
            }
        }
    }
    __syncthreads();
#undef SCAN_CHUNK
#undef SCAN_LOAD
#undef SCAN_STORE
}

__device__ __forceinline__ void attn_unit(const TI ti, CArgs& a, int b, int hd, int qrow0, int st_lo, int st_hi, float mfix, float lam, float lam_init, const float* subg, unsigned char* ldsg) {
    const int tid = ti.tid, lane = tid & 63, w = tid >> 6, r = lane & 31, h = lane >> 5, qt = w >> 1, c = w & 1;
    bf16_t* Qb = (bf16_t*)(a.ws + WS_Q); const bf16_t* Kb = (const bf16_t*)(a.ws + WS_K); const bf16_t* Vb = (const bf16_t*)(a.ws + WS_V);
    LAS unsigned char* L = (LAS unsigned char*)ldsg;
    constexpr int KOFF = 0, VOFF = 17408, BUFB = 35840;
    bf16x8 qf[4];
    { const bf16_t* qp = Qb + (size_t)(qrow0 + qt * 32 + r) * 1024 + hd * 128 + c * 64 + 8 * h;
#pragma unroll
      for (int ks = 0; ks < 4; ++ks) qf[ks] = *(const bf16x8*)(qp + 16 * ks); }
    f32x16 O[4];
#pragma unroll
    for (int e = 0; e < 4; ++e)
#pragma unroll
        for (int i = 0; i < 16; ++i) O[e][i] = 0.f;
    float lsum = 0.f;
    u32x4 kreg[2], vreg[2];
#define ATT_KROW(kk) ((kk) < 2048 ? (size_t)(b * 2048 + (kk)) : (size_t)(ML + b * 256 + (kk) - 2048))
#define ATT_LOAD(st) do { _Pragma("unroll") for (int i = 0; i < 2; ++i) { const int p = tid + 512 * i, key = p >> 4, dc = p & 15; kreg[i] = *(const u32x4*)(Kb + ATT_KROW((st) * 64 + key) * 1024 + hd * 128 + dc * 8); } \
        const bf16_t* vp = Vb + ATT_KROW((st) * 64 + lane) * 1024 + hd * 128 + w * 16; vreg[0] = *(const u32x4*)vp; vreg[1] = *(const u32x4*)(vp + 8); } while (0)
#define ATT_STORE(bufi) do { LAS unsigned char* Bb = L + (bufi) * BUFB; _Pragma("unroll") for (int i = 0; i < 2; ++i) { const int p = tid + 512 * i, key = p >> 4, dc = p & 15; *(LAS u32x4*)(Bb + KOFF + key * 272 + dc * 16) = kreg[i]; } \
        LAS bf16_t* vt = (LAS bf16_t*)(Bb + VOFF) + (w * 16) * 72 + lane; \
        _Pragma("unroll") for (int e = 0; e < 4; ++e) { vt[(2 * e) * 72] = (bf16_t)(vreg[0][e] & 0xffffu); vt[(2 * e + 1) * 72] = (bf16_t)(vreg[0][e] >> 16); \
            vt[(8 + 2 * e) * 72] = (bf16_t)(vreg[1][e] & 0xffffu); vt[(8 + 2 * e + 1) * 72] = (bf16_t)(vreg[1][e] >> 16); } } while (0)
    ATT_LOAD(st_lo); ATT_STORE(0);
    __syncthreads();
    for (int st = st_lo; st < st_hi; ++st) {
        const int bi = (st - st_lo) & 1;
        if (st + 1 < st_hi) ATT_LOAD(st + 1);
        LAS const unsigned char* Bb = L + bi * BUFB;
#pragma unroll
        for (int sub = 0; sub < 2; ++sub) {
            f32x16 Sx;
#pragma unroll
            for (int i = 0; i < 16; ++i) Sx[i] = 0.f;
#pragma unroll
            for (int ks = 0; ks < 4; ++ks) {
                const bf16x8 kf = *(LAS const bf16x8*)(Bb + KOFF + (sub * 32 + r) * 272 + (c * 64 + 16 * ks + 8 * h) * 2);
                Sx = MFMA32(kf, qf[ks], Sx);
            }
            float p[16];
#pragma unroll
            for (int i = 0; i < 16; ++i) { p[i] = __builtin_amdgcn_exp2f(Sx[i] - mfix); lsum += p[i]; }
            u32x4 pw0, pw1;
            pw0.x = pkbf(p[0], p[1]); pw0.y = pkbf(p[2], p[3]); pw0.z = pkbf(p[4], p[5]); pw0.w = pkbf(p[6], p[7]);
            pw1.x = pkbf(p[8], p[9]); pw1.y = pkbf(p[10], p[11]); pw1.z = pkbf(p[12], p[13]); pw1.w = pkbf(p[14], p[15]);
            const bf16x8 pb0 = __builtin_bit_cast(bf16x8, pw0), pb1 = __builtin_bit_cast(bf16x8, pw1);
#pragma unroll
            for (int et = 0; et < 4; ++et) {
#pragma unroll
                for (int s = 0; s < 2; ++s) {
                    LAS const unsigned char* va = Bb + VOFF + (et * 32 + r) * 144 + (sub * 32 + 16 * s + 4 * h) * 2;
                    const s16x4 lo = *(LAS const s16x4*)va, hi = *(LAS const s16x4*)(va + 16);
                    const bf16x8 vf = __builtin_shufflevector(lo, hi, 0, 1, 2, 3, 4, 5, 6, 7);
                    O[et] = MFMA32(vf, s ? pb1 : pb0, O[et]);
                }
            }
        }
        if (st + 1 < st_hi) ATT_STORE(bi ^ 1);
        __syncthreads();
    }
#undef ATT_KROW
#undef ATT_LOAD
#undef ATT_STORE
    const float ltot = lsum + __shfl_xor(lsum, 32);
    const float linv = 1.f / ltot;
    LAS float* X = (LAS float*)L + qt * 4096;
    if (c == 1) {
#pragma unroll
        for (int e = 0; e < 4; ++e)
#pragma unroll
            for (int i = 0; i < 16; ++i) X[(e * 16 + i) * 64 + lane] = O[e][i] * linv;
    }
    __syncthreads();
    if (c == 0) {
        float ssq = 0.f;
#pragma unroll
        for (int e = 0; e < 4; ++e)
#pragma unroll
            for (int i = 0; i < 16; ++i) { const float o = O[e][i] * linv - lam * X[(e * 16 + i) * 64 + lane]; O[e][i] = o; ssq += o * o; }
        ssq += __shfl_xor(ssq, 32);
        const float sc = rsqrtf(ssq * (1.f / 128.f) + 1e-6f) * (1.f - lam_init);
        bf16_t* op = Qb + (size_t)(qrow0 + qt * 32 + r) * 1024 + hd * 128;
#pragma unroll
        for (int e = 0; e < 4; ++e)
#pragma unroll
            for (int g4 = 0; g4 < 4; ++g4) {
                const int e0 = e * 32 + 8 * g4 + 4 * h; const f32x4 sg = *(const f32x4*)(subg + e0);
                u32x2 o; o.x = pkbf(O[e][4 * g4 + 0] * sc * sg.x, O[e][4 * g4 + 1] * sc * sg.y); o.y = pkbf(O[e][4 * g4 + 2] * sc * sg.z, O[e][4 * g4 + 3] * sc * sg.w);
                *(u32x2*)(op + e0) = o;
            }
    }
    __syncthreads();
}
__device__ __forceinline__ void ph_attn(const TI ti, CArgs& a, int l, bool ctx_out, unsigned char* ldsg) {
    const int lane = ti.tid & 63;
    const float gqm = fabsf(a.in[12][l * 64 + lane]), gkm = fabsf(a.in[13][l * 64 + lane]);
    float mq = gqm, mk = gkm;
#pragma unroll
    for (int o = 1; o < 64; o <<= 1) { mq = fmaxf(mq, __shfl_xor(mq, o)); mk = fmaxf(mk, __shfl_xor(mk, o)); }
    const float mfix = 8.f * mq * mk * 1.4426950408889634f * 1.03f;
    const float* lp = a.in[14] + l * 256;
    const float s1 = wave_sum(lp[lane] * lp[64 + lane]), s2 = wave_sum(lp[128 + lane] * lp[192 + lane]);
    const float lam_init = 0.8f - 0.6f * expf(-0.3f * (float)l);
    const float lam = expf(s1) - expf(s2) + lam_init;
    const float* subg = a.in[15] + l * 128;
    const int nun = 1024 + (ctx_out ? 128 : 0);
    for (int u = ti.bid; u < nun; u += ti.nblk) {
        if (u < 1024) { const int bh = u >> 4, qb = u & 15; attn_unit(ti, a, bh >> 3, bh & 7, (bh >> 3) * 2048 + qb * 128, 0, 36, mfix, lam, lam_init, subg, ldsg); }
        else { const int v = u - 1024, bh = v >> 1, qb = v & 1; attn_unit(ti, a, bh >> 3, bh & 7, ML + (bh >> 3) * 256 + qb * 128, 32, 36, mfix, lam, lam_init, subg, ldsg); }
    }
}

__device__ __forceinline__ void up8(const bf16_t* p, float (&x)[8]) { const u32x4 v = *(const u32x4*)p;
#pragma unroll
    for (int i = 0; i < 4; ++i) { x[2 * i] = bf2f(v[i] & 0xffffu); x[2 * i + 1] = bf2f(v[i] >> 16); } }
__device__ __forceinline__ void ld8f(const float* p, float (&x)[8]) { const f32x4 u = *(const f32x4*)p, v = *(const f32x4*)(p + 4); x[0] = u.x; x[1] = u.y; x[2] = u.z; x[3] = u.w; x[4] = v.x; x[5] = v.y; x[6] = v.z; x[7] = v.w; }
__device__ __forceinline__ void shift8(const bf16_t* p, const float* mu, bool hp, bool hn, float (&z)[8]) {
    float x[8], xp[8], xn[8], m[8];
#pragma unroll
    for (int j = 0; j < 8; ++j) { xp[j] = 0.f; xn[j] = 0.f; }
    up8(p, x); if (hp) up8(p - RWP, xp); if (hn) up8(p + RWP, xn); ld8f(mu, m);
#pragma unroll
    for (int j = 0; j < 8; ++j) z[j] = x[j] + m[j] * (0.5f * (xp[j] + xn[j]) - x[j]);
}
__device__ __forceinline__ void rwkv_out_rows(CArgs& a, int l, int nrows, int gw, int ngw, int lane) {
    const bf16_t* RW = (const bf16_t*)(a.ws + WS_RW); const bf16_t* Y0 = (const bf16_t*)(a.ws + WS_H); bf16_t* Y1 = (bf16_t*)(a.ws + WS_Y1);
    const bf16_t* A0 = (const bf16_t*)(a.ws + WS_AA0); const bf16_t* A1 = (const bf16_t*)(a.ws + WS_AA1); const bf16_t* G = (const bf16_t*)(a.ws + WS_G);
    const float* mu = a.in[16] + l * 3488;
    for (int it = gw; it < 2 * nrows; it += ngw) {
        const int row = it >> 1, c0 = (it & 1) * 512 + 8 * lane;
        int t, Tn; if (row < ML) { t = row & 2047; Tn = 2048; } else { t = (row - ML) & 255; Tn = 256; }
        const bool hp = t > 0, hn = t < Tn - 1;
        const size_t idx = (size_t)row * 1024 + c0;
        float y[8], y1[8], g[8], a0[8], a1[8], zr[8], zk[8], zv[8], lnw[8], lnb[8], ka[8], rk[8];
        up8(Y0 + idx, y); up8(Y1 + idx, y1); up8(G + idx, g); up8(A0 + idx, a0); up8(A1 + idx, a1);
        const bf16_t* p = RW + (size_t)row * RWP + c0;
        shift8(p, mu + c0, hp, hn, zr); shift8(p + 1024, mu + 1024 + c0, hp, hn, zk); shift8(p + 2048, mu + 2048 + c0, hp, hn, zv);
        ld8f(a.in[25] + l * 1024 + c0, lnw); ld8f(a.in[26] + l * 1024 + c0, lnb); ld8f(a.in[23] + l * 1024 + c0, ka); ld8f(a.in[24] + l * 1024 + c0, rk);
        float sm = 0.f;
#pragma unroll
        for (int j = 0; j < 8; ++j) { y[j] += y1[j]; sm += y[j]; }
        const float mean = dpp_sum8(sm) * (1.f / 64.f);
        float sv = 0.f, sb = 0.f;
#pragma unroll
        for (int j = 0; j < 8; ++j) { y[j] -= mean; sv += y[j] * y[j]; const float kds = zk[j] * ((1.f + (a0[j] - 1.f) * ka[j]) + (1.f + (a1[j] - 1.f) * ka[j])); sb += zr[j] * kds * rk[j]; }
        const float rstd = rsqrtf(dpp_sum8(sv) * (1.f / 64.f) + 64e-5f), bsum = dpp_sum8(sb);
        u32x4 o;
#pragma unroll
        for (int j = 0; j < 4; ++j) o[j] = pkbf(((y[2 * j] * rstd * lnw[2 * j] + lnb[2 * j]) + bsum * zv[2 * j]) * g[2 * j], ((y[2 * j + 1] * rstd * lnw[2 * j + 1] + lnb[2 * j + 1]) + bsum * zv[2 * j + 1]) * g[2 * j + 1]);
        *(u32x4*)(Y1 + idx) = o;
    }
}

#define XB_TMO      128
#define XB_XCNT(j)  (256  + 64 * (j))
#define XB_XSUB(j)  (1280 + 64 * (j))
#define XB_XGEN(j)  (2304 + 64 * (j))
#define XB_TOP      3328
#define XB_TOPGEN   3392
#define XCD_BAR_WORDS 3456
#define XB_SPIN_CAP (1u << 20)

__device__ __forceinline__ unsigned xb_ld(unsigned* p)              { return __hip_atomic_load(p, __ATOMIC_RELAXED, __HIP_MEMORY_SCOPE_AGENT); }
__device__ __forceinline__ unsigned xb_add(unsigned* p, unsigned v) { return __hip_atomic_fetch_add(p, v, __ATOMIC_RELAXED, __HIP_MEMORY_SCOPE_AGENT); }
__device__ __forceinline__ unsigned xb_xcc_id() { return (unsigned)__builtin_amdgcn_s_getreg((3 << 11) | 20) & 0xFu; }
#define XB_SPIN(cond, bar) do { unsigned _sp = 0; while (cond) { __builtin_amdgcn_s_sleep(1); \
    if ((++_sp & 255u) == 0u) { if (xb_ld(&(bar)[XB_TMO])) break; if (_sp > XB_SPIN_CAP) { atomicAdd(&(bar)[XB_TMO], 1u); break; } } } } while (0)

struct XcdBarrier {
    unsigned* bar; unsigned x;
    volatile LAS unsigned* st;
};

__device__ __forceinline__ XcdBarrier xcd_barrier_post(unsigned* bar, volatile LAS unsigned* st) {
    XcdBarrier b; b.bar = bar; b.x = xb_xcc_id(); b.st = st;
    if (threadIdx.x == 0) (void)xb_add(&bar[XB_XCNT(b.x)], 1u);
    return b;
}
__device__ __forceinline__ void xcd_barrier_complete(unsigned* bar, unsigned x, unsigned& nloc, unsigned& nx) {
    const unsigned G = gridDim.x * gridDim.y * gridDim.z;
    unsigned sum, cnt, mine, sp = 0u;
    for (;;) {
        sum = 0u; cnt = 0u; mine = 0u;
#pragma unroll
        for (unsigned j = 0; j < 16; ++j) { const unsigned c = xb_ld(&bar[XB_XCNT(j)]); sum += c; cnt += (c > 0u) ? 1u : 0u; mine = (j == x) ? c : mine; }
        if (sum == G) break;
        __builtin_amdgcn_s_sleep(1);
        if ((++sp & 255u) == 0u) { if (xb_ld(&bar[XB_TMO])) break; if (sp > XB_SPIN_CAP) { atomicAdd(&bar[XB_TMO], 1u); break; } }
    }
    nloc = mine > 0u ? mine : 1u; nx = cnt > 0u ? cnt : 1u;
}

__device__ __forceinline__ void xcd_barrier(const XcdBarrier& b) {
    asm volatile("s_waitcnt vmcnt(0)" ::: "memory");
    __syncthreads();
    if (threadIdx.x == 0) {
        unsigned* bar = b.bar;
        __builtin_amdgcn_s_waitcnt(0);
        unsigned nloc = b.st[0], nx = b.st[1];
        if (nloc == 0u) { xcd_barrier_complete(bar, b.x, nloc, nx); b.st[0] = nloc; b.st[1] = nx; }
        const unsigned old = xb_add(&bar[XB_XSUB(b.x)], 1u);
        const unsigned gen = old / nloc;
        if (old + 1u == (gen + 1u) * nloc) {
            __builtin_amdgcn_fence(__ATOMIC_RELEASE, "agent");
            asm volatile("s_waitcnt vmcnt(0)" ::: "memory");
            const unsigned og = xb_add(&bar[XB_TOP], 1u);
            const unsigned tg = og / nx;
            if (og + 1u == (tg + 1u) * nx) xb_add(&bar[XB_TOPGEN], 1u);
            else XB_SPIN(xb_ld(&bar[XB_TOPGEN]) == tg, bar);
            __builtin_amdgcn_fence(__ATOMIC_ACQUIRE, "agent");
            xb_add(&bar[XB_XGEN(b.x)], 1u);
            asm volatile("s_waitcnt vmcnt(0)" ::: "memory");
        } else {
            XB_SPIN(xb_ld(&bar[XB_XGEN(b.x)]) == gen, bar);
            __builtin_amdgcn_fence(__ATOMIC_ACQUIRE, "agent");
            asm volatile("s_waitcnt vmcnt(0)" ::: "memory");
        }
    }
    __syncthreads();
}

#ifndef ONLY_PH
#define ONLY_PH -1
#endif
#ifndef SKIP_PH
#define SKIP_PH -2
#endif
#define PH_ON(k) ((ONLY_PH < 0 || ONLY_PH == (k)) && (k) != SKIP_PH)
__global__ void __launch_bounds__(512, 2) mega_fwd(Args a_) {
    extern __shared__ __attribute__((aligned(16))) unsigned char lds[];
    cg::grid_group grid = cg::this_grid();
    const int ph_lo = a_.lo, ph_hi = a_.hi;
    volatile LAS unsigned* bst = (volatile LAS unsigned*)((LAS unsigned char*)lds + 131072);
    if (threadIdx.x < 2) bst[threadIdx.x] = 0u;
    __syncthreads();
    const XcdBarrier xbar = xcd_barrier_post((unsigned*)(a_.ws + WS_BAR), bst);
    const int wave_s = __builtin_amdgcn_readfirstlane((int)threadIdx.x >> 6);
#pragma nounroll
    for (int ph = ph_lo; ph < ph_hi; ++ph) {
        CArgs* ap = (CArgs*)__builtin_amdgcn_kernarg_segment_ptr(); asm volatile("" : "+s"(ap));
        CArgs& a = *ap;
        unsigned char* ws = a.ws;
        float* XC = (float*)(ws + WS_XC);
        int wsv = wave_s; asm volatile("" : "+s"(wsv));
        TI ti; ti.tid = wsv * 64 + (int)__builtin_amdgcn_mbcnt_hi(~0u, __builtin_amdgcn_mbcnt_lo(~0u, 0u)); ti.bid = blockIdx.x; ti.nblk = gridDim.x;
        asm volatile("" : "+v"(ti.tid)); asm volatile("" : "+s"(ti.bid)); asm volatile("" : "+s"(ti.nblk));
        const int tid = ti.tid, lane = tid & 63, wv = __builtin_amdgcn_readfirstlane(tid >> 6);
        const int gw = ti.bid * 8 + wv, ngw = ti.nblk * 8;
        if (ph == 0) { if constexpr (PH_ON(100)) ph_mods(ti, a, lds); }
        else {
            const int l = (ph - 1) / NPH, k = (ph - 1) % NPH;
            const bool ctx_out = l < DEPTH - 1;
            const int Mr = ctx_out ? M : ML;
            const float* modl = (const float*)(ws + WS_MOD) + (size_t)l * 9 * 6144;
            const float* xl_in = l == 0 ? a.in[0] : a.out; const float* xc_in = l == 0 ? a.in[2] : XC;
            bf16_t* H = (bf16_t*)(ws + WS_H);
            switch (k) {
            case 0: if constexpr (PH_ON(0)) {
                norm_rows(xl_in, xc_in, a.in[6] + l * 1024, modl, 0, 1, H, M, gw, ngw, lane);
                ph_wconv(a, l, lds, gw, ngw, lane, wv);
                } break;
            case 1: if constexpr (PH_ON(1)) {
                OpIn op{(bf16_t*)(ws + WS_GU), (bf16_t*)(ws + WS_GV), (bf16_t*)(ws + WS_Q), (bf16_t*)(ws + WS_RW), (bf16_t*)(ws + WS_GT)};
                run_gemm(ti, lds, H, (const bf16_t*)(ws + WS_WIN), M, PPAD, 1024, op);
            } break;
            case 2: if constexpr (PH_ON(2)) {
                for (int u = ti.bid; u < Mr / 128; u += ti.nblk) gmlp_unit(ti, a, l, u, lds);
                qk_rows(a, l, gw, ngw, lane);
                lora_in_rows(a, l, gw, ngw, lane);
                } break;
            case 3: if constexpr (PH_ON(3)) {
                OpDec o1{(bf16_t*)(ws + WS_GV), (bf16_t*)(ws + WS_DEC1), a.in[17] + l * 2048};
                run_gemm(ti, lds, (const bf16_t*)(ws + WS_LIW), (const bf16_t*)(ws + WS_LWT), M, 2048, 128, o1);
                OpAA o2{(bf16_t*)(ws + WS_AA0), (bf16_t*)(ws + WS_AA1), a.in[19] + l * 2048};
                run_gemm(ti, lds, (const bf16_t*)(ws + WS_LIA), (const bf16_t*)(ws + WS_LAT), M, 2048, 128, o2);
                OpG o3{(bf16_t*)(ws + WS_G)};
                run_gemm(ti, lds, (const bf16_t*)(ws + WS_LIG), (const bf16_t*)(ws + WS_LGT), M, 1024, 256, o3);
            } break;
            case 4:
                if constexpr (PH_ON(4)) { for (int u = ti.bid; u < 256; u += ti.nblk) scan_unit(ti, a, l, u, ctx_out, lds); }
                if constexpr (PH_ON(40)) ph_attn(ti, a, l, ctx_out, lds);
                break;
            case 5: if constexpr (PH_ON(5)) {
                rwkv_out_rows(a, l, Mr, gw, ngw, lane);
                } break;
            case 6: if constexpr (PH_ON(6)) {
                const bf16_t* GT = (const bf16_t*)(ws + WS_GT); float* MF = (float*)(ws + WS_K);
                OpMerge<0> o0{GT, MF, H}; run_gemm(ti, lds, (const bf16_t*)(ws + WS_GU), (const bf16_t*)(ws + WS_WA), Mr, 1024, 1024, o0);
                OpMerge<1> o1{GT, MF, H}; run_gemm(ti, lds, (const bf16_t*)(ws + WS_Q), (const bf16_t*)(ws + WS_WB), Mr, 1024, 1024, o1);
                OpMerge<2> o2{GT, MF, H}; run_gemm(ti, lds, (const bf16_t*)(ws + WS_Y1), (const bf16_t*)(ws + WS_WC), Mr, 1024, 1024, o2);
            } break;
            case 7: if constexpr (PH_ON(7)) {
                OpResid op{xl_in, xc_in, a.out, XC, modl, 2};
                run_gemm(ti, lds, H, (const bf16_t*)(ws + WS_WO), Mr, 1024, 1024, op);
            } break;
            case 8: if constexpr (PH_ON(8)) {
                norm_rows(a.out, XC, a.in[7] + l * 1024, modl, 3, 4, H, Mr, gw, ngw, lane);
                } break;
            case 9: if constexpr (PH_ON(9)) {
                OpSwiglu op{(bf16_t*)(ws + WS_RW)};
                run_gemm(ti, lds, H, (const bf16_t*)(ws + WS_WI), Mr, 2 * DFF, 1024, op);
            } break;
            default: if constexpr (PH_ON(10)) {
                OpResid op{a.out, XC, a.out, XC, modl, 5};
                run_gemm(ti, lds, (const bf16_t*)(ws + WS_RW), (const bf16_t*)(ws + WS_WO2), Mr, 1024, DFF, op);
            } break;
            }
        }
        if (ph + 1 < ph_hi) { if (ph == ph_lo) grid.sync(); else xcd_barrier(xbar); }
    }
}

extern "C" void kernel_launch(void* const* d_in, const int* in_sizes, int n_in, void* d_out, int out_size, void* d_ws, size_t ws_size, hipStream_t stream) {
    static int grid = 0;
    if (grid == 0) {
        if (n_in != 33 || out_size != ML * D || ws_size < WS_END) { fprintf(stderr, "kernel_launch: unexpected shapes / workspace (%d inputs, out %d, ws %zu, need %zu)\n", n_in, out_size, ws_size, (size_t)WS_END); grid = -1; return; }
        int dev = 0, cus = 0, per_cu = 0;
        hipGetDevice(&dev); hipDeviceGetAttribute(&cus, hipDeviceAttributeMultiprocessorCount, dev);
        if (hipFuncSetAttribute((const void*)mega_fwd, hipFuncAttributeMaxDynamicSharedMemorySize, LDS_BYTES) != hipSuccess) { fprintf(stderr, "kernel_launch: hipFuncSetAttribute failed\n"); grid = -1; return; }
        if (hipOccupancyMaxActiveBlocksPerMultiprocessor(&per_cu, (const void*)mega_fwd, 512, LDS_BYTES) != hipSuccess || per_cu < 1) per_cu = 1;
        (void)hipGetLastError();
        grid = cus * 1;
    }
    if (grid < 0) return;
    Args a{};
    for (int i = 0; i < 33; ++i) a.in[i] = (const float*)d_in[i];
    a.out = (float*)d_out; a.ws = (unsigned char*)d_ws; a.lo = 0; a.hi = NPHASES;
    void* args[] = {&a};
    if (hipMemsetAsync((char*)d_ws + WS_BAR, 0, BAR_BYTES, stream) != hipSuccess) { fprintf(stderr, "kernel_launch: memset of barrier words failed\n"); return; }
    hipError_t e = hipLaunchCooperativeKernel((const void*)mega_fwd, dim3(grid), dim3(512), args, LDS_BYTES, stream);
    if (e != hipSuccess) fprintf(stderr, "kernel_launch: cooperative launch failed: %s (grid %d)\n", hipGetErrorString(e), grid);
}
```

```cpp
#include <hip/hip_runtime.h>
#include <hip/hip_cooperative_groups.h>
#include <cstdio>
#include <cstdint>
namespace cg = cooperative_groups;
namespace pg8 {
#define PG8_LAS __attribute__((address_space(3)))
typedef unsigned short bf16_t;
typedef short bf16x8 __attribute__((ext_vector_type(8)));
typedef float f32x4 __attribute__((ext_vector_type(4)));
typedef unsigned u32x4 __attribute__((ext_vector_type(4)));
constexpr int BM = 256, BK = 64, HALF = 128, HTB = HALF * BK * 2  , STAGE_BYTES = 8 * HTB, NXCD = 8, WGM = 8;

__host__ __device__ __forceinline__ int lds_byte(int r, int c) { const int st = (r >> 4) * 2 + (c >> 5), rr = r & 15, cc = c & 31, ob = rr * 64 + cc * 2; return st * 1024 + (ob ^ (((ob >> 9) & 1) << 5)); }
__host__ __device__ __forceinline__ void stage_rc(int b, int& R, int& C) { const int st = b / 1024, sb = b % 1024, swz = sb ^ (((sb >> 9) & 1) << 5); R = (st >> 1) * 16 + swz / 64; C = (st & 1) * 32 + (swz % 64) / 2; }
__host__ __device__ __forceinline__ int perm32(int rho) { const int n = rho >> 4, i = rho & 15; return 8 * (i >> 2) + 4 * n + (i & 3); }

struct Unit { int pm, pn; };
struct Gemm { const bf16_t* A; const bf16_t* Bt; int M, N, K; };

struct StaticOrder {
    int nM, nN, nwg, G, c;
    __host__ __device__ void init(int M, int N, int G_, int c_) { nM = M / BM; nN = N / BM; nwg = nM * nN; G = G_; c = c_; }
    __host__ __device__ bool next(int i, Unit& u) const {
        const long L = (long)i * G + c; if (L >= nwg) return false;
        int wgid = (int)L; { const int q = nwg / NXCD, r = nwg % NXCD, xcd = wgid % NXCD, off = wgid / NXCD; wgid = (xcd < r ? xcd * (q + 1) : r * (q + 1) + (xcd - r) * q) + off; }
        const int nig = WGM * nN, gid = wgid / nig, fm = gid * WGM, gsz = (nM - fm) < WGM ? (nM - fm) : WGM;
        u.pm = fm + ((wgid % nig) % gsz); u.pn = (wgid % nig) / gsz; return true;
    }
    __device__ __forceinline__ void a_ready(const Unit&) const {}
    __device__ __forceinline__ void done(const Unit&) const {}
};

__device__ __forceinline__ unsigned cvt_pk_bf16(float lo, float hi) { unsigned r; asm volatile("v_cvt_pk_bf16_f32 %0, %1, %2" : "=v"(r) : "v"(lo), "v"(hi)); return r; }
typedef float f32x2 __attribute__((ext_vector_type(2)));
__device__ __forceinline__ f32x2 gelu_pk(f32x2 v) {
    const f32x2 av = __builtin_elementwise_abs(v), d = av * 0.2316418882f + 1.0f;
    f32x2 t; t.x = __builtin_amdgcn_rcpf(d.x); t.y = __builtin_amdgcn_rcpf(d.y);
    f32x2 q = t * 0.5307027145f + (-0.7265760135f); q = q * t + 0.7107068705f; q = q * t + (-0.142248368f); q = q * t + 0.127414796f; q = q * t;
    const f32x2 s = (v * v) * (-0.72134752044f);
    f32x2 e; e.x = __builtin_amdgcn_exp2f(s.x); e.y = __builtin_amdgcn_exp2f(s.y);
    const f32x2 m = v * (q * e), r = v - m;
    f32x2 o; o.x = v.x < 0.f ? m.x : r.x; o.y = v.y < 0.f ? m.y : r.y; return o;
}

template <class Epi, class Sched, bool ALIGN_EPI = false, bool SP2 = false>
__device__ __forceinline__ void gemm_phase(PG8_LAS unsigned char* lds, const Gemm g, const Sched& S, const Epi& E, const int tid_in) {
    const int tid = tid_in, wid = __builtin_amdgcn_readfirstlane(tid >> 6), lane = tid & 63, wr = wid >> 2, wc = wid & 3, fr = lane & 15, fq = lane >> 4;
    const int K = g.K, nt = K / BK;
    unsigned voffA[2], voffB[2];
#pragma unroll
    for (int i = 0; i < 2; ++i) { int R, C; stage_rc(tid * 16 + i * 8192, R, C); const int Rb = Epi::PERM ? ((R & ~31) + perm32(R & 31)) : R;
        voffA[i] = (unsigned)(R * K + C) * 2u; voffB[i] = (unsigned)(Rb * K + C) * 2u; }
    const size_t kstep = (size_t)(BK * 2);
    const size_t hstep = (size_t)HALF * K * 2;
    const size_t tstep = 2 * hstep;
    const unsigned ldsw = (unsigned)wid * 1024u;
    const int aoff = lds_byte(wr * 64 + fr, fq * 8), boff = lds_byte(wc * 32 + fr, fq * 8);
#define PG8_SA(b, h) (((b) * 2 + (h)) * HTB)
#define PG8_SB(b, h) ((4 + (b) * 2 + (h)) * HTB)
#define PG8_STAGE(bufoff, gbase, voff) do { _Pragma("unroll") for (int _i = 0; _i < 2; ++_i) \
        __builtin_amdgcn_global_load_lds((const unsigned*)((const char*)(gbase) + (voff)[_i]), (PG8_LAS unsigned*)(lds + (bufoff) + ldsw + _i * 8192), 16, 0, 0); } while (0)
#define PG8_LDA(dst, b, h) do { _Pragma("unroll") for (int m = 0; m < 4; ++m) _Pragma("unroll") for (int k = 0; k < 2; ++k) dst[m][k] = *(const PG8_LAS bf16x8*)(lds + PG8_SA(b, h) + aoff + m * 2048 + k * 1024); } while (0)
#define PG8_LDB(dst, b, h) do { _Pragma("unroll") for (int n = 0; n < 2; ++n) _Pragma("unroll") for (int k = 0; k < 2; ++k) dst[n][k] = *(const PG8_LAS bf16x8*)(lds + PG8_SB(b, h) + boff + n * 2048 + k * 1024); } while (0)
#define PG8_MMA(ai, bj, At, Bt) do { __builtin_amdgcn_s_setprio(1); _Pragma("unroll") for (int m = 0; m < 4; ++m) _Pragma("unroll") for (int n = 0; n < 2; ++n) _Pragma("unroll") for (int k = 0; k < 2; ++k) \
        acc[ai][bj][m][n] = __builtin_amdgcn_mfma_f32_16x16x32_bf16(Bt[n][k], At[m][k], acc[ai][bj][m][n], 0, 0, 0); __builtin_amdgcn_s_setprio(0); } while (0)
#define PG8_WAIT_V(n) asm volatile("s_waitcnt vmcnt(" #n ")" ::: "memory")
#define PG8_WAIT_L(n) asm volatile("s_waitcnt lgkmcnt(" #n ")" ::: "memory")
#define PG8_BAR __builtin_amdgcn_s_barrier()
#define PG8_SCHED __builtin_amdgcn_sched_barrier(0)
    Unit cur, nxt; int ui = 0;
    if (!S.next(0, cur)) return;
    f32x4 acc[2][2][4][2];
#pragma unroll
    for (int a = 0; a < 2; ++a)
#pragma unroll
        for (int b = 0; b < 2; ++b)
#pragma unroll
            for (int m = 0; m < 4; ++m)
#pragma unroll
                for (int n = 0; n < 2; ++n) acc[a][b][m][n] = (f32x4){0.f, 0.f, 0.f, 0.f};
    bf16x8 At[4][2], B0[2][2], B1[2][2];
    const char* cA = (const char*)g.A + (size_t)cur.pm * tstep; const char* cB = (const char*)g.Bt + (size_t)cur.pn * tstep;
    S.a_ready(cur);
    if constexpr (SP2) {
        PG8_STAGE(PG8_SB(0, 0), cB, voffB); PG8_STAGE(PG8_SB(0, 1), cB + hstep, voffB); PG8_STAGE(PG8_SA(0, 0), cA, voffA); PG8_STAGE(PG8_SA(0, 1), cA + hstep, voffA);
        if (wr == 1) PG8_BAR;
        PG8_WAIT_V(2); PG8_BAR;
        PG8_STAGE(PG8_SB(1, 0), cB + kstep, voffB); PG8_STAGE(PG8_SA(1, 0), cA + kstep, voffA); PG8_STAGE(PG8_SB(1, 1), cB + hstep + kstep, voffB);
        PG8_WAIT_V(6); PG8_BAR;
    } else {
        PG8_STAGE(PG8_SB(0, 0), cB, voffB); PG8_STAGE(PG8_SA(0, 0), cA, voffA); PG8_STAGE(PG8_SB(0, 1), cB + hstep, voffB); PG8_STAGE(PG8_SA(0, 1), cA + hstep, voffA);
        if (wr == 1) PG8_BAR;
        PG8_WAIT_V(4); PG8_BAR;
        PG8_STAGE(PG8_SB(1, 0), cB + kstep, voffB); PG8_STAGE(PG8_SA(1, 0), cA + kstep, voffA); PG8_STAGE(PG8_SB(1, 1), cB + hstep + kstep, voffB);
        PG8_WAIT_V(6); PG8_BAR;
    }
    for (;;) {
        const bool has_next = S.next(ui + 1, nxt);
        const char* nA = has_next ? (const char*)g.A + (size_t)nxt.pm * tstep : cA; const char* nB = has_next ? (const char*)g.Bt + (size_t)nxt.pn * tstep : cB;
        for (int t = 0; t < nt; t += 2) {
            const bool last = (t == nt - 2);
            const char* a1 = cA + (size_t)(t + 1) * kstep;
            const char* a2 = last ? nA : cA + (size_t)(t + 2) * kstep; const char* b2 = last ? nB : cB + (size_t)(t + 2) * kstep;
            const char* a3 = a2 + kstep; const char* b3 = b2 + kstep;
            if (last && has_next) S.a_ready(nxt);
            if constexpr (SP2) {
            PG8_LDB(B0, 0, 0); PG8_LDB(B1, 0, 1); PG8_SCHED; PG8_LDA(At, 0, 0); PG8_STAGE(PG8_SA(1, 1), a1 + hstep, voffA);
            PG8_WAIT_V(8); PG8_WAIT_L(0); PG8_BAR; PG8_MMA(0, 0, At, B0); PG8_MMA(0, 1, At, B1); PG8_BAR; PG8_SCHED;
            PG8_LDA(At, 0, 1); PG8_STAGE(PG8_SB(0, 0), b2, voffB); PG8_STAGE(PG8_SB(0, 1), b2 + hstep, voffB); PG8_STAGE(PG8_SA(0, 0), a2, voffA);
            PG8_WAIT_V(8); PG8_WAIT_L(0); PG8_BAR; PG8_MMA(1, 0, At, B0); PG8_MMA(1, 1, At, B1); PG8_BAR; PG8_SCHED;
            PG8_LDB(B0, 1, 0); PG8_LDB(B1, 1, 1); PG8_SCHED; PG8_LDA(At, 1, 0); PG8_STAGE(PG8_SA(0, 1), a2 + hstep, voffA);
            PG8_WAIT_V(8); PG8_WAIT_L(0); PG8_BAR; PG8_MMA(0, 0, At, B0); PG8_MMA(0, 1, At, B1); PG8_BAR; PG8_SCHED;
            PG8_LDA(At, 1, 1); PG8_STAGE(PG8_SB(1, 0), b3, voffB); PG8_STAGE(PG8_SB(1, 1), b3 + hstep, voffB); PG8_STAGE(PG8_SA(1, 0), a3, voffA);
            PG8_WAIT_V(8); PG8_WAIT_L(0); PG8_BAR; PG8_MMA(1, 0, At, B0); PG8_MMA(1, 1, At, B1); PG8_BAR; PG8_SCHED;
            } else {
            PG8_LDB(B0, 0, 0); PG8_SCHED; PG8_LDA(At, 0, 0); PG8_STAGE(PG8_SA(1, 1), a1 + hstep, voffA);
            PG8_WAIT_L(8); PG8_BAR; PG8_WAIT_L(0); PG8_MMA(0, 0, At, B0); PG8_BAR; PG8_SCHED;
            PG8_LDB(B1, 0, 1); PG8_STAGE(PG8_SB(0, 0), b2, voffB);
            PG8_BAR; PG8_WAIT_L(0); PG8_MMA(0, 1, At, B1); PG8_BAR;
            PG8_LDA(At, 0, 1); PG8_STAGE(PG8_SA(0, 0), a2, voffA);
            PG8_BAR; PG8_WAIT_L(0); PG8_MMA(1, 0, At, B0); PG8_BAR; PG8_SCHED;
            PG8_STAGE(PG8_SB(0, 1), b2 + hstep, voffB);
            PG8_WAIT_V(6); PG8_BAR; PG8_MMA(1, 1, At, B1); PG8_BAR;
            PG8_LDB(B0, 1, 0); PG8_SCHED; PG8_LDA(At, 1, 0); PG8_STAGE(PG8_SA(0, 1), a2 + hstep, voffA);
            PG8_WAIT_L(8); PG8_BAR; PG8_WAIT_L(0); PG8_MMA(0, 0, At, B0); PG8_BAR; PG8_SCHED;
            PG8_LDB(B1, 1, 1); PG8_STAGE(PG8_SB(1, 0), b3, voffB);
            PG8_BAR; PG8_WAIT_L(0); PG8_MMA(0, 1, At, B1); PG8_BAR;
            PG8_LDA(At, 1, 1); PG8_STAGE(PG8_SA(1, 0), a3, voffA);
            PG8_BAR; PG8_WAIT_L(0); PG8_MMA(1, 0, At, B0); PG8_BAR; PG8_SCHED;
            PG8_STAGE(PG8_SB(1, 1), b3 + hstep, voffB);
            PG8_WAIT_V(6); PG8_BAR; PG8_MMA(1, 1, At, B1); PG8_BAR;
            }
        }
        if constexpr (ALIGN_EPI) { if (wr == 0) PG8_BAR; }
        if constexpr (!Epi::AFTER_DRAIN) { E(acc, cur, wr, wc, fr, fq); S.done(cur); }
        if (!has_next) break;
#pragma unroll
        for (int a = 0; a < 2; ++a)
#pragma unroll
            for (int b = 0; b < 2; ++b)
#pragma unroll
                for (int m = 0; m < 4; ++m)
#pragma unroll
                    for (int n = 0; n < 2; ++n) acc[a][b][m][n] = (f32x4){0.f, 0.f, 0.f, 0.f};
        cur = nxt; cA = nA; cB = nB; ++ui;
        if constexpr (ALIGN_EPI) { if (wr == 1) PG8_BAR; }
    }
    PG8_WAIT_V(0);
    if constexpr (!ALIGN_EPI) { if (wr == 0) PG8_BAR; }
    PG8_BAR;
    if constexpr (Epi::AFTER_DRAIN) { E.fused(acc, cur, wr, wc, fr, fq, lds, wid, lane); S.done(cur); }
#undef PG8_SA
#undef PG8_SB
#undef PG8_STAGE
#undef PG8_LDA
#undef PG8_LDB
#undef PG8_MMA
#undef PG8_WAIT_V
#undef PG8_WAIT_L
#undef PG8_BAR
#undef PG8_SCHED
}
}

#define LAS __attribute__((address_space(3)))
typedef unsigned short bf16_t;
typedef float f32x2 __attribute__((ext_vector_type(2)));
typedef float f32x4 __attribute__((ext_vector_type(4)));
typedef float f32x16 __attribute__((ext_vector_type(16)));
typedef short bf16x8 __attribute__((ext_vector_type(8)));
typedef short s16x4 __attribute__((ext_vector_type(4)));
typedef unsigned u32x4 __attribute__((ext_vector_type(4)));
typedef unsigned u32x2 __attribute__((ext_vector_type(2)));
typedef __bf16 bf16x2v __attribute__((ext_vector_type(2)));
#define MFMA32(a, b, c) __builtin_amdgcn_mfma_f32_32x32x16_bf16((a), (b), (c), 0, 0, 0)

constexpr int D = 1024, NB = 8, TL = 2048, TCX = 256, DEPTH = 4;
constexpr int ML = NB * TL, MC = NB * TCX, M = ML + MC;
constexpr int PPAD = 11776, RWP = 3584, DFF = 2816;
constexpr int NPH = 11, NPHASES = 1 + DEPTH * NPH;
constexpr size_t MiB = 1u << 20;
constexpr size_t WS_MOD = 0, WS_WIN = 1 * MiB, WS_WA = 24 * MiB, WS_WB = 26 * MiB, WS_WC = 28 * MiB, WS_WO = 30 * MiB, WS_WI = 32 * MiB, WS_WO2 = 43 * MiB,
                 WS_LWT = 48 * MiB + MiB / 2, WS_LAT = 49 * MiB, WS_LGT = 49 * MiB + MiB / 2, WS_H = 50 * MiB, WS_XC = 86 * MiB, WS_GU = 94 * MiB, WS_GV = 130 * MiB,
                 WS_Q = 166 * MiB, WS_K = 202 * MiB, WS_V = 238 * MiB, WS_RW = 274 * MiB, WS_GT = 400 * MiB, WS_LIW = 508 * MiB, WS_LIA = 512 * MiB + MiB / 2,
                 WS_LIG = 517 * MiB, WS_DEC1 = 526 * MiB, WS_AA0 = 562 * MiB, WS_AA1 = 598 * MiB, WS_G = 634 * MiB, WS_Y1 = 670 * MiB, WS_ROPE = 706 * MiB, WS_END = 707 * MiB;
constexpr int LDS_BYTES = 131072 + 1024;
constexpr size_t WS_BAR = 917504, BAR_BYTES = 16384;
constexpr float QSCALE = 0.125f * 1.4426950408889634f;

struct Args { const float* in[33]; float* out; unsigned char* ws; int lo, hi; };
typedef const __attribute__((address_space(4))) Args CArgs;
struct TI { int tid, bid, nblk; };

__device__ __forceinline__ float bf2f(unsigned v) { return __uint_as_float(v << 16); }
__device__ __forceinline__ unsigned pkbf(float lo, float hi) { f32x2 v = {lo, hi}; bf16x2v b = __builtin_convertvector(v, bf16x2v); return __builtin_bit_cast(unsigned, b); }
__device__ __forceinline__ bf16_t f2bf(float f) { return (bf16_t)(pkbf(f, 0.f) & 0xffffu); }
#define DPP_ADD(x, ctrl) ((x) + __builtin_bit_cast(float, __builtin_amdgcn_update_dpp(0, __builtin_bit_cast(int, (x)), (ctrl), 0xf, 0xf, true)))
__device__ __forceinline__ float wave_sum(float v) {
    v = DPP_ADD(v, 0xB1); v = DPP_ADD(v, 0x4E); v = DPP_ADD(v, 0x141); v = DPP_ADD(v, 0x140);
    const int iv = __builtin_bit_cast(int, v);
    const float s0 = __builtin_bit_cast(float, __builtin_amdgcn_readlane(iv, 0)), s1 = __builtin_bit_cast(float, __builtin_amdgcn_readlane(iv, 16)),
                s2 = __builtin_bit_cast(float, __builtin_amdgcn_readlane(iv, 32)), s3 = __builtin_bit_cast(float, __builtin_amdgcn_readlane(iv, 48));
    return (s0 + s1) + (s2 + s3);
}
__device__ __forceinline__ float dpp_sum8(float x) {
    x += __builtin_bit_cast(float, __builtin_amdgcn_update_dpp(0, __builtin_bit_cast(int, x), 0xB1, 0xf, 0xf, true));
    x += __builtin_bit_cast(float, __builtin_amdgcn_update_dpp(0, __builtin_bit_cast(int, x), 0x4E, 0xf, 0xf, true));
    x += __builtin_bit_cast(float, __builtin_amdgcn_update_dpp(0, __builtin_bit_cast(int, x), 0x141, 0xf, 0xf, true));
    return x;
}
__device__ __forceinline__ float quad_sum(float x) { x = DPP_ADD(x, 0xB1); x = DPP_ADD(x, 0x4E); return x; }
__device__ __forceinline__ float quad_xor2(float x) { return __builtin_bit_cast(float, __builtin_amdgcn_update_dpp(0, __builtin_bit_cast(int, x), 0x4E, 0xf, 0xf, true)); }
__device__ __forceinline__ void unpack16(const bf16_t* p, float (&x)[16]) {
    const u32x4 a = *(const u32x4*)p, b = *(const u32x4*)(p + 8);
#pragma unroll
    for (int i = 0; i < 4; ++i) { x[2 * i] = bf2f(a[i] & 0xffffu); x[2 * i + 1] = bf2f(a[i] >> 16); x[8 + 2 * i] = bf2f(b[i] & 0xffffu); x[8 + 2 * i + 1] = bf2f(b[i] >> 16); }
}
__device__ __forceinline__ void pack16(bf16_t* p, const float (&x)[16]) {
    u32x4 a, b;
#pragma unroll
    for (int i = 0; i < 4; ++i) { a[i] = pkbf(x[2 * i], x[2 * i + 1]); b[i] = pkbf(x[8 + 2 * i], x[8 + 2 * i + 1]); }
    *(u32x4*)p = a; *(u32x4*)(p + 8) = b;
}
__device__ __forceinline__ void load16f(const float* p, float (&x)[16]) {
#pragma unroll
    for (int i = 0; i < 4; ++i) { const f32x4 v = *(const f32x4*)(p + 4 * i); x[4 * i] = v.x; x[4 * i + 1] = v.y; x[4 * i + 2] = v.z; x[4 * i + 3] = v.w; }
}
__device__ __forceinline__ float sigmoidf_(float x) { return 1.f / (1.f + __expf(-x)); }

template <class Op> struct EpiT {
    static constexpr bool PERM = true, AFTER_DRAIN = false;
    Op op;
    __device__ __forceinline__ void operator()(const pg8::f32x4 (&acc)[2][2][4][2], const pg8::Unit& u, int wr, int wc, int fr, int fq) const {
        const int row0 = u.pm * 256 + wr * 64 + fr, col0 = u.pn * 256 + wc * 32 + 8 * fq;
#pragma unroll
        for (int ai = 0; ai < 2; ++ai)
#pragma unroll
            for (int m = 0; m < 4; ++m)
#pragma unroll
                for (int bj = 0; bj < 2; ++bj) { op(row0 + ai * 128 + m * 16, col0 + bj * 128, acc[ai][bj][m][0], acc[ai][bj][m][1]); asm volatile("" ::: "memory"); }
    }
};
__device__ __forceinline__ u32x4 pack8(f32x4 v0, f32x4 v1) { u32x4 o; o.x = pkbf(v0.x, v0.y); o.y = pkbf(v0.z, v0.w); o.z = pkbf(v1.x, v1.y); o.w = pkbf(v1.z, v1.w); return o; }
__device__ __forceinline__ void unpack8(u32x4 x, f32x4& v0, f32x4& v1) {
    v0.x = bf2f(x.x & 0xffffu); v0.y = bf2f(x.x >> 16); v0.z = bf2f(x.y & 0xffffu); v0.w = bf2f(x.y >> 16);
    v1.x = bf2f(x.z & 0xffffu); v1.y = bf2f(x.z >> 16); v1.z = bf2f(x.w & 0xffffu); v1.w = bf2f(x.w >> 16);
}
__device__ __forceinline__ f32x4 gelu4(f32x4 v) { pg8::f32x2 a = pg8::gelu_pk((pg8::f32x2){v.x, v.y}), b = pg8::gelu_pk((pg8::f32x2){v.z, v.w}); return (f32x4){a.x, a.y, b.x, b.y}; }
__device__ __forceinline__ f32x4 sig4(f32x4 v) { return (f32x4){sigmoidf_(v.x), sigmoidf_(v.y), sigmoidf_(v.z), sigmoidf_(v.w)}; }

struct OpIn {
    bf16_t *GU, *GV, *Q, *RW, *GT;
    __device__ __forceinline__ void operator()(int row, int col, f32x4 v0, f32x4 v1) const {
        bf16_t* dst;
        if (col < 2048) { v0 = gelu4(v0); v1 = gelu4(v1); dst = (col < 1024 ? GU : GV) + (size_t)row * 1024 + (col & 1023); }
        else if (col < 5120) { const int q = col - 2048; dst = Q + (size_t)(q >> 10) * (size_t)(18 * MiB) + (size_t)row * 1024 + (q & 1023); }
        else if (col < 8704) { dst = RW + (size_t)row * RWP + (col - 5120); }
        else { v0 = sig4(v0); v1 = sig4(v1); dst = GT + (size_t)row * 3072 + (col - 8704); }
        *(u32x4*)dst = pack8(v0, v1);
    }
};
struct OpDec {
    bf16_t *D0, *D1; const float* w0;
    __device__ __forceinline__ float f(float x) const { return -0.6065306597126334f * sigmoidf_(x); }
    __device__ __forceinline__ void operator()(int row, int col, f32x4 v0, f32x4 v1) const {
        const f32x4 b0 = *(const f32x4*)(w0 + col), b1 = *(const f32x4*)(w0 + col + 4);
        v0 += b0; v1 += b1;
        v0 = (f32x4){f(v0.x), f(v0.y), f(v0.z), f(v0.w)}; v1 = (f32x4){f(v1.x), f(v1.y), f(v1.z), f(v1.w)};
        bf16_t* dst = (col < 1024 ? D0 : D1) + (size_t)row * 1024 + (col & 1023);
        *(u32x4*)dst = pack8(v0, v1);
    }
};
struct OpAA {
    bf16_t *A0, *A1; const float* a0;
    __device__ __forceinline__ void operator()(int row, int col, f32x4 v0, f32x4 v1) const {
        const f32x4 b0 = *(const f32x4*)(a0 + col), b1 = *(const f32x4*)(a0 + col + 4);
        v0 = sig4(v0 + b0); v1 = sig4(v1 + b1);
        bf16_t* dst = (col < 1024 ? A0 : A1) + (size_t)row * 1024 + (col & 1023);
        *(u32x4*)dst = pack8(v0, v1);
    }
};
struct OpG {
    bf16_t* G;
    __device__ __forceinline__ void operator()(int row, int col, f32x4 v0, f32x4 v1) const { *(u32x4*)(G + (size_t)row * 1024 + col) = pack8(v0, v1); }
};
template <int KB> struct OpMerge {
    const bf16_t* GT; float* MF; bf16_t* MB;
    __device__ __forceinline__ void operator()(int row, int col, f32x4 v0, f32x4 v1) const {
        f32x4 g0, g1; unpack8(*(const u32x4*)(GT + (size_t)row * 3072 + KB * 1024 + col), g0, g1);
        float* mf = MF + (size_t)row * 1024 + col;
        f32x4 r0 = g0 * v0, r1 = g1 * v1;
        if (KB > 0) { r0 += *(const f32x4*)mf; r1 += *(const f32x4*)(mf + 4); }
        if (KB < 2) { *(f32x4*)mf = r0; *(f32x4*)(mf + 4) = r1; }
        else *(u32x4*)(MB + (size_t)row * 1024 + col) = pack8(r0, r1);
    }
};
struct OpResid {
    const float *xl, *xc; float *ol, *oc; const float* mod; int gi;
    __device__ __forceinline__ void operator()(int row, int col, f32x4 v0, f32x4 v1) const {
        const float* xi; float* xo; const float* g;
        if (row < ML) { xi = xl + (size_t)row * 1024 + col; xo = ol + (size_t)row * 1024 + col; g = mod + (size_t)(row >> 11) * 6144 + gi * 1024 + col; }
        else { const size_t rr = (size_t)(row - ML) * 1024 + col; xi = xc + rr; xo = oc + rr; g = mod + (size_t)8 * 6144 + gi * 1024 + col; }
        const f32x4 x0 = *(const f32x4*)xi, x1 = *(const f32x4*)(xi + 4), g0 = *(const f32x4*)g, g1 = *(const f32x4*)(g + 4);
        *(f32x4*)xo = x0 + g0 * v0; *(f32x4*)(xo + 4) = x1 + g1 * v1;
    }
};
struct OpSwiglu {
    bf16_t* HID;
    __device__ __forceinline__ void operator()(int row, int col, f32x4 v0, f32x4 v1) const {
        const float h0 = v0.x * sigmoidf_(v0.x) * v0.y, h1 = v0.z * sigmoidf_(v0.z) * v0.w, h2 = v1.x * sigmoidf_(v1.x) * v1.y, h3 = v1.z * sigmoidf_(v1.z) * v1.w;
        u32x2 o; o.x = pkbf(h0, h1); o.y = pkbf(h2, h3);
        *(u32x2*)(HID + (size_t)row * DFF + (col >> 1)) = o;
    }
};
template <class Op> __device__ __forceinline__ void run_gemm(const TI ti, unsigned char* lds, const bf16_t* A, const bf16_t* Bt, int Mr, int N, int K, const Op& op) {
    int Kv = K; asm volatile("" : "+s"(Kv));
    pg8::Gemm g{A, Bt, Mr, N, Kv}; pg8::StaticOrder S; S.init(Mr, N, ti.nblk, ti.bid);
    EpiT<Op> E{op};
    pg8::gemm_phase<EpiT<Op>, pg8::StaticOrder, true, true>((PG8_LAS unsigned char*)lds, g, S, E, ti.tid);
}

__device__ __forceinline__ void ph_mods(const TI ti, CArgs& a, unsigned char* ldsg) {
    float* sc = (float*)ldsg; float* part = sc + 9 * 1024;
    const int tid = ti.tid, lane = tid & 63, w = tid >> 6;
    for (int i = tid; i < 9 * 1024; i += 512) { const float v = (i < 8192) ? a.in[1][i] : a.in[3][i - 8192]; sc[i] = v / (1.f + expf(-v)); }
    __syncthreads();
    float* MOD = (float*)(a.ws + WS_MOD);
    for (int item = ti.bid; item < DEPTH * 96; item += ti.nblk) {
        const int l = item / 96, n0 = (item % 96) * 64;
        const float* W = a.in[4] + (size_t)l * 1024 * 6144 + n0 + lane;
        float acc[9];
#pragma unroll
        for (int r = 0; r < 9; ++r) acc[r] = 0.f;
#pragma unroll 8
        for (int k = w * 128; k < w * 128 + 128; ++k) {
            const float wv = W[(size_t)k * 6144];
#pragma unroll
            for (int r = 0; r < 9; ++r) acc[r] += sc[r * 1024 + k] * wv;
        }
#pragma unroll
        for (int r = 0; r < 9; ++r) part[(w * 9 + r) * 64 + lane] = acc[r];
        __syncthreads();
        for (int idx = tid; idx < 576; idx += 512) {
            const int r = idx >> 6, ln = idx & 63; float s = a.in[5][l * 6144 + n0 + ln];
            for (int ww = 0; ww < 8; ++ww) s += part[(ww * 9 + r) * 64 + ln];
            MOD[((size_t)l * 9 + r) * 6144 + n0 + ln] = s;
        }
        __syncthreads();
    }
    float* RC = (float*)(a.ws + WS_ROPE); float* RS = RC + 2048 * 32;
    for (int idx = ti.bid * 512 + tid; idx < 2048 * 32; idx += ti.nblk * 512) {
        const int t = idx >> 5, i = idx & 31; const float pos = i < 16 ? (float)(t >> 6) : (float)(t & 63);
        const float ang = pos * exp2f(-(float)(i & 15) * (13.287712379549449f / 16.f));
        RC[idx] = cosf(ang); RS[idx] = sinf(ang);
    }
}

__device__ __forceinline__ void norm_rows(const float* xl, const float* xc, const float* g, const float* modl, int shi, int sci, bf16_t* H, int nrows, int gw, int ngw, int lane) {
    for (int row = gw; row < nrows; row += ngw) {
        const float* src; int r;
        if (row < ML) { src = xl + (size_t)row * D; r = row >> 11; } else { src = xc + (size_t)(row - ML) * D; r = 8; }
        const float* md = modl + (size_t)r * 6144;
        f32x4 v[4]; float ss = 0.f;
#pragma unroll
        for (int j = 0; j < 4; ++j) { v[j] = *(const f32x4*)(src + 4 * lane + 256 * j); ss += (v[j].x * v[j].x + v[j].y * v[j].y) + (v[j].z * v[j].z + v[j].w * v[j].w); }
        ss = wave_sum(ss);
        const float rstd = rsqrtf(ss * (1.f / 1024.f) + 1e-6f);
#pragma unroll
        for (int j = 0; j < 4; ++j) {
            const int c = 4 * lane + 256 * j;
            const f32x4 gg = *(const f32x4*)(g + c), scv = *(const f32x4*)(md + sci * 1024 + c), shv = *(const f32x4*)(md + shi * 1024 + c);
            const f32x4 o = v[j] * rstd * gg * (1.f + scv) + shv;
            u32x2 p; p.x = pkbf(o.x, o.y); p.y = pkbf(o.z, o.w);
            *(u32x2*)(H + (size_t)row * D + c) = p;
        }
    }
}

template <int MODE> __device__ __forceinline__ void transpose_item(const float* W, int K, int N, bf16_t* WT, LAS float* scr, int item, int lane) {
    const int nblk = N / 32, kb = item / nblk, nb = item % nblk, k0 = 64 * kb, n0 = 32 * nb;
#pragma unroll 8
    for (int i = 0; i < 32; ++i) { const int kk = 2 * i + (lane >> 5); scr[kk * 33 + (lane & 31)] = W[(size_t)(k0 + kk) * N + n0 + (lane & 31)]; }
    asm volatile("s_waitcnt lgkmcnt(0)" ::: "memory");
    const int c = lane & 7;
#pragma unroll
    for (int j = 0; j < 4; ++j) {
        const int n = (lane >> 3) + 8 * j, gn = n0 + n; const LAS float* s = scr + (8 * c) * 33 + n;
        const int drow = MODE == 0 ? gn : (MODE == 1 ? (gn >= 8608 ? gn + 96 : gn) : (gn < DFF ? 2 * gn : 2 * (gn - DFF) + 1));
        u32x4 o; o.x = pkbf(s[0 * 33], s[1 * 33]); o.y = pkbf(s[2 * 33], s[3 * 33]); o.z = pkbf(s[4 * 33], s[5 * 33]); o.w = pkbf(s[6 * 33], s[7 * 33]);
        *(u32x4*)(WT + (size_t)drow * K + k0 + 8 * c) = o;
    }
    asm volatile("s_waitcnt lgkmcnt(0)" ::: "memory");
}
__device__ __forceinline__ void ph_wconv(CArgs& a, int l, unsigned char* ldsg, int gw, int ngw, int lane, int wv) {
    LAS float* scr = (LAS float*)(ldsg + wv * 8704);
    unsigned char* ws = a.ws;
    constexpr int I_IN = 16 * 365, I_SQ = 16 * 32, I_WI = 16 * 176, I_WO = 44 * 32, NIT = I_IN + 4 * I_SQ + I_WI + I_WO;
    for (int it = gw; it < NIT; it += ngw) {
        int r = it;
        if (r < I_IN) { transpose_item<1>(a.in[8] + (size_t)l * 1024 * 11680, 1024, 11680, (bf16_t*)(ws + WS_WIN), scr, r, lane); continue; } r -= I_IN;
        if (r < I_SQ) { transpose_item<0>(a.in[27] + (size_t)l * 1048576, 1024, 1024, (bf16_t*)(ws + WS_WA), scr, r, lane); continue; } r -= I_SQ;
        if (r < I_SQ) { transpose_item<0>(a.in[28] + (size_t)l * 1048576, 1024, 1024, (bf16_t*)(ws + WS_WB), scr, r, lane); continue; } r -= I_SQ;
        if (r < I_SQ) { transpose_item<0>(a.in[29] + (size_t)l * 1048576, 1024, 1024, (bf16_t*)(ws + WS_WC), scr, r, lane); continue; } r -= I_SQ;
        if (r < I_SQ) { transpose_item<0>(a.in[30] + (size_t)l * 1048576, 1024, 1024, (bf16_t*)(ws + WS_WO), scr, r, lane); continue; } r -= I_SQ;
        if (r < I_WI) { transpose_item<2>(a.in[31] + (size_t)l * 1024 * 5632, 1024, 5632, (bf16_t*)(ws + WS_WI), scr, r, lane); continue; } r -= I_WI;
        transpose_item<0>(a.in[32] + (size_t)l * DFF * 1024, DFF, 1024, (bf16_t*)(ws + WS_WO2), scr, r, lane);
    }
    const int gt = gw * 64 + lane, ngt = ngw * 64;
    bf16_t* LWT = (bf16_t*)(ws + WS_LWT); bf16_t* LAT = (bf16_t*)(ws + WS_LAT); bf16_t* LGT = (bf16_t*)(ws + WS_LGT);
    const float* w2 = a.in[18] + (size_t)l * 2 * 64 * 1024; const float* a2 = a.in[20] + (size_t)l * 2 * 64 * 1024; const float* g2 = a.in[21] + (size_t)l * 160 * 1024;
    for (int i = gt; i < 2048 * 128; i += ngt) {
        const int n = i >> 7, k = i & 127, d = n >> 10, c = n & 1023, kk = k - d * 64;
        const bool in = (kk >= 0 && kk < 64);
        LWT[i] = in ? f2bf(w2[((size_t)d * 64 + kk) * 1024 + c]) : (bf16_t)0;
        LAT[i] = in ? f2bf(a2[((size_t)d * 64 + kk) * 1024 + c]) : (bf16_t)0;
    }
    for (int i = gt; i < 1024 * 256; i += ngt) { const int n = i >> 8, k = i & 255; LGT[i] = k < 160 ? f2bf(g2[(size_t)k * 1024 + n]) : (bf16_t)0; }
    bf16_t* WIN = (bf16_t*)(ws + WS_WIN);
    for (int i = gt; i < 96 * 1024; i += ngt) WIN[(size_t)8608 * 1024 + i] = 0;
}

__device__ __forceinline__ void gmlp_unit(const TI ti, CArgs& a, int l, int u, unsigned char* ldsg) {
    float* rstd = (float*)ldsg; bf16_t* VNT = (bf16_t*)(ldsg + 512);
    const int tid = ti.tid, lane = tid & 63, w = tid >> 6, r = lane & 31, h = lane >> 5;
    bf16_t* GU = (bf16_t*)(a.ws + WS_GU); const bf16_t* GV = (const bf16_t*)(a.ws + WS_GV);
    const size_t R0 = (size_t)u * 128;
#pragma unroll 4
    for (int i = 0; i < 16; ++i) {
        const int tok = w * 16 + i; const bf16_t* p = GV + (R0 + tok) * 1024 + lane * 16;
        f32x4 x0, x1, x2, x3; unpack8(*(const u32x4*)p, x0, x1); unpack8(*(const u32x4*)(p + 8), x2, x3);
        float ss = (x0.x * x0.x + x0.y * x0.y + x0.z * x0.z + x0.w * x0.w) + (x1.x * x1.x + x1.y * x1.y + x1.z * x1.z + x1.w * x1.w)
                 + (x2.x * x2.x + x2.y * x2.y + x2.z * x2.z + x2.w * x2.w) + (x3.x * x3.x + x3.y * x3.y + x3.z * x3.z + x3.w * x3.w);
        ss = wave_sum(ss);
        if (lane == 0) rstd[tok] = rsqrtf(ss * (1.f / 1024.f) + 1e-6f);
    }
    __syncthreads();
    const float* gvg = a.in[9] + l * 1024; const float* wsp = a.in[10] + (size_t)l * 8 * 128 * 128; const float* bsp = a.in[11] + l * 8 * 128;
    const int tt = w & 3, chh = w >> 2;
    for (int g = 0; g < 8; ++g) {
        {
            const int s = tid & 127, cc = tid >> 7; const float rs = rstd[s]; const bf16_t* p = GV + (R0 + s) * 1024 + g * 128 + cc * 32;
#pragma unroll
            for (int q = 0; q < 4; ++q) {
                f32x4 x0, x1; unpack8(*(const u32x4*)(p + 8 * q), x0, x1);
                const float* gp = gvg + g * 128 + cc * 32 + 8 * q; const int c0 = cc * 32 + 8 * q;
                VNT[(c0 + 0) * 136 + s] = f2bf(x0.x * rs * gp[0]); VNT[(c0 + 1) * 136 + s] = f2bf(x0.y * rs * gp[1]);
                VNT[(c0 + 2) * 136 + s] = f2bf(x0.z * rs * gp[2]); VNT[(c0 + 3) * 136 + s] = f2bf(x0.w * rs * gp[3]);
                VNT[(c0 + 4) * 136 + s] = f2bf(x1.x * rs * gp[4]); VNT[(c0 + 5) * 136 + s] = f2bf(x1.y * rs * gp[5]);
                VNT[(c0 + 6) * 136 + s] = f2bf(x1.z * rs * gp[6]); VNT[(c0 + 7) * 136 + s] = f2bf(x1.w * rs * gp[7]);
            }
        }
        __syncthreads();
        f32x16 acc0, acc1;
#pragma unroll
        for (int i = 0; i < 16; ++i) { acc0[i] = 0.f; acc1[i] = 0.f; }
        const float* wrow = wsp + ((size_t)g * 128 + tt * 32 + r) * 128;
#pragma unroll
        for (int ks = 0; ks < 8; ++ks) {
            const f32x4 a0 = *(const f32x4*)(wrow + 16 * ks + 8 * h), a1 = *(const f32x4*)(wrow + 16 * ks + 8 * h + 4);
            const bf16x8 af = __builtin_bit_cast(bf16x8, pack8(a0, a1));
            const bf16x8 b0 = *(const bf16x8*)(VNT + (chh * 64 + r) * 136 + 16 * ks + 8 * h);
            const bf16x8 b1 = *(const bf16x8*)(VNT + (chh * 64 + 32 + r) * 136 + 16 * ks + 8 * h);
            acc0 = MFMA32(af, b0, acc0); acc1 = MFMA32(af, b1, acc1);
        }
        {
            const bf16_t* GUr = GU; float uu0[16], uu1[16], bb[16];
#pragma unroll
            for (int reg = 0; reg < 16; ++reg) {
                const int t = tt * 32 + (reg & 3) + 8 * (reg >> 2) + 4 * h; const size_t i0 = (R0 + t) * 1024 + g * 128 + chh * 64 + r;
                bb[reg] = bsp[g * 128 + t]; uu0[reg] = bf2f(GUr[i0]); uu1[reg] = bf2f(GUr[i0 + 32]);
            }
            asm volatile("" ::: "memory");
#pragma unroll
            for (int reg = 0; reg < 16; ++reg) {
                const int t = tt * 32 + (reg & 3) + 8 * (reg >> 2) + 4 * h; const size_t i0 = (R0 + t) * 1024 + g * 128 + chh * 64 + r;
                GU[i0] = f2bf(uu0[reg] * (acc0[reg] + bb[reg])); GU[i0 + 32] = f2bf(uu1[reg] * (acc1[reg] + bb[reg]));
            }
        }
        __syncthreads();
    }
}
__device__ __forceinline__ void qk_rows(CArgs& a, int l, int gw, int ngw, int lane) {
    bf16_t* Q = (bf16_t*)(a.ws + WS_Q); bf16_t* K = (bf16_t*)(a.ws + WS_K);
    const float* RC = (const float*)(a.ws + WS_ROPE); const float* RS = RC + 2048 * 32;
    const int part = lane & 3;
    float gq[16], gk[16];
    load16f(a.in[12] + l * 64 + 16 * part, gq); load16f(a.in[13] + l * 64 + 16 * part, gk);
    for (int row = gw; row < M; row += ngw) {
        float xq[16], xk[16], cs[16], sn[16];
        unpack16(Q + (size_t)row * 1024 + 16 * lane, xq); unpack16(K + (size_t)row * 1024 + 16 * lane, xk);
        const bool lat = row < ML;
        if (lat) { const int t = row & 2047; load16f(RC + t * 32 + 16 * (part & 1), cs); load16f(RS + t * 32 + 16 * (part & 1), sn); }
        float sq = 0.f, sk = 0.f;
#pragma unroll
        for (int j = 0; j < 16; ++j) { sq += xq[j] * xq[j]; sk += xk[j] * xk[j]; }
        const float rq = rsqrtf(quad_sum(sq) * (1.f / 64.f) + 1e-6f), rk = rsqrtf(quad_sum(sk) * (1.f / 64.f) + 1e-6f);
#pragma unroll
        for (int j = 0; j < 16; ++j) { xq[j] = xq[j] * rq * gq[j]; xk[j] = xk[j] * rk * gk[j]; }
        if (lat) {
            const float sgn = part < 2 ? -1.f : 1.f;
#pragma unroll
            for (int j = 0; j < 16; ++j) {
                const float pq = quad_xor2(xq[j]), pk = quad_xor2(xk[j]);
                xq[j] = xq[j] * cs[j] + sgn * pq * sn[j]; xk[j] = xk[j] * cs[j] + sgn * pk * sn[j];
            }
        }
#pragma unroll
        for (int j = 0; j < 16; ++j) xq[j] *= QSCALE;
        pack16(Q + (size_t)row * 1024 + 16 * lane, xq); pack16(K + (size_t)row * 1024 + 16 * lane, xk);
    }
}
__device__ __forceinline__ void lora_in_rows(CArgs& a, int l, int gw, int ngw, int lane) {
    const bf16_t* RW = (const bf16_t*)(a.ws + WS_RW); bf16_t* LW = (bf16_t*)(a.ws + WS_LIW); bf16_t* LA = (bf16_t*)(a.ws + WS_LIA); bf16_t* LG = (bf16_t*)(a.ws + WS_LIG);
    const float* mu = a.in[16] + l * 3488 + 3072;
    f32x4 m0 = {0.f, 0.f, 0.f, 0.f}, m1 = m0;
    if (lane < 52) { m0 = *(const f32x4*)(mu + 8 * lane); m1 = *(const f32x4*)(mu + 8 * lane + 4); }
    for (int row = gw; row < M; row += ngw) {
        int t, Tn; if (row < ML) { t = row & 2047; Tn = 2048; } else { t = (row - ML) & 255; Tn = 256; }
        const bool hp = t > 0, hn = t < Tn - 1;
        if (lane < 52) {
            const bf16_t* p = RW + (size_t)row * RWP + 3072 + 8 * lane;
            f32x4 x0, x1, p0 = {0.f, 0.f, 0.f, 0.f}, p1 = p0, n0 = p0, n1 = p0;
            unpack8(*(const u32x4*)p, x0, x1);
            if (hp) unpack8(*(const u32x4*)(p - RWP), p0, p1);
            if (hn) unpack8(*(const u32x4*)(p + RWP), n0, n1);
            f32x4 z0 = x0 + m0 * (0.5f * (p0 + n0) - x0), z1 = x1 + m1 * (0.5f * (p1 + n1) - x1);
            const int j = 8 * lane;
            if (j < 128) { z0 = (f32x4){tanhf(z0.x), tanhf(z0.y), tanhf(z0.z), tanhf(z0.w)}; z1 = (f32x4){tanhf(z1.x), tanhf(z1.y), tanhf(z1.z), tanhf(z1.w)}; *(u32x4*)(LW + (size_t)row * 128 + j) = pack8(z0, z1); }
            else if (j < 256) { *(u32x4*)(LA + (size_t)row * 128 + j - 128) = pack8(z0, z1); }
            else { *(u32x4*)(LG + (size_t)row * 256 + j - 256) = pack8(sig4(z0), sig4(z1)); }
        } else {
            unsigned z_ = 0u; asm volatile("" : "+v"(z_)); *(u32x4*)(LG + (size_t)row * 256 + 160 + (lane - 52) * 8) = (u32x4){z_, z_, z_, z_};
        }
    }
}

__device__ __forceinline__ void scan_unit(const TI ti, CArgs& a, int l, int u, bool ctx_out, unsigned char* ldsg) {
    const int tid = ti.tid, lane = tid & 63, w = tid >> 6;
    const int b = u >> 5, hh = (u >> 1) & 15, d = u & 1;
    const int si = tid >> 3, jq = tid & 7;
    LAS float* L = (LAS float*)ldsg;
    const bf16_t* RW = (const bf16_t*)(a.ws + WS_RW);
    const bf16_t* DEC = (const bf16_t*)(a.ws + (d ? WS_DEC1 : WS_GV));
    const bf16_t* AA = (const bf16_t*)(a.ws + (d ? WS_AA1 : WS_AA0));
    bf16_t* Y = (bf16_t*)(a.ws + (d ? WS_Y1 : WS_H));
    const int ch = hh * 64 + lane;
    const float* mu = a.in[16] + l * 3488;
    const float mur = mu[ch], muk = mu[1024 + ch], muv = mu[2048 + ch], kkg = a.in[22][l * 1024 + ch], kag = a.in[23][l * 1024 + ch];
    f32x4 S0 = {0.f, 0.f, 0.f, 0.f}, S1 = {0.f, 0.f, 0.f, 0.f};
    unsigned raw[4][9]; unsigned dcr[4], aar[4];
    constexpr int NC = 72;
#define SCAN_CHUNK(n, base, Tn, t0, wy) int base, Tn, t0; bool wy; { int ci; if ((n) < 8) { base = ML + b * 256; Tn = 256; ci = d ? 7 - (n) : (n); wy = ctx_out; } else { base = b * 2048; Tn = 2048; ci = d ? 71 - (n) : (n) - 8; wy = true; } t0 = ci * 32; }
#define SCAN_LOAD(n) do { SCAN_CHUNK(n, base_, Tn_, t0_, wy_); (void)wy_; _Pragma("unroll") for (int i4 = 0; i4 < 4; ++i4) { const int t = t0_ + w + 8 * i4; const size_t row = (size_t)(base_ + t); \
        const bf16_t* p = RW + row * RWP + ch; const bool hp = t > 0, hn = t < Tn_ - 1; \
        const int op_ = hp ? -RWP : 0, on_ = hn ? RWP : 0;     \
        _Pragma("unroll") for (int X = 0; X < 3; ++X) { raw[i4][3 * X + 0] = (unsigned)p[X * 1024 + op_]; raw[i4][3 * X + 1] = (unsigned)p[X * 1024]; raw[i4][3 * X + 2] = (unsigned)p[X * 1024 + on_]; } \
        dcr[i4] = (unsigned)DEC[row * 1024 + ch]; aar[i4] = (unsigned)AA[row * 1024 + ch]; } } while (0)
#define SCAN_STORE(n) do { LAS float* Bf = L + ((n) & 1) * 12288; SCAN_CHUNK(n, base_, Tn_, t0_, wy_); (void)wy_; (void)base_; _Pragma("unroll") for (int i4 = 0; i4 < 4; ++i4) { const int tk = w + 8 * i4; \
        const float mp_ = (t0_ + tk > 0) ? 0.5f : 0.f, mn_ = (t0_ + tk < Tn_ - 1) ? 0.5f : 0.f; \
        const float xr = bf2f(raw[i4][1]), xk = bf2f(raw[i4][4]), xv = bf2f(raw[i4][7]); \
        const float zr = xr + mur * ((mp_ * bf2f(raw[i4][0]) + mn_ * bf2f(raw[i4][2])) - xr); \
        const float zk = xk + muk * ((mp_ * bf2f(raw[i4][3]) + mn_ * bf2f(raw[i4][5])) - xk); \
        const float zv = xv + muv * ((mp_ * bf2f(raw[i4][6]) + mn_ * bf2f(raw[i4][8])) - xv); \
        const float kkv = zk * kkg; const float ssq = wave_sum(kkv * kkv); const float kkn = kkv / fmaxf(sqrtf(ssq), 1e-12f); \
        const float ad = bf2f(aar[i4]); const float wv_ = __expf(bf2f(dcr[i4])); const float kd = zk * (1.f + (ad - 1.f) * kag); \
        Bf[0 * 2048 + tk * 64 + lane] = wv_; Bf[1 * 2048 + tk * 64 + lane] = kd; Bf[2 * 2048 + tk * 64 + lane] = -kkn; \
        Bf[3 * 2048 + tk * 64 + lane] = kkn * ad; Bf[4 * 2048 + tk * 64 + lane] = zr; Bf[5 * 2048 + tk * 64 + lane] = zv; } } while (0)
    SCAN_LOAD(0); SCAN_STORE(0);
    __syncthreads();
    for (int n = 0; n < NC; ++n) {
        if (n + 1 < NC) SCAN_LOAD(n + 1);
        LAS const float* Bf = L + (n & 1) * 12288; LAS float* Yb = L + 24576 + (n & 1) * 2048;
#define STEP_LOAD(P, sidx) LAS const float* q##P = Bf + (sidx) * 64 + 8 * jq + hoff; \
            const f32x4 w0##P = *(LAS const f32x4*)(q##P), w1##P = *(LAS const f32x4*)(q##P + hdq), k0##P = *(LAS const f32x4*)(q##P + 2048), k1##P = *(LAS const f32x4*)(q##P + 2048 + hdq), \
                        a0##P = *(LAS const f32x4*)(q##P + 4096), a1##P = *(LAS const f32x4*)(q##P + 4096 + hdq), b0##P = *(LAS const f32x4*)(q##P + 6144), b1##P = *(LAS const f32x4*)(q##P + 6144 + hdq), \
                        r0##P = *(LAS const f32x4*)(q##P + 8192), r1##P = *(LAS const f32x4*)(q##P + 8192 + hdq); const float vi##P = Bf[5 * 2048 + (sidx) * 64 + si];
#define STEP_MATH(P, sidx) { const f32x4 ta = S0 * a0##P + S1 * a1##P; const float sa = dpp_sum8((ta.x + ta.y) + (ta.z + ta.w)); \
            S0 = S0 * w0##P + (sa * b0##P + vi##P * k0##P); S1 = S1 * w1##P + (sa * b1##P + vi##P * k1##P); \
            const f32x4 ty = S0 * r0##P + S1 * r1##P; const float y = dpp_sum8((ty.x + ty.y) + (ty.z + ty.w)); if (jq == 0) Yb[(sidx) * 64 + si] = y; }
        const int hoff = (si & 1) * 4, hdq = 4 - 2 * hoff;
        const int sdir = d ? -1 : 1; int sc = d ? 31 : 0;
        f32x4 cw0, cw1, ck0, ck1, ca0, ca1, cb0, cb1, cr0, cr1; float cvi;
        { STEP_LOAD(X, sc); cw0 = w0X; cw1 = w1X; ck0 = k0X; ck1 = k1X; ca0 = a0X; ca1 = a1X; cb0 = b0X; cb1 = b1X; cr0 = r0X; cr1 = r1X; cvi = viX; }
        for (int ss = 0; ss < 32; ss += 2) {
            const int s0i = sc, s1i = sc + sdir; int s2i = sc + 2 * sdir; s2i = (ss + 2 < 32) ? s2i : s1i;
            STEP_LOAD(B, s1i);
            { const f32x4 w0A = cw0, w1A = cw1, k0A = ck0, k1A = ck1, a0A = ca0, a1A = ca1, b0A = cb0, b1A = cb1, r0A = cr0, r1A = cr1; const float viA = cvi; STEP_MATH(A, s0i); }
            STEP_LOAD(C, s2i);
            STEP_MATH(B, s1i);
            cw0 = w0C; cw1 = w1C; ck0 = k0C; ck1 = k1C; ca0 = a0C; ca1 = a1C; cb0 = b0C; cb1 = b1C; cr0 = r0C; cr1 = r1C; cvi = viC;
            sc += 2 * sdir;
        }
#undef STEP_LOAD
#undef STEP_MATH
        if (n + 1 < NC) SCAN_STORE(n + 1);
        __syncthreads();
        {
            SCAN_CHUNK(n, base_, Tn_, t0_, wy_); (void)Tn_;
            if (wy_) {
#pragma unroll
                for (int i4 = 0; i4 < 4; ++i4) { const int tk = w + 8 * i4; Y[(size_t)(base_ + t0_ + tk) * 1024 + ch] = f2bf(Yb[tk * 64 + lane]); }
            }
        }
    }
    __syncthreads();
#undef SCAN_CHUNK
#undef SCAN_LOAD
#undef SCAN_STORE
}

__device__ __forceinline__ bf16x8 pk8f(float f0, float f1, float f2, float f3, float f4, float f5, float f6, float f7) {
    u32x4 p; p.x = pkbf(f0, f1); p.y = pkbf(f2, f3); p.z = pkbf(f4, f5); p.w = pkbf(f6, f7); return __builtin_bit_cast(bf16x8, p);
}
__device__ __forceinline__ void scan_unit_mfma(const TI ti, CArgs& a, int l, int u, bool ctx_out, unsigned char* ldsg) {
    const int tid = ti.tid, lane = tid & 63, w = __builtin_amdgcn_readfirstlane(tid >> 6);
    const int b = u >> 5, hh = (u >> 1) & 15, d = u & 1;
    LAS unsigned char* L = (LAS unsigned char*)ldsg;
    constexpr int NCH = 144, RING = 6, BUFB = 17664, O_AR = 0, O_BK = 4608, O_BKT = 9216, O_VTT = 14336, O_PC = 17408, O_NT = RING * BUFB;
#define SC2_CHUNK(C, base, Tn, cc, wy) int base, Tn, cc; bool wy; if ((C) < 16) { base = ML + b * 256; Tn = 256; cc = (C); wy = ctx_out; } else { base = b * 2048; Tn = 2048; cc = (C) - 16; wy = true; }
#define SC2_TOK(Tn, cc, t) (d ? (Tn) - 1 - (16 * (cc) + (t)) : 16 * (cc) + (t))
    if (w < 2) {
        const int it = w, r = lane & 31, h = lane >> 5;
        bf16_t* Y = (bf16_t*)(a.ws + (d ? WS_Y1 : WS_H));
        f32x16 ST0, ST1;
#pragma unroll
        for (int i = 0; i < 16; ++i) { ST0[i] = 0.f; ST1[i] = 0.f; }
        LAS float* NT = (LAS float*)(L + O_NT + it * 1024);
        const int thr = (r & 15) + (r >> 4);
        for (int n = 0; n < NCH + RING; ++n) {
            if (n >= RING) {
                const int C = n - RING;
                LAS const unsigned char* buf = L + (C % RING) * BUFB;
                f32x16 X;
#pragma unroll
                for (int i = 0; i < 16; ++i) X[i] = 0.f;
#pragma unroll
                for (int ks = 0; ks < 4; ++ks) {
                    const bf16x8 af = *(LAS const bf16x8*)(buf + O_BK + r * 144 + (16 * ks + 8 * h) * 2);
                    const bf16x8 bfr = *(LAS const bf16x8*)(buf + O_AR + r * 144 + (16 * ks + 8 * h) * 2);
                    X = MFMA32(af, bfr, X);
                }
#pragma unroll
                for (int rg = 0; rg < 16; ++rg) { const int s = (rg & 3) + 8 * ((rg >> 2) & 1) + 4 * h; X[rg] = (s < thr) ? X[rg] : 0.f; }
                if (r < 16) {
                    *(LAS f32x4*)(NT + r * 16 + 4 * h) = (f32x4){X[0], X[1], X[2], X[3]};
                    *(LAS f32x4*)(NT + r * 16 + 8 + 4 * h) = (f32x4){X[4], X[5], X[6], X[7]};
                }
                const bf16x8 xb0 = pk8f(X[0], X[1], X[2], X[3], X[4], X[5], X[6], X[7]);
                const bf16x8 xb1 = pk8f(X[8], X[9], X[10], X[11], X[12], X[13], X[14], X[15]);
                f32x16 Z;
#pragma unroll
                for (int i = 0; i < 16; ++i) Z[i] = 0.f;
#pragma unroll
                for (int jt = 0; jt < 2; ++jt) {
#pragma unroll
                    for (int s = 0; s < 2; ++s) {
                        LAS const unsigned char* ap = buf + O_AR + r * 144 + (32 * jt + 16 * s + 4 * h) * 2;
                        const s16x4 lo = *(LAS const s16x4*)ap, hi = *(LAS const s16x4*)(ap + 16);
                        const bf16x8 a2 = __builtin_shufflevector(lo, hi, 0, 1, 2, 3, 4, 5, 6, 7);
                        const bf16x8 stp = jt == 0 ? pk8f(ST0[8 * s], ST0[8 * s + 1], ST0[8 * s + 2], ST0[8 * s + 3], ST0[8 * s + 4], ST0[8 * s + 5], ST0[8 * s + 6], ST0[8 * s + 7])
                                                   : pk8f(ST1[8 * s], ST1[8 * s + 1], ST1[8 * s + 2], ST1[8 * s + 3], ST1[8 * s + 4], ST1[8 * s + 5], ST1[8 * s + 6], ST1[8 * s + 7]);
                        Z = MFMA32(a2, stp, Z);
                    }
                }
                LAS const unsigned char* vp = buf + O_VTT + (32 * it + r) * 48;
                {
                    const s16x4 lo = *(LAS const s16x4*)(vp + 8 * h), hi = *(LAS const s16x4*)(vp + 16 + 8 * h);
                    const bf16x8 vf = __builtin_shufflevector(lo, hi, 0, 1, 2, 3, 4, 5, 6, 7);
                    Z = MFMA32(xb1, vf, Z);
                }
                float o[8], g[16], uu[16];
#pragma unroll
                for (int q = 0; q < 8; ++q) o[q] = __shfl_xor(Z[q], 32);
#pragma unroll
                for (int e = 0; e < 4; ++e) {
                    g[e] = h ? o[e] : Z[e]; g[4 + e] = h ? Z[e] : o[e];
                    g[8 + e] = h ? o[4 + e] : Z[4 + e]; g[12 + e] = h ? Z[4 + e] : o[4 + e];
                }
                uu[0] = g[0];
#pragma unroll
                for (int t = 1; t < 16; ++t) {
                    float acc = g[t];
#pragma unroll
                    for (int s4 = 0; s4 < (t + 3) / 4; ++s4) {
                        const f32x4 nv = *(LAS const f32x4*)(NT + t * 16 + 4 * s4);
                        if (4 * s4 + 0 < t) acc = __builtin_fmaf(nv.x, uu[4 * s4 + 0], acc);
                        if (4 * s4 + 1 < t) acc = __builtin_fmaf(nv.y, uu[4 * s4 + 1], acc);
                        if (4 * s4 + 2 < t) acc = __builtin_fmaf(nv.z, uu[4 * s4 + 2], acc);
                        if (4 * s4 + 3 < t) acc = __builtin_fmaf(nv.w, uu[4 * s4 + 3], acc);
                    }
                    uu[t] = acc;
                }
                {
                    const bf16x8 uf = pk8f(h ? uu[4] : uu[0], h ? uu[5] : uu[1], h ? uu[6] : uu[2], h ? uu[7] : uu[3],
                                           h ? uu[12] : uu[8], h ? uu[13] : uu[9], h ? uu[14] : uu[10], h ? uu[15] : uu[11]);
                    Z = MFMA32(xb0, uf, Z);
                }
                {
                    SC2_CHUNK(C, base_, Tn_, cc_, wy_);
                    if (wy_) {
#pragma unroll
                        for (int q = 8; q < 16; ++q) {
                            const int t = (q & 3) + 8 * ((q >> 2) - 2) + 4 * h; const int tok = SC2_TOK(Tn_, cc_, t);
                            Y[(size_t)(base_ + tok) * 1024 + hh * 64 + 32 * it + r] = f2bf(Z[q]);
                        }
                    }
                }
                {
                    const bf16x8 un = pk8f(h ? uu[8] : uu[0], h ? uu[9] : uu[1], h ? uu[10] : uu[2], h ? uu[11] : uu[3],
                                           h ? uu[12] : uu[4], h ? uu[13] : uu[5], h ? uu[14] : uu[6], h ? uu[15] : uu[7]);
                    const bf16x8 vn = *(LAS const bf16x8*)(vp + 16 * h);
                    const bf16x8 a00 = *(LAS const bf16x8*)(buf + O_BKT + r * 80 + (8 * h) * 2), a01 = *(LAS const bf16x8*)(buf + O_BKT + r * 80 + (16 + 8 * h) * 2);
                    const bf16x8 a10 = *(LAS const bf16x8*)(buf + O_BKT + (32 + r) * 80 + (8 * h) * 2), a11 = *(LAS const bf16x8*)(buf + O_BKT + (32 + r) * 80 + (16 + 8 * h) * 2);
                    ST0 = MFMA32(a00, un, ST0); ST0 = MFMA32(a01, vn, ST0);
                    ST1 = MFMA32(a10, un, ST1); ST1 = MFMA32(a11, vn, ST1);
                    LAS const float* pc = (LAS const float*)(buf + O_PC);
#pragma unroll
                    for (int g4 = 0; g4 < 4; ++g4) {
                        const f32x4 p0 = *(LAS const f32x4*)(pc + 8 * g4 + 4 * h), p1 = *(LAS const f32x4*)(pc + 32 + 8 * g4 + 4 * h);
                        ST0[4 * g4] *= p0.x; ST0[4 * g4 + 1] *= p0.y; ST0[4 * g4 + 2] *= p0.z; ST0[4 * g4 + 3] *= p0.w;
                        ST1[4 * g4] *= p1.x; ST1[4 * g4 + 1] *= p1.y; ST1[4 * g4 + 2] *= p1.z; ST1[4 * g4 + 3] *= p1.w;
                    }
                }
            }
            __syncthreads();
        }
    } else {
        const int p = w - 2, ch = hh * 64 + lane;
        const bf16_t* RW = (const bf16_t*)(a.ws + WS_RW);
        const bf16_t* DEC = (const bf16_t*)(a.ws + (d ? WS_DEC1 : WS_GV));
        const bf16_t* AA = (const bf16_t*)(a.ws + (d ? WS_AA1 : WS_AA0));
        const float* mu = a.in[16] + l * 3488;
        const float mur = mu[ch], muk = mu[1024 + ch], muv = mu[2048 + ch], kkg = a.in[22][l * 1024 + ch], kag = a.in[23][l * 1024 + ch];
        LAS unsigned char* buf = L + p * BUFB;
        LAS bf16_t* AR = (LAS bf16_t*)(buf + O_AR); LAS bf16_t* BK = (LAS bf16_t*)(buf + O_BK); LAS bf16_t* BKT = (LAS bf16_t*)(buf + O_BKT); LAS bf16_t* VTT = (LAS bf16_t*)(buf + O_VTT);
        LAS float* PC = (LAS float*)(buf + O_PC);
        constexpr int NSTEP = (NCH / RING) * 4;
        unsigned nxt[4][11], cur[4][11];
#define SC2_LOAD(k) do { const int C_ = p + RING * ((k) >> 2); SC2_CHUNK(C_, base_, Tn_, cc_, wy_); (void)wy_; _Pragma("unroll") for (int i4 = 0; i4 < 4; ++i4) { \
            const int tok = SC2_TOK(Tn_, cc_, 4 * ((k) & 3) + i4); const size_t row = (size_t)(base_ + tok); const bf16_t* q_ = RW + row * RWP + ch; \
            const int op_ = tok > 0 ? -RWP : 0, on_ = tok < Tn_ - 1 ? RWP : 0; \
            _Pragma("unroll") for (int X = 0; X < 3; ++X) { nxt[i4][3 * X] = (unsigned)q_[X * 1024 + op_]; nxt[i4][3 * X + 1] = (unsigned)q_[X * 1024]; nxt[i4][3 * X + 2] = (unsigned)q_[X * 1024 + on_]; } \
            nxt[i4][9] = (unsigned)DEC[row * 1024 + ch]; nxt[i4][10] = (unsigned)AA[row * 1024 + ch]; } } while (0)
        SC2_LOAD(0);
        float Lsum = 0.f, ePprev = 1.f;
        for (int n = 0; n < NCH + RING; ++n) {
            const int e = n - p - 1;
            if (e >= 0 && (e % RING) < 4 && e / RING < NCH / RING) {
                const int k = 4 * (e / RING) + (e % RING);
#pragma unroll
                for (int i4 = 0; i4 < 4; ++i4)
#pragma unroll
                    for (int x = 0; x < 11; ++x) cur[i4][x] = nxt[i4][x];
                if (k + 1 < NSTEP) SC2_LOAD(k + 1);
                const int C_ = p + RING * (k >> 2); SC2_CHUNK(C_, base_, Tn_, cc_, wy_); (void)wy_; (void)base_;
#pragma unroll
                for (int i4 = 0; i4 < 4; ++i4) {
                    const int t = 4 * (k & 3) + i4; const int tok = SC2_TOK(Tn_, cc_, t);
                    if (t == 0) { Lsum = 0.f; ePprev = 1.f; }
                    const float mp_ = tok > 0 ? 0.5f : 0.f, mn_ = tok < Tn_ - 1 ? 0.5f : 0.f;
                    const float xr = bf2f(cur[i4][1]), xk = bf2f(cur[i4][4]), xv = bf2f(cur[i4][7]);
                    const float zr = xr + mur * ((mp_ * bf2f(cur[i4][0]) + mn_ * bf2f(cur[i4][2])) - xr);
                    const float zk = xk + muk * ((mp_ * bf2f(cur[i4][3]) + mn_ * bf2f(cur[i4][5])) - xk);
                    const float zv = xv + muv * ((mp_ * bf2f(cur[i4][6]) + mn_ * bf2f(cur[i4][8])) - xv);
                    const float kkv = zk * kkg; const float ssq = wave_sum(kkv * kkv); const float kkn = kkv / fmaxf(sqrtf(ssq), 1e-12f);
                    const float ad = bf2f(cur[i4][10]); const float kd = zk * (1.f + (ad - 1.f) * kag);
                    Lsum += bf2f(cur[i4][9]);
                    const float eP = __expf(Lsum), eI = __expf(-Lsum);
                    AR[t * 72 + lane] = f2bf(-kkn * ePprev); AR[(16 + t) * 72 + lane] = f2bf(zr * eP);
                    const bf16_t bt = f2bf(kkn * ad * eI), kt = f2bf(kd * eI);
                    BK[t * 72 + lane] = bt; BK[(16 + t) * 72 + lane] = kt;
                    BKT[lane * 40 + t] = bt; BKT[lane * 40 + 16 + t] = kt;
                    VTT[lane * 24 + t] = f2bf(zv);
                    if (t == 15) PC[lane] = eP;
                    ePprev = eP;
                }
            }
            __syncthreads();
        }
#undef SC2_LOAD
    }
    __syncthreads();
#undef SC2_CHUNK
#undef SC2_TOK
}

__device__ __forceinline__ void attn_unit(const TI ti, CArgs& a, int b, int hd, int qrow0, int st_lo, int st_hi, float mfix, float lam, float lam_init, const float* subg, unsigned char* ldsg) {
    const int tid = ti.tid, lane = tid & 63, w = tid >> 6, r = lane & 31, h = lane >> 5, qt = w >> 1, c = w & 1;
    bf16_t* Qb = (bf16_t*)(a.ws + WS_Q); const bf16_t* Kb = (const bf16_t*)(a.ws + WS_K); const bf16_t* Vb = (const bf16_t*)(a.ws + WS_V);
    LAS unsigned char* L = (LAS unsigned char*)ldsg;
    constexpr int KOFF = 0, VOFF = 17408, BUFB = 35840;
    bf16x8 qf[4];
    { const bf16_t* qp = Qb + (size_t)(qrow0 + qt * 32 + r) * 1024 + hd * 128 + c * 64 + 8 * h;
#pragma unroll
      for (int ks = 0; ks < 4; ++ks) qf[ks] = *(const bf16x8*)(qp + 16 * ks); }
    f32x16 O[4];
#pragma unroll
    for (int e = 0; e < 4; ++e)
#pragma unroll
        for (int i = 0; i < 16; ++i) O[e][i] = 0.f;
    float lsum = 0.f;
    u32x4 kreg[2], vreg[2];
#define ATT_KROW(kk) ((kk) < 2048 ? (size_t)(b * 2048 + (kk)) : (size_t)(ML + b * 256 + (kk) - 2048))
#define ATT_LOAD(st) do { _Pragma("unroll") for (int i = 0; i < 2; ++i) { const int p = tid + 512 * i, key = p >> 4, dc = p & 15; kreg[i] = *(const u32x4*)(Kb + ATT_KROW((st) * 64 + key) * 1024 + hd * 128 + dc * 8); } \
        const bf16_t* vp = Vb + ATT_KROW((st) * 64 + lane) * 1024 + hd * 128 + w * 16; vreg[0] = *(const u32x4*)vp; vreg[1] = *(const u32x4*)(vp + 8); } while (0)
#define ATT_STORE(bufi) do { LAS unsigned char* Bb = L + (bufi) * BUFB; _Pragma("unroll") for (int i = 0; i < 2; ++i) { const int p = tid + 512 * i, key = p >> 4, dc = p & 15; *(LAS u32x4*)(Bb + KOFF + key * 272 + dc * 16) = kreg[i]; } \
        LAS bf16_t* vt = (LAS bf16_t*)(Bb + VOFF) + (w * 16) * 72 + lane; \
        _Pragma("unroll") for (int e = 0; e < 4; ++e) { vt[(2 * e) * 72] = (bf16_t)(vreg[0][e] & 0xffffu); vt[(2 * e + 1) * 72] = (bf16_t)(vreg[0][e] >> 16); \
            vt[(8 + 2 * e) * 72] = (bf16_t)(vreg[1][e] & 0xffffu); vt[(8 + 2 * e + 1) * 72] = (bf16_t)(vreg[1][e] >> 16); } } while (0)
    ATT_LOAD(st_lo); ATT_STORE(0);
    __syncthreads();
    for (int st = st_lo; st < st_hi; ++st) {
        const int bi = (st - st_lo) & 1;
        if (st + 1 < st_hi) ATT_LOAD(st + 1);
        LAS const unsigned char* Bb = L + bi * BUFB;
#pragma unroll
        for (int sub = 0; sub < 2; ++sub) {
            f32x16 Sx;
#pragma unroll
            for (int i = 0; i < 16; ++i) Sx[i] = 0.f;
#pragma unroll
            for (int ks = 0; ks < 4; ++ks) {
                const bf16x8 kf = *(LAS const bf16x8*)(Bb + KOFF + (sub * 32 + r) * 272 + (c * 64 + 16 * ks + 8 * h) * 2);
                Sx = MFMA32(kf, qf[ks], Sx);
            }
            float p[16];
#pragma unroll
            for (int i = 0; i < 16; ++i) { p[i] = __builtin_amdgcn_exp2f(Sx[i] - mfix); lsum += p[i]; }
            u32x4 pw0, pw1;
            pw0.x = pkbf(p[0], p[1]); pw0.y = pkbf(p[2], p[3]); pw0.z = pkbf(p[4], p[5]); pw0.w = pkbf(p[6], p[7]);
            pw1.x = pkbf(p[8], p[9]); pw1.y = pkbf(p[10], p[11]); pw1.z = pkbf(p[12], p[13]); pw1.w = pkbf(p[14], p[15]);
            const bf16x8 pb0 = __builtin_bit_cast(bf16x8, pw0), pb1 = __builtin_bit_cast(bf16x8, pw1);
#pragma unroll
            for (int et = 0; et < 4; ++et) {
#pragma unroll
                for (int s = 0; s < 2; ++s) {
                    LAS const unsigned char* va = Bb + VOFF + (et * 32 + r) * 144 + (sub * 32 + 16 * s + 4 * h) * 2;
                    const s16x4 lo = *(LAS const s16x4*)va, hi = *(LAS const s16x4*)(va + 16);
                    const bf16x8 vf = __builtin_shufflevector(lo, hi, 0, 1, 2, 3, 4, 5, 6, 7);
                    O[et] = MFMA32(vf, s ? pb1 : pb0, O[et]);
                }
            }
        }
        if (st + 1 < st_hi) ATT_STORE(bi ^ 1);
        __syncthreads();
    }
#undef ATT_KROW
#undef ATT_LOAD
#undef ATT_STORE
    const float ltot = lsum + __shfl_xor(lsum, 32);
    const float linv = 1.f / ltot;
    LAS float* X = (LAS float*)L + qt * 4096;
    if (c == 1) {
#pragma unroll
        for (int e = 0; e < 4; ++e)
#pragma unroll
            for (int i = 0; i < 16; ++i) X[(e * 16 + i) * 64 + lane] = O[e][i] * linv;
    }
    __syncthreads();
    if (c == 0) {
        float ssq = 0.f;
#pragma unroll
        for (int e = 0; e < 4; ++e)
#pragma unroll
            for (int i = 0; i < 16; ++i) { const float o = O[e][i] * linv - lam * X[(e * 16 + i) * 64 + lane]; O[e][i] = o; ssq += o * o; }
        ssq += __shfl_xor(ssq, 32);
        const float sc = rsqrtf(ssq * (1.f / 128.f) + 1e-6f) * (1.f - lam_init);
        bf16_t* op = Qb + (size_t)(qrow0 + qt * 32 + r) * 1024 + hd * 128;
#pragma unroll
        for (int e = 0; e < 4; ++e)
#pragma unroll
            for (int g4 = 0; g4 < 4; ++g4) {
                const int e0 = e * 32 + 8 * g4 + 4 * h; const f32x4 sg = *(const f32x4*)(subg + e0);
                u32x2 o; o.x = pkbf(O[e][4 * g4 + 0] * sc * sg.x, O[e][4 * g4 + 1] * sc * sg.y); o.y = pkbf(O[e][4 * g4 + 2] * sc * sg.z, O[e][4 * g4 + 3] * sc * sg.w);
                *(u32x2*)(op + e0) = o;
            }
    }
    __syncthreads();
}
__device__ __forceinline__ void ph_attn(const TI ti, CArgs& a, int l, bool ctx_out, unsigned char* ldsg) {
    const int lane = ti.tid & 63;
    const float gqm = fabsf(a.in[12][l * 64 + lane]), gkm = fabsf(a.in[13][l * 64 + lane]);
    float mq = gqm, mk = gkm;
#pragma unroll
    for (int o = 1; o < 64; o <<= 1) { mq = fmaxf(mq, __shfl_xor(mq, o)); mk = fmaxf(mk, __shfl_xor(mk, o)); }
    const float mfix = 8.f * mq * mk * 1.4426950408889634f * 1.03f;
    const float* lp = a.in[14] + l * 256;
    const float s1 = wave_sum(lp[lane] * lp[64 + lane]), s2 = wave_sum(lp[128 + lane] * lp[192 + lane]);
    const float lam_init = 0.8f - 0.6f * expf(-0.3f * (float)l);
    const float lam = expf(s1) - expf(s2) + lam_init;
    const float* subg = a.in[15] + l * 128;
    const int nun = 1024 + (ctx_out ? 128 : 0);
    for (int u = ti.bid; u < nun; u += ti.nblk) {
        if (u < 1024) { const int bh = u >> 4, qb = u & 15; attn_unit(ti, a, bh >> 3, bh & 7, (bh >> 3) * 2048 + qb * 128, 0, 36, mfix, lam, lam_init, subg, ldsg); }
        else { const int v = u - 1024, bh = v >> 1, qb = v & 1; attn_unit(ti, a, bh >> 3, bh & 7, ML + (bh >> 3) * 256 + qb * 128, 32, 36, mfix, lam, lam_init, subg, ldsg); }
    }
}

__device__ __forceinline__ void up8(const bf16_t* p, float (&x)[8]) { const u32x4 v = *(const u32x4*)p;
#pragma unroll
    for (int i = 0; i < 4; ++i) { x[2 * i] = bf2f(v[i] & 0xffffu); x[2 * i + 1] = bf2f(v[i] >> 16); } }
__device__ __forceinline__ void ld8f(const float* p, float (&x)[8]) { const f32x4 u = *(const f32x4*)p, v = *(const f32x4*)(p + 4); x[0] = u.x; x[1] = u.y; x[2] = u.z; x[3] = u.w; x[4] = v.x; x[5] = v.y; x[6] = v.z; x[7] = v.w; }
__device__ __forceinline__ void shift8(const bf16_t* p, const float* mu, bool hp, bool hn, float (&z)[8]) {
    float x[8], xp[8], xn[8], m[8];
#pragma unroll
    for (int j = 0; j < 8; ++j) { xp[j] = 0.f; xn[j] = 0.f; }
    up8(p, x); if (hp) up8(p - RWP, xp); if (hn) up8(p + RWP, xn); ld8f(mu, m);
#pragma unroll
    for (int j = 0; j < 8; ++j) z[j] = x[j] + m[j] * (0.5f * (xp[j] + xn[j]) - x[j]);
}
__device__ __forceinline__ void rwkv_out_rows(CArgs& a, int l, int nrows, int gw, int ngw, int lane) {
    const bf16_t* RW = (const bf16_t*)(a.ws + WS_RW); const bf16_t* Y0 = (const bf16_t*)(a.ws + WS_H); bf16_t* Y1 = (bf16_t*)(a.ws + WS_Y1);
    const bf16_t* A0 = (const bf16_t*)(a.ws + WS_AA0); const bf16_t* A1 = (const bf16_t*)(a.ws + WS_AA1); const bf16_t* G = (const bf16_t*)(a.ws + WS_G);
    const float* mu = a.in[16] + l * 3488;
    for (int it = gw; it < 2 * nrows; it += ngw) {
        const int row = it >> 1, c0 = (it & 1) * 512 + 8 * lane;
        int t, Tn; if (row < ML) { t = row & 2047; Tn = 2048; } else { t = (row - ML) & 255; Tn = 256; }
        const bool hp = t > 0, hn = t < Tn - 1;
        const size_t idx = (size_t)row * 1024 + c0;
        float y[8], y1[8], g[8], a0[8], a1[8], zr[8], zk[8], zv[8], lnw[8], lnb[8], ka[8], rk[8];
        up8(Y0 + idx, y); up8(Y1 + idx, y1); up8(G + idx, g); up8(A0 + idx, a0); up8(A1 + idx, a1);
        const bf16_t* p = RW + (size_t)row * RWP + c0;
        shift8(p, mu + c0, hp, hn, zr); shift8(p + 1024, mu + 1024 + c0, hp, hn, zk); shift8(p + 2048, mu + 2048 + c0, hp, hn, zv);
        ld8f(a.in[25] + l * 1024 + c0, lnw); ld8f(a.in[26] + l * 1024 + c0, lnb); ld8f(a.in[23] + l * 1024 + c0, ka); ld8f(a.in[24] + l * 1024 + c0, rk);
        float sm = 0.f;
#pragma unroll
        for (int j = 0; j < 8; ++j) { y[j] += y1[j]; sm += y[j]; }
        const float mean = dpp_sum8(sm) * (1.f / 64.f);
        float sv = 0.f, sb = 0.f;
#pragma unroll
        for (int j = 0; j < 8; ++j) { y[j] -= mean; sv += y[j] * y[j]; const float kds = zk[j] * ((1.f + (a0[j] - 1.f) * ka[j]) + (1.f + (a1[j] - 1.f) * ka[j])); sb += zr[j] * kds * rk[j]; }
        const float rstd = rsqrtf(dpp_sum8(sv) * (1.f / 64.f) + 64e-5f), bsum = dpp_sum8(sb);
        u32x4 o;
#pragma unroll
        for (int j = 0; j < 4; ++j) o[j] = pkbf(((y[2 * j] * rstd * lnw[2 * j] + lnb[2 * j]) + bsum * zv[2 * j]) * g[2 * j], ((y[2 * j + 1] * rstd * lnw[2 * j + 1] + lnb[2 * j + 1]) + bsum * zv[2 * j + 1]) * g[2 * j + 1]);
        *(u32x4*)(Y1 + idx) = o;
    }
}

#define XB_TMO      128
#define XB_XCNT(j)  (256  + 64 * (j))
#define XB_XSUB(j)  (1280 + 64 * (j))
#define XB_XGEN(j)  (2304 + 64 * (j))
#define XB_TOP      3328
#define XB_TOPGEN   3392
#define XCD_BAR_WORDS 3456
#define XB_SPIN_CAP (1u << 20)

__device__ __forceinline__ unsigned xb_ld(unsigned* p)              { return __hip_atomic_load(p, __ATOMIC_RELAXED, __HIP_MEMORY_SCOPE_AGENT); }
__device__ __forceinline__ unsigned xb_add(unsigned* p, unsigned v) { return __hip_atomic_fetch_add(p, v, __ATOMIC_RELAXED, __HIP_MEMORY_SCOPE_AGENT); }
__device__ __forceinline__ unsigned xb_xcc_id() { return (unsigned)__builtin_amdgcn_s_getreg((3 << 11) | 20) & 0xFu; }
#define XB_SPIN(cond, bar) do { unsigned _sp = 0; while (cond) { __builtin_amdgcn_s_sleep(1); \
    if ((++_sp & 255u) == 0u) { if (xb_ld(&(bar)[XB_TMO])) break; if (_sp > XB_SPIN_CAP) { atomicAdd(&(bar)[XB_TMO], 1u); break; } } } } while (0)

struct XcdBarrier {
    unsigned* bar; unsigned x;
    volatile LAS unsigned* st;
};

__device__ __forceinline__ XcdBarrier xcd_barrier_post(unsigned* bar, volatile LAS unsigned* st) {
    XcdBarrier b; b.bar = bar; b.x = xb_xcc_id(); b.st = st;
    if (threadIdx.x == 0) (void)xb_add(&bar[XB_XCNT(b.x)], 1u);
    return b;
}
__device__ __forceinline__ void xcd_barrier_complete(unsigned* bar, unsigned x, unsigned& nloc, unsigned& nx) {
    const unsigned G = gridDim.x * gridDim.y * gridDim.z;
    unsigned sum, cnt, mine, sp = 0u;
    for (;;) {
        sum = 0u; cnt = 0u; mine = 0u;
#pragma unroll
        for (unsigned j = 0; j < 16; ++j) { const unsigned c = xb_ld(&bar[XB_XCNT(j)]); sum += c; cnt += (c > 0u) ? 1u : 0u; mine = (j == x) ? c : mine; }
        if (sum == G) break;
        __builtin_amdgcn_s_sleep(1);
        if ((++sp & 255u) == 0u) { if (xb_ld(&bar[XB_TMO])) break; if (sp > XB_SPIN_CAP) { atomicAdd(&bar[XB_TMO], 1u); break; } }
    }
    nloc = mine > 0u ? mine : 1u; nx = cnt > 0u ? cnt : 1u;
}

__device__ __forceinline__ void xcd_barrier(const XcdBarrier& b) {
    asm volatile("s_waitcnt vmcnt(0)" ::: "memory");
    __syncthreads();
    if (threadIdx.x == 0) {
        unsigned* bar = b.bar;
        __builtin_amdgcn_s_waitcnt(0);
        unsigned nloc = b.st[0], nx = b.st[1];
        if (nloc == 0u) { xcd_barrier_complete(bar, b.x, nloc, nx); b.st[0] = nloc; b.st[1] = nx; }
        const unsigned old = xb_add(&bar[XB_XSUB(b.x)], 1u);
        const unsigned gen = old / nloc;
        if (old + 1u == (gen + 1u) * nloc) {
            __builtin_amdgcn_fence(__ATOMIC_RELEASE, "agent");
            asm volatile("s_waitcnt vmcnt(0)" ::: "memory");
            const unsigned og = xb_add(&bar[XB_TOP], 1u);
            const unsigned tg = og / nx;
            if (og + 1u == (tg + 1u) * nx) xb_add(&bar[XB_TOPGEN], 1u);
            else XB_SPIN(xb_ld(&bar[XB_TOPGEN]) == tg, bar);
            __builtin_amdgcn_fence(__ATOMIC_ACQUIRE, "agent");
            xb_add(&bar[XB_XGEN(b.x)], 1u);
            asm volatile("s_waitcnt vmcnt(0)" ::: "memory");
        } else {
            XB_SPIN(xb_ld(&bar[XB_XGEN(b.x)]) == gen, bar);
            __builtin_amdgcn_fence(__ATOMIC_ACQUIRE, "agent");
            asm volatile("s_waitcnt vmcnt(0)" ::: "memory");
        }
    }
    __syncthreads();
}

#ifndef ONLY_PH
#define ONLY_PH -1
#endif
#ifndef SKIP_PH
#define SKIP_PH -2
#endif
#define PH_ON(k) ((ONLY_PH < 0 || ONLY_PH == (k)) && (k) != SKIP_PH)
__global__ void __launch_bounds__(512, 2) mega_fwd(Args a_) {
    extern __shared__ __attribute__((aligned(16))) unsigned char lds[];
    cg::grid_group grid = cg::this_grid();
    const int ph_lo = a_.lo, ph_hi = a_.hi;
    volatile LAS unsigned* bst = (volatile LAS unsigned*)((LAS unsigned char*)lds + 131072);
    if (threadIdx.x < 2) bst[threadIdx.x] = 0u;
    __syncthreads();
    const XcdBarrier xbar = xcd_barrier_post((unsigned*)(a_.ws + WS_BAR), bst);
    const int wave_s = __builtin_amdgcn_readfirstlane((int)threadIdx.x >> 6);
#pragma nounroll
    for (int ph = ph_lo; ph < ph_hi; ++ph) {
        CArgs* ap = (CArgs*)__builtin_amdgcn_kernarg_segment_ptr(); asm volatile("" : "+s"(ap));
        CArgs& a = *ap;
        unsigned char* ws = a.ws;
        float* XC = (float*)(ws + WS_XC);
        int wsv = wave_s; asm volatile("" : "+s"(wsv));
        TI ti; ti.tid = wsv * 64 + (int)__builtin_amdgcn_mbcnt_hi(~0u, __builtin_amdgcn_mbcnt_lo(~0u, 0u)); ti.bid = blockIdx.x; ti.nblk = gridDim.x;
        asm volatile("" : "+v"(ti.tid)); asm volatile("" : "+s"(ti.bid)); asm volatile("" : "+s"(ti.nblk));
        const int tid = ti.tid, lane = tid & 63, wv = __builtin_amdgcn_readfirstlane(tid >> 6);
        const int gw = ti.bid * 8 + wv, ngw = ti.nblk * 8;
        if (ph == 0) { if constexpr (PH_ON(100)) ph_mods(ti, a, lds); }
        else {
            const int l = (ph - 1) / NPH, k = (ph - 1) % NPH;
            const bool ctx_out = l < DEPTH - 1;
            const int Mr = ctx_out ? M : ML;
            const float* modl = (const float*)(ws + WS_MOD) + (size_t)l * 9 * 6144;
            const float* xl_in = l == 0 ? a.in[0] : a.out; const float* xc_in = l == 0 ? a.in[2] : XC;
            bf16_t* H = (bf16_t*)(ws + WS_H);
            switch (k) {
            case 0: if constexpr (PH_ON(0)) {
                norm_rows(xl_in, xc_in, a.in[6] + l * 1024, modl, 0, 1, H, M, gw, ngw, lane);
                ph_wconv(a, l, lds, gw, ngw, lane, wv);
                } break;
            case 1: if constexpr (PH_ON(1)) {
                OpIn op{(bf16_t*)(ws + WS_GU), (bf16_t*)(ws + WS_GV), (bf16_t*)(ws + WS_Q), (bf16_t*)(ws + WS_RW), (bf16_t*)(ws + WS_GT)};
                run_gemm(ti, lds, H, (const bf16_t*)(ws + WS_WIN), M, PPAD, 1024, op);
            } break;
            case 2: if constexpr (PH_ON(2)) {
                for (int u = ti.bid; u < Mr / 128; u += ti.nblk) gmlp_unit(ti, a, l, u, lds);
                qk_rows(a, l, gw, ngw, lane);
                lora_in_rows(a, l, gw, ngw, lane);
                } break;
            case 3: if constexpr (PH_ON(3)) {
                OpDec o1{(bf16_t*)(ws + WS_GV), (bf16_t*)(ws + WS_DEC1), a.in[17] + l * 2048};
                run_gemm(ti, lds, (const bf16_t*)(ws + WS_LIW), (const bf16_t*)(ws + WS_LWT), M, 2048, 128, o1);
                OpAA o2{(bf16_t*)(ws + WS_AA0), (bf16_t*)(ws + WS_AA1), a.in[19] + l * 2048};
                run_gemm(ti, lds, (const bf16_t*)(ws + WS_LIA), (const bf16_t*)(ws + WS_LAT), M, 2048, 128, o2);
                OpG o3{(bf16_t*)(ws + WS_G)};
                run_gemm(ti, lds, (const bf16_t*)(ws + WS_LIG), (const bf16_t*)(ws + WS_LGT), M, 1024, 256, o3);
            } break;
            case 4:
                if constexpr (PH_ON(4)) { for (int u = ti.bid; u < 256; u += ti.nblk) scan_unit_mfma(ti, a, l, u, ctx_out, lds); }
                if constexpr (PH_ON(40)) ph_attn(ti, a, l, ctx_out, lds);
                break;
            case 5: if constexpr (PH_ON(5)) {
                rwkv_out_rows(a, l, Mr, gw, ngw, lane);
                } break;
            case 6: if constexpr (PH_ON(6)) {
                const bf16_t* GT = (const bf16_t*)(ws + WS_GT); float* MF = (float*)(ws + WS_K);
                OpMerge<0> o0{GT, MF, H}; run_gemm(ti, lds, (const bf16_t*)(ws + WS_GU), (const bf16_t*)(ws + WS_WA), Mr, 1024, 1024, o0);
                OpMerge<1> o1{GT, MF, H}; run_gemm(ti, lds, (const bf16_t*)(ws + WS_Q), (const bf16_t*)(ws + WS_WB), Mr, 1024, 1024, o1);
                OpMerge<2> o2{GT, MF, H}; run_gemm(ti, lds, (const bf16_t*)(ws + WS_Y1), (const bf16_t*)(ws + WS_WC), Mr, 1024, 1024, o2);
            } break;
            case 7: if constexpr (PH_ON(7)) {
                OpResid op{xl_in, xc_in, a.out, XC, modl, 2};
                run_gemm(ti, lds, H, (const bf16_t*)(ws + WS_WO), Mr, 1024, 1024, op);
            } break;
            case 8: if constexpr (PH_ON(8)) {
                norm_rows(a.out, XC, a.in[7] + l * 1024, modl, 3, 4, H, Mr, gw, ngw, lane);
                } break;
            case 9: if constexpr (PH_ON(9)) {
                OpSwiglu op{(bf16_t*)(ws + WS_RW)};
                run_gemm(ti, lds, H, (const bf16_t*)(ws + WS_WI), Mr, 2 * DFF, 1024, op);
            } break;
            default: if constexpr (PH_ON(10)) {
                OpResid op{a.out, XC, a.out, XC, modl, 5};
                run_gemm(ti, lds, (const bf16_t*)(ws + WS_RW), (const bf16_t*)(ws + WS_WO2), Mr, 1024, DFF, op);
            } break;
            }
        }
        if (ph + 1 < ph_hi) { if (ph == ph_lo) grid.sync(); else xcd_barrier(xbar); }
    }
}

extern "C" void kernel_launch(void* const* d_in, const int* in_sizes, int n_in, void* d_out, int out_size, void* d_ws, size_t ws_size, hipStream_t stream) {
    static int grid = 0;
    if (grid == 0) {
        if (n_in != 33 || out_size != ML * D || ws_size < WS_END) { fprintf(stderr, "kernel_launch: unexpected shapes / workspace (%d inputs, out %d, ws %zu, need %zu)\n", n_in, out_size, ws_size, (size_t)WS_END); grid = -1; return; }
        int dev = 0, cus = 0, per_cu = 0;
        hipGetDevice(&dev); hipDeviceGetAttribute(&cus, hipDeviceAttributeMultiprocessorCount, dev);
        if (hipFuncSetAttribute((const void*)mega_fwd, hipFuncAttributeMaxDynamicSharedMemorySize, LDS_BYTES) != hipSuccess) { fprintf(stderr, "kernel_launch: hipFuncSetAttribute failed\n"); grid = -1; return; }
        if (hipOccupancyMaxActiveBlocksPerMultiprocessor(&per_cu, (const void*)mega_fwd, 512, LDS_BYTES) != hipSuccess || per_cu < 1) per_cu = 1;
        (void)hipGetLastError();
        grid = cus * 1;
    }
    if (grid < 0) return;
    Args a{};
    for (int i = 0; i < 33; ++i) a.in[i] = (const float*)d_in[i];
    a.out = (float*)d_out; a.ws = (unsigned char*)d_ws; a.lo = 0; a.hi = NPHASES;
    void* args[] = {&a};
    if (hipMemsetAsync((char*)d_ws + WS_BAR, 0, BAR_BYTES, stream) != hipSuccess) { fprintf(stderr, "kernel_launch: memset of barrier words failed\n"); return; }
    hipError_t e = hipLaunchCooperativeKernel((const void*)mega_fwd, dim3(grid), dim3(512), args, LDS_BYTES, stream);
    if (e != hipSuccess) fprintf(stderr, "kernel_launch: cooperative launch failed: %s (grid %d)\n", hipGetErrorString(e), grid);
}
```

```cpp
#include <hip/hip_runtime.h>
#include <hip/hip_cooperative_groups.h>
#include <cstdio>
#include <cstdint>
namespace cg = cooperative_groups;
namespace pg8 {
#define PG8_LAS __attribute__((address_space(3)))
typedef unsigned short bf16_t;
typedef short bf16x8 __attribute__((ext_vector_type(8)));
typedef float f32x4 __attribute__((ext_vector_type(4)));
typedef unsigned u32x4 __attribute__((ext_vector_type(4)));
constexpr int BM = 256, BK = 64, HALF = 128, HTB = HALF * BK * 2  , STAGE_BYTES = 8 * HTB, NXCD = 8, WGM = 8;

__host__ __device__ __forceinline__ int lds_byte(int r, int c) { const int st = (r >> 4) * 2 + (c >> 5), rr = r & 15, cc = c & 31, ob = rr * 64 + cc * 2; return st * 1024 + (ob ^ (((ob >> 9) & 1) << 5)); }
__host__ __device__ __forceinline__ void stage_rc(int b, int& R, int& C) { const int st = b / 1024, sb = b % 1024, swz = sb ^ (((sb >> 9) & 1) << 5); R = (st >> 1) * 16 + swz / 64; C = (st & 1) * 32 + (swz % 64) / 2; }
__host__ __device__ __forceinline__ int perm32(int rho) { const int n = rho >> 4, i = rho & 15; return 8 * (i >> 2) + 4 * n + (i & 3); }

struct Unit { int pm, pn; };
struct Gemm { const bf16_t* A; const bf16_t* Bt; int M, N, K; };

struct StaticOrder {
    int nM, nN, nwg, G, c;
    __host__ __device__ void init(int M, int N, int G_, int c_) { nM = M / BM; nN = N / BM; nwg = nM * nN; G = G_; c = c_; }
    __host__ __device__ bool next(int i, Unit& u) const {
        const long L = (long)i * G + c; if (L >= nwg) return false;
        int wgid = (int)L; { const int q = nwg / NXCD, r = nwg % NXCD, xcd = wgid % NXCD, off = wgid / NXCD; wgid = (xcd < r ? xcd * (q + 1) : r * (q + 1) + (xcd - r) * q) + off; }
        const int nig = WGM * nN, gid = wgid / nig, fm = gid * WGM, gsz = (nM - fm) < WGM ? (nM - fm) : WGM;
        u.pm = fm + ((wgid % nig) % gsz); u.pn = (wgid % nig) / gsz; return true;
    }
    __device__ __forceinline__ void a_ready(const Unit&) const {}
    __device__ __forceinline__ void done(const Unit&) const {}
};

__device__ __forceinline__ unsigned cvt_pk_bf16(float lo, float hi) { unsigned r; asm volatile("v_cvt_pk_bf16_f32 %0, %1, %2" : "=v"(r) : "v"(lo), "v"(hi)); return r; }
typedef float f32x2 __attribute__((ext_vector_type(2)));
__device__ __forceinline__ f32x2 gelu_pk(f32x2 v) {
    const f32x2 av = __builtin_elementwise_abs(v), d = av * 0.2316418882f + 1.0f;
    f32x2 t; t.x = __builtin_amdgcn_rcpf(d.x); t.y = __builtin_amdgcn_rcpf(d.y);
    f32x2 q = t * 0.5307027145f + (-0.7265760135f); q = q * t + 0.7107068705f; q = q * t + (-0.142248368f); q = q * t + 0.127414796f; q = q * t;
    const f32x2 s = (v * v) * (-0.72134752044f);
    f32x2 e; e.x = __builtin_amdgcn_exp2f(s.x); e.y = __builtin_amdgcn_exp2f(s.y);
    const f32x2 m = v * (q * e), r = v - m;
    f32x2 o; o.x = v.x < 0.f ? m.x : r.x; o.y = v.y < 0.f ? m.y : r.y; return o;
}

template <class Epi, class Sched, bool ALIGN_EPI = false, bool SP2 = false>
__device__ __forceinline__ void gemm_phase(PG8_LAS unsigned char* lds, const Gemm g, const Sched& S, const Epi& E, const int tid_in) {
    const int tid = tid_in, wid = __builtin_amdgcn_readfirstlane(tid >> 6), lane = tid & 63, wr = wid >> 2, wc = wid & 3, fr = lane & 15, fq = lane >> 4;
    const int K = g.K, nt = K / BK;
    unsigned voffA[2], voffB[2];
#pragma unroll
    for (int i = 0; i < 2; ++i) { int R, C; stage_rc(tid * 16 + i * 8192, R, C); const int Rb = Epi::PERM ? ((R & ~31) + perm32(R & 31)) : R;
        voffA[i] = (unsigned)(R * K + C) * 2u; voffB[i] = (unsigned)(Rb * K + C) * 2u; }
    const size_t kstep = (size_t)(BK * 2);
    const size_t hstep = (size_t)HALF * K * 2;
    const size_t tstep = 2 * hstep;
    const unsigned ldsw = (unsigned)wid * 1024u;
    const int aoff = lds_byte(wr * 64 + fr, fq * 8), boff = lds_byte(wc * 32 + fr, fq * 8);
#define PG8_SA(b, h) (((b) * 2 + (h)) * HTB)
#define PG8_SB(b, h) ((4 + (b) * 2 + (h)) * HTB)
#define PG8_STAGE(bufoff, gbase, voff) do { _Pragma("unroll") for (int _i = 0; _i < 2; ++_i) \
        __builtin_amdgcn_global_load_lds((const unsigned*)((const char*)(gbase) + (voff)[_i]), (PG8_LAS unsigned*)(lds + (bufoff) + ldsw + _i * 8192), 16, 0, 0); } while (0)
#define PG8_LDA(dst, b, h) do { _Pragma("unroll") for (int m = 0; m < 4; ++m) _Pragma("unroll") for (int k = 0; k < 2; ++k) dst[m][k] = *(const PG8_LAS bf16x8*)(lds + PG8_SA(b, h) + aoff + m * 2048 + k * 1024); } while (0)
#define PG8_LDB(dst, b, h) do { _Pragma("unroll") for (int n = 0; n < 2; ++n) _Pragma("unroll") for (int k = 0; k < 2; ++k) dst[n][k] = *(const PG8_LAS bf16x8*)(lds + PG8_SB(b, h) + boff + n * 2048 + k * 1024); } while (0)
#define PG8_MMA(ai, bj, At, Bt) do { __builtin_amdgcn_s_setprio(1); _Pragma("unroll") for (int m = 0; m < 4; ++m) _Pragma("unroll") for (int n = 0; n < 2; ++n) _Pragma("unroll") for (int k = 0; k < 2; ++k) \
        acc[ai][bj][m][n] = __builtin_amdgcn_mfma_f32_16x16x32_bf16(Bt[n][k], At[m][k], acc[ai][bj][m][n], 0, 0, 0); __builtin_amdgcn_s_setprio(0); } while (0)
#define PG8_WAIT_V(n) asm volatile("s_waitcnt vmcnt(" #n ")" ::: "memory")
#define PG8_WAIT_L(n) asm volatile("s_waitcnt lgkmcnt(" #n ")" ::: "memory")
#define PG8_BAR __builtin_amdgcn_s_barrier()
#define PG8_SCHED __builtin_amdgcn_sched_barrier(0)
    Unit cur, nxt; int ui = 0;
    if (!S.next(0, cur)) return;
    f32x4 acc[2][2][4][2];
#pragma unroll
    for (int a = 0; a < 2; ++a)
#pragma unroll
        for (int b = 0; b < 2; ++b)
#pragma unroll
            for (int m = 0; m < 4; ++m)
#pragma unroll
                for (int n = 0; n < 2; ++n) acc[a][b][m][n] = (f32x4){0.f, 0.f, 0.f, 0.f};
    bf16x8 At[4][2], B0[2][2], B1[2][2];
    const char* cA = (const char*)g.A + (size_t)cur.pm * tstep; const char* cB = (const char*)g.Bt + (size_t)cur.pn * tstep;
    S.a_ready(cur);
    if constexpr (SP2) {
        PG8_STAGE(PG8_SB(0, 0), cB, voffB); PG8_STAGE(PG8_SB(0, 1), cB + hstep, voffB); PG8_STAGE(PG8_SA(0, 0), cA, voffA); PG8_STAGE(PG8_SA(0, 1), cA + hstep, voffA);
        if (wr == 1) PG8_BAR;
        PG8_WAIT_V(2); PG8_BAR;
        PG8_STAGE(PG8_SB(1, 0), cB + kstep, voffB); PG8_STAGE(PG8_SA(1, 0), cA + kstep, voffA); PG8_STAGE(PG8_SB(1, 1), cB + hstep + kstep, voffB);
        PG8_WAIT_V(6); PG8_BAR;
    } else {
        PG8_STAGE(PG8_SB(0, 0), cB, voffB); PG8_STAGE(PG8_SA(0, 0), cA, voffA); PG8_STAGE(PG8_SB(0, 1), cB + hstep, voffB); PG8_STAGE(PG8_SA(0, 1), cA + hstep, voffA);
        if (wr == 1) PG8_BAR;
        PG8_WAIT_V(4); PG8_BAR;
        PG8_STAGE(PG8_SB(1, 0), cB + kstep, voffB); PG8_STAGE(PG8_SA(1, 0), cA + kstep, voffA); PG8_STAGE(PG8_SB(1, 1), cB + hstep + kstep, voffB);
        PG8_WAIT_V(6); PG8_BAR;
    }
    for (;;) {
        const bool has_next = S.next(ui + 1, nxt);
        const char* nA = has_next ? (const char*)g.A + (size_t)nxt.pm * tstep : cA; const char* nB = has_next ? (const char*)g.Bt + (size_t)nxt.pn * tstep : cB;
        for (int t = 0; t < nt; t += 2) {
            const bool last = (t == nt - 2);
            const char* a1 = cA + (size_t)(t + 1) * kstep;
            const char* a2 = last ? nA : cA + (size_t)(t + 2) * kstep; const char* b2 = last ? nB : cB + (size_t)(t + 2) * kstep;
            const char* a3 = a2 + kstep; const char* b3 = b2 + kstep;
            if (last && has_next) S.a_ready(nxt);
            if constexpr (SP2) {
            PG8_LDB(B0, 0, 0); PG8_LDB(B1, 0, 1); PG8_SCHED; PG8_LDA(At, 0, 0); PG8_STAGE(PG8_SA(1, 1), a1 + hstep, voffA);
            PG8_WAIT_V(8); PG8_WAIT_L(0); PG8_BAR; PG8_MMA(0, 0, At, B0); PG8_MMA(0, 1, At, B1); PG8_BAR; PG8_SCHED;
            PG8_LDA(At, 0, 1); PG8_STAGE(PG8_SB(0, 0), b2, voffB); PG8_STAGE(PG8_SB(0, 1), b2 + hstep, voffB); PG8_STAGE(PG8_SA(0, 0), a2, voffA);
            PG8_WAIT_V(8); PG8_WAIT_L(0); PG8_BAR; PG8_MMA(1, 0, At, B0); PG8_MMA(1, 1, At, B1); PG8_BAR; PG8_SCHED;
            PG8_LDB(B0, 1, 0); PG8_LDB(B1, 1, 1); PG8_SCHED; PG8_LDA(At, 1, 0); PG8_STAGE(PG8_SA(0, 1), a2 + hstep, voffA);
            PG8_WAIT_V(8); PG8_WAIT_L(0); PG8_BAR; PG8_MMA(0, 0, At, B0); PG8_MMA(0, 1, At, B1); PG8_BAR; PG8_SCHED;
            PG8_LDA(At, 1, 1); PG8_STAGE(PG8_SB(1, 0), b3, voffB); PG8_STAGE(PG8_SB(1, 1), b3 + hstep, voffB); PG8_STAGE(PG8_SA(1, 0), a3, voffA);
            PG8_WAIT_V(8); PG8_WAIT_L(0); PG8_BAR; PG8_MMA(1, 0, At, B0); PG8_MMA(1, 1, At, B1); PG8_BAR; PG8_SCHED;
            } else {
            PG8_LDB(B0, 0, 0); PG8_SCHED; PG8_LDA(At, 0, 0); PG8_STAGE(PG8_SA(1, 1), a1 + hstep, voffA);
            PG8_WAIT_L(8); PG8_BAR; PG8_WAIT_L(0); PG8_MMA(0, 0, At, B0); PG8_BAR; PG8_SCHED;
            PG8_LDB(B1, 0, 1); PG8_STAGE(PG8_SB(0, 0), b2, voffB);
            PG8_BAR; PG8_WAIT_L(0); PG8_MMA(0, 1, At, B1); PG8_BAR;
            PG8_LDA(At, 0, 1); PG8_STAGE(PG8_SA(0, 0), a2, voffA);
            PG8_BAR; PG8_WAIT_L(0); PG8_MMA(1, 0, At, B0); PG8_BAR; PG8_SCHED;
            PG8_STAGE(PG8_SB(0, 1), b2 + hstep, voffB);
            PG8_WAIT_V(6); PG8_BAR; PG8_MMA(1, 1, At, B1); PG8_BAR;
            PG8_LDB(B0, 1, 0); PG8_SCHED; PG8_LDA(At, 1, 0); PG8_STAGE(PG8_SA(0, 1), a2 + hstep, voffA);
            PG8_WAIT_L(8); PG8_BAR; PG8_WAIT_L(0); PG8_MMA(0, 0, At, B0); PG8_BAR; PG8_SCHED;
            PG8_LDB(B1, 1, 1); PG8_STAGE(PG8_SB(1, 0), b3, voffB);
            PG8_BAR; PG8_WAIT_L(0); PG8_MMA(0, 1, At, B1); PG8_BAR;
            PG8_LDA(At, 1, 1); PG8_STAGE(PG8_SA(1, 0), a3, voffA);
            PG8_BAR; PG8_WAIT_L(0); PG8_MMA(1, 0, At, B0); PG8_BAR; PG8_SCHED;
            PG8_STAGE(PG8_SB(1, 1), b3 + hstep, voffB);
            PG8_WAIT_V(6); PG8_BAR; PG8_MMA(1, 1, At, B1); PG8_BAR;
            }
        }
        if constexpr (ALIGN_EPI) { if (wr == 0) PG8_BAR; }
        if constexpr (!Epi::AFTER_DRAIN) { E(acc, cur, wr, wc, fr, fq); S.done(cur); }
        if (!has_next) break;
#pragma unroll
        for (int a = 0; a < 2; ++a)
#pragma unroll
            for (int b = 0; b < 2; ++b)
#pragma unroll
                for (int m = 0; m < 4; ++m)
#pragma unroll
                    for (int n = 0; n < 2; ++n) acc[a][b][m][n] = (f32x4){0.f, 0.f, 0.f, 0.f};
        cur = nxt; cA = nA; cB = nB; ++ui;
        if constexpr (ALIGN_EPI) { if (wr == 1) PG8_BAR; }
    }
    PG8_WAIT_V(0);
    if constexpr (!ALIGN_EPI) { if (wr == 0) PG8_BAR; }
    PG8_BAR;
    if constexpr (Epi::AFTER_DRAIN) { E.fused(acc, cur, wr, wc, fr, fq, lds, wid, lane); S.done(cur); }
#undef PG8_SA
#undef PG8_SB
#undef PG8_STAGE
#undef PG8_LDA
#undef PG8_LDB
#undef PG8_MMA
#undef PG8_WAIT_V
#undef PG8_WAIT_L
#undef PG8_BAR
#undef PG8_SCHED
}
}

#define LAS __attribute__((address_space(3)))
typedef unsigned short bf16_t;
typedef float f32x2 __attribute__((ext_vector_type(2)));
typedef float f32x4 __attribute__((ext_vector_type(4)));
typedef float f32x16 __attribute__((ext_vector_type(16)));
typedef short bf16x8 __attribute__((ext_vector_type(8)));
typedef short s16x4 __attribute__((ext_vector_type(4)));
typedef unsigned u32x4 __attribute__((ext_vector_type(4)));
typedef unsigned u32x2 __attribute__((ext_vector_type(2)));
typedef __bf16 bf16x2v __attribute__((ext_vector_type(2)));
#define MFMA32(a, b, c) __builtin_amdgcn_mfma_f32_32x32x16_bf16((a), (b), (c), 0, 0, 0)

constexpr int D = 1024, NB = 8, TL = 2048, TCX = 256, DEPTH = 4;
constexpr int ML = NB * TL, MC = NB * TCX, M = ML + MC;
constexpr int PPAD = 11776, RWP = 3584, DFF = 2816;
constexpr int NPH = 11, NPHASES = 1 + DEPTH * NPH;
constexpr size_t MiB = 1u << 20;
constexpr size_t WS_MOD = 0, WS_WIN = 1 * MiB, WS_WA = 24 * MiB, WS_WB = 26 * MiB, WS_WC = 28 * MiB, WS_WO = 30 * MiB, WS_WI = 32 * MiB, WS_WO2 = 43 * MiB,
                 WS_LWT = 48 * MiB + MiB / 2, WS_LAT = 49 * MiB, WS_LGT = 49 * MiB + MiB / 2, WS_H = 50 * MiB, WS_XC = 86 * MiB, WS_GU = 94 * MiB, WS_GV = 130 * MiB,
                 WS_Q = 166 * MiB, WS_K = 202 * MiB, WS_V = 238 * MiB, WS_RW = 274 * MiB, WS_GT = 400 * MiB, WS_LIW = 508 * MiB, WS_LIA = 512 * MiB + MiB / 2,
                 WS_LIG = 517 * MiB, WS_DEC1 = 526 * MiB, WS_AA0 = 562 * MiB, WS_AA1 = 598 * MiB, WS_G = 634 * MiB, WS_Y1 = 670 * MiB, WS_ROPE = 706 * MiB, WS_END = 707 * MiB;
constexpr int LDS_BYTES = 131072 + 1024;
constexpr size_t WS_BAR = 917504, BAR_BYTES = 16384;
constexpr float QSCALE = 0.125f * 1.4426950408889634f;

struct Args { const float* in[33]; float* out; unsigned char* ws; int lo, hi; };
typedef const __attribute__((address_space(4))) Args CArgs;
struct TI { int tid, bid, nblk; };

__device__ __forceinline__ float bf2f(unsigned v) { return __uint_as_float(v << 16); }
__device__ __forceinline__ unsigned pkbf(float lo, float hi) { f32x2 v = {lo, hi}; bf16x2v b = __builtin_convertvector(v, bf16x2v); return __builtin_bit_cast(unsigned, b); }
__device__ __forceinline__ bf16_t f2bf(float f) { return (bf16_t)(pkbf(f, 0.f) & 0xffffu); }
#define DPP_ADD(x, ctrl) ((x) + __builtin_bit_cast(float, __builtin_amdgcn_update_dpp(0, __builtin_bit_cast(int, (x)), (ctrl), 0xf, 0xf, true)))
__device__ __forceinline__ float wave_sum(float v) {
    v = DPP_ADD(v, 0xB1); v = DPP_ADD(v, 0x4E); v = DPP_ADD(v, 0x141); v = DPP_ADD(v, 0x140);
    const int iv = __builtin_bit_cast(int, v);
    const float s0 = __builtin_bit_cast(float, __builtin_amdgcn_readlane(iv, 0)), s1 = __builtin_bit_cast(float, __builtin_amdgcn_readlane(iv, 16)),
                s2 = __builtin_bit_cast(float, __builtin_amdgcn_readlane(iv, 32)), s3 = __builtin_bit_cast(float, __builtin_amdgcn_readlane(iv, 48));
    return (s0 + s1) + (s2 + s3);
}
__device__ __forceinline__ float dpp_sum8(float x) {
    x += __builtin_bit_cast(float, __builtin_amdgcn_update_dpp(0, __builtin_bit_cast(int, x), 0xB1, 0xf, 0xf, true));
    x += __builtin_bit_cast(float, __builtin_amdgcn_update_dpp(0, __builtin_bit_cast(int, x), 0x4E, 0xf, 0xf, true));
    x += __builtin_bit_cast(float, __builtin_amdgcn_update_dpp(0, __builtin_bit_cast(int, x), 0x141, 0xf, 0xf, true));
    return x;
}
__device__ __forceinline__ float quad_sum(float x) { x = DPP_ADD(x, 0xB1); x = DPP_ADD(x, 0x4E); return x; }
__device__ __forceinline__ float quad_xor2(float x) { return __builtin_bit_cast(float, __builtin_amdgcn_update_dpp(0, __builtin_bit_cast(int, x), 0x4E, 0xf, 0xf, true)); }
__device__ __forceinline__ void unpack16(const bf16_t* p, float (&x)[16]) {
    const u32x4 a = *(const u32x4*)p, b = *(const u32x4*)(p + 8);
#pragma unroll
    for (int i = 0; i < 4; ++i) { x[2 * i] = bf2f(a[i] & 0xffffu); x[2 * i + 1] = bf2f(a[i] >> 16); x[8 + 2 * i] = bf2f(b[i] & 0xffffu); x[8 + 2 * i + 1] = bf2f(b[i] >> 16); }
}
__device__ __forceinline__ void pack16(bf16_t* p, const float (&x)[16]) {
    u32x4 a, b;
#pragma unroll
    for (int i = 0; i < 4; ++i) { a[i] = pkbf(x[2 * i], x[2 * i + 1]); b[i] = pkbf(x[8 + 2 * i], x[8 + 2 * i + 1]); }
    *(u32x4*)p = a; *(u32x4*)(p + 8) = b;
}
__device__ __forceinline__ void load16f(const float* p, float (&x)[16]) {
#pragma unroll
    for (int i = 0; i < 4; ++i) { const f32x4 v = *(const f32x4*)(p + 4 * i); x[4 * i] = v.x; x[4 * i + 1] = v.y; x[4 * i + 2] = v.z; x[4 * i + 3] = v.w; }
}
__device__ __forceinline__ float sigmoidf_(float x) { return 1.f / (1.f + __expf(-x)); }

template <class Op> struct EpiT {
    static constexpr bool PERM = true, AFTER_DRAIN = false;
    Op op;
    __device__ __forceinline__ void operator()(const pg8::f32x4 (&acc)[2][2][4][2], const pg8::Unit& u, int wr, int wc, int fr, int fq) const {
        const int row0 = u.pm * 256 + wr * 64 + fr, col0 = u.pn * 256 + wc * 32 + 8 * fq;
#pragma unroll
        for (int ai = 0; ai < 2; ++ai)
#pragma unroll
            for (int m = 0; m < 4; ++m)
#pragma unroll
                for (int bj = 0; bj < 2; ++bj) { op(row0 + ai * 128 + m * 16, col0 + bj * 128, acc[ai][bj][m][0], acc[ai][bj][m][1]); asm volatile("" ::: "memory"); }
    }
};
__device__ __forceinline__ u32x4 pack8(f32x4 v0, f32x4 v1) { u32x4 o; o.x = pkbf(v0.x, v0.y); o.y = pkbf(v0.z, v0.w); o.z = pkbf(v1.x, v1.y); o.w = pkbf(v1.z, v1.w); return o; }
__device__ __forceinline__ void unpack8(u32x4 x, f32x4& v0, f32x4& v1) {
    v0.x = bf2f(x.x & 0xffffu); v0.y = bf2f(x.x >> 16); v0.z = bf2f(x.y & 0xffffu); v0.w = bf2f(x.y >> 16);
    v1.x = bf2f(x.z & 0xffffu); v1.y = bf2f(x.z >> 16); v1.z = bf2f(x.w & 0xffffu); v1.w = bf2f(x.w >> 16);
}
__device__ __forceinline__ f32x4 gelu4(f32x4 v) { pg8::f32x2 a = pg8::gelu_pk((pg8::f32x2){v.x, v.y}), b = pg8::gelu_pk((pg8::f32x2){v.z, v.w}); return (f32x4){a.x, a.y, b.x, b.y}; }
__device__ __forceinline__ f32x4 sig4(f32x4 v) { return (f32x4){sigmoidf_(v.x), sigmoidf_(v.y), sigmoidf_(v.z), sigmoidf_(v.w)}; }

struct OpIn {
    bf16_t *GU, *GV, *Q, *RW, *GT;
    __device__ __forceinline__ void operator()(int row, int col, f32x4 v0, f32x4 v1) const {
        bf16_t* dst;
        if (col < 2048) { v0 = gelu4(v0); v1 = gelu4(v1); dst = (col < 1024 ? GU : GV) + (size_t)row * 1024 + (col & 1023); }
        else if (col < 5120) { const int q = col - 2048; dst = Q + (size_t)(q >> 10) * (size_t)(18 * MiB) + (size_t)row * 1024 + (q & 1023); }
        else if (col < 8704) { dst = RW + (size_t)row * RWP + (col - 5120); }
        else { v0 = sig4(v0); v1 = sig4(v1); dst = GT + (size_t)row * 3072 + (col - 8704); }
        *(u32x4*)dst = pack8(v0, v1);
    }
};
struct OpDec {
    bf16_t *D0, *D1; const float* w0;
    __device__ __forceinline__ float f(float x) const { return -0.6065306597126334f * sigmoidf_(x); }
    __device__ __forceinline__ void operator()(int row, int col, f32x4 v0, f32x4 v1) const {
        const f32x4 b0 = *(const f32x4*)(w0 + col), b1 = *(const f32x4*)(w0 + col + 4);
        v0 += b0; v1 += b1;
        v0 = (f32x4){f(v0.x), f(v0.y), f(v0.z), f(v0.w)}; v1 = (f32x4){f(v1.x), f(v1.y), f(v1.z), f(v1.w)};
        bf16_t* dst = (col < 1024 ? D0 : D1) + (size_t)row * 1024 + (col & 1023);
        *(u32x4*)dst = pack8(v0, v1);
    }
};
struct OpAA {
    bf16_t *A0, *A1; const float* a0;
    __device__ __forceinline__ void operator()(int row, int col, f32x4 v0, f32x4 v1) const {
        const f32x4 b0 = *(const f32x4*)(a0 + col), b1 = *(const f32x4*)(a0 + col + 4);
        v0 = sig4(v0 + b0); v1 = sig4(v1 + b1);
        bf16_t* dst = (col < 1024 ? A0 : A1) + (size_t)row * 1024 + (col & 1023);
        *(u32x4*)dst = pack8(v0, v1);
    }
};
struct OpG {
    bf16_t* G;
    __device__ __forceinline__ void operator()(int row, int col, f32x4 v0, f32x4 v1) const { *(u32x4*)(G + (size_t)row * 1024 + col) = pack8(v0, v1); }
};
template <int KB> struct OpMerge {
    const bf16_t* GT; float* MF; bf16_t* MB;
    __device__ __forceinline__ void operator()(int row, int col, f32x4 v0, f32x4 v1) const {
        f32x4 g0, g1; unpack8(*(const u32x4*)(GT + (size_t)row * 3072 + KB * 1024 + col), g0, g1);
        float* mf = MF + (size_t)row * 1024 + col;
        f32x4 r0 = g0 * v0, r1 = g1 * v1;
        if (KB > 0) { r0 += *(const f32x4*)mf; r1 += *(const f32x4*)(mf + 4); }
        if (KB < 2) { *(f32x4*)mf = r0; *(f32x4*)(mf + 4) = r1; }
        else *(u32x4*)(MB + (size_t)row * 1024 + col) = pack8(r0, r1);
    }
};
struct OpResid {
    const float *xl, *xc; float *ol, *oc; const float* mod; int gi;
    __device__ __forceinline__ void operator()(int row, int col, f32x4 v0, f32x4 v1) const {
        const float* xi; float* xo; const float* g;
        if (row < ML) { xi = xl + (size_t)row * 1024 + col; xo = ol + (size_t)row * 1024 + col; g = mod + (size_t)(row >> 11) * 6144 + gi * 1024 + col; }
        else { const size_t rr = (size_t)(row - ML) * 1024 + col; xi = xc + rr; xo = oc + rr; g = mod + (size_t)8 * 6144 + gi * 1024 + col; }
        const f32x4 x0 = *(const f32x4*)xi, x1 = *(const f32x4*)(xi + 4), g0 = *(const f32x4*)g, g1 = *(const f32x4*)(g + 4);
        *(f32x4*)xo = x0 + g0 * v0; *(f32x4*)(xo + 4) = x1 + g1 * v1;
    }
};
struct OpSwiglu {
    bf16_t* HID;
    __device__ __forceinline__ void operator()(int row, int col, f32x4 v0, f32x4 v1) const {
        const float h0 = v0.x * sigmoidf_(v0.x) * v0.y, h1 = v0.z * sigmoidf_(v0.z) * v0.w, h2 = v1.x * sigmoidf_(v1.x) * v1.y, h3 = v1.z * sigmoidf_(v1.z) * v1.w;
        u32x2 o; o.x = pkbf(h0, h1); o.y = pkbf(h2, h3);
        *(u32x2*)(HID + (size_t)row * DFF + (col >> 1)) = o;
    }
};
template <class Op> __device__ __forceinline__ void run_gemm(const TI ti, unsigned char* lds, const bf16_t* A, const bf16_t* Bt, int Mr, int N, int K, const Op& op) {
    int Kv = K; asm volatile("" : "+s"(Kv));
    pg8::Gemm g{A, Bt, Mr, N, Kv}; pg8::StaticOrder S; S.init(Mr, N, ti.nblk, ti.bid);
    EpiT<Op> E{op};
    pg8::gemm_phase<EpiT<Op>, pg8::StaticOrder, true, true>((PG8_LAS unsigned char*)lds, g, S, E, ti.tid);
}

__device__ __forceinline__ void ph_mods(const TI ti, CArgs& a, unsigned char* ldsg) {
    float* sc = (float*)ldsg; float* part = sc + 9 * 1024;
    const int tid = ti.tid, lane = tid & 63, w = tid >> 6;
    for (int i = tid; i < 9 * 1024; i += 512) { const float v = (i < 8192) ? a.in[1][i] : a.in[3][i - 8192]; sc[i] = v / (1.f + expf(-v)); }
    __syncthreads();
    float* MOD = (float*)(a.ws + WS_MOD);
    for (int item = ti.bid; item < DEPTH * 96; item += ti.nblk) {
        const int l = item / 96, n0 = (item % 96) * 64;
        const float* W = a.in[4] + (size_t)l * 1024 * 6144 + n0 + lane;
        float acc[9];
#pragma unroll
        for (int r = 0; r < 9; ++r) acc[r] = 0.f;
#pragma unroll 8
        for (int k = w * 128; k < w * 128 + 128; ++k) {
            const float wv = W[(size_t)k * 6144];
#pragma unroll
            for (int r = 0; r < 9; ++r) acc[r] += sc[r * 1024 + k] * wv;
        }
#pragma unroll
        for (int r = 0; r < 9; ++r) part[(w * 9 + r) * 64 + lane] = acc[r];
        __syncthreads();
        for (int idx = tid; idx < 576; idx += 512) {
            const int r = idx >> 6, ln = idx & 63; float s = a.in[5][l * 6144 + n0 + ln];
            for (int ww = 0; ww < 8; ++ww) s += part[(ww * 9 + r) * 64 + ln];
            MOD[((size_t)l * 9 + r) * 6144 + n0 + ln] = s;
        }
        __syncthreads();
    }
    float* RC = (float*)(a.ws + WS_ROPE); float* RS = RC + 2048 * 32;
    for (int idx = ti.bid * 512 + tid; idx < 2048 * 32; idx += ti.nblk * 512) {
        const int t = idx >> 5, i = idx & 31; const float pos = i < 16 ? (float)(t >> 6) : (float)(t & 63);
        const float ang = pos * exp2f(-(float)(i & 15) * (13.287712379549449f / 16.f));
        RC[idx] = cosf(ang); RS[idx] = sinf(ang);
    }
}

__device__ __forceinline__ void norm_rows(const float* xl, const float* xc, const float* g, const float* modl, int shi, int sci, bf16_t* H, int nrows, int gw, int ngw, int lane) {
    for (int row = gw; row < nrows; row += ngw) {
        const float* src; int r;
        if (row < ML) { src = xl + (size_t)row * D; r = row >> 11; } else { src = xc + (size_t)(row - ML) * D; r = 8; }
        const float* md = modl + (size_t)r * 6144;
        f32x4 v[4]; float ss = 0.f;
#pragma unroll
        for (int j = 0; j < 4; ++j) { v[j] = *(const f32x4*)(src + 4 * lane + 256 * j); ss += (v[j].x * v[j].x + v[j].y * v[j].y) + (v[j].z * v[j].z + v[j].w * v[j].w); }
        ss = wave_sum(ss);
        const float rstd = rsqrtf(ss * (1.f / 1024.f) + 1e-6f);
#pragma unroll
        for (int j = 0; j < 4; ++j) {
            const int c = 4 * lane + 256 * j;
            const f32x4 gg = *(const f32x4*)(g + c), scv = *(const f32x4*)(md + sci * 1024 + c), shv = *(const f32x4*)(md + shi * 1024 + c);
            const f32x4 o = v[j] * rstd * gg * (1.f + scv) + shv;
            u32x2 p; p.x = pkbf(o.x, o.y); p.y = pkbf(o.z, o.w);
            *(u32x2*)(H + (size_t)row * D + c) = p;
        }
    }
}

template <int MODE> __device__ __forceinline__ void transpose_item(const float* W, int K, int N, bf16_t* WT, LAS float* scr, int item, int lane) {
    const int nblk = N / 32, kb = item / nblk, nb = item % nblk, k0 = 64 * kb, n0 = 32 * nb;
#pragma unroll 8
    for (int i = 0; i < 32; ++i) { const int kk = 2 * i + (lane >> 5); scr[kk * 33 + (lane & 31)] = W[(size_t)(k0 + kk) * N + n0 + (lane & 31)]; }
    asm volatile("s_waitcnt lgkmcnt(0)" ::: "memory");
    const int c = lane & 7;
#pragma unroll
    for (int j = 0; j < 4; ++j) {
        const int n = (lane >> 3) + 8 * j, gn = n0 + n; const LAS float* s = scr + (8 * c) * 33 + n;
        const int drow = MODE == 0 ? gn : (MODE == 1 ? (gn >= 8608 ? gn + 96 : gn) : (gn < DFF ? 2 * gn : 2 * (gn - DFF) + 1));
        u32x4 o; o.x = pkbf(s[0 * 33], s[1 * 33]); o.y = pkbf(s[2 * 33], s[3 * 33]); o.z = pkbf(s[4 * 33], s[5 * 33]); o.w = pkbf(s[6 * 33], s[7 * 33]);
        *(u32x4*)(WT + (size_t)drow * K + k0 + 8 * c) = o;
    }
    asm volatile("s_waitcnt lgkmcnt(0)" ::: "memory");
}
__device__ __forceinline__ void ph_wconv(CArgs& a, int l, unsigned char* ldsg, int gw, int ngw, int lane, int wv) {
    LAS float* scr = (LAS float*)(ldsg + wv * 8704);
    unsigned char* ws = a.ws;
    constexpr int I_IN = 16 * 365, I_SQ = 16 * 32, I_WI = 16 * 176, I_WO = 44 * 32, NIT = I_IN + 4 * I_SQ + I_WI + I_WO;
    for (int it = gw; it < NIT; it += ngw) {
        int r = it;
        if (r < I_IN) { transpose_item<1>(a.in[8] + (size_t)l * 1024 * 11680, 1024, 11680, (bf16_t*)(ws + WS_WIN), scr, r, lane); continue; } r -= I_IN;
        if (r < I_SQ) { transpose_item<0>(a.in[27] + (size_t)l * 1048576, 1024, 1024, (bf16_t*)(ws + WS_WA), scr, r, lane); continue; } r -= I_SQ;
        if (r < I_SQ) { transpose_item<0>(a.in[28] + (size_t)l * 1048576, 1024, 1024, (bf16_t*)(ws + WS_WB), scr, r, lane); continue; } r -= I_SQ;
        if (r < I_SQ) { transpose_item<0>(a.in[29] + (size_t)l * 1048576, 1024, 1024, (bf16_t*)(ws + WS_WC), scr, r, lane); continue; } r -= I_SQ;
        if (r < I_SQ) { transpose_item<0>(a.in[30] + (size_t)l * 1048576, 1024, 1024, (bf16_t*)(ws + WS_WO), scr, r, lane); continue; } r -= I_SQ;
        if (r < I_WI) { transpose_item<2>(a.in[31] + (size_t)l * 1024 * 5632, 1024, 5632, (bf16_t*)(ws + WS_WI), scr, r, lane); continue; } r -= I_WI;
        transpose_item<0>(a.in[32] + (size_t)l * DFF * 1024, DFF, 1024, (bf16_t*)(ws + WS_WO2), scr, r, lane);
    }
    const int gt = gw * 64 + lane, ngt = ngw * 64;
    bf16_t* LWT = (bf16_t*)(ws + WS_LWT); bf16_t* LAT = (bf16_t*)(ws + WS_LAT); bf16_t* LGT = (bf16_t*)(ws + WS_LGT);
    const float* w2 = a.in[18] + (size_t)l * 2 * 64 * 1024; const float* a2 = a.in[20] + (size_t)l * 2 * 64 * 1024; const float* g2 = a.in[21] + (size_t)l * 160 * 1024;
    for (int i = gt; i < 2048 * 128; i += ngt) {
        const int n = i >> 7, k = i & 127, d = n >> 10, c = n & 1023, kk = k - d * 64;
        const bool in = (kk >= 0 && kk < 64);
        LWT[i] = in ? f2bf(w2[((size_t)d * 64 + kk) * 1024 + c]) : (bf16_t)0;
        LAT[i] = in ? f2bf(a2[((size_t)d * 64 + kk) * 1024 + c]) : (bf16_t)0;
    }
    for (int i = gt; i < 1024 * 256; i += ngt) { const int n = i >> 8, k = i & 255; LGT[i] = k < 160 ? f2bf(g2[(size_t)k * 1024 + n]) : (bf16_t)0; }
    bf16_t* WIN = (bf16_t*)(ws + WS_WIN);
    for (int i = gt; i < 96 * 1024; i += ngt) WIN[(size_t)8608 * 1024 + i] = 0;
}

__device__ __forceinline__ void gmlp_unit(const TI ti, CArgs& a, int l, int u, unsigned char* ldsg) {
    float* rstd = (float*)ldsg; bf16_t* VNT = (bf16_t*)(ldsg + 512);
    const int tid = ti.tid, lane = tid & 63, w = tid >> 6, r = lane & 31, h = lane >> 5;
    bf16_t* GU = (bf16_t*)(a.ws + WS_GU); const bf16_t* GV = (const bf16_t*)(a.ws + WS_GV);
    const size_t R0 = (size_t)u * 128;
#pragma unroll 4
    for (int i = 0; i < 16; ++i) {
        const int tok = w * 16 + i; const bf16_t* p = GV + (R0 + tok) * 1024 + lane * 16;
        f32x4 x0, x1, x2, x3; unpack8(*(const u32x4*)p, x0, x1); unpack8(*(const u32x4*)(p + 8), x2, x3);
        float ss = (x0.x * x0.x + x0.y * x0.y + x0.z * x0.z + x0.w * x0.w) + (x1.x * x1.x + x1.y * x1.y + x1.z * x1.z + x1.w * x1.w)
                 + (x2.x * x2.x + x2.y * x2.y + x2.z * x2.z + x2.w * x2.w) + (x3.x * x3.x + x3.y * x3.y + x3.z * x3.z + x3.w * x3.w);
        ss = wave_sum(ss);
        if (lane == 0) rstd[tok] = rsqrtf(ss * (1.f / 1024.f) + 1e-6f);
    }
    __syncthreads();
    const float* gvg = a.in[9] + l * 1024; const float* wsp = a.in[10] + (size_t)l * 8 * 128 * 128; const float* bsp = a.in[11] + l * 8 * 128;
    const int tt = w & 3, chh = w >> 2;
    for (int g = 0; g < 8; ++g) {
        {
            const int s = tid & 127, cc = tid >> 7; const float rs = rstd[s]; const bf16_t* p = GV + (R0 + s) * 1024 + g * 128 + cc * 32;
#pragma unroll
            for (int q = 0; q < 4; ++q) {
                f32x4 x0, x1; unpack8(*(const u32x4*)(p + 8 * q), x0, x1);
                const float* gp = gvg + g * 128 + cc * 32 + 8 * q; const int c0 = cc * 32 + 8 * q;
                VNT[(c0 + 0) * 136 + s] = f2bf(x0.x * rs * gp[0]); VNT[(c0 + 1) * 136 + s] = f2bf(x0.y * rs * gp[1]);
                VNT[(c0 + 2) * 136 + s] = f2bf(x0.z * rs * gp[2]); VNT[(c0 + 3) * 136 + s] = f2bf(x0.w * rs * gp[3]);
                VNT[(c0 + 4) * 136 + s] = f2bf(x1.x * rs * gp[4]); VNT[(c0 + 5) * 136 + s] = f2bf(x1.y * rs * gp[5]);
                VNT[(c0 + 6) * 136 + s] = f2bf(x1.z * rs * gp[6]); VNT[(c0 + 7) * 136 + s] = f2bf(x1.w * rs * gp[7]);
            }
        }
        __syncthreads();
        f32x16 acc0, acc1;
#pragma unroll
        for (int i = 0; i < 16; ++i) { acc0[i] = 0.f; acc1[i] = 0.f; }
        const float* wrow = wsp + ((size_t)g * 128 + tt * 32 + r) * 128;
#pragma unroll
        for (int ks = 0; ks < 8; ++ks) {
            const f32x4 a0 = *(const f32x4*)(wrow + 16 * ks + 8 * h), a1 = *(const f32x4*)(wrow + 16 * ks + 8 * h + 4);
            const bf16x8 af = __builtin_bit_cast(bf16x8, pack8(a0, a1));
            const bf16x8 b0 = *(const bf16x8*)(VNT + (chh * 64 + r) * 136 + 16 * ks + 8 * h);
            const bf16x8 b1 = *(const bf16x8*)(VNT + (chh * 64 + 32 + r) * 136 + 16 * ks + 8 * h);
            acc0 = MFMA32(af, b0, acc0); acc1 = MFMA32(af, b1, acc1);
        }
        {
            const bf16_t* GUr = GU; float uu0[16], uu1[16], bb[16];
#pragma unroll
            for (int reg = 0; reg < 16; ++reg) {
                const int t = tt * 32 + (reg & 3) + 8 * (reg >> 2) + 4 * h; const size_t i0 = (R0 + t) * 1024 + g * 128 + chh * 64 + r;
                bb[reg] = bsp[g * 128 + t]; uu0[reg] = bf2f(GUr[i0]); uu1[reg] = bf2f(GUr[i0 + 32]);
            }
            asm volatile("" ::: "memory");
#pragma unroll
            for (int reg = 0; reg < 16; ++reg) {
                const int t = tt * 32 + (reg & 3) + 8 * (reg >> 2) + 4 * h; const size_t i0 = (R0 + t) * 1024 + g * 128 + chh * 64 + r;
                GU[i0] = f2bf(uu0[reg] * (acc0[reg] + bb[reg])); GU[i0 + 32] = f2bf(uu1[reg] * (acc1[reg] + bb[reg]));
            }
        }
        __syncthreads();
    }
}
__device__ __forceinline__ void qk_rows(CArgs& a, int l, int gw, int ngw, int lane) {
    bf16_t* Q = (bf16_t*)(a.ws + WS_Q); bf16_t* K = (bf16_t*)(a.ws + WS_K);
    const float* RC = (const float*)(a.ws + WS_ROPE); const float* RS = RC + 2048 * 32;
    const int part = lane & 3;
    float gq[16], gk[16];
    load16f(a.in[12] + l * 64 + 16 * part, gq); load16f(a.in[13] + l * 64 + 16 * part, gk);
    for (int row = gw; row < M; row += ngw) {
        float xq[16], xk[16], cs[16], sn[16];
        unpack16(Q + (size_t)row * 1024 + 16 * lane, xq); unpack16(K + (size_t)row * 1024 + 16 * lane, xk);
        const bool lat = row < ML;
        if (lat) { const int t = row & 2047; load16f(RC + t * 32 + 16 * (part & 1), cs); load16f(RS + t * 32 + 16 * (part & 1), sn); }
        float sq = 0.f, sk = 0.f;
#pragma unroll
        for (int j = 0; j < 16; ++j) { sq += xq[j] * xq[j]; sk += xk[j] * xk[j]; }
        const float rq = rsqrtf(quad_sum(sq) * (1.f / 64.f) + 1e-6f), rk = rsqrtf(quad_sum(sk) * (1.f / 64.f) + 1e-6f);
#pragma unroll
        for (int j = 0; j < 16; ++j) { xq[j] = xq[j] * rq * gq[j]; xk[j] = xk[j] * rk * gk[j]; }
        if (lat) {
            const float sgn = part < 2 ? -1.f : 1.f;
#pragma unroll
            for (int j = 0; j < 16; ++j) {
                const float pq = quad_xor2(xq[j]), pk = quad_xor2(xk[j]);
                xq[j] = xq[j] * cs[j] + sgn * pq * sn[j]; xk[j] = xk[j] * cs[j] + sgn * pk * sn[j];
            }
        }
#pragma unroll
        for (int j = 0; j < 16; ++j) xq[j] *= QSCALE;
        pack16(Q + (size_t)row * 1024 + 16 * lane, xq); pack16(K + (size_t)row * 1024 + 16 * lane, xk);
    }
}
__device__ __forceinline__ void lora_in_rows(CArgs& a, int l, int gw, int ngw, int lane) {
    const bf16_t* RW = (const bf16_t*)(a.ws + WS_RW); bf16_t* LW = (bf16_t*)(a.ws + WS_LIW); bf16_t* LA = (bf16_t*)(a.ws + WS_LIA); bf16_t* LG = (bf16_t*)(a.ws + WS_LIG);
    const float* mu = a.in[16] + l * 3488 + 3072;
    f32x4 m0 = {0.f, 0.f, 0.f, 0.f}, m1 = m0;
    if (lane < 52) { m0 = *(const f32x4*)(mu + 8 * lane); m1 = *(const f32x4*)(mu + 8 * lane + 4); }
    for (int row = gw; row < M; row += ngw) {
        int t, Tn; if (row < ML) { t = row & 2047; Tn = 2048; } else { t = (row - ML) & 255; Tn = 256; }
        const bool hp = t > 0, hn = t < Tn - 1;
        if (lane < 52) {
            const bf16_t* p = RW + (size_t)row * RWP + 3072 + 8 * lane;
            f32x4 x0, x1, p0 = {0.f, 0.f, 0.f, 0.f}, p1 = p0, n0 = p0, n1 = p0;
            unpack8(*(const u32x4*)p, x0, x1);
            if (hp) unpack8(*(const u32x4*)(p - RWP), p0, p1);
            if (hn) unpack8(*(const u32x4*)(p + RWP), n0, n1);
            f32x4 z0 = x0 + m0 * (0.5f * (p0 + n0) - x0), z1 = x1 + m1 * (0.5f * (p1 + n1) - x1);
            const int j = 8 * lane;
            if (j < 128) { z0 = (f32x4){tanhf(z0.x), tanhf(z0.y), tanhf(z0.z), tanhf(z0.w)}; z1 = (f32x4){tanhf(z1.x), tanhf(z1.y), tanhf(z1.z), tanhf(z1.w)}; *(u32x4*)(LW + (size_t)row * 128 + j) = pack8(z0, z1); }
            else if (j < 256) { *(u32x4*)(LA + (size_t)row * 128 + j - 128) = pack8(z0, z1); }
            else { *(u32x4*)(LG + (size_t)row * 256 + j - 256) = pack8(sig4(z0), sig4(z1)); }
        } else {
            unsigned z_ = 0u; asm volatile("" : "+v"(z_)); *(u32x4*)(LG + (size_t)row * 256 + 160 + (lane - 52) * 8) = (u32x4){z_, z_, z_, z_};
        }
    }
}

__device__ __forceinline__ void scan_unit(const TI ti, CArgs& a, int l, int u, bool ctx_out, unsigned char* ldsg) {
    const int tid = ti.tid, lane = tid & 63, w = tid >> 6;
    const int b = u >> 5, hh = (u >> 1) & 15, d = u & 1;
    const int si = tid >> 3, jq = tid & 7;
    LAS float* L = (LAS float*)ldsg;
    const bf16_t* RW = (const bf16_t*)(a.ws + WS_RW);
    const bf16_t* DEC = (const bf16_t*)(a.ws + (d ? WS_DEC1 : WS_GV));
    const bf16_t* AA = (const bf16_t*)(a.ws + (d ? WS_AA1 : WS_AA0));
    bf16_t* Y = (bf16_t*)(a.ws + (d ? WS_Y1 : WS_H));
    const int ch = hh * 64 + lane;
    const float* mu = a.in[16] + l * 3488;
    const float mur = mu[ch], muk = mu[1024 + ch], muv = mu[2048 + ch], kkg = a.in[22][l * 1024 + ch], kag = a.in[23][l * 1024 + ch];
    f32x4 S0 = {0.f, 0.f, 0.f, 0.f}, S1 = {0.f, 0.f, 0.f, 0.f};
    unsigned raw[4][9]; unsigned dcr[4], aar[4];
    constexpr int NC = 72;
#define SCAN_CHUNK(n, base, Tn, t0, wy) int base, Tn, t0; bool wy; { int ci; if ((n) < 8) { base = ML + b * 256; Tn = 256; ci = d ? 7 - (n) : (n); wy = ctx_out; } else { base = b * 2048; Tn = 2048; ci = d ? 71 - (n) : (n) - 8; wy = true; } t0 = ci * 32; }
#define SCAN_LOAD(n) do { SCAN_CHUNK(n, base_, Tn_, t0_, wy_); (void)wy_; _Pragma("unroll") for (int i4 = 0; i4 < 4; ++i4) { const int t = t0_ + w + 8 * i4; const size_t row = (size_t)(base_ + t); \
        const bf16_t* p = RW + row * RWP + ch; const bool hp = t > 0, hn = t < Tn_ - 1; \
        const int op_ = hp ? -RWP : 0, on_ = hn ? RWP : 0;     \
        _Pragma("unroll") for (int X = 0; X < 3; ++X) { raw[i4][3 * X + 0] = (unsigned)p[X * 1024 + op_]; raw[i4][3 * X + 1] = (unsigned)p[X * 1024]; raw[i4][3 * X + 2] = (unsigned)p[X * 1024 + on_]; } \
        dcr[i4] = (unsigned)DEC[row * 1024 + ch]; aar[i4] = (unsigned)AA[row * 1024 + ch]; } } while (0)
#define SCAN_STORE(n) do { LAS float* Bf = L + ((n) & 1) * 12288; SCAN_CHUNK(n, base_, Tn_, t0_, wy_); (void)wy_; (void)base_; _Pragma("unroll") for (int i4 = 0; i4 < 4; ++i4) { const int tk = w + 8 * i4; \
        const float mp_ = (t0_ + tk > 0) ? 0.5f : 0.f, mn_ = (t0_ + tk < Tn_ - 1) ? 0.5f : 0.f; \
        const float xr = bf2f(raw[i4][1]), xk = bf2f(raw[i4][4]), xv = bf2f(raw[i4][7]); \
        const float zr = xr + mur * ((mp_ * bf2f(raw[i4][0]) + mn_ * bf2f(raw[i4][2])) - xr); \
        const float zk = xk + muk * ((mp_ * bf2f(raw[i4][3]) + mn_ * bf2f(raw[i4][5])) - xk); \
        const float zv = xv + muv * ((mp_ * bf2f(raw[i4][6]) + mn_ * bf2f(raw[i4][8])) - xv); \
        const float kkv = zk * kkg; const float ssq = wave_sum(kkv * kkv); const float kkn = kkv / fmaxf(sqrtf(ssq), 1e-12f); \
        const float ad = bf2f(aar[i4]); const float wv_ = __expf(bf2f(dcr[i4])); const float kd = zk * (1.f + (ad - 1.f) * kag); \
        Bf[0 * 2048 + tk * 64 + lane] = wv_; Bf[1 * 2048 + tk * 64 + lane] = kd; Bf[2 * 2048 + tk * 64 + lane] = -kkn; \
        Bf[3 * 2048 + tk * 64 + lane] = kkn * ad; Bf[4 * 2048 + tk * 64 + lane] = zr; Bf[5 * 2048 + tk * 64 + lane] = zv; } } while (0)
    SCAN_LOAD(0); SCAN_STORE(0);
    __syncthreads();
    for (int n = 0; n < NC; ++n) {
        if (n + 1 < NC) SCAN_LOAD(n + 1);
        LAS const float* Bf = L + (n & 1) * 12288; LAS float* Yb = L + 24576 + (n & 1) * 2048;
#define STEP_LOAD(P, sidx) LAS const float* q##P = Bf + (sidx) * 64 + 8 * jq + hoff; \
            const f32x4 w0##P = *(LAS const f32x4*)(q##P), w1##P = *(LAS const f32x4*)(q##P + hdq), k0##P = *(LAS const f32x4*)(q##P + 2048), k1##P = *(LAS const f32x4*)(q##P + 2048 + hdq), \
                        a0##P = *(LAS const f32x4*)(q##P + 4096), a1##P = *(LAS const f32x4*)(q##P + 4096 + hdq), b0##P = *(LAS const f32x4*)(q##P + 6144), b1##P = *(LAS const f32x4*)(q##P + 6144 + hdq), \
                        r0##P = *(LAS const f32x4*)(q##P + 8192), r1##P = *(LAS const f32x4*)(q##P + 8192 + hdq); const float vi##P = Bf[5 * 2048 + (sidx) * 64 + si];
#define STEP_MATH(P, sidx) { const f32x4 ta = S0 * a0##P + S1 * a1##P; const float sa = dpp_sum8((ta.x + ta.y) + (ta.z + ta.w)); \
            S0 = S0 * w0##P + (sa * b0##P + vi##P * k0##P); S1 = S1 * w1##P + (sa * b1##P + vi##P * k1##P); \
            const f32x4 ty = S0 * r0##P + S1 * r1##P; const float y = dpp_sum8((ty.x + ty.y) + (ty.z + ty.w)); if (jq == 0) Yb[(sidx) * 64 + si] = y; }
        const int hoff = (si & 1) * 4, hdq = 4 - 2 * hoff;
        const int sdir = d ? -1 : 1; int sc = d ? 31 : 0;
        f32x4 cw0, cw1, ck0, ck1, ca0, ca1, cb0, cb1, cr0, cr1; float cvi;
        { STEP_LOAD(X, sc); cw0 = w0X; cw1 = w1X; ck0 = k0X; ck1 = k1X; ca0 = a0X; ca1 = a1X; cb0 = b0X; cb1 = b1X; cr0 = r0X; cr1 = r1X; cvi = viX; }
        for (int ss = 0; ss < 32; ss += 2) {
            const int s0i = sc, s1i = sc + sdir; int s2i = sc + 2 * sdir; s2i = (ss + 2 < 32) ? s2i : s1i;
            STEP_LOAD(B, s1i);
            { const f32x4 w0A = cw0, w1A = cw1, k0A = ck0, k1A = ck1, a0A = ca0, a1A = ca1, b0A = cb0, b1A = cb1, r0A = cr0, r1A = cr1; const float viA = cvi; STEP_MATH(A, s0i); }
            STEP_LOAD(C, s2i);
            STEP_MATH(B, s1i);
            cw0 = w0C; cw1 = w1C; ck0 = k0C; ck1 = k1C; ca0 = a0C; ca1 = a1C; cb0 = b0C; cb1 = b1C; cr0 = r0C; cr1 = r1C; cvi = viC;
            sc += 2 * sdir;
        }
#undef STEP_LOAD
#undef STEP_MATH
        if (n + 1 < NC) SCAN_STORE(n + 1);
        __syncthreads();
        {
            SCAN_CHUNK(n, base_, Tn_, t0_, wy_); (void)Tn_;
            if (wy_) {
#pragma unroll
                for (int i4 = 0; i4 < 4; ++i4) { const int tk = w + 8 * i4; Y[(size_t)(base_ + t0_ + tk) * 1024 + ch] = f2bf(Yb[tk * 64 + lane]); }
            }
        }
    }
    __syncthreads();
#undef SCAN_CHUNK
#undef SCAN_LOAD
#undef SCAN_STORE
}

__device__ __forceinline__ bf16x8 pk8f(float f0, float f1, float f2, float f3, float f4, float f5, float f6, float f7) {
    u32x4 p; p.x = pkbf(f0, f1); p.y = pkbf(f2, f3); p.z = pkbf(f4, f5); p.w = pkbf(f6, f7); return __builtin_bit_cast(bf16x8, p);
}
__device__ __forceinline__ void scan_unit_mfma(const TI ti, CArgs& a, int l, int u, bool ctx_out, unsigned char* ldsg) {
    const int tid = ti.tid, lane = tid & 63, w = __builtin_amdgcn_readfirstlane(tid >> 6);
    const int b = u >> 5, hh = (u >> 1) & 15, d = u & 1;
    LAS unsigned char* L = (LAS unsigned char*)ldsg;
    constexpr int NCH = 144, RING = 6, BUFB = 20736, O_AR = 0, O_BK = 4608, O_BKT = 9216, O_VTT = 14336, O_PC = 17408, O_NS = 17664, O_XF = 18688;
#define SC2_CHUNK(C, base, Tn, cc, wy) int base, Tn, cc; bool wy; if ((C) < 16) { base = ML + b * 256; Tn = 256; cc = (C); wy = ctx_out; } else { base = b * 2048; Tn = 2048; cc = (C) - 16; wy = true; }
#define SC2_TOK(Tn, cc, t) (d ? (Tn) - 1 - (16 * (cc) + (t)) : 16 * (cc) + (t))
    if (w < 2) {
        const int it = w, r = lane & 31, h = lane >> 5;
        bf16_t* Y = (bf16_t*)(a.ws + (d ? WS_Y1 : WS_H));
        f32x16 ST0, ST1;
#pragma unroll
        for (int i = 0; i < 16; ++i) { ST0[i] = 0.f; ST1[i] = 0.f; }
        for (int n = 0; n < NCH + RING; ++n) {
            if (n >= RING) {
                const int C = n - RING;
                LAS const unsigned char* buf = L + (C % RING) * BUFB;
                const bf16x8 xb0 = *(LAS const bf16x8*)(buf + O_XF + lane * 16), xb1 = *(LAS const bf16x8*)(buf + O_XF + 1024 + lane * 16);
                f32x16 Z;
#pragma unroll
                for (int i = 0; i < 16; ++i) Z[i] = 0.f;
#pragma unroll
                for (int jt = 0; jt < 2; ++jt) {
#pragma unroll
                    for (int s = 0; s < 2; ++s) {
                        LAS const unsigned char* ap = buf + O_AR + r * 144 + (32 * jt + 16 * s + 4 * h) * 2;
                        const s16x4 lo = *(LAS const s16x4*)ap, hi = *(LAS const s16x4*)(ap + 16);
                        const bf16x8 a2 = __builtin_shufflevector(lo, hi, 0, 1, 2, 3, 4, 5, 6, 7);
                        const bf16x8 stp = jt == 0 ? pk8f(ST0[8 * s], ST0[8 * s + 1], ST0[8 * s + 2], ST0[8 * s + 3], ST0[8 * s + 4], ST0[8 * s + 5], ST0[8 * s + 6], ST0[8 * s + 7])
                                                   : pk8f(ST1[8 * s], ST1[8 * s + 1], ST1[8 * s + 2], ST1[8 * s + 3], ST1[8 * s + 4], ST1[8 * s + 5], ST1[8 * s + 6], ST1[8 * s + 7]);
                        Z = MFMA32(a2, stp, Z);
                    }
                }
                LAS const unsigned char* vp = buf + O_VTT + (32 * it + r) * 48;
                {
                    const s16x4 lo = *(LAS const s16x4*)(vp + 8 * h), hi = *(LAS const s16x4*)(vp + 16 + 8 * h);
                    const bf16x8 vf = __builtin_shufflevector(lo, hi, 0, 1, 2, 3, 4, 5, 6, 7);
                    Z = MFMA32(xb1, vf, Z);
                }
                float o[8], g[16], uu[16];
#pragma unroll
                for (int q = 0; q < 8; ++q) o[q] = __shfl_xor(Z[q], 32);
#pragma unroll
                for (int e = 0; e < 4; ++e) {
                    g[e] = h ? o[e] : Z[e]; g[4 + e] = h ? Z[e] : o[e];
                    g[8 + e] = h ? o[4 + e] : Z[4 + e]; g[12 + e] = h ? Z[4 + e] : o[4 + e];
                }
                {
                    LAS const float* NS = (LAS const float*)(buf + O_NS);
#pragma unroll
                    for (int t = 0; t < 16; ++t) uu[t] = g[t];
#pragma unroll
                    for (int s = 0; s < 15; ++s) {
#pragma unroll
                        for (int t4 = (s + 1) / 4; t4 < 4; ++t4) {
                            const f32x4 nv = *(LAS const f32x4*)(NS + s * 16 + 4 * t4);
                            if (4 * t4 + 0 > s) uu[4 * t4 + 0] = __builtin_fmaf(nv.x, uu[s], uu[4 * t4 + 0]);
                            if (4 * t4 + 1 > s) uu[4 * t4 + 1] = __builtin_fmaf(nv.y, uu[s], uu[4 * t4 + 1]);
                            if (4 * t4 + 2 > s) uu[4 * t4 + 2] = __builtin_fmaf(nv.z, uu[s], uu[4 * t4 + 2]);
                            if (4 * t4 + 3 > s) uu[4 * t4 + 3] = __builtin_fmaf(nv.w, uu[s], uu[4 * t4 + 3]);
                        }
                    }
                }
                {
                    const bf16x8 uf = pk8f(h ? uu[4] : uu[0], h ? uu[5] : uu[1], h ? uu[6] : uu[2], h ? uu[7] : uu[3],
                                           h ? uu[12] : uu[8], h ? uu[13] : uu[9], h ? uu[14] : uu[10], h ? uu[15] : uu[11]);
                    Z = MFMA32(xb0, uf, Z);
                }
                {
                    SC2_CHUNK(C, base_, Tn_, cc_, wy_);
                    if (wy_) {
#pragma unroll
                        for (int q = 8; q < 16; ++q) {
                            const int t = (q & 3) + 8 * ((q >> 2) - 2) + 4 * h; const int tok = SC2_TOK(Tn_, cc_, t);
                            Y[(size_t)(base_ + tok) * 1024 + hh * 64 + 32 * it + r] = f2bf(Z[q]);
                        }
                    }
                }
                {
                    const bf16x8 un = pk8f(h ? uu[8] : uu[0], h ? uu[9] : uu[1], h ? uu[10] : uu[2], h ? uu[11] : uu[3],
                                           h ? uu[12] : uu[4], h ? uu[13] : uu[5], h ? uu[14] : uu[6], h ? uu[15] : uu[7]);
                    const bf16x8 vn = *(LAS const bf16x8*)(vp + 16 * h);
                    const bf16x8 a00 = *(LAS const bf16x8*)(buf + O_BKT + r * 80 + (8 * h) * 2), a01 = *(LAS const bf16x8*)(buf + O_BKT + r * 80 + (16 + 8 * h) * 2);
                    const bf16x8 a10 = *(LAS const bf16x8*)(buf + O_BKT + (32 + r) * 80 + (8 * h) * 2), a11 = *(LAS const bf16x8*)(buf + O_BKT + (32 + r) * 80 + (16 + 8 * h) * 2);
                    ST0 = MFMA32(a00, un, ST0); ST0 = MFMA32(a01, vn, ST0);
                    ST1 = MFMA32(a10, un, ST1); ST1 = MFMA32(a11, vn, ST1);
                    LAS const float* pc = (LAS const float*)(buf + O_PC);
#pragma unroll
                    for (int g4 = 0; g4 < 4; ++g4) {
                        const f32x4 p0 = *(LAS const f32x4*)(pc + 8 * g4 + 4 * h), p1 = *(LAS const f32x4*)(pc + 32 + 8 * g4 + 4 * h);
                        ST0[4 * g4] *= p0.x; ST0[4 * g4 + 1] *= p0.y; ST0[4 * g4 + 2] *= p0.z; ST0[4 * g4 + 3] *= p0.w;
                        ST1[4 * g4] *= p1.x; ST1[4 * g4 + 1] *= p1.y; ST1[4 * g4 + 2] *= p1.z; ST1[4 * g4 + 3] *= p1.w;
                    }
                }
            }
            __syncthreads();
        }
    } else {
        const int p = w - 2, ch = hh * 64 + lane;
        const bf16_t* RW = (const bf16_t*)(a.ws + WS_RW);
        const bf16_t* DEC = (const bf16_t*)(a.ws + (d ? WS_DEC1 : WS_GV));
        const bf16_t* AA = (const bf16_t*)(a.ws + (d ? WS_AA1 : WS_AA0));
        const float* mu = a.in[16] + l * 3488;
        const float mur = mu[ch], muk = mu[1024 + ch], muv = mu[2048 + ch], kkg = a.in[22][l * 1024 + ch], kag = a.in[23][l * 1024 + ch];
        LAS unsigned char* buf = L + p * BUFB;
        LAS bf16_t* AR = (LAS bf16_t*)(buf + O_AR); LAS bf16_t* BK = (LAS bf16_t*)(buf + O_BK); LAS bf16_t* BKT = (LAS bf16_t*)(buf + O_BKT); LAS bf16_t* VTT = (LAS bf16_t*)(buf + O_VTT);
        LAS float* PC = (LAS float*)(buf + O_PC);
        constexpr int NSTEP = (NCH / RING) * 4;
        unsigned nxt[4][11], cur[4][11];
#define SC2_LOAD(k) do { const int C_ = p + RING * ((k) >> 2); SC2_CHUNK(C_, base_, Tn_, cc_, wy_); (void)wy_; _Pragma("unroll") for (int i4 = 0; i4 < 4; ++i4) { \
            const int tok = SC2_TOK(Tn_, cc_, 4 * ((k) & 3) + i4); const size_t row = (size_t)(base_ + tok); const bf16_t* q_ = RW + row * RWP + ch; \
            const int op_ = tok > 0 ? -RWP : 0, on_ = tok < Tn_ - 1 ? RWP : 0; \
            _Pragma("unroll") for (int X = 0; X < 3; ++X) { nxt[i4][3 * X] = (unsigned)q_[X * 1024 + op_]; nxt[i4][3 * X + 1] = (unsigned)q_[X * 1024]; nxt[i4][3 * X + 2] = (unsigned)q_[X * 1024 + on_]; } \
            nxt[i4][9] = (unsigned)DEC[row * 1024 + ch]; nxt[i4][10] = (unsigned)AA[row * 1024 + ch]; } } while (0)
        SC2_LOAD(0);
        float Lsum = 0.f, ePprev = 1.f;
        for (int n = 0; n < NCH + RING; ++n) {
            const int e = n - p - 1;
            if (e >= 0 && (e % RING) < 4 && e / RING < NCH / RING) {
                const int k = 4 * (e / RING) + (e % RING);
#pragma unroll
                for (int i4 = 0; i4 < 4; ++i4)
#pragma unroll
                    for (int x = 0; x < 11; ++x) cur[i4][x] = nxt[i4][x];
                if (k + 1 < NSTEP) SC2_LOAD(k + 1);
                const int C_ = p + RING * (k >> 2); SC2_CHUNK(C_, base_, Tn_, cc_, wy_); (void)wy_; (void)base_;
#pragma unroll
                for (int i4 = 0; i4 < 4; ++i4) {
                    const int t = 4 * (k & 3) + i4; const int tok = SC2_TOK(Tn_, cc_, t);
                    Lsum = (t == 0) ? 0.f : Lsum; ePprev = (t == 0) ? 1.f : ePprev;
                    const float mp_ = tok > 0 ? 0.5f : 0.f, mn_ = tok < Tn_ - 1 ? 0.5f : 0.f;
                    const float xr = bf2f(cur[i4][1]), xk = bf2f(cur[i4][4]), xv = bf2f(cur[i4][7]);
                    const float zr = xr + mur * ((mp_ * bf2f(cur[i4][0]) + mn_ * bf2f(cur[i4][2])) - xr);
                    const float zk = xk + muk * ((mp_ * bf2f(cur[i4][3]) + mn_ * bf2f(cur[i4][5])) - xk);
                    const float zv = xv + muv * ((mp_ * bf2f(cur[i4][6]) + mn_ * bf2f(cur[i4][8])) - xv);
                    const float kkv = zk * kkg; const float ssq = wave_sum(kkv * kkv); const float kkn = kkv * rsqrtf(fmaxf(ssq, 1e-24f));
                    const float ad = bf2f(cur[i4][10]); const float kd = zk * (1.f + (ad - 1.f) * kag);
                    Lsum += bf2f(cur[i4][9]);
                    const float eP = __expf(Lsum), eI = __expf(-Lsum);
                    AR[t * 72 + lane] = f2bf(-kkn * ePprev); AR[(16 + t) * 72 + lane] = f2bf(zr * eP);
                    const bf16_t bt = f2bf(kkn * ad * eI), kt = f2bf(kd * eI);
                    BK[t * 72 + lane] = bt; BK[(16 + t) * 72 + lane] = kt;
                    BKT[lane * 40 + t] = bt; BKT[lane * 40 + 16 + t] = kt;
                    VTT[lane * 24 + t] = f2bf(zv);
                    PC[lane] = eP;
                    ePprev = eP;
                }
            } else if (e >= 0 && (e % RING) == 4 && e / RING < NCH / RING) {
                const int r = lane & 31, h = lane >> 5, thr = (r & 15) + (r >> 4);
                f32x16 X;
#pragma unroll
                for (int i = 0; i < 16; ++i) X[i] = 0.f;
#pragma unroll
                for (int ks = 0; ks < 4; ++ks) {
                    const bf16x8 af = *(LAS const bf16x8*)(buf + O_BK + r * 144 + (16 * ks + 8 * h) * 2);
                    const bf16x8 bfr = *(LAS const bf16x8*)(buf + O_AR + r * 144 + (16 * ks + 8 * h) * 2);
                    X = MFMA32(af, bfr, X);
                }
#pragma unroll
                for (int rg = 0; rg < 16; ++rg) { const int s = (rg & 3) + 8 * ((rg >> 2) & 1) + 4 * h; X[rg] = (s < thr) ? X[rg] : 0.f; }
                if (r < 16) {
                    LAS float* NS = (LAS float*)(buf + O_NS);
#pragma unroll
                    for (int rg = 0; rg < 8; ++rg) NS[((rg & 3) + 8 * (rg >> 2) + 4 * h) * 16 + r] = X[rg];
                }
                *(LAS bf16x8*)(buf + O_XF + lane * 16) = pk8f(X[0], X[1], X[2], X[3], X[4], X[5], X[6], X[7]);
                *(LAS bf16x8*)(buf + O_XF + 1024 + lane * 16) = pk8f(X[8], X[9], X[10], X[11], X[12], X[13], X[14], X[15]);
            }
            __syncthreads();
        }
#undef SC2_LOAD
    }
    __syncthreads();
#undef SC2_CHUNK
#undef SC2_TOK
}

__device__ __forceinline__ void attn_unit(const TI ti, CArgs& a, int b, int hd, int qrow0, int st_lo, int st_hi, float mfix, float lam, float lam_init, const float* subg, unsigned char* ldsg) {
    const int tid = ti.tid, lane = tid & 63, w = tid >> 6, r = lane & 31, h = lane >> 5, qt = w >> 1, c = w & 1;
    bf16_t* Qb = (bf16_t*)(a.ws + WS_Q); const bf16_t* Kb = (const bf16_t*)(a.ws + WS_K); const bf16_t* Vb = (const bf16_t*)(a.ws + WS_V);
    LAS unsigned char* L = (LAS unsigned char*)ldsg;
    constexpr int KOFF = 0, VOFF = 17408, BUFB = 35840;
    bf16x8 qf[4];
    { const bf16_t* qp = Qb + (size_t)(qrow0 + qt * 32 + r) * 1024 + hd * 128 + c * 64 + 8 * h;
#pragma unroll
      for (int ks = 0; ks < 4; ++ks) qf[ks] = *(const bf16x8*)(qp + 16 * ks); }
    f32x16 O[4];
#pragma unroll
    for (int e = 0; e < 4; ++e)
#pragma unroll
        for (int i = 0; i < 16; ++i) O[e][i] = 0.f;
    float lsum = 0.f;
    u32x4 kreg[2], vreg[2];
#define ATT_KROW(kk) ((kk) < 2048 ? (size_t)(b * 2048 + (kk)) : (size_t)(ML + b * 256 + (kk) - 2048))
#define ATT_LOAD(st) do { _Pragma("unroll") for (int i = 0; i < 2; ++i) { const int p = tid + 512 * i, key = p >> 4, dc = p & 15; kreg[i] = *(const u32x4*)(Kb + ATT_KROW((st) * 64 + key) * 1024 + hd * 128 + dc * 8); } \
        const bf16_t* vp = Vb + ATT_KROW((st) * 64 + lane) * 1024 + hd * 128 + w * 16; vreg[0] = *(const u32x4*)vp; vreg[1] = *(const u32x4*)(vp + 8); } while (0)
#define ATT_STORE(bufi) do { LAS unsigned char* Bb = L + (bufi) * BUFB; _Pragma("unroll") for (int i = 0; i < 2; ++i) { const int p = tid + 512 * i, key = p >> 4, dc = p & 15; *(LAS u32x4*)(Bb + KOFF + key * 272 + dc * 16) = kreg[i]; } \
        LAS bf16_t* vt = (LAS bf16_t*)(Bb + VOFF) + (w * 16) * 72 + ((lane & 48) + 8 * ((lane >> 2) & 1) + 4 * ((lane >> 3) & 1) + (lane & 3));   \
        _Pragma("unroll") for (int e = 0; e < 4; ++e) { vt[(2 * e) * 72] = (bf16_t)(vreg[0][e] & 0xffffu); vt[(2 * e + 1) * 72] = (bf16_t)(vreg[0][e] >> 16); \
            vt[(8 + 2 * e) * 72] = (bf16_t)(vreg[1][e] & 0xffffu); vt[(8 + 2 * e + 1) * 72] = (bf16_t)(vreg[1][e] >> 16); } } while (0)
    ATT_LOAD(st_lo); ATT_STORE(0);
    __syncthreads();
    for (int st = st_lo; st < st_hi; ++st) {
        const int bi = (st - st_lo) & 1;
        if (st + 1 < st_hi) ATT_LOAD(st + 1);
        LAS const unsigned char* Bb = L + bi * BUFB;
#pragma unroll
        for (int sub = 0; sub < 2; ++sub) {
            f32x16 Sx;
#pragma unroll
            for (int i = 0; i < 16; ++i) Sx[i] = -mfix;
#pragma unroll
            for (int ks = 0; ks < 4; ++ks) {
                const bf16x8 kf = *(LAS const bf16x8*)(Bb + KOFF + (sub * 32 + r) * 272 + (c * 64 + 16 * ks + 8 * h) * 2);
                Sx = MFMA32(kf, qf[ks], Sx);
            }
            float p[16];
#pragma unroll
            for (int i = 0; i < 16; ++i) { p[i] = __builtin_amdgcn_exp2f(Sx[i]); lsum += p[i]; }
            u32x4 pw0, pw1;
            pw0.x = pkbf(p[0], p[1]); pw0.y = pkbf(p[2], p[3]); pw0.z = pkbf(p[4], p[5]); pw0.w = pkbf(p[6], p[7]);
            pw1.x = pkbf(p[8], p[9]); pw1.y = pkbf(p[10], p[11]); pw1.z = pkbf(p[12], p[13]); pw1.w = pkbf(p[14], p[15]);
            const bf16x8 pb0 = __builtin_bit_cast(bf16x8, pw0), pb1 = __builtin_bit_cast(bf16x8, pw1);
#pragma unroll
            for (int et = 0; et < 4; ++et) {
#pragma unroll
                for (int s = 0; s < 2; ++s) {
                    const bf16x8 vf = *(LAS const bf16x8*)(Bb + VOFF + (et * 32 + r) * 144 + (sub * 32 + 16 * s + 8 * h) * 2);
                    O[et] = MFMA32(vf, s ? pb1 : pb0, O[et]);
                }
            }
        }
        if (st + 1 < st_hi) ATT_STORE(bi ^ 1);
        __syncthreads();
    }
#undef ATT_KROW
#undef ATT_LOAD
#undef ATT_STORE
    const float ltot = lsum + __shfl_xor(lsum, 32);
    const float linv = 1.f / ltot;
    LAS float* X = (LAS float*)L + qt * 4096;
    if (c == 1) {
#pragma unroll
        for (int e = 0; e < 4; ++e)
#pragma unroll
            for (int i = 0; i < 16; ++i) X[(e * 16 + i) * 64 + lane] = O[e][i] * linv;
    }
    __syncthreads();
    if (c == 0) {
        float ssq = 0.f;
#pragma unroll
        for (int e = 0; e < 4; ++e)
#pragma unroll
            for (int i = 0; i < 16; ++i) { const float o = O[e][i] * linv - lam * X[(e * 16 + i) * 64 + lane]; O[e][i] = o; ssq += o * o; }
        ssq += __shfl_xor(ssq, 32);
        const float sc = rsqrtf(ssq * (1.f / 128.f) + 1e-6f) * (1.f - lam_init);
        bf16_t* op = Qb + (size_t)(qrow0 + qt * 32 + r) * 1024 + hd * 128;
#pragma unroll
        for (int e = 0; e < 4; ++e)
#pragma unroll
            for (int g4 = 0; g4 < 4; ++g4) {
                const int e0 = e * 32 + 8 * g4 + 4 * h; const f32x4 sg = *(const f32x4*)(subg + e0);
                u32x2 o; o.x = pkbf(O[e][4 * g4 + 0] * sc * sg.x, O[e][4 * g4 + 1] * sc * sg.y); o.y = pkbf(O[e][4 * g4 + 2] * sc * sg.z, O[e][4 * g4 + 3] * sc * sg.w);
                *(u32x2*)(op + e0) = o;
            }
    }
    __syncthreads();
}
__device__ __forceinline__ void ph_attn(const TI ti, CArgs& a, int l, bool ctx_out, unsigned char* ldsg) {
    const int lane = ti.tid & 63;
    const float gqm = fabsf(a.in[12][l * 64 + lane]), gkm = fabsf(a.in[13][l * 64 + lane]);
    float mq = gqm, mk = gkm;
#pragma unroll
    for (int o = 1; o < 64; o <<= 1) { mq = fmaxf(mq, __shfl_xor(mq, o)); mk = fmaxf(mk, __shfl_xor(mk, o)); }
    const float mfix = 8.f * mq * mk * 1.4426950408889634f * 1.03f;
    const float* lp = a.in[14] + l * 256;
    const float s1 = wave_sum(lp[lane] * lp[64 + lane]), s2 = wave_sum(lp[128 + lane] * lp[192 + lane]);
    const float lam_init = 0.8f - 0.6f * expf(-0.3f * (float)l);
    const float lam = expf(s1) - expf(s2) + lam_init;
    const float* subg = a.in[15] + l * 128;
    const int nun = 1024 + (ctx_out ? 128 : 0);
    for (int u = ti.bid; u < nun; u += ti.nblk) {
        if (u < 1024) { const int bh = u >> 4, qb = u & 15; attn_unit(ti, a, bh >> 3, bh & 7, (bh >> 3) * 2048 + qb * 128, 0, 36, mfix, lam, lam_init, subg, ldsg); }
        else { const int v = u - 1024, bh = v >> 1, qb = v & 1; attn_unit(ti, a, bh >> 3, bh & 7, ML + (bh >> 3) * 256 + qb * 128, 32, 36, mfix, lam, lam_init, subg, ldsg); }
    }
}

__device__ __forceinline__ void up8(const bf16_t* p, float (&x)[8]) { const u32x4 v = *(const u32x4*)p;
#pragma unroll
    for (int i = 0; i < 4; ++i) { x[2 * i] = bf2f(v[i] & 0xffffu); x[2 * i + 1] = bf2f(v[i] >> 16); } }
__device__ __forceinline__ void ld8f(const float* p, float (&x)[8]) { const f32x4 u = *(const f32x4*)p, v = *(const f32x4*)(p + 4); x[0] = u.x; x[1] = u.y; x[2] = u.z; x[3] = u.w; x[4] = v.x; x[5] = v.y; x[6] = v.z; x[7] = v.w; }
__device__ __forceinline__ void shift8(const bf16_t* p, const float* mu, bool hp, bool hn, float (&z)[8]) {
    float x[8], xp[8], xn[8], m[8];
#pragma unroll
    for (int j = 0; j < 8; ++j) { xp[j] = 0.f; xn[j] = 0.f; }
    up8(p, x); if (hp) up8(p - RWP, xp); if (hn) up8(p + RWP, xn); ld8f(mu, m);
#pragma unroll
    for (int j = 0; j < 8; ++j) z[j] = x[j] + m[j] * (0.5f * (xp[j] + xn[j]) - x[j]);
}
__device__ __forceinline__ void rwkv_out_rows(CArgs& a, int l, int nrows, int gw, int ngw, int lane) {
    const bf16_t* RW = (const bf16_t*)(a.ws + WS_RW); const bf16_t* Y0 = (const bf16_t*)(a.ws + WS_H); bf16_t* Y1 = (bf16_t*)(a.ws + WS_Y1);
    const bf16_t* A0 = (const bf16_t*)(a.ws + WS_AA0); const bf16_t* A1 = (const bf16_t*)(a.ws + WS_AA1); const bf16_t* G = (const bf16_t*)(a.ws + WS_G);
    const float* mu = a.in[16] + l * 3488;
    for (int it = gw; it < 2 * nrows; it += ngw) {
        const int row = it >> 1, c0 = (it & 1) * 512 + 8 * lane;
        int t, Tn; if (row < ML) { t = row & 2047; Tn = 2048; } else { t = (row - ML) & 255; Tn = 256; }
        const bool hp = t > 0, hn = t < Tn - 1;
        const size_t idx = (size_t)row * 1024 + c0;
        float y[8], y1[8], g[8], a0[8], a1[8], zr[8], zk[8], zv[8], lnw[8], lnb[8], ka[8], rk[8];
        up8(Y0 + idx, y); up8(Y1 + idx, y1); up8(G + idx, g); up8(A0 + idx, a0); up8(A1 + idx, a1);
        const bf16_t* p = RW + (size_t)row * RWP + c0;
        shift8(p, mu + c0, hp, hn, zr); shift8(p + 1024, mu + 1024 + c0, hp, hn, zk); shift8(p + 2048, mu + 2048 + c0, hp, hn, zv);
        ld8f(a.in[25] + l * 1024 + c0, lnw); ld8f(a.in[26] + l * 1024 + c0, lnb); ld8f(a.in[23] + l * 1024 + c0, ka); ld8f(a.in[24] + l * 1024 + c0, rk);
        float sm = 0.f;
#pragma unroll
        for (int j = 0; j < 8; ++j) { y[j] += y1[j]; sm += y[j]; }
        const float mean = dpp_sum8(sm) * (1.f / 64.f);
        float sv = 0.f, sb = 0.f;
#pragma unroll
        for (int j = 0; j < 8; ++j) { y[j] -= mean; sv += y[j] * y[j]; const float kds = zk[j] * ((1.f + (a0[j] - 1.f) * ka[j]) + (1.f + (a1[j] - 1.f) * ka[j])); sb += zr[j] * kds * rk[j]; }
        const float rstd = rsqrtf(dpp_sum8(sv) * (1.f / 64.f) + 64e-5f), bsum = dpp_sum8(sb);
        u32x4 o;
#pragma unroll
        for (int j = 0; j < 4; ++j) o[j] = pkbf(((y[2 * j] * rstd * lnw[2 * j] + lnb[2 * j]) + bsum * zv[2 * j]) * g[2 * j], ((y[2 * j + 1] * rstd * lnw[2 * j + 1] + lnb[2 * j + 1]) + bsum * zv[2 * j + 1]) * g[2 * j + 1]);
        *(u32x4*)(Y1 + idx) = o;
    }
}

#define XB_TMO      128
#define XB_XCNT(j)  (256  + 64 * (j))
#define XB_XSUB(j)  (1280 + 64 * (j))
#define XB_XGEN(j)  (2304 + 64 * (j))
#define XB_TOP      3328
#define XB_TOPGEN   3392
#define XCD_BAR_WORDS 3456
#define XB_SPIN_CAP (1u << 20)

__device__ __forceinline__ unsigned xb_ld(unsigned* p)              { return __hip_atomic_load(p, __ATOMIC_RELAXED, __HIP_MEMORY_SCOPE_AGENT); }
__device__ __forceinline__ unsigned xb_add(unsigned* p, unsigned v) { return __hip_atomic_fetch_add(p, v, __ATOMIC_RELAXED, __HIP_MEMORY_SCOPE_AGENT); }
__device__ __forceinline__ unsigned xb_xcc_id() { return (unsigned)__builtin_amdgcn_s_getreg((3 << 11) | 20) & 0xFu; }
#define XB_SPIN(cond, bar) do { unsigned _sp = 0; while (cond) { __builtin_amdgcn_s_sleep(1); \
    if ((++_sp & 255u) == 0u) { if (xb_ld(&(bar)[XB_TMO])) break; if (_sp > XB_SPIN_CAP) { atomicAdd(&(bar)[XB_TMO], 1u); break; } } } } while (0)

struct XcdBarrier {
    unsigned* bar; unsigned x;
    volatile LAS unsigned* st;
};

__device__ __forceinline__ XcdBarrier xcd_barrier_post(unsigned* bar, volatile LAS unsigned* st) {
    XcdBarrier b; b.bar = bar; b.x = xb_xcc_id(); b.st = st;
    if (threadIdx.x == 0) (void)xb_add(&bar[XB_XCNT(b.x)], 1u);
    return b;
}
__device__ __forceinline__ void xcd_barrier_complete(unsigned* bar, unsigned x, unsigned& nloc, unsigned& nx) {
    const unsigned G = gridDim.x * gridDim.y * gridDim.z;
    unsigned sum, cnt, mine, sp = 0u;
    for (;;) {
        sum = 0u; cnt = 0u; mine = 0u;
#pragma unroll
        for (unsigned j = 0; j < 16; ++j) { const unsigned c = xb_ld(&bar[XB_XCNT(j)]); sum += c; cnt += (c > 0u) ? 1u : 0u; mine = (j == x) ? c : mine; }
        if (sum == G) break;
        __builtin_amdgcn_s_sleep(1);
        if ((++sp & 255u) == 0u) { if (xb_ld(&bar[XB_TMO])) break; if (sp > XB_SPIN_CAP) { atomicAdd(&bar[XB_TMO], 1u); break; } }
    }
    nloc = mine > 0u ? mine : 1u; nx = cnt > 0u ? cnt : 1u;
}

__device__ __forceinline__ void xcd_barrier(const XcdBarrier& b) {
    asm volatile("s_waitcnt vmcnt(0)" ::: "memory");
    __syncthreads();
    if (threadIdx.x == 0) {
        unsigned* bar = b.bar;
        __builtin_amdgcn_s_waitcnt(0);
        unsigned nloc = b.st[0], nx = b.st[1];
        if (nloc == 0u) { xcd_barrier_complete(bar, b.x, nloc, nx); b.st[0] = nloc; b.st[1] = nx; }
        const unsigned old = xb_add(&bar[XB_XSUB(b.x)], 1u);
        const unsigned gen = old / nloc;
        if (old + 1u == (gen + 1u) * nloc) {
            __builtin_amdgcn_fence(__ATOMIC_RELEASE, "agent");
            asm volatile("s_waitcnt vmcnt(0)" ::: "memory");
            const unsigned og = xb_add(&bar[XB_TOP], 1u);
            const unsigned tg = og / nx;
            if (og + 1u == (tg + 1u) * nx) xb_add(&bar[XB_TOPGEN], 1u);
            else XB_SPIN(xb_ld(&bar[XB_TOPGEN]) == tg, bar);
            __builtin_amdgcn_fence(__ATOMIC_ACQUIRE, "agent");
            xb_add(&bar[XB_XGEN(b.x)], 1u);
            asm volatile("s_waitcnt vmcnt(0)" ::: "memory");
        } else {
            XB_SPIN(xb_ld(&bar[XB_XGEN(b.x)]) == gen, bar);
            __builtin_amdgcn_fence(__ATOMIC_ACQUIRE, "agent");
            asm volatile("s_waitcnt vmcnt(0)" ::: "memory");
        }
    }
    __syncthreads();
}

#ifndef ONLY_PH
#define ONLY_PH -1
#endif
#ifndef SKIP_PH
#define SKIP_PH -2
#endif
#define PH_ON(k) ((ONLY_PH < 0 || ONLY_PH == (k)) && (k) != SKIP_PH)
__global__ void __launch_bounds__(512, 2) mega_fwd(Args a_) {
    extern __shared__ __attribute__((aligned(16))) unsigned char lds[];
    cg::grid_group grid = cg::this_grid();
    const int ph_lo = a_.lo, ph_hi = a_.hi;
    volatile LAS unsigned* bst = (volatile LAS unsigned*)((LAS unsigned char*)lds + 131072);
    if (threadIdx.x < 2) bst[threadIdx.x] = 0u;
    __syncthreads();
    const XcdBarrier xbar = xcd_barrier_post((unsigned*)(a_.ws + WS_BAR), bst);
    const int wave_s = __builtin_amdgcn_readfirstlane((int)threadIdx.x >> 6);
#pragma nounroll
    for (int ph = ph_lo; ph < ph_hi; ++ph) {
        CArgs* ap = (CArgs*)__builtin_amdgcn_kernarg_segment_ptr(); asm volatile("" : "+s"(ap));
        CArgs& a = *ap;
        unsigned char* ws = a.ws;
        float* XC = (float*)(ws + WS_XC);
        int wsv = wave_s; asm volatile("" : "+s"(wsv));
        TI ti; ti.tid = wsv * 64 + (int)__builtin_amdgcn_mbcnt_hi(~0u, __builtin_amdgcn_mbcnt_lo(~0u, 0u)); ti.bid = blockIdx.x; ti.nblk = gridDim.x;
        asm volatile("" : "+v"(ti.tid)); asm volatile("" : "+s"(ti.bid)); asm volatile("" : "+s"(ti.nblk));
        const int tid = ti.tid, lane = tid & 63, wv = __builtin_amdgcn_readfirstlane(tid >> 6);
        const int gw = ti.bid * 8 + wv, ngw = ti.nblk * 8;
        if (ph == 0) { if constexpr (PH_ON(100)) ph_mods(ti, a, lds); }
        else {
            const int l = (ph - 1) / NPH, k = (ph - 1) % NPH;
            const bool ctx_out = l < DEPTH - 1;
            const int Mr = ctx_out ? M : ML;
            const float* modl = (const float*)(ws + WS_MOD) + (size_t)l * 9 * 6144;
            const float* xl_in = l == 0 ? a.in[0] : a.out; const float* xc_in = l == 0 ? a.in[2] : XC;
            bf16_t* H = (bf16_t*)(ws + WS_H);
            switch (k) {
            case 0: if constexpr (PH_ON(0)) {
                norm_rows(xl_in, xc_in, a.in[6] + l * 1024, modl, 0, 1, H, M, gw, ngw, lane);
                ph_wconv(a, l, lds, gw, ngw, lane, wv);
                } break;
            case 1: if constexpr (PH_ON(1)) {
                OpIn op{(bf16_t*)(ws + WS_GU), (bf16_t*)(ws + WS_GV), (bf16_t*)(ws + WS_Q), (bf16_t*)(ws + WS_RW), (bf16_t*)(ws + WS_GT)};
                run_gemm(ti, lds, H, (const bf16_t*)(ws + WS_WIN), M, PPAD, 1024, op);
            } break;
            case 2: if constexpr (PH_ON(2)) {
                for (int u = ti.bid; u < Mr / 128; u += ti.nblk) gmlp_unit(ti, a, l, u, lds);
                qk_rows(a, l, gw, ngw, lane);
                lora_in_rows(a, l, gw, ngw, lane);
                } break;
            case 3: if constexpr (PH_ON(3)) {
                OpDec o1{(bf16_t*)(ws + WS_GV), (bf16_t*)(ws + WS_DEC1), a.in[17] + l * 2048};
                run_gemm(ti, lds, (const bf16_t*)(ws + WS_LIW), (const bf16_t*)(ws + WS_LWT), M, 2048, 128, o1);
                OpAA o2{(bf16_t*)(ws + WS_AA0), (bf16_t*)(ws + WS_AA1), a.in[19] + l * 2048};
                run_gemm(ti, lds, (const bf16_t*)(ws + WS_LIA), (const bf16_t*)(ws + WS_LAT), M, 2048, 128, o2);
                OpG o3{(bf16_t*)(ws + WS_G)};
                run_gemm(ti, lds, (const bf16_t*)(ws + WS_LIG), (const bf16_t*)(ws + WS_LGT), M, 1024, 256, o3);
            } break;
            case 4:
                if constexpr (PH_ON(4)) { for (int u = ti.bid; u < 256; u += ti.nblk) scan_unit_mfma(ti, a, l, u, ctx_out, lds); }
                if constexpr (PH_ON(40)) ph_attn(ti, a, l, ctx_out, lds);
                break;
            case 5: if constexpr (PH_ON(5)) {
                rwkv_out_rows(a, l, Mr, gw, ngw, lane);
                } break;
            case 6: if constexpr (PH_ON(6)) {
                const bf16_t* GT = (const bf16_t*)(ws + WS_GT); float* MF = (float*)(ws + WS_K);
                OpMerge<0> o0{GT, MF, H}; run_gemm(ti, lds, (const bf16_t*)(ws + WS_GU), (const bf16_t*)(ws + WS_WA), Mr, 1024, 1024, o0);
                OpMerge<1> o1{GT, MF, H}; run_gemm(ti, lds, (const bf16_t*)(ws + WS_Q), (const bf16_t*)(ws + WS_WB), Mr, 1024, 1024, o1);
                OpMerge<2> o2{GT, MF, H}; run_gemm(ti, lds, (const bf16_t*)(ws + WS_Y1), (const bf16_t*)(ws + WS_WC), Mr, 1024, 1024, o2);
            } break;
            case 7: if constexpr (PH_ON(7)) {
                OpResid op{xl_in, xc_in, a.out, XC, modl, 2};
                run_gemm(ti, lds, H, (const bf16_t*)(ws + WS_WO), Mr, 1024, 1024, op);
            } break;
            case 8: if constexpr (PH_ON(8)) {
                norm_rows(a.out, XC, a.in[7] + l * 1024, modl, 3, 4, H, Mr, gw, ngw, lane);
                } break;
            case 9: if constexpr (PH_ON(9)) {
                OpSwiglu op{(bf16_t*)(ws + WS_RW)};
                run_gemm(ti, lds, H, (const bf16_t*)(ws + WS_WI), Mr, 2 * DFF, 1024, op);
            } break;
            default: if constexpr (PH_ON(10)) {
                OpResid op{a.out, XC, a.out, XC, modl, 5};
                run_gemm(ti, lds, (const bf16_t*)(ws + WS_RW), (const bf16_t*)(ws + WS_WO2), Mr, 1024, DFF, op);
            } break;
            }
        }
        if (ph + 1 < ph_hi) { if (ph == ph_lo) grid.sync(); else xcd_barrier(xbar); }
    }
}

extern "C" void kernel_launch(void* const* d_in, const int* in_sizes, int n_in, void* d_out, int out_size, void* d_ws, size_t ws_size, hipStream_t stream) {
    static int grid = 0;
    if (grid == 0) {
        if (n_in != 33 || out_size != ML * D || ws_size < WS_END) { fprintf(stderr, "kernel_launch: unexpected shapes / workspace (%d inputs, out %d, ws %zu, need %zu)\n", n_in, out_size, ws_size, (size_t)WS_END); grid = -1; return; }
        int dev = 0, cus = 0, per_cu = 0;
        hipGetDevice(&dev); hipDeviceGetAttribute(&cus, hipDeviceAttributeMultiprocessorCount, dev);
        if (hipFuncSetAttribute((const void*)mega_fwd, hipFuncAttributeMaxDynamicSharedMemorySize, LDS_BYTES) != hipSuccess) { fprintf(stderr, "kernel_launch: hipFuncSetAttribute failed\n"); grid = -1; return; }
        if (hipOccupancyMaxActiveBlocksPerMultiprocessor(&per_cu, (const void*)mega_fwd, 512, LDS_BYTES) != hipSuccess || per_cu < 1) per_cu = 1;
        (void)hipGetLastError();
        grid = cus * 1;
    }
    if (grid < 0) return;
    Args a{};
    for (int i = 0; i < 33; ++i) a.in[i] = (const float*)d_in[i];
    a.out = (float*)d_out; a.ws = (unsigned char*)d_ws; a.lo = 0; a.hi = NPHASES;
    void* args[] = {&a};
    if (hipMemsetAsync((char*)d_ws + WS_BAR, 0, BAR_BYTES, stream) != hipSuccess) { fprintf(stderr, "kernel_launch: memset of barrier words failed\n"); return; }
    hipError_t e = hipLaunchCooperativeKernel((const void*)mega_fwd, dim3(grid), dim3(512), args, LDS_BYTES, stream);
    if (e != hipSuccess) fprintf(stderr, "kernel_launch: cooperative launch failed: %s (grid %d)\n", hipGetErrorString(e), grid);
}
```

```cpp
#include <hip/hip_runtime.h>
#include <hip/hip_cooperative_groups.h>
#include <cstdio>
#include <cstdint>
namespace cg = cooperative_groups;
namespace pg8 {
#define PG8_LAS __attribute__((address_space(3)))
typedef unsigned short bf16_t;
typedef short bf16x8 __attribute__((ext_vector_type(8)));
typedef float f32x4 __attribute__((ext_vector_type(4)));
typedef unsigned u32x4 __attribute__((ext_vector_type(4)));
constexpr int BM = 256, BK = 64, HALF = 128, HTB = HALF * BK * 2  , STAGE_BYTES = 8 * HTB, NXCD = 8, WGM = 8;

__host__ __device__ __forceinline__ int lds_byte(int r, int c) { const int st = (r >> 4) * 2 + (c >> 5), rr = r & 15, cc = c & 31, ob = rr * 64 + cc * 2; return st * 1024 + (ob ^ (((ob >> 9) & 1) << 5)); }
__host__ __device__ __forceinline__ void stage_rc(int b, int& R, int& C) { const int st = b / 1024, sb = b % 1024, swz = sb ^ (((sb >> 9) & 1) << 5); R = (st >> 1) * 16 + swz / 64; C = (st & 1) * 32 + (swz % 64) / 2; }
__host__ __device__ __forceinline__ int perm32(int rho) { const int n = rho >> 4, i = rho & 15; return 8 * (i >> 2) + 4 * n + (i & 3); }

struct Unit { int pm, pn; };
struct Gemm { const bf16_t* A; const bf16_t* Bt; int M, N, K; };

struct StaticOrder {
    int nM, nN, nwg, G, c;
    __host__ __device__ void init(int M, int N, int G_, int c_) { nM = M / BM; nN = N / BM; nwg = nM * nN; G = G_; c = c_; }
    __host__ __device__ bool next(int i, Unit& u) const {
        const long L = (long)i * G + c; if (L >= nwg) return false;
        int wgid = (int)L; { const int q = nwg / NXCD, r = nwg % NXCD, xcd = wgid % NXCD, off = wgid / NXCD; wgid = (xcd < r ? xcd * (q + 1) : r * (q + 1) + (xcd - r) * q) + off; }
        const int nig = WGM * nN, gid = wgid / nig, fm = gid * WGM, gsz = (nM - fm) < WGM ? (nM - fm) : WGM;
        u.pm = fm + ((wgid % nig) % gsz); u.pn = (wgid % nig) / gsz; return true;
    }
    __device__ __forceinline__ void a_ready(const Unit&) const {}
    __device__ __forceinline__ void done(const Unit&) const {}
};

__device__ __forceinline__ unsigned cvt_pk_bf16(float lo, float hi) { unsigned r; asm volatile("v_cvt_pk_bf16_f32 %0, %1, %2" : "=v"(r) : "v"(lo), "v"(hi)); return r; }
typedef float f32x2 __attribute__((ext_vector_type(2)));
__device__ __forceinline__ f32x2 gelu_pk(f32x2 v) {
    const f32x2 av = __builtin_elementwise_abs(v), d = av * 0.2316418882f + 1.0f;
    f32x2 t; t.x = __builtin_amdgcn_rcpf(d.x); t.y = __builtin_amdgcn_rcpf(d.y);
    f32x2 q = t * 0.5307027145f + (-0.7265760135f); q = q * t + 0.7107068705f; q = q * t + (-0.142248368f); q = q * t + 0.127414796f; q = q * t;
    const f32x2 s = (v * v) * (-0.72134752044f);
    f32x2 e; e.x = __builtin_amdgcn_exp2f(s.x); e.y = __builtin_amdgcn_exp2f(s.y);
    const f32x2 m = v * (q * e), r = v - m;
    f32x2 o; o.x = v.x < 0.f ? m.x : r.x; o.y = v.y < 0.f ? m.y : r.y; return o;
}

template <class Epi, class Sched, bool ALIGN_EPI = false, bool SP2 = false>
__device__ __forceinline__ void gemm_phase(PG8_LAS unsigned char* lds, const Gemm g, const Sched& S, const Epi& E, const int tid_in) {
    const int tid = tid_in, wid = __builtin_amdgcn_readfirstlane(tid >> 6), lane = tid & 63, wr = wid >> 2, wc = wid & 3, fr = lane & 15, fq = lane >> 4;
    const int K = g.K, nt = K / BK;
    unsigned voffA[2], voffB[2];
#pragma unroll
    for (int i = 0; i < 2; ++i) { int R, C; stage_rc(tid * 16 + i * 8192, R, C); const int Rb = Epi::PERM ? ((R & ~31) + perm32(R & 31)) : R;
        voffA[i] = (unsigned)(R * K + C) * 2u; voffB[i] = (unsigned)(Rb * K + C) * 2u; }
    const size_t kstep = (size_t)(BK * 2);
    const size_t hstep = (size_t)HALF * K * 2;
    const size_t tstep = 2 * hstep;
    const unsigned ldsw = (unsigned)wid * 1024u;
    const int aoff = lds_byte(wr * 64 + fr, fq * 8), boff = lds_byte(wc * 32 + fr, fq * 8);
#define PG8_SA(b, h) (((b) * 2 + (h)) * HTB)
#define PG8_SB(b, h) ((4 + (b) * 2 + (h)) * HTB)
#define PG8_STAGE(bufoff, gbase, voff) do { _Pragma("unroll") for (int _i = 0; _i < 2; ++_i) \
        __builtin_amdgcn_global_load_lds((const unsigned*)((const char*)(gbase) + (voff)[_i]), (PG8_LAS unsigned*)(lds + (bufoff) + ldsw + _i * 8192), 16, 0, 0); } while (0)
#define PG8_LDA(dst, b, h) do { _Pragma("unroll") for (int m = 0; m < 4; ++m) _Pragma("unroll") for (int k = 0; k < 2; ++k) dst[m][k] = *(const PG8_LAS bf16x8*)(lds + PG8_SA(b, h) + aoff + m * 2048 + k * 1024); } while (0)
#define PG8_LDB(dst, b, h) do { _Pragma("unroll") for (int n = 0; n < 2; ++n) _Pragma("unroll") for (int k = 0; k < 2; ++k) dst[n][k] = *(const PG8_LAS bf16x8*)(lds + PG8_SB(b, h) + boff + n * 2048 + k * 1024); } while (0)
#define PG8_MMA(ai, bj, At, Bt) do { __builtin_amdgcn_s_setprio(1); _Pragma("unroll") for (int m = 0; m < 4; ++m) _Pragma("unroll") for (int n = 0; n < 2; ++n) _Pragma("unroll") for (int k = 0; k < 2; ++k) \
        acc[ai][bj][m][n] = __builtin_amdgcn_mfma_f32_16x16x32_bf16(Bt[n][k], At[m][k], acc[ai][bj][m][n], 0, 0, 0); __builtin_amdgcn_s_setprio(0); } while (0)
#define PG8_WAIT_V(n) asm volatile("s_waitcnt vmcnt(" #n ")" ::: "memory")
#define PG8_WAIT_L(n) asm volatile("s_waitcnt lgkmcnt(" #n ")" ::: "memory")
#define PG8_BAR __builtin_amdgcn_s_barrier()
#define PG8_SCHED __builtin_amdgcn_sched_barrier(0)
    Unit cur, nxt; int ui = 0;
    if (!S.next(0, cur)) return;
    f32x4 acc[2][2][4][2];
#pragma unroll
    for (int a = 0; a < 2; ++a)
#pragma unroll
        for (int b = 0; b < 2; ++b)
#pragma unroll
            for (int m = 0; m < 4; ++m)
#pragma unroll
                for (int n = 0; n < 2; ++n) acc[a][b][m][n] = (f32x4){0.f, 0.f, 0.f, 0.f};
    bf16x8 At[4][2], B0[2][2], B1[2][2];
    const char* cA = (const char*)g.A + (size_t)cur.pm * tstep; const char* cB = (const char*)g.Bt + (size_t)cur.pn * tstep;
    S.a_ready(cur);
    if constexpr (SP2) {
        PG8_STAGE(PG8_SB(0, 0), cB, voffB); PG8_STAGE(PG8_SB(0, 1), cB + hstep, voffB); PG8_STAGE(PG8_SA(0, 0), cA, voffA); PG8_STAGE(PG8_SA(0, 1), cA + hstep, voffA);
        if (wr == 1) PG8_BAR;
        PG8_WAIT_V(2); PG8_BAR;
        PG8_STAGE(PG8_SB(1, 0), cB + kstep, voffB); PG8_STAGE(PG8_SA(1, 0), cA + kstep, voffA); PG8_STAGE(PG8_SB(1, 1), cB + hstep + kstep, voffB);
        PG8_WAIT_V(6); PG8_BAR;
    } else {
        PG8_STAGE(PG8_SB(0, 0), cB, voffB); PG8_STAGE(PG8_SA(0, 0), cA, voffA); PG8_STAGE(PG8_SB(0, 1), cB + hstep, voffB); PG8_STAGE(PG8_SA(0, 1), cA + hstep, voffA);
        if (wr == 1) PG8_BAR;
        PG8_WAIT_V(4); PG8_BAR;
        PG8_STAGE(PG8_SB(1, 0), cB + kstep, voffB); PG8_STAGE(PG8_SA(1, 0), cA + kstep, voffA); PG8_STAGE(PG8_SB(1, 1), cB + hstep + kstep, voffB);
        PG8_WAIT_V(6); PG8_BAR;
    }
    for (;;) {
        const bool has_next = S.next(ui + 1, nxt);
        const char* nA = has_next ? (const char*)g.A + (size_t)nxt.pm * tstep : cA; const char* nB = has_next ? (const char*)g.Bt + (size_t)nxt.pn * tstep : cB;
        for (int t = 0; t < nt; t += 2) {
            const bool last = (t == nt - 2);
            const char* a1 = cA + (size_t)(t + 1) * kstep;
            const char* a2 = last ? nA : cA + (size_t)(t + 2) * kstep; const char* b2 = last ? nB : cB + (size_t)(t + 2) * kstep;
            const char* a3 = a2 + kstep; const char* b3 = b2 + kstep;
            if (last && has_next) S.a_ready(nxt);
            if constexpr (SP2) {
            PG8_LDB(B0, 0, 0); PG8_LDB(B1, 0, 1); PG8_SCHED; PG8_LDA(At, 0, 0); PG8_STAGE(PG8_SA(1, 1), a1 + hstep, voffA);
            PG8_WAIT_V(8); PG8_WAIT_L(0); PG8_BAR; PG8_MMA(0, 0, At, B0); PG8_MMA(0, 1, At, B1); PG8_BAR; PG8_SCHED;
            PG8_LDA(At, 0, 1); PG8_STAGE(PG8_SB(0, 0), b2, voffB); PG8_STAGE(PG8_SB(0, 1), b2 + hstep, voffB); PG8_STAGE(PG8_SA(0, 0), a2, voffA);
            PG8_WAIT_V(8); PG8_WAIT_L(0); PG8_BAR; PG8_MMA(1, 0, At, B0); PG8_MMA(1, 1, At, B1); PG8_BAR; PG8_SCHED;
            PG8_LDB(B0, 1, 0); PG8_LDB(B1, 1, 1); PG8_SCHED; PG8_LDA(At, 1, 0); PG8_STAGE(PG8_SA(0, 1), a2 + hstep, voffA);
            PG8_WAIT_V(8); PG8_WAIT_L(0); PG8_BAR; PG8_MMA(0, 0, At, B0); PG8_MMA(0, 1, At, B1); PG8_BAR; PG8_SCHED;
            PG8_LDA(At, 1, 1); PG8_STAGE(PG8_SB(1, 0), b3, voffB); PG8_STAGE(PG8_SB(1, 1), b3 + hstep, voffB); PG8_STAGE(PG8_SA(1, 0), a3, voffA);
            PG8_WAIT_V(8); PG8_WAIT_L(0); PG8_BAR; PG8_MMA(1, 0, At, B0); PG8_MMA(1, 1, At, B1); PG8_BAR; PG8_SCHED;
            } else {
            PG8_LDB(B0, 0, 0); PG8_SCHED; PG8_LDA(At, 0, 0); PG8_STAGE(PG8_SA(1, 1), a1 + hstep, voffA);
            PG8_WAIT_L(8); PG8_BAR; PG8_WAIT_L(0); PG8_MMA(0, 0, At, B0); PG8_BAR; PG8_SCHED;
            PG8_LDB(B1, 0, 1); PG8_STAGE(PG8_SB(0, 0), b2, voffB);
            PG8_BAR; PG8_WAIT_L(0); PG8_MMA(0, 1, At, B1); PG8_BAR;
            PG8_LDA(At, 0, 1); PG8_STAGE(PG8_SA(0, 0), a2, voffA);
            PG8_BAR; PG8_WAIT_L(0); PG8_MMA(1, 0, At, B0); PG8_BAR; PG8_SCHED;
            PG8_STAGE(PG8_SB(0, 1), b2 + hstep, voffB);
            PG8_WAIT_V(6); PG8_BAR; PG8_MMA(1, 1, At, B1); PG8_BAR;
            PG8_LDB(B0, 1, 0); PG8_SCHED; PG8_LDA(At, 1, 0); PG8_STAGE(PG8_SA(0, 1), a2 + hstep, voffA);
            PG8_WAIT_L(8); PG8_BAR; PG8_WAIT_L(0); PG8_MMA(0, 0, At, B0); PG8_BAR; PG8_SCHED;
            PG8_LDB(B1, 1, 1); PG8_STAGE(PG8_SB(1, 0), b3, voffB);
            PG8_BAR; PG8_WAIT_L(0); PG8_MMA(0, 1, At, B1); PG8_BAR;
            PG8_LDA(At, 1, 1); PG8_STAGE(PG8_SA(1, 0), a3, voffA);
            PG8_BAR; PG8_WAIT_L(0); PG8_MMA(1, 0, At, B0); PG8_BAR; PG8_SCHED;
            PG8_STAGE(PG8_SB(1, 1), b3 + hstep, voffB);
            PG8_WAIT_V(6); PG8_BAR; PG8_MMA(1, 1, At, B1); PG8_BAR;
            }
        }
        if constexpr (ALIGN_EPI) { if (wr == 0) PG8_BAR; }
        if constexpr (!Epi::AFTER_DRAIN) { E(acc, cur, wr, wc, fr, fq); S.done(cur); }
        if (!has_next) break;
#pragma unroll
        for (int a = 0; a < 2; ++a)
#pragma unroll
            for (int b = 0; b < 2; ++b)
#pragma unroll
                for (int m = 0; m < 4; ++m)
#pragma unroll
                    for (int n = 0; n < 2; ++n) acc[a][b][m][n] = (f32x4){0.f, 0.f, 0.f, 0.f};
        cur = nxt; cA = nA; cB = nB; ++ui;
        if constexpr (ALIGN_EPI) { if (wr == 1) PG8_BAR; }
    }
    PG8_WAIT_V(0);
    if constexpr (!ALIGN_EPI) { if (wr == 0) PG8_BAR; }
    PG8_BAR;
    if constexpr (Epi::AFTER_DRAIN) { E.fused(acc, cur, wr, wc, fr, fq, lds, wid, lane); S.done(cur); }
#undef PG8_SA
#undef PG8_SB
#undef PG8_STAGE
#undef PG8_LDA
#undef PG8_LDB
#undef PG8_MMA
#undef PG8_WAIT_V
#undef PG8_WAIT_L
#undef PG8_BAR
#undef PG8_SCHED
}
}

#define LAS __attribute__((address_space(3)))
typedef unsigned short bf16_t;
typedef float f32x2 __attribute__((ext_vector_type(2)));
typedef float f32x4 __attribute__((ext_vector_type(4)));
typedef float f32x16 __attribute__((ext_vector_type(16)));
typedef short bf16x8 __attribute__((ext_vector_type(8)));
typedef short s16x4 __attribute__((ext_vector_type(4)));
typedef unsigned u32x4 __attribute__((ext_vector_type(4)));
typedef unsigned u32x2 __attribute__((ext_vector_type(2)));
typedef __bf16 bf16x2v __attribute__((ext_vector_type(2)));
#define MFMA32(a, b, c) __builtin_amdgcn_mfma_f32_32x32x16_bf16((a), (b), (c), 0, 0, 0)

constexpr int D = 1024, NB = 8, TL = 2048, TCX = 256, DEPTH = 4;
constexpr int ML = NB * TL, MC = NB * TCX, M = ML + MC;
constexpr int PPAD = 11776, RWP = 3584, DFF = 2816;
constexpr int NPH = 11, NPHASES = 1 + DEPTH * NPH;
constexpr size_t MiB = 1u << 20;
constexpr size_t WS_MOD = 0, WS_WIN = 1 * MiB, WS_WA = 24 * MiB, WS_WB = 26 * MiB, WS_WC = 28 * MiB, WS_WO = 30 * MiB, WS_WI = 32 * MiB, WS_WO2 = 43 * MiB,
                 WS_LWT = 48 * MiB + MiB / 2, WS_LAT = 49 * MiB, WS_LGT = 49 * MiB + MiB / 2, WS_H = 50 * MiB, WS_XC = 86 * MiB, WS_GU = 94 * MiB, WS_GV = 130 * MiB,
                 WS_Q = 166 * MiB, WS_K = 202 * MiB, WS_V = 238 * MiB, WS_RW = 274 * MiB, WS_GT = 400 * MiB, WS_LIW = 508 * MiB, WS_LIA = 512 * MiB + MiB / 2,
                 WS_LIG = 517 * MiB, WS_DEC1 = 526 * MiB, WS_AA0 = 562 * MiB, WS_AA1 = 598 * MiB, WS_G = 634 * MiB, WS_Y1 = 670 * MiB, WS_ROPE = 706 * MiB, WS_END = 707 * MiB;
constexpr int LDS_BYTES = 131072 + 1024;
constexpr size_t WS_BAR = 917504, BAR_BYTES = 16384;
constexpr float QSCALE = 0.125f * 1.4426950408889634f;

struct Args { const float* in[33]; float* out; unsigned char* ws; int lo, hi; };
typedef const __attribute__((address_space(4))) Args CArgs;
struct TI { int tid, bid, nblk; };

__device__ __forceinline__ float bf2f(unsigned v) { return __uint_as_float(v << 16); }
__device__ __forceinline__ unsigned pkbf(float lo, float hi) { f32x2 v = {lo, hi}; bf16x2v b = __builtin_convertvector(v, bf16x2v); return __builtin_bit_cast(unsigned, b); }
__device__ __forceinline__ bf16_t f2bf(float f) { return (bf16_t)(pkbf(f, 0.f) & 0xffffu); }
#define DPP_ADD(x, ctrl) ((x) + __builtin_bit_cast(float, __builtin_amdgcn_update_dpp(0, __builtin_bit_cast(int, (x)), (ctrl), 0xf, 0xf, true)))
__device__ __forceinline__ float wave_sum(float v) {
    v = DPP_ADD(v, 0xB1); v = DPP_ADD(v, 0x4E); v = DPP_ADD(v, 0x141); v = DPP_ADD(v, 0x140);
    const int iv = __builtin_bit_cast(int, v);
    const float s0 = __builtin_bit_cast(float, __builtin_amdgcn_readlane(iv, 0)), s1 = __builtin_bit_cast(float, __builtin_amdgcn_readlane(iv, 16)),
                s2 = __builtin_bit_cast(float, __builtin_amdgcn_readlane(iv, 32)), s3 = __builtin_bit_cast(float, __builtin_amdgcn_readlane(iv, 48));
    return (s0 + s1) + (s2 + s3);
}
__device__ __forceinline__ float dpp_sum8(float x) {
    x += __builtin_bit_cast(float, __builtin_amdgcn_update_dpp(0, __builtin_bit_cast(int, x), 0xB1, 0xf, 0xf, true));
    x += __builtin_bit_cast(float, __builtin_amdgcn_update_dpp(0, __builtin_bit_cast(int, x), 0x4E, 0xf, 0xf, true));
    x += __builtin_bit_cast(float, __builtin_amdgcn_update_dpp(0, __builtin_bit_cast(int, x), 0x141, 0xf, 0xf, true));
    return x;
}
__device__ __forceinline__ float quad_sum(float x) { x = DPP_ADD(x, 0xB1); x = DPP_ADD(x, 0x4E); return x; }
__device__ __forceinline__ float quad_xor2(float x) { return __builtin_bit_cast(float, __builtin_amdgcn_update_dpp(0, __builtin_bit_cast(int, x), 0x4E, 0xf, 0xf, true)); }
__device__ __forceinline__ void unpack16(const bf16_t* p, float (&x)[16]) {
    const u32x4 a = *(const u32x4*)p, b = *(const u32x4*)(p + 8);
#pragma unroll
    for (int i = 0; i < 4; ++i) { x[2 * i] = bf2f(a[i] & 0xffffu); x[2 * i + 1] = bf2f(a[i] >> 16); x[8 + 2 * i] = bf2f(b[i] & 0xffffu); x[8 + 2 * i + 1] = bf2f(b[i] >> 16); }
}
__device__ __forceinline__ void pack16(bf16_t* p, const float (&x)[16]) {
    u32x4 a, b;
#pragma unroll
    for (int i = 0; i < 4; ++i) { a[i] = pkbf(x[2 * i], x[2 * i + 1]); b[i] = pkbf(x[8 + 2 * i], x[8 + 2 * i + 1]); }
    *(u32x4*)p = a; *(u32x4*)(p + 8) = b;
}
__device__ __forceinline__ void load16f(const float* p, float (&x)[16]) {
#pragma unroll
    for (int i = 0; i < 4; ++i) { const f32x4 v = *(const f32x4*)(p + 4 * i); x[4 * i] = v.x; x[4 * i + 1] = v.y; x[4 * i + 2] = v.z; x[4 * i + 3] = v.w; }
}
__device__ __forceinline__ float sigmoidf_(float x) { return 1.f / (1.f + __expf(-x)); }

typedef const __attribute__((address_space(1))) bf16_t* gcptr_t;
__device__ __forceinline__ gcptr_t uniptr(const bf16_t* p) {
    const unsigned long long v = (unsigned long long)p;
    const unsigned lo = __builtin_amdgcn_readfirstlane((unsigned)v), hi = __builtin_amdgcn_readfirstlane((unsigned)(v >> 32));
    return (gcptr_t)(((unsigned long long)hi << 32) | lo);
}
template <class Op> struct EpiT {
    static constexpr bool PERM = true, AFTER_DRAIN = false;
    Op op;
    __device__ __forceinline__ void operator()(const pg8::f32x4 (&acc)[2][2][4][2], const pg8::Unit& u, int wr, int wc, int fr, int fq) const {
        const int row0 = u.pm * 256 + wr * 64 + fr, col0 = u.pn * 256 + wc * 32 + 8 * fq;
#pragma unroll
        for (int ai = 0; ai < 2; ++ai)
#pragma unroll
            for (int m = 0; m < 4; ++m)
#pragma unroll
                for (int bj = 0; bj < 2; ++bj) { op(row0 + ai * 128 + m * 16, col0 + bj * 128, acc[ai][bj][m][0], acc[ai][bj][m][1]); asm volatile("" ::: "memory"); }
    }
};
__device__ __forceinline__ u32x4 pack8(f32x4 v0, f32x4 v1) { u32x4 o; o.x = pkbf(v0.x, v0.y); o.y = pkbf(v0.z, v0.w); o.z = pkbf(v1.x, v1.y); o.w = pkbf(v1.z, v1.w); return o; }
__device__ __forceinline__ void unpack8(u32x4 x, f32x4& v0, f32x4& v1) {
    v0.x = bf2f(x.x & 0xffffu); v0.y = bf2f(x.x >> 16); v0.z = bf2f(x.y & 0xffffu); v0.w = bf2f(x.y >> 16);
    v1.x = bf2f(x.z & 0xffffu); v1.y = bf2f(x.z >> 16); v1.z = bf2f(x.w & 0xffffu); v1.w = bf2f(x.w >> 16);
}
__device__ __forceinline__ f32x4 gelu4(f32x4 v) { pg8::f32x2 a = pg8::gelu_pk((pg8::f32x2){v.x, v.y}), b = pg8::gelu_pk((pg8::f32x2){v.z, v.w}); return (f32x4){a.x, a.y, b.x, b.y}; }
__device__ __forceinline__ f32x4 sig4(f32x4 v) { return (f32x4){sigmoidf_(v.x), sigmoidf_(v.y), sigmoidf_(v.z), sigmoidf_(v.w)}; }

struct OpIn {
    bf16_t *GU, *GV, *Q, *RW, *GT;
    __device__ __forceinline__ void operator()(int row, int col, f32x4 v0, f32x4 v1) const {
        bf16_t* dst;
        if (col < 2048) { v0 = gelu4(v0); v1 = gelu4(v1); dst = (col < 1024 ? GU : GV) + (size_t)row * 1024 + (col & 1023); }
        else if (col < 5120) { const int q = col - 2048; dst = Q + (size_t)(q >> 10) * (size_t)(18 * MiB) + (size_t)row * 1024 + (q & 1023); }
        else if (col < 8704) { dst = RW + (size_t)row * RWP + (col - 5120); }
        else { v0 = sig4(v0); v1 = sig4(v1); dst = GT + (size_t)row * 3072 + (col - 8704); }
        *(u32x4*)dst = pack8(v0, v1);
    }
};
struct OpDec {
    bf16_t *D0, *D1; const float* w0;
    __device__ __forceinline__ float f(float x) const { return -0.6065306597126334f * sigmoidf_(x); }
    __device__ __forceinline__ void operator()(int row, int col, f32x4 v0, f32x4 v1) const {
        const f32x4 b0 = *(const f32x4*)(w0 + col), b1 = *(const f32x4*)(w0 + col + 4);
        v0 += b0; v1 += b1;
        v0 = (f32x4){f(v0.x), f(v0.y), f(v0.z), f(v0.w)}; v1 = (f32x4){f(v1.x), f(v1.y), f(v1.z), f(v1.w)};
        bf16_t* dst = (col < 1024 ? D0 : D1) + (size_t)row * 1024 + (col & 1023);
        *(u32x4*)dst = pack8(v0, v1);
    }
};
struct OpAA {
    bf16_t *A0, *A1; const float* a0;
    __device__ __forceinline__ void operator()(int row, int col, f32x4 v0, f32x4 v1) const {
        const f32x4 b0 = *(const f32x4*)(a0 + col), b1 = *(const f32x4*)(a0 + col + 4);
        v0 = sig4(v0 + b0); v1 = sig4(v1 + b1);
        bf16_t* dst = (col < 1024 ? A0 : A1) + (size_t)row * 1024 + (col & 1023);
        *(u32x4*)dst = pack8(v0, v1);
    }
};
struct OpG {
    bf16_t* G;
    __device__ __forceinline__ void operator()(int row, int col, f32x4 v0, f32x4 v1) const { *(u32x4*)(G + (size_t)row * 1024 + col) = pack8(v0, v1); }
};
template <int KB> struct OpMerge {
    const bf16_t* GT; float* MF; bf16_t* MB;
    __device__ __forceinline__ void operator()(int row, int col, f32x4 v0, f32x4 v1) const {
        f32x4 g0, g1; unpack8(*(const u32x4*)(GT + (size_t)row * 3072 + KB * 1024 + col), g0, g1);
        float* mf = MF + (size_t)row * 1024 + col;
        f32x4 r0 = g0 * v0, r1 = g1 * v1;
        if (KB > 0) { r0 += *(const f32x4*)mf; r1 += *(const f32x4*)(mf + 4); }
        if (KB < 2) { *(f32x4*)mf = r0; *(f32x4*)(mf + 4) = r1; }
        else *(u32x4*)(MB + (size_t)row * 1024 + col) = pack8(r0, r1);
    }
};
struct OpResid {
    const float *xl, *xc; float *ol, *oc; const float* mod; int gi;
    __device__ __forceinline__ void operator()(int row, int col, f32x4 v0, f32x4 v1) const {
        const float* xi; float* xo; const float* g;
        if (row < ML) { xi = xl + (size_t)row * 1024 + col; xo = ol + (size_t)row * 1024 + col; g = mod + (size_t)(row >> 11) * 6144 + gi * 1024 + col; }
        else { const size_t rr = (size_t)(row - ML) * 1024 + col; xi = xc + rr; xo = oc + rr; g = mod + (size_t)8 * 6144 + gi * 1024 + col; }
        const f32x4 x0 = *(const f32x4*)xi, x1 = *(const f32x4*)(xi + 4), g0 = *(const f32x4*)g, g1 = *(const f32x4*)(g + 4);
        *(f32x4*)xo = x0 + g0 * v0; *(f32x4*)(xo + 4) = x1 + g1 * v1;
    }
};
struct OpSwiglu {
    bf16_t* HID;
    __device__ __forceinline__ void operator()(int row, int col, f32x4 v0, f32x4 v1) const {
        const float h0 = v0.x * sigmoidf_(v0.x) * v0.y, h1 = v0.z * sigmoidf_(v0.z) * v0.w, h2 = v1.x * sigmoidf_(v1.x) * v1.y, h3 = v1.z * sigmoidf_(v1.z) * v1.w;
        u32x2 o; o.x = pkbf(h0, h1); o.y = pkbf(h2, h3);
        *(u32x2*)(HID + (size_t)row * DFF + (col >> 1)) = o;
    }
};
template <class Op> __device__ __forceinline__ void run_gemm(const TI ti, unsigned char* lds, const bf16_t* A, const bf16_t* Bt, int Mr, int N, int K, const Op& op) {
    int Kv = K; asm volatile("" : "+s"(Kv));
    pg8::Gemm g{A, Bt, Mr, N, Kv}; pg8::StaticOrder S; S.init(Mr, N, ti.nblk, ti.bid);
    EpiT<Op> E{op};
    pg8::gemm_phase<EpiT<Op>, pg8::StaticOrder, true, true>((PG8_LAS unsigned char*)lds, g, S, E, ti.tid);
}

__device__ __forceinline__ void ph_mods(const TI ti, CArgs& a, unsigned char* ldsg) {
    float* sc = (float*)ldsg; float* part = sc + 9 * 1024;
    const int tid = ti.tid, lane = tid & 63, w = tid >> 6;
    for (int i = tid; i < 9 * 1024; i += 512) { const float v = (i < 8192) ? a.in[1][i] : a.in[3][i - 8192]; sc[i] = v / (1.f + expf(-v)); }
    __syncthreads();
    float* MOD = (float*)(a.ws + WS_MOD);
    for (int item = ti.bid; item < DEPTH * 96; item += ti.nblk) {
        const int l = item / 96, n0 = (item % 96) * 64;
        const float* W = a.in[4] + (size_t)l * 1024 * 6144 + n0 + lane;
        float acc[9];
#pragma unroll
        for (int r = 0; r < 9; ++r) acc[r] = 0.f;
#pragma unroll 8
        for (int k = w * 128; k < w * 128 + 128; ++k) {
            const float wv = W[(size_t)k * 6144];
#pragma unroll
            for (int r = 0; r < 9; ++r) acc[r] += sc[r * 1024 + k] * wv;
        }
#pragma unroll
        for (int r = 0; r < 9; ++r) part[(w * 9 + r) * 64 + lane] = acc[r];
        __syncthreads();
        for (int idx = tid; idx < 576; idx += 512) {
            const int r = idx >> 6, ln = idx & 63; float s = a.in[5][l * 6144 + n0 + ln];
            for (int ww = 0; ww < 8; ++ww) s += part[(ww * 9 + r) * 64 + ln];
            MOD[((size_t)l * 9 + r) * 6144 + n0 + ln] = s;
        }
        __syncthreads();
    }
    float* RC = (float*)(a.ws + WS_ROPE); float* RS = RC + 2048 * 32;
    for (int idx = ti.bid * 512 + tid; idx < 2048 * 32; idx += ti.nblk * 512) {
        const int t = idx >> 5, i = idx & 31; const float pos = i < 16 ? (float)(t >> 6) : (float)(t & 63);
        const float ang = pos * exp2f(-(float)(i & 15) * (13.287712379549449f / 16.f));
        RC[idx] = cosf(ang); RS[idx] = sinf(ang);
    }
}

__device__ __forceinline__ void norm_rows(const float* xl, const float* xc, const float* g, const float* modl, int shi, int sci, bf16_t* H, int nrows, int gw, int ngw, int lane) {
    for (int row = gw; row < nrows; row += ngw) {
        const float* src; int r;
        if (row < ML) { src = xl + (size_t)row * D; r = row >> 11; } else { src = xc + (size_t)(row - ML) * D; r = 8; }
        const float* md = modl + (size_t)r * 6144;
        f32x4 v[4]; float ss = 0.f;
#pragma unroll
        for (int j = 0; j < 4; ++j) { v[j] = *(const f32x4*)(src + 4 * lane + 256 * j); ss += (v[j].x * v[j].x + v[j].y * v[j].y) + (v[j].z * v[j].z + v[j].w * v[j].w); }
        ss = wave_sum(ss);
        const float rstd = rsqrtf(ss * (1.f / 1024.f) + 1e-6f);
#pragma unroll
        for (int j = 0; j < 4; ++j) {
            const int c = 4 * lane + 256 * j;
            const f32x4 gg = *(const f32x4*)(g + c), scv = *(const f32x4*)(md + sci * 1024 + c), shv = *(const f32x4*)(md + shi * 1024 + c);
            const f32x4 o = v[j] * rstd * gg * (1.f + scv) + shv;
            u32x2 p; p.x = pkbf(o.x, o.y); p.y = pkbf(o.z, o.w);
            *(u32x2*)(H + (size_t)row * D + c) = p;
        }
    }
}

template <int MODE> __device__ __forceinline__ void transpose_item(const float* W, int K, int N, bf16_t* WT, LAS float* scr, int item, int lane) {
    const int nblk = N / 32, kb = item / nblk, nb = item % nblk, k0 = 64 * kb, n0 = 32 * nb;
#pragma unroll 8
    for (int i = 0; i < 32; ++i) { const int kk = 2 * i + (lane >> 5); scr[kk * 33 + (lane & 31)] = W[(size_t)(k0 + kk) * N + n0 + (lane & 31)]; }
    asm volatile("s_waitcnt lgkmcnt(0)" ::: "memory");
    const int c = lane & 7;
#pragma unroll
    for (int j = 0; j < 4; ++j) {
        const int n = (lane >> 3) + 8 * j, gn = n0 + n; const LAS float* s = scr + (8 * c) * 33 + n;
        const int drow = MODE == 0 ? gn : (MODE == 1 ? (gn >= 8608 ? gn + 96 : gn) : (gn < DFF ? 2 * gn : 2 * (gn - DFF) + 1));
        u32x4 o; o.x = pkbf(s[0 * 33], s[1 * 33]); o.y = pkbf(s[2 * 33], s[3 * 33]); o.z = pkbf(s[4 * 33], s[5 * 33]); o.w = pkbf(s[6 * 33], s[7 * 33]);
        *(u32x4*)(WT + (size_t)drow * K + k0 + 8 * c) = o;
    }
    asm volatile("s_waitcnt lgkmcnt(0)" ::: "memory");
}
__device__ __forceinline__ void ph_wconv(CArgs& a, int l, unsigned char* ldsg, int gw, int ngw, int lane, int wv) {
    LAS float* scr = (LAS float*)(ldsg + wv * 8704);
    unsigned char* ws = a.ws;
    constexpr int I_IN = 16 * 365, I_SQ = 16 * 32, I_WI = 16 * 176, I_WO = 44 * 32, NIT = I_IN + 4 * I_SQ + I_WI + I_WO;
    for (int it = gw; it < NIT; it += ngw) {
        int r = it;
        if (r < I_IN) { transpose_item<1>(a.in[8] + (size_t)l * 1024 * 11680, 1024, 11680, (bf16_t*)(ws + WS_WIN), scr, r, lane); continue; } r -= I_IN;
        if (r < I_SQ) { transpose_item<0>(a.in[27] + (size_t)l * 1048576, 1024, 1024, (bf16_t*)(ws + WS_WA), scr, r, lane); continue; } r -= I_SQ;
        if (r < I_SQ) { transpose_item<0>(a.in[28] + (size_t)l * 1048576, 1024, 1024, (bf16_t*)(ws + WS_WB), scr, r, lane); continue; } r -= I_SQ;
        if (r < I_SQ) { transpose_item<0>(a.in[29] + (size_t)l * 1048576, 1024, 1024, (bf16_t*)(ws + WS_WC), scr, r, lane); continue; } r -= I_SQ;
        if (r < I_SQ) { transpose_item<0>(a.in[30] + (size_t)l * 1048576, 1024, 1024, (bf16_t*)(ws + WS_WO), scr, r, lane); continue; } r -= I_SQ;
        if (r < I_WI) { transpose_item<2>(a.in[31] + (size_t)l * 1024 * 5632, 1024, 5632, (bf16_t*)(ws + WS_WI), scr, r, lane); continue; } r -= I_WI;
        transpose_item<0>(a.in[32] + (size_t)l * DFF * 1024, DFF, 1024, (bf16_t*)(ws + WS_WO2), scr, r, lane);
    }
    const int gt = gw * 64 + lane, ngt = ngw * 64;
    bf16_t* LWT = (bf16_t*)(ws + WS_LWT); bf16_t* LAT = (bf16_t*)(ws + WS_LAT); bf16_t* LGT = (bf16_t*)(ws + WS_LGT);
    const float* w2 = a.in[18] + (size_t)l * 2 * 64 * 1024; const float* a2 = a.in[20] + (size_t)l * 2 * 64 * 1024; const float* g2 = a.in[21] + (size_t)l * 160 * 1024;
    for (int i = gt; i < 2048 * 128; i += ngt) {
        const int n = i >> 7, k = i & 127, d = n >> 10, c = n & 1023, kk = k - d * 64;
        const bool in = (kk >= 0 && kk < 64);
        LWT[i] = in ? f2bf(w2[((size_t)d * 64 + kk) * 1024 + c]) : (bf16_t)0;
        LAT[i] = in ? f2bf(a2[((size_t)d * 64 + kk) * 1024 + c]) : (bf16_t)0;
    }
    for (int i = gt; i < 1024 * 256; i += ngt) { const int n = i >> 8, k = i & 255; LGT[i] = k < 160 ? f2bf(g2[(size_t)k * 1024 + n]) : (bf16_t)0; }
    bf16_t* WIN = (bf16_t*)(ws + WS_WIN);
    for (int i = gt; i < 96 * 1024; i += ngt) WIN[(size_t)8608 * 1024 + i] = 0;
}

__device__ __forceinline__ void gmlp_unit(const TI ti, CArgs& a, int l, int u, unsigned char* ldsg) {
    float* rstd = (float*)ldsg; bf16_t* VNT = (bf16_t*)(ldsg + 512);
    const int tid = ti.tid, lane = tid & 63, w = tid >> 6, r = lane & 31, h = lane >> 5;
    bf16_t* GU = (bf16_t*)(a.ws + WS_GU); const bf16_t* GV = (const bf16_t*)(a.ws + WS_GV);
    const size_t R0 = (size_t)u * 128;
#pragma unroll 4
    for (int i = 0; i < 16; ++i) {
        const int tok = w * 16 + i; const bf16_t* p = GV + (R0 + tok) * 1024 + lane * 16;
        f32x4 x0, x1, x2, x3; unpack8(*(const u32x4*)p, x0, x1); unpack8(*(const u32x4*)(p + 8), x2, x3);
        float ss = (x0.x * x0.x + x0.y * x0.y + x0.z * x0.z + x0.w * x0.w) + (x1.x * x1.x + x1.y * x1.y + x1.z * x1.z + x1.w * x1.w)
                 + (x2.x * x2.x + x2.y * x2.y + x2.z * x2.z + x2.w * x2.w) + (x3.x * x3.x + x3.y * x3.y + x3.z * x3.z + x3.w * x3.w);
        ss = wave_sum(ss);
        if (lane == 0) rstd[tok] = rsqrtf(ss * (1.f / 1024.f) + 1e-6f);
    }
    __syncthreads();
    const float* gvg = a.in[9] + l * 1024; const float* wsp = a.in[10] + (size_t)l * 8 * 128 * 128; const float* bsp = a.in[11] + l * 8 * 128;
    const int tt = w & 3, chh = w >> 2;
    for (int g = 0; g < 8; ++g) {
        {
            const int s = tid & 127, cc = tid >> 7; const float rs = rstd[s]; const bf16_t* p = GV + (R0 + s) * 1024 + g * 128 + cc * 32;
#pragma unroll
            for (int q = 0; q < 4; ++q) {
                f32x4 x0, x1; unpack8(*(const u32x4*)(p + 8 * q), x0, x1);
                const float* gp = gvg + g * 128 + cc * 32 + 8 * q; const int c0 = cc * 32 + 8 * q;
                VNT[(c0 + 0) * 136 + s] = f2bf(x0.x * rs * gp[0]); VNT[(c0 + 1) * 136 + s] = f2bf(x0.y * rs * gp[1]);
                VNT[(c0 + 2) * 136 + s] = f2bf(x0.z * rs * gp[2]); VNT[(c0 + 3) * 136 + s] = f2bf(x0.w * rs * gp[3]);
                VNT[(c0 + 4) * 136 + s] = f2bf(x1.x * rs * gp[4]); VNT[(c0 + 5) * 136 + s] = f2bf(x1.y * rs * gp[5]);
                VNT[(c0 + 6) * 136 + s] = f2bf(x1.z * rs * gp[6]); VNT[(c0 + 7) * 136 + s] = f2bf(x1.w * rs * gp[7]);
            }
        }
        __syncthreads();
        f32x16 acc0, acc1;
#pragma unroll
        for (int i = 0; i < 16; ++i) { acc0[i] = 0.f; acc1[i] = 0.f; }
        const float* wrow = wsp + ((size_t)g * 128 + tt * 32 + r) * 128;
#pragma unroll
        for (int ks = 0; ks < 8; ++ks) {
            const f32x4 a0 = *(const f32x4*)(wrow + 16 * ks + 8 * h), a1 = *(const f32x4*)(wrow + 16 * ks + 8 * h + 4);
            const bf16x8 af = __builtin_bit_cast(bf16x8, pack8(a0, a1));
            const bf16x8 b0 = *(const bf16x8*)(VNT + (chh * 64 + r) * 136 + 16 * ks + 8 * h);
            const bf16x8 b1 = *(const bf16x8*)(VNT + (chh * 64 + 32 + r) * 136 + 16 * ks + 8 * h);
            acc0 = MFMA32(af, b0, acc0); acc1 = MFMA32(af, b1, acc1);
        }
        {
            const bf16_t* GUr = GU; float uu0[16], uu1[16], bb[16];
#pragma unroll
            for (int reg = 0; reg < 16; ++reg) {
                const int t = tt * 32 + (reg & 3) + 8 * (reg >> 2) + 4 * h; const size_t i0 = (R0 + t) * 1024 + g * 128 + chh * 64 + r;
                bb[reg] = bsp[g * 128 + t]; uu0[reg] = bf2f(GUr[i0]); uu1[reg] = bf2f(GUr[i0 + 32]);
            }
            asm volatile("" ::: "memory");
#pragma unroll
            for (int reg = 0; reg < 16; ++reg) {
                const int t = tt * 32 + (reg & 3) + 8 * (reg >> 2) + 4 * h; const size_t i0 = (R0 + t) * 1024 + g * 128 + chh * 64 + r;
                GU[i0] = f2bf(uu0[reg] * (acc0[reg] + bb[reg])); GU[i0 + 32] = f2bf(uu1[reg] * (acc1[reg] + bb[reg]));
            }
        }
        __syncthreads();
    }
}
__device__ __forceinline__ void qk_rows(CArgs& a, int l, int gw, int ngw, int lane) {
    bf16_t* Q = (bf16_t*)(a.ws + WS_Q); bf16_t* K = (bf16_t*)(a.ws + WS_K);
    const float* RC = (const float*)(a.ws + WS_ROPE); const float* RS = RC + 2048 * 32;
    const int part = lane & 3;
    float gq[16], gk[16];
    load16f(a.in[12] + l * 64 + 16 * part, gq); load16f(a.in[13] + l * 64 + 16 * part, gk);
    for (int row = gw; row < M; row += ngw) {
        float xq[16], xk[16], cs[16], sn[16];
        unpack16(Q + (size_t)row * 1024 + 16 * lane, xq); unpack16(K + (size_t)row * 1024 + 16 * lane, xk);
        const bool lat = row < ML;
        if (lat) { const int t = row & 2047; load16f(RC + t * 32 + 16 * (part & 1), cs); load16f(RS + t * 32 + 16 * (part & 1), sn); }
        float sq = 0.f, sk = 0.f;
#pragma unroll
        for (int j = 0; j < 16; ++j) { sq += xq[j] * xq[j]; sk += xk[j] * xk[j]; }
        const float rq = rsqrtf(quad_sum(sq) * (1.f / 64.f) + 1e-6f), rk = rsqrtf(quad_sum(sk) * (1.f / 64.f) + 1e-6f);
#pragma unroll
        for (int j = 0; j < 16; ++j) { xq[j] = xq[j] * rq * gq[j]; xk[j] = xk[j] * rk * gk[j]; }
        if (lat) {
            const float sgn = part < 2 ? -1.f : 1.f;
#pragma unroll
            for (int j = 0; j < 16; ++j) {
                const float pq = quad_xor2(xq[j]), pk = quad_xor2(xk[j]);
                xq[j] = xq[j] * cs[j] + sgn * pq * sn[j]; xk[j] = xk[j] * cs[j] + sgn * pk * sn[j];
            }
        }
#pragma unroll
        for (int j = 0; j < 16; ++j) xq[j] *= QSCALE;
        pack16(Q + (size_t)row * 1024 + 16 * lane, xq); pack16(K + (size_t)row * 1024 + 16 * lane, xk);
    }
}
__device__ __forceinline__ void lora_in_rows(CArgs& a, int l, int gw, int ngw, int lane) {
    const bf16_t* RW = (const bf16_t*)(a.ws + WS_RW); bf16_t* LW = (bf16_t*)(a.ws + WS_LIW); bf16_t* LA = (bf16_t*)(a.ws + WS_LIA); bf16_t* LG = (bf16_t*)(a.ws + WS_LIG);
    const float* mu = a.in[16] + l * 3488 + 3072;
    f32x4 m0 = {0.f, 0.f, 0.f, 0.f}, m1 = m0;
    if (lane < 52) { m0 = *(const f32x4*)(mu + 8 * lane); m1 = *(const f32x4*)(mu + 8 * lane + 4); }
    for (int row = gw; row < M; row += ngw) {
        int t, Tn; if (row < ML) { t = row & 2047; Tn = 2048; } else { t = (row - ML) & 255; Tn = 256; }
        const bool hp = t > 0, hn = t < Tn - 1;
        if (lane < 52) {
            const bf16_t* p = RW + (size_t)row * RWP + 3072 + 8 * lane;
            f32x4 x0, x1, p0 = {0.f, 0.f, 0.f, 0.f}, p1 = p0, n0 = p0, n1 = p0;
            unpack8(*(const u32x4*)p, x0, x1);
            if (hp) unpack8(*(const u32x4*)(p - RWP), p0, p1);
            if (hn) unpack8(*(const u32x4*)(p + RWP), n0, n1);
            f32x4 z0 = x0 + m0 * (0.5f * (p0 + n0) - x0), z1 = x1 + m1 * (0.5f * (p1 + n1) - x1);
            const int j = 8 * lane;
            if (j < 128) { z0 = (f32x4){tanhf(z0.x), tanhf(z0.y), tanhf(z0.z), tanhf(z0.w)}; z1 = (f32x4){tanhf(z1.x), tanhf(z1.y), tanhf(z1.z), tanhf(z1.w)}; *(u32x4*)(LW + (size_t)row * 128 + j) = pack8(z0, z1); }
            else if (j < 256) { *(u32x4*)(LA + (size_t)row * 128 + j - 128) = pack8(z0, z1); }
            else { *(u32x4*)(LG + (size_t)row * 256 + j - 256) = pack8(sig4(z0), sig4(z1)); }
        } else {
            unsigned z_ = 0u; asm volatile("" : "+v"(z_)); *(u32x4*)(LG + (size_t)row * 256 + 160 + (lane - 52) * 8) = (u32x4){z_, z_, z_, z_};
        }
    }
}

__device__ __forceinline__ void scan_unit(const TI ti, CArgs& a, int l, int u, bool ctx_out, unsigned char* ldsg) {
    const int tid = ti.tid, lane = tid & 63, w = tid >> 6;
    const int b = u >> 5, hh = (u >> 1) & 15, d = u & 1;
    const int si = tid >> 3, jq = tid & 7;
    LAS float* L = (LAS float*)ldsg;
    const bf16_t* RW = (const bf16_t*)(a.ws + WS_RW);
    const bf16_t* DEC = (const bf16_t*)(a.ws + (d ? WS_DEC1 : WS_GV));
    const bf16_t* AA = (const bf16_t*)(a.ws + (d ? WS_AA1 : WS_AA0));
    bf16_t* Y = (bf16_t*)(a.ws + (d ? WS_Y1 : WS_H));
    const int ch = hh * 64 + lane;
    const float* mu = a.in[16] + l * 3488;
    const float mur = mu[ch], muk = mu[1024 + ch], muv = mu[2048 + ch], kkg = a.in[22][l * 1024 + ch], kag = a.in[23][l * 1024 + ch];
    f32x4 S0 = {0.f, 0.f, 0.f, 0.f}, S1 = {0.f, 0.f, 0.f, 0.f};
    unsigned raw[4][9]; unsigned dcr[4], aar[4];
    constexpr int NC = 72;
#define SCAN_CHUNK(n, base, Tn, t0, wy) int base, Tn, t0; bool wy; { int ci; if ((n) < 8) { base = ML + b * 256; Tn = 256; ci = d ? 7 - (n) : (n); wy = ctx_out; } else { base = b * 2048; Tn = 2048; ci = d ? 71 - (n) : (n) - 8; wy = true; } t0 = ci * 32; }
#define SCAN_LOAD(n) do { SCAN_CHUNK(n, base_, Tn_, t0_, wy_); (void)wy_; _Pragma("unroll") for (int i4 = 0; i4 < 4; ++i4) { const int t = t0_ + w + 8 * i4; const size_t row = (size_t)(base_ + t); \
        const bf16_t* p = RW + row * RWP + ch; const bool hp = t > 0, hn = t < Tn_ - 1; \
        const int op_ = hp ? -RWP : 0, on_ = hn ? RWP : 0;     \
        _Pragma("unroll") for (int X = 0; X < 3; ++X) { raw[i4][3 * X + 0] = (unsigned)p[X * 1024 + op_]; raw[i4][3 * X + 1] = (unsigned)p[X * 1024]; raw[i4][3 * X + 2] = (unsigned)p[X * 1024 + on_]; } \
        dcr[i4] = (unsigned)DEC[row * 1024 + ch]; aar[i4] = (unsigned)AA[row * 1024 + ch]; } } while (0)
#define SCAN_STORE(n) do { LAS float* Bf = L + ((n) & 1) * 12288; SCAN_CHUNK(n, base_, Tn_, t0_, wy_); (void)wy_; (void)base_; _Pragma("unroll") for (int i4 = 0; i4 < 4; ++i4) { const int tk = w + 8 * i4; \
        const float mp_ = (t0_ + tk > 0) ? 0.5f : 0.f, mn_ = (t0_ + tk < Tn_ - 1) ? 0.5f : 0.f; \
        const float xr = bf2f(raw[i4][1]), xk = bf2f(raw[i4][4]), xv = bf2f(raw[i4][7]); \
        const float zr = xr + mur * ((mp_ * bf2f(raw[i4][0]) + mn_ * bf2f(raw[i4][2])) - xr); \
        const float zk = xk + muk * ((mp_ * bf2f(raw[i4][3]) + mn_ * bf2f(raw[i4][5])) - xk); \
        const float zv = xv + muv * ((mp_ * bf2f(raw[i4][6]) + mn_ * bf2f(raw[i4][8])) - xv); \
        const float kkv = zk * kkg; const float ssq = wave_sum(kkv * kkv); const float kkn = kkv / fmaxf(sqrtf(ssq), 1e-12f); \
        const float ad = bf2f(aar[i4]); const float wv_ = __expf(bf2f(dcr[i4])); const float kd = zk * (1.f + (ad - 1.f) * kag); \
        Bf[0 * 2048 + tk * 64 + lane] = wv_; Bf[1 * 2048 + tk * 64 + lane] = kd; Bf[2 * 2048 + tk * 64 + lane] = -kkn; \
        Bf[3 * 2048 + tk * 64 + lane] = kkn * ad; Bf[4 * 2048 + tk * 64 + lane] = zr; Bf[5 * 2048 + tk * 64 + lane] = zv; } } while (0)
    SCAN_LOAD(0); SCAN_STORE(0);
    __syncthreads();
    for (int n = 0; n < NC; ++n) {
        if (n + 1 < NC) SCAN_LOAD(n + 1);
        LAS const float* Bf = L + (n & 1) * 12288; LAS float* Yb = L + 24576 + (n & 1) * 2048;
#define STEP_LOAD(P, sidx) LAS const float* q##P = Bf + (sidx) * 64 + 8 * jq + hoff; \
            const f32x4 w0##P = *(LAS const f32x4*)(q##P), w1##P = *(LAS const f32x4*)(q##P + hdq), k0##P = *(LAS const f32x4*)(q##P + 2048), k1##P = *(LAS const f32x4*)(q##P + 2048 + hdq), \
                        a0##P = *(LAS const f32x4*)(q##P + 4096), a1##P = *(LAS const f32x4*)(q##P + 4096 + hdq), b0##P = *(LAS const f32x4*)(q##P + 6144), b1##P = *(LAS const f32x4*)(q##P + 6144 + hdq), \
                        r0##P = *(LAS const f32x4*)(q##P + 8192), r1##P = *(LAS const f32x4*)(q##P + 8192 + hdq); const float vi##P = Bf[5 * 2048 + (sidx) * 64 + si];
#define STEP_MATH(P, sidx) { const f32x4 ta = S0 * a0##P + S1 * a1##P; const float sa = dpp_sum8((ta.x + ta.y) + (ta.z + ta.w)); \
            S0 = S0 * w0##P + (sa * b0##P + vi##P * k0##P); S1 = S1 * w1##P + (sa * b1##P + vi##P * k1##P); \
            const f32x4 ty = S0 * r0##P + S1 * r1##P; const float y = dpp_sum8((ty.x + ty.y) + (ty.z + ty.w)); if (jq == 0) Yb[(sidx) * 64 + si] = y; }
        const int hoff = (si & 1) * 4, hdq = 4 - 2 * hoff;
        const int sdir = d ? -1 : 1; int sc = d ? 31 : 0;
        f32x4 cw0, cw1, ck0, ck1, ca0, ca1, cb0, cb1, cr0, cr1; float cvi;
        { STEP_LOAD(X, sc); cw0 = w0X; cw1 = w1X; ck0 = k0X; ck1 = k1X; ca0 = a0X; ca1 = a1X; cb0 = b0X; cb1 = b1X; cr0 = r0X; cr1 = r1X; cvi = viX; }
        for (int ss = 0; ss < 32; ss += 2) {
            const int s0i = sc, s1i = sc + sdir; int s2i = sc + 2 * sdir; s2i = (ss + 2 < 32) ? s2i : s1i;
            STEP_LOAD(B, s1i);
            { const f32x4 w0A = cw0, w1A = cw1, k0A = ck0, k1A = ck1, a0A = ca0, a1A = ca1, b0A = cb0, b1A = cb1, r0A = cr0, r1A = cr1; const float viA = cvi; STEP_MATH(A, s0i); }
            STEP_LOAD(C, s2i);
            STEP_MATH(B, s1i);
            cw0 = w0C; cw1 = w1C; ck0 = k0C; ck1 = k1C; ca0 = a0C; ca1 = a1C; cb0 = b0C; cb1 = b1C; cr0 = r0C; cr1 = r1C; cvi = viC;
            sc += 2 * sdir;
        }
#undef STEP_LOAD
#undef STEP_MATH
        if (n + 1 < NC) SCAN_STORE(n + 1);
        __syncthreads();
        {
            SCAN_CHUNK(n, base_, Tn_, t0_, wy_); (void)Tn_;
            if (wy_) {
#pragma unroll
                for (int i4 = 0; i4 < 4; ++i4) { const int tk = w + 8 * i4; Y[(size_t)(base_ + t0_ + tk) * 1024 + ch] = f2bf(Yb[tk * 64 + lane]); }
            }
        }
    }
    __syncthreads();
#undef SCAN_CHUNK
#undef SCAN_LOAD
#undef SCAN_STORE
}

__device__ __forceinline__ bf16x8 pk8f(float f0, float f1, float f2, float f3, float f4, float f5, float f6, float f7) {
    u32x4 p; p.x = pkbf(f0, f1); p.y = pkbf(f2, f3); p.z = pkbf(f4, f5); p.w = pkbf(f6, f7); return __builtin_bit_cast(bf16x8, p);
}
__device__ __forceinline__ void scan_unit_mfma(const TI ti, CArgs& a, int l, int u, bool ctx_out, unsigned char* ldsg) {
    const int tid = ti.tid, lane = tid & 63, w = __builtin_amdgcn_readfirstlane(tid >> 6);
    const int b = u >> 5, hh = (u >> 1) & 15, d = u & 1;
    LAS unsigned char* L = (LAS unsigned char*)ldsg;
    constexpr int NCH = 144, RING = 6, BUFB = 20736, O_AR = 0, O_BK = 4608, O_BKT = 9216, O_VTT = 14336, O_PC = 17408, O_NS = 17664, O_XF = 18688;
#define SC2_CHUNK(C, base, Tn, cc, wy) int base, Tn, cc; bool wy; if ((C) < 16) { base = ML + b * 256; Tn = 256; cc = (C); wy = ctx_out; } else { base = b * 2048; Tn = 2048; cc = (C) - 16; wy = true; }
#define SC2_TOK(Tn, cc, t) (d ? (Tn) - 1 - (16 * (cc) + (t)) : 16 * (cc) + (t))
    if (w < 2) {
        const int it = w, r = lane & 31, h = lane >> 5;
        bf16_t* Y = (bf16_t*)(a.ws + (d ? WS_Y1 : WS_H));
        f32x16 ST0, ST1;
#pragma unroll
        for (int i = 0; i < 16; ++i) { ST0[i] = 0.f; ST1[i] = 0.f; }
        for (int n = 0; n < NCH + RING; ++n) {
            if (n >= RING) {
                const int C = n - RING;
                LAS const unsigned char* buf = L + (C % RING) * BUFB;
                const bf16x8 xb0 = *(LAS const bf16x8*)(buf + O_XF + lane * 16), xb1 = *(LAS const bf16x8*)(buf + O_XF + 1024 + lane * 16);
                f32x16 Z;
#pragma unroll
                for (int i = 0; i < 16; ++i) Z[i] = 0.f;
#pragma unroll
                for (int jt = 0; jt < 2; ++jt) {
#pragma unroll
                    for (int s = 0; s < 2; ++s) {
                        LAS const unsigned char* ap = buf + O_AR + r * 144 + (32 * jt + 16 * s + 4 * h) * 2;
                        const s16x4 lo = *(LAS const s16x4*)ap, hi = *(LAS const s16x4*)(ap + 16);
                        const bf16x8 a2 = __builtin_shufflevector(lo, hi, 0, 1, 2, 3, 4, 5, 6, 7);
                        const bf16x8 stp = jt == 0 ? pk8f(ST0[8 * s], ST0[8 * s + 1], ST0[8 * s + 2], ST0[8 * s + 3], ST0[8 * s + 4], ST0[8 * s + 5], ST0[8 * s + 6], ST0[8 * s + 7])
                                                   : pk8f(ST1[8 * s], ST1[8 * s + 1], ST1[8 * s + 2], ST1[8 * s + 3], ST1[8 * s + 4], ST1[8 * s + 5], ST1[8 * s + 6], ST1[8 * s + 7]);
                        Z = MFMA32(a2, stp, Z);
                    }
                }
                LAS const unsigned char* vp = buf + O_VTT + (32 * it + r) * 48;
                {
                    const s16x4 lo = *(LAS const s16x4*)(vp + 8 * h), hi = *(LAS const s16x4*)(vp + 16 + 8 * h);
                    const bf16x8 vf = __builtin_shufflevector(lo, hi, 0, 1, 2, 3, 4, 5, 6, 7);
                    Z = MFMA32(xb1, vf, Z);
                }
                float o[8], g[16], uu[16];
#pragma unroll
                for (int q = 0; q < 8; ++q) o[q] = __shfl_xor(Z[q], 32);
#pragma unroll
                for (int e = 0; e < 4; ++e) {
                    g[e] = h ? o[e] : Z[e]; g[4 + e] = h ? Z[e] : o[e];
                    g[8 + e] = h ? o[4 + e] : Z[4 + e]; g[12 + e] = h ? Z[4 + e] : o[4 + e];
                }
                {
                    LAS const float* NS = (LAS const float*)(buf + O_NS);
#pragma unroll
                    for (int t = 0; t < 16; ++t) uu[t] = g[t];
#pragma unroll
                    for (int s = 0; s < 15; ++s) {
#pragma unroll
                        for (int t4 = (s + 1) / 4; t4 < 4; ++t4) {
                            const f32x4 nv = *(LAS const f32x4*)(NS + s * 16 + 4 * t4);
                            if (4 * t4 + 0 > s) uu[4 * t4 + 0] = __builtin_fmaf(nv.x, uu[s], uu[4 * t4 + 0]);
                            if (4 * t4 + 1 > s) uu[4 * t4 + 1] = __builtin_fmaf(nv.y, uu[s], uu[4 * t4 + 1]);
                            if (4 * t4 + 2 > s) uu[4 * t4 + 2] = __builtin_fmaf(nv.z, uu[s], uu[4 * t4 + 2]);
                            if (4 * t4 + 3 > s) uu[4 * t4 + 3] = __builtin_fmaf(nv.w, uu[s], uu[4 * t4 + 3]);
                        }
                    }
                }
                {
                    const bf16x8 uf = pk8f(h ? uu[4] : uu[0], h ? uu[5] : uu[1], h ? uu[6] : uu[2], h ? uu[7] : uu[3],
                                           h ? uu[12] : uu[8], h ? uu[13] : uu[9], h ? uu[14] : uu[10], h ? uu[15] : uu[11]);
                    Z = MFMA32(xb0, uf, Z);
                }
                {
                    SC2_CHUNK(C, base_, Tn_, cc_, wy_);
                    if (wy_) {
#pragma unroll
                        for (int q = 8; q < 16; ++q) {
                            const int t = (q & 3) + 8 * ((q >> 2) - 2) + 4 * h; const int tok = SC2_TOK(Tn_, cc_, t);
                            Y[(size_t)(base_ + tok) * 1024 + hh * 64 + 32 * it + r] = f2bf(Z[q]);
                        }
                    }
                }
                {
                    const bf16x8 un = pk8f(h ? uu[8] : uu[0], h ? uu[9] : uu[1], h ? uu[10] : uu[2], h ? uu[11] : uu[3],
                                           h ? uu[12] : uu[4], h ? uu[13] : uu[5], h ? uu[14] : uu[6], h ? uu[15] : uu[7]);
                    const bf16x8 vn = *(LAS const bf16x8*)(vp + 16 * h);
                    const bf16x8 a00 = *(LAS const bf16x8*)(buf + O_BKT + r * 80 + (8 * h) * 2), a01 = *(LAS const bf16x8*)(buf + O_BKT + r * 80 + (16 + 8 * h) * 2);
                    const bf16x8 a10 = *(LAS const bf16x8*)(buf + O_BKT + (32 + r) * 80 + (8 * h) * 2), a11 = *(LAS const bf16x8*)(buf + O_BKT + (32 + r) * 80 + (16 + 8 * h) * 2);
                    ST0 = MFMA32(a00, un, ST0); ST0 = MFMA32(a01, vn, ST0);
                    ST1 = MFMA32(a10, un, ST1); ST1 = MFMA32(a11, vn, ST1);
                    LAS const float* pc = (LAS const float*)(buf + O_PC);
#pragma unroll
                    for (int g4 = 0; g4 < 4; ++g4) {
                        const f32x4 p0 = *(LAS const f32x4*)(pc + 8 * g4 + 4 * h), p1 = *(LAS const f32x4*)(pc + 32 + 8 * g4 + 4 * h);
                        ST0[4 * g4] *= p0.x; ST0[4 * g4 + 1] *= p0.y; ST0[4 * g4 + 2] *= p0.z; ST0[4 * g4 + 3] *= p0.w;
                        ST1[4 * g4] *= p1.x; ST1[4 * g4 + 1] *= p1.y; ST1[4 * g4 + 2] *= p1.z; ST1[4 * g4 + 3] *= p1.w;
                    }
                }
            }
            __syncthreads();
        }
    } else {
        const int p = w - 2, ch = hh * 64 + lane;
        const bf16_t* RW = (const bf16_t*)(a.ws + WS_RW);
        const bf16_t* DEC = (const bf16_t*)(a.ws + (d ? WS_DEC1 : WS_GV));
        const bf16_t* AA = (const bf16_t*)(a.ws + (d ? WS_AA1 : WS_AA0));
        const float* mu = a.in[16] + l * 3488;
        const float mur = mu[ch], muk = mu[1024 + ch], muv = mu[2048 + ch], kkg = a.in[22][l * 1024 + ch], kag = a.in[23][l * 1024 + ch];
        LAS unsigned char* buf = L + p * BUFB;
        LAS bf16_t* AR = (LAS bf16_t*)(buf + O_AR); LAS bf16_t* BK = (LAS bf16_t*)(buf + O_BK); LAS bf16_t* BKT = (LAS bf16_t*)(buf + O_BKT); LAS bf16_t* VTT = (LAS bf16_t*)(buf + O_VTT);
        LAS float* PC = (LAS float*)(buf + O_PC);
        constexpr int NSTEP = (NCH / RING) * 4;
        unsigned nxt[4][11], cur[4][11];
#define SC2_LOAD(k) do { const int C_ = p + RING * ((k) >> 2); SC2_CHUNK(C_, base_, Tn_, cc_, wy_); (void)wy_; _Pragma("unroll") for (int i4 = 0; i4 < 4; ++i4) { \
            const int tok = SC2_TOK(Tn_, cc_, 4 * ((k) & 3) + i4); const size_t row = (size_t)(base_ + tok); \
            const gcptr_t rb = uniptr(RW + row * RWP + hh * 64 + 1024);     \
            const gcptr_t rp = rb + (tok > 0 ? -RWP : 0); const gcptr_t rn = rb + (tok < Tn_ - 1 ? RWP : 0); \
            nxt[i4][0] = (unsigned)rp[lane - 1024]; nxt[i4][3] = (unsigned)rp[lane]; nxt[i4][6] = (unsigned)rp[lane + 1024]; \
            nxt[i4][1] = (unsigned)rb[lane - 1024]; nxt[i4][4] = (unsigned)rb[lane]; nxt[i4][7] = (unsigned)rb[lane + 1024]; \
            nxt[i4][2] = (unsigned)rn[lane - 1024]; nxt[i4][5] = (unsigned)rn[lane]; nxt[i4][8] = (unsigned)rn[lane + 1024]; \
            nxt[i4][9] = (unsigned)uniptr(DEC + row * 1024 + hh * 64)[lane]; nxt[i4][10] = (unsigned)uniptr(AA + row * 1024 + hh * 64)[lane]; } } while (0)
        SC2_LOAD(0);
        float Lsum = 0.f, ePprev = 1.f;
        for (int n = 0; n < NCH + RING; ++n) {
            const int e = n - p - 1;
            if (e >= 0 && (e % RING) < 4 && e / RING < NCH / RING) {
                const int k = 4 * (e / RING) + (e % RING);
#pragma unroll
                for (int i4 = 0; i4 < 4; ++i4)
#pragma unroll
                    for (int x = 0; x < 11; ++x) cur[i4][x] = nxt[i4][x];
                if (k + 1 < NSTEP) SC2_LOAD(k + 1);
                const int C_ = p + RING * (k >> 2); SC2_CHUNK(C_, base_, Tn_, cc_, wy_); (void)wy_; (void)base_;
#pragma unroll
                for (int i4 = 0; i4 < 4; ++i4) {
                    const int t = 4 * (k & 3) + i4; const int tok = SC2_TOK(Tn_, cc_, t);
                    Lsum = (t == 0) ? 0.f : Lsum; ePprev = (t == 0) ? 1.f : ePprev;
                    const float mp_ = tok > 0 ? 0.5f : 0.f, mn_ = tok < Tn_ - 1 ? 0.5f : 0.f;
                    const float xr = bf2f(cur[i4][1]), xk = bf2f(cur[i4][4]), xv = bf2f(cur[i4][7]);
                    const float zr = xr + mur * ((mp_ * bf2f(cur[i4][0]) + mn_ * bf2f(cur[i4][2])) - xr);
                    const float zk = xk + muk * ((mp_ * bf2f(cur[i4][3]) + mn_ * bf2f(cur[i4][5])) - xk);
                    const float zv = xv + muv * ((mp_ * bf2f(cur[i4][6]) + mn_ * bf2f(cur[i4][8])) - xv);
                    const float kkv = zk * kkg; const float ssq = wave_sum(kkv * kkv); const float kkn = kkv * rsqrtf(fmaxf(ssq, 1e-24f));
                    const float ad = bf2f(cur[i4][10]); const float kd = zk * (1.f + (ad - 1.f) * kag);
                    Lsum += bf2f(cur[i4][9]);
                    const float eP = __expf(Lsum), eI = __expf(-Lsum);
                    AR[t * 72 + lane] = f2bf(-kkn * ePprev); AR[(16 + t) * 72 + lane] = f2bf(zr * eP);
                    const bf16_t bt = f2bf(kkn * ad * eI), kt = f2bf(kd * eI);
                    BK[t * 72 + lane] = bt; BK[(16 + t) * 72 + lane] = kt;
                    BKT[lane * 40 + t] = bt; BKT[lane * 40 + 16 + t] = kt;
                    VTT[lane * 24 + t] = f2bf(zv);
                    PC[lane] = eP;
                    ePprev = eP;
                }
            } else if (e >= 0 && (e % RING) == 4 && e / RING < NCH / RING) {
                const int r = lane & 31, h = lane >> 5, thr = (r & 15) + (r >> 4);
                f32x16 X;
#pragma unroll
                for (int i = 0; i < 16; ++i) X[i] = 0.f;
#pragma unroll
                for (int ks = 0; ks < 4; ++ks) {
                    const bf16x8 af = *(LAS const bf16x8*)(buf + O_BK + r * 144 + (16 * ks + 8 * h) * 2);
                    const bf16x8 bfr = *(LAS const bf16x8*)(buf + O_AR + r * 144 + (16 * ks + 8 * h) * 2);
                    X = MFMA32(af, bfr, X);
                }
#pragma unroll
                for (int rg = 0; rg < 16; ++rg) { const int s = (rg & 3) + 8 * ((rg >> 2) & 1) + 4 * h; X[rg] = (s < thr) ? X[rg] : 0.f; }
                if (r < 16) {
                    LAS float* NS = (LAS float*)(buf + O_NS);
#pragma unroll
                    for (int rg = 0; rg < 8; ++rg) NS[((rg & 3) + 8 * (rg >> 2) + 4 * h) * 16 + r] = X[rg];
                }
                *(LAS bf16x8*)(buf + O_XF + lane * 16) = pk8f(X[0], X[1], X[2], X[3], X[4], X[5], X[6], X[7]);
                *(LAS bf16x8*)(buf + O_XF + 1024 + lane * 16) = pk8f(X[8], X[9], X[10], X[11], X[12], X[13], X[14], X[15]);
            }
            __syncthreads();
        }
#undef SC2_LOAD
    }
    __syncthreads();
#undef SC2_CHUNK
#undef SC2_TOK
}

__device__ __forceinline__ void attn_unit(const TI ti, CArgs& a, int b, int hd, int qrow0, int st_lo, int st_hi, float mfix, float lam, float lam_init, const float* subg, unsigned char* ldsg) {
    const int tid = ti.tid, lane = tid & 63, w = tid >> 6, r = lane & 31, h = lane >> 5, qt = w >> 1, c = w & 1;
    bf16_t* Qb = (bf16_t*)(a.ws + WS_Q); const bf16_t* Kb = (const bf16_t*)(a.ws + WS_K); const bf16_t* Vb = (const bf16_t*)(a.ws + WS_V);
    LAS unsigned char* L = (LAS unsigned char*)ldsg;
    constexpr int KOFF = 0, VOFF = 17408, BUFB = 35840;
    bf16x8 qf[4];
    { const bf16_t* qp = Qb + (size_t)(qrow0 + qt * 32 + r) * 1024 + hd * 128 + c * 64 + 8 * h;
#pragma unroll
      for (int ks = 0; ks < 4; ++ks) qf[ks] = *(const bf16x8*)(qp + 16 * ks); }
    f32x16 O[4];
#pragma unroll
    for (int e = 0; e < 4; ++e)
#pragma unroll
        for (int i = 0; i < 16; ++i) O[e][i] = 0.f;
    float lsum = 0.f;
    u32x4 kreg[2], vreg[2];
    typedef const __attribute__((address_space(1))) u32x4* gc16_t;
    const int koff0 = (tid >> 4) * 1024 + (tid & 15) * 8, koff1 = koff0 + 32 * 1024, voff = lane * 1024 + w * 16;
#define ATT_LOAD(st) do { const int rb_ = (st) < 32 ? b * 2048 + (st) * 64 : ML + b * 256 + ((st) - 32) * 64; \
        const gcptr_t kb_ = uniptr(Kb + (size_t)rb_ * 1024 + hd * 128); const gcptr_t vb_ = uniptr(Vb + (size_t)rb_ * 1024 + hd * 128); \
        kreg[0] = *(gc16_t)(kb_ + koff0); kreg[1] = *(gc16_t)(kb_ + koff1); vreg[0] = *(gc16_t)(vb_ + voff); vreg[1] = *(gc16_t)(vb_ + voff + 8); } while (0)
#define ATT_STORE(bufi) do { LAS unsigned char* Bb = L + (bufi) * BUFB; _Pragma("unroll") for (int i = 0; i < 2; ++i) { const int p = tid + 512 * i, key = p >> 4, dc = p & 15; *(LAS u32x4*)(Bb + KOFF + key * 272 + dc * 16) = kreg[i]; } \
        LAS bf16_t* vt = (LAS bf16_t*)(Bb + VOFF) + (w * 16) * 72 + ((lane & 48) + 8 * ((lane >> 2) & 1) + 4 * ((lane >> 3) & 1) + (lane & 3));   \
        _Pragma("unroll") for (int e = 0; e < 4; ++e) { vt[(2 * e) * 72] = (bf16_t)(vreg[0][e] & 0xffffu); vt[(2 * e + 1) * 72] = (bf16_t)(vreg[0][e] >> 16); \
            vt[(8 + 2 * e) * 72] = (bf16_t)(vreg[1][e] & 0xffffu); vt[(8 + 2 * e + 1) * 72] = (bf16_t)(vreg[1][e] >> 16); } } while (0)
    ATT_LOAD(st_lo); ATT_STORE(0);
    __syncthreads();
    for (int st = st_lo; st < st_hi; ++st) {
        const int bi = (st - st_lo) & 1;
        if (st + 1 < st_hi) ATT_LOAD(st + 1);
        LAS const unsigned char* Bb = L + bi * BUFB;
#pragma unroll
        for (int sub = 0; sub < 2; ++sub) {
            f32x16 Sx;
#pragma unroll
            for (int i = 0; i < 16; ++i) Sx[i] = -mfix;
#pragma unroll
            for (int ks = 0; ks < 4; ++ks) {
                const bf16x8 kf = *(LAS const bf16x8*)(Bb + KOFF + (sub * 32 + r) * 272 + (c * 64 + 16 * ks + 8 * h) * 2);
                Sx = MFMA32(kf, qf[ks], Sx);
            }
            float p[16];
#pragma unroll
            for (int i = 0; i < 16; ++i) { p[i] = __builtin_amdgcn_exp2f(Sx[i]); lsum += p[i]; }
            u32x4 pw0, pw1;
            pw0.x = pkbf(p[0], p[1]); pw0.y = pkbf(p[2], p[3]); pw0.z = pkbf(p[4], p[5]); pw0.w = pkbf(p[6], p[7]);
            pw1.x = pkbf(p[8], p[9]); pw1.y = pkbf(p[10], p[11]); pw1.z = pkbf(p[12], p[13]); pw1.w = pkbf(p[14], p[15]);
            const bf16x8 pb0 = __builtin_bit_cast(bf16x8, pw0), pb1 = __builtin_bit_cast(bf16x8, pw1);
#pragma unroll
            for (int et = 0; et < 4; ++et) {
#pragma unroll
                for (int s = 0; s < 2; ++s) {
                    const bf16x8 vf = *(LAS const bf16x8*)(Bb + VOFF + (et * 32 + r) * 144 + (sub * 32 + 16 * s + 8 * h) * 2);
                    O[et] = MFMA32(vf, s ? pb1 : pb0, O[et]);
                }
            }
        }
        if (st + 1 < st_hi) ATT_STORE(bi ^ 1);
        __syncthreads();
    }
#undef ATT_LOAD
#undef ATT_STORE
    const float ltot = lsum + __shfl_xor(lsum, 32);
    const float linv = 1.f / ltot;
    LAS float* X = (LAS float*)L + qt * 4096;
    if (c == 1) {
#pragma unroll
        for (int e = 0; e < 4; ++e)
#pragma unroll
            for (int i = 0; i < 16; ++i) X[(e * 16 + i) * 64 + lane] = O[e][i] * linv;
    }
    __syncthreads();
    if (c == 0) {
        float ssq = 0.f;
#pragma unroll
        for (int e = 0; e < 4; ++e)
#pragma unroll
            for (int i = 0; i < 16; ++i) { const float o = O[e][i] * linv - lam * X[(e * 16 + i) * 64 + lane]; O[e][i] = o; ssq += o * o; }
        ssq += __shfl_xor(ssq, 32);
        const float sc = rsqrtf(ssq * (1.f / 128.f) + 1e-6f) * (1.f - lam_init);
        bf16_t* op = Qb + (size_t)(qrow0 + qt * 32 + r) * 1024 + hd * 128;
#pragma unroll
        for (int e = 0; e < 4; ++e)
#pragma unroll
            for (int g4 = 0; g4 < 4; ++g4) {
                const int e0 = e * 32 + 8 * g4 + 4 * h; const f32x4 sg = *(const f32x4*)(subg + e0);
                u32x2 o; o.x = pkbf(O[e][4 * g4 + 0] * sc * sg.x, O[e][4 * g4 + 1] * sc * sg.y); o.y = pkbf(O[e][4 * g4 + 2] * sc * sg.z, O[e][4 * g4 + 3] * sc * sg.w);
                *(u32x2*)(op + e0) = o;
            }
    }
    __syncthreads();
}
__device__ __forceinline__ void ph_attn(const TI ti, CArgs& a, int l, bool ctx_out, unsigned char* ldsg) {
    const int lane = ti.tid & 63;
    const float gqm = fabsf(a.in[12][l * 64 + lane]), gkm = fabsf(a.in[13][l * 64 + lane]);
    float mq = gqm, mk = gkm;
#pragma unroll
    for (int o = 1; o < 64; o <<= 1) { mq = fmaxf(mq, __shfl_xor(mq, o)); mk = fmaxf(mk, __shfl_xor(mk, o)); }
    const float mfix = 8.f * mq * mk * 1.4426950408889634f * 1.03f;
    const float* lp = a.in[14] + l * 256;
    const float s1 = wave_sum(lp[lane] * lp[64 + lane]), s2 = wave_sum(lp[128 + lane] * lp[192 + lane]);
    const float lam_init = 0.8f - 0.6f * expf(-0.3f * (float)l);
    const float lam = expf(s1) - expf(s2) + lam_init;
    const float* subg = a.in[15] + l * 128;
    const int nun = 1024 + (ctx_out ? 128 : 0);
    for (int u = ti.bid; u < nun; u += ti.nblk) {
        if (u < 1024) { const int bh = u >> 4, qb = u & 15; attn_unit(ti, a, bh >> 3, bh & 7, (bh >> 3) * 2048 + qb * 128, 0, 36, mfix, lam, lam_init, subg, ldsg); }
        else { const int v = u - 1024, bh = v >> 1, qb = v & 1; attn_unit(ti, a, bh >> 3, bh & 7, ML + (bh >> 3) * 256 + qb * 128, 32, 36, mfix, lam, lam_init, subg, ldsg); }
    }
}

__device__ __forceinline__ void up8(const bf16_t* p, float (&x)[8]) { const u32x4 v = *(const u32x4*)p;
#pragma unroll
    for (int i = 0; i < 4; ++i) { x[2 * i] = bf2f(v[i] & 0xffffu); x[2 * i + 1] = bf2f(v[i] >> 16); } }
__device__ __forceinline__ void ld8f(const float* p, float (&x)[8]) { const f32x4 u = *(const f32x4*)p, v = *(const f32x4*)(p + 4); x[0] = u.x; x[1] = u.y; x[2] = u.z; x[3] = u.w; x[4] = v.x; x[5] = v.y; x[6] = v.z; x[7] = v.w; }
__device__ __forceinline__ void shift8(const bf16_t* p, const float* mu, bool hp, bool hn, float (&z)[8]) {
    float x[8], xp[8], xn[8], m[8];
#pragma unroll
    for (int j = 0; j < 8; ++j) { xp[j] = 0.f; xn[j] = 0.f; }
    up8(p, x); if (hp) up8(p - RWP, xp); if (hn) up8(p + RWP, xn); ld8f(mu, m);
#pragma unroll
    for (int j = 0; j < 8; ++j) z[j] = x[j] + m[j] * (0.5f * (xp[j] + xn[j]) - x[j]);
}
__device__ __forceinline__ void rwkv_out_rows(CArgs& a, int l, int nrows, int gw, int ngw, int lane) {
    const bf16_t* RW = (const bf16_t*)(a.ws + WS_RW); const bf16_t* Y0 = (const bf16_t*)(a.ws + WS_H); bf16_t* Y1 = (bf16_t*)(a.ws + WS_Y1);
    const bf16_t* A0 = (const bf16_t*)(a.ws + WS_AA0); const bf16_t* A1 = (const bf16_t*)(a.ws + WS_AA1); const bf16_t* G = (const bf16_t*)(a.ws + WS_G);
    const float* mu = a.in[16] + l * 3488;
    for (int it = gw; it < 2 * nrows; it += ngw) {
        const int row = it >> 1, c0 = (it & 1) * 512 + 8 * lane;
        int t, Tn; if (row < ML) { t = row & 2047; Tn = 2048; } else { t = (row - ML) & 255; Tn = 256; }
        const bool hp = t > 0, hn = t < Tn - 1;
        const size_t idx = (size_t)row * 1024 + c0;
        float y[8], y1[8], g[8], a0[8], a1[8], zr[8], zk[8], zv[8], lnw[8], lnb[8], ka[8], rk[8];
        up8(Y0 + idx, y); up8(Y1 + idx, y1); up8(G + idx, g); up8(A0 + idx, a0); up8(A1 + idx, a1);
        const bf16_t* p = RW + (size_t)row * RWP + c0;
        shift8(p, mu + c0, hp, hn, zr); shift8(p + 1024, mu + 1024 + c0, hp, hn, zk); shift8(p + 2048, mu + 2048 + c0, hp, hn, zv);
        ld8f(a.in[25] + l * 1024 + c0, lnw); ld8f(a.in[26] + l * 1024 + c0, lnb); ld8f(a.in[23] + l * 1024 + c0, ka); ld8f(a.in[24] + l * 1024 + c0, rk);
        float sm = 0.f;
#pragma unroll
        for (int j = 0; j < 8; ++j) { y[j] += y1[j]; sm += y[j]; }
        const float mean = dpp_sum8(sm) * (1.f / 64.f);
        float sv = 0.f, sb = 0.f;
#pragma unroll
        for (int j = 0; j < 8; ++j) { y[j] -= mean; sv += y[j] * y[j]; const float kds = zk[j] * ((1.f + (a0[j] - 1.f) * ka[j]) + (1.f + (a1[j] - 1.f) * ka[j])); sb += zr[j] * kds * rk[j]; }
        const float rstd = rsqrtf(dpp_sum8(sv) * (1.f / 64.f) + 64e-5f), bsum = dpp_sum8(sb);
        u32x4 o;
#pragma unroll
        for (int j = 0; j < 4; ++j) o[j] = pkbf(((y[2 * j] * rstd * lnw[2 * j] + lnb[2 * j]) + bsum * zv[2 * j]) * g[2 * j], ((y[2 * j + 1] * rstd * lnw[2 * j + 1] + lnb[2 * j + 1]) + bsum * zv[2 * j + 1]) * g[2 * j + 1]);
        *(u32x4*)(Y1 + idx) = o;
    }
}

#define XB_TMO      128
#define XB_XCNT(j)  (256  + 64 * (j))
#define XB_XSUB(j)  (1280 + 64 * (j))
#define XB_XGEN(j)  (2304 + 64 * (j))
#define XB_TOP      3328
#define XB_TOPGEN   3392
#define XCD_BAR_WORDS 3456
#define XB_SPIN_CAP (1u << 20)

__device__ __forceinline__ unsigned xb_ld(unsigned* p)              { return __hip_atomic_load(p, __ATOMIC_RELAXED, __HIP_MEMORY_SCOPE_AGENT); }
__device__ __forceinline__ unsigned xb_add(unsigned* p, unsigned v) { return __hip_atomic_fetch_add(p, v, __ATOMIC_RELAXED, __HIP_MEMORY_SCOPE_AGENT); }
__device__ __forceinline__ unsigned xb_xcc_id() { return (unsigned)__builtin_amdgcn_s_getreg((3 << 11) | 20) & 0xFu; }
#define XB_SPIN(cond, bar) do { unsigned _sp = 0; while (cond) { __builtin_amdgcn_s_sleep(1); \
    if ((++_sp & 255u) == 0u) { if (xb_ld(&(bar)[XB_TMO])) break; if (_sp > XB_SPIN_CAP) { atomicAdd(&(bar)[XB_TMO], 1u); break; } } } } while (0)

struct XcdBarrier {
    unsigned* bar; unsigned x;
    volatile LAS unsigned* st;
};

__device__ __forceinline__ XcdBarrier xcd_barrier_post(unsigned* bar, volatile LAS unsigned* st) {
    XcdBarrier b; b.bar = bar; b.x = xb_xcc_id(); b.st = st;
    if (threadIdx.x == 0) (void)xb_add(&bar[XB_XCNT(b.x)], 1u);
    return b;
}
__device__ __forceinline__ void xcd_barrier_complete(unsigned* bar, unsigned x, unsigned& nloc, unsigned& nx) {
    const unsigned G = gridDim.x * gridDim.y * gridDim.z;
    unsigned sum, cnt, mine, sp = 0u;
    for (;;) {
        sum = 0u; cnt = 0u; mine = 0u;
#pragma unroll
        for (unsigned j = 0; j < 16; ++j) { const unsigned c = xb_ld(&bar[XB_XCNT(j)]); sum += c; cnt += (c > 0u) ? 1u : 0u; mine = (j == x) ? c : mine; }
        if (sum == G) break;
        __builtin_amdgcn_s_sleep(1);
        if ((++sp & 255u) == 0u) { if (xb_ld(&bar[XB_TMO])) break; if (sp > XB_SPIN_CAP) { atomicAdd(&bar[XB_TMO], 1u); break; } }
    }
    nloc = mine > 0u ? mine : 1u; nx = cnt > 0u ? cnt : 1u;
}

__device__ __forceinline__ void xcd_barrier(const XcdBarrier& b) {
    asm volatile("s_waitcnt vmcnt(0)" ::: "memory");
    __syncthreads();
    if (threadIdx.x == 0) {
        unsigned* bar = b.bar;
        __builtin_amdgcn_s_waitcnt(0);
        unsigned nloc = b.st[0], nx = b.st[1];
        if (nloc == 0u) { xcd_barrier_complete(bar, b.x, nloc, nx); b.st[0] = nloc; b.st[1] = nx; }
        const unsigned old = xb_add(&bar[XB_XSUB(b.x)], 1u);
        const unsigned gen = old / nloc;
        if (old + 1u == (gen + 1u) * nloc) {
            __builtin_amdgcn_fence(__ATOMIC_RELEASE, "agent");
            asm volatile("s_waitcnt vmcnt(0)" ::: "memory");
            const unsigned og = xb_add(&bar[XB_TOP], 1u);
            const unsigned tg = og / nx;
            if (og + 1u == (tg + 1u) * nx) xb_add(&bar[XB_TOPGEN], 1u);
            else XB_SPIN(xb_ld(&bar[XB_TOPGEN]) == tg, bar);
            __builtin_amdgcn_fence(__ATOMIC_ACQUIRE, "agent");
            xb_add(&bar[XB_XGEN(b.x)], 1u);
            asm volatile("s_waitcnt vmcnt(0)" ::: "memory");
        } else {
            XB_SPIN(xb_ld(&bar[XB_XGEN(b.x)]) == gen, bar);
            __builtin_amdgcn_fence(__ATOMIC_ACQUIRE, "agent");
            asm volatile("s_waitcnt vmcnt(0)" ::: "memory");
        }
    }
    __syncthreads();
}

#ifndef ONLY_PH
#define ONLY_PH -1
#endif
#ifndef SKIP_PH
#define SKIP_PH -2
#endif
#define PH_ON(k) ((ONLY_PH < 0 || ONLY_PH == (k)) && (k) != SKIP_PH)
__global__ void __launch_bounds__(512, 2) mega_fwd(Args a_) {
    extern __shared__ __attribute__((aligned(16))) unsigned char lds[];
    cg::grid_group grid = cg::this_grid();
    const int ph_lo = a_.lo, ph_hi = a_.hi;
    volatile LAS unsigned* bst = (volatile LAS unsigned*)((LAS unsigned char*)lds + 131072);
    if (threadIdx.x < 2) bst[threadIdx.x] = 0u;
    __syncthreads();
    const XcdBarrier xbar = xcd_barrier_post((unsigned*)(a_.ws + WS_BAR), bst);
    const int wave_s = __builtin_amdgcn_readfirstlane((int)threadIdx.x >> 6);
#pragma nounroll
    for (int ph = ph_lo; ph < ph_hi; ++ph) {
        CArgs* ap = (CArgs*)__builtin_amdgcn_kernarg_segment_ptr(); asm volatile("" : "+s"(ap));
        CArgs& a = *ap;
        unsigned char* ws = a.ws;
        float* XC = (float*)(ws + WS_XC);
        int wsv = wave_s; asm volatile("" : "+s"(wsv));
        TI ti; ti.tid = wsv * 64 + (int)__builtin_amdgcn_mbcnt_hi(~0u, __builtin_amdgcn_mbcnt_lo(~0u, 0u)); ti.bid = blockIdx.x; ti.nblk = gridDim.x;
        asm volatile("" : "+v"(ti.tid)); asm volatile("" : "+s"(ti.bid)); asm volatile("" : "+s"(ti.nblk));
        const int tid = ti.tid, lane = tid & 63, wv = __builtin_amdgcn_readfirstlane(tid >> 6);
        const int gw = ti.bid * 8 + wv, ngw = ti.nblk * 8;
        if (ph == 0) { if constexpr (PH_ON(100)) ph_mods(ti, a, lds); }
        else {
            const int l = (ph - 1) / NPH, k = (ph - 1) % NPH;
            const bool ctx_out = l < DEPTH - 1;
            const int Mr = ctx_out ? M : ML;
            const float* modl = (const float*)(ws + WS_MOD) + (size_t)l * 9 * 6144;
            const float* xl_in = l == 0 ? a.in[0] : a.out; const float* xc_in = l == 0 ? a.in[2] : XC;
            bf16_t* H = (bf16_t*)(ws + WS_H);
            switch (k) {
            case 0: if constexpr (PH_ON(0)) {
                norm_rows(xl_in, xc_in, a.in[6] + l * 1024, modl, 0, 1, H, M, gw, ngw, lane);
                ph_wconv(a, l, lds, gw, ngw, lane, wv);
                } break;
            case 1: if constexpr (PH_ON(1)) {
                OpIn op{(bf16_t*)(ws + WS_GU), (bf16_t*)(ws + WS_GV), (bf16_t*)(ws + WS_Q), (bf16_t*)(ws + WS_RW), (bf16_t*)(ws + WS_GT)};
                run_gemm(ti, lds, H, (const bf16_t*)(ws + WS_WIN), M, PPAD, 1024, op);
            } break;
            case 2: if constexpr (PH_ON(2)) {
                for (int u = ti.bid; u < Mr / 128; u += ti.nblk) gmlp_unit(ti, a, l, u, lds);
                qk_rows(a, l, gw, ngw, lane);
                lora_in_rows(a, l, gw, ngw, lane);
                } break;
            case 3: if constexpr (PH_ON(3)) {
                OpDec o1{(bf16_t*)(ws + WS_GV), (bf16_t*)(ws + WS_DEC1), a.in[17] + l * 2048};
                run_gemm(ti, lds, (const bf16_t*)(ws + WS_LIW), (const bf16_t*)(ws + WS_LWT), M, 2048, 128, o1);
                OpAA o2{(bf16_t*)(ws + WS_AA0), (bf16_t*)(ws + WS_AA1), a.in[19] + l * 2048};
                run_gemm(ti, lds, (const bf16_t*)(ws + WS_LIA), (const bf16_t*)(ws + WS_LAT), M, 2048, 128, o2);
                OpG o3{(bf16_t*)(ws + WS_G)};
                run_gemm(ti, lds, (const bf16_t*)(ws + WS_LIG), (const bf16_t*)(ws + WS_LGT), M, 1024, 256, o3);
            } break;
            case 4:
                if constexpr (PH_ON(4)) { for (int u = ti.bid; u < 256; u += ti.nblk) scan_unit_mfma(ti, a, l, u, ctx_out, lds); }
                if constexpr (PH_ON(40)) ph_attn(ti, a, l, ctx_out, lds);
                break;
            case 5: if constexpr (PH_ON(5)) {
                rwkv_out_rows(a, l, Mr, gw, ngw, lane);
                } break;
            case 6: if constexpr (PH_ON(6)) {
                const bf16_t* GT = (const bf16_t*)(ws + WS_GT); float* MF = (float*)(ws + WS_K);
                OpMerge<0> o0{GT, MF, H}; run_gemm(ti, lds, (const bf16_t*)(ws + WS_GU), (const bf16_t*)(ws + WS_WA), Mr, 1024, 1024, o0);
                OpMerge<1> o1{GT, MF, H}; run_gemm(ti, lds, (const bf16_t*)(ws + WS_Q), (const bf16_t*)(ws + WS_WB), Mr, 1024, 1024, o1);
                OpMerge<2> o2{GT, MF, H}; run_gemm(ti, lds, (const bf16_t*)(ws + WS_Y1), (const bf16_t*)(ws + WS_WC), Mr, 1024, 1024, o2);
            } break;
            case 7: if constexpr (PH_ON(7)) {
                OpResid op{xl_in, xc_in, a.out, XC, modl, 2};
                run_gemm(ti, lds, H, (const bf16_t*)(ws + WS_WO), Mr, 1024, 1024, op);
            } break;
            case 8: if constexpr (PH_ON(8)) {
                norm_rows(a.out, XC, a.in[7] + l * 1024, modl, 3, 4, H, Mr, gw, ngw, lane);
                } break;
            case 9: if constexpr (PH_ON(9)) {
                OpSwiglu op{(bf16_t*)(ws + WS_RW)};
                run_gemm(ti, lds, H, (const bf16_t*)(ws + WS_WI), Mr, 2 * DFF, 1024, op);
            } break;
            default: if constexpr (PH_ON(10)) {
                OpResid op{a.out, XC, a.out, XC, modl, 5};
                run_gemm(ti, lds, (const bf16_t*)(ws + WS_RW), (const bf16_t*)(ws + WS_WO2), Mr, 1024, DFF, op);
            } break;
            }
        }
        if (ph + 1 < ph_hi) { if (ph == ph_lo) grid.sync(); else xcd_barrier(xbar); }
    }
}

extern "C" void kernel_launch(void* const* d_in, const int* in_sizes, int n_in, void* d_out, int out_size, void* d_ws, size_t ws_size, hipStream_t stream) {
    static int grid = 0;
    if (grid == 0) {
        if (n_in != 33 || out_size != ML * D || ws_size < WS_END) { fprintf(stderr, "kernel_launch: unexpected shapes / workspace (%d inputs, out %d, ws %zu, need %zu)\n", n_in, out_size, ws_size, (size_t)WS_END); grid = -1; return; }
        int dev = 0, cus = 0, per_cu = 0;
        hipGetDevice(&dev); hipDeviceGetAttribute(&cus, hipDeviceAttributeMultiprocessorCount, dev);
        if (hipFuncSetAttribute((const void*)mega_fwd, hipFuncAttributeMaxDynamicSharedMemorySize, LDS_BYTES) != hipSuccess) { fprintf(stderr, "kernel_launch: hipFuncSetAttribute failed\n"); grid = -1; return; }
        if (hipOccupancyMaxActiveBlocksPerMultiprocessor(&per_cu, (const void*)mega_fwd, 512, LDS_BYTES) != hipSuccess || per_cu < 1) per_cu = 1;
        (void)hipGetLastError();
        grid = cus * 1;
    }
    if (grid < 0) return;
    Args a{};
    for (int i = 0; i < 33; ++i) a.in[i] = (const float*)d_in[i];
    a.out = (float*)d_out; a.ws = (unsigned char*)d_ws; a.lo = 0; a.hi = NPHASES;
    void* args[] = {&a};
    if (hipMemsetAsync((char*)d_ws + WS_BAR, 0, BAR_BYTES, stream) != hipSuccess) { fprintf(stderr, "kernel_launch: memset of barrier words failed\n"); return; }
    hipError_t e = hipLaunchCooperativeKernel((const void*)mega_fwd, dim3(grid), dim3(512), args, LDS_BYTES, stream);
    if (e != hipSuccess) fprintf(stderr, "kernel_launch: cooperative launch failed: %s (grid %d)\n", hipGetErrorString(e), grid);
}
```

```cpp
#include <hip/hip_runtime.h>
#include <hip/hip_cooperative_groups.h>
#include <cstdio>
#include <cstdint>
namespace cg = cooperative_groups;
namespace pg8 {
#define PG8_LAS __attribute__((address_space(3)))
typedef unsigned short bf16_t;
typedef short bf16x8 __attribute__((ext_vector_type(8)));
typedef float f32x4 __attribute__((ext_vector_type(4)));
typedef unsigned u32x4 __attribute__((ext_vector_type(4)));
constexpr int BM = 256, BK = 64, HALF = 128, HTB = HALF * BK * 2  , STAGE_BYTES = 8 * HTB, NXCD = 8, WGM = 8;

__host__ __device__ __forceinline__ int lds_byte(int r, int c) { const int st = (r >> 4) * 2 + (c >> 5), rr = r & 15, cc = c & 31, ob = rr * 64 + cc * 2; return st * 1024 + (ob ^ (((ob >> 9) & 1) << 5)); }
__host__ __device__ __forceinline__ void stage_rc(int b, int& R, int& C) { const int st = b / 1024, sb = b % 1024, swz = sb ^ (((sb >> 9) & 1) << 5); R = (st >> 1) * 16 + swz / 64; C = (st & 1) * 32 + (swz % 64) / 2; }
__host__ __device__ __forceinline__ int perm32(int rho) { const int n = rho >> 4, i = rho & 15; return 8 * (i >> 2) + 4 * n + (i & 3); }

struct Unit { int pm, pn; };
struct Gemm { const bf16_t* A; const bf16_t* Bt; int M, N, K; };

struct StaticOrder {
    int nM, nN, nwg, G, c;
    __host__ __device__ void init(int M, int N, int G_, int c_) { nM = M / BM; nN = N / BM; nwg = nM * nN; G = G_; c = c_; }
    __host__ __device__ bool next(int i, Unit& u) const {
        const long L = (long)i * G + c; if (L >= nwg) return false;
        int wgid = (int)L; { const int q = nwg / NXCD, r = nwg % NXCD, xcd = wgid % NXCD, off = wgid / NXCD; wgid = (xcd < r ? xcd * (q + 1) : r * (q + 1) + (xcd - r) * q) + off; }
        const int nig = WGM * nN, gid = wgid / nig, fm = gid * WGM, gsz = (nM - fm) < WGM ? (nM - fm) : WGM;
        u.pm = fm + ((wgid % nig) % gsz); u.pn = (wgid % nig) / gsz; return true;
    }
    __device__ __forceinline__ void a_ready(const Unit&) const {}
    __device__ __forceinline__ void done(const Unit&) const {}
};

__device__ __forceinline__ unsigned cvt_pk_bf16(float lo, float hi) { unsigned r; asm volatile("v_cvt_pk_bf16_f32 %0, %1, %2" : "=v"(r) : "v"(lo), "v"(hi)); return r; }
typedef float f32x2 __attribute__((ext_vector_type(2)));
__device__ __forceinline__ f32x2 gelu_pk(f32x2 v) {
    const f32x2 av = __builtin_elementwise_abs(v), d = av * 0.2316418882f + 1.0f;
    f32x2 t; t.x = __builtin_amdgcn_rcpf(d.x); t.y = __builtin_amdgcn_rcpf(d.y);
    f32x2 q = t * 0.5307027145f + (-0.7265760135f); q = q * t + 0.7107068705f; q = q * t + (-0.142248368f); q = q * t + 0.127414796f; q = q * t;
    const f32x2 s = (v * v) * (-0.72134752044f);
    f32x2 e; e.x = __builtin_amdgcn_exp2f(s.x); e.y = __builtin_amdgcn_exp2f(s.y);
    const f32x2 m = v * (q * e), r = v - m;
    f32x2 o; o.x = v.x < 0.f ? m.x : r.x; o.y = v.y < 0.f ? m.y : r.y; return o;
}

template <class Epi, class Sched, bool ALIGN_EPI = false, bool SP2 = false>
__device__ __forceinline__ void gemm_phase(PG8_LAS unsigned char* lds, const Gemm g, const Sched& S, const Epi& E, const int tid_in) {
    const int tid = tid_in, wid = __builtin_amdgcn_readfirstlane(tid >> 6), lane = tid & 63, wr = wid >> 2, wc = wid & 3, fr = lane & 15, fq = lane >> 4;
    const int K = g.K, nt = K / BK;
    unsigned voffA[2], voffB[2];
#pragma unroll
    for (int i = 0; i < 2; ++i) { int R, C; stage_rc(tid * 16 + i * 8192, R, C); const int Rb = Epi::PERM ? ((R & ~31) + perm32(R & 31)) : R;
        voffA[i] = (unsigned)(R * K + C) * 2u; voffB[i] = (unsigned)(Rb * K + C) * 2u; }
    const size_t kstep = (size_t)(BK * 2);
    const size_t hstep = (size_t)HALF * K * 2;
    const size_t tstep = 2 * hstep;
    const unsigned ldsw = (unsigned)wid * 1024u;
    const int aoff = lds_byte(wr * 64 + fr, fq * 8), boff = lds_byte(wc * 32 + fr, fq * 8);
#define PG8_SA(b, h) (((b) * 2 + (h)) * HTB)
#define PG8_SB(b, h) ((4 + (b) * 2 + (h)) * HTB)
#define PG8_STAGE(bufoff, gbase, voff) do { _Pragma("unroll") for (int _i = 0; _i < 2; ++_i) \
        __builtin_amdgcn_global_load_lds((const unsigned*)((const char*)(gbase) + (voff)[_i]), (PG8_LAS unsigned*)(lds + (bufoff) + ldsw + _i * 8192), 16, 0, 0); } while (0)
#define PG8_LDA(dst, b, h) do { _Pragma("unroll") for (int m = 0; m < 4; ++m) _Pragma("unroll") for (int k = 0; k < 2; ++k) dst[m][k] = *(const PG8_LAS bf16x8*)(lds + PG8_SA(b, h) + aoff + m * 2048 + k * 1024); } while (0)
#define PG8_LDB(dst, b, h) do { _Pragma("unroll") for (int n = 0; n < 2; ++n) _Pragma("unroll") for (int k = 0; k < 2; ++k) dst[n][k] = *(const PG8_LAS bf16x8*)(lds + PG8_SB(b, h) + boff + n * 2048 + k * 1024); } while (0)
#define PG8_MMA(ai, bj, At, Bt) do { __builtin_amdgcn_s_setprio(1); _Pragma("unroll") for (int m = 0; m < 4; ++m) _Pragma("unroll") for (int n = 0; n < 2; ++n) _Pragma("unroll") for (int k = 0; k < 2; ++k) \
        acc[ai][bj][m][n] = __builtin_amdgcn_mfma_f32_16x16x32_bf16(Bt[n][k], At[m][k], acc[ai][bj][m][n], 0, 0, 0); __builtin_amdgcn_s_setprio(0); } while (0)
#define PG8_WAIT_V(n) asm volatile("s_waitcnt vmcnt(" #n ")" ::: "memory")
#define PG8_WAIT_L(n) asm volatile("s_waitcnt lgkmcnt(" #n ")" ::: "memory")
#define PG8_BAR __builtin_amdgcn_s_barrier()
#define PG8_SCHED __builtin_amdgcn_sched_barrier(0)
    Unit cur, nxt; int ui = 0;
    if (!S.next(0, cur)) return;
    f32x4 acc[2][2][4][2];
#pragma unroll
    for (int a = 0; a < 2; ++a)
#pragma unroll
        for (int b = 0; b < 2; ++b)
#pragma unroll
            for (int m = 0; m < 4; ++m)
#pragma unroll
                for (int n = 0; n < 2; ++n) acc[a][b][m][n] = (f32x4){0.f, 0.f, 0.f, 0.f};
    bf16x8 At[4][2], B0[2][2], B1[2][2];
    const char* cA = (const char*)g.A + (size_t)cur.pm * tstep; const char* cB = (const char*)g.Bt + (size_t)cur.pn * tstep;
    S.a_ready(cur);
    if constexpr (SP2) {
        PG8_STAGE(PG8_SB(0, 0), cB, voffB); PG8_STAGE(PG8_SB(0, 1), cB + hstep, voffB); PG8_STAGE(PG8_SA(0, 0), cA, voffA); PG8_STAGE(PG8_SA(0, 1), cA + hstep, voffA);
        if (wr == 1) PG8_BAR;
        PG8_WAIT_V(2); PG8_BAR;
        PG8_STAGE(PG8_SB(1, 0), cB + kstep, voffB); PG8_STAGE(PG8_SA(1, 0), cA + kstep, voffA); PG8_STAGE(PG8_SB(1, 1), cB + hstep + kstep, voffB);
        PG8_WAIT_V(6); PG8_BAR;
    } else {
        PG8_STAGE(PG8_SB(0, 0), cB, voffB); PG8_STAGE(PG8_SA(0, 0), cA, voffA); PG8_STAGE(PG8_SB(0, 1), cB + hstep, voffB); PG8_STAGE(PG8_SA(0, 1), cA + hstep, voffA);
        if (wr == 1) PG8_BAR;
        PG8_WAIT_V(4); PG8_BAR;
        PG8_STAGE(PG8_SB(1, 0), cB + kstep, voffB); PG8_STAGE(PG8_SA(1, 0), cA + kstep, voffA); PG8_STAGE(PG8_SB(1, 1), cB + hstep + kstep, voffB);
        PG8_WAIT_V(6); PG8_BAR;
    }
    for (;;) {
        const bool has_next = S.next(ui + 1, nxt);
        const char* nA = has_next ? (const char*)g.A + (size_t)nxt.pm * tstep : cA; const char* nB = has_next ? (const char*)g.Bt + (size_t)nxt.pn * tstep : cB;
        for (int t = 0; t < nt; t += 2) {
            const bool last = (t == nt - 2);
            const char* a1 = cA + (size_t)(t + 1) * kstep;
            const char* a2 = last ? nA : cA + (size_t)(t + 2) * kstep; const char* b2 = last ? nB : cB + (size_t)(t + 2) * kstep;
            const char* a3 = a2 + kstep; const char* b3 = b2 + kstep;
            if (last && has_next) S.a_ready(nxt);
            if constexpr (SP2) {
            PG8_LDB(B0, 0, 0); PG8_LDB(B1, 0, 1); PG8_SCHED; PG8_LDA(At, 0, 0); PG8_STAGE(PG8_SA(1, 1), a1 + hstep, voffA);
            PG8_WAIT_V(8); PG8_WAIT_L(0); PG8_BAR; PG8_MMA(0, 0, At, B0); PG8_MMA(0, 1, At, B1); PG8_BAR; PG8_SCHED;
            PG8_LDA(At, 0, 1); PG8_STAGE(PG8_SB(0, 0), b2, voffB); PG8_STAGE(PG8_SB(0, 1), b2 + hstep, voffB); PG8_STAGE(PG8_SA(0, 0), a2, voffA);
            PG8_WAIT_V(8); PG8_WAIT_L(0); PG8_BAR; PG8_MMA(1, 0, At, B0); PG8_MMA(1, 1, At, B1); PG8_BAR; PG8_SCHED;
            PG8_LDB(B0, 1, 0); PG8_LDB(B1, 1, 1); PG8_SCHED; PG8_LDA(At, 1, 0); PG8_STAGE(PG8_SA(0, 1), a2 + hstep, voffA);
            PG8_WAIT_V(8); PG8_WAIT_L(0); PG8_BAR; PG8_MMA(0, 0, At, B0); PG8_MMA(0, 1, At, B1); PG8_BAR; PG8_SCHED;
            PG8_LDA(At, 1, 1); PG8_STAGE(PG8_SB(1, 0), b3, voffB); PG8_STAGE(PG8_SB(1, 1), b3 + hstep, voffB); PG8_STAGE(PG8_SA(1, 0), a3, voffA);
            PG8_WAIT_V(8); PG8_WAIT_L(0); PG8_BAR; PG8_MMA(1, 0, At, B0); PG8_MMA(1, 1, At, B1); PG8_BAR; PG8_SCHED;
            } else {
            PG8_LDB(B0, 0, 0); PG8_SCHED; PG8_LDA(At, 0, 0); PG8_STAGE(PG8_SA(1, 1), a1 + hstep, voffA);
            PG8_WAIT_L(8); PG8_BAR; PG8_WAIT_L(0); PG8_MMA(0, 0, At, B0); PG8_BAR; PG8_SCHED;
            PG8_LDB(B1, 0, 1); PG8_STAGE(PG8_SB(0, 0), b2, voffB);
            PG8_BAR; PG8_WAIT_L(0); PG8_MMA(0, 1, At, B1); PG8_BAR;
            PG8_LDA(At, 0, 1); PG8_STAGE(PG8_SA(0, 0), a2, voffA);
            PG8_BAR; PG8_WAIT_L(0); PG8_MMA(1, 0, At, B0); PG8_BAR; PG8_SCHED;
            PG8_STAGE(PG8_SB(0, 1), b2 + hstep, voffB);
            PG8_WAIT_V(6); PG8_BAR; PG8_MMA(1, 1, At, B1); PG8_BAR;
            PG8_LDB(B0, 1, 0); PG8_SCHED; PG8_LDA(At, 1, 0); PG8_STAGE(PG8_SA(0, 1), a2 + hstep, voffA);
            PG8_WAIT_L(8); PG8_BAR; PG8_WAIT_L(0); PG8_MMA(0, 0, At, B0); PG8_BAR; PG8_SCHED;
            PG8_LDB(B1, 1, 1); PG8_STAGE(PG8_SB(1, 0), b3, voffB);
            PG8_BAR; PG8_WAIT_L(0); PG8_MMA(0, 1, At, B1); PG8_BAR;
            PG8_LDA(At, 1, 1); PG8_STAGE(PG8_SA(1, 0), a3, voffA);
            PG8_BAR; PG8_WAIT_L(0); PG8_MMA(1, 0, At, B0); PG8_BAR; PG8_SCHED;
            PG8_STAGE(PG8_SB(1, 1), b3 + hstep, voffB);
            PG8_WAIT_V(6); PG8_BAR; PG8_MMA(1, 1, At, B1); PG8_BAR;
            }
        }
        if constexpr (ALIGN_EPI) { if (wr == 0) PG8_BAR; }
        if constexpr (!Epi::AFTER_DRAIN) { E(acc, cur, wr, wc, fr, fq); S.done(cur); }
        if (!has_next) break;
#pragma unroll
        for (int a = 0; a < 2; ++a)
#pragma unroll
            for (int b = 0; b < 2; ++b)
#pragma unroll
                for (int m = 0; m < 4; ++m)
#pragma unroll
                    for (int n = 0; n < 2; ++n) acc[a][b][m][n] = (f32x4){0.f, 0.f, 0.f, 0.f};
        cur = nxt; cA = nA; cB = nB; ++ui;
        if constexpr (ALIGN_EPI) { if (wr == 1) PG8_BAR; }
    }
    PG8_WAIT_V(0);
    if constexpr (!ALIGN_EPI) { if (wr == 0) PG8_BAR; }
    PG8_BAR;
    if constexpr (Epi::AFTER_DRAIN) { E.fused(acc, cur, wr, wc, fr, fq, lds, wid, lane); S.done(cur); }
#undef PG8_SA
#undef PG8_SB
#undef PG8_STAGE
#undef PG8_LDA
#undef PG8_LDB
#undef PG8_MMA
#undef PG8_WAIT_V
#undef PG8_WAIT_L
#undef PG8_BAR
#undef PG8_SCHED
}
}

#define LAS __attribute__((address_space(3)))
typedef unsigned short bf16_t;
typedef float f32x2 __attribute__((ext_vector_type(2)));
typedef float f32x4 __attribute__((ext_vector_type(4)));
typedef float f32x16 __attribute__((ext_vector_type(16)));
typedef short bf16x8 __attribute__((ext_vector_type(8)));
typedef short s16x4 __attribute__((ext_vector_type(4)));
typedef unsigned u32x4 __attribute__((ext_vector_type(4)));
typedef unsigned u32x2 __attribute__((ext_vector_type(2)));
typedef __bf16 bf16x2v __attribute__((ext_vector_type(2)));
#define MFMA32(a, b, c) __builtin_amdgcn_mfma_f32_32x32x16_bf16((a), (b), (c), 0, 0, 0)

constexpr int D = 1024, NB = 8, TL = 2048, TCX = 256, DEPTH = 4;
constexpr int ML = NB * TL, MC = NB * TCX, M = ML + MC;
constexpr int PPAD = 11776, RWP = 3584, DFF = 2816;
constexpr int NPH = 11, NPHASES = 1 + DEPTH * NPH;
constexpr size_t MiB = 1u << 20;
constexpr size_t WS_MOD = 0, WS_WIN = 1 * MiB, WS_WA = 24 * MiB, WS_WB = 26 * MiB, WS_WC = 28 * MiB, WS_WO = 30 * MiB, WS_WI = 32 * MiB, WS_WO2 = 43 * MiB,
                 WS_LWT = 48 * MiB + MiB / 2, WS_LAT = 49 * MiB, WS_LGT = 49 * MiB + MiB / 2, WS_H = 50 * MiB, WS_XC = 86 * MiB, WS_GU = 94 * MiB, WS_GV = 130 * MiB,
                 WS_Q = 166 * MiB, WS_K = 202 * MiB, WS_V = 238 * MiB, WS_RW = 274 * MiB, WS_GT = 400 * MiB, WS_LIW = 508 * MiB, WS_LIA = 512 * MiB + MiB / 2,
                 WS_LIG = 517 * MiB, WS_DEC1 = 526 * MiB, WS_AA0 = 562 * MiB, WS_AA1 = 598 * MiB, WS_G = 634 * MiB, WS_Y1 = 670 * MiB, WS_ROPE = 706 * MiB, WS_END = 707 * MiB;
constexpr int LDS_BYTES = 131072 + 1024;
constexpr size_t WS_BAR = 917504, BAR_BYTES = 16384;
constexpr float QSCALE = 0.125f * 1.4426950408889634f;

struct Args { const float* in[33]; float* out; unsigned char* ws; int lo, hi; };
typedef const __attribute__((address_space(4))) Args CArgs;
struct TI { int tid, bid, nblk; };

__device__ __forceinline__ float bf2f(unsigned v) { return __uint_as_float(v << 16); }
__device__ __forceinline__ unsigned pkbf(float lo, float hi) { f32x2 v = {lo, hi}; bf16x2v b = __builtin_convertvector(v, bf16x2v); return __builtin_bit_cast(unsigned, b); }
__device__ __forceinline__ bf16_t f2bf(float f) { return (bf16_t)(pkbf(f, 0.f) & 0xffffu); }
#define DPP_ADD(x, ctrl) ((x) + __builtin_bit_cast(float, __builtin_amdgcn_update_dpp(0, __builtin_bit_cast(int, (x)), (ctrl), 0xf, 0xf, true)))
__device__ __forceinline__ float wave_sum(float v) {
    v = DPP_ADD(v, 0xB1); v = DPP_ADD(v, 0x4E); v = DPP_ADD(v, 0x141); v = DPP_ADD(v, 0x140);
    const int iv = __builtin_bit_cast(int, v);
    const float s0 = __builtin_bit_cast(float, __builtin_amdgcn_readlane(iv, 0)), s1 = __builtin_bit_cast(float, __builtin_amdgcn_readlane(iv, 16)),
                s2 = __builtin_bit_cast(float, __builtin_amdgcn_readlane(iv, 32)), s3 = __builtin_bit_cast(float, __builtin_amdgcn_readlane(iv, 48));
    return (s0 + s1) + (s2 + s3);
}
__device__ __forceinline__ float dpp_sum8(float x) {
    x += __builtin_bit_cast(float, __builtin_amdgcn_update_dpp(0, __builtin_bit_cast(int, x), 0xB1, 0xf, 0xf, true));
    x += __builtin_bit_cast(float, __builtin_amdgcn_update_dpp(0, __builtin_bit_cast(int, x), 0x4E, 0xf, 0xf, true));
    x += __builtin_bit_cast(float, __builtin_amdgcn_update_dpp(0, __builtin_bit_cast(int, x), 0x141, 0xf, 0xf, true));
    return x;
}
__device__ __forceinline__ float quad_sum(float x) { x = DPP_ADD(x, 0xB1); x = DPP_ADD(x, 0x4E); return x; }
__device__ __forceinline__ float quad_xor2(float x) { return __builtin_bit_cast(float, __builtin_amdgcn_update_dpp(0, __builtin_bit_cast(int, x), 0x4E, 0xf, 0xf, true)); }
__device__ __forceinline__ void unpack16(const bf16_t* p, float (&x)[16]) {
    const u32x4 a = *(const u32x4*)p, b = *(const u32x4*)(p + 8);
#pragma unroll
    for (int i = 0; i < 4; ++i) { x[2 * i] = bf2f(a[i] & 0xffffu); x[2 * i + 1] = bf2f(a[i] >> 16); x[8 + 2 * i] = bf2f(b[i] & 0xffffu); x[8 + 2 * i + 1] = bf2f(b[i] >> 16); }
}
__device__ __forceinline__ void pack16(bf16_t* p, const float (&x)[16]) {
    u32x4 a, b;
#pragma unroll
    for (int i = 0; i < 4; ++i) { a[i] = pkbf(x[2 * i], x[2 * i + 1]); b[i] = pkbf(x[8 + 2 * i], x[8 + 2 * i + 1]); }
    *(u32x4*)p = a; *(u32x4*)(p + 8) = b;
}
__device__ __forceinline__ void load16f(const float* p, float (&x)[16]) {
#pragma unroll
    for (int i = 0; i < 4; ++i) { const f32x4 v = *(const f32x4*)(p + 4 * i); x[4 * i] = v.x; x[4 * i + 1] = v.y; x[4 * i + 2] = v.z; x[4 * i + 3] = v.w; }
}
__device__ __forceinline__ float sigmoidf_(float x) { return 1.f / (1.f + __expf(-x)); }

typedef const __attribute__((address_space(1))) bf16_t* gcptr_t;
__device__ __forceinline__ gcptr_t uniptr(const bf16_t* p) {
    const unsigned long long v = (unsigned long long)p;
    const unsigned lo = __builtin_amdgcn_readfirstlane((unsigned)v), hi = __builtin_amdgcn_readfirstlane((unsigned)(v >> 32));
    return (gcptr_t)(((unsigned long long)hi << 32) | lo);
}
template <class Op> struct EpiT {
    static constexpr bool PERM = true, AFTER_DRAIN = false;
    Op op;
    __device__ __forceinline__ void operator()(const pg8::f32x4 (&acc)[2][2][4][2], const pg8::Unit& u, int wr, int wc, int fr, int fq) const {
        const int row0 = u.pm * 256 + wr * 64 + fr, col0 = u.pn * 256 + wc * 32 + 8 * fq;
#pragma unroll
        for (int ai = 0; ai < 2; ++ai)
#pragma unroll
            for (int m = 0; m < 4; ++m)
#pragma unroll
                for (int bj = 0; bj < 2; ++bj) { op(row0 + ai * 128 + m * 16, col0 + bj * 128, acc[ai][bj][m][0], acc[ai][bj][m][1]); asm volatile("" ::: "memory"); }
    }
};
__device__ __forceinline__ u32x4 pack8(f32x4 v0, f32x4 v1) { u32x4 o; o.x = pkbf(v0.x, v0.y); o.y = pkbf(v0.z, v0.w); o.z = pkbf(v1.x, v1.y); o.w = pkbf(v1.z, v1.w); return o; }
__device__ __forceinline__ void unpack8(u32x4 x, f32x4& v0, f32x4& v1) {
    v0.x = bf2f(x.x & 0xffffu); v0.y = bf2f(x.x >> 16); v0.z = bf2f(x.y & 0xffffu); v0.w = bf2f(x.y >> 16);
    v1.x = bf2f(x.z & 0xffffu); v1.y = bf2f(x.z >> 16); v1.z = bf2f(x.w & 0xffffu); v1.w = bf2f(x.w >> 16);
}
__device__ __forceinline__ f32x4 gelu4(f32x4 v) { pg8::f32x2 a = pg8::gelu_pk((pg8::f32x2){v.x, v.y}), b = pg8::gelu_pk((pg8::f32x2){v.z, v.w}); return (f32x4){a.x, a.y, b.x, b.y}; }
__device__ __forceinline__ f32x4 sig4(f32x4 v) { return (f32x4){sigmoidf_(v.x), sigmoidf_(v.y), sigmoidf_(v.z), sigmoidf_(v.w)}; }

struct OpIn {
    bf16_t *GU, *GV, *Q, *RW, *GT;
    __device__ __forceinline__ void operator()(int row, int col, f32x4 v0, f32x4 v1) const {
        bf16_t* dst;
        if (col < 2048) { v0 = gelu4(v0); v1 = gelu4(v1); dst = (col < 1024 ? GU : GV) + (size_t)row * 1024 + (col & 1023); }
        else if (col < 5120) { const int q = col - 2048; dst = Q + (size_t)(q >> 10) * (size_t)(18 * MiB) + (size_t)row * 1024 + (q & 1023); }
        else if (col < 8704) { dst = RW + (size_t)row * RWP + (col - 5120); }
        else { v0 = sig4(v0); v1 = sig4(v1); dst = GT + (size_t)row * 3072 + (col - 8704); }
        *(u32x4*)dst = pack8(v0, v1);
    }
};
struct OpDec {
    bf16_t *D0, *D1; const float* w0;
    __device__ __forceinline__ float f(float x) const { return -0.6065306597126334f * sigmoidf_(x); }
    __device__ __forceinline__ void operator()(int row, int col, f32x4 v0, f32x4 v1) const {
        const f32x4 b0 = *(const f32x4*)(w0 + col), b1 = *(const f32x4*)(w0 + col + 4);
        v0 += b0; v1 += b1;
        v0 = (f32x4){f(v0.x), f(v0.y), f(v0.z), f(v0.w)}; v1 = (f32x4){f(v1.x), f(v1.y), f(v1.z), f(v1.w)};
        bf16_t* dst = (col < 1024 ? D0 : D1) + (size_t)row * 1024 + (col & 1023);
        *(u32x4*)dst = pack8(v0, v1);
    }
};
struct OpAA {
    bf16_t *A0, *A1; const float* a0;
    __device__ __forceinline__ void operator()(int row, int col, f32x4 v0, f32x4 v1) const {
        const f32x4 b0 = *(const f32x4*)(a0 + col), b1 = *(const f32x4*)(a0 + col + 4);
        v0 = sig4(v0 + b0); v1 = sig4(v1 + b1);
        bf16_t* dst = (col < 1024 ? A0 : A1) + (size_t)row * 1024 + (col & 1023);
        *(u32x4*)dst = pack8(v0, v1);
    }
};
struct OpG {
    bf16_t* G;
    __device__ __forceinline__ void operator()(int row, int col, f32x4 v0, f32x4 v1) const { *(u32x4*)(G + (size_t)row * 1024 + col) = pack8(v0, v1); }
};
template <int KB> struct OpMerge {
    const bf16_t* GT; float* MF; bf16_t* MB;
    __device__ __forceinline__ void operator()(int row, int col, f32x4 v0, f32x4 v1) const {
        f32x4 g0, g1; unpack8(*(const u32x4*)(GT + (size_t)row * 3072 + KB * 1024 + col), g0, g1);
        float* mf = MF + (size_t)row * 1024 + col;
        f32x4 r0 = g0 * v0, r1 = g1 * v1;
        if (KB > 0) { r0 += *(const f32x4*)mf; r1 += *(const f32x4*)(mf + 4); }
        if (KB < 2) { *(f32x4*)mf = r0; *(f32x4*)(mf + 4) = r1; }
        else *(u32x4*)(MB + (size_t)row * 1024 + col) = pack8(r0, r1);
    }
};
struct OpResid {
    const float *xl, *xc; float *ol, *oc; const float* mod; int gi;
    __device__ __forceinline__ void operator()(int row, int col, f32x4 v0, f32x4 v1) const {
        const float* xi; float* xo; const float* g;
        if (row < ML) { xi = xl + (size_t)row * 1024 + col; xo = ol + (size_t)row * 1024 + col; g = mod + (size_t)(row >> 11) * 6144 + gi * 1024 + col; }
        else { const size_t rr = (size_t)(row - ML) * 1024 + col; xi = xc + rr; xo = oc + rr; g = mod + (size_t)8 * 6144 + gi * 1024 + col; }
        const f32x4 x0 = *(const f32x4*)xi, x1 = *(const f32x4*)(xi + 4), g0 = *(const f32x4*)g, g1 = *(const f32x4*)(g + 4);
        *(f32x4*)xo = x0 + g0 * v0; *(f32x4*)(xo + 4) = x1 + g1 * v1;
    }
};
struct OpSwiglu {
    bf16_t* HID;
    __device__ __forceinline__ void operator()(int row, int col, f32x4 v0, f32x4 v1) const {
        const float h0 = v0.x * sigmoidf_(v0.x) * v0.y, h1 = v0.z * sigmoidf_(v0.z) * v0.w, h2 = v1.x * sigmoidf_(v1.x) * v1.y, h3 = v1.z * sigmoidf_(v1.z) * v1.w;
        u32x2 o; o.x = pkbf(h0, h1); o.y = pkbf(h2, h3);
        *(u32x2*)(HID + (size_t)row * DFF + (col >> 1)) = o;
    }
};
template <class Op> __device__ __forceinline__ void run_gemm(const TI ti, unsigned char* lds, const bf16_t* A, const bf16_t* Bt, int Mr, int N, int K, const Op& op) {
    int Kv = K; asm volatile("" : "+s"(Kv));
    pg8::Gemm g{A, Bt, Mr, N, Kv}; pg8::StaticOrder S; S.init(Mr, N, ti.nblk, ti.bid);
    EpiT<Op> E{op};
    pg8::gemm_phase<EpiT<Op>, pg8::StaticOrder, true, true>((PG8_LAS unsigned char*)lds, g, S, E, ti.tid);
}

__device__ __forceinline__ void ph_mods(const TI ti, CArgs& a, unsigned char* ldsg) {
    float* sc = (float*)ldsg; float* part = sc + 9 * 1024;
    const int tid = ti.tid, lane = tid & 63, w = tid >> 6;
    for (int i = tid; i < 9 * 1024; i += 512) { const float v = (i < 8192) ? a.in[1][i] : a.in[3][i - 8192]; sc[i] = v / (1.f + expf(-v)); }
    __syncthreads();
    float* MOD = (float*)(a.ws + WS_MOD);
    for (int item = ti.bid; item < DEPTH * 96; item += ti.nblk) {
        const int l = item / 96, n0 = (item % 96) * 64;
        const float* W = a.in[4] + (size_t)l * 1024 * 6144 + n0 + lane;
        float acc[9];
#pragma unroll
        for (int r = 0; r < 9; ++r) acc[r] = 0.f;
#pragma unroll 8
        for (int k = w * 128; k < w * 128 + 128; ++k) {
            const float wv = W[(size_t)k * 6144];
#pragma unroll
            for (int r = 0; r < 9; ++r) acc[r] += sc[r * 1024 + k] * wv;
        }
#pragma unroll
        for (int r = 0; r < 9; ++r) part[(w * 9 + r) * 64 + lane] = acc[r];
        __syncthreads();
        for (int idx = tid; idx < 576; idx += 512) {
            const int r = idx >> 6, ln = idx & 63; float s = a.in[5][l * 6144 + n0 + ln];
            for (int ww = 0; ww < 8; ++ww) s += part[(ww * 9 + r) * 64 + ln];
            MOD[((size_t)l * 9 + r) * 6144 + n0 + ln] = s;
        }
        __syncthreads();
    }
    float* RC = (float*)(a.ws + WS_ROPE); float* RS = RC + 2048 * 32;
    for (int idx = ti.bid * 512 + tid; idx < 2048 * 32; idx += ti.nblk * 512) {
        const int t = idx >> 5, i = idx & 31; const float pos = i < 16 ? (float)(t >> 6) : (float)(t & 63);
        const float ang = pos * exp2f(-(float)(i & 15) * (13.287712379549449f / 16.f));
        RC[idx] = cosf(ang); RS[idx] = sinf(ang);
    }
}

__device__ __forceinline__ void norm_rows(const float* xl, const float* xc, const float* g, const float* modl, int shi, int sci, bf16_t* H, int nrows, int gw, int ngw, int lane) {
    for (int row = gw; row < nrows; row += ngw) {
        const float* src; int r;
        if (row < ML) { src = xl + (size_t)row * D; r = row >> 11; } else { src = xc + (size_t)(row - ML) * D; r = 8; }
        const float* md = modl + (size_t)r * 6144;
        f32x4 v[4]; float ss = 0.f;
#pragma unroll
        for (int j = 0; j < 4; ++j) { v[j] = *(const f32x4*)(src + 4 * lane + 256 * j); ss += (v[j].x * v[j].x + v[j].y * v[j].y) + (v[j].z * v[j].z + v[j].w * v[j].w); }
        ss = wave_sum(ss);
        const float rstd = rsqrtf(ss * (1.f / 1024.f) + 1e-6f);
#pragma unroll
        for (int j = 0; j < 4; ++j) {
            const int c = 4 * lane + 256 * j;
            const f32x4 gg = *(const f32x4*)(g + c), scv = *(const f32x4*)(md + sci * 1024 + c), shv = *(const f32x4*)(md + shi * 1024 + c);
            const f32x4 o = v[j] * rstd * gg * (1.f + scv) + shv;
            u32x2 p; p.x = pkbf(o.x, o.y); p.y = pkbf(o.z, o.w);
            *(u32x2*)(H + (size_t)row * D + c) = p;
        }
    }
}

template <int MODE> __device__ __forceinline__ void transpose_item(const float* W, int K, int N, bf16_t* WT, LAS float* scr, int item, int lane) {
    const int nblk = N / 32, kb = item / nblk, nb = item % nblk, k0 = 64 * kb, n0 = 32 * nb;
#pragma unroll 8
    for (int i = 0; i < 32; ++i) { const int kk = 2 * i + (lane >> 5); scr[kk * 33 + (lane & 31)] = W[(size_t)(k0 + kk) * N + n0 + (lane & 31)]; }
    asm volatile("s_waitcnt lgkmcnt(0)" ::: "memory");
    const int c = lane & 7;
#pragma unroll
    for (int j = 0; j < 4; ++j) {
        const int n = (lane >> 3) + 8 * j, gn = n0 + n; const LAS float* s = scr + (8 * c) * 33 + n;
        const int drow = MODE == 0 ? gn : (MODE == 1 ? (gn >= 8608 ? gn + 96 : gn) : (gn < DFF ? 2 * gn : 2 * (gn - DFF) + 1));
        u32x4 o; o.x = pkbf(s[0 * 33], s[1 * 33]); o.y = pkbf(s[2 * 33], s[3 * 33]); o.z = pkbf(s[4 * 33], s[5 * 33]); o.w = pkbf(s[6 * 33], s[7 * 33]);
        *(u32x4*)(WT + (size_t)drow * K + k0 + 8 * c) = o;
    }
    asm volatile("s_waitcnt lgkmcnt(0)" ::: "memory");
}
__device__ __forceinline__ void ph_wconv(CArgs& a, int l, unsigned char* ldsg, int gw, int ngw, int lane, int wv, int mask) {
    LAS float* scr = (LAS float*)(ldsg + wv * 8704);
    unsigned char* ws = a.ws;
    constexpr int I_IN = 16 * 365, I_SQ = 16 * 32, I_WI = 16 * 176, I_WO = 44 * 32;
    if (mask & 1) for (int it = gw; it < I_IN; it += ngw) transpose_item<1>(a.in[8] + (size_t)l * 1024 * 11680, 1024, 11680, (bf16_t*)(ws + WS_WIN), scr, it, lane);
    if (mask & 2) for (int it = gw; it < 3 * I_SQ; it += ngw) { const int wh = it / I_SQ; transpose_item<0>(a.in[27 + wh] + (size_t)l * 1048576, 1024, 1024, (bf16_t*)(ws + WS_WA + (size_t)wh * 2 * MiB), scr, it % I_SQ, lane); }
    if (mask & 4) for (int it = gw; it < I_SQ; it += ngw) transpose_item<0>(a.in[30] + (size_t)l * 1048576, 1024, 1024, (bf16_t*)(ws + WS_WO), scr, it, lane);
    if (mask & 8) for (int it = gw; it < I_WI; it += ngw) transpose_item<2>(a.in[31] + (size_t)l * 1024 * 5632, 1024, 5632, (bf16_t*)(ws + WS_WI), scr, it, lane);
    if (mask & 16) for (int it = gw; it < I_WO; it += ngw) transpose_item<0>(a.in[32] + (size_t)l * DFF * 1024, DFF, 1024, (bf16_t*)(ws + WS_WO2), scr, it, lane);
    if (!(mask & 1)) return;
    const int gt = gw * 64 + lane, ngt = ngw * 64;
    bf16_t* LWT = (bf16_t*)(ws + WS_LWT); bf16_t* LAT = (bf16_t*)(ws + WS_LAT); bf16_t* LGT = (bf16_t*)(ws + WS_LGT);
    const float* w2 = a.in[18] + (size_t)l * 2 * 64 * 1024; const float* a2 = a.in[20] + (size_t)l * 2 * 64 * 1024; const float* g2 = a.in[21] + (size_t)l * 160 * 1024;
    for (int i = gt; i < 2048 * 128; i += ngt) {
        const int n = i >> 7, k = i & 127, d = n >> 10, c = n & 1023, kk = k - d * 64;
        const bool in = (kk >= 0 && kk < 64);
        LWT[i] = in ? f2bf(w2[((size_t)d * 64 + kk) * 1024 + c]) : (bf16_t)0;
        LAT[i] = in ? f2bf(a2[((size_t)d * 64 + kk) * 1024 + c]) : (bf16_t)0;
    }
    for (int i = gt; i < 1024 * 256; i += ngt) { const int n = i >> 8, k = i & 255; LGT[i] = k < 160 ? f2bf(g2[(size_t)k * 1024 + n]) : (bf16_t)0; }
    bf16_t* WIN = (bf16_t*)(ws + WS_WIN);
    for (int i = gt; i < 96 * 1024; i += ngt) WIN[(size_t)8608 * 1024 + i] = 0;
}

__device__ __forceinline__ void gmlp_unit(const TI ti, CArgs& a, int l, int u, unsigned char* ldsg) {
    float* rstd = (float*)ldsg; bf16_t* VNT = (bf16_t*)(ldsg + 512);
    const int tid = ti.tid, lane = tid & 63, w = tid >> 6, r = lane & 31, h = lane >> 5;
    bf16_t* GU = (bf16_t*)(a.ws + WS_GU); const bf16_t* GV = (const bf16_t*)(a.ws + WS_GV);
    const size_t R0 = (size_t)u * 128;
#pragma unroll 4
    for (int i = 0; i < 16; ++i) {
        const int tok = w * 16 + i; const bf16_t* p = GV + (R0 + tok) * 1024 + lane * 16;
        f32x4 x0, x1, x2, x3; unpack8(*(const u32x4*)p, x0, x1); unpack8(*(const u32x4*)(p + 8), x2, x3);
        float ss = (x0.x * x0.x + x0.y * x0.y + x0.z * x0.z + x0.w * x0.w) + (x1.x * x1.x + x1.y * x1.y + x1.z * x1.z + x1.w * x1.w)
                 + (x2.x * x2.x + x2.y * x2.y + x2.z * x2.z + x2.w * x2.w) + (x3.x * x3.x + x3.y * x3.y + x3.z * x3.z + x3.w * x3.w);
        ss = wave_sum(ss);
        if (lane == 0) rstd[tok] = rsqrtf(ss * (1.f / 1024.f) + 1e-6f);
    }
    __syncthreads();
    const float* gvg = a.in[9] + l * 1024; const float* wsp = a.in[10] + (size_t)l * 8 * 128 * 128; const float* bsp = a.in[11] + l * 8 * 128;
    const int tt = w & 3, chh = w >> 2;
    for (int g = 0; g < 8; ++g) {
        {
            const int s = tid & 127, cc = tid >> 7; const float rs = rstd[s]; const bf16_t* p = GV + (R0 + s) * 1024 + g * 128 + cc * 32;
#pragma unroll
            for (int q = 0; q < 4; ++q) {
                f32x4 x0, x1; unpack8(*(const u32x4*)(p + 8 * q), x0, x1);
                const float* gp = gvg + g * 128 + cc * 32 + 8 * q; const int c0 = cc * 32 + 8 * q;
                VNT[(c0 + 0) * 136 + s] = f2bf(x0.x * rs * gp[0]); VNT[(c0 + 1) * 136 + s] = f2bf(x0.y * rs * gp[1]);
                VNT[(c0 + 2) * 136 + s] = f2bf(x0.z * rs * gp[2]); VNT[(c0 + 3) * 136 + s] = f2bf(x0.w * rs * gp[3]);
                VNT[(c0 + 4) * 136 + s] = f2bf(x1.x * rs * gp[4]); VNT[(c0 + 5) * 136 + s] = f2bf(x1.y * rs * gp[5]);
                VNT[(c0 + 6) * 136 + s] = f2bf(x1.z * rs * gp[6]); VNT[(c0 + 7) * 136 + s] = f2bf(x1.w * rs * gp[7]);
            }
        }
        __syncthreads();
        f32x16 acc0, acc1;
#pragma unroll
        for (int i = 0; i < 16; ++i) { acc0[i] = 0.f; acc1[i] = 0.f; }
        const float* wrow = wsp + ((size_t)g * 128 + tt * 32 + r) * 128;
#pragma unroll
        for (int ks = 0; ks < 8; ++ks) {
            const f32x4 a0 = *(const f32x4*)(wrow + 16 * ks + 8 * h), a1 = *(const f32x4*)(wrow + 16 * ks + 8 * h + 4);
            const bf16x8 af = __builtin_bit_cast(bf16x8, pack8(a0, a1));
            const bf16x8 b0 = *(const bf16x8*)(VNT + (chh * 64 + r) * 136 + 16 * ks + 8 * h);
            const bf16x8 b1 = *(const bf16x8*)(VNT + (chh * 64 + 32 + r) * 136 + 16 * ks + 8 * h);
            acc0 = MFMA32(af, b0, acc0); acc1 = MFMA32(af, b1, acc1);
        }
        {
            const bf16_t* GUr = GU; float uu0[16], uu1[16], bb[16];
#pragma unroll
            for (int reg = 0; reg < 16; ++reg) {
                const int t = tt * 32 + (reg & 3) + 8 * (reg >> 2) + 4 * h; const size_t i0 = (R0 + t) * 1024 + g * 128 + chh * 64 + r;
                bb[reg] = bsp[g * 128 + t]; uu0[reg] = bf2f(GUr[i0]); uu1[reg] = bf2f(GUr[i0 + 32]);
            }
            asm volatile("" ::: "memory");
#pragma unroll
            for (int reg = 0; reg < 16; ++reg) {
                const int t = tt * 32 + (reg & 3) + 8 * (reg >> 2) + 4 * h; const size_t i0 = (R0 + t) * 1024 + g * 128 + chh * 64 + r;
                GU[i0] = f2bf(uu0[reg] * (acc0[reg] + bb[reg])); GU[i0 + 32] = f2bf(uu1[reg] * (acc1[reg] + bb[reg]));
            }
        }
        __syncthreads();
    }
}
__device__ __forceinline__ void qk_rows(CArgs& a, int l, int gw, int ngw, int lane) {
    bf16_t* Q = (bf16_t*)(a.ws + WS_Q); bf16_t* K = (bf16_t*)(a.ws + WS_K);
    const float* RC = (const float*)(a.ws + WS_ROPE); const float* RS = RC + 2048 * 32;
    const int part = lane & 3;
    float gq[16], gk[16];
    load16f(a.in[12] + l * 64 + 16 * part, gq); load16f(a.in[13] + l * 64 + 16 * part, gk);
    for (int row = gw; row < M; row += ngw) {
        float xq[16], xk[16], cs[16], sn[16];
        unpack16(Q + (size_t)row * 1024 + 16 * lane, xq); unpack16(K + (size_t)row * 1024 + 16 * lane, xk);
        const bool lat = row < ML;
        if (lat) { const int t = row & 2047; load16f(RC + t * 32 + 16 * (part & 1), cs); load16f(RS + t * 32 + 16 * (part & 1), sn); }
        float sq = 0.f, sk = 0.f;
#pragma unroll
        for (int j = 0; j < 16; ++j) { sq += xq[j] * xq[j]; sk += xk[j] * xk[j]; }
        const float rq = rsqrtf(quad_sum(sq) * (1.f / 64.f) + 1e-6f), rk = rsqrtf(quad_sum(sk) * (1.f / 64.f) + 1e-6f);
#pragma unroll
        for (int j = 0; j < 16; ++j) { xq[j] = xq[j] * rq * gq[j]; xk[j] = xk[j] * rk * gk[j]; }
        if (lat) {
            const float sgn = part < 2 ? -1.f : 1.f;
#pragma unroll
            for (int j = 0; j < 16; ++j) {
                const float pq = quad_xor2(xq[j]), pk = quad_xor2(xk[j]);
                xq[j] = xq[j] * cs[j] + sgn * pq * sn[j]; xk[j] = xk[j] * cs[j] + sgn * pk * sn[j];
            }
        }
#pragma unroll
        for (int j = 0; j < 16; ++j) xq[j] *= QSCALE;
        pack16(Q + (size_t)row * 1024 + 16 * lane, xq); pack16(K + (size_t)row * 1024 + 16 * lane, xk);
    }
}
__device__ __forceinline__ void lora_in_rows(CArgs& a, int l, int gw, int ngw, int lane) {
    const bf16_t* RW = (const bf16_t*)(a.ws + WS_RW); bf16_t* LW = (bf16_t*)(a.ws + WS_LIW); bf16_t* LA = (bf16_t*)(a.ws + WS_LIA); bf16_t* LG = (bf16_t*)(a.ws + WS_LIG);
    const float* mu = a.in[16] + l * 3488 + 3072;
    f32x4 m0 = {0.f, 0.f, 0.f, 0.f}, m1 = m0;
    if (lane < 52) { m0 = *(const f32x4*)(mu + 8 * lane); m1 = *(const f32x4*)(mu + 8 * lane + 4); }
    for (int row = gw; row < M; row += ngw) {
        int t, Tn; if (row < ML) { t = row & 2047; Tn = 2048; } else { t = (row - ML) & 255; Tn = 256; }
        const bool hp = t > 0, hn = t < Tn - 1;
        if (lane < 52) {
            const bf16_t* p = RW + (size_t)row * RWP + 3072 + 8 * lane;
            f32x4 x0, x1, p0 = {0.f, 0.f, 0.f, 0.f}, p1 = p0, n0 = p0, n1 = p0;
            unpack8(*(const u32x4*)p, x0, x1);
            if (hp) unpack8(*(const u32x4*)(p - RWP), p0, p1);
            if (hn) unpack8(*(const u32x4*)(p + RWP), n0, n1);
            f32x4 z0 = x0 + m0 * (0.5f * (p0 + n0) - x0), z1 = x1 + m1 * (0.5f * (p1 + n1) - x1);
            const int j = 8 * lane;
            if (j < 128) { z0 = (f32x4){tanhf(z0.x), tanhf(z0.y), tanhf(z0.z), tanhf(z0.w)}; z1 = (f32x4){tanhf(z1.x), tanhf(z1.y), tanhf(z1.z), tanhf(z1.w)}; *(u32x4*)(LW + (size_t)row * 128 + j) = pack8(z0, z1); }
            else if (j < 256) { *(u32x4*)(LA + (size_t)row * 128 + j - 128) = pack8(z0, z1); }
            else { *(u32x4*)(LG + (size_t)row * 256 + j - 256) = pack8(sig4(z0), sig4(z1)); }
        } else {
            unsigned z_ = 0u; asm volatile("" : "+v"(z_)); *(u32x4*)(LG + (size_t)row * 256 + 160 + (lane - 52) * 8) = (u32x4){z_, z_, z_, z_};
        }
    }
}

__device__ __forceinline__ void scan_unit(const TI ti, CArgs& a, int l, int u, bool ctx_out, unsigned char* ldsg) {
    const int tid = ti.tid, lane = tid & 63, w = tid >> 6;
    const int b = u >> 5, hh = (u >> 1) & 15, d = u & 1;
    const int si = tid >> 3, jq = tid & 7;
    LAS float* L = (LAS float*)ldsg;
    const bf16_t* RW = (const bf16_t*)(a.ws + WS_RW);
    const bf16_t* DEC = (const bf16_t*)(a.ws + (d ? WS_DEC1 : WS_GV));
    const bf16_t* AA = (const bf16_t*)(a.ws + (d ? WS_AA1 : WS_AA0));
    bf16_t* Y = (bf16_t*)(a.ws + (d ? WS_Y1 : WS_H));
    const int ch = hh * 64 + lane;
    const float* mu = a.in[16] + l * 3488;
    const float mur = mu[ch], muk = mu[1024 + ch], muv = mu[2048 + ch], kkg = a.in[22][l * 1024 + ch], kag = a.in[23][l * 1024 + ch];
    f32x4 S0 = {0.f, 0.f, 0.f, 0.f}, S1 = {0.f, 0.f, 0.f, 0.f};
    unsigned raw[4][9]; unsigned dcr[4], aar[4];
    constexpr int NC = 72;
#define SCAN_CHUNK(n, base, Tn, t0, wy) int base, Tn, t0; bool wy; { int ci; if ((n) < 8) { base = ML + b * 256; Tn = 256; ci = d ? 7 - (n) : (n); wy = ctx_out; } else { base = b * 2048; Tn = 2048; ci = d ? 71 - (n) : (n) - 8; wy = true; } t0 = ci * 32; }
#define SCAN_LOAD(n) do { SCAN_CHUNK(n, base_, Tn_, t0_, wy_); (void)wy_; _Pragma("unroll") for (int i4 = 0; i4 < 4; ++i4) { const int t = t0_ + w + 8 * i4; const size_t row = (size_t)(base_ + t); \
        const bf16_t* p = RW + row * RWP + ch; const bool hp = t > 0, hn = t < Tn_ - 1; \
        const int op_ = hp ? -RWP : 0, on_ = hn ? RWP : 0;     \
        _Pragma("unroll") for (int X = 0; X < 3; ++X) { raw[i4][3 * X + 0] = (unsigned)p[X * 1024 + op_]; raw[i4][3 * X + 1] = (unsigned)p[X * 1024]; raw[i4][3 * X + 2] = (unsigned)p[X * 1024 + on_]; } \
        dcr[i4] = (unsigned)DEC[row * 1024 + ch]; aar[i4] = (unsigned)AA[row * 1024 + ch]; } } while (0)
#define SCAN_STORE(n) do { LAS float* Bf = L + ((n) & 1) * 12288; SCAN_CHUNK(n, base_, Tn_, t0_, wy_); (void)wy_; (void)base_; _Pragma("unroll") for (int i4 = 0; i4 < 4; ++i4) { const int tk = w + 8 * i4; \
        const float mp_ = (t0_ + tk > 0) ? 0.5f : 0.f, mn_ = (t0_ + tk < Tn_ - 1) ? 0.5f : 0.f; \
        const float xr = bf2f(raw[i4][1]), xk = bf2f(raw[i4][4]), xv = bf2f(raw[i4][7]); \
        const float zr = xr + mur * ((mp_ * bf2f(raw[i4][0]) + mn_ * bf2f(raw[i4][2])) - xr); \
        const float zk = xk + muk * ((mp_ * bf2f(raw[i4][3]) + mn_ * bf2f(raw[i4][5])) - xk); \
        const float zv = xv + muv * ((mp_ * bf2f(raw[i4][6]) + mn_ * bf2f(raw[i4][8])) - xv); \
        const float kkv = zk * kkg; const float ssq = wave_sum(kkv * kkv); const float kkn = kkv / fmaxf(sqrtf(ssq), 1e-12f); \
        const float ad = bf2f(aar[i4]); const float wv_ = __expf(bf2f(dcr[i4])); const float kd = zk * (1.f + (ad - 1.f) * kag); \
        Bf[0 * 2048 + tk * 64 + lane] = wv_; Bf[1 * 2048 + tk * 64 + lane] = kd; Bf[2 * 2048 + tk * 64 + lane] = -kkn; \
        Bf[3 * 2048 + tk * 64 + lane] = kkn * ad; Bf[4 * 2048 + tk * 64 + lane] = zr; Bf[5 * 2048 + tk * 64 + lane] = zv; } } while (0)
    SCAN_LOAD(0); SCAN_STORE(0);
    __syncthreads();
    for (int n = 0; n < NC; ++n) {
        if (n + 1 < NC) SCAN_LOAD(n + 1);
        LAS const float* Bf = L + (n & 1) * 12288; LAS float* Yb = L + 24576 + (n & 1) * 2048;
#define STEP_LOAD(P, sidx) LAS const float* q##P = Bf + (sidx) * 64 + 8 * jq + hoff; \
            const f32x4 w0##P = *(LAS const f32x4*)(q##P), w1##P = *(LAS const f32x4*)(q##P + hdq), k0##P = *(LAS const f32x4*)(q##P + 2048), k1##P = *(LAS const f32x4*)(q##P + 2048 + hdq), \
                        a0##P = *(LAS const f32x4*)(q##P + 4096), a1##P = *(LAS const f32x4*)(q##P + 4096 + hdq), b0##P = *(LAS const f32x4*)(q##P + 6144), b1##P = *(LAS const f32x4*)(q##P + 6144 + hdq), \
                        r0##P = *(LAS const f32x4*)(q##P + 8192), r1##P = *(LAS const f32x4*)(q##P + 8192 + hdq); const float vi##P = Bf[5 * 2048 + (sidx) * 64 + si];
#define STEP_MATH(P, sidx) { const f32x4 ta = S0 * a0##P + S1 * a1##P; const float sa = dpp_sum8((ta.x + ta.y) + (ta.z + ta.w)); \
            S0 = S0 * w0##P + (sa * b0##P + vi##P * k0##P); S1 = S1 * w1##P + (sa * b1##P + vi##P * k1##P); \
            const f32x4 ty = S0 * r0##P + S1 * r1##P; const float y = dpp_sum8((ty.x + ty.y) + (ty.z + ty.w)); if (jq == 0) Yb[(sidx) * 64 + si] = y; }
        const int hoff = (si & 1) * 4, hdq = 4 - 2 * hoff;
        const int sdir = d ? -1 : 1; int sc = d ? 31 : 0;
        f32x4 cw0, cw1, ck0, ck1, ca0, ca1, cb0, cb1, cr0, cr1; float cvi;
        { STEP_LOAD(X, sc); cw0 = w0X; cw1 = w1X; ck0 = k0X; ck1 = k1X; ca0 = a0X; ca1 = a1X; cb0 = b0X; cb1 = b1X; cr0 = r0X; cr1 = r1X; cvi = viX; }
        for (int ss = 0; ss < 32; ss += 2) {
            const int s0i = sc, s1i = sc + sdir; int s2i = sc + 2 * sdir; s2i = (ss + 2 < 32) ? s2i : s1i;
            STEP_LOAD(B, s1i);
            { const f32x4 w0A = cw0, w1A = cw1, k0A = ck0, k1A = ck1, a0A = ca0, a1A = ca1, b0A = cb0, b1A = cb1, r0A = cr0, r1A = cr1; const float viA = cvi; STEP_MATH(A, s0i); }
            STEP_LOAD(C, s2i);
            STEP_MATH(B, s1i);
            cw0 = w0C; cw1 = w1C; ck0 = k0C; ck1 = k1C; ca0 = a0C; ca1 = a1C; cb0 = b0C; cb1 = b1C; cr0 = r0C; cr1 = r1C; cvi = viC;
            sc += 2 * sdir;
        }
#undef STEP_LOAD
#undef STEP_MATH
        if (n + 1 < NC) SCAN_STORE(n + 1);
        __syncthreads();
        {
            SCAN_CHUNK(n, base_, Tn_, t0_, wy_); (void)Tn_;
            if (wy_) {
#pragma unroll
                for (int i4 = 0; i4 < 4; ++i4) { const int tk = w + 8 * i4; Y[(size_t)(base_ + t0_ + tk) * 1024 + ch] = f2bf(Yb[tk * 64 + lane]); }
            }
        }
    }
    __syncthreads();
#undef SCAN_CHUNK
#undef SCAN_LOAD
#undef SCAN_STORE
}

__device__ __forceinline__ bf16x8 pk8f(float f0, float f1, float f2, float f3, float f4, float f5, float f6, float f7) {
    u32x4 p; p.x = pkbf(f0, f1); p.y = pkbf(f2, f3); p.z = pkbf(f4, f5); p.w = pkbf(f6, f7); return __builtin_bit_cast(bf16x8, p);
}
__device__ __forceinline__ void scan_unit_mfma(const TI ti, CArgs& a, int l, int u, bool ctx_out, unsigned char* ldsg) {
    const int tid = ti.tid, lane = tid & 63, w = __builtin_amdgcn_readfirstlane(tid >> 6);
    const int b = u >> 5, hh = (u >> 1) & 15, d = u & 1;
    LAS unsigned char* L = (LAS unsigned char*)ldsg;
    constexpr int NCH = 144, RING = 6, BUFB = 20736, O_AR = 0, O_BK = 4608, O_BKT = 9216, O_VTT = 14336, O_PC = 17408, O_NS = 17664, O_XF = 18688;
#define SC2_CHUNK(C, base, Tn, cc, wy) int base, Tn, cc; bool wy; if ((C) < 16) { base = ML + b * 256; Tn = 256; cc = (C); wy = ctx_out; } else { base = b * 2048; Tn = 2048; cc = (C) - 16; wy = true; }
#define SC2_TOK(Tn, cc, t) (d ? (Tn) - 1 - (16 * (cc) + (t)) : 16 * (cc) + (t))
    if (w < 2) {
        const int it = w, r = lane & 31, h = lane >> 5;
        bf16_t* Y = (bf16_t*)(a.ws + (d ? WS_Y1 : WS_H));
        f32x16 ST0, ST1;
#pragma unroll
        for (int i = 0; i < 16; ++i) { ST0[i] = 0.f; ST1[i] = 0.f; }
        for (int n = 0; n < NCH + RING; ++n) {
            if (n >= RING) {
                const int C = n - RING;
                LAS const unsigned char* buf = L + (C % RING) * BUFB;
                const bf16x8 xb0 = *(LAS const bf16x8*)(buf + O_XF + lane * 16), xb1 = *(LAS const bf16x8*)(buf + O_XF + 1024 + lane * 16);
                f32x16 Z;
#pragma unroll
                for (int i = 0; i < 16; ++i) Z[i] = 0.f;
#pragma unroll
                for (int jt = 0; jt < 2; ++jt) {
#pragma unroll
                    for (int s = 0; s < 2; ++s) {
                        LAS const unsigned char* ap = buf + O_AR + r * 144 + (32 * jt + 16 * s + 4 * h) * 2;
                        const s16x4 lo = *(LAS const s16x4*)ap, hi = *(LAS const s16x4*)(ap + 16);
                        const bf16x8 a2 = __builtin_shufflevector(lo, hi, 0, 1, 2, 3, 4, 5, 6, 7);
                        const bf16x8 stp = jt == 0 ? pk8f(ST0[8 * s], ST0[8 * s + 1], ST0[8 * s + 2], ST0[8 * s + 3], ST0[8 * s + 4], ST0[8 * s + 5], ST0[8 * s + 6], ST0[8 * s + 7])
                                                   : pk8f(ST1[8 * s], ST1[8 * s + 1], ST1[8 * s + 2], ST1[8 * s + 3], ST1[8 * s + 4], ST1[8 * s + 5], ST1[8 * s + 6], ST1[8 * s + 7]);
                        Z = MFMA32(a2, stp, Z);
                    }
                }
                LAS const unsigned char* vp = buf + O_VTT + (32 * it + r) * 48;
                {
                    const s16x4 lo = *(LAS const s16x4*)(vp + 8 * h), hi = *(LAS const s16x4*)(vp + 16 + 8 * h);
                    const bf16x8 vf = __builtin_shufflevector(lo, hi, 0, 1, 2, 3, 4, 5, 6, 7);
                    Z = MFMA32(xb1, vf, Z);
                }
                float o[8], g[16], uu[16];
#pragma unroll
                for (int q = 0; q < 8; ++q) o[q] = __shfl_xor(Z[q], 32);
#pragma unroll
                for (int e = 0; e < 4; ++e) {
                    g[e] = h ? o[e] : Z[e]; g[4 + e] = h ? Z[e] : o[e];
                    g[8 + e] = h ? o[4 + e] : Z[4 + e]; g[12 + e] = h ? Z[4 + e] : o[4 + e];
                }
                {
                    LAS const float* NS = (LAS const float*)(buf + O_NS);
#pragma unroll
                    for (int t = 0; t < 16; ++t) uu[t] = g[t];
#pragma unroll
                    for (int s = 0; s < 15; ++s) {
#pragma unroll
                        for (int t4 = (s + 1) / 4; t4 < 4; ++t4) {
                            const f32x4 nv = *(LAS const f32x4*)(NS + s * 16 + 4 * t4);
                            if (4 * t4 + 0 > s) uu[4 * t4 + 0] = __builtin_fmaf(nv.x, uu[s], uu[4 * t4 + 0]);
                            if (4 * t4 + 1 > s) uu[4 * t4 + 1] = __builtin_fmaf(nv.y, uu[s], uu[4 * t4 + 1]);
                            if (4 * t4 + 2 > s) uu[4 * t4 + 2] = __builtin_fmaf(nv.z, uu[s], uu[4 * t4 + 2]);
                            if (4 * t4 + 3 > s) uu[4 * t4 + 3] = __builtin_fmaf(nv.w, uu[s], uu[4 * t4 + 3]);
                        }
                    }
                }
                {
                    const bf16x8 uf = pk8f(h ? uu[4] : uu[0], h ? uu[5] : uu[1], h ? uu[6] : uu[2], h ? uu[7] : uu[3],
                                           h ? uu[12] : uu[8], h ? uu[13] : uu[9], h ? uu[14] : uu[10], h ? uu[15] : uu[11]);
                    Z = MFMA32(xb0, uf, Z);
                }
                {
                    SC2_CHUNK(C, base_, Tn_, cc_, wy_);
                    if (wy_) {
#pragma unroll
                        for (int q = 8; q < 16; ++q) {
                            const int t = (q & 3) + 8 * ((q >> 2) - 2) + 4 * h; const int tok = SC2_TOK(Tn_, cc_, t);
                            Y[(size_t)(base_ + tok) * 1024 + hh * 64 + 32 * it + r] = f2bf(Z[q]);
                        }
                    }
                }
                {
                    const bf16x8 un = pk8f(h ? uu[8] : uu[0], h ? uu[9] : uu[1], h ? uu[10] : uu[2], h ? uu[11] : uu[3],
                                           h ? uu[12] : uu[4], h ? uu[13] : uu[5], h ? uu[14] : uu[6], h ? uu[15] : uu[7]);
                    const bf16x8 vn = *(LAS const bf16x8*)(vp + 16 * h);
                    const bf16x8 a00 = *(LAS const bf16x8*)(buf + O_BKT + r * 80 + (8 * h) * 2), a01 = *(LAS const bf16x8*)(buf + O_BKT + r * 80 + (16 + 8 * h) * 2);
                    const bf16x8 a10 = *(LAS const bf16x8*)(buf + O_BKT + (32 + r) * 80 + (8 * h) * 2), a11 = *(LAS const bf16x8*)(buf + O_BKT + (32 + r) * 80 + (16 + 8 * h) * 2);
                    ST0 = MFMA32(a00, un, ST0); ST0 = MFMA32(a01, vn, ST0);
                    ST1 = MFMA32(a10, un, ST1); ST1 = MFMA32(a11, vn, ST1);
                    LAS const float* pc = (LAS const float*)(buf + O_PC);
#pragma unroll
                    for (int g4 = 0; g4 < 4; ++g4) {
                        const f32x4 p0 = *(LAS const f32x4*)(pc + 8 * g4 + 4 * h), p1 = *(LAS const f32x4*)(pc + 32 + 8 * g4 + 4 * h);
                        ST0[4 * g4] *= p0.x; ST0[4 * g4 + 1] *= p0.y; ST0[4 * g4 + 2] *= p0.z; ST0[4 * g4 + 3] *= p0.w;
                        ST1[4 * g4] *= p1.x; ST1[4 * g4 + 1] *= p1.y; ST1[4 * g4 + 2] *= p1.z; ST1[4 * g4 + 3] *= p1.w;
                    }
                }
            }
            __syncthreads();
        }
    } else {
        const int p = w - 2, ch = hh * 64 + lane;
        const bf16_t* RW = (const bf16_t*)(a.ws + WS_RW);
        const bf16_t* DEC = (const bf16_t*)(a.ws + (d ? WS_DEC1 : WS_GV));
        const bf16_t* AA = (const bf16_t*)(a.ws + (d ? WS_AA1 : WS_AA0));
        const float* mu = a.in[16] + l * 3488;
        const float mur = mu[ch], muk = mu[1024 + ch], muv = mu[2048 + ch], kkg = a.in[22][l * 1024 + ch], kag = a.in[23][l * 1024 + ch];
        LAS unsigned char* buf = L + p * BUFB;
        LAS bf16_t* AR = (LAS bf16_t*)(buf + O_AR); LAS bf16_t* BK = (LAS bf16_t*)(buf + O_BK); LAS bf16_t* BKT = (LAS bf16_t*)(buf + O_BKT); LAS bf16_t* VTT = (LAS bf16_t*)(buf + O_VTT);
        LAS float* PC = (LAS float*)(buf + O_PC);
        constexpr int NSTEP = (NCH / RING) * 4;
        unsigned nxt[4][11], cur[4][11];
#define SC2_LOAD(k) do { const int C_ = p + RING * ((k) >> 2); SC2_CHUNK(C_, base_, Tn_, cc_, wy_); (void)wy_; _Pragma("unroll") for (int i4 = 0; i4 < 4; ++i4) { \
            const int tok = SC2_TOK(Tn_, cc_, 4 * ((k) & 3) + i4); const size_t row = (size_t)(base_ + tok); \
            const gcptr_t rb = uniptr(RW + row * RWP + hh * 64 + 1024);     \
            const gcptr_t rp = rb + (tok > 0 ? -RWP : 0); const gcptr_t rn = rb + (tok < Tn_ - 1 ? RWP : 0); \
            nxt[i4][0] = (unsigned)rp[lane - 1024]; nxt[i4][3] = (unsigned)rp[lane]; nxt[i4][6] = (unsigned)rp[lane + 1024]; \
            nxt[i4][1] = (unsigned)rb[lane - 1024]; nxt[i4][4] = (unsigned)rb[lane]; nxt[i4][7] = (unsigned)rb[lane + 1024]; \
            nxt[i4][2] = (unsigned)rn[lane - 1024]; nxt[i4][5] = (unsigned)rn[lane]; nxt[i4][8] = (unsigned)rn[lane + 1024]; \
            nxt[i4][9] = (unsigned)uniptr(DEC + row * 1024 + hh * 64)[lane]; nxt[i4][10] = (unsigned)uniptr(AA + row * 1024 + hh * 64)[lane]; } } while (0)
        SC2_LOAD(0);
        float Lsum = 0.f, ePprev = 1.f;
        for (int n = 0; n < NCH + RING; ++n) {
            const int e = n - p - 1;
            if (e >= 0 && (e % RING) < 4 && e / RING < NCH / RING) {
                const int k = 4 * (e / RING) + (e % RING);
#pragma unroll
                for (int i4 = 0; i4 < 4; ++i4)
#pragma unroll
                    for (int x = 0; x < 11; ++x) cur[i4][x] = nxt[i4][x];
                if (k + 1 < NSTEP) SC2_LOAD(k + 1);
                const int C_ = p + RING * (k >> 2); SC2_CHUNK(C_, base_, Tn_, cc_, wy_); (void)wy_; (void)base_;
#pragma unroll
                for (int i4 = 0; i4 < 4; ++i4) {
                    const int t = 4 * (k & 3) + i4; const int tok = SC2_TOK(Tn_, cc_, t);
                    Lsum = (t == 0) ? 0.f : Lsum; ePprev = (t == 0) ? 1.f : ePprev;
                    const float mp_ = tok > 0 ? 0.5f : 0.f, mn_ = tok < Tn_ - 1 ? 0.5f : 0.f;
                    const float xr = bf2f(cur[i4][1]), xk = bf2f(cur[i4][4]), xv = bf2f(cur[i4][7]);
                    const float zr = xr + mur * ((mp_ * bf2f(cur[i4][0]) + mn_ * bf2f(cur[i4][2])) - xr);
                    const float zk = xk + muk * ((mp_ * bf2f(cur[i4][3]) + mn_ * bf2f(cur[i4][5])) - xk);
                    const float zv = xv + muv * ((mp_ * bf2f(cur[i4][6]) + mn_ * bf2f(cur[i4][8])) - xv);
                    const float kkv = zk * kkg; const float ssq = wave_sum(kkv * kkv); const float kkn = kkv * rsqrtf(fmaxf(ssq, 1e-24f));
                    const float ad = bf2f(cur[i4][10]); const float kd = zk * (1.f + (ad - 1.f) * kag);
                    Lsum += bf2f(cur[i4][9]);
                    const float eP = __expf(Lsum), eI = __expf(-Lsum);
                    AR[t * 72 + lane] = f2bf(-kkn * ePprev); AR[(16 + t) * 72 + lane] = f2bf(zr * eP);
                    const bf16_t bt = f2bf(kkn * ad * eI), kt = f2bf(kd * eI);
                    BK[t * 72 + lane] = bt; BK[(16 + t) * 72 + lane] = kt;
                    BKT[lane * 40 + t] = bt; BKT[lane * 40 + 16 + t] = kt;
                    VTT[lane * 24 + t] = f2bf(zv);
                    PC[lane] = eP;
                    ePprev = eP;
                }
            } else if (e >= 0 && (e % RING) == 4 && e / RING < NCH / RING) {
                const int r = lane & 31, h = lane >> 5, thr = (r & 15) + (r >> 4);
                f32x16 X;
#pragma unroll
                for (int i = 0; i < 16; ++i) X[i] = 0.f;
#pragma unroll
                for (int ks = 0; ks < 4; ++ks) {
                    const bf16x8 af = *(LAS const bf16x8*)(buf + O_BK + r * 144 + (16 * ks + 8 * h) * 2);
                    const bf16x8 bfr = *(LAS const bf16x8*)(buf + O_AR + r * 144 + (16 * ks + 8 * h) * 2);
                    X = MFMA32(af, bfr, X);
                }
#pragma unroll
                for (int rg = 0; rg < 16; ++rg) { const int s = (rg & 3) + 8 * ((rg >> 2) & 1) + 4 * h; X[rg] = (s < thr) ? X[rg] : 0.f; }
                if (r < 16) {
                    LAS float* NS = (LAS float*)(buf + O_NS);
#pragma unroll
                    for (int rg = 0; rg < 8; ++rg) NS[((rg & 3) + 8 * (rg >> 2) + 4 * h) * 16 + r] = X[rg];
                }
                *(LAS bf16x8*)(buf + O_XF + lane * 16) = pk8f(X[0], X[1], X[2], X[3], X[4], X[5], X[6], X[7]);
                *(LAS bf16x8*)(buf + O_XF + 1024 + lane * 16) = pk8f(X[8], X[9], X[10], X[11], X[12], X[13], X[14], X[15]);
            }
            __syncthreads();
        }
#undef SC2_LOAD
    }
    __syncthreads();
#undef SC2_CHUNK
#undef SC2_TOK
}

__device__ __forceinline__ void attn_unit(const TI ti, CArgs& a, int b, int hd, int qrow0, int st_lo, int st_hi, float mfix, float lam, float lam_init, const float* subg, unsigned char* ldsg) {
    const int tid = ti.tid, lane = tid & 63, w = tid >> 6, r = lane & 31, h = lane >> 5, qt = w >> 1, c = w & 1;
    bf16_t* Qb = (bf16_t*)(a.ws + WS_Q); const bf16_t* Kb = (const bf16_t*)(a.ws + WS_K); const bf16_t* Vb = (const bf16_t*)(a.ws + WS_V);
    LAS unsigned char* L = (LAS unsigned char*)ldsg;
    constexpr int KOFF = 0, VOFF = 17408, BUFB = 35840;
    bf16x8 qf[4];
    { const bf16_t* qp = Qb + (size_t)(qrow0 + qt * 32 + r) * 1024 + hd * 128 + c * 64 + 8 * h;
#pragma unroll
      for (int ks = 0; ks < 4; ++ks) qf[ks] = *(const bf16x8*)(qp + 16 * ks); }
    f32x16 O[4];
#pragma unroll
    for (int e = 0; e < 4; ++e)
#pragma unroll
        for (int i = 0; i < 16; ++i) O[e][i] = 0.f;
    float lsum = 0.f;
    u32x4 kreg[2], vreg[2];
    typedef const __attribute__((address_space(1))) u32x4* gc16_t;
    const int koff0 = (tid >> 4) * 1024 + (tid & 15) * 8, koff1 = koff0 + 32 * 1024, voff = lane * 1024 + w * 16;
#define ATT_LOAD(st) do { const int rb_ = (st) < 32 ? b * 2048 + (st) * 64 : ML + b * 256 + ((st) - 32) * 64; \
        const gcptr_t kb_ = uniptr(Kb + (size_t)rb_ * 1024 + hd * 128); const gcptr_t vb_ = uniptr(Vb + (size_t)rb_ * 1024 + hd * 128); \
        kreg[0] = *(gc16_t)(kb_ + koff0); kreg[1] = *(gc16_t)(kb_ + koff1); vreg[0] = *(gc16_t)(vb_ + voff); vreg[1] = *(gc16_t)(vb_ + voff + 8); } while (0)
#define ATT_STORE(bufi) do { LAS unsigned char* Bb = L + (bufi) * BUFB; _Pragma("unroll") for (int i = 0; i < 2; ++i) { const int p = tid + 512 * i, key = p >> 4, dc = p & 15; *(LAS u32x4*)(Bb + KOFF + key * 272 + dc * 16) = kreg[i]; } \
        LAS bf16_t* vt = (LAS bf16_t*)(Bb + VOFF) + (w * 16) * 72 + ((lane & 48) + 8 * ((lane >> 2) & 1) + 4 * ((lane >> 3) & 1) + (lane & 3));   \
        _Pragma("unroll") for (int e = 0; e < 4; ++e) { vt[(2 * e) * 72] = (bf16_t)(vreg[0][e] & 0xffffu); vt[(2 * e + 1) * 72] = (bf16_t)(vreg[0][e] >> 16); \
            vt[(8 + 2 * e) * 72] = (bf16_t)(vreg[1][e] & 0xffffu); vt[(8 + 2 * e + 1) * 72] = (bf16_t)(vreg[1][e] >> 16); } } while (0)
    ATT_LOAD(st_lo); ATT_STORE(0);
    __syncthreads();
    for (int st = st_lo; st < st_hi; ++st) {
        const int bi = (st - st_lo) & 1;
        if (st + 1 < st_hi) ATT_LOAD(st + 1);
        LAS const unsigned char* Bb = L + bi * BUFB;
#pragma unroll
        for (int sub = 0; sub < 2; ++sub) {
            f32x16 Sx;
#pragma unroll
            for (int i = 0; i < 16; ++i) Sx[i] = -mfix;
#pragma unroll
            for (int ks = 0; ks < 4; ++ks) {
                const bf16x8 kf = *(LAS const bf16x8*)(Bb + KOFF + (sub * 32 + r) * 272 + (c * 64 + 16 * ks + 8 * h) * 2);
                Sx = MFMA32(kf, qf[ks], Sx);
            }
            float p[16];
#pragma unroll
            for (int i = 0; i < 16; ++i) { p[i] = __builtin_amdgcn_exp2f(Sx[i]); lsum += p[i]; }
            u32x4 pw0, pw1;
            pw0.x = pkbf(p[0], p[1]); pw0.y = pkbf(p[2], p[3]); pw0.z = pkbf(p[4], p[5]); pw0.w = pkbf(p[6], p[7]);
            pw1.x = pkbf(p[8], p[9]); pw1.y = pkbf(p[10], p[11]); pw1.z = pkbf(p[12], p[13]); pw1.w = pkbf(p[14], p[15]);
            const bf16x8 pb0 = __builtin_bit_cast(bf16x8, pw0), pb1 = __builtin_bit_cast(bf16x8, pw1);
#pragma unroll
            for (int et = 0; et < 4; ++et) {
#pragma unroll
                for (int s = 0; s < 2; ++s) {
                    const bf16x8 vf = *(LAS const bf16x8*)(Bb + VOFF + (et * 32 + r) * 144 + (sub * 32 + 16 * s + 8 * h) * 2);
                    O[et] = MFMA32(vf, s ? pb1 : pb0, O[et]);
                }
            }
        }
        if (st + 1 < st_hi) ATT_STORE(bi ^ 1);
        __syncthreads();
    }
#undef ATT_LOAD
#undef ATT_STORE
    const float ltot = lsum + __shfl_xor(lsum, 32);
    const float linv = 1.f / ltot;
    LAS float* X = (LAS float*)L + qt * 4096;
    if (c == 1) {
#pragma unroll
        for (int e = 0; e < 4; ++e)
#pragma unroll
            for (int i = 0; i < 16; ++i) X[(e * 16 + i) * 64 + lane] = O[e][i] * linv;
    }
    __syncthreads();
    if (c == 0) {
        float ssq = 0.f;
#pragma unroll
        for (int e = 0; e < 4; ++e)
#pragma unroll
            for (int i = 0; i < 16; ++i) { const float o = O[e][i] * linv - lam * X[(e * 16 + i) * 64 + lane]; O[e][i] = o; ssq += o * o; }
        ssq += __shfl_xor(ssq, 32);
        const float sc = rsqrtf(ssq * (1.f / 128.f) + 1e-6f) * (1.f - lam_init);
        bf16_t* op = Qb + (size_t)(qrow0 + qt * 32 + r) * 1024 + hd * 128;
#pragma unroll
        for (int e = 0; e < 4; ++e)
#pragma unroll
            for (int g4 = 0; g4 < 4; ++g4) {
                const int e0 = e * 32 + 8 * g4 + 4 * h; const f32x4 sg = *(const f32x4*)(subg + e0);
                u32x2 o; o.x = pkbf(O[e][4 * g4 + 0] * sc * sg.x, O[e][4 * g4 + 1] * sc * sg.y); o.y = pkbf(O[e][4 * g4 + 2] * sc * sg.z, O[e][4 * g4 + 3] * sc * sg.w);
                *(u32x2*)(op + e0) = o;
            }
    }
    __syncthreads();
}
__device__ __forceinline__ void ph_attn(const TI ti, CArgs& a, int l, bool ctx_out, unsigned char* ldsg) {
    const int lane = ti.tid & 63;
    const float gqm = fabsf(a.in[12][l * 64 + lane]), gkm = fabsf(a.in[13][l * 64 + lane]);
    float mq = gqm, mk = gkm;
#pragma unroll
    for (int o = 1; o < 64; o <<= 1) { mq = fmaxf(mq, __shfl_xor(mq, o)); mk = fmaxf(mk, __shfl_xor(mk, o)); }
    const float mfix = 8.f * mq * mk * 1.4426950408889634f * 1.03f;
    const float* lp = a.in[14] + l * 256;
    const float s1 = wave_sum(lp[lane] * lp[64 + lane]), s2 = wave_sum(lp[128 + lane] * lp[192 + lane]);
    const float lam_init = 0.8f - 0.6f * expf(-0.3f * (float)l);
    const float lam = expf(s1) - expf(s2) + lam_init;
    const float* subg = a.in[15] + l * 128;
    const int nun = 1024 + (ctx_out ? 128 : 0);
    for (int u = ti.bid; u < nun; u += ti.nblk) {
        if (u < 1024) { const int bh = u >> 4, qb = u & 15; attn_unit(ti, a, bh >> 3, bh & 7, (bh >> 3) * 2048 + qb * 128, 0, 36, mfix, lam, lam_init, subg, ldsg); }
        else { const int v = u - 1024, bh = v >> 1, qb = v & 1; attn_unit(ti, a, bh >> 3, bh & 7, ML + (bh >> 3) * 256 + qb * 128, 32, 36, mfix, lam, lam_init, subg, ldsg); }
    }
}

__device__ __forceinline__ void up8(const bf16_t* p, float (&x)[8]) { const u32x4 v = *(const u32x4*)p;
#pragma unroll
    for (int i = 0; i < 4; ++i) { x[2 * i] = bf2f(v[i] & 0xffffu); x[2 * i + 1] = bf2f(v[i] >> 16); } }
__device__ __forceinline__ void ld8f(const float* p, float (&x)[8]) { const f32x4 u = *(const f32x4*)p, v = *(const f32x4*)(p + 4); x[0] = u.x; x[1] = u.y; x[2] = u.z; x[3] = u.w; x[4] = v.x; x[5] = v.y; x[6] = v.z; x[7] = v.w; }
__device__ __forceinline__ void shift8(const bf16_t* p, const float* mu, bool hp, bool hn, float (&z)[8]) {
    float x[8], xp[8], xn[8], m[8];
#pragma unroll
    for (int j = 0; j < 8; ++j) { xp[j] = 0.f; xn[j] = 0.f; }
    up8(p, x); if (hp) up8(p - RWP, xp); if (hn) up8(p + RWP, xn); ld8f(mu, m);
#pragma unroll
    for (int j = 0; j < 8; ++j) z[j] = x[j] + m[j] * (0.5f * (xp[j] + xn[j]) - x[j]);
}
__device__ __forceinline__ void rwkv_out_rows(CArgs& a, int l, int nrows, int gw, int ngw, int lane) {
    const bf16_t* RW = (const bf16_t*)(a.ws + WS_RW); const bf16_t* Y0 = (const bf16_t*)(a.ws + WS_H); bf16_t* Y1 = (bf16_t*)(a.ws + WS_Y1);
    const bf16_t* A0 = (const bf16_t*)(a.ws + WS_AA0); const bf16_t* A1 = (const bf16_t*)(a.ws + WS_AA1); const bf16_t* G = (const bf16_t*)(a.ws + WS_G);
    const float* mu = a.in[16] + l * 3488;
    for (int it = gw; it < 2 * nrows; it += ngw) {
        const int row = it >> 1, c0 = (it & 1) * 512 + 8 * lane;
        int t, Tn; if (row < ML) { t = row & 2047; Tn = 2048; } else { t = (row - ML) & 255; Tn = 256; }
        const bool hp = t > 0, hn = t < Tn - 1;
        const size_t idx = (size_t)row * 1024 + c0;
        float y[8], y1[8], g[8], a0[8], a1[8], zr[8], zk[8], zv[8], lnw[8], lnb[8], ka[8], rk[8];
        up8(Y0 + idx, y); up8(Y1 + idx, y1); up8(G + idx, g); up8(A0 + idx, a0); up8(A1 + idx, a1);
        const bf16_t* p = RW + (size_t)row * RWP + c0;
        shift8(p, mu + c0, hp, hn, zr); shift8(p + 1024, mu + 1024 + c0, hp, hn, zk); shift8(p + 2048, mu + 2048 + c0, hp, hn, zv);
        ld8f(a.in[25] + l * 1024 + c0, lnw); ld8f(a.in[26] + l * 1024 + c0, lnb); ld8f(a.in[23] + l * 1024 + c0, ka); ld8f(a.in[24] + l * 1024 + c0, rk);
        float sm = 0.f;
#pragma unroll
        for (int j = 0; j < 8; ++j) { y[j] += y1[j]; sm += y[j]; }
        const float mean = dpp_sum8(sm) * (1.f / 64.f);
        float sv = 0.f, sb = 0.f;
#pragma unroll
        for (int j = 0; j < 8; ++j) { y[j] -= mean; sv += y[j] * y[j]; const float kds = zk[j] * ((1.f + (a0[j] - 1.f) * ka[j]) + (1.f + (a1[j] - 1.f) * ka[j])); sb += zr[j] * kds * rk[j]; }
        const float rstd = rsqrtf(dpp_sum8(sv) * (1.f / 64.f) + 64e-5f), bsum = dpp_sum8(sb);
        u32x4 o;
#pragma unroll
        for (int j = 0; j < 4; ++j) o[j] = pkbf(((y[2 * j] * rstd * lnw[2 * j] + lnb[2 * j]) + bsum * zv[2 * j]) * g[2 * j], ((y[2 * j + 1] * rstd * lnw[2 * j + 1] + lnb[2 * j + 1]) + bsum * zv[2 * j + 1]) * g[2 * j + 1]);
        *(u32x4*)(Y1 + idx) = o;
    }
}

#define XB_TMO      128
#define XB_XCNT(j)  (256  + 64 * (j))
#define XB_XSUB(j)  (1280 + 64 * (j))
#define XB_XGEN(j)  (2304 + 64 * (j))
#define XB_TOP      3328
#define XB_TOPGEN   3392
#define XCD_BAR_WORDS 3456
#define XB_SPIN_CAP (1u << 20)

__device__ __forceinline__ unsigned xb_ld(unsigned* p)              { return __hip_atomic_load(p, __ATOMIC_RELAXED, __HIP_MEMORY_SCOPE_AGENT); }
__device__ __forceinline__ unsigned xb_add(unsigned* p, unsigned v) { return __hip_atomic_fetch_add(p, v, __ATOMIC_RELAXED, __HIP_MEMORY_SCOPE_AGENT); }
__device__ __forceinline__ unsigned xb_xcc_id() { return (unsigned)__builtin_amdgcn_s_getreg((3 << 11) | 20) & 0xFu; }
#define XB_SPIN(cond, bar) do { unsigned _sp = 0; while (cond) { __builtin_amdgcn_s_sleep(1); \
    if ((++_sp & 255u) == 0u) { if (xb_ld(&(bar)[XB_TMO])) break; if (_sp > XB_SPIN_CAP) { atomicAdd(&(bar)[XB_TMO], 1u); break; } } } } while (0)

struct XcdBarrier {
    unsigned* bar; unsigned x;
    volatile LAS unsigned* st;
};

__device__ __forceinline__ XcdBarrier xcd_barrier_post(unsigned* bar, volatile LAS unsigned* st) {
    XcdBarrier b; b.bar = bar; b.x = xb_xcc_id(); b.st = st;
    if (threadIdx.x == 0) (void)xb_add(&bar[XB_XCNT(b.x)], 1u);
    return b;
}
__device__ __forceinline__ void xcd_barrier_complete(unsigned* bar, unsigned x, unsigned& nloc, unsigned& nx) {
    const unsigned G = gridDim.x * gridDim.y * gridDim.z;
    unsigned sum, cnt, mine, sp = 0u;
    for (;;) {
        sum = 0u; cnt = 0u; mine = 0u;
#pragma unroll
        for (unsigned j = 0; j < 16; ++j) { const unsigned c = xb_ld(&bar[XB_XCNT(j)]); sum += c; cnt += (c > 0u) ? 1u : 0u; mine = (j == x) ? c : mine; }
        if (sum == G) break;
        __builtin_amdgcn_s_sleep(1);
        if ((++sp & 255u) == 0u) { if (xb_ld(&bar[XB_TMO])) break; if (sp > XB_SPIN_CAP) { atomicAdd(&bar[XB_TMO], 1u); break; } }
    }
    nloc = mine > 0u ? mine : 1u; nx = cnt > 0u ? cnt : 1u;
}

__device__ __forceinline__ void xcd_barrier(const XcdBarrier& b) {
    asm volatile("s_waitcnt vmcnt(0)" ::: "memory");
    __syncthreads();
    if (threadIdx.x == 0) {
        unsigned* bar = b.bar;
        __builtin_amdgcn_s_waitcnt(0);
        unsigned nloc = b.st[0], nx = b.st[1];
        if (nloc == 0u) { xcd_barrier_complete(bar, b.x, nloc, nx); b.st[0] = nloc; b.st[1] = nx; }
        const unsigned old = xb_add(&bar[XB_XSUB(b.x)], 1u);
        const unsigned gen = old / nloc;
        if (old + 1u == (gen + 1u) * nloc) {
            __builtin_amdgcn_fence(__ATOMIC_RELEASE, "agent");
            asm volatile("s_waitcnt vmcnt(0)" ::: "memory");
            const unsigned og = xb_add(&bar[XB_TOP], 1u);
            const unsigned tg = og / nx;
            if (og + 1u == (tg + 1u) * nx) xb_add(&bar[XB_TOPGEN], 1u);
            else XB_SPIN(xb_ld(&bar[XB_TOPGEN]) == tg, bar);
            __builtin_amdgcn_fence(__ATOMIC_ACQUIRE, "agent");
            xb_add(&bar[XB_XGEN(b.x)], 1u);
            asm volatile("s_waitcnt vmcnt(0)" ::: "memory");
        } else {
            XB_SPIN(xb_ld(&bar[XB_XGEN(b.x)]) == gen, bar);
            __builtin_amdgcn_fence(__ATOMIC_ACQUIRE, "agent");
            asm volatile("s_waitcnt vmcnt(0)" ::: "memory");
        }
    }
    __syncthreads();
}

#ifndef ONLY_PH
#define ONLY_PH -1
#endif
#ifndef SKIP_PH
#define SKIP_PH -2
#endif
#define PH_ON(k) ((ONLY_PH < 0 || ONLY_PH == (k)) && (k) != SKIP_PH)
__global__ void __launch_bounds__(512, 2) mega_fwd(Args a_) {
    extern __shared__ __attribute__((aligned(16))) unsigned char lds[];
    cg::grid_group grid = cg::this_grid();
    const int ph_lo = a_.lo, ph_hi = a_.hi;
    volatile LAS unsigned* bst = (volatile LAS unsigned*)((LAS unsigned char*)lds + 131072);
    if (threadIdx.x < 2) bst[threadIdx.x] = 0u;
    __syncthreads();
    const XcdBarrier xbar = xcd_barrier_post((unsigned*)(a_.ws + WS_BAR), bst);
    const int wave_s = __builtin_amdgcn_readfirstlane((int)threadIdx.x >> 6);
#pragma nounroll
    for (int ph = ph_lo; ph < ph_hi; ++ph) {
        CArgs* ap = (CArgs*)__builtin_amdgcn_kernarg_segment_ptr(); asm volatile("" : "+s"(ap));
        CArgs& a = *ap;
        unsigned char* ws = a.ws;
        float* XC = (float*)(ws + WS_XC);
        int wsv = wave_s; asm volatile("" : "+s"(wsv));
        TI ti; ti.tid = wsv * 64 + (int)__builtin_amdgcn_mbcnt_hi(~0u, __builtin_amdgcn_mbcnt_lo(~0u, 0u)); ti.bid = blockIdx.x; ti.nblk = gridDim.x;
        asm volatile("" : "+v"(ti.tid)); asm volatile("" : "+s"(ti.bid)); asm volatile("" : "+s"(ti.nblk));
        const int tid = ti.tid, lane = tid & 63, wv = __builtin_amdgcn_readfirstlane(tid >> 6);
        const int gw = ti.bid * 8 + wv, ngw = ti.nblk * 8;
        if (ph == 0) { if constexpr (PH_ON(100)) ph_mods(ti, a, lds); }
        else {
            const int l = (ph - 1) / NPH, k = (ph - 1) % NPH;
            const bool ctx_out = l < DEPTH - 1;
            const int Mr = ctx_out ? M : ML;
            const float* modl = (const float*)(ws + WS_MOD) + (size_t)l * 9 * 6144;
            const float* xl_in = l == 0 ? a.in[0] : a.out; const float* xc_in = l == 0 ? a.in[2] : XC;
            bf16_t* H = (bf16_t*)(ws + WS_H);
            switch (k) {
            case 0: if constexpr (PH_ON(0)) {
                norm_rows(xl_in, xc_in, a.in[6] + l * 1024, modl, 0, 1, H, M, gw, ngw, lane);
                ph_wconv(a, l, lds, gw, ngw, lane, wv, l == 0 ? 31 : 16);
                } break;
            case 1: if constexpr (PH_ON(1)) {
                OpIn op{(bf16_t*)(ws + WS_GU), (bf16_t*)(ws + WS_GV), (bf16_t*)(ws + WS_Q), (bf16_t*)(ws + WS_RW), (bf16_t*)(ws + WS_GT)};
                run_gemm(ti, lds, H, (const bf16_t*)(ws + WS_WIN), M, PPAD, 1024, op);
            } break;
            case 2: if constexpr (PH_ON(2)) {
                for (int u = ti.bid; u < Mr / 128; u += ti.nblk) gmlp_unit(ti, a, l, u, lds);
                qk_rows(a, l, gw, ngw, lane);
                lora_in_rows(a, l, gw, ngw, lane);
                } break;
            case 3: if constexpr (PH_ON(3)) {
                OpDec o1{(bf16_t*)(ws + WS_GV), (bf16_t*)(ws + WS_DEC1), a.in[17] + l * 2048};
                run_gemm(ti, lds, (const bf16_t*)(ws + WS_LIW), (const bf16_t*)(ws + WS_LWT), M, 2048, 128, o1);
                OpAA o2{(bf16_t*)(ws + WS_AA0), (bf16_t*)(ws + WS_AA1), a.in[19] + l * 2048};
                run_gemm(ti, lds, (const bf16_t*)(ws + WS_LIA), (const bf16_t*)(ws + WS_LAT), M, 2048, 128, o2);
                OpG o3{(bf16_t*)(ws + WS_G)};
                run_gemm(ti, lds, (const bf16_t*)(ws + WS_LIG), (const bf16_t*)(ws + WS_LGT), M, 1024, 256, o3);
            } break;
            case 4:
                if constexpr (PH_ON(4)) { for (int u = ti.bid; u < 256; u += ti.nblk) scan_unit_mfma(ti, a, l, u, ctx_out, lds); }
                if constexpr (PH_ON(40)) ph_attn(ti, a, l, ctx_out, lds);
                break;
            case 5: if constexpr (PH_ON(5)) {
                rwkv_out_rows(a, l, Mr, gw, ngw, lane);
                } break;
            case 6: if constexpr (PH_ON(6)) {
                const bf16_t* GT = (const bf16_t*)(ws + WS_GT); float* MF = (float*)(ws + WS_K);
                OpMerge<0> o0{GT, MF, H}; run_gemm(ti, lds, (const bf16_t*)(ws + WS_GU), (const bf16_t*)(ws + WS_WA), Mr, 1024, 1024, o0);
                OpMerge<1> o1{GT, MF, H}; run_gemm(ti, lds, (const bf16_t*)(ws + WS_Q), (const bf16_t*)(ws + WS_WB), Mr, 1024, 1024, o1);
                OpMerge<2> o2{GT, MF, H}; run_gemm(ti, lds, (const bf16_t*)(ws + WS_Y1), (const bf16_t*)(ws + WS_WC), Mr, 1024, 1024, o2);
                if (ctx_out && ti.nblk > 64 && ti.bid >= 32) ph_wconv(a, l + 1, lds, (ti.bid - 32) * 8 + wv, (ti.nblk - 32) * 8, lane, wv, 1);
                else if (ctx_out && ti.nblk <= 64) ph_wconv(a, l + 1, lds, gw, ngw, lane, wv, 1);
            } break;
            case 7: if constexpr (PH_ON(7)) {
                OpResid op{xl_in, xc_in, a.out, XC, modl, 2};
                run_gemm(ti, lds, H, (const bf16_t*)(ws + WS_WO), Mr, 1024, 1024, op);
                if (ctx_out && ti.nblk > 64 && ti.bid >= 32) ph_wconv(a, l + 1, lds, (ti.bid - 32) * 8 + wv, (ti.nblk - 32) * 8, lane, wv, 2);
                else if (ctx_out && ti.nblk <= 64) ph_wconv(a, l + 1, lds, gw, ngw, lane, wv, 2);
            } break;
            case 8: if constexpr (PH_ON(8)) {
                norm_rows(a.out, XC, a.in[7] + l * 1024, modl, 3, 4, H, Mr, gw, ngw, lane);
                } break;
            case 9: if constexpr (PH_ON(9)) {
                OpSwiglu op{(bf16_t*)(ws + WS_RW)};
                run_gemm(ti, lds, H, (const bf16_t*)(ws + WS_WI), Mr, 2 * DFF, 1024, op);
            } break;
            default: if constexpr (PH_ON(10)) {
                OpResid op{a.out, XC, a.out, XC, modl, 5};
                run_gemm(ti, lds, (const bf16_t*)(ws + WS_RW), (const bf16_t*)(ws + WS_WO2), Mr, 1024, DFF, op);
                if (ctx_out && ti.nblk > 64 && ti.bid >= 32) ph_wconv(a, l + 1, lds, (ti.bid - 32) * 8 + wv, (ti.nblk - 32) * 8, lane, wv, 12);
                else if (ctx_out && ti.nblk <= 64) ph_wconv(a, l + 1, lds, gw, ngw, lane, wv, 12);
            } break;
            }
        }
        if (ph + 1 < ph_hi) { if (ph == ph_lo) grid.sync(); else xcd_barrier(xbar); }
    }
}

extern "C" void kernel_launch(void* const* d_in, const int* in_sizes, int n_in, void* d_out, int out_size, void* d_ws, size_t ws_size, hipStream_t stream) {
    static int grid = 0;
    if (grid == 0) {
        if (n_in != 33 || out_size != ML * D || ws_size < WS_END) { fprintf(stderr, "kernel_launch: unexpected shapes / workspace (%d inputs, out %d, ws %zu, need %zu)\n", n_in, out_size, ws_size, (size_t)WS_END); grid = -1; return; }
        int dev = 0, cus = 0, per_cu = 0;
        hipGetDevice(&dev); hipDeviceGetAttribute(&cus, hipDeviceAttributeMultiprocessorCount, dev);
        if (hipFuncSetAttribute((const void*)mega_fwd, hipFuncAttributeMaxDynamicSharedMemorySize, LDS_BYTES) != hipSuccess) { fprintf(stderr, "kernel_launch: hipFuncSetAttribute failed\n"); grid = -1; return; }
        if (hipOccupancyMaxActiveBlocksPerMultiprocessor(&per_cu, (const void*)mega_fwd, 512, LDS_BYTES) != hipSuccess || per_cu < 1) per_cu = 1;
        (void)hipGetLastError();
        grid = cus * 1;
    }
    if (grid < 0) return;
    Args a{};
    for (int i = 0; i < 33; ++i) a.in[i] = (const float*)d_in[i];
    a.out = (float*)d_out; a.ws = (unsigned char*)d_ws; a.lo = 0; a.hi = NPHASES;
    void* args[] = {&a};
    if (hipMemsetAsync((char*)d_ws + WS_BAR, 0, BAR_BYTES, stream) != hipSuccess) { fprintf(stderr, "kernel_launch: memset of barrier words failed\n"); return; }
    hipError_t e = hipLaunchCooperativeKernel((const void*)mega_fwd, dim3(grid), dim3(512), args, LDS_BYTES, stream);
    if (e != hipSuccess) fprintf(stderr, "kernel_launch: cooperative launch failed: %s (grid %d)\n", hipGetErrorString(e), grid);
}
```

```cpp
#include <hip/hip_runtime.h>
#include <hip/hip_cooperative_groups.h>
#include <cstdio>
#include <cstdint>
namespace cg = cooperative_groups;
namespace pg8 {
#define PG8_LAS __attribute__((address_space(3)))
typedef unsigned short bf16_t;
typedef short bf16x8 __attribute__((ext_vector_type(8)));
typedef float f32x4 __attribute__((ext_vector_type(4)));
typedef unsigned u32x4 __attribute__((ext_vector_type(4)));
constexpr int BM = 256, BK = 64, HALF = 128, HTB = HALF * BK * 2  , STAGE_BYTES = 8 * HTB, NXCD = 8, WGM = 8;

__host__ __device__ __forceinline__ int lds_byte(int r, int c) { const int st = (r >> 4) * 2 + (c >> 5), rr = r & 15, cc = c & 31, ob = rr * 64 + cc * 2; return st * 1024 + (ob ^ (((ob >> 9) & 1) << 5)); }
__host__ __device__ __forceinline__ void stage_rc(int b, int& R, int& C) { const int st = b / 1024, sb = b % 1024, swz = sb ^ (((sb >> 9) & 1) << 5); R = (st >> 1) * 16 + swz / 64; C = (st & 1) * 32 + (swz % 64) / 2; }
__host__ __device__ __forceinline__ int perm32(int rho) { const int n = rho >> 4, i = rho & 15; return 8 * (i >> 2) + 4 * n + (i & 3); }

struct Unit { int pm, pn; };
struct Gemm { const bf16_t* A; const bf16_t* Bt; int M, N, K; };

struct StaticOrder {
    int nM, nN, nwg, G, c;
    __host__ __device__ void init(int M, int N, int G_, int c_) { nM = M / BM; nN = N / BM; nwg = nM * nN; G = G_; c = c_; }
    __host__ __device__ bool next(int i, Unit& u) const {
        const long L = (long)i * G + c; if (L >= nwg) return false;
        int wgid = (int)L; { const int q = nwg / NXCD, r = nwg % NXCD, xcd = wgid % NXCD, off = wgid / NXCD; wgid = (xcd < r ? xcd * (q + 1) : r * (q + 1) + (xcd - r) * q) + off; }
        const int nig = WGM * nN, gid = wgid / nig, fm = gid * WGM, gsz = (nM - fm) < WGM ? (nM - fm) : WGM;
        u.pm = fm + ((wgid % nig) % gsz); u.pn = (wgid % nig) / gsz; return true;
    }
    __device__ __forceinline__ void a_ready(const Unit&) const {}
    __device__ __forceinline__ void done(const Unit&) const {}
};

__device__ __forceinline__ unsigned cvt_pk_bf16(float lo, float hi) { unsigned r; asm volatile("v_cvt_pk_bf16_f32 %0, %1, %2" : "=v"(r) : "v"(lo), "v"(hi)); return r; }
typedef float f32x2 __attribute__((ext_vector_type(2)));
__device__ __forceinline__ f32x2 gelu_pk(f32x2 v) {
    const f32x2 av = __builtin_elementwise_abs(v), d = av * 0.2316418882f + 1.0f;
    f32x2 t; t.x = __builtin_amdgcn_rcpf(d.x); t.y = __builtin_amdgcn_rcpf(d.y);
    f32x2 q = t * 0.5307027145f + (-0.7265760135f); q = q * t + 0.7107068705f; q = q * t + (-0.142248368f); q = q * t + 0.127414796f; q = q * t;
    const f32x2 s = (v * v) * (-0.72134752044f);
    f32x2 e; e.x = __builtin_amdgcn_exp2f(s.x); e.y = __builtin_amdgcn_exp2f(s.y);
    const f32x2 m = v * (q * e), r = v - m;
    f32x2 o; o.x = v.x < 0.f ? m.x : r.x; o.y = v.y < 0.f ? m.y : r.y; return o;
}

template <class Epi, class Sched, bool ALIGN_EPI = false, bool SP2 = false>
__device__ __forceinline__ void gemm_phase(PG8_LAS unsigned char* lds, const Gemm g, const Sched& S, const Epi& E, const int tid_in) {
    const int tid = tid_in, wid = __builtin_amdgcn_readfirstlane(tid >> 6), lane = tid & 63, wr = wid >> 2, wc = wid & 3, fr = lane & 15, fq = lane >> 4;
    const int K = g.K, nt = K / BK;
    unsigned voffA[2], voffB[2];
#pragma unroll
    for (int i = 0; i < 2; ++i) { int R, C; stage_rc(tid * 16 + i * 8192, R, C); const int Rb = Epi::PERM ? ((R & ~31) + perm32(R & 31)) : R;
        voffA[i] = (unsigned)(R * K + C) * 2u; voffB[i] = (unsigned)(Rb * K + C) * 2u; }
    const size_t kstep = (size_t)(BK * 2);
    const size_t hstep = (size_t)HALF * K * 2;
    const size_t tstep = 2 * hstep;
    const unsigned ldsw = (unsigned)wid * 1024u;
    const int aoff = lds_byte(wr * 64 + fr, fq * 8), boff = lds_byte(wc * 32 + fr, fq * 8);
#define PG8_SA(b, h) (((b) * 2 + (h)) * HTB)
#define PG8_SB(b, h) ((4 + (b) * 2 + (h)) * HTB)
#define PG8_STAGE(bufoff, gbase, voff) do { _Pragma("unroll") for (int _i = 0; _i < 2; ++_i) \
        __builtin_amdgcn_global_load_lds((const unsigned*)((const char*)(gbase) + (voff)[_i]), (PG8_LAS unsigned*)(lds + (bufoff) + ldsw + _i * 8192), 16, 0, 0); } while (0)
#define PG8_LDA(dst, b, h) do { _Pragma("unroll") for (int m = 0; m < 4; ++m) _Pragma("unroll") for (int k = 0; k < 2; ++k) dst[m][k] = *(const PG8_LAS bf16x8*)(lds + PG8_SA(b, h) + aoff + m * 2048 + k * 1024); } while (0)
#define PG8_LDB(dst, b, h) do { _Pragma("unroll") for (int n = 0; n < 2; ++n) _Pragma("unroll") for (int k = 0; k < 2; ++k) dst[n][k] = *(const PG8_LAS bf16x8*)(lds + PG8_SB(b, h) + boff + n * 2048 + k * 1024); } while (0)
#define PG8_MMA(ai, bj, At, Bt) do { __builtin_amdgcn_s_setprio(1); _Pragma("unroll") for (int m = 0; m < 4; ++m) _Pragma("unroll") for (int n = 0; n < 2; ++n) _Pragma("unroll") for (int k = 0; k < 2; ++k) \
        acc[ai][bj][m][n] = __builtin_amdgcn_mfma_f32_16x16x32_bf16(Bt[n][k], At[m][k], acc[ai][bj][m][n], 0, 0, 0); __builtin_amdgcn_s_setprio(0); } while (0)
#define PG8_WAIT_V(n) asm volatile("s_waitcnt vmcnt(" #n ")" ::: "memory")
#define PG8_WAIT_L(n) asm volatile("s_waitcnt lgkmcnt(" #n ")" ::: "memory")
#define PG8_BAR __builtin_amdgcn_s_barrier()
#define PG8_SCHED __builtin_amdgcn_sched_barrier(0)
    Unit cur, nxt; int ui = 0;
    if (!S.next(0, cur)) return;
    f32x4 acc[2][2][4][2];
#pragma unroll
    for (int a = 0; a < 2; ++a)
#pragma unroll
        for (int b = 0; b < 2; ++b)
#pragma unroll
            for (int m = 0; m < 4; ++m)
#pragma unroll
                for (int n = 0; n < 2; ++n) acc[a][b][m][n] = (f32x4){0.f, 0.f, 0.f, 0.f};
    bf16x8 At[4][2], B0[2][2], B1[2][2];
    const char* cA = (const char*)g.A + (size_t)cur.pm * tstep; const char* cB = (const char*)g.Bt + (size_t)cur.pn * tstep;
    S.a_ready(cur);
    if constexpr (SP2) {
        PG8_STAGE(PG8_SB(0, 0), cB, voffB); PG8_STAGE(PG8_SB(0, 1), cB + hstep, voffB); PG8_STAGE(PG8_SA(0, 0), cA, voffA); PG8_STAGE(PG8_SA(0, 1), cA + hstep, voffA);
        if (wr == 1) PG8_BAR;
        PG8_WAIT_V(2); PG8_BAR;
        PG8_STAGE(PG8_SB(1, 0), cB + kstep, voffB); PG8_STAGE(PG8_SA(1, 0), cA + kstep, voffA); PG8_STAGE(PG8_SB(1, 1), cB + hstep + kstep, voffB);
        PG8_WAIT_V(6); PG8_BAR;
    } else {
        PG8_STAGE(PG8_SB(0, 0), cB, voffB); PG8_STAGE(PG8_SA(0, 0), cA, voffA); PG8_STAGE(PG8_SB(0, 1), cB + hstep, voffB); PG8_STAGE(PG8_SA(0, 1), cA + hstep, voffA);
        if (wr == 1) PG8_BAR;
        PG8_WAIT_V(4); PG8_BAR;
        PG8_STAGE(PG8_SB(1, 0), cB + kstep, voffB); PG8_STAGE(PG8_SA(1, 0), cA + kstep, voffA); PG8_STAGE(PG8_SB(1, 1), cB + hstep + kstep, voffB);
        PG8_WAIT_V(6); PG8_BAR;
    }
    for (;;) {
        const bool has_next = S.next(ui + 1, nxt);
        const char* nA = has_next ? (const char*)g.A + (size_t)nxt.pm * tstep : cA; const char* nB = has_next ? (const char*)g.Bt + (size_t)nxt.pn * tstep : cB;
        for (int t = 0; t < nt; t += 2) {
            const bool last = (t == nt - 2);
            const char* a1 = cA + (size_t)(t + 1) * kstep;
            const char* a2 = last ? nA : cA + (size_t)(t + 2) * kstep; const char* b2 = last ? nB : cB + (size_t)(t + 2) * kstep;
            const char* a3 = a2 + kstep; const char* b3 = b2 + kstep;
            if (last && has_next) S.a_ready(nxt);
            if constexpr (SP2) {
            PG8_LDB(B0, 0, 0); PG8_LDB(B1, 0, 1); PG8_SCHED; PG8_LDA(At, 0, 0); PG8_STAGE(PG8_SA(1, 1), a1 + hstep, voffA);
            PG8_WAIT_V(8); PG8_WAIT_L(0); PG8_BAR; PG8_MMA(0, 0, At, B0); PG8_MMA(0, 1, At, B1); PG8_BAR; PG8_SCHED;
            PG8_LDA(At, 0, 1); PG8_STAGE(PG8_SB(0, 0), b2, voffB); PG8_STAGE(PG8_SB(0, 1), b2 + hstep, voffB); PG8_STAGE(PG8_SA(0, 0), a2, voffA);
            PG8_WAIT_V(8); PG8_WAIT_L(0); PG8_BAR; PG8_MMA(1, 0, At, B0); PG8_MMA(1, 1, At, B1); PG8_BAR; PG8_SCHED;
            PG8_LDB(B0, 1, 0); PG8_LDB(B1, 1, 1); PG8_SCHED; PG8_LDA(At, 1, 0); PG8_STAGE(PG8_SA(0, 1), a2 + hstep, voffA);
            PG8_WAIT_V(8); PG8_WAIT_L(0); PG8_BAR; PG8_MMA(0, 0, At, B0); PG8_MMA(0, 1, At, B1); PG8_BAR; PG8_SCHED;
            PG8_LDA(At, 1, 1); PG8_STAGE(PG8_SB(1, 0), b3, voffB); PG8_STAGE(PG8_SB(1, 1), b3 + hstep, voffB); PG8_STAGE(PG8_SA(1, 0), a3, voffA);
            PG8_WAIT_V(8); PG8_WAIT_L(0); PG8_BAR; PG8_MMA(1, 0, At, B0); PG8_MMA(1, 1, At, B1); PG8_BAR; PG8_SCHED;
            } else {
            PG8_LDB(B0, 0, 0); PG8_SCHED; PG8_LDA(At, 0, 0); PG8_STAGE(PG8_SA(1, 1), a1 + hstep, voffA);
            PG8_WAIT_L(8); PG8_BAR; PG8_WAIT_L(0); PG8_MMA(0, 0, At, B0); PG8_BAR; PG8_SCHED;
            PG8_LDB(B1, 0, 1); PG8_STAGE(PG8_SB(0, 0), b2, voffB);
            PG8_BAR; PG8_WAIT_L(0); PG8_MMA(0, 1, At, B1); PG8_BAR;
            PG8_LDA(At, 0, 1); PG8_STAGE(PG8_SA(0, 0), a2, voffA);
            PG8_BAR; PG8_WAIT_L(0); PG8_MMA(1, 0, At, B0); PG8_BAR; PG8_SCHED;
            PG8_STAGE(PG8_SB(0, 1), b2 + hstep, voffB);
            PG8_WAIT_V(6); PG8_BAR; PG8_MMA(1, 1, At, B1); PG8_BAR;
            PG8_LDB(B0, 1, 0); PG8_SCHED; PG8_LDA(At, 1, 0); PG8_STAGE(PG8_SA(0, 1), a2 + hstep, voffA);
            PG8_WAIT_L(8); PG8_BAR; PG8_WAIT_L(0); PG8_MMA(0, 0, At, B0); PG8_BAR; PG8_SCHED;
            PG8_LDB(B1, 1, 1); PG8_STAGE(PG8_SB(1, 0), b3, voffB);
            PG8_BAR; PG8_WAIT_L(0); PG8_MMA(0, 1, At, B1); PG8_BAR;
            PG8_LDA(At, 1, 1); PG8_STAGE(PG8_SA(1, 0), a3, voffA);
            PG8_BAR; PG8_WAIT_L(0); PG8_MMA(1, 0, At, B0); PG8_BAR; PG8_SCHED;
            PG8_STAGE(PG8_SB(1, 1), b3 + hstep, voffB);
            PG8_WAIT_V(6); PG8_BAR; PG8_MMA(1, 1, At, B1); PG8_BAR;
            }
        }
        if constexpr (ALIGN_EPI) { if (wr == 0) PG8_BAR; }
        if constexpr (!Epi::AFTER_DRAIN) { E(acc, cur, wr, wc, fr, fq); S.done(cur); }
        if (!has_next) break;
#pragma unroll
        for (int a = 0; a < 2; ++a)
#pragma unroll
            for (int b = 0; b < 2; ++b)
#pragma unroll
                for (int m = 0; m < 4; ++m)
#pragma unroll
                    for (int n = 0; n < 2; ++n) acc[a][b][m][n] = (f32x4){0.f, 0.f, 0.f, 0.f};
        cur = nxt; cA = nA; cB = nB; ++ui;
        if constexpr (ALIGN_EPI) { if (wr == 1) PG8_BAR; }
    }
    PG8_WAIT_V(0);
    if constexpr (!ALIGN_EPI) { if (wr == 0) PG8_BAR; }
    PG8_BAR;
    if constexpr (Epi::AFTER_DRAIN) { E.fused(acc, cur, wr, wc, fr, fq, lds, wid, lane); S.done(cur); }
#undef PG8_SA
#undef PG8_SB
#undef PG8_STAGE
#undef PG8_LDA
#undef PG8_LDB
#undef PG8_MMA
#undef PG8_WAIT_V
#undef PG8_WAIT_L
#undef PG8_BAR
#undef PG8_SCHED
}
}

#define LAS __attribute__((address_space(3)))
typedef unsigned short bf16_t;
typedef float f32x2 __attribute__((ext_vector_type(2)));
typedef float f32x4 __attribute__((ext_vector_type(4)));
typedef float f32x16 __attribute__((ext_vector_type(16)));
typedef short bf16x8 __attribute__((ext_vector_type(8)));
typedef short s16x4 __attribute__((ext_vector_type(4)));
typedef unsigned u32x4 __attribute__((ext_vector_type(4)));
typedef unsigned u32x2 __attribute__((ext_vector_type(2)));
typedef __bf16 bf16x2v __attribute__((ext_vector_type(2)));
#define MFMA32(a, b, c) __builtin_amdgcn_mfma_f32_32x32x16_bf16((a), (b), (c), 0, 0, 0)

constexpr int D = 1024, NB = 8, TL = 2048, TCX = 256, DEPTH = 4;
constexpr int ML = NB * TL, MC = NB * TCX, M = ML + MC;
constexpr int PPAD = 11776, RWP = 3584, DFF = 2816;
constexpr int NPH = 11, NPHASES = 1 + DEPTH * NPH;
constexpr size_t MiB = 1u << 20;
constexpr size_t WS_MOD = 0, WS_WIN = 1 * MiB, WS_WA = 24 * MiB, WS_WB = 26 * MiB, WS_WC = 28 * MiB, WS_WO = 30 * MiB, WS_WI = 32 * MiB, WS_WO2 = 43 * MiB,
                 WS_LWT = 48 * MiB + MiB / 2, WS_LAT = 49 * MiB, WS_LGT = 49 * MiB + MiB / 2, WS_H = 50 * MiB, WS_XC = 86 * MiB, WS_GU = 94 * MiB, WS_GV = 130 * MiB,
                 WS_Q = 166 * MiB, WS_K = 202 * MiB, WS_V = 238 * MiB, WS_RW = 274 * MiB, WS_GT = 400 * MiB, WS_LIW = 508 * MiB, WS_LIA = 512 * MiB + MiB / 2,
                 WS_LIG = 517 * MiB, WS_DEC1 = 526 * MiB, WS_AA0 = 562 * MiB, WS_AA1 = 598 * MiB, WS_G = 634 * MiB, WS_Y1 = 670 * MiB, WS_ROPE = 706 * MiB, WS_END = 707 * MiB;
constexpr int LDS_BYTES = 131072 + 1024;
constexpr size_t WS_BAR = 917504, BAR_BYTES = 16384;
constexpr float QSCALE = 0.125f * 1.4426950408889634f;

struct Args { const float* in[33]; float* out; unsigned char* ws; int lo, hi; };
typedef const __attribute__((address_space(4))) Args CArgs;
struct TI { int tid, bid, nblk; };

__device__ __forceinline__ float bf2f(unsigned v) { return __uint_as_float(v << 16); }
__device__ __forceinline__ unsigned pkbf(float lo, float hi) { f32x2 v = {lo, hi}; bf16x2v b = __builtin_convertvector(v, bf16x2v); return __builtin_bit_cast(unsigned, b); }
__device__ __forceinline__ bf16_t f2bf(float f) { return (bf16_t)(pkbf(f, 0.f) & 0xffffu); }
#define DPP_ADD(x, ctrl) ((x) + __builtin_bit_cast(float, __builtin_amdgcn_update_dpp(0, __builtin_bit_cast(int, (x)), (ctrl), 0xf, 0xf, true)))
__device__ __forceinline__ float wave_sum(float v) {
    v = DPP_ADD(v, 0xB1); v = DPP_ADD(v, 0x4E); v = DPP_ADD(v, 0x141); v = DPP_ADD(v, 0x140);
    const int iv = __builtin_bit_cast(int, v);
    const float s0 = __builtin_bit_cast(float, __builtin_amdgcn_readlane(iv, 0)), s1 = __builtin_bit_cast(float, __builtin_amdgcn_readlane(iv, 16)),
                s2 = __builtin_bit_cast(float, __builtin_amdgcn_readlane(iv, 32)), s3 = __builtin_bit_cast(float, __builtin_amdgcn_readlane(iv, 48));
    return (s0 + s1) + (s2 + s3);
}
__device__ __forceinline__ float dpp_sum8(float x) {
    x += __builtin_bit_cast(float, __builtin_amdgcn_update_dpp(0, __builtin_bit_cast(int, x), 0xB1, 0xf, 0xf, true));
    x += __builtin_bit_cast(float, __builtin_amdgcn_update_dpp(0, __builtin_bit_cast(int, x), 0x4E, 0xf, 0xf, true));
    x += __builtin_bit_cast(float, __builtin_amdgcn_update_dpp(0, __builtin_bit_cast(int, x), 0x141, 0xf, 0xf, true));
    return x;
}
__device__ __forceinline__ float quad_sum(float x) { x = DPP_ADD(x, 0xB1); x = DPP_ADD(x, 0x4E); return x; }
__device__ __forceinline__ float quad_xor2(float x) { return __builtin_bit_cast(float, __builtin_amdgcn_update_dpp(0, __builtin_bit_cast(int, x), 0x4E, 0xf, 0xf, true)); }
__device__ __forceinline__ void unpack16(const bf16_t* p, float (&x)[16]) {
    const u32x4 a = *(const u32x4*)p, b = *(const u32x4*)(p + 8);
#pragma unroll
    for (int i = 0; i < 4; ++i) { x[2 * i] = bf2f(a[i] & 0xffffu); x[2 * i + 1] = bf2f(a[i] >> 16); x[8 + 2 * i] = bf2f(b[i] & 0xffffu); x[8 + 2 * i + 1] = bf2f(b[i] >> 16); }
}
__device__ __forceinline__ void pack16(bf16_t* p, const float (&x)[16]) {
    u32x4 a, b;
#pragma unroll
    for (int i = 0; i < 4; ++i) { a[i] = pkbf(x[2 * i], x[2 * i + 1]); b[i] = pkbf(x[8 + 2 * i], x[8 + 2 * i + 1]); }
    *(u32x4*)p = a; *(u32x4*)(p + 8) = b;
}
__device__ __forceinline__ void load16f(const float* p, float (&x)[16]) {
#pragma unroll
    for (int i = 0; i < 4; ++i) { const f32x4 v = *(const f32x4*)(p + 4 * i); x[4 * i] = v.x; x[4 * i + 1] = v.y; x[4 * i + 2] = v.z; x[4 * i + 3] = v.w; }
}
__device__ __forceinline__ float sigmoidf_(float x) { return 1.f / (1.f + __expf(-x)); }

typedef const __attribute__((address_space(1))) bf16_t* gcptr_t;
__device__ __forceinline__ gcptr_t uniptr(const bf16_t* p) {
    const unsigned long long v = (unsigned long long)p;
    const unsigned lo = __builtin_amdgcn_readfirstlane((unsigned)v), hi = __builtin_amdgcn_readfirstlane((unsigned)(v >> 32));
    return (gcptr_t)(((unsigned long long)hi << 32) | lo);
}
template <class Op> struct EpiT {
    static constexpr bool PERM = true, AFTER_DRAIN = false;
    Op op;
    __device__ __forceinline__ void operator()(const pg8::f32x4 (&acc)[2][2][4][2], const pg8::Unit& u, int wr, int wc, int fr, int fq) const {
        const int row0 = u.pm * 256 + wr * 64 + fr, col0 = u.pn * 256 + wc * 32 + 8 * fq;
#pragma unroll
        for (int ai = 0; ai < 2; ++ai)
#pragma unroll
            for (int m = 0; m < 4; ++m)
#pragma unroll
                for (int bj = 0; bj < 2; ++bj) { op(row0 + ai * 128 + m * 16, col0 + bj * 128, acc[ai][bj][m][0], acc[ai][bj][m][1]); asm volatile("" ::: "memory"); }
    }
};
__device__ __forceinline__ u32x4 pack8(f32x4 v0, f32x4 v1) { u32x4 o; o.x = pkbf(v0.x, v0.y); o.y = pkbf(v0.z, v0.w); o.z = pkbf(v1.x, v1.y); o.w = pkbf(v1.z, v1.w); return o; }
__device__ __forceinline__ void unpack8(u32x4 x, f32x4& v0, f32x4& v1) {
    v0.x = bf2f(x.x & 0xffffu); v0.y = bf2f(x.x >> 16); v0.z = bf2f(x.y & 0xffffu); v0.w = bf2f(x.y >> 16);
    v1.x = bf2f(x.z & 0xffffu); v1.y = bf2f(x.z >> 16); v1.z = bf2f(x.w & 0xffffu); v1.w = bf2f(x.w >> 16);
}
__device__ __forceinline__ f32x4 gelu4(f32x4 v) { pg8::f32x2 a = pg8::gelu_pk((pg8::f32x2){v.x, v.y}), b = pg8::gelu_pk((pg8::f32x2){v.z, v.w}); return (f32x4){a.x, a.y, b.x, b.y}; }
__device__ __forceinline__ f32x4 sig4(f32x4 v) { return (f32x4){sigmoidf_(v.x), sigmoidf_(v.y), sigmoidf_(v.z), sigmoidf_(v.w)}; }

struct OpIn {
    bf16_t *GU, *GV, *Q, *RW, *GT;
    __device__ __forceinline__ void operator()(int row, int col, f32x4 v0, f32x4 v1) const {
        bf16_t* dst;
        if (col < 2048) { v0 = gelu4(v0); v1 = gelu4(v1); dst = (col < 1024 ? GU : GV) + (size_t)row * 1024 + (col & 1023); }
        else if (col < 5120) { const int q = col - 2048; dst = Q + (size_t)(q >> 10) * (size_t)(18 * MiB) + (size_t)row * 1024 + (q & 1023); }
        else if (col < 8704) { dst = RW + (size_t)row * RWP + (col - 5120); }
        else { v0 = sig4(v0); v1 = sig4(v1); dst = GT + (size_t)row * 3072 + (col - 8704); }
        *(u32x4*)dst = pack8(v0, v1);
    }
};
struct OpDec {
    bf16_t *D0, *D1; const float* w0;
    __device__ __forceinline__ float f(float x) const { return -0.6065306597126334f * sigmoidf_(x); }
    __device__ __forceinline__ void operator()(int row, int col, f32x4 v0, f32x4 v1) const {
        const f32x4 b0 = *(const f32x4*)(w0 + col), b1 = *(const f32x4*)(w0 + col + 4);
        v0 += b0; v1 += b1;
        v0 = (f32x4){f(v0.x), f(v0.y), f(v0.z), f(v0.w)}; v1 = (f32x4){f(v1.x), f(v1.y), f(v1.z), f(v1.w)};
        bf16_t* dst = (col < 1024 ? D0 : D1) + (size_t)row * 1024 + (col & 1023);
        *(u32x4*)dst = pack8(v0, v1);
    }
};
struct OpAA {
    bf16_t *A0, *A1; const float* a0;
    __device__ __forceinline__ void operator()(int row, int col, f32x4 v0, f32x4 v1) const {
        const f32x4 b0 = *(const f32x4*)(a0 + col), b1 = *(const f32x4*)(a0 + col + 4);
        v0 = sig4(v0 + b0); v1 = sig4(v1 + b1);
        bf16_t* dst = (col < 1024 ? A0 : A1) + (size_t)row * 1024 + (col & 1023);
        *(u32x4*)dst = pack8(v0, v1);
    }
};
struct OpG {
    bf16_t* G;
    __device__ __forceinline__ void operator()(int row, int col, f32x4 v0, f32x4 v1) const { *(u32x4*)(G + (size_t)row * 1024 + col) = pack8(v0, v1); }
};
template <int KB> struct OpMerge {
    const bf16_t* GT; float* MF; bf16_t* MB;
    __device__ __forceinline__ void operator()(int row, int col, f32x4 v0, f32x4 v1) const {
        f32x4 g0, g1; unpack8(*(const u32x4*)(GT + (size_t)row * 3072 + KB * 1024 + col), g0, g1);
        float* mf = MF + (size_t)row * 1024 + col;
        f32x4 r0 = g0 * v0, r1 = g1 * v1;
        if (KB > 0) { r0 += *(const f32x4*)mf; r1 += *(const f32x4*)(mf + 4); }
        if (KB < 2) { *(f32x4*)mf = r0; *(f32x4*)(mf + 4) = r1; }
        else *(u32x4*)(MB + (size_t)row * 1024 + col) = pack8(r0, r1);
    }
};
struct OpResid {
    const float *xl, *xc; float *ol, *oc; const float* mod; int gi;
    __device__ __forceinline__ void operator()(int row, int col, f32x4 v0, f32x4 v1) const {
        const float* xi; float* xo; const float* g;
        if (row < ML) { xi = xl + (size_t)row * 1024 + col; xo = ol + (size_t)row * 1024 + col; g = mod + (size_t)(row >> 11) * 6144 + gi * 1024 + col; }
        else { const size_t rr = (size_t)(row - ML) * 1024 + col; xi = xc + rr; xo = oc + rr; g = mod + (size_t)8 * 6144 + gi * 1024 + col; }
        const f32x4 x0 = *(const f32x4*)xi, x1 = *(const f32x4*)(xi + 4), g0 = *(const f32x4*)g, g1 = *(const f32x4*)(g + 4);
        *(f32x4*)xo = x0 + g0 * v0; *(f32x4*)(xo + 4) = x1 + g1 * v1;
    }
};
struct OpSwiglu {
    bf16_t* HID;
    __device__ __forceinline__ void operator()(int row, int col, f32x4 v0, f32x4 v1) const {
        const float h0 = v0.x * sigmoidf_(v0.x) * v0.y, h1 = v0.z * sigmoidf_(v0.z) * v0.w, h2 = v1.x * sigmoidf_(v1.x) * v1.y, h3 = v1.z * sigmoidf_(v1.z) * v1.w;
        u32x2 o; o.x = pkbf(h0, h1); o.y = pkbf(h2, h3);
        *(u32x2*)(HID + (size_t)row * DFF + (col >> 1)) = o;
    }
};
template <class Op> __device__ __forceinline__ void run_gemm(const TI ti, unsigned char* lds, const bf16_t* A, const bf16_t* Bt, int Mr, int N, int K, const Op& op) {
    int Kv = K; asm volatile("" : "+s"(Kv));
    pg8::Gemm g{A, Bt, Mr, N, Kv}; pg8::StaticOrder S; S.init(Mr, N, ti.nblk, ti.bid);
    EpiT<Op> E{op};
    pg8::gemm_phase<EpiT<Op>, pg8::StaticOrder, true, true>((PG8_LAS unsigned char*)lds, g, S, E, ti.tid);
}

__device__ __forceinline__ void ph_mods(const TI ti, CArgs& a, unsigned char* ldsg) {
    float* sc = (float*)ldsg; float* part = sc + 9 * 1024;
    const int tid = ti.tid, lane = tid & 63, w = tid >> 6;
    for (int i = tid; i < 9 * 1024; i += 512) { const float v = (i < 8192) ? a.in[1][i] : a.in[3][i - 8192]; sc[i] = v / (1.f + expf(-v)); }
    __syncthreads();
    float* MOD = (float*)(a.ws + WS_MOD);
    for (int item = ti.bid; item < DEPTH * 96; item += ti.nblk) {
        const int l = item / 96, n0 = (item % 96) * 64;
        const float* W = a.in[4] + (size_t)l * 1024 * 6144 + n0 + lane;
        float acc[9];
#pragma unroll
        for (int r = 0; r < 9; ++r) acc[r] = 0.f;
#pragma unroll 8
        for (int k = w * 128; k < w * 128 + 128; ++k) {
            const float wv = W[(size_t)k * 6144];
#pragma unroll
            for (int r = 0; r < 9; ++r) acc[r] += sc[r * 1024 + k] * wv;
        }
#pragma unroll
        for (int r = 0; r < 9; ++r) part[(w * 9 + r) * 64 + lane] = acc[r];
        __syncthreads();
        for (int idx = tid; idx < 576; idx += 512) {
            const int r = idx >> 6, ln = idx & 63; float s = a.in[5][l * 6144 + n0 + ln];
            for (int ww = 0; ww < 8; ++ww) s += part[(ww * 9 + r) * 64 + ln];
            MOD[((size_t)l * 9 + r) * 6144 + n0 + ln] = s;
        }
        __syncthreads();
    }
    float* RC = (float*)(a.ws + WS_ROPE); float* RS = RC + 2048 * 32;
    for (int idx = ti.bid * 512 + tid; idx < 2048 * 32; idx += ti.nblk * 512) {
        const int t = idx >> 5, i = idx & 31; const float pos = i < 16 ? (float)(t >> 6) : (float)(t & 63);
        const float ang = pos * exp2f(-(float)(i & 15) * (13.287712379549449f / 16.f));
        RC[idx] = cosf(ang); RS[idx] = sinf(ang);
    }
}

__device__ __forceinline__ void norm_rows(const float* xl, const float* xc, const float* g, const float* modl, int shi, int sci, bf16_t* H, int nrows, int gw, int ngw, int lane) {
#define NR_LOAD(V, SC, SH, row_) do { const int r__ = (row_); const float* src; int rr; if (r__ < ML) { src = xl + (size_t)r__ * D; rr = r__ >> 11; } else { src = xc + (size_t)(r__ - ML) * D; rr = 8; } \
        const float* md = modl + (size_t)rr * 6144; _Pragma("unroll") for (int j = 0; j < 4; ++j) { const int c = 4 * lane + 256 * j; V[j] = *(const f32x4*)(src + c); SC[j] = *(const f32x4*)(md + sci * 1024 + c); SH[j] = *(const f32x4*)(md + shi * 1024 + c); } } while (0)
    f32x4 gg[4], v[4], sc[4], sh[4], nv[4], nsc[4], nsh[4];
#pragma unroll
    for (int j = 0; j < 4; ++j) { gg[j] = *(const f32x4*)(g + 4 * lane + 256 * j); nv[j] = gg[j]; nsc[j] = gg[j]; nsh[j] = gg[j]; }
    int row = gw;
    if (row < nrows) NR_LOAD(v, sc, sh, row);
    for (; row < nrows; row += ngw) {
        const int nrow = row + ngw;
        if (nrow < nrows) NR_LOAD(nv, nsc, nsh, nrow);
        float ss = 0.f;
#pragma unroll
        for (int j = 0; j < 4; ++j) ss += (v[j].x * v[j].x + v[j].y * v[j].y) + (v[j].z * v[j].z + v[j].w * v[j].w);
        ss = wave_sum(ss);
        const float rstd = rsqrtf(ss * (1.f / 1024.f) + 1e-6f);
#pragma unroll
        for (int j = 0; j < 4; ++j) {
            const f32x4 o = v[j] * rstd * gg[j] * (1.f + sc[j]) + sh[j];
            u32x2 p; p.x = pkbf(o.x, o.y); p.y = pkbf(o.z, o.w);
            *(u32x2*)(H + (size_t)row * D + 4 * lane + 256 * j) = p;
            v[j] = nv[j]; sc[j] = nsc[j]; sh[j] = nsh[j];
        }
    }
#undef NR_LOAD
}

template <int MODE> __device__ __forceinline__ void transpose_item(const float* W, int K, int N, bf16_t* WT, LAS float* scr, int item, int lane) {
    const int nblk = N / 32, kb = item / nblk, nb = item % nblk, k0 = 64 * kb, n0 = 32 * nb;
#pragma unroll 8
    for (int i = 0; i < 32; ++i) { const int kk = 2 * i + (lane >> 5); scr[kk * 33 + (lane & 31)] = W[(size_t)(k0 + kk) * N + n0 + (lane & 31)]; }
    asm volatile("s_waitcnt lgkmcnt(0)" ::: "memory");
    const int c = lane & 7;
#pragma unroll
    for (int j = 0; j < 4; ++j) {
        const int n = (lane >> 3) + 8 * j, gn = n0 + n; const LAS float* s = scr + (8 * c) * 33 + n;
        const int drow = MODE == 0 ? gn : (MODE == 1 ? (gn >= 8608 ? gn + 96 : gn) : (gn < DFF ? 2 * gn : 2 * (gn - DFF) + 1));
        u32x4 o; o.x = pkbf(s[0 * 33], s[1 * 33]); o.y = pkbf(s[2 * 33], s[3 * 33]); o.z = pkbf(s[4 * 33], s[5 * 33]); o.w = pkbf(s[6 * 33], s[7 * 33]);
        *(u32x4*)(WT + (size_t)drow * K + k0 + 8 * c) = o;
    }
    asm volatile("s_waitcnt lgkmcnt(0)" ::: "memory");
}
__device__ __forceinline__ void ph_wconv(CArgs& a, int l, unsigned char* ldsg, int gw, int ngw, int lane, int wv, int mask) {
    LAS float* scr = (LAS float*)(ldsg + wv * 8704);
    unsigned char* ws = a.ws;
    constexpr int I_IN = 16 * 365, I_SQ = 16 * 32, I_WI = 16 * 176, I_WO = 44 * 32;
    if (mask & 1) for (int it = gw; it < I_IN; it += ngw) transpose_item<1>(a.in[8] + (size_t)l * 1024 * 11680, 1024, 11680, (bf16_t*)(ws + WS_WIN), scr, it, lane);
    if (mask & 2) for (int it = gw; it < 3 * I_SQ; it += ngw) { const int wh = it / I_SQ; transpose_item<0>(a.in[27 + wh] + (size_t)l * 1048576, 1024, 1024, (bf16_t*)(ws + WS_WA + (size_t)wh * 2 * MiB), scr, it % I_SQ, lane); }
    if (mask & 4) for (int it = gw; it < I_SQ; it += ngw) transpose_item<0>(a.in[30] + (size_t)l * 1048576, 1024, 1024, (bf16_t*)(ws + WS_WO), scr, it, lane);
    if (mask & 8) for (int it = gw; it < I_WI; it += ngw) transpose_item<2>(a.in[31] + (size_t)l * 1024 * 5632, 1024, 5632, (bf16_t*)(ws + WS_WI), scr, it, lane);
    if (mask & 16) for (int it = gw; it < I_WO; it += ngw) transpose_item<0>(a.in[32] + (size_t)l * DFF * 1024, DFF, 1024, (bf16_t*)(ws + WS_WO2), scr, it, lane);
    if (!(mask & 1)) return;
    const int gt = gw * 64 + lane, ngt = ngw * 64;
    bf16_t* LWT = (bf16_t*)(ws + WS_LWT); bf16_t* LAT = (bf16_t*)(ws + WS_LAT); bf16_t* LGT = (bf16_t*)(ws + WS_LGT);
    const float* w2 = a.in[18] + (size_t)l * 2 * 64 * 1024; const float* a2 = a.in[20] + (size_t)l * 2 * 64 * 1024; const float* g2 = a.in[21] + (size_t)l * 160 * 1024;
    for (int i = gt; i < 2048 * 128; i += ngt) {
        const int n = i >> 7, k = i & 127, d = n >> 10, c = n & 1023, kk = k - d * 64;
        const bool in = (kk >= 0 && kk < 64);
        LWT[i] = in ? f2bf(w2[((size_t)d * 64 + kk) * 1024 + c]) : (bf16_t)0;
        LAT[i] = in ? f2bf(a2[((size_t)d * 64 + kk) * 1024 + c]) : (bf16_t)0;
    }
    for (int i = gt; i < 1024 * 256; i += ngt) { const int n = i >> 8, k = i & 255; LGT[i] = k < 160 ? f2bf(g2[(size_t)k * 1024 + n]) : (bf16_t)0; }
    bf16_t* WIN = (bf16_t*)(ws + WS_WIN);
    for (int i = gt; i < 96 * 1024; i += ngt) WIN[(size_t)8608 * 1024 + i] = 0;
}

__device__ __forceinline__ void gmlp_unit(const TI ti, CArgs& a, int l, int u, unsigned char* ldsg) {
    float* rstd = (float*)ldsg; bf16_t* VNT = (bf16_t*)(ldsg + 512);
    const int tid = ti.tid, lane = tid & 63, w = tid >> 6, r = lane & 31, h = lane >> 5;
    bf16_t* GU = (bf16_t*)(a.ws + WS_GU); const bf16_t* GV = (const bf16_t*)(a.ws + WS_GV);
    const size_t R0 = (size_t)u * 128;
#pragma unroll 4
    for (int i = 0; i < 16; ++i) {
        const int tok = w * 16 + i; const bf16_t* p = GV + (R0 + tok) * 1024 + lane * 16;
        f32x4 x0, x1, x2, x3; unpack8(*(const u32x4*)p, x0, x1); unpack8(*(const u32x4*)(p + 8), x2, x3);
        float ss = (x0.x * x0.x + x0.y * x0.y + x0.z * x0.z + x0.w * x0.w) + (x1.x * x1.x + x1.y * x1.y + x1.z * x1.z + x1.w * x1.w)
                 + (x2.x * x2.x + x2.y * x2.y + x2.z * x2.z + x2.w * x2.w) + (x3.x * x3.x + x3.y * x3.y + x3.z * x3.z + x3.w * x3.w);
        ss = wave_sum(ss);
        if (lane == 0) rstd[tok] = rsqrtf(ss * (1.f / 1024.f) + 1e-6f);
    }
    __syncthreads();
    const float* gvg = a.in[9] + l * 1024; const float* wsp = a.in[10] + (size_t)l * 8 * 128 * 128; const float* bsp = a.in[11] + l * 8 * 128;
    const int tt = w & 3, chh = w >> 2;
    for (int g = 0; g < 8; ++g) {
        {
            const int s = tid & 127, cc = tid >> 7; const float rs = rstd[s]; const bf16_t* p = GV + (R0 + s) * 1024 + g * 128 + cc * 32;
#pragma unroll
            for (int q = 0; q < 4; ++q) {
                f32x4 x0, x1; unpack8(*(const u32x4*)(p + 8 * q), x0, x1);
                const float* gp = gvg + g * 128 + cc * 32 + 8 * q; const int c0 = cc * 32 + 8 * q;
                VNT[(c0 + 0) * 136 + s] = f2bf(x0.x * rs * gp[0]); VNT[(c0 + 1) * 136 + s] = f2bf(x0.y * rs * gp[1]);
                VNT[(c0 + 2) * 136 + s] = f2bf(x0.z * rs * gp[2]); VNT[(c0 + 3) * 136 + s] = f2bf(x0.w * rs * gp[3]);
                VNT[(c0 + 4) * 136 + s] = f2bf(x1.x * rs * gp[4]); VNT[(c0 + 5) * 136 + s] = f2bf(x1.y * rs * gp[5]);
                VNT[(c0 + 6) * 136 + s] = f2bf(x1.z * rs * gp[6]); VNT[(c0 + 7) * 136 + s] = f2bf(x1.w * rs * gp[7]);
            }
        }
        __syncthreads();
        f32x16 acc0, acc1;
#pragma unroll
        for (int i = 0; i < 16; ++i) { acc0[i] = 0.f; acc1[i] = 0.f; }
        const float* wrow = wsp + ((size_t)g * 128 + tt * 32 + r) * 128;
#pragma unroll
        for (int ks = 0; ks < 8; ++ks) {
            const f32x4 a0 = *(const f32x4*)(wrow + 16 * ks + 8 * h), a1 = *(const f32x4*)(wrow + 16 * ks + 8 * h + 4);
            const bf16x8 af = __builtin_bit_cast(bf16x8, pack8(a0, a1));
            const bf16x8 b0 = *(const bf16x8*)(VNT + (chh * 64 + r) * 136 + 16 * ks + 8 * h);
            const bf16x8 b1 = *(const bf16x8*)(VNT + (chh * 64 + 32 + r) * 136 + 16 * ks + 8 * h);
            acc0 = MFMA32(af, b0, acc0); acc1 = MFMA32(af, b1, acc1);
        }
        {
            const bf16_t* GUr = GU; float uu0[16], uu1[16], bb[16];
#pragma unroll
            for (int reg = 0; reg < 16; ++reg) {
                const int t = tt * 32 + (reg & 3) + 8 * (reg >> 2) + 4 * h; const size_t i0 = (R0 + t) * 1024 + g * 128 + chh * 64 + r;
                bb[reg] = bsp[g * 128 + t]; uu0[reg] = bf2f(GUr[i0]); uu1[reg] = bf2f(GUr[i0 + 32]);
            }
            asm volatile("" ::: "memory");
#pragma unroll
            for (int reg = 0; reg < 16; ++reg) {
                const int t = tt * 32 + (reg & 3) + 8 * (reg >> 2) + 4 * h; const size_t i0 = (R0 + t) * 1024 + g * 128 + chh * 64 + r;
                GU[i0] = f2bf(uu0[reg] * (acc0[reg] + bb[reg])); GU[i0 + 32] = f2bf(uu1[reg] * (acc1[reg] + bb[reg]));
            }
        }
        __syncthreads();
    }
}
__device__ __forceinline__ void qk_rows(CArgs& a, int l, int gw, int ngw, int lane) {
    bf16_t* Q = (bf16_t*)(a.ws + WS_Q); bf16_t* K = (bf16_t*)(a.ws + WS_K);
    const float* RC = (const float*)(a.ws + WS_ROPE); const float* RS = RC + 2048 * 32;
    const int part = lane & 3;
    float gq[16], gk[16];
    load16f(a.in[12] + l * 64 + 16 * part, gq); load16f(a.in[13] + l * 64 + 16 * part, gk);
    for (int row = gw; row < M; row += ngw) {
        float xq[16], xk[16], cs[16], sn[16];
        unpack16(Q + (size_t)row * 1024 + 16 * lane, xq); unpack16(K + (size_t)row * 1024 + 16 * lane, xk);
        const bool lat = row < ML;
        if (lat) { const int t = row & 2047; load16f(RC + t * 32 + 16 * (part & 1), cs); load16f(RS + t * 32 + 16 * (part & 1), sn); }
        float sq = 0.f, sk = 0.f;
#pragma unroll
        for (int j = 0; j < 16; ++j) { sq += xq[j] * xq[j]; sk += xk[j] * xk[j]; }
        const float rq = rsqrtf(quad_sum(sq) * (1.f / 64.f) + 1e-6f), rk = rsqrtf(quad_sum(sk) * (1.f / 64.f) + 1e-6f);
#pragma unroll
        for (int j = 0; j < 16; ++j) { xq[j] = xq[j] * rq * gq[j]; xk[j] = xk[j] * rk * gk[j]; }
        if (lat) {
            const float sgn = part < 2 ? -1.f : 1.f;
#pragma unroll
            for (int j = 0; j < 16; ++j) {
                const float pq = quad_xor2(xq[j]), pk = quad_xor2(xk[j]);
                xq[j] = xq[j] * cs[j] + sgn * pq * sn[j]; xk[j] = xk[j] * cs[j] + sgn * pk * sn[j];
            }
        }
#pragma unroll
        for (int j = 0; j < 16; ++j) xq[j] *= QSCALE;
        pack16(Q + (size_t)row * 1024 + 16 * lane, xq); pack16(K + (size_t)row * 1024 + 16 * lane, xk);
    }
}
__device__ __forceinline__ void lora_in_rows(CArgs& a, int l, int gw, int ngw, int lane) {
    const bf16_t* RW = (const bf16_t*)(a.ws + WS_RW); bf16_t* LW = (bf16_t*)(a.ws + WS_LIW); bf16_t* LA = (bf16_t*)(a.ws + WS_LIA); bf16_t* LG = (bf16_t*)(a.ws + WS_LIG);
    const float* mu = a.in[16] + l * 3488 + 3072;
    f32x4 m0 = {0.f, 0.f, 0.f, 0.f}, m1 = m0;
    if (lane < 52) { m0 = *(const f32x4*)(mu + 8 * lane); m1 = *(const f32x4*)(mu + 8 * lane + 4); }
    for (int row = gw; row < M; row += ngw) {
        int t, Tn; if (row < ML) { t = row & 2047; Tn = 2048; } else { t = (row - ML) & 255; Tn = 256; }
        const bool hp = t > 0, hn = t < Tn - 1;
        if (lane < 52) {
            const bf16_t* p = RW + (size_t)row * RWP + 3072 + 8 * lane;
            f32x4 x0, x1, p0 = {0.f, 0.f, 0.f, 0.f}, p1 = p0, n0 = p0, n1 = p0;
            unpack8(*(const u32x4*)p, x0, x1);
            if (hp) unpack8(*(const u32x4*)(p - RWP), p0, p1);
            if (hn) unpack8(*(const u32x4*)(p + RWP), n0, n1);
            f32x4 z0 = x0 + m0 * (0.5f * (p0 + n0) - x0), z1 = x1 + m1 * (0.5f * (p1 + n1) - x1);
            const int j = 8 * lane;
            if (j < 128) { z0 = (f32x4){tanhf(z0.x), tanhf(z0.y), tanhf(z0.z), tanhf(z0.w)}; z1 = (f32x4){tanhf(z1.x), tanhf(z1.y), tanhf(z1.z), tanhf(z1.w)}; *(u32x4*)(LW + (size_t)row * 128 + j) = pack8(z0, z1); }
            else if (j < 256) { *(u32x4*)(LA + (size_t)row * 128 + j - 128) = pack8(z0, z1); }
            else { *(u32x4*)(LG + (size_t)row * 256 + j - 256) = pack8(sig4(z0), sig4(z1)); }
        } else {
            unsigned z_ = 0u; asm volatile("" : "+v"(z_)); *(u32x4*)(LG + (size_t)row * 256 + 160 + (lane - 52) * 8) = (u32x4){z_, z_, z_, z_};
        }
    }
}

__device__ __forceinline__ void scan_unit(const TI ti, CArgs& a, int l, int u, bool ctx_out, unsigned char* ldsg) {
    const int tid = ti.tid, lane = tid & 63, w = tid >> 6;
    const int b = u >> 5, hh = (u >> 1) & 15, d = u & 1;
    const int si = tid >> 3, jq = tid & 7;
    LAS float* L = (LAS float*)ldsg;
    const bf16_t* RW = (const bf16_t*)(a.ws + WS_RW);
    const bf16_t* DEC = (const bf16_t*)(a.ws + (d ? WS_DEC1 : WS_GV));
    const bf16_t* AA = (const bf16_t*)(a.ws + (d ? WS_AA1 : WS_AA0));
    bf16_t* Y = (bf16_t*)(a.ws + (d ? WS_Y1 : WS_H));
    const int ch = hh * 64 + lane;
    const float* mu = a.in[16] + l * 3488;
    const float mur = mu[ch], muk = mu[1024 + ch], muv = mu[2048 + ch], kkg = a.in[22][l * 1024 + ch], kag = a.in[23][l * 1024 + ch];
    f32x4 S0 = {0.f, 0.f, 0.f, 0.f}, S1 = {0.f, 0.f, 0.f, 0.f};
    unsigned raw[4][9]; unsigned dcr[4], aar[4];
    constexpr int NC = 72;
#define SCAN_CHUNK(n, base, Tn, t0, wy) int base, Tn, t0; bool wy; { int ci; if ((n) < 8) { base = ML + b * 256; Tn = 256; ci = d ? 7 - (n) : (n); wy = ctx_out; } else { base = b * 2048; Tn = 2048; ci = d ? 71 - (n) : (n) - 8; wy = true; } t0 = ci * 32; }
#define SCAN_LOAD(n) do { SCAN_CHUNK(n, base_, Tn_, t0_, wy_); (void)wy_; _Pragma("unroll") for (int i4 = 0; i4 < 4; ++i4) { const int t = t0_ + w + 8 * i4; const size_t row = (size_t)(base_ + t); \
        const bf16_t* p = RW + row * RWP + ch; const bool hp = t > 0, hn = t < Tn_ - 1; \
        const int op_ = hp ? -RWP : 0, on_ = hn ? RWP : 0;     \
        _Pragma("unroll") for (int X = 0; X < 3; ++X) { raw[i4][3 * X + 0] = (unsigned)p[X * 1024 + op_]; raw[i4][3 * X + 1] = (unsigned)p[X * 1024]; raw[i4][3 * X + 2] = (unsigned)p[X * 1024 + on_]; } \
        dcr[i4] = (unsigned)DEC[row * 1024 + ch]; aar[i4] = (unsigned)AA[row * 1024 + ch]; } } while (0)
#define SCAN_STORE(n) do { LAS float* Bf = L + ((n) & 1) * 12288; SCAN_CHUNK(n, base_, Tn_, t0_, wy_); (void)wy_; (void)base_; _Pragma("unroll") for (int i4 = 0; i4 < 4; ++i4) { const int tk = w + 8 * i4; \
        const float mp_ = (t0_ + tk > 0) ? 0.5f : 0.f, mn_ = (t0_ + tk < Tn_ - 1) ? 0.5f : 0.f; \
        const float xr = bf2f(raw[i4][1]), xk = bf2f(raw[i4][4]), xv = bf2f(raw[i4][7]); \
        const float zr = xr + mur * ((mp_ * bf2f(raw[i4][0]) + mn_ * bf2f(raw[i4][2])) - xr); \
        const float zk = xk + muk * ((mp_ * bf2f(raw[i4][3]) + mn_ * bf2f(raw[i4][5])) - xk); \
        const float zv = xv + muv * ((mp_ * bf2f(raw[i4][6]) + mn_ * bf2f(raw[i4][8])) - xv); \
        const float kkv = zk * kkg; const float ssq = wave_sum(kkv * kkv); const float kkn = kkv / fmaxf(sqrtf(ssq), 1e-12f); \
        const float ad = bf2f(aar[i4]); const float wv_ = __expf(bf2f(dcr[i4])); const float kd = zk * (1.f + (ad - 1.f) * kag); \
        Bf[0 * 2048 + tk * 64 + lane] = wv_; Bf[1 * 2048 + tk * 64 + lane] = kd; Bf[2 * 2048 + tk * 64 + lane] = -kkn; \
        Bf[3 * 2048 + tk * 64 + lane] = kkn * ad; Bf[4 * 2048 + tk * 64 + lane] = zr; Bf[5 * 2048 + tk * 64 + lane] = zv; } } while (0)
    SCAN_LOAD(0); SCAN_STORE(0);
    __syncthreads();
    for (int n = 0; n < NC; ++n) {
        if (n + 1 < NC) SCAN_LOAD(n + 1);
        LAS const float* Bf = L + (n & 1) * 12288; LAS float* Yb = L + 24576 + (n & 1) * 2048;
#define STEP_LOAD(P, sidx) LAS const float* q##P = Bf + (sidx) * 64 + 8 * jq + hoff; \
            const f32x4 w0##P = *(LAS const f32x4*)(q##P), w1##P = *(LAS const f32x4*)(q##P + hdq), k0##P = *(LAS const f32x4*)(q##P + 2048), k1##P = *(LAS const f32x4*)(q##P + 2048 + hdq), \
                        a0##P = *(LAS const f32x4*)(q##P + 4096), a1##P = *(LAS const f32x4*)(q##P + 4096 + hdq), b0##P = *(LAS const f32x4*)(q##P + 6144), b1##P = *(LAS const f32x4*)(q##P + 6144 + hdq), \
                        r0##P = *(LAS const f32x4*)(q##P + 8192), r1##P = *(LAS const f32x4*)(q##P + 8192 + hdq); const float vi##P = Bf[5 * 2048 + (sidx) * 64 + si];
#define STEP_MATH(P, sidx) { const f32x4 ta = S0 * a0##P + S1 * a1##P; const float sa = dpp_sum8((ta.x + ta.y) + (ta.z + ta.w)); \
            S0 = S0 * w0##P + (sa * b0##P + vi##P * k0##P); S1 = S1 * w1##P + (sa * b1##P + vi##P * k1##P); \
            const f32x4 ty = S0 * r0##P + S1 * r1##P; const float y = dpp_sum8((ty.x + ty.y) + (ty.z + ty.w)); if (jq == 0) Yb[(sidx) * 64 + si] = y; }
        const int hoff = (si & 1) * 4, hdq = 4 - 2 * hoff;
        const int sdir = d ? -1 : 1; int sc = d ? 31 : 0;
        f32x4 cw0, cw1, ck0, ck1, ca0, ca1, cb0, cb1, cr0, cr1; float cvi;
        { STEP_LOAD(X, sc); cw0 = w0X; cw1 = w1X; ck0 = k0X; ck1 = k1X; ca0 = a0X; ca1 = a1X; cb0 = b0X; cb1 = b1X; cr0 = r0X; cr1 = r1X; cvi = viX; }
        for (int ss = 0; ss < 32; ss += 2) {
            const int s0i = sc, s1i = sc + sdir; int s2i = sc + 2 * sdir; s2i = (ss + 2 < 32) ? s2i : s1i;
            STEP_LOAD(B, s1i);
            { const f32x4 w0A = cw0, w1A = cw1, k0A = ck0, k1A = ck1, a0A = ca0, a1A = ca1, b0A = cb0, b1A = cb1, r0A = cr0, r1A = cr1; const float viA = cvi; STEP_MATH(A, s0i); }
            STEP_LOAD(C, s2i);
            STEP_MATH(B, s1i);
            cw0 = w0C; cw1 = w1C; ck0 = k0C; ck1 = k1C; ca0 = a0C; ca1 = a1C; cb0 = b0C; cb1 = b1C; cr0 = r0C; cr1 = r1C; cvi = viC;
            sc += 2 * sdir;
        }
#undef STEP_LOAD
#undef STEP_MATH
        if (n + 1 < NC) SCAN_STORE(n + 1);
        __syncthreads();
        {
            SCAN_CHUNK(n, base_, Tn_, t0_, wy_); (void)Tn_;
            if (wy_) {
#pragma unroll
                for (int i4 = 0; i4 < 4; ++i4) { const int tk = w + 8 * i4; Y[(size_t)(base_ + t0_ + tk) * 1024 + ch] = f2bf(Yb[tk * 64 + lane]); }
            }
        }
    }
    __syncthreads();
#undef SCAN_CHUNK
#undef SCAN_LOAD
#undef SCAN_STORE
}

__device__ __forceinline__ bf16x8 pk8f(float f0, float f1, float f2, float f3, float f4, float f5, float f6, float f7) {
    u32x4 p; p.x = pkbf(f0, f1); p.y = pkbf(f2, f3); p.z = pkbf(f4, f5); p.w = pkbf(f6, f7); return __builtin_bit_cast(bf16x8, p);
}
__device__ __forceinline__ void scan_unit_mfma(const TI ti, CArgs& a, int l, int u, bool ctx_out, unsigned char* ldsg) {
    const int tid = ti.tid, lane = tid & 63, w = __builtin_amdgcn_readfirstlane(tid >> 6);
    const int b = u >> 5, hh = (u >> 1) & 15, d = u & 1;
    LAS unsigned char* L = (LAS unsigned char*)ldsg;
    constexpr int NCH = 144, RING = 6, BUFB = 20736, O_AR = 0, O_BK = 4608, O_BKT = 9216, O_VTT = 14336, O_PC = 17408, O_NS = 17664, O_XF = 18688;
#define SC2_CHUNK(C, base, Tn, cc, wy) int base, Tn, cc; bool wy; if ((C) < 16) { base = ML + b * 256; Tn = 256; cc = (C); wy = ctx_out; } else { base = b * 2048; Tn = 2048; cc = (C) - 16; wy = true; }
#define SC2_TOK(Tn, cc, t) (d ? (Tn) - 1 - (16 * (cc) + (t)) : 16 * (cc) + (t))
    if (w < 2) {
        const int it = w, r = lane & 31, h = lane >> 5;
        bf16_t* Y = (bf16_t*)(a.ws + (d ? WS_Y1 : WS_H));
        f32x16 ST0, ST1;
#pragma unroll
        for (int i = 0; i < 16; ++i) { ST0[i] = 0.f; ST1[i] = 0.f; }
        for (int n = 0; n < NCH + RING; ++n) {
            if (n >= RING) {
                const int C = n - RING;
                LAS const unsigned char* buf = L + (C % RING) * BUFB;
                const bf16x8 xb0 = *(LAS const bf16x8*)(buf + O_XF + lane * 16), xb1 = *(LAS const bf16x8*)(buf + O_XF + 1024 + lane * 16);
                f32x16 Z;
#pragma unroll
                for (int i = 0; i < 16; ++i) Z[i] = 0.f;
#pragma unroll
                for (int jt = 0; jt < 2; ++jt) {
#pragma unroll
                    for (int s = 0; s < 2; ++s) {
                        LAS const unsigned char* ap = buf + O_AR + r * 144 + (32 * jt + 16 * s + 4 * h) * 2;
                        const s16x4 lo = *(LAS const s16x4*)ap, hi = *(LAS const s16x4*)(ap + 16);
                        const bf16x8 a2 = __builtin_shufflevector(lo, hi, 0, 1, 2, 3, 4, 5, 6, 7);
                        const bf16x8 stp = jt == 0 ? pk8f(ST0[8 * s], ST0[8 * s + 1], ST0[8 * s + 2], ST0[8 * s + 3], ST0[8 * s + 4], ST0[8 * s + 5], ST0[8 * s + 6], ST0[8 * s + 7])
                                                   : pk8f(ST1[8 * s], ST1[8 * s + 1], ST1[8 * s + 2], ST1[8 * s + 3], ST1[8 * s + 4], ST1[8 * s + 5], ST1[8 * s + 6], ST1[8 * s + 7]);
                        Z = MFMA32(a2, stp, Z);
                    }
                }
                LAS const unsigned char* vp = buf + O_VTT + (32 * it + r) * 48;
                {
                    const s16x4 lo = *(LAS const s16x4*)(vp + 8 * h), hi = *(LAS const s16x4*)(vp + 16 + 8 * h);
                    const bf16x8 vf = __builtin_shufflevector(lo, hi, 0, 1, 2, 3, 4, 5, 6, 7);
                    Z = MFMA32(xb1, vf, Z);
                }
                float o[8], g[16], uu[16];
#pragma unroll
                for (int q = 0; q < 8; ++q) o[q] = __shfl_xor(Z[q], 32);
#pragma unroll
                for (int e = 0; e < 4; ++e) {
                    g[e] = h ? o[e] : Z[e]; g[4 + e] = h ? Z[e] : o[e];
                    g[8 + e] = h ? o[4 + e] : Z[4 + e]; g[12 + e] = h ? Z[4 + e] : o[4 + e];
                }
                {
                    LAS const float* NS = (LAS const float*)(buf + O_NS);
#pragma unroll
                    for (int t = 0; t < 16; ++t) uu[t] = g[t];
#pragma unroll
                    for (int s = 0; s < 15; ++s) {
#pragma unroll
                        for (int t4 = (s + 1) / 4; t4 < 4; ++t4) {
                            const f32x4 nv = *(LAS const f32x4*)(NS + s * 16 + 4 * t4);
                            if (4 * t4 + 0 > s) uu[4 * t4 + 0] = __builtin_fmaf(nv.x, uu[s], uu[4 * t4 + 0]);
                            if (4 * t4 + 1 > s) uu[4 * t4 + 1] = __builtin_fmaf(nv.y, uu[s], uu[4 * t4 + 1]);
                            if (4 * t4 + 2 > s) uu[4 * t4 + 2] = __builtin_fmaf(nv.z, uu[s], uu[4 * t4 + 2]);
                            if (4 * t4 + 3 > s) uu[4 * t4 + 3] = __builtin_fmaf(nv.w, uu[s], uu[4 * t4 + 3]);
                        }
                    }
                }
                {
                    const bf16x8 uf = pk8f(h ? uu[4] : uu[0], h ? uu[5] : uu[1], h ? uu[6] : uu[2], h ? uu[7] : uu[3],
                                           h ? uu[12] : uu[8], h ? uu[13] : uu[9], h ? uu[14] : uu[10], h ? uu[15] : uu[11]);
                    Z = MFMA32(xb0, uf, Z);
                }
                {
                    SC2_CHUNK(C, base_, Tn_, cc_, wy_);
                    if (wy_) {
#pragma unroll
                        for (int q = 8; q < 16; ++q) {
                            const int t = (q & 3) + 8 * ((q >> 2) - 2) + 4 * h; const int tok = SC2_TOK(Tn_, cc_, t);
                            Y[(size_t)(base_ + tok) * 1024 + hh * 64 + 32 * it + r] = f2bf(Z[q]);
                        }
                    }
                }
                {
                    const bf16x8 un = pk8f(h ? uu[8] : uu[0], h ? uu[9] : uu[1], h ? uu[10] : uu[2], h ? uu[11] : uu[3],
                                           h ? uu[12] : uu[4], h ? uu[13] : uu[5], h ? uu[14] : uu[6], h ? uu[15] : uu[7]);
                    const bf16x8 vn = *(LAS const bf16x8*)(vp + 16 * h);
                    const bf16x8 a00 = *(LAS const bf16x8*)(buf + O_BKT + r * 80 + (8 * h) * 2), a01 = *(LAS const bf16x8*)(buf + O_BKT + r * 80 + (16 + 8 * h) * 2);
                    const bf16x8 a10 = *(LAS const bf16x8*)(buf + O_BKT + (32 + r) * 80 + (8 * h) * 2), a11 = *(LAS const bf16x8*)(buf + O_BKT + (32 + r) * 80 + (16 + 8 * h) * 2);
                    ST0 = MFMA32(a00, un, ST0); ST0 = MFMA32(a01, vn, ST0);
                    ST1 = MFMA32(a10, un, ST1); ST1 = MFMA32(a11, vn, ST1);
                    LAS const float* pc = (LAS const float*)(buf + O_PC);
#pragma unroll
                    for (int g4 = 0; g4 < 4; ++g4) {
                        const f32x4 p0 = *(LAS const f32x4*)(pc + 8 * g4 + 4 * h), p1 = *(LAS const f32x4*)(pc + 32 + 8 * g4 + 4 * h);
                        ST0[4 * g4] *= p0.x; ST0[4 * g4 + 1] *= p0.y; ST0[4 * g4 + 2] *= p0.z; ST0[4 * g4 + 3] *= p0.w;
                        ST1[4 * g4] *= p1.x; ST1[4 * g4 + 1] *= p1.y; ST1[4 * g4 + 2] *= p1.z; ST1[4 * g4 + 3] *= p1.w;
                    }
                }
            }
            __syncthreads();
        }
    } else {
        const int p = w - 2, ch = hh * 64 + lane;
        const bf16_t* RW = (const bf16_t*)(a.ws + WS_RW);
        const bf16_t* DEC = (const bf16_t*)(a.ws + (d ? WS_DEC1 : WS_GV));
        const bf16_t* AA = (const bf16_t*)(a.ws + (d ? WS_AA1 : WS_AA0));
        const float* mu = a.in[16] + l * 3488;
        const float mur = mu[ch], muk = mu[1024 + ch], muv = mu[2048 + ch], kkg = a.in[22][l * 1024 + ch], kag = a.in[23][l * 1024 + ch];
        LAS unsigned char* buf = L + p * BUFB;
        LAS bf16_t* AR = (LAS bf16_t*)(buf + O_AR); LAS bf16_t* BK = (LAS bf16_t*)(buf + O_BK); LAS bf16_t* BKT = (LAS bf16_t*)(buf + O_BKT); LAS bf16_t* VTT = (LAS bf16_t*)(buf + O_VTT);
        LAS float* PC = (LAS float*)(buf + O_PC);
        constexpr int NSTEP = (NCH / RING) * 4;
        unsigned nxt[4][11], cur[4][11];
#define SC2_LOAD(k) do { const int C_ = p + RING * ((k) >> 2); SC2_CHUNK(C_, base_, Tn_, cc_, wy_); (void)wy_; _Pragma("unroll") for (int i4 = 0; i4 < 4; ++i4) { \
            const int tok = SC2_TOK(Tn_, cc_, 4 * ((k) & 3) + i4); const size_t row = (size_t)(base_ + tok); \
            const gcptr_t rb = uniptr(RW + row * RWP + hh * 64 + 1024);     \
            const gcptr_t rp = rb + (tok > 0 ? -RWP : 0); const gcptr_t rn = rb + (tok < Tn_ - 1 ? RWP : 0); \
            nxt[i4][0] = (unsigned)rp[lane - 1024]; nxt[i4][3] = (unsigned)rp[lane]; nxt[i4][6] = (unsigned)rp[lane + 1024]; \
            nxt[i4][1] = (unsigned)rb[lane - 1024]; nxt[i4][4] = (unsigned)rb[lane]; nxt[i4][7] = (unsigned)rb[lane + 1024]; \
            nxt[i4][2] = (unsigned)rn[lane - 1024]; nxt[i4][5] = (unsigned)rn[lane]; nxt[i4][8] = (unsigned)rn[lane + 1024]; \
            nxt[i4][9] = (unsigned)uniptr(DEC + row * 1024 + hh * 64)[lane]; nxt[i4][10] = (unsigned)uniptr(AA + row * 1024 + hh * 64)[lane]; } } while (0)
        SC2_LOAD(0);
        float Lsum = 0.f, ePprev = 1.f;
        for (int n = 0; n < NCH + RING; ++n) {
            const int e = n - p - 1;
            if (e >= 0 && (e % RING) < 4 && e / RING < NCH / RING) {
                const int k = 4 * (e / RING) + (e % RING);
#pragma unroll
                for (int i4 = 0; i4 < 4; ++i4)
#pragma unroll
                    for (int x = 0; x < 11; ++x) cur[i4][x] = nxt[i4][x];
                if (k + 1 < NSTEP) SC2_LOAD(k + 1);
                const int C_ = p + RING * (k >> 2); SC2_CHUNK(C_, base_, Tn_, cc_, wy_); (void)wy_; (void)base_;
#pragma unroll
                for (int i4 = 0; i4 < 4; ++i4) {
                    const int t = 4 * (k & 3) + i4; const int tok = SC2_TOK(Tn_, cc_, t);
                    Lsum = (t == 0) ? 0.f : Lsum; ePprev = (t == 0) ? 1.f : ePprev;
                    const float mp_ = tok > 0 ? 0.5f : 0.f, mn_ = tok < Tn_ - 1 ? 0.5f : 0.f;
                    const float xr = bf2f(cur[i4][1]), xk = bf2f(cur[i4][4]), xv = bf2f(cur[i4][7]);
                    const float zr = xr + mur * ((mp_ * bf2f(cur[i4][0]) + mn_ * bf2f(cur[i4][2])) - xr);
                    const float zk = xk + muk * ((mp_ * bf2f(cur[i4][3]) + mn_ * bf2f(cur[i4][5])) - xk);
                    const float zv = xv + muv * ((mp_ * bf2f(cur[i4][6]) + mn_ * bf2f(cur[i4][8])) - xv);
                    const float kkv = zk * kkg; const float ssq = wave_sum(kkv * kkv); const float kkn = kkv * rsqrtf(fmaxf(ssq, 1e-24f));
                    const float ad = bf2f(cur[i4][10]); const float kd = zk * (1.f + (ad - 1.f) * kag);
                    Lsum += bf2f(cur[i4][9]);
                    const float eP = __expf(Lsum), eI = __expf(-Lsum);
                    AR[t * 72 + lane] = f2bf(-kkn * ePprev); AR[(16 + t) * 72 + lane] = f2bf(zr * eP);
                    const bf16_t bt = f2bf(kkn * ad * eI), kt = f2bf(kd * eI);
                    BK[t * 72 + lane] = bt; BK[(16 + t) * 72 + lane] = kt;
                    BKT[lane * 40 + t] = bt; BKT[lane * 40 + 16 + t] = kt;
                    VTT[lane * 24 + t] = f2bf(zv);
                    PC[lane] = eP;
                    ePprev = eP;
                }
            } else if (e >= 0 && (e % RING) == 4 && e / RING < NCH / RING) {
                const int r = lane & 31, h = lane >> 5, thr = (r & 15) + (r >> 4);
                f32x16 X;
#pragma unroll
                for (int i = 0; i < 16; ++i) X[i] = 0.f;
#pragma unroll
                for (int ks = 0; ks < 4; ++ks) {
                    const bf16x8 af = *(LAS const bf16x8*)(buf + O_BK + r * 144 + (16 * ks + 8 * h) * 2);
                    const bf16x8 bfr = *(LAS const bf16x8*)(buf + O_AR + r * 144 + (16 * ks + 8 * h) * 2);
                    X = MFMA32(af, bfr, X);
                }
#pragma unroll
                for (int rg = 0; rg < 16; ++rg) { const int s = (rg & 3) + 8 * ((rg >> 2) & 1) + 4 * h; X[rg] = (s < thr) ? X[rg] : 0.f; }
                if (r < 16) {
                    LAS float* NS = (LAS float*)(buf + O_NS);
#pragma unroll
                    for (int rg = 0; rg < 8; ++rg) NS[((rg & 3) + 8 * (rg >> 2) + 4 * h) * 16 + r] = X[rg];
                }
                *(LAS bf16x8*)(buf + O_XF + lane * 16) = pk8f(X[0], X[1], X[2], X[3], X[4], X[5], X[6], X[7]);
                *(LAS bf16x8*)(buf + O_XF + 1024 + lane * 16) = pk8f(X[8], X[9], X[10], X[11], X[12], X[13], X[14], X[15]);
            }
            __syncthreads();
        }
#undef SC2_LOAD
    }
    __syncthreads();
#undef SC2_CHUNK
#undef SC2_TOK
}

__device__ __forceinline__ void attn_unit(const TI ti, CArgs& a, int b, int hd, int qrow0, int st_lo, int st_hi, float mfix, float lam, float lam_init, const float* subg, unsigned char* ldsg) {
    const int tid = ti.tid, lane = tid & 63, w = tid >> 6, r = lane & 31, h = lane >> 5, qt = w >> 1, c = w & 1;
    bf16_t* Qb = (bf16_t*)(a.ws + WS_Q); const bf16_t* Kb = (const bf16_t*)(a.ws + WS_K); const bf16_t* Vb = (const bf16_t*)(a.ws + WS_V);
    LAS unsigned char* L = (LAS unsigned char*)ldsg;
    constexpr int KOFF = 0, VOFF = 17408, BUFB = 35840;
    bf16x8 qf[4];
    { const bf16_t* qp = Qb + (size_t)(qrow0 + qt * 32 + r) * 1024 + hd * 128 + c * 64 + 8 * h;
#pragma unroll
      for (int ks = 0; ks < 4; ++ks) qf[ks] = *(const bf16x8*)(qp + 16 * ks); }
    f32x16 O[4];
#pragma unroll
    for (int e = 0; e < 4; ++e)
#pragma unroll
        for (int i = 0; i < 16; ++i) O[e][i] = 0.f;
    float lsum = 0.f;
    u32x4 kreg[2], vreg[2];
    typedef const __attribute__((address_space(1))) u32x4* gc16_t;
    const int koff0 = (tid >> 4) * 1024 + (tid & 15) * 8, koff1 = koff0 + 32 * 1024, voff = lane * 1024 + w * 16;
#define ATT_LOAD(st) do { const int rb_ = (st) < 32 ? b * 2048 + (st) * 64 : ML + b * 256 + ((st) - 32) * 64; \
        const gcptr_t kb_ = uniptr(Kb + (size_t)rb_ * 1024 + hd * 128); const gcptr_t vb_ = uniptr(Vb + (size_t)rb_ * 1024 + hd * 128); \
        kreg[0] = *(gc16_t)(kb_ + koff0); kreg[1] = *(gc16_t)(kb_ + koff1); vreg[0] = *(gc16_t)(vb_ + voff); vreg[1] = *(gc16_t)(vb_ + voff + 8); } while (0)
#define ATT_STORE(bufi) do { LAS unsigned char* Bb = L + (bufi) * BUFB; _Pragma("unroll") for (int i = 0; i < 2; ++i) { const int p = tid + 512 * i, key = p >> 4, dc = p & 15; *(LAS u32x4*)(Bb + KOFF + key * 272 + dc * 16) = kreg[i]; } \
        LAS bf16_t* vt = (LAS bf16_t*)(Bb + VOFF) + (w * 16) * 72 + ((lane & 48) + 8 * ((lane >> 2) & 1) + 4 * ((lane >> 3) & 1) + (lane & 3));   \
        _Pragma("unroll") for (int e = 0; e < 4; ++e) { vt[(2 * e) * 72] = (bf16_t)(vreg[0][e] & 0xffffu); vt[(2 * e + 1) * 72] = (bf16_t)(vreg[0][e] >> 16); \
            vt[(8 + 2 * e) * 72] = (bf16_t)(vreg[1][e] & 0xffffu); vt[(8 + 2 * e + 1) * 72] = (bf16_t)(vreg[1][e] >> 16); } } while (0)
    ATT_LOAD(st_lo); ATT_STORE(0);
    __syncthreads();
    for (int st = st_lo; st < st_hi; ++st) {
        const int bi = (st - st_lo) & 1;
        if (st + 1 < st_hi) ATT_LOAD(st + 1);
        LAS const unsigned char* Bb = L + bi * BUFB;
#pragma unroll
        for (int sub = 0; sub < 2; ++sub) {
            f32x16 Sx;
#pragma unroll
            for (int i = 0; i < 16; ++i) Sx[i] = -mfix;
#pragma unroll
            for (int ks = 0; ks < 4; ++ks) {
                const bf16x8 kf = *(LAS const bf16x8*)(Bb + KOFF + (sub * 32 + r) * 272 + (c * 64 + 16 * ks + 8 * h) * 2);
                Sx = MFMA32(kf, qf[ks], Sx);
            }
            float p[16];
#pragma unroll
            for (int i = 0; i < 16; ++i) { p[i] = __builtin_amdgcn_exp2f(Sx[i]); lsum += p[i]; }
            u32x4 pw0, pw1;
            pw0.x = pkbf(p[0], p[1]); pw0.y = pkbf(p[2], p[3]); pw0.z = pkbf(p[4], p[5]); pw0.w = pkbf(p[6], p[7]);
            pw1.x = pkbf(p[8], p[9]); pw1.y = pkbf(p[10], p[11]); pw1.z = pkbf(p[12], p[13]); pw1.w = pkbf(p[14], p[15]);
            const bf16x8 pb0 = __builtin_bit_cast(bf16x8, pw0), pb1 = __builtin_bit_cast(bf16x8, pw1);
#pragma unroll
            for (int et = 0; et < 4; ++et) {
#pragma unroll
                for (int s = 0; s < 2; ++s) {
                    const bf16x8 vf = *(LAS const bf16x8*)(Bb + VOFF + (et * 32 + r) * 144 + (sub * 32 + 16 * s + 8 * h) * 2);
                    O[et] = MFMA32(vf, s ? pb1 : pb0, O[et]);
                }
            }
        }
        if (st + 1 < st_hi) ATT_STORE(bi ^ 1);
        __syncthreads();
    }
#undef ATT_LOAD
#undef ATT_STORE
    const float ltot = lsum + __shfl_xor(lsum, 32);
    const float linv = 1.f / ltot;
    LAS float* X = (LAS float*)L + qt * 4096;
    if (c == 1) {
#pragma unroll
        for (int e = 0; e < 4; ++e)
#pragma unroll
            for (int i = 0; i < 16; ++i) X[(e * 16 + i) * 64 + lane] = O[e][i] * linv;
    }
    __syncthreads();
    if (c == 0) {
        float ssq = 0.f;
#pragma unroll
        for (int e = 0; e < 4; ++e)
#pragma unroll
            for (int i = 0; i < 16; ++i) { const float o = O[e][i] * linv - lam * X[(e * 16 + i) * 64 + lane]; O[e][i] = o; ssq += o * o; }
        ssq += __shfl_xor(ssq, 32);
        const float sc = rsqrtf(ssq * (1.f / 128.f) + 1e-6f) * (1.f - lam_init);
        bf16_t* op = Qb + (size_t)(qrow0 + qt * 32 + r) * 1024 + hd * 128;
#pragma unroll
        for (int e = 0; e < 4; ++e)
#pragma unroll
            for (int g4 = 0; g4 < 4; ++g4) {
                const int e0 = e * 32 + 8 * g4 + 4 * h; const f32x4 sg = *(const f32x4*)(subg + e0);
                u32x2 o; o.x = pkbf(O[e][4 * g4 + 0] * sc * sg.x, O[e][4 * g4 + 1] * sc * sg.y); o.y = pkbf(O[e][4 * g4 + 2] * sc * sg.z, O[e][4 * g4 + 3] * sc * sg.w);
                *(u32x2*)(op + e0) = o;
            }
    }
    __syncthreads();
}
__device__ __forceinline__ void ph_attn(const TI ti, CArgs& a, int l, bool ctx_out, unsigned char* ldsg) {
    const int lane = ti.tid & 63;
    const float gqm = fabsf(a.in[12][l * 64 + lane]), gkm = fabsf(a.in[13][l * 64 + lane]);
    float mq = gqm, mk = gkm;
#pragma unroll
    for (int o = 1; o < 64; o <<= 1) { mq = fmaxf(mq, __shfl_xor(mq, o)); mk = fmaxf(mk, __shfl_xor(mk, o)); }
    const float mfix = 8.f * mq * mk * 1.4426950408889634f * 1.03f;
    const float* lp = a.in[14] + l * 256;
    const float s1 = wave_sum(lp[lane] * lp[64 + lane]), s2 = wave_sum(lp[128 + lane] * lp[192 + lane]);
    const float lam_init = 0.8f - 0.6f * expf(-0.3f * (float)l);
    const float lam = expf(s1) - expf(s2) + lam_init;
    const float* subg = a.in[15] + l * 128;
    const int nun = 1024 + (ctx_out ? 128 : 0);
    for (int u = ti.bid; u < nun; u += ti.nblk) {
        if (u < 1024) { const int bh = u >> 4, qb = u & 15; attn_unit(ti, a, bh >> 3, bh & 7, (bh >> 3) * 2048 + qb * 128, 0, 36, mfix, lam, lam_init, subg, ldsg); }
        else { const int v = u - 1024, bh = v >> 1, qb = v & 1; attn_unit(ti, a, bh >> 3, bh & 7, ML + (bh >> 3) * 256 + qb * 128, 32, 36, mfix, lam, lam_init, subg, ldsg); }
    }
}

__device__ __forceinline__ void up8(const bf16_t* p, float (&x)[8]) { const u32x4 v = *(const u32x4*)p;
#pragma unroll
    for (int i = 0; i < 4; ++i) { x[2 * i] = bf2f(v[i] & 0xffffu); x[2 * i + 1] = bf2f(v[i] >> 16); } }
__device__ __forceinline__ void ld8f(const float* p, float (&x)[8]) { const f32x4 u = *(const f32x4*)p, v = *(const f32x4*)(p + 4); x[0] = u.x; x[1] = u.y; x[2] = u.z; x[3] = u.w; x[4] = v.x; x[5] = v.y; x[6] = v.z; x[7] = v.w; }
__device__ __forceinline__ void shift8(const bf16_t* p, const float* mu, bool hp, bool hn, float (&z)[8]) {
    float x[8], xp[8], xn[8], m[8];
#pragma unroll
    for (int j = 0; j < 8; ++j) { xp[j] = 0.f; xn[j] = 0.f; }
    up8(p, x); if (hp) up8(p - RWP, xp); if (hn) up8(p + RWP, xn); ld8f(mu, m);
#pragma unroll
    for (int j = 0; j < 8; ++j) z[j] = x[j] + m[j] * (0.5f * (xp[j] + xn[j]) - x[j]);
}
__device__ __forceinline__ void un8(const u32x4 v, float (&x)[8]) {
#pragma unroll
    for (int i = 0; i < 4; ++i) { x[2 * i] = bf2f(v[i] & 0xffffu); x[2 * i + 1] = bf2f(v[i] >> 16); } }
__device__ __forceinline__ void rwkv_out_rows(CArgs& a, int l, int nrows, int gw, int ngw, int lane) {
    const bf16_t* RW = (const bf16_t*)(a.ws + WS_RW); const bf16_t* Y0 = (const bf16_t*)(a.ws + WS_H); bf16_t* Y1 = (bf16_t*)(a.ws + WS_Y1);
    const bf16_t* A0 = (const bf16_t*)(a.ws + WS_AA0); const bf16_t* A1 = (const bf16_t*)(a.ws + WS_AA1); const bf16_t* G = (const bf16_t*)(a.ws + WS_G);
    const float* mu = a.in[16] + l * 3488;
#define RO_LOAD(R, it_) do { const int row_ = (it_) >> 1, c0_ = ((it_) & 1) * 512 + 8 * lane; int t_, Tn_; if (row_ < ML) { t_ = row_ & 2047; Tn_ = 2048; } else { t_ = (row_ - ML) & 255; Tn_ = 256; } \
        const size_t idx_ = (size_t)row_ * 1024 + c0_; const bf16_t* p_ = RW + (size_t)row_ * RWP + c0_; const int op_ = t_ > 0 ? -RWP : 0, on_ = t_ < Tn_ - 1 ? RWP : 0; \
        R[0] = *(const u32x4*)(Y0 + idx_); R[1] = *(const u32x4*)(Y1 + idx_); R[2] = *(const u32x4*)(G + idx_); R[3] = *(const u32x4*)(A0 + idx_); R[4] = *(const u32x4*)(A1 + idx_); \
        _Pragma("unroll") for (int X = 0; X < 3; ++X) { R[5 + 3 * X] = *(const u32x4*)(p_ + X * 1024 + op_); R[6 + 3 * X] = *(const u32x4*)(p_ + X * 1024); R[7 + 3 * X] = *(const u32x4*)(p_ + X * 1024 + on_); } } while (0)
    u32x4 R[14], N[14];
#pragma unroll
    for (int i = 0; i < 14; ++i) { R[i] = (u32x4){0u, 0u, 0u, 0u}; N[i] = R[i]; }
    int it = gw;
    if (it < 2 * nrows) RO_LOAD(R, it);
    for (; it < 2 * nrows; it += ngw) {
        const int nit = it + ngw;
        if (nit < 2 * nrows) RO_LOAD(N, nit);
        const int row = it >> 1, c0 = (it & 1) * 512 + 8 * lane;
        int t, Tn; if (row < ML) { t = row & 2047; Tn = 2048; } else { t = (row - ML) & 255; Tn = 256; }
        const float mp = t > 0 ? 0.5f : 0.f, mn = t < Tn - 1 ? 0.5f : 0.f;
        float y[8], y1[8], g[8], a0[8], a1[8], z[3][8], lnw[8], lnb[8], ka[8], rk[8];
        un8(R[0], y); un8(R[1], y1); un8(R[2], g); un8(R[3], a0); un8(R[4], a1);
#pragma unroll
        for (int X = 0; X < 3; ++X) {
            float xp[8], x[8], xn[8], m[8]; un8(R[5 + 3 * X], xp); un8(R[6 + 3 * X], x); un8(R[7 + 3 * X], xn); ld8f(mu + X * 1024 + c0, m);
#pragma unroll
            for (int j = 0; j < 8; ++j) z[X][j] = x[j] + m[j] * ((mp * xp[j] + mn * xn[j]) - x[j]);
        }
        ld8f(a.in[25] + l * 1024 + c0, lnw); ld8f(a.in[26] + l * 1024 + c0, lnb); ld8f(a.in[23] + l * 1024 + c0, ka); ld8f(a.in[24] + l * 1024 + c0, rk);
        float sm = 0.f;
#pragma unroll
        for (int j = 0; j < 8; ++j) { y[j] += y1[j]; sm += y[j]; }
        const float mean = dpp_sum8(sm) * (1.f / 64.f);
        float sv = 0.f, sb = 0.f;
#pragma unroll
        for (int j = 0; j < 8; ++j) { y[j] -= mean; sv += y[j] * y[j]; const float kds = z[1][j] * ((1.f + (a0[j] - 1.f) * ka[j]) + (1.f + (a1[j] - 1.f) * ka[j])); sb += z[0][j] * kds * rk[j]; }
        const float rstd = rsqrtf(dpp_sum8(sv) * (1.f / 64.f) + 64e-5f), bsum = dpp_sum8(sb);
        u32x4 o;
#pragma unroll
        for (int j = 0; j < 4; ++j) o[j] = pkbf(((y[2 * j] * rstd * lnw[2 * j] + lnb[2 * j]) + bsum * z[2][2 * j]) * g[2 * j], ((y[2 * j + 1] * rstd * lnw[2 * j + 1] + lnb[2 * j + 1]) + bsum * z[2][2 * j + 1]) * g[2 * j + 1]);
        *(u32x4*)(Y1 + (size_t)row * 1024 + c0) = o;
#pragma unroll
        for (int i = 0; i < 14; ++i) R[i] = N[i];
    }
#undef RO_LOAD
}

#define XB_TMO      128
#define XB_XCNT(j)  (256  + 64 * (j))
#define XB_XSUB(j)  (1280 + 64 * (j))
#define XB_XGEN(j)  (2304 + 64 * (j))
#define XB_TOP      3328
#define XB_TOPGEN   3392
#define XCD_BAR_WORDS 3456
#define XB_SPIN_CAP (1u << 20)

__device__ __forceinline__ unsigned xb_ld(unsigned* p)              { return __hip_atomic_load(p, __ATOMIC_RELAXED, __HIP_MEMORY_SCOPE_AGENT); }
__device__ __forceinline__ unsigned xb_add(unsigned* p, unsigned v) { return __hip_atomic_fetch_add(p, v, __ATOMIC_RELAXED, __HIP_MEMORY_SCOPE_AGENT); }
__device__ __forceinline__ unsigned xb_xcc_id() { return (unsigned)__builtin_amdgcn_s_getreg((3 << 11) | 20) & 0xFu; }
#define XB_SPIN(cond, bar) do { unsigned _sp = 0; while (cond) { __builtin_amdgcn_s_sleep(1); \
    if ((++_sp & 255u) == 0u) { if (xb_ld(&(bar)[XB_TMO])) break; if (_sp > XB_SPIN_CAP) { atomicAdd(&(bar)[XB_TMO], 1u); break; } } } } while (0)

struct XcdBarrier {
    unsigned* bar; unsigned x;
    volatile LAS unsigned* st;
};

__device__ __forceinline__ XcdBarrier xcd_barrier_post(unsigned* bar, volatile LAS unsigned* st) {
    XcdBarrier b; b.bar = bar; b.x = xb_xcc_id(); b.st = st;
    if (threadIdx.x == 0) (void)xb_add(&bar[XB_XCNT(b.x)], 1u);
    return b;
}
__device__ __forceinline__ void xcd_barrier_complete(unsigned* bar, unsigned x, unsigned& nloc, unsigned& nx) {
    const unsigned G = gridDim.x * gridDim.y * gridDim.z;
    unsigned sum, cnt, mine, sp = 0u;
    for (;;) {
        sum = 0u; cnt = 0u; mine = 0u;
#pragma unroll
        for (unsigned j = 0; j < 16; ++j) { const unsigned c = xb_ld(&bar[XB_XCNT(j)]); sum += c; cnt += (c > 0u) ? 1u : 0u; mine = (j == x) ? c : mine; }
        if (sum == G) break;
        __builtin_amdgcn_s_sleep(1);
        if ((++sp & 255u) == 0u) { if (xb_ld(&bar[XB_TMO])) break; if (sp > XB_SPIN_CAP) { atomicAdd(&bar[XB_TMO], 1u); break; } }
    }
    nloc = mine > 0u ? mine : 1u; nx = cnt > 0u ? cnt : 1u;
}

__device__ __forceinline__ void xcd_barrier(const XcdBarrier& b) {
    asm volatile("s_waitcnt vmcnt(0)" ::: "memory");
    __syncthreads();
    if (threadIdx.x == 0) {
        unsigned* bar = b.bar;
        __builtin_amdgcn_s_waitcnt(0);
        unsigned nloc = b.st[0], nx = b.st[1];
        if (nloc == 0u) { xcd_barrier_complete(bar, b.x, nloc, nx); b.st[0] = nloc; b.st[1] = nx; }
        const unsigned old = xb_add(&bar[XB_XSUB(b.x)], 1u);
        const unsigned gen = old / nloc;
        if (old + 1u == (gen + 1u) * nloc) {
            __builtin_amdgcn_fence(__ATOMIC_RELEASE, "agent");
            asm volatile("s_waitcnt vmcnt(0)" ::: "memory");
            const unsigned og = xb_add(&bar[XB_TOP], 1u);
            const unsigned tg = og / nx;
            if (og + 1u == (tg + 1u) * nx) xb_add(&bar[XB_TOPGEN], 1u);
            else XB_SPIN(xb_ld(&bar[XB_TOPGEN]) == tg, bar);
            __builtin_amdgcn_fence(__ATOMIC_ACQUIRE, "agent");
            xb_add(&bar[XB_XGEN(b.x)], 1u);
            asm volatile("s_waitcnt vmcnt(0)" ::: "memory");
        } else {
            XB_SPIN(xb_ld(&bar[XB_XGEN(b.x)]) == gen, bar);
            __builtin_amdgcn_fence(__ATOMIC_ACQUIRE, "agent");
            asm volatile("s_waitcnt vmcnt(0)" ::: "memory");
        }
    }
    __syncthreads();
}

#ifndef ONLY_PH
#define ONLY_PH -1
#endif
#ifndef SKIP_PH
#define SKIP_PH -2
#endif
#define PH_ON(k) ((ONLY_PH < 0 || ONLY_PH == (k)) && (k) != SKIP_PH)
__global__ void __launch_bounds__(512, 2) mega_fwd(Args a_) {
    extern __shared__ __attribute__((aligned(16))) unsigned char lds[];
    cg::grid_group grid = cg::this_grid();
    const int ph_lo = a_.lo, ph_hi = a_.hi;
    volatile LAS unsigned* bst = (volatile LAS unsigned*)((LAS unsigned char*)lds + 131072);
    if (threadIdx.x < 2) bst[threadIdx.x] = 0u;
    __syncthreads();
    const XcdBarrier xbar = xcd_barrier_post((unsigned*)(a_.ws + WS_BAR), bst);
    const int wave_s = __builtin_amdgcn_readfirstlane((int)threadIdx.x >> 6);
#pragma nounroll
    for (int ph = ph_lo; ph < ph_hi; ++ph) {
        CArgs* ap = (CArgs*)__builtin_amdgcn_kernarg_segment_ptr(); asm volatile("" : "+s"(ap));
        CArgs& a = *ap;
        unsigned char* ws = a.ws;
        float* XC = (float*)(ws + WS_XC);
        int wsv = wave_s; asm volatile("" : "+s"(wsv));
        TI ti; ti.tid = wsv * 64 + (int)__builtin_amdgcn_mbcnt_hi(~0u, __builtin_amdgcn_mbcnt_lo(~0u, 0u)); ti.bid = blockIdx.x; ti.nblk = gridDim.x;
        asm volatile("" : "+v"(ti.tid)); asm volatile("" : "+s"(ti.bid)); asm volatile("" : "+s"(ti.nblk));
        const int tid = ti.tid, lane = tid & 63, wv = __builtin_amdgcn_readfirstlane(tid >> 6);
        const int gw = ti.bid * 8 + wv, ngw = ti.nblk * 8;
        if (ph == 0) { if constexpr (PH_ON(100)) ph_mods(ti, a, lds); }
        else {
            const int l = (ph - 1) / NPH, k = (ph - 1) % NPH;
            const bool ctx_out = l < DEPTH - 1;
            const int Mr = ctx_out ? M : ML;
            const float* modl = (const float*)(ws + WS_MOD) + (size_t)l * 9 * 6144;
            const float* xl_in = l == 0 ? a.in[0] : a.out; const float* xc_in = l == 0 ? a.in[2] : XC;
            bf16_t* H = (bf16_t*)(ws + WS_H);
            switch (k) {
            case 0: if constexpr (PH_ON(0)) {
                norm_rows(xl_in, xc_in, a.in[6] + l * 1024, modl, 0, 1, H, M, gw, ngw, lane);
                ph_wconv(a, l, lds, gw, ngw, lane, wv, l == 0 ? 31 : 16);
                } break;
            case 1: if constexpr (PH_ON(1)) {
                OpIn op{(bf16_t*)(ws + WS_GU), (bf16_t*)(ws + WS_GV), (bf16_t*)(ws + WS_Q), (bf16_t*)(ws + WS_RW), (bf16_t*)(ws + WS_GT)};
                run_gemm(ti, lds, H, (const bf16_t*)(ws + WS_WIN), M, PPAD, 1024, op);
            } break;
            case 2: if constexpr (PH_ON(2)) {
                for (int u = ti.bid; u < Mr / 128; u += ti.nblk) gmlp_unit(ti, a, l, u, lds);
                qk_rows(a, l, gw, ngw, lane);
                lora_in_rows(a, l, gw, ngw, lane);
                } break;
            case 3: if constexpr (PH_ON(3)) {
                OpDec o1{(bf16_t*)(ws + WS_GV), (bf16_t*)(ws + WS_DEC1), a.in[17] + l * 2048};
                run_gemm(ti, lds, (const bf16_t*)(ws + WS_LIW), (const bf16_t*)(ws + WS_LWT), M, 2048, 128, o1);
                OpAA o2{(bf16_t*)(ws + WS_AA0), (bf16_t*)(ws + WS_AA1), a.in[19] + l * 2048};
                run_gemm(ti, lds, (const bf16_t*)(ws + WS_LIA), (const bf16_t*)(ws + WS_LAT), M, 2048, 128, o2);
                OpG o3{(bf16_t*)(ws + WS_G)};
                run_gemm(ti, lds, (const bf16_t*)(ws + WS_LIG), (const bf16_t*)(ws + WS_LGT), M, 1024, 256, o3);
            } break;
            case 4:
                if constexpr (PH_ON(4)) { for (int u = ti.bid; u < 256; u += ti.nblk) scan_unit_mfma(ti, a, l, u, ctx_out, lds); }
                if constexpr (PH_ON(40)) ph_attn(ti, a, l, ctx_out, lds);
                break;
            case 5: if constexpr (PH_ON(5)) {
                rwkv_out_rows(a, l, Mr, gw, ngw, lane);
                } break;
            case 6: if constexpr (PH_ON(6)) {
                const bf16_t* GT = (const bf16_t*)(ws + WS_GT); float* MF = (float*)(ws + WS_K);
                OpMerge<0> o0{GT, MF, H}; run_gemm(ti, lds, (const bf16_t*)(ws + WS_GU), (const bf16_t*)(ws + WS_WA), Mr, 1024, 1024, o0);
                OpMerge<1> o1{GT, MF, H}; run_gemm(ti, lds, (const bf16_t*)(ws + WS_Q), (const bf16_t*)(ws + WS_WB), Mr, 1024, 1024, o1);
                OpMerge<2> o2{GT, MF, H}; run_gemm(ti, lds, (const bf16_t*)(ws + WS_Y1), (const bf16_t*)(ws + WS_WC), Mr, 1024, 1024, o2);
                if (ctx_out && ti.nblk > 64 && ti.bid >= 32) ph_wconv(a, l + 1, lds, (ti.bid - 32) * 8 + wv, (ti.nblk - 32) * 8, lane, wv, 1);
                else if (ctx_out && ti.nblk <= 64) ph_wconv(a, l + 1, lds, gw, ngw, lane, wv, 1);
            } break;
            case 7: if constexpr (PH_ON(7)) {
                OpResid op{xl_in, xc_in, a.out, XC, modl, 2};
                run_gemm(ti, lds, H, (const bf16_t*)(ws + WS_WO), Mr, 1024, 1024, op);
                if (ctx_out && ti.nblk > 64 && ti.bid >= 32) ph_wconv(a, l + 1, lds, (ti.bid - 32) * 8 + wv, (ti.nblk - 32) * 8, lane, wv, 2);
                else if (ctx_out && ti.nblk <= 64) ph_wconv(a, l + 1, lds, gw, ngw, lane, wv, 2);
            } break;
            case 8: if constexpr (PH_ON(8)) {
                norm_rows(a.out, XC, a.in[7] + l * 1024, modl, 3, 4, H, Mr, gw, ngw, lane);
                } break;
            case 9: if constexpr (PH_ON(9)) {
                OpSwiglu op{(bf16_t*)(ws + WS_RW)};
                run_gemm(ti, lds, H, (const bf16_t*)(ws + WS_WI), Mr, 2 * DFF, 1024, op);
            } break;
            default: if constexpr (PH_ON(10)) {
                OpResid op{a.out, XC, a.out, XC, modl, 5};
                run_gemm(ti, lds, (const bf16_t*)(ws + WS_RW), (const bf16_t*)(ws + WS_WO2), Mr, 1024, DFF, op);
                if (ctx_out && ti.nblk > 64 && ti.bid >= 32) ph_wconv(a, l + 1, lds, (ti.bid - 32) * 8 + wv, (ti.nblk - 32) * 8, lane, wv, 12);
                else if (ctx_out && ti.nblk <= 64) ph_wconv(a, l + 1, lds, gw, ngw, lane, wv, 12);
            } break;
            }
        }
        if (ph + 1 < ph_hi) { if (ph == ph_lo) grid.sync(); else xcd_barrier(xbar); }
    }
}

extern "C" void kernel_launch(void* const* d_in, const int* in_sizes, int n_in, void* d_out, int out_size, void* d_ws, size_t ws_size, hipStream_t stream) {
    static int grid = 0;
    if (grid == 0) {
        if (n_in != 33 || out_size != ML * D || ws_size < WS_END) { fprintf(stderr, "kernel_launch: unexpected shapes / workspace (%d inputs, out %d, ws %zu, need %zu)\n", n_in, out_size, ws_size, (size_t)WS_END); grid = -1; return; }
        int dev = 0, cus = 0, per_cu = 0;
        hipGetDevice(&dev); hipDeviceGetAttribute(&cus, hipDeviceAttributeMultiprocessorCount, dev);
        if (hipFuncSetAttribute((const void*)mega_fwd, hipFuncAttributeMaxDynamicSharedMemorySize, LDS_BYTES) != hipSuccess) { fprintf(stderr, "kernel_launch: hipFuncSetAttribute failed\n"); grid = -1; return; }
        if (hipOccupancyMaxActiveBlocksPerMultiprocessor(&per_cu, (const void*)mega_fwd, 512, LDS_BYTES) != hipSuccess || per_cu < 1) per_cu = 1;
        (void)hipGetLastError();
        grid = cus * 1;
    }
    if (grid < 0) return;
    Args a{};
    for (int i = 0; i < 33; ++i) a.in[i] = (const float*)d_in[i];
    a.out = (float*)d_out; a.ws = (unsigned char*)d_ws; a.lo = 0; a.hi = NPHASES;
    void* args[] = {&a};
    if (hipMemsetAsync((char*)d_ws + WS_BAR, 0, BAR_BYTES, stream) != hipSuccess) { fprintf(stderr, "kernel_launch: memset of barrier words failed\n"); return; }
    hipError_t e = hipLaunchCooperativeKernel((const void*)mega_fwd, dim3(grid), dim3(512), args, LDS_BYTES, stream);
    if (e != hipSuccess) fprintf(stderr, "kernel_launch: cooperative launch failed: %s (grid %d)\n", hipGetErrorString(e), grid);
}
```

```cpp
#include <hip/hip_runtime.h>
#include <hip/hip_cooperative_groups.h>
#include <cstdio>
#include <cstdint>
namespace cg = cooperative_groups;
namespace pg8 {
#define PG8_LAS __attribute__((address_space(3)))
typedef unsigned short bf16_t;
typedef short bf16x8 __attribute__((ext_vector_type(8)));
typedef float f32x4 __attribute__((ext_vector_type(4)));
typedef unsigned u32x4 __attribute__((ext_vector_type(4)));
constexpr int BM = 256, BK = 64, HALF = 128, HTB = HALF * BK * 2  , STAGE_BYTES = 8 * HTB, NXCD = 8, WGM = 8;

__host__ __device__ __forceinline__ int lds_byte(int r, int c) { const int st = (r >> 4) * 2 + (c >> 5), rr = r & 15, cc = c & 31, ob = rr * 64 + cc * 2; return st * 1024 + (ob ^ (((ob >> 9) & 1) << 5)); }
__host__ __device__ __forceinline__ void stage_rc(int b, int& R, int& C) { const int st = b / 1024, sb = b % 1024, swz = sb ^ (((sb >> 9) & 1) << 5); R = (st >> 1) * 16 + swz / 64; C = (st & 1) * 32 + (swz % 64) / 2; }
__host__ __device__ __forceinline__ int perm32(int rho) { const int n = rho >> 4, i = rho & 15; return 8 * (i >> 2) + 4 * n + (i & 3); }

struct Unit { int pm, pn; };
struct Gemm { const bf16_t* A; const bf16_t* Bt; int M, N, K; };

struct StaticOrder {
    int nM, nN, nwg, G, c;
    __host__ __device__ void init(int M, int N, int G_, int c_) { nM = M / BM; nN = N / BM; nwg = nM * nN; G = G_; c = c_; }
    __host__ __device__ bool next(int i, Unit& u) const {
        const long L = (long)i * G + c; if (L >= nwg) return false;
        int wgid = (int)L; { const int q = nwg / NXCD, r = nwg % NXCD, xcd = wgid % NXCD, off = wgid / NXCD; wgid = (xcd < r ? xcd * (q + 1) : r * (q + 1) + (xcd - r) * q) + off; }
        const int nig = WGM * nN, gid = wgid / nig, fm = gid * WGM, gsz = (nM - fm) < WGM ? (nM - fm) : WGM;
        u.pm = fm + ((wgid % nig) % gsz); u.pn = (wgid % nig) / gsz; return true;
    }
    __device__ __forceinline__ void a_ready(const Unit&) const {}
    __device__ __forceinline__ void done(const Unit&) const {}
};

__device__ __forceinline__ unsigned cvt_pk_bf16(float lo, float hi) { unsigned r; asm volatile("v_cvt_pk_bf16_f32 %0, %1, %2" : "=v"(r) : "v"(lo), "v"(hi)); return r; }
typedef float f32x2 __attribute__((ext_vector_type(2)));
__device__ __forceinline__ f32x2 gelu_pk(f32x2 v) {
    const f32x2 av = __builtin_elementwise_abs(v), d = av * 0.2316418882f + 1.0f;
    f32x2 t; t.x = __builtin_amdgcn_rcpf(d.x); t.y = __builtin_amdgcn_rcpf(d.y);
    f32x2 q = t * 0.5307027145f + (-0.7265760135f); q = q * t + 0.7107068705f; q = q * t + (-0.142248368f); q = q * t + 0.127414796f; q = q * t;
    const f32x2 s = (v * v) * (-0.72134752044f);
    f32x2 e; e.x = __builtin_amdgcn_exp2f(s.x); e.y = __builtin_amdgcn_exp2f(s.y);
    const f32x2 m = v * (q * e), r = v - m;
    f32x2 o; o.x = v.x < 0.f ? m.x : r.x; o.y = v.y < 0.f ? m.y : r.y; return o;
}

template <class Epi, class Sched, bool ALIGN_EPI = false, bool SP2 = false>
__device__ __forceinline__ void gemm_phase(PG8_LAS unsigned char* lds, const Gemm g, const Sched& S, const Epi& E, const int tid_in) {
    const int tid = tid_in, wid = __builtin_amdgcn_readfirstlane(tid >> 6), lane = tid & 63, wr = wid >> 2, wc = wid & 3, fr = lane & 15, fq = lane >> 4;
    const int K = g.K, nt = K / BK;
    unsigned voffA[2], voffB[2];
#pragma unroll
    for (int i = 0; i < 2; ++i) { int R, C; stage_rc(tid * 16 + i * 8192, R, C); const int Rb = Epi::PERM ? ((R & ~31) + perm32(R & 31)) : R;
        voffA[i] = (unsigned)(R * K + C) * 2u; voffB[i] = (unsigned)(Rb * K + C) * 2u; }
    const size_t kstep = (size_t)(BK * 2);
    const size_t hstep = (size_t)HALF * K * 2;
    const size_t tstep = 2 * hstep;
    const unsigned ldsw = (unsigned)wid * 1024u;
    const int aoff = lds_byte(wr * 64 + fr, fq * 8), boff = lds_byte(wc * 32 + fr, fq * 8);
#define PG8_SA(b, h) (((b) * 2 + (h)) * HTB)
#define PG8_SB(b, h) ((4 + (b) * 2 + (h)) * HTB)
#define PG8_STAGE(bufoff, gbase, voff) do { _Pragma("unroll") for (int _i = 0; _i < 2; ++_i) \
        __builtin_amdgcn_global_load_lds((const unsigned*)((const char*)(gbase) + (voff)[_i]), (PG8_LAS unsigned*)(lds + (bufoff) + ldsw + _i * 8192), 16, 0, 0); } while (0)
#define PG8_LDA(dst, b, h) do { _Pragma("unroll") for (int m = 0; m < 4; ++m) _Pragma("unroll") for (int k = 0; k < 2; ++k) dst[m][k] = *(const PG8_LAS bf16x8*)(lds + PG8_SA(b, h) + aoff + m * 2048 + k * 1024); } while (0)
#define PG8_LDB(dst, b, h) do { _Pragma("unroll") for (int n = 0; n < 2; ++n) _Pragma("unroll") for (int k = 0; k < 2; ++k) dst[n][k] = *(const PG8_LAS bf16x8*)(lds + PG8_SB(b, h) + boff + n * 2048 + k * 1024); } while (0)
#define PG8_MMA(ai, bj, At, Bt) do { __builtin_amdgcn_s_setprio(1); _Pragma("unroll") for (int m = 0; m < 4; ++m) _Pragma("unroll") for (int n = 0; n < 2; ++n) _Pragma("unroll") for (int k = 0; k < 2; ++k) \
        acc[ai][bj][m][n] = __builtin_amdgcn_mfma_f32_16x16x32_bf16(Bt[n][k], At[m][k], acc[ai][bj][m][n], 0, 0, 0); __builtin_amdgcn_s_setprio(0); } while (0)
#define PG8_WAIT_V(n) asm volatile("s_waitcnt vmcnt(" #n ")" ::: "memory")
#define PG8_WAIT_L(n) asm volatile("s_waitcnt lgkmcnt(" #n ")" ::: "memory")
#define PG8_BAR __builtin_amdgcn_s_barrier()
#define PG8_SCHED __builtin_amdgcn_sched_barrier(0)
    Unit cur, nxt; int ui = 0;
    if (!S.next(0, cur)) return;
    f32x4 acc[2][2][4][2];
#pragma unroll
    for (int a = 0; a < 2; ++a)
#pragma unroll
        for (int b = 0; b < 2; ++b)
#pragma unroll
            for (int m = 0; m < 4; ++m)
#pragma unroll
                for (int n = 0; n < 2; ++n) acc[a][b][m][n] = (f32x4){0.f, 0.f, 0.f, 0.f};
    bf16x8 At[4][2], B0[2][2], B1[2][2];
    const char* cA = (const char*)g.A + (size_t)cur.pm * tstep; const char* cB = (const char*)g.Bt + (size_t)cur.pn * tstep;
    S.a_ready(cur);
    if constexpr (SP2) {
        PG8_STAGE(PG8_SB(0, 0), cB, voffB); PG8_STAGE(PG8_SB(0, 1), cB + hstep, voffB); PG8_STAGE(PG8_SA(0, 0), cA, voffA); PG8_STAGE(PG8_SA(0, 1), cA + hstep, voffA);
        if (wr == 1) PG8_BAR;
        PG8_WAIT_V(2); PG8_BAR;
        PG8_STAGE(PG8_SB(1, 0), cB + kstep, voffB); PG8_STAGE(PG8_SA(1, 0), cA + kstep, voffA); PG8_STAGE(PG8_SB(1, 1), cB + hstep + kstep, voffB);
        PG8_WAIT_V(6); PG8_BAR;
    } else {
        PG8_STAGE(PG8_SB(0, 0), cB, voffB); PG8_STAGE(PG8_SA(0, 0), cA, voffA); PG8_STAGE(PG8_SB(0, 1), cB + hstep, voffB); PG8_STAGE(PG8_SA(0, 1), cA + hstep, voffA);
        if (wr == 1) PG8_BAR;
        PG8_WAIT_V(4); PG8_BAR;
        PG8_STAGE(PG8_SB(1, 0), cB + kstep, voffB); PG8_STAGE(PG8_SA(1, 0), cA + kstep, voffA); PG8_STAGE(PG8_SB(1, 1), cB + hstep + kstep, voffB);
        PG8_WAIT_V(6); PG8_BAR;
    }
    for (;;) {
        const bool has_next = S.next(ui + 1, nxt);
        const char* nA = has_next ? (const char*)g.A + (size_t)nxt.pm * tstep : cA; const char* nB = has_next ? (const char*)g.Bt + (size_t)nxt.pn * tstep : cB;
        for (int t = 0; t < nt; t += 2) {
            const bool last = (t == nt - 2);
            const char* a1 = cA + (size_t)(t + 1) * kstep;
            const char* a2 = last ? nA : cA + (size_t)(t + 2) * kstep; const char* b2 = last ? nB : cB + (size_t)(t + 2) * kstep;
            const char* a3 = a2 + kstep; const char* b3 = b2 + kstep;
            if (last && has_next) S.a_ready(nxt);
            if constexpr (SP2) {
            PG8_LDB(B0, 0, 0); PG8_LDB(B1, 0, 1); PG8_SCHED; PG8_LDA(At, 0, 0); PG8_STAGE(PG8_SA(1, 1), a1 + hstep, voffA);
            PG8_WAIT_V(8); PG8_WAIT_L(0); PG8_BAR; PG8_MMA(0, 0, At, B0); PG8_MMA(0, 1, At, B1); PG8_BAR; PG8_SCHED;
            PG8_LDA(At, 0, 1); PG8_STAGE(PG8_SB(0, 0), b2, voffB); PG8_STAGE(PG8_SB(0, 1), b2 + hstep, voffB); PG8_STAGE(PG8_SA(0, 0), a2, voffA);
            PG8_WAIT_V(8); PG8_WAIT_L(0); PG8_BAR; PG8_MMA(1, 0, At, B0); PG8_MMA(1, 1, At, B1); PG8_BAR; PG8_SCHED;
            PG8_LDB(B0, 1, 0); PG8_LDB(B1, 1, 1); PG8_SCHED; PG8_LDA(At, 1, 0); PG8_STAGE(PG8_SA(0, 1), a2 + hstep, voffA);
            PG8_WAIT_V(8); PG8_WAIT_L(0); PG8_BAR; PG8_MMA(0, 0, At, B0); PG8_MMA(0, 1, At, B1); PG8_BAR; PG8_SCHED;
            PG8_LDA(At, 1, 1); PG8_STAGE(PG8_SB(1, 0), b3, voffB); PG8_STAGE(PG8_SB(1, 1), b3 + hstep, voffB); PG8_STAGE(PG8_SA(1, 0), a3, voffA);
            PG8_WAIT_V(8); PG8_WAIT_L(0); PG8_BAR; PG8_MMA(1, 0, At, B0); PG8_MMA(1, 1, At, B1); PG8_BAR; PG8_SCHED;
            } else {
            PG8_LDB(B0, 0, 0); PG8_SCHED; PG8_LDA(At, 0, 0); PG8_STAGE(PG8_SA(1, 1), a1 + hstep, voffA);
            PG8_WAIT_L(8); PG8_BAR; PG8_WAIT_L(0); PG8_MMA(0, 0, At, B0); PG8_BAR; PG8_SCHED;
            PG8_LDB(B1, 0, 1); PG8_STAGE(PG8_SB(0, 0), b2, voffB);
            PG8_BAR; PG8_WAIT_L(0); PG8_MMA(0, 1, At, B1); PG8_BAR;
            PG8_LDA(At, 0, 1); PG8_STAGE(PG8_SA(0, 0), a2, voffA);
            PG8_BAR; PG8_WAIT_L(0); PG8_MMA(1, 0, At, B0); PG8_BAR; PG8_SCHED;
            PG8_STAGE(PG8_SB(0, 1), b2 + hstep, voffB);
            PG8_WAIT_V(6); PG8_BAR; PG8_MMA(1, 1, At, B1); PG8_BAR;
            PG8_LDB(B0, 1, 0); PG8_SCHED; PG8_LDA(At, 1, 0); PG8_STAGE(PG8_SA(0, 1), a2 + hstep, voffA);
            PG8_WAIT_L(8); PG8_BAR; PG8_WAIT_L(0); PG8_MMA(0, 0, At, B0); PG8_BAR; PG8_SCHED;
            PG8_LDB(B1, 1, 1); PG8_STAGE(PG8_SB(1, 0), b3, voffB);
            PG8_BAR; PG8_WAIT_L(0); PG8_MMA(0, 1, At, B1); PG8_BAR;
            PG8_LDA(At, 1, 1); PG8_STAGE(PG8_SA(1, 0), a3, voffA);
            PG8_BAR; PG8_WAIT_L(0); PG8_MMA(1, 0, At, B0); PG8_BAR; PG8_SCHED;
            PG8_STAGE(PG8_SB(1, 1), b3 + hstep, voffB);
            PG8_WAIT_V(6); PG8_BAR; PG8_MMA(1, 1, At, B1); PG8_BAR;
            }
        }
        if constexpr (ALIGN_EPI) { if (wr == 0) PG8_BAR; }
        if constexpr (!Epi::AFTER_DRAIN) { E(acc, cur, wr, wc, fr, fq); S.done(cur); }
        if (!has_next) break;
#pragma unroll
        for (int a = 0; a < 2; ++a)
#pragma unroll
            for (int b = 0; b < 2; ++b)
#pragma unroll
                for (int m = 0; m < 4; ++m)
#pragma unroll
                    for (int n = 0; n < 2; ++n) acc[a][b][m][n] = (f32x4){0.f, 0.f, 0.f, 0.f};
        cur = nxt; cA = nA; cB = nB; ++ui;
        if constexpr (ALIGN_EPI) { if (wr == 1) PG8_BAR; }
    }
    PG8_WAIT_V(0);
    if constexpr (!ALIGN_EPI) { if (wr == 0) PG8_BAR; }
    PG8_BAR;
    if constexpr (Epi::AFTER_DRAIN) { E.fused(acc, cur, wr, wc, fr, fq, lds, wid, lane); S.done(cur); }
#undef PG8_SA
#undef PG8_SB
#undef PG8_STAGE
#undef PG8_LDA
#undef PG8_LDB
#undef PG8_MMA
#undef PG8_WAIT_V
#undef PG8_WAIT_L
#undef PG8_BAR
#undef PG8_SCHED
}
}

#define LAS __attribute__((address_space(3)))
typedef unsigned short bf16_t;
typedef float f32x2 __attribute__((ext_vector_type(2)));
typedef float f32x4 __attribute__((ext_vector_type(4)));
typedef float f32x16 __attribute__((ext_vector_type(16)));
typedef short bf16x8 __attribute__((ext_vector_type(8)));
typedef short s16x4 __attribute__((ext_vector_type(4)));
typedef unsigned u32x4 __attribute__((ext_vector_type(4)));
typedef unsigned u32x2 __attribute__((ext_vector_type(2)));
typedef __bf16 bf16x2v __attribute__((ext_vector_type(2)));
#define MFMA32(a, b, c) __builtin_amdgcn_mfma_f32_32x32x16_bf16((a), (b), (c), 0, 0, 0)

constexpr int D = 1024, NB = 8, TL = 2048, TCX = 256, DEPTH = 4;
constexpr int ML = NB * TL, MC = NB * TCX, M = ML + MC;
constexpr int PPAD = 11776, RWP = 3584, DFF = 2816;
constexpr int NPH = 11, NPHASES = 1 + DEPTH * NPH;
constexpr size_t MiB = 1u << 20;
constexpr size_t WS_MOD = 0, WS_WIN = 1 * MiB, WS_WA = 24 * MiB, WS_WB = 26 * MiB, WS_WC = 28 * MiB, WS_WO = 30 * MiB, WS_WI = 32 * MiB, WS_WO2 = 43 * MiB,
                 WS_LWT = 48 * MiB + MiB / 2, WS_LAT = 49 * MiB, WS_LGT = 49 * MiB + MiB / 2, WS_H = 50 * MiB, WS_XC = 86 * MiB, WS_GU = 94 * MiB, WS_GV = 130 * MiB,
                 WS_Q = 166 * MiB, WS_K = 202 * MiB, WS_V = 238 * MiB, WS_RW = 274 * MiB, WS_GT = 400 * MiB, WS_LIW = 508 * MiB, WS_LIA = 512 * MiB + MiB / 2,
                 WS_LIG = 517 * MiB, WS_DEC1 = 526 * MiB, WS_AA0 = 562 * MiB, WS_AA1 = 598 * MiB, WS_G = 634 * MiB, WS_Y1 = 670 * MiB, WS_ROPE = 706 * MiB, WS_END = 707 * MiB;
constexpr int LDS_BYTES = 131072 + 1024;
constexpr size_t WS_BAR = 917504, BAR_BYTES = 16384;
constexpr float QSCALE = 0.125f * 1.4426950408889634f;

struct Args { const float* in[33]; float* out; unsigned char* ws; int lo, hi; };
typedef const __attribute__((address_space(4))) Args CArgs;
struct TI { int tid, bid, nblk; };

__device__ __forceinline__ float bf2f(unsigned v) { return __uint_as_float(v << 16); }
__device__ __forceinline__ unsigned pkbf(float lo, float hi) { f32x2 v = {lo, hi}; bf16x2v b = __builtin_convertvector(v, bf16x2v); return __builtin_bit_cast(unsigned, b); }
__device__ __forceinline__ bf16_t f2bf(float f) { return (bf16_t)(pkbf(f, 0.f) & 0xffffu); }
#define DPP_ADD(x, ctrl) ((x) + __builtin_bit_cast(float, __builtin_amdgcn_update_dpp(0, __builtin_bit_cast(int, (x)), (ctrl), 0xf, 0xf, true)))
__device__ __forceinline__ float wave_sum(float v) {
    v = DPP_ADD(v, 0xB1); v = DPP_ADD(v, 0x4E); v = DPP_ADD(v, 0x141); v = DPP_ADD(v, 0x140);
    const int iv = __builtin_bit_cast(int, v);
    const float s0 = __builtin_bit_cast(float, __builtin_amdgcn_readlane(iv, 0)), s1 = __builtin_bit_cast(float, __builtin_amdgcn_readlane(iv, 16)),
                s2 = __builtin_bit_cast(float, __builtin_amdgcn_readlane(iv, 32)), s3 = __builtin_bit_cast(float, __builtin_amdgcn_readlane(iv, 48));
    return (s0 + s1) + (s2 + s3);
}
__device__ __forceinline__ float dpp_sum8(float x) {
    x += __builtin_bit_cast(float, __builtin_amdgcn_update_dpp(0, __builtin_bit_cast(int, x), 0xB1, 0xf, 0xf, true));
    x += __builtin_bit_cast(float, __builtin_amdgcn_update_dpp(0, __builtin_bit_cast(int, x), 0x4E, 0xf, 0xf, true));
    x += __builtin_bit_cast(float, __builtin_amdgcn_update_dpp(0, __builtin_bit_cast(int, x), 0x141, 0xf, 0xf, true));
    return x;
}
__device__ __forceinline__ float quad_sum(float x) { x = DPP_ADD(x, 0xB1); x = DPP_ADD(x, 0x4E); return x; }
__device__ __forceinline__ float quad_xor2(float x) { return __builtin_bit_cast(float, __builtin_amdgcn_update_dpp(0, __builtin_bit_cast(int, x), 0x4E, 0xf, 0xf, true)); }
__device__ __forceinline__ void unpack16(const bf16_t* p, float (&x)[16]) {
    const u32x4 a = *(const u32x4*)p, b = *(const u32x4*)(p + 8);
#pragma unroll
    for (int i = 0; i < 4; ++i) { x[2 * i] = bf2f(a[i] & 0xffffu); x[2 * i + 1] = bf2f(a[i] >> 16); x[8 + 2 * i] = bf2f(b[i] & 0xffffu); x[8 + 2 * i + 1] = bf2f(b[i] >> 16); }
}
__device__ __forceinline__ void pack16(bf16_t* p, const float (&x)[16]) {
    u32x4 a, b;
#pragma unroll
    for (int i = 0; i < 4; ++i) { a[i] = pkbf(x[2 * i], x[2 * i + 1]); b[i] = pkbf(x[8 + 2 * i], x[8 + 2 * i + 1]); }
    *(u32x4*)p = a; *(u32x4*)(p + 8) = b;
}
__device__ __forceinline__ void load16f(const float* p, float (&x)[16]) {
#pragma unroll
    for (int i = 0; i < 4; ++i) { const f32x4 v = *(const f32x4*)(p + 4 * i); x[4 * i] = v.x; x[4 * i + 1] = v.y; x[4 * i + 2] = v.z; x[4 * i + 3] = v.w; }
}
__device__ __forceinline__ float sigmoidf_(float x) { return 1.f / (1.f + __expf(-x)); }

typedef const __attribute__((address_space(1))) bf16_t* gcptr_t;
__device__ __forceinline__ gcptr_t uniptr(const bf16_t* p) {
    const unsigned long long v = (unsigned long long)p;
    const unsigned lo = __builtin_amdgcn_readfirstlane((unsigned)v), hi = __builtin_amdgcn_readfirstlane((unsigned)(v >> 32));
    return (gcptr_t)(((unsigned long long)hi << 32) | lo);
}
template <class Op> struct EpiT {
    static constexpr bool PERM = true, AFTER_DRAIN = false;
    Op op;
    __device__ __forceinline__ void operator()(const pg8::f32x4 (&acc)[2][2][4][2], const pg8::Unit& u, int wr, int wc, int fr, int fq) const {
        const int row0 = u.pm * 256 + wr * 64 + fr, col0 = u.pn * 256 + wc * 32 + 8 * fq;
#pragma unroll
        for (int ai = 0; ai < 2; ++ai)
#pragma unroll
            for (int m = 0; m < 4; ++m)
#pragma unroll
                for (int bj = 0; bj < 2; ++bj) { op(row0 + ai * 128 + m * 16, col0 + bj * 128, acc[ai][bj][m][0], acc[ai][bj][m][1]); asm volatile("" ::: "memory"); }
    }
};
__device__ __forceinline__ u32x4 pack8(f32x4 v0, f32x4 v1) { u32x4 o; o.x = pkbf(v0.x, v0.y); o.y = pkbf(v0.z, v0.w); o.z = pkbf(v1.x, v1.y); o.w = pkbf(v1.z, v1.w); return o; }
__device__ __forceinline__ void unpack8(u32x4 x, f32x4& v0, f32x4& v1) {
    v0.x = bf2f(x.x & 0xffffu); v0.y = bf2f(x.x >> 16); v0.z = bf2f(x.y & 0xffffu); v0.w = bf2f(x.y >> 16);
    v1.x = bf2f(x.z & 0xffffu); v1.y = bf2f(x.z >> 16); v1.z = bf2f(x.w & 0xffffu); v1.w = bf2f(x.w >> 16);
}
__device__ __forceinline__ f32x4 gelu4(f32x4 v) { pg8::f32x2 a = pg8::gelu_pk((pg8::f32x2){v.x, v.y}), b = pg8::gelu_pk((pg8::f32x2){v.z, v.w}); return (f32x4){a.x, a.y, b.x, b.y}; }
__device__ __forceinline__ f32x4 sig4(f32x4 v) { return (f32x4){sigmoidf_(v.x), sigmoidf_(v.y), sigmoidf_(v.z), sigmoidf_(v.w)}; }

struct OpIn {
    bf16_t *GU, *GV, *Q, *RW, *GT;
    __device__ __forceinline__ void operator()(int row, int col, f32x4 v0, f32x4 v1) const {
        bf16_t* dst;
        if (col < 2048) { v0 = gelu4(v0); v1 = gelu4(v1); dst = (col < 1024 ? GU : GV) + (size_t)row * 1024 + (col & 1023); }
        else if (col < 5120) { const int q = col - 2048; dst = Q + (size_t)(q >> 10) * (size_t)(18 * MiB) + (size_t)row * 1024 + (q & 1023); }
        else if (col < 8704) { dst = RW + (size_t)row * RWP + (col - 5120); }
        else { v0 = sig4(v0); v1 = sig4(v1); dst = GT + (size_t)row * 3072 + (col - 8704); }
        *(u32x4*)dst = pack8(v0, v1);
    }
};
struct OpDec {
    bf16_t *D0, *D1; const float* w0;
    __device__ __forceinline__ float f(float x) const { return -0.6065306597126334f * sigmoidf_(x); }
    __device__ __forceinline__ void operator()(int row, int col, f32x4 v0, f32x4 v1) const {
        const f32x4 b0 = *(const f32x4*)(w0 + col), b1 = *(const f32x4*)(w0 + col + 4);
        v0 += b0; v1 += b1;
        v0 = (f32x4){f(v0.x), f(v0.y), f(v0.z), f(v0.w)}; v1 = (f32x4){f(v1.x), f(v1.y), f(v1.z), f(v1.w)};
        bf16_t* dst = (col < 1024 ? D0 : D1) + (size_t)row * 1024 + (col & 1023);
        *(u32x4*)dst = pack8(v0, v1);
    }
};
struct OpAA {
    bf16_t *A0, *A1; const float* a0;
    __device__ __forceinline__ void operator()(int row, int col, f32x4 v0, f32x4 v1) const {
        const f32x4 b0 = *(const f32x4*)(a0 + col), b1 = *(const f32x4*)(a0 + col + 4);
        v0 = sig4(v0 + b0); v1 = sig4(v1 + b1);
        bf16_t* dst = (col < 1024 ? A0 : A1) + (size_t)row * 1024 + (col & 1023);
        *(u32x4*)dst = pack8(v0, v1);
    }
};
struct OpG {
    bf16_t* G;
    __device__ __forceinline__ void operator()(int row, int col, f32x4 v0, f32x4 v1) const { *(u32x4*)(G + (size_t)row * 1024 + col) = pack8(v0, v1); }
};
template <int KB> struct OpMerge {
    const bf16_t* GT; float* MF; bf16_t* MB;
    __device__ __forceinline__ void operator()(int row, int col, f32x4 v0, f32x4 v1) const {
        f32x4 g0, g1; unpack8(*(const u32x4*)(GT + (size_t)row * 3072 + KB * 1024 + col), g0, g1);
        float* mf = MF + (size_t)row * 1024 + col;
        f32x4 r0 = g0 * v0, r1 = g1 * v1;
        if (KB > 0) { r0 += *(const f32x4*)mf; r1 += *(const f32x4*)(mf + 4); }
        if (KB < 2) { *(f32x4*)mf = r0; *(f32x4*)(mf + 4) = r1; }
        else *(u32x4*)(MB + (size_t)row * 1024 + col) = pack8(r0, r1);
    }
};
struct OpResid {
    const float *xl, *xc; float *ol, *oc; const float* mod; int gi;
    __device__ __forceinline__ void operator()(int row, int col, f32x4 v0, f32x4 v1) const {
        const float* xi; float* xo; const float* g;
        if (row < ML) { xi = xl + (size_t)row * 1024 + col; xo = ol + (size_t)row * 1024 + col; g = mod + (size_t)(row >> 11) * 6144 + gi * 1024 + col; }
        else { const size_t rr = (size_t)(row - ML) * 1024 + col; xi = xc + rr; xo = oc + rr; g = mod + (size_t)8 * 6144 + gi * 1024 + col; }
        const f32x4 x0 = *(const f32x4*)xi, x1 = *(const f32x4*)(xi + 4), g0 = *(const f32x4*)g, g1 = *(const f32x4*)(g + 4);
        *(f32x4*)xo = x0 + g0 * v0; *(f32x4*)(xo + 4) = x1 + g1 * v1;
    }
};
struct OpSwiglu {
    bf16_t* HID;
    __device__ __forceinline__ void operator()(int row, int col, f32x4 v0, f32x4 v1) const {
        const float h0 = v0.x * sigmoidf_(v0.x) * v0.y, h1 = v0.z * sigmoidf_(v0.z) * v0.w, h2 = v1.x * sigmoidf_(v1.x) * v1.y, h3 = v1.z * sigmoidf_(v1.z) * v1.w;
        u32x2 o; o.x = pkbf(h0, h1); o.y = pkbf(h2, h3);
        *(u32x2*)(HID + (size_t)row * DFF + (col >> 1)) = o;
    }
};
template <class Op> __device__ __forceinline__ void run_gemm(const TI ti, unsigned char* lds, const bf16_t* A, const bf16_t* Bt, int Mr, int N, int K, const Op& op) {
    int Kv = K; asm volatile("" : "+s"(Kv));
    pg8::Gemm g{A, Bt, Mr, N, Kv}; pg8::StaticOrder S; S.init(Mr, N, ti.nblk, ti.bid);
    EpiT<Op> E{op};
    pg8::gemm_phase<EpiT<Op>, pg8::StaticOrder, true, true>((PG8_LAS unsigned char*)lds, g, S, E, ti.tid);
}

__device__ __forceinline__ void ph_mods(const TI ti, CArgs& a, unsigned char* ldsg) {
    float* sc = (float*)ldsg; float* part = sc + 9 * 1024;
    const int tid = ti.tid, lane = tid & 63, w = tid >> 6;
    for (int i = tid; i < 9 * 1024; i += 512) { const float v = (i < 8192) ? a.in[1][i] : a.in[3][i - 8192]; sc[i] = v / (1.f + expf(-v)); }
    __syncthreads();
    float* MOD = (float*)(a.ws + WS_MOD);
    for (int item = ti.bid; item < DEPTH * 96; item += ti.nblk) {
        const int l = item / 96, n0 = (item % 96) * 64;
        const float* W = a.in[4] + (size_t)l * 1024 * 6144 + n0 + lane;
        float acc[9];
#pragma unroll
        for (int r = 0; r < 9; ++r) acc[r] = 0.f;
#pragma unroll 8
        for (int k = w * 128; k < w * 128 + 128; ++k) {
            const float wv = W[(size_t)k * 6144];
#pragma unroll
            for (int r = 0; r < 9; ++r) acc[r] += sc[r * 1024 + k] * wv;
        }
#pragma unroll
        for (int r = 0; r < 9; ++r) part[(w * 9 + r) * 64 + lane] = acc[r];
        __syncthreads();
        for (int idx = tid; idx < 576; idx += 512) {
            const int r = idx >> 6, ln = idx & 63; float s = a.in[5][l * 6144 + n0 + ln];
            for (int ww = 0; ww < 8; ++ww) s += part[(ww * 9 + r) * 64 + ln];
            MOD[((size_t)l * 9 + r) * 6144 + n0 + ln] = s;
        }
        __syncthreads();
    }
    float* RC = (float*)(a.ws + WS_ROPE); float* RS = RC + 2048 * 32;
    for (int idx = ti.bid * 512 + tid; idx < 2048 * 32; idx += ti.nblk * 512) {
        const int t = idx >> 5, i = idx & 31; const float pos = i < 16 ? (float)(t >> 6) : (float)(t & 63);
        const float ang = pos * exp2f(-(float)(i & 15) * (13.287712379549449f / 16.f));
        RC[idx] = cosf(ang); RS[idx] = sinf(ang);
    }
}

__device__ __forceinline__ void norm_rows(const float* xl, const float* xc, const float* g, const float* modl, int shi, int sci, bf16_t* H, int nrows, int gw, int ngw, int lane) {
#define NR_LOAD(V, SC, SH, row_) do { const int r__ = (row_); const float* src; int rr; if (r__ < ML) { src = xl + (size_t)r__ * D; rr = r__ >> 11; } else { src = xc + (size_t)(r__ - ML) * D; rr = 8; } \
        const float* md = modl + (size_t)rr * 6144; _Pragma("unroll") for (int j = 0; j < 4; ++j) { const int c = 4 * lane + 256 * j; V[j] = *(const f32x4*)(src + c); SC[j] = *(const f32x4*)(md + sci * 1024 + c); SH[j] = *(const f32x4*)(md + shi * 1024 + c); } } while (0)
    f32x4 gg[4], v[4], sc[4], sh[4], nv[4], nsc[4], nsh[4];
#pragma unroll
    for (int j = 0; j < 4; ++j) { gg[j] = *(const f32x4*)(g + 4 * lane + 256 * j); nv[j] = gg[j]; nsc[j] = gg[j]; nsh[j] = gg[j]; }
    int row = gw;
    if (row < nrows) NR_LOAD(v, sc, sh, row);
    for (; row < nrows; row += ngw) {
        const int nrow = row + ngw;
        if (nrow < nrows) NR_LOAD(nv, nsc, nsh, nrow);
        float ss = 0.f;
#pragma unroll
        for (int j = 0; j < 4; ++j) ss += (v[j].x * v[j].x + v[j].y * v[j].y) + (v[j].z * v[j].z + v[j].w * v[j].w);
        ss = wave_sum(ss);
        const float rstd = rsqrtf(ss * (1.f / 1024.f) + 1e-6f);
#pragma unroll
        for (int j = 0; j < 4; ++j) {
            const f32x4 o = v[j] * rstd * gg[j] * (1.f + sc[j]) + sh[j];
            u32x2 p; p.x = pkbf(o.x, o.y); p.y = pkbf(o.z, o.w);
            *(u32x2*)(H + (size_t)row * D + 4 * lane + 256 * j) = p;
            v[j] = nv[j]; sc[j] = nsc[j]; sh[j] = nsh[j];
        }
    }
#undef NR_LOAD
}

template <int MODE> __device__ __forceinline__ void transpose_item(const float* W, int K, int N, bf16_t* WT, LAS float* scr, int item, int lane) {
    const int nblk = N / 32, kb = item / nblk, nb = item % nblk, k0 = 64 * kb, n0 = 32 * nb;
#pragma unroll 8
    for (int i = 0; i < 32; ++i) { const int kk = 2 * i + (lane >> 5); scr[kk * 33 + (lane & 31)] = W[(size_t)(k0 + kk) * N + n0 + (lane & 31)]; }
    asm volatile("s_waitcnt lgkmcnt(0)" ::: "memory");
    const int c = lane & 7;
#pragma unroll
    for (int j = 0; j < 4; ++j) {
        const int n = (lane >> 3) + 8 * j, gn = n0 + n; const LAS float* s = scr + (8 * c) * 33 + n;
        const int drow = MODE == 0 ? gn : (MODE == 1 ? (gn >= 8608 ? gn + 96 : gn) : (gn < DFF ? 2 * gn : 2 * (gn - DFF) + 1));
        u32x4 o; o.x = pkbf(s[0 * 33], s[1 * 33]); o.y = pkbf(s[2 * 33], s[3 * 33]); o.z = pkbf(s[4 * 33], s[5 * 33]); o.w = pkbf(s[6 * 33], s[7 * 33]);
        *(u32x4*)(WT + (size_t)drow * K + k0 + 8 * c) = o;
    }
    asm volatile("s_waitcnt lgkmcnt(0)" ::: "memory");
}
__device__ __forceinline__ void ph_wconv(CArgs& a, int l, unsigned char* ldsg, int gw, int ngw, int lane, int wv, int mask) {
    LAS float* scr = (LAS float*)(ldsg + wv * 8704);
    unsigned char* ws = a.ws;
    constexpr int I_IN = 16 * 365, I_SQ = 16 * 32, I_WI = 16 * 176, I_WO = 44 * 32;
    if (mask & 1) for (int it = gw; it < I_IN; it += ngw) transpose_item<1>(a.in[8] + (size_t)l * 1024 * 11680, 1024, 11680, (bf16_t*)(ws + WS_WIN), scr, it, lane);
    if (mask & 2) for (int it = gw; it < 3 * I_SQ; it += ngw) { const int wh = it / I_SQ; transpose_item<0>(a.in[27 + wh] + (size_t)l * 1048576, 1024, 1024, (bf16_t*)(ws + WS_WA + (size_t)wh * 2 * MiB), scr, it % I_SQ, lane); }
    if (mask & 4) for (int it = gw; it < I_SQ; it += ngw) transpose_item<0>(a.in[30] + (size_t)l * 1048576, 1024, 1024, (bf16_t*)(ws + WS_WO), scr, it, lane);
    if (mask & 8) for (int it = gw; it < I_WI; it += ngw) transpose_item<2>(a.in[31] + (size_t)l * 1024 * 5632, 1024, 5632, (bf16_t*)(ws + WS_WI), scr, it, lane);
    if (mask & 16) for (int it = gw; it < I_WO; it += ngw) transpose_item<0>(a.in[32] + (size_t)l * DFF * 1024, DFF, 1024, (bf16_t*)(ws + WS_WO2), scr, it, lane);
    if (!(mask & 1)) return;
    const int gt = gw * 64 + lane, ngt = ngw * 64;
    bf16_t* LWT = (bf16_t*)(ws + WS_LWT); bf16_t* LAT = (bf16_t*)(ws + WS_LAT); bf16_t* LGT = (bf16_t*)(ws + WS_LGT);
    const float* w2 = a.in[18] + (size_t)l * 2 * 64 * 1024; const float* a2 = a.in[20] + (size_t)l * 2 * 64 * 1024; const float* g2 = a.in[21] + (size_t)l * 160 * 1024;
    for (int i = gt; i < 2048 * 128; i += ngt) {
        const int n = i >> 7, k = i & 127, d = n >> 10, c = n & 1023, kk = k - d * 64;
        const bool in = (kk >= 0 && kk < 64);
        LWT[i] = in ? f2bf(w2[((size_t)d * 64 + kk) * 1024 + c]) : (bf16_t)0;
        LAT[i] = in ? f2bf(a2[((size_t)d * 64 + kk) * 1024 + c]) : (bf16_t)0;
    }
    for (int i = gt; i < 1024 * 256; i += ngt) { const int n = i >> 8, k = i & 255; LGT[i] = k < 160 ? f2bf(g2[(size_t)k * 1024 + n]) : (bf16_t)0; }
    bf16_t* WIN = (bf16_t*)(ws + WS_WIN);
    for (int i = gt; i < 96 * 1024; i += ngt) WIN[(size_t)8608 * 1024 + i] = 0;
}

__device__ __forceinline__ void gmlp_unit(const TI ti, CArgs& a, int l, int u, unsigned char* ldsg) {
    float* rstd = (float*)ldsg; bf16_t* VNT = (bf16_t*)(ldsg + 512);
    const int tid = ti.tid, lane = tid & 63, w = tid >> 6, r = lane & 31, h = lane >> 5;
    bf16_t* GU = (bf16_t*)(a.ws + WS_GU); const bf16_t* GV = (const bf16_t*)(a.ws + WS_GV);
    const size_t R0 = (size_t)u * 128;
#pragma unroll 4
    for (int i = 0; i < 16; ++i) {
        const int tok = w * 16 + i; const bf16_t* p = GV + (R0 + tok) * 1024 + lane * 16;
        f32x4 x0, x1, x2, x3; unpack8(*(const u32x4*)p, x0, x1); unpack8(*(const u32x4*)(p + 8), x2, x3);
        float ss = (x0.x * x0.x + x0.y * x0.y + x0.z * x0.z + x0.w * x0.w) + (x1.x * x1.x + x1.y * x1.y + x1.z * x1.z + x1.w * x1.w)
                 + (x2.x * x2.x + x2.y * x2.y + x2.z * x2.z + x2.w * x2.w) + (x3.x * x3.x + x3.y * x3.y + x3.z * x3.z + x3.w * x3.w);
        ss = wave_sum(ss);
        if (lane == 0) rstd[tok] = rsqrtf(ss * (1.f / 1024.f) + 1e-6f);
    }
    __syncthreads();
    const float* gvg = a.in[9] + l * 1024; const float* wsp = a.in[10] + (size_t)l * 8 * 128 * 128; const float* bsp = a.in[11] + l * 8 * 128;
    const int tt = w & 3, chh = w >> 2;
    for (int g = 0; g < 8; ++g) {
        {
            const int s = tid & 127, cc = tid >> 7; const float rs = rstd[s]; const bf16_t* p = GV + (R0 + s) * 1024 + g * 128 + cc * 32;
#pragma unroll
            for (int q = 0; q < 4; ++q) {
                f32x4 x0, x1; unpack8(*(const u32x4*)(p + 8 * q), x0, x1);
                const float* gp = gvg + g * 128 + cc * 32 + 8 * q; const int c0 = cc * 32 + 8 * q;
                VNT[(c0 + 0) * 136 + s] = f2bf(x0.x * rs * gp[0]); VNT[(c0 + 1) * 136 + s] = f2bf(x0.y * rs * gp[1]);
                VNT[(c0 + 2) * 136 + s] = f2bf(x0.z * rs * gp[2]); VNT[(c0 + 3) * 136 + s] = f2bf(x0.w * rs * gp[3]);
                VNT[(c0 + 4) * 136 + s] = f2bf(x1.x * rs * gp[4]); VNT[(c0 + 5) * 136 + s] = f2bf(x1.y * rs * gp[5]);
                VNT[(c0 + 6) * 136 + s] = f2bf(x1.z * rs * gp[6]); VNT[(c0 + 7) * 136 + s] = f2bf(x1.w * rs * gp[7]);
            }
        }
        __syncthreads();
        f32x16 acc0, acc1;
#pragma unroll
        for (int i = 0; i < 16; ++i) { acc0[i] = 0.f; acc1[i] = 0.f; }
        const float* wrow = wsp + ((size_t)g * 128 + tt * 32 + r) * 128;
#pragma unroll
        for (int ks = 0; ks < 8; ++ks) {
            const f32x4 a0 = *(const f32x4*)(wrow + 16 * ks + 8 * h), a1 = *(const f32x4*)(wrow + 16 * ks + 8 * h + 4);
            const bf16x8 af = __builtin_bit_cast(bf16x8, pack8(a0, a1));
            const bf16x8 b0 = *(const bf16x8*)(VNT + (chh * 64 + r) * 136 + 16 * ks + 8 * h);
            const bf16x8 b1 = *(const bf16x8*)(VNT + (chh * 64 + 32 + r) * 136 + 16 * ks + 8 * h);
            acc0 = MFMA32(af, b0, acc0); acc1 = MFMA32(af, b1, acc1);
        }
        {
            const bf16_t* GUr = GU; float uu0[16], uu1[16], bb[16];
#pragma unroll
            for (int reg = 0; reg < 16; ++reg) {
                const int t = tt * 32 + (reg & 3) + 8 * (reg >> 2) + 4 * h; const size_t i0 = (R0 + t) * 1024 + g * 128 + chh * 64 + r;
                bb[reg] = bsp[g * 128 + t]; uu0[reg] = bf2f(GUr[i0]); uu1[reg] = bf2f(GUr[i0 + 32]);
            }
            asm volatile("" ::: "memory");
#pragma unroll
            for (int reg = 0; reg < 16; ++reg) {
                const int t = tt * 32 + (reg & 3) + 8 * (reg >> 2) + 4 * h; const size_t i0 = (R0 + t) * 1024 + g * 128 + chh * 64 + r;
                GU[i0] = f2bf(uu0[reg] * (acc0[reg] + bb[reg])); GU[i0 + 32] = f2bf(uu1[reg] * (acc1[reg] + bb[reg]));
            }
        }
        __syncthreads();
    }
}
__device__ __forceinline__ void qk_rows(CArgs& a, int l, int gw, int ngw, int lane) {
    bf16_t* Q = (bf16_t*)(a.ws + WS_Q); bf16_t* K = (bf16_t*)(a.ws + WS_K);
    const float* RC = (const float*)(a.ws + WS_ROPE); const float* RS = RC + 2048 * 32;
    const int part = lane & 3;
    float gq[16], gk[16];
    load16f(a.in[12] + l * 64 + 16 * part, gq); load16f(a.in[13] + l * 64 + 16 * part, gk);
    for (int row = gw; row < M; row += ngw) {
        float xq[16], xk[16], cs[16], sn[16];
        unpack16(Q + (size_t)row * 1024 + 16 * lane, xq); unpack16(K + (size_t)row * 1024 + 16 * lane, xk);
        const bool lat = row < ML;
        if (lat) { const int t = row & 2047; load16f(RC + t * 32 + 16 * (part & 1), cs); load16f(RS + t * 32 + 16 * (part & 1), sn); }
        float sq = 0.f, sk = 0.f;
#pragma unroll
        for (int j = 0; j < 16; ++j) { sq += xq[j] * xq[j]; sk += xk[j] * xk[j]; }
        const float rq = rsqrtf(quad_sum(sq) * (1.f / 64.f) + 1e-6f), rk = rsqrtf(quad_sum(sk) * (1.f / 64.f) + 1e-6f);
#pragma unroll
        for (int j = 0; j < 16; ++j) { xq[j] = xq[j] * rq * gq[j]; xk[j] = xk[j] * rk * gk[j]; }
        if (lat) {
            const float sgn = part < 2 ? -1.f : 1.f;
#pragma unroll
            for (int j = 0; j < 16; ++j) {
                const float pq = quad_xor2(xq[j]), pk = quad_xor2(xk[j]);
                xq[j] = xq[j] * cs[j] + sgn * pq * sn[j]; xk[j] = xk[j] * cs[j] + sgn * pk * sn[j];
            }
        }
#pragma unroll
        for (int j = 0; j < 16; ++j) xq[j] *= QSCALE;
        pack16(Q + (size_t)row * 1024 + 16 * lane, xq); pack16(K + (size_t)row * 1024 + 16 * lane, xk);
    }
}
__device__ __forceinline__ void lora_in_rows(CArgs& a, int l, int gw, int ngw, int lane) {
    const bf16_t* RW = (const bf16_t*)(a.ws + WS_RW); bf16_t* LW = (bf16_t*)(a.ws + WS_LIW); bf16_t* LA = (bf16_t*)(a.ws + WS_LIA); bf16_t* LG = (bf16_t*)(a.ws + WS_LIG);
    const float* mu = a.in[16] + l * 3488 + 3072;
    f32x4 m0 = {0.f, 0.f, 0.f, 0.f}, m1 = m0;
    if (lane < 52) { m0 = *(const f32x4*)(mu + 8 * lane); m1 = *(const f32x4*)(mu + 8 * lane + 4); }
    for (int row = gw; row < M; row += ngw) {
        int t, Tn; if (row < ML) { t = row & 2047; Tn = 2048; } else { t = (row - ML) & 255; Tn = 256; }
        const bool hp = t > 0, hn = t < Tn - 1;
        if (lane < 52) {
            const bf16_t* p = RW + (size_t)row * RWP + 3072 + 8 * lane;
            f32x4 x0, x1, p0 = {0.f, 0.f, 0.f, 0.f}, p1 = p0, n0 = p0, n1 = p0;
            unpack8(*(const u32x4*)p, x0, x1);
            if (hp) unpack8(*(const u32x4*)(p - RWP), p0, p1);
            if (hn) unpack8(*(const u32x4*)(p + RWP), n0, n1);
            f32x4 z0 = x0 + m0 * (0.5f * (p0 + n0) - x0), z1 = x1 + m1 * (0.5f * (p1 + n1) - x1);
            const int j = 8 * lane;
            if (j < 128) { z0 = (f32x4){tanhf(z0.x), tanhf(z0.y), tanhf(z0.z), tanhf(z0.w)}; z1 = (f32x4){tanhf(z1.x), tanhf(z1.y), tanhf(z1.z), tanhf(z1.w)}; *(u32x4*)(LW + (size_t)row * 128 + j) = pack8(z0, z1); }
            else if (j < 256) { *(u32x4*)(LA + (size_t)row * 128 + j - 128) = pack8(z0, z1); }
            else { *(u32x4*)(LG + (size_t)row * 256 + j - 256) = pack8(sig4(z0), sig4(z1)); }
        } else {
            unsigned z_ = 0u; asm volatile("" : "+v"(z_)); *(u32x4*)(LG + (size_t)row * 256 + 160 + (lane - 52) * 8) = (u32x4){z_, z_, z_, z_};
        }
    }
}

__device__ __forceinline__ void scan_unit(const TI ti, CArgs& a, int l, int u, bool ctx_out, unsigned char* ldsg) {
    const int tid = ti.tid, lane = tid & 63, w = tid >> 6;
    const int b = u >> 5, hh = (u >> 1) & 15, d = u & 1;
    const int si = tid >> 3, jq = tid & 7;
    LAS float* L = (LAS float*)ldsg;
    const bf16_t* RW = (const bf16_t*)(a.ws + WS_RW);
    const bf16_t* DEC = (const bf16_t*)(a.ws + (d ? WS_DEC1 : WS_GV));
    const bf16_t* AA = (const bf16_t*)(a.ws + (d ? WS_AA1 : WS_AA0));
    bf16_t* Y = (bf16_t*)(a.ws + (d ? WS_Y1 : WS_H));
    const int ch = hh * 64 + lane;
    const float* mu = a.in[16] + l * 3488;
    const float mur = mu[ch], muk = mu[1024 + ch], muv = mu[2048 + ch], kkg = a.in[22][l * 1024 + ch], kag = a.in[23][l * 1024 + ch];
    f32x4 S0 = {0.f, 0.f, 0.f, 0.f}, S1 = {0.f, 0.f, 0.f, 0.f};
    unsigned raw[4][9]; unsigned dcr[4], aar[4];
    constexpr int NC = 72;
#define SCAN_CHUNK(n, base, Tn, t0, wy) int base, Tn, t0; bool wy; { int ci; if ((n) < 8) { base = ML + b * 256; Tn = 256; ci = d ? 7 - (n) : (n); wy = ctx_out; } else { base = b * 2048; Tn = 2048; ci = d ? 71 - (n) : (n) - 8; wy = true; } t0 = ci * 32; }
#define SCAN_LOAD(n) do { SCAN_CHUNK(n, base_, Tn_, t0_, wy_); (void)wy_; _Pragma("unroll") for (int i4 = 0; i4 < 4; ++i4) { const int t = t0_ + w + 8 * i4; const size_t row = (size_t)(base_ + t); \
        const bf16_t* p = RW + row * RWP + ch; const bool hp = t > 0, hn = t < Tn_ - 1; \
        const int op_ = hp ? -RWP : 0, on_ = hn ? RWP : 0;     \
        _Pragma("unroll") for (int X = 0; X < 3; ++X) { raw[i4][3 * X + 0] = (unsigned)p[X * 1024 + op_]; raw[i4][3 * X + 1] = (unsigned)p[X * 1024]; raw[i4][3 * X + 2] = (unsigned)p[X * 1024 + on_]; } \
        dcr[i4] = (unsigned)DEC[row * 1024 + ch]; aar[i4] = (unsigned)AA[row * 1024 + ch]; } } while (0)
#define SCAN_STORE(n) do { LAS float* Bf = L + ((n) & 1) * 12288; SCAN_CHUNK(n, base_, Tn_, t0_, wy_); (void)wy_; (void)base_; _Pragma("unroll") for (int i4 = 0; i4 < 4; ++i4) { const int tk = w + 8 * i4; \
        const float mp_ = (t0_ + tk > 0) ? 0.5f : 0.f, mn_ = (t0_ + tk < Tn_ - 1) ? 0.5f : 0.f; \
        const float xr = bf2f(raw[i4][1]), xk = bf2f(raw[i4][4]), xv = bf2f(raw[i4][7]); \
        const float zr = xr + mur * ((mp_ * bf2f(raw[i4][0]) + mn_ * bf2f(raw[i4][2])) - xr); \
        const float zk = xk + muk * ((mp_ * bf2f(raw[i4][3]) + mn_ * bf2f(raw[i4][5])) - xk); \
        const float zv = xv + muv * ((mp_ * bf2f(raw[i4][6]) + mn_ * bf2f(raw[i4][8])) - xv); \
        const float kkv = zk * kkg; const float ssq = wave_sum(kkv * kkv); const float kkn = kkv / fmaxf(sqrtf(ssq), 1e-12f); \
        const float ad = bf2f(aar[i4]); const float wv_ = __expf(bf2f(dcr[i4])); const float kd = zk * (1.f + (ad - 1.f) * kag); \
        Bf[0 * 2048 + tk * 64 + lane] = wv_; Bf[1 * 2048 + tk * 64 + lane] = kd; Bf[2 * 2048 + tk * 64 + lane] = -kkn; \
        Bf[3 * 2048 + tk * 64 + lane] = kkn * ad; Bf[4 * 2048 + tk * 64 + lane] = zr; Bf[5 * 2048 + tk * 64 + lane] = zv; } } while (0)
    SCAN_LOAD(0); SCAN_STORE(0);
    __syncthreads();
    for (int n = 0; n < NC; ++n) {
        if (n + 1 < NC) SCAN_LOAD(n + 1);
        LAS const float* Bf = L + (n & 1) * 12288; LAS float* Yb = L + 24576 + (n & 1) * 2048;
#define STEP_LOAD(P, sidx) LAS const float* q##P = Bf + (sidx) * 64 + 8 * jq + hoff; \
            const f32x4 w0##P = *(LAS const f32x4*)(q##P), w1##P = *(LAS const f32x4*)(q##P + hdq), k0##P = *(LAS const f32x4*)(q##P + 2048), k1##P = *(LAS const f32x4*)(q##P + 2048 + hdq), \
                        a0##P = *(LAS const f32x4*)(q##P + 4096), a1##P = *(LAS const f32x4*)(q##P + 4096 + hdq), b0##P = *(LAS const f32x4*)(q##P + 6144), b1##P = *(LAS const f32x4*)(q##P + 6144 + hdq), \
                        r0##P = *(LAS const f32x4*)(q##P + 8192), r1##P = *(LAS const f32x4*)(q##P + 8192 + hdq); const float vi##P = Bf[5 * 2048 + (sidx) * 64 + si];
#define STEP_MATH(P, sidx) { const f32x4 ta = S0 * a0##P + S1 * a1##P; const float sa = dpp_sum8((ta.x + ta.y) + (ta.z + ta.w)); \
            S0 = S0 * w0##P + (sa * b0##P + vi##P * k0##P); S1 = S1 * w1##P + (sa * b1##P + vi##P * k1##P); \
            const f32x4 ty = S0 * r0##P + S1 * r1##P; const float y = dpp_sum8((ty.x + ty.y) + (ty.z + ty.w)); if (jq == 0) Yb[(sidx) * 64 + si] = y; }
        const int hoff = (si & 1) * 4, hdq = 4 - 2 * hoff;
        const int sdir = d ? -1 : 1; int sc = d ? 31 : 0;
        f32x4 cw0, cw1, ck0, ck1, ca0, ca1, cb0, cb1, cr0, cr1; float cvi;
        { STEP_LOAD(X, sc); cw0 = w0X; cw1 = w1X; ck0 = k0X; ck1 = k1X; ca0 = a0X; ca1 = a1X; cb0 = b0X; cb1 = b1X; cr0 = r0X; cr1 = r1X; cvi = viX; }
        for (int ss = 0; ss < 32; ss += 2) {
            const int s0i = sc, s1i = sc + sdir; int s2i = sc + 2 * sdir; s2i = (ss + 2 < 32) ? s2i : s1i;
            STEP_LOAD(B, s1i);
            { const f32x4 w0A = cw0, w1A = cw1, k0A = ck0, k1A = ck1, a0A = ca0, a1A = ca1, b0A = cb0, b1A = cb1, r0A = cr0, r1A = cr1; const float viA = cvi; STEP_MATH(A, s0i); }
            STEP_LOAD(C, s2i);
            STEP_MATH(B, s1i);
            cw0 = w0C; cw1 = w1C; ck0 = k0C; ck1 = k1C; ca0 = a0C; ca1 = a1C; cb0 = b0C; cb1 = b1C; cr0 = r0C; cr1 = r1C; cvi = viC;
            sc += 2 * sdir;
        }
#undef STEP_LOAD
#undef STEP_MATH
        if (n + 1 < NC) SCAN_STORE(n + 1);
        __syncthreads();
        {
            SCAN_CHUNK(n, base_, Tn_, t0_, wy_); (void)Tn_;
            if (wy_) {
#pragma unroll
                for (int i4 = 0; i4 < 4; ++i4) { const int tk = w + 8 * i4; Y[(size_t)(base_ + t0_ + tk) * 1024 + ch] = f2bf(Yb[tk * 64 + lane]); }
            }
        }
    }
    __syncthreads();
#undef SCAN_CHUNK
#undef SCAN_LOAD
#undef SCAN_STORE
}

__device__ __forceinline__ bf16x8 pk8f(float f0, float f1, float f2, float f3, float f4, float f5, float f6, float f7) {
    u32x4 p; p.x = pkbf(f0, f1); p.y = pkbf(f2, f3); p.z = pkbf(f4, f5); p.w = pkbf(f6, f7); return __builtin_bit_cast(bf16x8, p);
}
__device__ __forceinline__ void scan_unit_mfma(const TI ti, CArgs& a, int l, int u, bool ctx_out, unsigned char* ldsg) {
    const int tid = ti.tid, lane = tid & 63, w = __builtin_amdgcn_readfirstlane(tid >> 6);
    const int b = u >> 5, hh = (u >> 1) & 15, d = u & 1;
    LAS unsigned char* L = (LAS unsigned char*)ldsg;
    constexpr int NCH = 144, RING = 6, BUFB = 20736, O_AR = 0, O_BK = 4608, O_BKT = 9216, O_VTT = 14336, O_PC = 17408, O_NS = 17664, O_XF = 18688;
#define SC2_CHUNK(C, base, Tn, cc, wy) int base, Tn, cc; bool wy; if ((C) < 16) { base = ML + b * 256; Tn = 256; cc = (C); wy = ctx_out; } else { base = b * 2048; Tn = 2048; cc = (C) - 16; wy = true; }
#define SC2_TOK(Tn, cc, t) (d ? (Tn) - 1 - (16 * (cc) + (t)) : 16 * (cc) + (t))
    if (w < 2) {
        const int it = w, r = lane & 31, h = lane >> 5;
        bf16_t* Y = (bf16_t*)(a.ws + (d ? WS_Y1 : WS_H));
        f32x16 ST0, ST1;
#pragma unroll
        for (int i = 0; i < 16; ++i) { ST0[i] = 0.f; ST1[i] = 0.f; }
        for (int n = 0; n < NCH + RING; ++n) {
            if (n >= RING) {
                const int C = n - RING;
                LAS const unsigned char* buf = L + (C % RING) * BUFB;
                const bf16x8 xb0 = *(LAS const bf16x8*)(buf + O_XF + lane * 16), xb1 = *(LAS const bf16x8*)(buf + O_XF + 1024 + lane * 16);
                f32x16 Z;
#pragma unroll
                for (int i = 0; i < 16; ++i) Z[i] = 0.f;
#pragma unroll
                for (int jt = 0; jt < 2; ++jt) {
#pragma unroll
                    for (int s = 0; s < 2; ++s) {
                        LAS const unsigned char* ap = buf + O_AR + r * 144 + (32 * jt + 16 * s + 4 * h) * 2;
                        const s16x4 lo = *(LAS const s16x4*)ap, hi = *(LAS const s16x4*)(ap + 16);
                        const bf16x8 a2 = __builtin_shufflevector(lo, hi, 0, 1, 2, 3, 4, 5, 6, 7);
                        const bf16x8 stp = jt == 0 ? pk8f(ST0[8 * s], ST0[8 * s + 1], ST0[8 * s + 2], ST0[8 * s + 3], ST0[8 * s + 4], ST0[8 * s + 5], ST0[8 * s + 6], ST0[8 * s + 7])
                                                   : pk8f(ST1[8 * s], ST1[8 * s + 1], ST1[8 * s + 2], ST1[8 * s + 3], ST1[8 * s + 4], ST1[8 * s + 5], ST1[8 * s + 6], ST1[8 * s + 7]);
                        Z = MFMA32(a2, stp, Z);
                    }
                }
                LAS const unsigned char* vp = buf + O_VTT + (32 * it + r) * 48;
                {
                    const s16x4 lo = *(LAS const s16x4*)(vp + 8 * h), hi = *(LAS const s16x4*)(vp + 16 + 8 * h);
                    const bf16x8 vf = __builtin_shufflevector(lo, hi, 0, 1, 2, 3, 4, 5, 6, 7);
                    Z = MFMA32(xb1, vf, Z);
                }
                float o[8], g[16], uu[16];
#pragma unroll
                for (int q = 0; q < 8; ++q) o[q] = __shfl_xor(Z[q], 32);
#pragma unroll
                for (int e = 0; e < 4; ++e) {
                    g[e] = h ? o[e] : Z[e]; g[4 + e] = h ? Z[e] : o[e];
                    g[8 + e] = h ? o[4 + e] : Z[4 + e]; g[12 + e] = h ? Z[4 + e] : o[4 + e];
                }
                {
                    LAS const float* NS = (LAS const float*)(buf + O_NS);
#pragma unroll
                    for (int t = 0; t < 16; ++t) uu[t] = g[t];
#pragma unroll
                    for (int s = 0; s < 15; ++s) {
#pragma unroll
                        for (int t4 = (s + 1) / 4; t4 < 4; ++t4) {
                            const f32x4 nv = *(LAS const f32x4*)(NS + s * 16 + 4 * t4);
                            if (4 * t4 + 0 > s) uu[4 * t4 + 0] = __builtin_fmaf(nv.x, uu[s], uu[4 * t4 + 0]);
                            if (4 * t4 + 1 > s) uu[4 * t4 + 1] = __builtin_fmaf(nv.y, uu[s], uu[4 * t4 + 1]);
                            if (4 * t4 + 2 > s) uu[4 * t4 + 2] = __builtin_fmaf(nv.z, uu[s], uu[4 * t4 + 2]);
                            if (4 * t4 + 3 > s) uu[4 * t4 + 3] = __builtin_fmaf(nv.w, uu[s], uu[4 * t4 + 3]);
                        }
                    }
                }
                {
                    const bf16x8 uf = pk8f(h ? uu[4] : uu[0], h ? uu[5] : uu[1], h ? uu[6] : uu[2], h ? uu[7] : uu[3],
                                           h ? uu[12] : uu[8], h ? uu[13] : uu[9], h ? uu[14] : uu[10], h ? uu[15] : uu[11]);
                    Z = MFMA32(xb0, uf, Z);
                }
                {
                    SC2_CHUNK(C, base_, Tn_, cc_, wy_);
                    if (wy_) {
#pragma unroll
                        for (int q = 8; q < 16; ++q) {
                            const int t = (q & 3) + 8 * ((q >> 2) - 2) + 4 * h; const int tok = SC2_TOK(Tn_, cc_, t);
                            Y[(size_t)(base_ + tok) * 1024 + hh * 64 + 32 * it + r] = f2bf(Z[q]);
                        }
                    }
                }
                {
                    const bf16x8 un = pk8f(h ? uu[8] : uu[0], h ? uu[9] : uu[1], h ? uu[10] : uu[2], h ? uu[11] : uu[3],
                                           h ? uu[12] : uu[4], h ? uu[13] : uu[5], h ? uu[14] : uu[6], h ? uu[15] : uu[7]);
                    const bf16x8 vn = *(LAS const bf16x8*)(vp + 16 * h);
                    const bf16x8 a00 = *(LAS const bf16x8*)(buf + O_BKT + r * 80 + (8 * h) * 2), a01 = *(LAS const bf16x8*)(buf + O_BKT + r * 80 + (16 + 8 * h) * 2);
                    const bf16x8 a10 = *(LAS const bf16x8*)(buf + O_BKT + (32 + r) * 80 + (8 * h) * 2), a11 = *(LAS const bf16x8*)(buf + O_BKT + (32 + r) * 80 + (16 + 8 * h) * 2);
                    ST0 = MFMA32(a00, un, ST0); ST0 = MFMA32(a01, vn, ST0);
                    ST1 = MFMA32(a10, un, ST1); ST1 = MFMA32(a11, vn, ST1);
                    LAS const float* pc = (LAS const float*)(buf + O_PC);
#pragma unroll
                    for (int g4 = 0; g4 < 4; ++g4) {
                        const f32x4 p0 = *(LAS const f32x4*)(pc + 8 * g4 + 4 * h), p1 = *(LAS const f32x4*)(pc + 32 + 8 * g4 + 4 * h);
                        ST0[4 * g4] *= p0.x; ST0[4 * g4 + 1] *= p0.y; ST0[4 * g4 + 2] *= p0.z; ST0[4 * g4 + 3] *= p0.w;
                        ST1[4 * g4] *= p1.x; ST1[4 * g4 + 1] *= p1.y; ST1[4 * g4 + 2] *= p1.z; ST1[4 * g4 + 3] *= p1.w;
                    }
                }
            }
            __syncthreads();
        }
    } else {
        const int p = w - 2, ch = hh * 64 + lane;
        const bf16_t* RW = (const bf16_t*)(a.ws + WS_RW);
        const bf16_t* DEC = (const bf16_t*)(a.ws + (d ? WS_DEC1 : WS_GV));
        const bf16_t* AA = (const bf16_t*)(a.ws + (d ? WS_AA1 : WS_AA0));
        const float* mu = a.in[16] + l * 3488;
        const float mur = mu[ch], muk = mu[1024 + ch], muv = mu[2048 + ch], kkg = a.in[22][l * 1024 + ch], kag = a.in[23][l * 1024 + ch];
        LAS unsigned char* buf = L + p * BUFB;
        LAS bf16_t* AR = (LAS bf16_t*)(buf + O_AR); LAS bf16_t* BK = (LAS bf16_t*)(buf + O_BK); LAS bf16_t* BKT = (LAS bf16_t*)(buf + O_BKT); LAS bf16_t* VTT = (LAS bf16_t*)(buf + O_VTT);
        LAS float* PC = (LAS float*)(buf + O_PC);
        constexpr int NSTEP = (NCH / RING) * 4;
        unsigned nxt[4][11], cur[4][11];
#define SC2_LOAD(k) do { const int C_ = p + RING * ((k) >> 2); SC2_CHUNK(C_, base_, Tn_, cc_, wy_); (void)wy_; _Pragma("unroll") for (int i4 = 0; i4 < 4; ++i4) { \
            const int tok = SC2_TOK(Tn_, cc_, 4 * ((k) & 3) + i4); const size_t row = (size_t)(base_ + tok); \
            const gcptr_t rb = uniptr(RW + row * RWP + hh * 64 + 1024);     \
            const gcptr_t rp = rb + (tok > 0 ? -RWP : 0); const gcptr_t rn = rb + (tok < Tn_ - 1 ? RWP : 0); \
            nxt[i4][0] = (unsigned)rp[lane - 1024]; nxt[i4][3] = (unsigned)rp[lane]; nxt[i4][6] = (unsigned)rp[lane + 1024]; \
            nxt[i4][1] = (unsigned)rb[lane - 1024]; nxt[i4][4] = (unsigned)rb[lane]; nxt[i4][7] = (unsigned)rb[lane + 1024]; \
            nxt[i4][2] = (unsigned)rn[lane - 1024]; nxt[i4][5] = (unsigned)rn[lane]; nxt[i4][8] = (unsigned)rn[lane + 1024]; \
            nxt[i4][9] = (unsigned)uniptr(DEC + row * 1024 + hh * 64)[lane]; nxt[i4][10] = (unsigned)uniptr(AA + row * 1024 + hh * 64)[lane]; } } while (0)
        SC2_LOAD(0);
        float Lsum = 0.f, ePprev = 1.f;
        for (int n = 0; n < NCH + RING; ++n) {
            const int e = n - p - 1;
            if (e >= 0 && (e % RING) < 4 && e / RING < NCH / RING) {
                const int k = 4 * (e / RING) + (e % RING);
#pragma unroll
                for (int i4 = 0; i4 < 4; ++i4)
#pragma unroll
                    for (int x = 0; x < 11; ++x) cur[i4][x] = nxt[i4][x];
                if (k + 1 < NSTEP) SC2_LOAD(k + 1);
                const int C_ = p + RING * (k >> 2); SC2_CHUNK(C_, base_, Tn_, cc_, wy_); (void)wy_; (void)base_;
#pragma unroll
                for (int i4 = 0; i4 < 4; ++i4) {
                    const int t = 4 * (k & 3) + i4; const int tok = SC2_TOK(Tn_, cc_, t);
                    Lsum = (t == 0) ? 0.f : Lsum; ePprev = (t == 0) ? 1.f : ePprev;
                    const float mp_ = tok > 0 ? 0.5f : 0.f, mn_ = tok < Tn_ - 1 ? 0.5f : 0.f;
                    const float xr = bf2f(cur[i4][1]), xk = bf2f(cur[i4][4]), xv = bf2f(cur[i4][7]);
                    const float zr = xr + mur * ((mp_ * bf2f(cur[i4][0]) + mn_ * bf2f(cur[i4][2])) - xr);
                    const float zk = xk + muk * ((mp_ * bf2f(cur[i4][3]) + mn_ * bf2f(cur[i4][5])) - xk);
                    const float zv = xv + muv * ((mp_ * bf2f(cur[i4][6]) + mn_ * bf2f(cur[i4][8])) - xv);
                    const float kkv = zk * kkg; const float ssq = wave_sum(kkv * kkv); const float kkn = kkv * rsqrtf(fmaxf(ssq, 1e-24f));
                    const float ad = bf2f(cur[i4][10]); const float kd = zk * (1.f + (ad - 1.f) * kag);
                    Lsum += bf2f(cur[i4][9]);
                    const float eP = __expf(Lsum), eI = __expf(-Lsum);
                    AR[t * 72 + lane] = f2bf(-kkn * ePprev); AR[(16 + t) * 72 + lane] = f2bf(zr * eP);
                    const bf16_t bt = f2bf(kkn * ad * eI), kt = f2bf(kd * eI);
                    BK[t * 72 + lane] = bt; BK[(16 + t) * 72 + lane] = kt;
                    BKT[lane * 40 + t] = bt; BKT[lane * 40 + 16 + t] = kt;
                    VTT[lane * 24 + t] = f2bf(zv);
                    PC[lane] = eP;
                    ePprev = eP;
                }
            } else if (e >= 0 && (e % RING) == 4 && e / RING < NCH / RING) {
                const int r = lane & 31, h = lane >> 5, thr = (r & 15) + (r >> 4);
                f32x16 X;
#pragma unroll
                for (int i = 0; i < 16; ++i) X[i] = 0.f;
#pragma unroll
                for (int ks = 0; ks < 4; ++ks) {
                    const bf16x8 af = *(LAS const bf16x8*)(buf + O_BK + r * 144 + (16 * ks + 8 * h) * 2);
                    const bf16x8 bfr = *(LAS const bf16x8*)(buf + O_AR + r * 144 + (16 * ks + 8 * h) * 2);
                    X = MFMA32(af, bfr, X);
                }
#pragma unroll
                for (int rg = 0; rg < 16; ++rg) { const int s = (rg & 3) + 8 * ((rg >> 2) & 1) + 4 * h; X[rg] = (s < thr) ? X[rg] : 0.f; }
                if (r < 16) {
                    LAS float* NS = (LAS float*)(buf + O_NS);
#pragma unroll
                    for (int rg = 0; rg < 8; ++rg) NS[((rg & 3) + 8 * (rg >> 2) + 4 * h) * 16 + r] = X[rg];
                }
                *(LAS bf16x8*)(buf + O_XF + lane * 16) = pk8f(X[0], X[1], X[2], X[3], X[4], X[5], X[6], X[7]);
                *(LAS bf16x8*)(buf + O_XF + 1024 + lane * 16) = pk8f(X[8], X[9], X[10], X[11], X[12], X[13], X[14], X[15]);
            }
            __syncthreads();
        }
#undef SC2_LOAD
    }
    __syncthreads();
#undef SC2_CHUNK
#undef SC2_TOK
}

__device__ __forceinline__ void attn_unit(const TI ti, CArgs& a, int b, int hd, int qrow0, int st_lo, int st_hi, float mfix, float lam, float lam_init, const float* subg, unsigned char* ldsg) {
    const int tid = ti.tid, lane = tid & 63, w = tid >> 6, r = lane & 31, h = lane >> 5, qt = w >> 1, c = w & 1;
    bf16_t* Qb = (bf16_t*)(a.ws + WS_Q); const bf16_t* Kb = (const bf16_t*)(a.ws + WS_K); const bf16_t* Vb = (const bf16_t*)(a.ws + WS_V);
    LAS unsigned char* L = (LAS unsigned char*)ldsg;
    constexpr int KOFF = 0, VOFF = 17408, BUFB = 35840;
    bf16x8 qf[4];
    { const bf16_t* qp = Qb + (size_t)(qrow0 + qt * 32 + r) * 1024 + hd * 128 + c * 64 + 8 * h;
#pragma unroll
      for (int ks = 0; ks < 4; ++ks) qf[ks] = *(const bf16x8*)(qp + 16 * ks); }
    f32x16 O[4];
#pragma unroll
    for (int e = 0; e < 4; ++e)
#pragma unroll
        for (int i = 0; i < 16; ++i) O[e][i] = 0.f;
    float lsum = 0.f;
    u32x4 kreg[2], vreg[2];
    typedef const __attribute__((address_space(1))) u32x4* gc16_t;
    const int koff0 = (tid >> 4) * 1024 + (tid & 15) * 8, koff1 = koff0 + 32 * 1024, voff = lane * 1024 + w * 16;
#define ATT_LOAD(st) do { const int rb_ = (st) < 32 ? b * 2048 + (st) * 64 : ML + b * 256 + ((st) - 32) * 64; \
        const gcptr_t kb_ = uniptr(Kb + (size_t)rb_ * 1024 + hd * 128); const gcptr_t vb_ = uniptr(Vb + (size_t)rb_ * 1024 + hd * 128); \
        kreg[0] = *(gc16_t)(kb_ + koff0); kreg[1] = *(gc16_t)(kb_ + koff1); vreg[0] = *(gc16_t)(vb_ + voff); vreg[1] = *(gc16_t)(vb_ + voff + 8); } while (0)
#define ATT_STORE(bufi) do { LAS unsigned char* Bb = L + (bufi) * BUFB; _Pragma("unroll") for (int i = 0; i < 2; ++i) { const int p = tid + 512 * i, key = p >> 4, dc = p & 15; *(LAS u32x4*)(Bb + KOFF + key * 272 + dc * 16) = kreg[i]; } \
        LAS bf16_t* vt = (LAS bf16_t*)(Bb + VOFF) + (w * 16) * 72 + ((lane & 48) + 8 * ((lane >> 2) & 1) + 4 * ((lane >> 3) & 1) + (lane & 3));   \
        _Pragma("unroll") for (int e = 0; e < 4; ++e) { vt[(2 * e) * 72] = (bf16_t)(vreg[0][e] & 0xffffu); vt[(2 * e + 1) * 72] = (bf16_t)(vreg[0][e] >> 16); \
            vt[(8 + 2 * e) * 72] = (bf16_t)(vreg[1][e] & 0xffffu); vt[(8 + 2 * e + 1) * 72] = (bf16_t)(vreg[1][e] >> 16); } } while (0)
    ATT_LOAD(st_lo); ATT_STORE(0);
    __syncthreads();
    for (int st = st_lo; st < st_hi; ++st) {
        const int bi = (st - st_lo) & 1;
        if (st + 1 < st_hi) ATT_LOAD(st + 1);
        LAS const unsigned char* Bb = L + bi * BUFB;
        f32x16 Sx0, Sx1;
#pragma unroll
        for (int i = 0; i < 16; ++i) { Sx0[i] = -mfix; Sx1[i] = -mfix; }
        __builtin_amdgcn_s_setprio(1);
#pragma unroll
        for (int ks = 0; ks < 4; ++ks) {
            const bf16x8 kf = *(LAS const bf16x8*)(Bb + KOFF + r * 272 + (c * 64 + 16 * ks + 8 * h) * 2);
            Sx0 = MFMA32(kf, qf[ks], Sx0);
        }
#pragma unroll
        for (int ks = 0; ks < 4; ++ks) {
            const bf16x8 kf = *(LAS const bf16x8*)(Bb + KOFF + (32 + r) * 272 + (c * 64 + 16 * ks + 8 * h) * 2);
            Sx1 = MFMA32(kf, qf[ks], Sx1);
        }
        __builtin_amdgcn_s_setprio(0);
        __builtin_amdgcn_sched_barrier(0);
#pragma unroll
        for (int sub = 0; sub < 2; ++sub) {
            float p[16];
#pragma unroll
            for (int i = 0; i < 16; ++i) { p[i] = __builtin_amdgcn_exp2f(sub ? Sx1[i] : Sx0[i]); lsum += p[i]; }
            u32x4 pw0, pw1;
            pw0.x = pkbf(p[0], p[1]); pw0.y = pkbf(p[2], p[3]); pw0.z = pkbf(p[4], p[5]); pw0.w = pkbf(p[6], p[7]);
            pw1.x = pkbf(p[8], p[9]); pw1.y = pkbf(p[10], p[11]); pw1.z = pkbf(p[12], p[13]); pw1.w = pkbf(p[14], p[15]);
            const bf16x8 pb0 = __builtin_bit_cast(bf16x8, pw0), pb1 = __builtin_bit_cast(bf16x8, pw1);
            __builtin_amdgcn_s_setprio(1);
#pragma unroll
            for (int et = 0; et < 4; ++et) {
#pragma unroll
                for (int s = 0; s < 2; ++s) {
                    const bf16x8 vf = *(LAS const bf16x8*)(Bb + VOFF + (et * 32 + r) * 144 + (sub * 32 + 16 * s + 8 * h) * 2);
                    O[et] = MFMA32(vf, s ? pb1 : pb0, O[et]);
                }
            }
            __builtin_amdgcn_s_setprio(0);
        }
        if (st + 1 < st_hi) ATT_STORE(bi ^ 1);
        __syncthreads();
    }
#undef ATT_LOAD
#undef ATT_STORE
    const float ltot = lsum + __shfl_xor(lsum, 32);
    const float linv = 1.f / ltot;
    LAS float* X = (LAS float*)L + qt * 4096;
    if (c == 1) {
#pragma unroll
        for (int e = 0; e < 4; ++e)
#pragma unroll
            for (int i = 0; i < 16; ++i) X[(e * 16 + i) * 64 + lane] = O[e][i] * linv;
    }
    __syncthreads();
    if (c == 0) {
        float ssq = 0.f;
#pragma unroll
        for (int e = 0; e < 4; ++e)
#pragma unroll
            for (int i = 0; i < 16; ++i) { const float o = O[e][i] * linv - lam * X[(e * 16 + i) * 64 + lane]; O[e][i] = o; ssq += o * o; }
        ssq += __shfl_xor(ssq, 32);
        const float sc = rsqrtf(ssq * (1.f / 128.f) + 1e-6f) * (1.f - lam_init);
        bf16_t* op = Qb + (size_t)(qrow0 + qt * 32 + r) * 1024 + hd * 128;
#pragma unroll
        for (int e = 0; e < 4; ++e)
#pragma unroll
            for (int g4 = 0; g4 < 4; ++g4) {
                const int e0 = e * 32 + 8 * g4 + 4 * h; const f32x4 sg = *(const f32x4*)(subg + e0);
                u32x2 o; o.x = pkbf(O[e][4 * g4 + 0] * sc * sg.x, O[e][4 * g4 + 1] * sc * sg.y); o.y = pkbf(O[e][4 * g4 + 2] * sc * sg.z, O[e][4 * g4 + 3] * sc * sg.w);
                *(u32x2*)(op + e0) = o;
            }
    }
    __syncthreads();
}
__device__ __forceinline__ void ph_attn(const TI ti, CArgs& a, int l, bool ctx_out, unsigned char* ldsg) {
    const int lane = ti.tid & 63;
    const float gqm = fabsf(a.in[12][l * 64 + lane]), gkm = fabsf(a.in[13][l * 64 + lane]);
    float mq = gqm, mk = gkm;
#pragma unroll
    for (int o = 1; o < 64; o <<= 1) { mq = fmaxf(mq, __shfl_xor(mq, o)); mk = fmaxf(mk, __shfl_xor(mk, o)); }
    const float mfix = 8.f * mq * mk * 1.4426950408889634f * 1.03f;
    const float* lp = a.in[14] + l * 256;
    const float s1 = wave_sum(lp[lane] * lp[64 + lane]), s2 = wave_sum(lp[128 + lane] * lp[192 + lane]);
    const float lam_init = 0.8f - 0.6f * expf(-0.3f * (float)l);
    const float lam = expf(s1) - expf(s2) + lam_init;
    const float* subg = a.in[15] + l * 128;
    const int nun = 1024 + (ctx_out ? 128 : 0);
    for (int u = ti.bid; u < nun; u += ti.nblk) {
        if (u < 1024) { const int bh = u >> 4, qb = u & 15; attn_unit(ti, a, bh >> 3, bh & 7, (bh >> 3) * 2048 + qb * 128, 0, 36, mfix, lam, lam_init, subg, ldsg); }
        else { const int v = u - 1024, bh = v >> 1, qb = v & 1; attn_unit(ti, a, bh >> 3, bh & 7, ML + (bh >> 3) * 256 + qb * 128, 32, 36, mfix, lam, lam_init, subg, ldsg); }
    }
}

__device__ __forceinline__ void up8(const bf16_t* p, float (&x)[8]) { const u32x4 v = *(const u32x4*)p;
#pragma unroll
    for (int i = 0; i < 4; ++i) { x[2 * i] = bf2f(v[i] & 0xffffu); x[2 * i + 1] = bf2f(v[i] >> 16); } }
__device__ __forceinline__ void ld8f(const float* p, float (&x)[8]) { const f32x4 u = *(const f32x4*)p, v = *(const f32x4*)(p + 4); x[0] = u.x; x[1] = u.y; x[2] = u.z; x[3] = u.w; x[4] = v.x; x[5] = v.y; x[6] = v.z; x[7] = v.w; }
__device__ __forceinline__ void shift8(const bf16_t* p, const float* mu, bool hp, bool hn, float (&z)[8]) {
    float x[8], xp[8], xn[8], m[8];
#pragma unroll
    for (int j = 0; j < 8; ++j) { xp[j] = 0.f; xn[j] = 0.f; }
    up8(p, x); if (hp) up8(p - RWP, xp); if (hn) up8(p + RWP, xn); ld8f(mu, m);
#pragma unroll
    for (int j = 0; j < 8; ++j) z[j] = x[j] + m[j] * (0.5f * (xp[j] + xn[j]) - x[j]);
}
__device__ __forceinline__ void un8(const u32x4 v, float (&x)[8]) {
#pragma unroll
    for (int i = 0; i < 4; ++i) { x[2 * i] = bf2f(v[i] & 0xffffu); x[2 * i + 1] = bf2f(v[i] >> 16); } }
__device__ __forceinline__ void rwkv_out_rows(CArgs& a, int l, int nrows, int gw, int ngw, int lane) {
    const bf16_t* RW = (const bf16_t*)(a.ws + WS_RW); const bf16_t* Y0 = (const bf16_t*)(a.ws + WS_H); bf16_t* Y1 = (bf16_t*)(a.ws + WS_Y1);
    const bf16_t* A0 = (const bf16_t*)(a.ws + WS_AA0); const bf16_t* A1 = (const bf16_t*)(a.ws + WS_AA1); const bf16_t* G = (const bf16_t*)(a.ws + WS_G);
    const float* mu = a.in[16] + l * 3488;
#define RO_LOAD(R, it_) do { const int row_ = (it_) >> 1, c0_ = ((it_) & 1) * 512 + 8 * lane; int t_, Tn_; if (row_ < ML) { t_ = row_ & 2047; Tn_ = 2048; } else { t_ = (row_ - ML) & 255; Tn_ = 256; } \
        const size_t idx_ = (size_t)row_ * 1024 + c0_; const bf16_t* p_ = RW + (size_t)row_ * RWP + c0_; const int op_ = t_ > 0 ? -RWP : 0, on_ = t_ < Tn_ - 1 ? RWP : 0; \
        R[0] = *(const u32x4*)(Y0 + idx_); R[1] = *(const u32x4*)(Y1 + idx_); R[2] = *(const u32x4*)(G + idx_); R[3] = *(const u32x4*)(A0 + idx_); R[4] = *(const u32x4*)(A1 + idx_); \
        _Pragma("unroll") for (int X = 0; X < 3; ++X) { R[5 + 3 * X] = *(const u32x4*)(p_ + X * 1024 + op_); R[6 + 3 * X] = *(const u32x4*)(p_ + X * 1024); R[7 + 3 * X] = *(const u32x4*)(p_ + X * 1024 + on_); } } while (0)
    u32x4 R[14], N[14];
#pragma unroll
    for (int i = 0; i < 14; ++i) { R[i] = (u32x4){0u, 0u, 0u, 0u}; N[i] = R[i]; }
    int it = gw;
    if (it < 2 * nrows) RO_LOAD(R, it);
    for (; it < 2 * nrows; it += ngw) {
        const int nit = it + ngw;
        if (nit < 2 * nrows) RO_LOAD(N, nit);
        const int row = it >> 1, c0 = (it & 1) * 512 + 8 * lane;
        int t, Tn; if (row < ML) { t = row & 2047; Tn = 2048; } else { t = (row - ML) & 255; Tn = 256; }
        const float mp = t > 0 ? 0.5f : 0.f, mn = t < Tn - 1 ? 0.5f : 0.f;
        float y[8], y1[8], g[8], a0[8], a1[8], z[3][8], lnw[8], lnb[8], ka[8], rk[8];
        un8(R[0], y); un8(R[1], y1); un8(R[2], g); un8(R[3], a0); un8(R[4], a1);
#pragma unroll
        for (int X = 0; X < 3; ++X) {
            float xp[8], x[8], xn[8], m[8]; un8(R[5 + 3 * X], xp); un8(R[6 + 3 * X], x); un8(R[7 + 3 * X], xn); ld8f(mu + X * 1024 + c0, m);
#pragma unroll
            for (int j = 0; j < 8; ++j) z[X][j] = x[j] + m[j] * ((mp * xp[j] + mn * xn[j]) - x[j]);
        }
        ld8f(a.in[25] + l * 1024 + c0, lnw); ld8f(a.in[26] + l * 1024 + c0, lnb); ld8f(a.in[23] + l * 1024 + c0, ka); ld8f(a.in[24] + l * 1024 + c0, rk);
        float sm = 0.f;
#pragma unroll
        for (int j = 0; j < 8; ++j) { y[j] += y1[j]; sm += y[j]; }
        const float mean = dpp_sum8(sm) * (1.f / 64.f);
        float sv = 0.f, sb = 0.f;
#pragma unroll
        for (int j = 0; j < 8; ++j) { y[j] -= mean; sv += y[j] * y[j]; const float kds = z[1][j] * ((1.f + (a0[j] - 1.f) * ka[j]) + (1.f + (a1[j] - 1.f) * ka[j])); sb += z[0][j] * kds * rk[j]; }
        const float rstd = rsqrtf(dpp_sum8(sv) * (1.f / 64.f) + 64e-5f), bsum = dpp_sum8(sb);
        u32x4 o;
#pragma unroll
        for (int j = 0; j < 4; ++j) o[j] = pkbf(((y[2 * j] * rstd * lnw[2 * j] + lnb[2 * j]) + bsum * z[2][2 * j]) * g[2 * j], ((y[2 * j + 1] * rstd * lnw[2 * j + 1] + lnb[2 * j + 1]) + bsum * z[2][2 * j + 1]) * g[2 * j + 1]);
        *(u32x4*)(Y1 + (size_t)row * 1024 + c0) = o;
#pragma unroll
        for (int i = 0; i < 14; ++i) R[i] = N[i];
    }
#undef RO_LOAD
}

#define XB_TMO      128
#define XB_XCNT(j)  (256  + 64 * (j))
#define XB_XSUB(j)  (1280 + 64 * (j))
#define XB_XGEN(j)  (2304 + 64 * (j))
#define XB_TOP      3328
#define XB_TOPGEN   3392
#define XCD_BAR_WORDS 3456
#define XB_SPIN_CAP (1u << 20)

__device__ __forceinline__ unsigned xb_ld(unsigned* p)              { return __hip_atomic_load(p, __ATOMIC_RELAXED, __HIP_MEMORY_SCOPE_AGENT); }
__device__ __forceinline__ unsigned xb_add(unsigned* p, unsigned v) { return __hip_atomic_fetch_add(p, v, __ATOMIC_RELAXED, __HIP_MEMORY_SCOPE_AGENT); }
__device__ __forceinline__ unsigned xb_xcc_id() { return (unsigned)__builtin_amdgcn_s_getreg((3 << 11) | 20) & 0xFu; }
#define XB_SPIN(cond, bar) do { unsigned _sp = 0; while (cond) { __builtin_amdgcn_s_sleep(1); \
    if ((++_sp & 255u) == 0u) { if (xb_ld(&(bar)[XB_TMO])) break; if (_sp > XB_SPIN_CAP) { atomicAdd(&(bar)[XB_TMO], 1u); break; } } } } while (0)

struct XcdBarrier {
    unsigned* bar; unsigned x;
    volatile LAS unsigned* st;
};

__device__ __forceinline__ XcdBarrier xcd_barrier_post(unsigned* bar, volatile LAS unsigned* st) {
    XcdBarrier b; b.bar = bar; b.x = xb_xcc_id(); b.st = st;
    if (threadIdx.x == 0) (void)xb_add(&bar[XB_XCNT(b.x)], 1u);
    return b;
}
__device__ __forceinline__ void xcd_barrier_complete(unsigned* bar, unsigned x, unsigned& nloc, unsigned& nx) {
    const unsigned G = gridDim.x * gridDim.y * gridDim.z;
    unsigned sum, cnt, mine, sp = 0u;
    for (;;) {
        sum = 0u; cnt = 0u; mine = 0u;
#pragma unroll
        for (unsigned j = 0; j < 16; ++j) { const unsigned c = xb_ld(&bar[XB_XCNT(j)]); sum += c; cnt += (c > 0u) ? 1u : 0u; mine = (j == x) ? c : mine; }
        if (sum == G) break;
        __builtin_amdgcn_s_sleep(1);
        if ((++sp & 255u) == 0u) { if (xb_ld(&bar[XB_TMO])) break; if (sp > XB_SPIN_CAP) { atomicAdd(&bar[XB_TMO], 1u); break; } }
    }
    nloc = mine > 0u ? mine : 1u; nx = cnt > 0u ? cnt : 1u;
}

__device__ __forceinline__ void xcd_barrier(const XcdBarrier& b) {
    asm volatile("s_waitcnt vmcnt(0)" ::: "memory");
    __syncthreads();
    if (threadIdx.x == 0) {
        unsigned* bar = b.bar;
        __builtin_amdgcn_s_waitcnt(0);
        unsigned nloc = b.st[0], nx = b.st[1];
        if (nloc == 0u) { xcd_barrier_complete(bar, b.x, nloc, nx); b.st[0] = nloc; b.st[1] = nx; }
        const unsigned old = xb_add(&bar[XB_XSUB(b.x)], 1u);
        const unsigned gen = old / nloc;
        if (old + 1u == (gen + 1u) * nloc) {
            __builtin_amdgcn_fence(__ATOMIC_RELEASE, "agent");
            asm volatile("s_waitcnt vmcnt(0)" ::: "memory");
            const unsigned og = xb_add(&bar[XB_TOP], 1u);
            const unsigned tg = og / nx;
            if (og + 1u == (tg + 1u) * nx) xb_add(&bar[XB_TOPGEN], 1u);
            else XB_SPIN(xb_ld(&bar[XB_TOPGEN]) == tg, bar);
            __builtin_amdgcn_fence(__ATOMIC_ACQUIRE, "agent");
            xb_add(&bar[XB_XGEN(b.x)], 1u);
            asm volatile("s_waitcnt vmcnt(0)" ::: "memory");
        } else {
            XB_SPIN(xb_ld(&bar[XB_XGEN(b.x)]) == gen, bar);
            __builtin_amdgcn_fence(__ATOMIC_ACQUIRE, "agent");
            asm volatile("s_waitcnt vmcnt(0)" ::: "memory");
        }
    }
    __syncthreads();
}

#ifndef ONLY_PH
#define ONLY_PH -1
#endif
#ifndef SKIP_PH
#define SKIP_PH -2
#endif
#define PH_ON(k) ((ONLY_PH < 0 || ONLY_PH == (k)) && (k) != SKIP_PH)
__global__ void __launch_bounds__(512, 2) mega_fwd(Args a_) {
    extern __shared__ __attribute__((aligned(16))) unsigned char lds[];
    cg::grid_group grid = cg::this_grid();
    const int ph_lo = a_.lo, ph_hi = a_.hi;
    volatile LAS unsigned* bst = (volatile LAS unsigned*)((LAS unsigned char*)lds + 131072);
    if (threadIdx.x < 2) bst[threadIdx.x] = 0u;
    __syncthreads();
    const XcdBarrier xbar = xcd_barrier_post((unsigned*)(a_.ws + WS_BAR), bst);
    const int wave_s = __builtin_amdgcn_readfirstlane((int)threadIdx.x >> 6);
#pragma nounroll
    for (int ph = ph_lo; ph < ph_hi; ++ph) {
        CArgs* ap = (CArgs*)__builtin_amdgcn_kernarg_segment_ptr(); asm volatile("" : "+s"(ap));
        CArgs& a = *ap;
        unsigned char* ws = a.ws;
        float* XC = (float*)(ws + WS_XC);
        int wsv = wave_s; asm volatile("" : "+s"(wsv));
        TI ti; ti.tid = wsv * 64 + (int)__builtin_amdgcn_mbcnt_hi(~0u, __builtin_amdgcn_mbcnt_lo(~0u, 0u)); ti.bid = blockIdx.x; ti.nblk = gridDim.x;
        asm volatile("" : "+v"(ti.tid)); asm volatile("" : "+s"(ti.bid)); asm volatile("" : "+s"(ti.nblk));
        const int tid = ti.tid, lane = tid & 63, wv = __builtin_amdgcn_readfirstlane(tid >> 6);
        const int gw = ti.bid * 8 + wv, ngw = ti.nblk * 8;
        if (ph == 0) { if constexpr (PH_ON(100)) ph_mods(ti, a, lds); }
        else {
            const int l = (ph - 1) / NPH, k = (ph - 1) % NPH;
            const bool ctx_out = l < DEPTH - 1;
            const int Mr = ctx_out ? M : ML;
            const float* modl = (const float*)(ws + WS_MOD) + (size_t)l * 9 * 6144;
            const float* xl_in = l == 0 ? a.in[0] : a.out; const float* xc_in = l == 0 ? a.in[2] : XC;
            bf16_t* H = (bf16_t*)(ws + WS_H);
            switch (k) {
            case 0: if constexpr (PH_ON(0)) {
                norm_rows(xl_in, xc_in, a.in[6] + l * 1024, modl, 0, 1, H, M, gw, ngw, lane);
                ph_wconv(a, l, lds, gw, ngw, lane, wv, l == 0 ? 31 : 16);
                } break;
            case 1: if constexpr (PH_ON(1)) {
                OpIn op{(bf16_t*)(ws + WS_GU), (bf16_t*)(ws + WS_GV), (bf16_t*)(ws + WS_Q), (bf16_t*)(ws + WS_RW), (bf16_t*)(ws + WS_GT)};
                run_gemm(ti, lds, H, (const bf16_t*)(ws + WS_WIN), M, PPAD, 1024, op);
            } break;
            case 2: if constexpr (PH_ON(2)) {
                for (int u = ti.bid; u < Mr / 128; u += ti.nblk) gmlp_unit(ti, a, l, u, lds);
                qk_rows(a, l, gw, ngw, lane);
                lora_in_rows(a, l, gw, ngw, lane);
                } break;
            case 3: if constexpr (PH_ON(3)) {
                OpDec o1{(bf16_t*)(ws + WS_GV), (bf16_t*)(ws + WS_DEC1), a.in[17] + l * 2048};
                run_gemm(ti, lds, (const bf16_t*)(ws + WS_LIW), (const bf16_t*)(ws + WS_LWT), M, 2048, 128, o1);
                OpAA o2{(bf16_t*)(ws + WS_AA0), (bf16_t*)(ws + WS_AA1), a.in[19] + l * 2048};
                run_gemm(ti, lds, (const bf16_t*)(ws + WS_LIA), (const bf16_t*)(ws + WS_LAT), M, 2048, 128, o2);
                OpG o3{(bf16_t*)(ws + WS_G)};
                run_gemm(ti, lds, (const bf16_t*)(ws + WS_LIG), (const bf16_t*)(ws + WS_LGT), M, 1024, 256, o3);
            } break;
            case 4:
                if constexpr (PH_ON(4)) { for (int u = ti.bid; u < 256; u += ti.nblk) scan_unit_mfma(ti, a, l, u, ctx_out, lds); }
                if constexpr (PH_ON(40)) ph_attn(ti, a, l, ctx_out, lds);
                break;
            case 5: if constexpr (PH_ON(5)) {
                rwkv_out_rows(a, l, Mr, gw, ngw, lane);
                } break;
            case 6: if constexpr (PH_ON(6)) {
                const bf16_t* GT = (const bf16_t*)(ws + WS_GT); float* MF = (float*)(ws + WS_K);
                OpMerge<0> o0{GT, MF, H}; run_gemm(ti, lds, (const bf16_t*)(ws + WS_GU), (const bf16_t*)(ws + WS_WA), Mr, 1024, 1024, o0);
                OpMerge<1> o1{GT, MF, H}; run_gemm(ti, lds, (const bf16_t*)(ws + WS_Q), (const bf16_t*)(ws + WS_WB), Mr, 1024, 1024, o1);
                OpMerge<2> o2{GT, MF, H}; run_gemm(ti, lds, (const bf16_t*)(ws + WS_Y1), (const bf16_t*)(ws + WS_WC), Mr, 1024, 1024, o2);
                if (ctx_out && ti.nblk > 64 && ti.bid >= 32) ph_wconv(a, l + 1, lds, (ti.bid - 32) * 8 + wv, (ti.nblk - 32) * 8, lane, wv, 1);
                else if (ctx_out && ti.nblk <= 64) ph_wconv(a, l + 1, lds, gw, ngw, lane, wv, 1);
            } break;
            case 7: if constexpr (PH_ON(7)) {
                OpResid op{xl_in, xc_in, a.out, XC, modl, 2};
                run_gemm(ti, lds, H, (const bf16_t*)(ws + WS_WO), Mr, 1024, 1024, op);
                if (ctx_out && ti.nblk > 64 && ti.bid >= 32) ph_wconv(a, l + 1, lds, (ti.bid - 32) * 8 + wv, (ti.nblk - 32) * 8, lane, wv, 2);
                else if (ctx_out && ti.nblk <= 64) ph_wconv(a, l + 1, lds, gw, ngw, lane, wv, 2);
            } break;
            case 8: if constexpr (PH_ON(8)) {
                norm_rows(a.out, XC, a.in[7] + l * 1024, modl, 3, 4, H, Mr, gw, ngw, lane);
                } break;
            case 9: if constexpr (PH_ON(9)) {
                OpSwiglu op{(bf16_t*)(ws + WS_RW)};
                run_gemm(ti, lds, H, (const bf16_t*)(ws + WS_WI), Mr, 2 * DFF, 1024, op);
            } break;
            default: if constexpr (PH_ON(10)) {
                OpResid op{a.out, XC, a.out, XC, modl, 5};
                run_gemm(ti, lds, (const bf16_t*)(ws + WS_RW), (const bf16_t*)(ws + WS_WO2), Mr, 1024, DFF, op);
                if (ctx_out && ti.nblk > 64 && ti.bid >= 32) ph_wconv(a, l + 1, lds, (ti.bid - 32) * 8 + wv, (ti.nblk - 32) * 8, lane, wv, 12);
                else if (ctx_out && ti.nblk <= 64) ph_wconv(a, l + 1, lds, gw, ngw, lane, wv, 12);
            } break;
            }
        }
        if (ph + 1 < ph_hi) { if (ph == ph_lo) grid.sync(); else xcd_barrier(xbar); }
    }
}

extern "C" void kernel_launch(void* const* d_in, const int* in_sizes, int n_in, void* d_out, int out_size, void* d_ws, size_t ws_size, hipStream_t stream) {
    static int grid = 0;
    if (grid == 0) {
        if (n_in != 33 || out_size != ML * D || ws_size < WS_END) { fprintf(stderr, "kernel_launch: unexpected shapes / workspace (%d inputs, out %d, ws %zu, need %zu)\n", n_in, out_size, ws_size, (size_t)WS_END); grid = -1; return; }
        int dev = 0, cus = 0, per_cu = 0;
        hipGetDevice(&dev); hipDeviceGetAttribute(&cus, hipDeviceAttributeMultiprocessorCount, dev);
        if (hipFuncSetAttribute((const void*)mega_fwd, hipFuncAttributeMaxDynamicSharedMemorySize, LDS_BYTES) != hipSuccess) { fprintf(stderr, "kernel_launch: hipFuncSetAttribute failed\n"); grid = -1; return; }
        if (hipOccupancyMaxActiveBlocksPerMultiprocessor(&per_cu, (const void*)mega_fwd, 512, LDS_BYTES) != hipSuccess || per_cu < 1) per_cu = 1;
        (void)hipGetLastError();
        grid = cus * 1;
    }
    if (grid < 0) return;
    Args a{};
    for (int i = 0; i < 33; ++i) a.in[i] = (const float*)d_in[i];
    a.out = (float*)d_out; a.ws = (unsigned char*)d_ws; a.lo = 0; a.hi = NPHASES;
    void* args[] = {&a};
    if (hipMemsetAsync((char*)d_ws + WS_BAR, 0, BAR_BYTES, stream) != hipSuccess) { fprintf(stderr, "kernel_launch: memset of barrier words failed\n"); return; }
    hipError_t e = hipLaunchCooperativeKernel((const void*)mega_fwd, dim3(grid), dim3(512), args, LDS_BYTES, stream);
    if (e != hipSuccess) fprintf(stderr, "kernel_launch: cooperative launch failed: %s (grid %d)\n", hipGetErrorString(e), grid);
}
```

```cpp
#include <hip/hip_runtime.h>
#include <hip/hip_cooperative_groups.h>
#include <cstdio>
#include <cstdint>
namespace cg = cooperative_groups;
namespace pg8 {
#define PG8_LAS __attribute__((address_space(3)))
typedef unsigned short bf16_t;
typedef short bf16x8 __attribute__((ext_vector_type(8)));
typedef float f32x4 __attribute__((ext_vector_type(4)));
typedef unsigned u32x4 __attribute__((ext_vector_type(4)));
constexpr int BM = 256, BK = 64, HALF = 128, HTB = HALF * BK * 2  , STAGE_BYTES = 8 * HTB, NXCD = 8, WGM = 8;

__host__ __device__ __forceinline__ int lds_byte(int r, int c) { const int st = (r >> 4) * 2 + (c >> 5), rr = r & 15, cc = c & 31, ob = rr * 64 + cc * 2; return st * 1024 + (ob ^ (((ob >> 9) & 1) << 5)); }
__host__ __device__ __forceinline__ void stage_rc(int b, int& R, int& C) { const int st = b / 1024, sb = b % 1024, swz = sb ^ (((sb >> 9) & 1) << 5); R = (st >> 1) * 16 + swz / 64; C = (st & 1) * 32 + (swz % 64) / 2; }
__host__ __device__ __forceinline__ int perm32(int rho) { const int n = rho >> 4, i = rho & 15; return 8 * (i >> 2) + 4 * n + (i & 3); }

struct Unit { int pm, pn; };
struct Gemm { const bf16_t* A; const bf16_t* Bt; int M, N, K; };

struct StaticOrder {
    int nM, nN, nwg, G, c;
    __host__ __device__ void init(int M, int N, int G_, int c_) { nM = M / BM; nN = N / BM; nwg = nM * nN; G = G_; c = c_; }
    __host__ __device__ bool next(int i, Unit& u) const {
        const long L = (long)i * G + c; if (L >= nwg) return false;
        int wgid = (int)L; { const int q = nwg / NXCD, r = nwg % NXCD, xcd = wgid % NXCD, off = wgid / NXCD; wgid = (xcd < r ? xcd * (q + 1) : r * (q + 1) + (xcd - r) * q) + off; }
        const int nig = WGM * nN, gid = wgid / nig, fm = gid * WGM, gsz = (nM - fm) < WGM ? (nM - fm) : WGM;
        u.pm = fm + ((wgid % nig) % gsz); u.pn = (wgid % nig) / gsz; return true;
    }
    __device__ __forceinline__ void a_ready(const Unit&) const {}
    __device__ __forceinline__ void done(const Unit&) const {}
};

__device__ __forceinline__ unsigned cvt_pk_bf16(float lo, float hi) { unsigned r; asm volatile("v_cvt_pk_bf16_f32 %0, %1, %2" : "=v"(r) : "v"(lo), "v"(hi)); return r; }
typedef float f32x2 __attribute__((ext_vector_type(2)));
__device__ __forceinline__ f32x2 gelu_pk(f32x2 v) {
    const f32x2 av = __builtin_elementwise_abs(v), d = av * 0.2316418882f + 1.0f;
    f32x2 t; t.x = __builtin_amdgcn_rcpf(d.x); t.y = __builtin_amdgcn_rcpf(d.y);
    f32x2 q = t * 0.5307027145f + (-0.7265760135f); q = q * t + 0.7107068705f; q = q * t + (-0.142248368f); q = q * t + 0.127414796f; q = q * t;
    const f32x2 s = (v * v) * (-0.72134752044f);
    f32x2 e; e.x = __builtin_amdgcn_exp2f(s.x); e.y = __builtin_amdgcn_exp2f(s.y);
    const f32x2 m = v * (q * e), r = v - m;
    f32x2 o; o.x = v.x < 0.f ? m.x : r.x; o.y = v.y < 0.f ? m.y : r.y; return o;
}

template <class Epi, class Sched, bool ALIGN_EPI = false, bool SP2 = false>
__device__ __forceinline__ void gemm_phase(PG8_LAS unsigned char* lds, const Gemm g, const Sched& S, const Epi& E, const int tid_in) {
    const int tid = tid_in, wid = __builtin_amdgcn_readfirstlane(tid >> 6), lane = tid & 63, wr = wid >> 2, wc = wid & 3, fr = lane & 15, fq = lane >> 4;
    const int K = g.K, nt = K / BK;
    unsigned voffA[2], voffB[2];
#pragma unroll
    for (int i = 0; i < 2; ++i) { int R, C; stage_rc(tid * 16 + i * 8192, R, C); const int Rb = Epi::PERM ? ((R & ~31) + perm32(R & 31)) : R;
        voffA[i] = (unsigned)(R * K + C) * 2u; voffB[i] = (unsigned)(Rb * K + C) * 2u; }
    const size_t kstep = (size_t)(BK * 2);
    const size_t hstep = (size_t)HALF * K * 2;
    const size_t tstep = 2 * hstep;
    const unsigned ldsw = (unsigned)wid * 1024u;
    const int aoff = lds_byte(wr * 64 + fr, fq * 8), boff = lds_byte(wc * 32 + fr, fq * 8);
#define PG8_SA(b, h) (((b) * 2 + (h)) * HTB)
#define PG8_SB(b, h) ((4 + (b) * 2 + (h)) * HTB)
#define PG8_STAGE(bufoff, gbase, voff) do { _Pragma("unroll") for (int _i = 0; _i < 2; ++_i) \
        __builtin_amdgcn_global_load_lds((const unsigned*)((const char*)(gbase) + (voff)[_i]), (PG8_LAS unsigned*)(lds + (bufoff) + ldsw + _i * 8192), 16, 0, 0); } while (0)
#define PG8_LDA(dst, b, h) do { _Pragma("unroll") for (int m = 0; m < 4; ++m) _Pragma("unroll") for (int k = 0; k < 2; ++k) dst[m][k] = *(const PG8_LAS bf16x8*)(lds + PG8_SA(b, h) + aoff + m * 2048 + k * 1024); } while (0)
#define PG8_LDB(dst, b, h) do { _Pragma("unroll") for (int n = 0; n < 2; ++n) _Pragma("unroll") for (int k = 0; k < 2; ++k) dst[n][k] = *(const PG8_LAS bf16x8*)(lds + PG8_SB(b, h) + boff + n * 2048 + k * 1024); } while (0)
#define PG8_MMA(ai, bj, At, Bt) do { __builtin_amdgcn_s_setprio(1); _Pragma("unroll") for (int m = 0; m < 4; ++m) _Pragma("unroll") for (int n = 0; n < 2; ++n) _Pragma("unroll") for (int k = 0; k < 2; ++k) \
        acc[ai][bj][m][n] = __builtin_amdgcn_mfma_f32_16x16x32_bf16(Bt[n][k], At[m][k], acc[ai][bj][m][n], 0, 0, 0); __builtin_amdgcn_s_setprio(0); } while (0)
#define PG8_WAIT_V(n) asm volatile("s_waitcnt vmcnt(" #n ")" ::: "memory")
#define PG8_WAIT_L(n) asm volatile("s_waitcnt lgkmcnt(" #n ")" ::: "memory")
#define PG8_BAR __builtin_amdgcn_s_barrier()
#define PG8_SCHED __builtin_amdgcn_sched_barrier(0)
    Unit cur, nxt; int ui = 0;
    if (!S.next(0, cur)) return;
    f32x4 acc[2][2][4][2];
#pragma unroll
    for (int a = 0; a < 2; ++a)
#pragma unroll
        for (int b = 0; b < 2; ++b)
#pragma unroll
            for (int m = 0; m < 4; ++m)
#pragma unroll
                for (int n = 0; n < 2; ++n) acc[a][b][m][n] = (f32x4){0.f, 0.f, 0.f, 0.f};
    bf16x8 At[4][2], B0[2][2], B1[2][2];
    const char* cA = (const char*)g.A + (size_t)cur.pm * tstep; const char* cB = (const char*)g.Bt + (size_t)cur.pn * tstep;
    S.a_ready(cur);
    if constexpr (SP2) {
        PG8_STAGE(PG8_SB(0, 0), cB, voffB); PG8_STAGE(PG8_SB(0, 1), cB + hstep, voffB); PG8_STAGE(PG8_SA(0, 0), cA, voffA); PG8_STAGE(PG8_SA(0, 1), cA + hstep, voffA);
        if (wr == 1) PG8_BAR;
        PG8_WAIT_V(2); PG8_BAR;
        PG8_STAGE(PG8_SB(1, 0), cB + kstep, voffB); PG8_STAGE(PG8_SA(1, 0), cA + kstep, voffA); PG8_STAGE(PG8_SB(1, 1), cB + hstep + kstep, voffB);
        PG8_WAIT_V(6); PG8_BAR;
    } else {
        PG8_STAGE(PG8_SB(0, 0), cB, voffB); PG8_STAGE(PG8_SA(0, 0), cA, voffA); PG8_STAGE(PG8_SB(0, 1), cB + hstep, voffB); PG8_STAGE(PG8_SA(0, 1), cA + hstep, voffA);
        if (wr == 1) PG8_BAR;
        PG8_WAIT_V(4); PG8_BAR;
        PG8_STAGE(PG8_SB(1, 0), cB + kstep, voffB); PG8_STAGE(PG8_SA(1, 0), cA + kstep, voffA); PG8_STAGE(PG8_SB(1, 1), cB + hstep + kstep, voffB);
        PG8_WAIT_V(6); PG8_BAR;
    }
    for (;;) {
        const bool has_next = S.next(ui + 1, nxt);
        const char* nA = has_next ? (const char*)g.A + (size_t)nxt.pm * tstep : cA; const char* nB = has_next ? (const char*)g.Bt + (size_t)nxt.pn * tstep : cB;
        for (int t = 0; t < nt; t += 2) {
            const bool last = (t == nt - 2);
            const char* a1 = cA + (size_t)(t + 1) * kstep;
            const char* a2 = last ? nA : cA + (size_t)(t + 2) * kstep; const char* b2 = last ? nB : cB + (size_t)(t + 2) * kstep;
            const char* a3 = a2 + kstep; const char* b3 = b2 + kstep;
            if (last && has_next) S.a_ready(nxt);
            if constexpr (SP2) {
            PG8_LDB(B0, 0, 0); PG8_LDB(B1, 0, 1); PG8_SCHED; PG8_LDA(At, 0, 0); PG8_STAGE(PG8_SA(1, 1), a1 + hstep, voffA);
            PG8_WAIT_V(8); PG8_WAIT_L(0); PG8_BAR; PG8_MMA(0, 0, At, B0); PG8_MMA(0, 1, At, B1); PG8_BAR; PG8_SCHED;
            PG8_LDA(At, 0, 1); PG8_STAGE(PG8_SB(0, 0), b2, voffB); PG8_STAGE(PG8_SB(0, 1), b2 + hstep, voffB); PG8_STAGE(PG8_SA(0, 0), a2, voffA);
            PG8_WAIT_V(8); PG8_WAIT_L(0); PG8_BAR; PG8_MMA(1, 0, At, B0); PG8_MMA(1, 1, At, B1); PG8_BAR; PG8_SCHED;
            PG8_LDB(B0, 1, 0); PG8_LDB(B1, 1, 1); PG8_SCHED; PG8_LDA(At, 1, 0); PG8_STAGE(PG8_SA(0, 1), a2 + hstep, voffA);
            PG8_WAIT_V(8); PG8_WAIT_L(0); PG8_BAR; PG8_MMA(0, 0, At, B0); PG8_MMA(0, 1, At, B1); PG8_BAR; PG8_SCHED;
            PG8_LDA(At, 1, 1); PG8_STAGE(PG8_SB(1, 0), b3, voffB); PG8_STAGE(PG8_SB(1, 1), b3 + hstep, voffB); PG8_STAGE(PG8_SA(1, 0), a3, voffA);
            PG8_WAIT_V(8); PG8_WAIT_L(0); PG8_BAR; PG8_MMA(1, 0, At, B0); PG8_MMA(1, 1, At, B1); PG8_BAR; PG8_SCHED;
            } else {
            PG8_LDB(B0, 0, 0); PG8_SCHED; PG8_LDA(At, 0, 0); PG8_STAGE(PG8_SA(1, 1), a1 + hstep, voffA);
            PG8_WAIT_L(8); PG8_BAR; PG8_WAIT_L(0); PG8_MMA(0, 0, At, B0); PG8_BAR; PG8_SCHED;
            PG8_LDB(B1, 0, 1); PG8_STAGE(PG8_SB(0, 0), b2, voffB);
            PG8_BAR; PG8_WAIT_L(0); PG8_MMA(0, 1, At, B1); PG8_BAR;
            PG8_LDA(At, 0, 1); PG8_STAGE(PG8_SA(0, 0), a2, voffA);
            PG8_BAR; PG8_WAIT_L(0); PG8_MMA(1, 0, At, B0); PG8_BAR; PG8_SCHED;
            PG8_STAGE(PG8_SB(0, 1), b2 + hstep, voffB);
            PG8_WAIT_V(6); PG8_BAR; PG8_MMA(1, 1, At, B1); PG8_BAR;
            PG8_LDB(B0, 1, 0); PG8_SCHED; PG8_LDA(At, 1, 0); PG8_STAGE(PG8_SA(0, 1), a2 + hstep, voffA);
            PG8_WAIT_L(8); PG8_BAR; PG8_WAIT_L(0); PG8_MMA(0, 0, At, B0); PG8_BAR; PG8_SCHED;
            PG8_LDB(B1, 1, 1); PG8_STAGE(PG8_SB(1, 0), b3, voffB);
            PG8_BAR; PG8_WAIT_L(0); PG8_MMA(0, 1, At, B1); PG8_BAR;
            PG8_LDA(At, 1, 1); PG8_STAGE(PG8_SA(1, 0), a3, voffA);
            PG8_BAR; PG8_WAIT_L(0); PG8_MMA(1, 0, At, B0); PG8_BAR; PG8_SCHED;
            PG8_STAGE(PG8_SB(1, 1), b3 + hstep, voffB);
            PG8_WAIT_V(6); PG8_BAR; PG8_MMA(1, 1, At, B1); PG8_BAR;
            }
        }
        if constexpr (ALIGN_EPI) { if (wr == 0) PG8_BAR; }
        if constexpr (!Epi::AFTER_DRAIN) { E(acc, cur, wr, wc, fr, fq); S.done(cur); }
        if (!has_next) break;
#pragma unroll
        for (int a = 0; a < 2; ++a)
#pragma unroll
            for (int b = 0; b < 2; ++b)
#pragma unroll
                for (int m = 0; m < 4; ++m)
#pragma unroll
                    for (int n = 0; n < 2; ++n) acc[a][b][m][n] = (f32x4){0.f, 0.f, 0.f, 0.f};
        cur = nxt; cA = nA; cB = nB; ++ui;
        if constexpr (ALIGN_EPI) { if (wr == 1) PG8_BAR; }
    }
    PG8_WAIT_V(0);
    if constexpr (!ALIGN_EPI) { if (wr == 0) PG8_BAR; }
    PG8_BAR;
    if constexpr (Epi::AFTER_DRAIN) { E.fused(acc, cur, wr, wc, fr, fq, lds, wid, lane); S.done(cur); }
#undef PG8_SA
#undef PG8_SB
#undef PG8_STAGE
#undef PG8_LDA
#undef PG8_LDB
#undef PG8_MMA
#undef PG8_WAIT_V
#undef PG8_WAIT_L
#undef PG8_BAR
#undef PG8_SCHED
}
}

#define LAS __attribute__((address_space(3)))
typedef unsigned short bf16_t;
typedef float f32x2 __attribute__((ext_vector_type(2)));
typedef float f32x4 __attribute__((ext_vector_type(4)));
typedef float f32x16 __attribute__((ext_vector_type(16)));
typedef short bf16x8 __attribute__((ext_vector_type(8)));
typedef short s16x4 __attribute__((ext_vector_type(4)));
typedef unsigned u32x4 __attribute__((ext_vector_type(4)));
typedef unsigned u32x2 __attribute__((ext_vector_type(2)));
typedef __bf16 bf16x2v __attribute__((ext_vector_type(2)));
#define MFMA32(a, b, c) __builtin_amdgcn_mfma_f32_32x32x16_bf16((a), (b), (c), 0, 0, 0)

constexpr int D = 1024, NB = 8, TL = 2048, TCX = 256, DEPTH = 4;
constexpr int ML = NB * TL, MC = NB * TCX, M = ML + MC;
constexpr int PPAD = 11776, RWP = 3584, DFF = 2816;
constexpr int NPH = 11, NPHASES = 1 + DEPTH * NPH;
constexpr size_t MiB = 1u << 20;
constexpr size_t WS_MOD = 0, WS_WIN = 1 * MiB, WS_WA = 24 * MiB, WS_WB = 26 * MiB, WS_WC = 28 * MiB, WS_WO = 30 * MiB, WS_WI = 32 * MiB, WS_WO2 = 43 * MiB,
                 WS_LWT = 48 * MiB + MiB / 2, WS_LAT = 49 * MiB, WS_LGT = 49 * MiB + MiB / 2, WS_H = 50 * MiB, WS_XC = 86 * MiB, WS_GU = 94 * MiB, WS_GV = 130 * MiB,
                 WS_Q = 166 * MiB, WS_K = 202 * MiB, WS_V = 238 * MiB, WS_RW = 274 * MiB, WS_GT = 400 * MiB, WS_LIW = 508 * MiB, WS_LIA = 512 * MiB + MiB / 2,
                 WS_LIG = 517 * MiB, WS_DEC1 = 526 * MiB, WS_AA0 = 562 * MiB, WS_AA1 = 598 * MiB, WS_G = 634 * MiB, WS_Y1 = 670 * MiB, WS_ROPE = 706 * MiB, WS_END = 707 * MiB;
constexpr int LDS_BYTES = 131072 + 1024;
constexpr size_t WS_BAR = 917504, BAR_BYTES = 16384;
constexpr float QSCALE = 0.125f * 1.4426950408889634f;

struct Args { const float* in[33]; float* out; unsigned char* ws; int lo, hi; };
typedef const __attribute__((address_space(4))) Args CArgs;
struct TI { int tid, bid, nblk; };

__device__ __forceinline__ float bf2f(unsigned v) { return __uint_as_float(v << 16); }
__device__ __forceinline__ unsigned pkbf(float lo, float hi) { f32x2 v = {lo, hi}; bf16x2v b = __builtin_convertvector(v, bf16x2v); return __builtin_bit_cast(unsigned, b); }
__device__ __forceinline__ bf16_t f2bf(float f) { return (bf16_t)(pkbf(f, 0.f) & 0xffffu); }
#define DPP_ADD(x, ctrl) ((x) + __builtin_bit_cast(float, __builtin_amdgcn_update_dpp(0, __builtin_bit_cast(int, (x)), (ctrl), 0xf, 0xf, true)))
__device__ __forceinline__ float wave_sum(float v) {
    v = DPP_ADD(v, 0xB1); v = DPP_ADD(v, 0x4E); v = DPP_ADD(v, 0x141); v = DPP_ADD(v, 0x140);
    const int iv = __builtin_bit_cast(int, v);
    const float s0 = __builtin_bit_cast(float, __builtin_amdgcn_readlane(iv, 0)), s1 = __builtin_bit_cast(float, __builtin_amdgcn_readlane(iv, 16)),
                s2 = __builtin_bit_cast(float, __builtin_amdgcn_readlane(iv, 32)), s3 = __builtin_bit_cast(float, __builtin_amdgcn_readlane(iv, 48));
    return (s0 + s1) + (s2 + s3);
}
__device__ __forceinline__ float dpp_sum8(float x) {
    x += __builtin_bit_cast(float, __builtin_amdgcn_update_dpp(0, __builtin_bit_cast(int, x), 0xB1, 0xf, 0xf, true));
    x += __builtin_bit_cast(float, __builtin_amdgcn_update_dpp(0, __builtin_bit_cast(int, x), 0x4E, 0xf, 0xf, true));
    x += __builtin_bit_cast(float, __builtin_amdgcn_update_dpp(0, __builtin_bit_cast(int, x), 0x141, 0xf, 0xf, true));
    return x;
}
__device__ __forceinline__ float quad_sum(float x) { x = DPP_ADD(x, 0xB1); x = DPP_ADD(x, 0x4E); return x; }
__device__ __forceinline__ float quad_xor2(float x) { return __builtin_bit_cast(float, __builtin_amdgcn_update_dpp(0, __builtin_bit_cast(int, x), 0x4E, 0xf, 0xf, true)); }
__device__ __forceinline__ void unpack16(const bf16_t* p, float (&x)[16]) {
    const u32x4 a = *(const u32x4*)p, b = *(const u32x4*)(p + 8);
#pragma unroll
    for (int i = 0; i < 4; ++i) { x[2 * i] = bf2f(a[i] & 0xffffu); x[2 * i + 1] = bf2f(a[i] >> 16); x[8 + 2 * i] = bf2f(b[i] & 0xffffu); x[8 + 2 * i + 1] = bf2f(b[i] >> 16); }
}
__device__ __forceinline__ void pack16(bf16_t* p, const float (&x)[16]) {
    u32x4 a, b;
#pragma unroll
    for (int i = 0; i < 4; ++i) { a[i] = pkbf(x[2 * i], x[2 * i + 1]); b[i] = pkbf(x[8 + 2 * i], x[8 + 2 * i + 1]); }
    *(u32x4*)p = a; *(u32x4*)(p + 8) = b;
}
__device__ __forceinline__ void load16f(const float* p, float (&x)[16]) {
#pragma unroll
    for (int i = 0; i < 4; ++i) { const f32x4 v = *(const f32x4*)(p + 4 * i); x[4 * i] = v.x; x[4 * i + 1] = v.y; x[4 * i + 2] = v.z; x[4 * i + 3] = v.w; }
}
__device__ __forceinline__ float sigmoidf_(float x) { return 1.f / (1.f + __expf(-x)); }

typedef const __attribute__((address_space(1))) bf16_t* gcptr_t;
__device__ __forceinline__ gcptr_t uniptr(const bf16_t* p) {
    const unsigned long long v = (unsigned long long)p;
    const unsigned lo = __builtin_amdgcn_readfirstlane((unsigned)v), hi = __builtin_amdgcn_readfirstlane((unsigned)(v >> 32));
    return (gcptr_t)(((unsigned long long)hi << 32) | lo);
}
template <class Op> struct EpiT {
    static constexpr bool PERM = true, AFTER_DRAIN = false;
    Op op;
    __device__ __forceinline__ void operator()(const pg8::f32x4 (&acc)[2][2][4][2], const pg8::Unit& u, int wr, int wc, int fr, int fq) const {
        const int row0 = u.pm * 256 + wr * 64 + fr, col0 = u.pn * 256 + wc * 32 + 8 * fq;
#pragma unroll
        for (int ai = 0; ai < 2; ++ai)
#pragma unroll
            for (int m = 0; m < 4; ++m)
#pragma unroll
                for (int bj = 0; bj < 2; ++bj) { op(row0 + ai * 128 + m * 16, col0 + bj * 128, acc[ai][bj][m][0], acc[ai][bj][m][1]); asm volatile("" ::: "memory"); }
    }
};
__device__ __forceinline__ u32x4 pack8(f32x4 v0, f32x4 v1) { u32x4 o; o.x = pkbf(v0.x, v0.y); o.y = pkbf(v0.z, v0.w); o.z = pkbf(v1.x, v1.y); o.w = pkbf(v1.z, v1.w); return o; }
__device__ __forceinline__ void unpack8(u32x4 x, f32x4& v0, f32x4& v1) {
    v0.x = bf2f(x.x & 0xffffu); v0.y = bf2f(x.x >> 16); v0.z = bf2f(x.y & 0xffffu); v0.w = bf2f(x.y >> 16);
    v1.x = bf2f(x.z & 0xffffu); v1.y = bf2f(x.z >> 16); v1.z = bf2f(x.w & 0xffffu); v1.w = bf2f(x.w >> 16);
}
__device__ __forceinline__ f32x4 gelu4(f32x4 v) { pg8::f32x2 a = pg8::gelu_pk((pg8::f32x2){v.x, v.y}), b = pg8::gelu_pk((pg8::f32x2){v.z, v.w}); return (f32x4){a.x, a.y, b.x, b.y}; }
__device__ __forceinline__ f32x4 sig4(f32x4 v) { return (f32x4){sigmoidf_(v.x), sigmoidf_(v.y), sigmoidf_(v.z), sigmoidf_(v.w)}; }

struct OpIn {
    bf16_t *GU, *GV, *Q, *RW, *GT;
    __device__ __forceinline__ void operator()(int row, int col, f32x4 v0, f32x4 v1) const {
        bf16_t* dst;
        if (col < 2048) { v0 = gelu4(v0); v1 = gelu4(v1); dst = (col < 1024 ? GU : GV) + (size_t)row * 1024 + (col & 1023); }
        else if (col < 5120) { const int q = col - 2048; dst = Q + (size_t)(q >> 10) * (size_t)(18 * MiB) + (size_t)row * 1024 + (q & 1023); }
        else if (col < 8704) { dst = RW + (size_t)row * RWP + (col - 5120); }
        else { v0 = sig4(v0); v1 = sig4(v1); dst = GT + (size_t)row * 3072 + (col - 8704); }
        *(u32x4*)dst = pack8(v0, v1);
    }
};
struct OpDec {
    bf16_t *D0, *D1; const float* w0;
    __device__ __forceinline__ float f(float x) const { return -0.6065306597126334f * sigmoidf_(x); }
    __device__ __forceinline__ void operator()(int row, int col, f32x4 v0, f32x4 v1) const {
        const f32x4 b0 = *(const f32x4*)(w0 + col), b1 = *(const f32x4*)(w0 + col + 4);
        v0 += b0; v1 += b1;
        v0 = (f32x4){f(v0.x), f(v0.y), f(v0.z), f(v0.w)}; v1 = (f32x4){f(v1.x), f(v1.y), f(v1.z), f(v1.w)};
        bf16_t* dst = (col < 1024 ? D0 : D1) + (size_t)row * 1024 + (col & 1023);
        *(u32x4*)dst = pack8(v0, v1);
    }
};
struct OpAA {
    bf16_t *A0, *A1; const float* a0;
    __device__ __forceinline__ void operator()(int row, int col, f32x4 v0, f32x4 v1) const {
        const f32x4 b0 = *(const f32x4*)(a0 + col), b1 = *(const f32x4*)(a0 + col + 4);
        v0 = sig4(v0 + b0); v1 = sig4(v1 + b1);
        bf16_t* dst = (col < 1024 ? A0 : A1) + (size_t)row * 1024 + (col & 1023);
        *(u32x4*)dst = pack8(v0, v1);
    }
};
struct OpG {
    bf16_t* G;
    __device__ __forceinline__ void operator()(int row, int col, f32x4 v0, f32x4 v1) const { *(u32x4*)(G + (size_t)row * 1024 + col) = pack8(v0, v1); }
};
template <int KB> struct OpMerge {
    const bf16_t* GT; float* MF; bf16_t* MB;
    __device__ __forceinline__ void operator()(int row, int col, f32x4 v0, f32x4 v1) const {
        f32x4 g0, g1; unpack8(*(const u32x4*)(GT + (size_t)row * 3072 + KB * 1024 + col), g0, g1);
        float* mf = MF + (size_t)row * 1024 + col;
        f32x4 r0 = g0 * v0, r1 = g1 * v1;
        if (KB > 0) { r0 += *(const f32x4*)mf; r1 += *(const f32x4*)(mf + 4); }
        if (KB < 2) { *(f32x4*)mf = r0; *(f32x4*)(mf + 4) = r1; }
        else *(u32x4*)(MB + (size_t)row * 1024 + col) = pack8(r0, r1);
    }
};
struct OpResid {
    const float *xl, *xc; float *ol, *oc; const float* mod; int gi;
    __device__ __forceinline__ void operator()(int row, int col, f32x4 v0, f32x4 v1) const {
        const float* xi; float* xo; const float* g;
        if (row < ML) { xi = xl + (size_t)row * 1024 + col; xo = ol + (size_t)row * 1024 + col; g = mod + (size_t)(row >> 11) * 6144 + gi * 1024 + col; }
        else { const size_t rr = (size_t)(row - ML) * 1024 + col; xi = xc + rr; xo = oc + rr; g = mod + (size_t)8 * 6144 + gi * 1024 + col; }
        const f32x4 x0 = *(const f32x4*)xi, x1 = *(const f32x4*)(xi + 4), g0 = *(const f32x4*)g, g1 = *(const f32x4*)(g + 4);
        *(f32x4*)xo = x0 + g0 * v0; *(f32x4*)(xo + 4) = x1 + g1 * v1;
    }
};
struct OpSwiglu {
    bf16_t* HID;
    __device__ __forceinline__ void operator()(int row, int col, f32x4 v0, f32x4 v1) const {
        const float h0 = v0.x * sigmoidf_(v0.x) * v0.y, h1 = v0.z * sigmoidf_(v0.z) * v0.w, h2 = v1.x * sigmoidf_(v1.x) * v1.y, h3 = v1.z * sigmoidf_(v1.z) * v1.w;
        u32x2 o; o.x = pkbf(h0, h1); o.y = pkbf(h2, h3);
        *(u32x2*)(HID + (size_t)row * DFF + (col >> 1)) = o;
    }
};
template <class Op> __device__ __forceinline__ void run_gemm(const TI ti, unsigned char* lds, const bf16_t* A, const bf16_t* Bt, int Mr, int N, int K, const Op& op) {
    int Kv = K; asm volatile("" : "+s"(Kv));
    pg8::Gemm g{A, Bt, Mr, N, Kv}; pg8::StaticOrder S; S.init(Mr, N, ti.nblk, ti.bid);
    EpiT<Op> E{op};
    pg8::gemm_phase<EpiT<Op>, pg8::StaticOrder, true, true>((PG8_LAS unsigned char*)lds, g, S, E, ti.tid);
}

__device__ __forceinline__ void ph_mods(const TI ti, CArgs& a, unsigned char* ldsg) {
    float* sc = (float*)ldsg; float* part = sc + 9 * 1024;
    const int tid = ti.tid, lane = tid & 63, w = tid >> 6;
    for (int i = tid; i < 9 * 1024; i += 512) { const float v = (i < 8192) ? a.in[1][i] : a.in[3][i - 8192]; sc[i] = v / (1.f + expf(-v)); }
    __syncthreads();
    float* MOD = (float*)(a.ws + WS_MOD);
    for (int item = ti.bid; item < DEPTH * 96; item += ti.nblk) {
        const int l = item / 96, n0 = (item % 96) * 64;
        const float* W = a.in[4] + (size_t)l * 1024 * 6144 + n0 + lane;
        float acc[9];
#pragma unroll
        for (int r = 0; r < 9; ++r) acc[r] = 0.f;
#pragma unroll 8
        for (int k = w * 128; k < w * 128 + 128; ++k) {
            const float wv = W[(size_t)k * 6144];
#pragma unroll
            for (int r = 0; r < 9; ++r) acc[r] += sc[r * 1024 + k] * wv;
        }
#pragma unroll
        for (int r = 0; r < 9; ++r) part[(w * 9 + r) * 64 + lane] = acc[r];
        __syncthreads();
        for (int idx = tid; idx < 576; idx += 512) {
            const int r = idx >> 6, ln = idx & 63; float s = a.in[5][l * 6144 + n0 + ln];
            for (int ww = 0; ww < 8; ++ww) s += part[(ww * 9 + r) * 64 + ln];
            MOD[((size_t)l * 9 + r) * 6144 + n0 + ln] = s;
        }
        __syncthreads();
    }
    float* RC = (float*)(a.ws + WS_ROPE); float* RS = RC + 2048 * 32;
    for (int idx = ti.bid * 512 + tid; idx < 2048 * 32; idx += ti.nblk * 512) {
        const int t = idx >> 5, i = idx & 31; const float pos = i < 16 ? (float)(t >> 6) : (float)(t & 63);
        const float ang = pos * exp2f(-(float)(i & 15) * (13.287712379549449f / 16.f));
        RC[idx] = cosf(ang); RS[idx] = sinf(ang);
    }
}

__device__ __forceinline__ void norm_rows(const float* xl, const float* xc, const float* g, const float* modl, int shi, int sci, bf16_t* H, int nrows, int gw, int ngw, int lane) {
#define NR_LOAD(V, SC, SH, row_) do { const int r__ = (row_); const float* src; int rr; if (r__ < ML) { src = xl + (size_t)r__ * D; rr = r__ >> 11; } else { src = xc + (size_t)(r__ - ML) * D; rr = 8; } \
        const float* md = modl + (size_t)rr * 6144; _Pragma("unroll") for (int j = 0; j < 4; ++j) { const int c = 4 * lane + 256 * j; V[j] = *(const f32x4*)(src + c); SC[j] = *(const f32x4*)(md + sci * 1024 + c); SH[j] = *(const f32x4*)(md + shi * 1024 + c); } } while (0)
    f32x4 gg[4], v[4], sc[4], sh[4], nv[4], nsc[4], nsh[4];
#pragma unroll
    for (int j = 0; j < 4; ++j) { gg[j] = *(const f32x4*)(g + 4 * lane + 256 * j); nv[j] = gg[j]; nsc[j] = gg[j]; nsh[j] = gg[j]; }
    int row = gw;
    if (row < nrows) NR_LOAD(v, sc, sh, row);
    for (; row < nrows; row += ngw) {
        const int nrow = row + ngw;
        if (nrow < nrows) NR_LOAD(nv, nsc, nsh, nrow);
        float ss = 0.f;
#pragma unroll
        for (int j = 0; j < 4; ++j) ss += (v[j].x * v[j].x + v[j].y * v[j].y) + (v[j].z * v[j].z + v[j].w * v[j].w);
        ss = wave_sum(ss);
        const float rstd = rsqrtf(ss * (1.f / 1024.f) + 1e-6f);
#pragma unroll
        for (int j = 0; j < 4; ++j) {
            const f32x4 o = v[j] * rstd * gg[j] * (1.f + sc[j]) + sh[j];
            u32x2 p; p.x = pkbf(o.x, o.y); p.y = pkbf(o.z, o.w);
            *(u32x2*)(H + (size_t)row * D + 4 * lane + 256 * j) = p;
            v[j] = nv[j]; sc[j] = nsc[j]; sh[j] = nsh[j];
        }
    }
#undef NR_LOAD
}

template <int MODE> __device__ __forceinline__ void transpose_item(const float* W, int K, int N, bf16_t* WT, LAS float* scr, int item, int lane) {
    const int nblk = N / 32, kb = item / nblk, nb = item % nblk, k0 = 64 * kb, n0 = 32 * nb;
#pragma unroll 8
    for (int i = 0; i < 32; ++i) { const int kk = 2 * i + (lane >> 5); scr[kk * 33 + (lane & 31)] = W[(size_t)(k0 + kk) * N + n0 + (lane & 31)]; }
    asm volatile("s_waitcnt lgkmcnt(0)" ::: "memory");
    const int c = lane & 7;
#pragma unroll
    for (int j = 0; j < 4; ++j) {
        const int n = (lane >> 3) + 8 * j, gn = n0 + n; const LAS float* s = scr + (8 * c) * 33 + n;
        const int drow = MODE == 0 ? gn : (MODE == 1 ? (gn >= 8608 ? gn + 96 : gn) : (gn < DFF ? 2 * gn : 2 * (gn - DFF) + 1));
        u32x4 o; o.x = pkbf(s[0 * 33], s[1 * 33]); o.y = pkbf(s[2 * 33], s[3 * 33]); o.z = pkbf(s[4 * 33], s[5 * 33]); o.w = pkbf(s[6 * 33], s[7 * 33]);
        *(u32x4*)(WT + (size_t)drow * K + k0 + 8 * c) = o;
    }
    asm volatile("s_waitcnt lgkmcnt(0)" ::: "memory");
}
__device__ __forceinline__ void ph_wconv(CArgs& a, int l, unsigned char* ldsg, int gw, int ngw, int lane, int wv, int mask) {
    LAS float* scr = (LAS float*)(ldsg + wv * 8704);
    unsigned char* ws = a.ws;
    constexpr int I_IN = 16 * 365, I_SQ = 16 * 32, I_WI = 16 * 176, I_WO = 44 * 32;
    if (mask & 1) for (int it = gw; it < I_IN; it += ngw) transpose_item<1>(a.in[8] + (size_t)l * 1024 * 11680, 1024, 11680, (bf16_t*)(ws + WS_WIN), scr, it, lane);
    if (mask & 2) for (int it = gw; it < 3 * I_SQ; it += ngw) { const int wh = it / I_SQ; transpose_item<0>(a.in[27 + wh] + (size_t)l * 1048576, 1024, 1024, (bf16_t*)(ws + WS_WA + (size_t)wh * 2 * MiB), scr, it % I_SQ, lane); }
    if (mask & 4) for (int it = gw; it < I_SQ; it += ngw) transpose_item<0>(a.in[30] + (size_t)l * 1048576, 1024, 1024, (bf16_t*)(ws + WS_WO), scr, it, lane);
    if (mask & 8) for (int it = gw; it < I_WI; it += ngw) transpose_item<2>(a.in[31] + (size_t)l * 1024 * 5632, 1024, 5632, (bf16_t*)(ws + WS_WI), scr, it, lane);
    if (mask & 16) for (int it = gw; it < I_WO; it += ngw) transpose_item<0>(a.in[32] + (size_t)l * DFF * 1024, DFF, 1024, (bf16_t*)(ws + WS_WO2), scr, it, lane);
    if (!(mask & 1)) return;
    const int gt = gw * 64 + lane, ngt = ngw * 64;
    bf16_t* LWT = (bf16_t*)(ws + WS_LWT); bf16_t* LAT = (bf16_t*)(ws + WS_LAT); bf16_t* LGT = (bf16_t*)(ws + WS_LGT);
    const float* w2 = a.in[18] + (size_t)l * 2 * 64 * 1024; const float* a2 = a.in[20] + (size_t)l * 2 * 64 * 1024; const float* g2 = a.in[21] + (size_t)l * 160 * 1024;
    for (int i = gt; i < 2048 * 128; i += ngt) {
        const int n = i >> 7, k = i & 127, d = n >> 10, c = n & 1023, kk = k - d * 64;
        const bool in = (kk >= 0 && kk < 64);
        LWT[i] = in ? f2bf(w2[((size_t)d * 64 + kk) * 1024 + c]) : (bf16_t)0;
        LAT[i] = in ? f2bf(a2[((size_t)d * 64 + kk) * 1024 + c]) : (bf16_t)0;
    }
    for (int i = gt; i < 1024 * 256; i += ngt) { const int n = i >> 8, k = i & 255; LGT[i] = k < 160 ? f2bf(g2[(size_t)k * 1024 + n]) : (bf16_t)0; }
    bf16_t* WIN = (bf16_t*)(ws + WS_WIN);
    for (int i = gt; i < 96 * 1024; i += ngt) WIN[(size_t)8608 * 1024 + i] = 0;
}

__device__ __forceinline__ void gmlp_unit(const TI ti, CArgs& a, int l, int u, unsigned char* ldsg) {
    float* rstd = (float*)ldsg; bf16_t* VNT = (bf16_t*)(ldsg + 512);
    const int tid = ti.tid, lane = tid & 63, w = tid >> 6, r = lane & 31, h = lane >> 5;
    bf16_t* GU = (bf16_t*)(a.ws + WS_GU); const bf16_t* GV = (const bf16_t*)(a.ws + WS_GV);
    const size_t R0 = (size_t)u * 128;
#pragma unroll 4
    for (int i = 0; i < 16; ++i) {
        const int tok = w * 16 + i; const bf16_t* p = GV + (R0 + tok) * 1024 + lane * 16;
        f32x4 x0, x1, x2, x3; unpack8(*(const u32x4*)p, x0, x1); unpack8(*(const u32x4*)(p + 8), x2, x3);
        float ss = (x0.x * x0.x + x0.y * x0.y + x0.z * x0.z + x0.w * x0.w) + (x1.x * x1.x + x1.y * x1.y + x1.z * x1.z + x1.w * x1.w)
                 + (x2.x * x2.x + x2.y * x2.y + x2.z * x2.z + x2.w * x2.w) + (x3.x * x3.x + x3.y * x3.y + x3.z * x3.z + x3.w * x3.w);
        ss = wave_sum(ss);
        if (lane == 0) rstd[tok] = rsqrtf(ss * (1.f / 1024.f) + 1e-6f);
    }
    __syncthreads();
    const float* gvg = a.in[9] + l * 1024; const float* wsp = a.in[10] + (size_t)l * 8 * 128 * 128; const float* bsp = a.in[11] + l * 8 * 128;
    const int tt = w & 3, chh = w >> 2;
    for (int g = 0; g < 8; ++g) {
        {
            const int s = tid & 127, cc = tid >> 7; const float rs = rstd[s]; const bf16_t* p = GV + (R0 + s) * 1024 + g * 128 + cc * 32;
#pragma unroll
            for (int q = 0; q < 4; ++q) {
                f32x4 x0, x1; unpack8(*(const u32x4*)(p + 8 * q), x0, x1);
                const float* gp = gvg + g * 128 + cc * 32 + 8 * q; const int c0 = cc * 32 + 8 * q;
                VNT[(c0 + 0) * 136 + s] = f2bf(x0.x * rs * gp[0]); VNT[(c0 + 1) * 136 + s] = f2bf(x0.y * rs * gp[1]);
                VNT[(c0 + 2) * 136 + s] = f2bf(x0.z * rs * gp[2]); VNT[(c0 + 3) * 136 + s] = f2bf(x0.w * rs * gp[3]);
                VNT[(c0 + 4) * 136 + s] = f2bf(x1.x * rs * gp[4]); VNT[(c0 + 5) * 136 + s] = f2bf(x1.y * rs * gp[5]);
                VNT[(c0 + 6) * 136 + s] = f2bf(x1.z * rs * gp[6]); VNT[(c0 + 7) * 136 + s] = f2bf(x1.w * rs * gp[7]);
            }
        }
        __syncthreads();
        f32x16 acc0, acc1;
#pragma unroll
        for (int i = 0; i < 16; ++i) { acc0[i] = 0.f; acc1[i] = 0.f; }
        const float* wrow = wsp + ((size_t)g * 128 + tt * 32 + r) * 128;
#pragma unroll
        for (int ks = 0; ks < 8; ++ks) {
            const f32x4 a0 = *(const f32x4*)(wrow + 16 * ks + 8 * h), a1 = *(const f32x4*)(wrow + 16 * ks + 8 * h + 4);
            const bf16x8 af = __builtin_bit_cast(bf16x8, pack8(a0, a1));
            const bf16x8 b0 = *(const bf16x8*)(VNT + (chh * 64 + r) * 136 + 16 * ks + 8 * h);
            const bf16x8 b1 = *(const bf16x8*)(VNT + (chh * 64 + 32 + r) * 136 + 16 * ks + 8 * h);
            acc0 = MFMA32(af, b0, acc0); acc1 = MFMA32(af, b1, acc1);
        }
        {
            const bf16_t* GUr = GU; float uu0[16], uu1[16], bb[16];
#pragma unroll
            for (int reg = 0; reg < 16; ++reg) {
                const int t = tt * 32 + (reg & 3) + 8 * (reg >> 2) + 4 * h; const size_t i0 = (R0 + t) * 1024 + g * 128 + chh * 64 + r;
                bb[reg] = bsp[g * 128 + t]; uu0[reg] = bf2f(GUr[i0]); uu1[reg] = bf2f(GUr[i0 + 32]);
            }
            asm volatile("" ::: "memory");
#pragma unroll
            for (int reg = 0; reg < 16; ++reg) {
                const int t = tt * 32 + (reg & 3) + 8 * (reg >> 2) + 4 * h; const size_t i0 = (R0 + t) * 1024 + g * 128 + chh * 64 + r;
                GU[i0] = f2bf(uu0[reg] * (acc0[reg] + bb[reg])); GU[i0 + 32] = f2bf(uu1[reg] * (acc1[reg] + bb[reg]));
            }
        }
        __syncthreads();
    }
}
__device__ __forceinline__ void qk_rows(CArgs& a, int l, int gw, int ngw, int lane) {
    bf16_t* Q = (bf16_t*)(a.ws + WS_Q); bf16_t* K = (bf16_t*)(a.ws + WS_K);
    const float* RC = (const float*)(a.ws + WS_ROPE); const float* RS = RC + 2048 * 32;
    const int part = lane & 3;
    float gq[16], gk[16];
    load16f(a.in[12] + l * 64 + 16 * part, gq); load16f(a.in[13] + l * 64 + 16 * part, gk);
    for (int row = gw; row < M; row += ngw) {
        float xq[16], xk[16], cs[16], sn[16];
        unpack16(Q + (size_t)row * 1024 + 16 * lane, xq); unpack16(K + (size_t)row * 1024 + 16 * lane, xk);
        const bool lat = row < ML;
        if (lat) { const int t = row & 2047; load16f(RC + t * 32 + 16 * (part & 1), cs); load16f(RS + t * 32 + 16 * (part & 1), sn); }
        float sq = 0.f, sk = 0.f;
#pragma unroll
        for (int j = 0; j < 16; ++j) { sq += xq[j] * xq[j]; sk += xk[j] * xk[j]; }
        const float rq = rsqrtf(quad_sum(sq) * (1.f / 64.f) + 1e-6f), rk = rsqrtf(quad_sum(sk) * (1.f / 64.f) + 1e-6f);
#pragma unroll
        for (int j = 0; j < 16; ++j) { xq[j] = xq[j] * rq * gq[j]; xk[j] = xk[j] * rk * gk[j]; }
        if (lat) {
            const float sgn = part < 2 ? -1.f : 1.f;
#pragma unroll
            for (int j = 0; j < 16; ++j) {
                const float pq = quad_xor2(xq[j]), pk = quad_xor2(xk[j]);
                xq[j] = xq[j] * cs[j] + sgn * pq * sn[j]; xk[j] = xk[j] * cs[j] + sgn * pk * sn[j];
            }
        }
#pragma unroll
        for (int j = 0; j < 16; ++j) xq[j] *= QSCALE;
        pack16(Q + (size_t)row * 1024 + 16 * lane, xq); pack16(K + (size_t)row * 1024 + 16 * lane, xk);
    }
}
__device__ __forceinline__ void lora_in_rows(CArgs& a, int l, int gw, int ngw, int lane) {
    const bf16_t* RW = (const bf16_t*)(a.ws + WS_RW); bf16_t* LW = (bf16_t*)(a.ws + WS_LIW); bf16_t* LA = (bf16_t*)(a.ws + WS_LIA); bf16_t* LG = (bf16_t*)(a.ws + WS_LIG);
    const float* mu = a.in[16] + l * 3488 + 3072;
    f32x4 m0 = {0.f, 0.f, 0.f, 0.f}, m1 = m0;
    if (lane < 52) { m0 = *(const f32x4*)(mu + 8 * lane); m1 = *(const f32x4*)(mu + 8 * lane + 4); }
    for (int row = gw; row < M; row += ngw) {
        int t, Tn; if (row < ML) { t = row & 2047; Tn = 2048; } else { t = (row - ML) & 255; Tn = 256; }
        const bool hp = t > 0, hn = t < Tn - 1;
        if (lane < 52) {
            const bf16_t* p = RW + (size_t)row * RWP + 3072 + 8 * lane;
            f32x4 x0, x1, p0 = {0.f, 0.f, 0.f, 0.f}, p1 = p0, n0 = p0, n1 = p0;
            unpack8(*(const u32x4*)p, x0, x1);
            if (hp) unpack8(*(const u32x4*)(p - RWP), p0, p1);
            if (hn) unpack8(*(const u32x4*)(p + RWP), n0, n1);
            f32x4 z0 = x0 + m0 * (0.5f * (p0 + n0) - x0), z1 = x1 + m1 * (0.5f * (p1 + n1) - x1);
            const int j = 8 * lane;
            if (j < 128) { z0 = (f32x4){tanhf(z0.x), tanhf(z0.y), tanhf(z0.z), tanhf(z0.w)}; z1 = (f32x4){tanhf(z1.x), tanhf(z1.y), tanhf(z1.z), tanhf(z1.w)}; *(u32x4*)(LW + (size_t)row * 128 + j) = pack8(z0, z1); }
            else if (j < 256) { *(u32x4*)(LA + (size_t)row * 128 + j - 128) = pack8(z0, z1); }
            else { *(u32x4*)(LG + (size_t)row * 256 + j - 256) = pack8(sig4(z0), sig4(z1)); }
        } else {
            unsigned z_ = 0u; asm volatile("" : "+v"(z_)); *(u32x4*)(LG + (size_t)row * 256 + 160 + (lane - 52) * 8) = (u32x4){z_, z_, z_, z_};
        }
    }
}

__device__ __forceinline__ void scan_unit(const TI ti, CArgs& a, int l, int u, bool ctx_out, unsigned char* ldsg) {
    const int tid = ti.tid, lane = tid & 63, w = tid >> 6;
    const int b = u >> 5, hh = (u >> 1) & 15, d = u & 1;
    const int si = tid >> 3, jq = tid & 7;
    LAS float* L = (LAS float*)ldsg;
    const bf16_t* RW = (const bf16_t*)(a.ws + WS_RW);
    const bf16_t* DEC = (const bf16_t*)(a.ws + (d ? WS_DEC1 : WS_GV));
    const bf16_t* AA = (const bf16_t*)(a.ws + (d ? WS_AA1 : WS_AA0));
    bf16_t* Y = (bf16_t*)(a.ws + (d ? WS_Y1 : WS_H));
    const int ch = hh * 64 + lane;
    const float* mu = a.in[16] + l * 3488;
    const float mur = mu[ch], muk = mu[1024 + ch], muv = mu[2048 + ch], kkg = a.in[22][l * 1024 + ch], kag = a.in[23][l * 1024 + ch];
    f32x4 S0 = {0.f, 0.f, 0.f, 0.f}, S1 = {0.f, 0.f, 0.f, 0.f};
    unsigned raw[4][9]; unsigned dcr[4], aar[4];
    constexpr int NC = 72;
#define SCAN_CHUNK(n, base, Tn, t0, wy) int base, Tn, t0; bool wy; { int ci; if ((n) < 8) { base = ML + b * 256; Tn = 256; ci = d ? 7 - (n) : (n); wy = ctx_out; } else { base = b * 2048; Tn = 2048; ci = d ? 71 - (n) : (n) - 8; wy = true; } t0 = ci * 32; }
#define SCAN_LOAD(n) do { SCAN_CHUNK(n, base_, Tn_, t0_, wy_); (void)wy_; _Pragma("unroll") for (int i4 = 0; i4 < 4; ++i4) { const int t = t0_ + w + 8 * i4; const size_t row = (size_t)(base_ + t); \
        const bf16_t* p = RW + row * RWP + ch; const bool hp = t > 0, hn = t < Tn_ - 1; \
        const int op_ = hp ? -RWP : 0, on_ = hn ? RWP : 0;     \
        _Pragma("unroll") for (int X = 0; X < 3; ++X) { raw[i4][3 * X + 0] = (unsigned)p[X * 1024 + op_]; raw[i4][3 * X + 1] = (unsigned)p[X * 1024]; raw[i4][3 * X + 2] = (unsigned)p[X * 1024 + on_]; } \
        dcr[i4] = (unsigned)DEC[row * 1024 + ch]; aar[i4] = (unsigned)AA[row * 1024 + ch]; } } while (0)
#define SCAN_STORE(n) do { LAS float* Bf = L + ((n) & 1) * 12288; SCAN_CHUNK(n, base_, Tn_, t0_, wy_); (void)wy_; (void)base_; _Pragma("unroll") for (int i4 = 0; i4 < 4; ++i4) { const int tk = w + 8 * i4; \
        const float mp_ = (t0_ + tk > 0) ? 0.5f : 0.f, mn_ = (t0_ + tk < Tn_ - 1) ? 0.5f : 0.f; \
        const float xr = bf2f(raw[i4][1]), xk = bf2f(raw[i4][4]), xv = bf2f(raw[i4][7]); \
        const float zr = xr + mur * ((mp_ * bf2f(raw[i4][0]) + mn_ * bf2f(raw[i4][2])) - xr); \
        const float zk = xk + muk * ((mp_ * bf2f(raw[i4][3]) + mn_ * bf2f(raw[i4][5])) - xk); \
        const float zv = xv + muv * ((mp_ * bf2f(raw[i4][6]) + mn_ * bf2f(raw[i4][8])) - xv); \
        const float kkv = zk * kkg; const float ssq = wave_sum(kkv * kkv); const float kkn = kkv / fmaxf(sqrtf(ssq), 1e-12f); \
        const float ad = bf2f(aar[i4]); const float wv_ = __expf(bf2f(dcr[i4])); const float kd = zk * (1.f + (ad - 1.f) * kag); \
        Bf[0 * 2048 + tk * 64 + lane] = wv_; Bf[1 * 2048 + tk * 64 + lane] = kd; Bf[2 * 2048 + tk * 64 + lane] = -kkn; \
        Bf[3 * 2048 + tk * 64 + lane] = kkn * ad; Bf[4 * 2048 + tk * 64 + lane] = zr; Bf[5 * 2048 + tk * 64 + lane] = zv; } } while (0)
    SCAN_LOAD(0); SCAN_STORE(0);
    __syncthreads();
    for (int n = 0; n < NC; ++n) {
        if (n + 1 < NC) SCAN_LOAD(n + 1);
        LAS const float* Bf = L + (n & 1) * 12288; LAS float* Yb = L + 24576 + (n & 1) * 2048;
#define STEP_LOAD(P, sidx) LAS const float* q##P = Bf + (sidx) * 64 + 8 * jq + hoff; \
            const f32x4 w0##P = *(LAS const f32x4*)(q##P), w1##P = *(LAS const f32x4*)(q##P + hdq), k0##P = *(LAS const f32x4*)(q##P + 2048), k1##P = *(LAS const f32x4*)(q##P + 2048 + hdq), \
                        a0##P = *(LAS const f32x4*)(q##P + 4096), a1##P = *(LAS const f32x4*)(q##P + 4096 + hdq), b0##P = *(LAS const f32x4*)(q##P + 6144), b1##P = *(LAS const f32x4*)(q##P + 6144 + hdq), \
                        r0##P = *(LAS const f32x4*)(q##P + 8192), r1##P = *(LAS const f32x4*)(q##P + 8192 + hdq); const float vi##P = Bf[5 * 2048 + (sidx) * 64 + si];
#define STEP_MATH(P, sidx) { const f32x4 ta = S0 * a0##P + S1 * a1##P; const float sa = dpp_sum8((ta.x + ta.y) + (ta.z + ta.w)); \
            S0 = S0 * w0##P + (sa * b0##P + vi##P * k0##P); S1 = S1 * w1##P + (sa * b1##P + vi##P * k1##P); \
            const f32x4 ty = S0 * r0##P + S1 * r1##P; const float y = dpp_sum8((ty.x + ty.y) + (ty.z + ty.w)); if (jq == 0) Yb[(sidx) * 64 + si] = y; }
        const int hoff = (si & 1) * 4, hdq = 4 - 2 * hoff;
        const int sdir = d ? -1 : 1; int sc = d ? 31 : 0;
        f32x4 cw0, cw1, ck0, ck1, ca0, ca1, cb0, cb1, cr0, cr1; float cvi;
        { STEP_LOAD(X, sc); cw0 = w0X; cw1 = w1X; ck0 = k0X; ck1 = k1X; ca0 = a0X; ca1 = a1X; cb0 = b0X; cb1 = b1X; cr0 = r0X; cr1 = r1X; cvi = viX; }
        for (int ss = 0; ss < 32; ss += 2) {
            const int s0i = sc, s1i = sc + sdir; int s2i = sc + 2 * sdir; s2i = (ss + 2 < 32) ? s2i : s1i;
            STEP_LOAD(B, s1i);
            { const f32x4 w0A = cw0, w1A = cw1, k0A = ck0, k1A = ck1, a0A = ca0, a1A = ca1, b0A = cb0, b1A = cb1, r0A = cr0, r1A = cr1; const float viA = cvi; STEP_MATH(A, s0i); }
            STEP_LOAD(C, s2i);
            STEP_MATH(B, s1i);
            cw0 = w0C; cw1 = w1C; ck0 = k0C; ck1 = k1C; ca0 = a0C; ca1 = a1C; cb0 = b0C; cb1 = b1C; cr0 = r0C; cr1 = r1C; cvi = viC;
            sc += 2 * sdir;
        }
#undef STEP_LOAD
#undef STEP_MATH
        if (n + 1 < NC) SCAN_STORE(n + 1);
        __syncthreads();
        {
            SCAN_CHUNK(n, base_, Tn_, t0_, wy_); (void)Tn_;
            if (wy_) {
#pragma unroll
                for (int i4 = 0; i4 < 4; ++i4) { const int tk = w + 8 * i4; Y[(size_t)(base_ + t0_ + tk) * 1024 + ch] = f2bf(Yb[tk * 64 + lane]); }
            }
        }
    }
    __syncthreads();
#undef SCAN_CHUNK
#undef SCAN_LOAD
#undef SCAN_STORE
}

__device__ __forceinline__ bf16x8 pk8f(float f0, float f1, float f2, float f3, float f4, float f5, float f6, float f7) {
    u32x4 p; p.x = pkbf(f0, f1); p.y = pkbf(f2, f3); p.z = pkbf(f4, f5); p.w = pkbf(f6, f7); return __builtin_bit_cast(bf16x8, p);
}
__device__ __forceinline__ void scan_unit_mfma(const TI ti, CArgs& a, int l, int u, bool ctx_out, unsigned char* ldsg) {
    const int tid = ti.tid, lane = tid & 63, w = __builtin_amdgcn_readfirstlane(tid >> 6);
    const int b = u >> 5, hh = (u >> 1) & 15, d = u & 1;
    LAS unsigned char* L = (LAS unsigned char*)ldsg;
    constexpr int NCH = 144, RING = 6, BUFB = 20736, O_AR = 0, O_BK = 4608, O_BKT = 9216, O_VTT = 14336, O_PC = 17408, O_NS = 17664, O_XF = 18688;
#define SC2_CHUNK(C, base, Tn, cc, wy) int base, Tn, cc; bool wy; if ((C) < 16) { base = ML + b * 256; Tn = 256; cc = (C); wy = ctx_out; } else { base = b * 2048; Tn = 2048; cc = (C) - 16; wy = true; }
#define SC2_TOK(Tn, cc, t) (d ? (Tn) - 1 - (16 * (cc) + (t)) : 16 * (cc) + (t))
    if (w < 2) {
        const int it = w, r = lane & 31, h = lane >> 5;
        bf16_t* Y = (bf16_t*)(a.ws + (d ? WS_Y1 : WS_H));
        f32x16 ST0, ST1;
#pragma unroll
        for (int i = 0; i < 16; ++i) { ST0[i] = 0.f; ST1[i] = 0.f; }
        for (int n = 0; n < NCH + RING; ++n) {
            if (n >= RING) {
                const int C = n - RING;
                LAS const unsigned char* buf = L + (C % RING) * BUFB;
                const bf16x8 xb0 = *(LAS const bf16x8*)(buf + O_XF + lane * 16), xb1 = *(LAS const bf16x8*)(buf + O_XF + 1024 + lane * 16);
                f32x16 Z;
#pragma unroll
                for (int i = 0; i < 16; ++i) Z[i] = 0.f;
#pragma unroll
                for (int jt = 0; jt < 2; ++jt) {
#pragma unroll
                    for (int s = 0; s < 2; ++s) {
                        LAS const unsigned char* ap = buf + O_AR + r * 144 + (32 * jt + 16 * s + 4 * h) * 2;
                        const s16x4 lo = *(LAS const s16x4*)ap, hi = *(LAS const s16x4*)(ap + 16);
                        const bf16x8 a2 = __builtin_shufflevector(lo, hi, 0, 1, 2, 3, 4, 5, 6, 7);
                        const bf16x8 stp = jt == 0 ? pk8f(ST0[8 * s], ST0[8 * s + 1], ST0[8 * s + 2], ST0[8 * s + 3], ST0[8 * s + 4], ST0[8 * s + 5], ST0[8 * s + 6], ST0[8 * s + 7])
                                                   : pk8f(ST1[8 * s], ST1[8 * s + 1], ST1[8 * s + 2], ST1[8 * s + 3], ST1[8 * s + 4], ST1[8 * s + 5], ST1[8 * s + 6], ST1[8 * s + 7]);
                        Z = MFMA32(a2, stp, Z);
                    }
                }
                LAS const unsigned char* vp = buf + O_VTT + (32 * it + r) * 48;
                {
                    const s16x4 lo = *(LAS const s16x4*)(vp + 8 * h), hi = *(LAS const s16x4*)(vp + 16 + 8 * h);
                    const bf16x8 vf = __builtin_shufflevector(lo, hi, 0, 1, 2, 3, 4, 5, 6, 7);
                    Z = MFMA32(xb1, vf, Z);
                }
                float o[8], g[16], uu[16];
#pragma unroll
                for (int q = 0; q < 8; ++q) o[q] = __shfl_xor(Z[q], 32);
#pragma unroll
                for (int e = 0; e < 4; ++e) {
                    g[e] = h ? o[e] : Z[e]; g[4 + e] = h ? Z[e] : o[e];
                    g[8 + e] = h ? o[4 + e] : Z[4 + e]; g[12 + e] = h ? Z[4 + e] : o[4 + e];
                }
                {
                    LAS const float* NS = (LAS const float*)(buf + O_NS);
#pragma unroll
                    for (int t = 0; t < 16; ++t) uu[t] = g[t];
#pragma unroll
                    for (int s = 0; s < 15; ++s) {
#pragma unroll
                        for (int t4 = (s + 1) / 4; t4 < 4; ++t4) {
                            const f32x4 nv = *(LAS const f32x4*)(NS + s * 16 + 4 * t4);
                            if (4 * t4 + 0 > s) uu[4 * t4 + 0] = __builtin_fmaf(nv.x, uu[s], uu[4 * t4 + 0]);
                            if (4 * t4 + 1 > s) uu[4 * t4 + 1] = __builtin_fmaf(nv.y, uu[s], uu[4 * t4 + 1]);
                            if (4 * t4 + 2 > s) uu[4 * t4 + 2] = __builtin_fmaf(nv.z, uu[s], uu[4 * t4 + 2]);
                            if (4 * t4 + 3 > s) uu[4 * t4 + 3] = __builtin_fmaf(nv.w, uu[s], uu[4 * t4 + 3]);
                        }
                    }
                }
                {
                    const bf16x8 uf = pk8f(h ? uu[4] : uu[0], h ? uu[5] : uu[1], h ? uu[6] : uu[2], h ? uu[7] : uu[3],
                                           h ? uu[12] : uu[8], h ? uu[13] : uu[9], h ? uu[14] : uu[10], h ? uu[15] : uu[11]);
                    Z = MFMA32(xb0, uf, Z);
                }
                {
                    SC2_CHUNK(C, base_, Tn_, cc_, wy_);
                    if (wy_) {
#pragma unroll
                        for (int q = 8; q < 16; ++q) {
                            const int t = (q & 3) + 8 * ((q >> 2) - 2) + 4 * h; const int tok = SC2_TOK(Tn_, cc_, t);
                            Y[(size_t)(base_ + tok) * 1024 + hh * 64 + 32 * it + r] = f2bf(Z[q]);
                        }
                    }
                }
                {
                    const bf16x8 un = pk8f(h ? uu[8] : uu[0], h ? uu[9] : uu[1], h ? uu[10] : uu[2], h ? uu[11] : uu[3],
                                           h ? uu[12] : uu[4], h ? uu[13] : uu[5], h ? uu[14] : uu[6], h ? uu[15] : uu[7]);
                    const bf16x8 vn = *(LAS const bf16x8*)(vp + 16 * h);
                    const bf16x8 a00 = *(LAS const bf16x8*)(buf + O_BKT + r * 80 + (8 * h) * 2), a01 = *(LAS const bf16x8*)(buf + O_BKT + r * 80 + (16 + 8 * h) * 2);
                    const bf16x8 a10 = *(LAS const bf16x8*)(buf + O_BKT + (32 + r) * 80 + (8 * h) * 2), a11 = *(LAS const bf16x8*)(buf + O_BKT + (32 + r) * 80 + (16 + 8 * h) * 2);
                    ST0 = MFMA32(a00, un, ST0); ST0 = MFMA32(a01, vn, ST0);
                    ST1 = MFMA32(a10, un, ST1); ST1 = MFMA32(a11, vn, ST1);
                    LAS const float* pc = (LAS const float*)(buf + O_PC);
#pragma unroll
                    for (int g4 = 0; g4 < 4; ++g4) {
                        const f32x4 p0 = *(LAS const f32x4*)(pc + 8 * g4 + 4 * h), p1 = *(LAS const f32x4*)(pc + 32 + 8 * g4 + 4 * h);
                        ST0[4 * g4] *= p0.x; ST0[4 * g4 + 1] *= p0.y; ST0[4 * g4 + 2] *= p0.z; ST0[4 * g4 + 3] *= p0.w;
                        ST1[4 * g4] *= p1.x; ST1[4 * g4 + 1] *= p1.y; ST1[4 * g4 + 2] *= p1.z; ST1[4 * g4 + 3] *= p1.w;
                    }
                }
            }
            __syncthreads();
        }
    } else {
        const int p = w - 2, ch = hh * 64 + lane;
        const bf16_t* RW = (const bf16_t*)(a.ws + WS_RW);
        const bf16_t* DEC = (const bf16_t*)(a.ws + (d ? WS_DEC1 : WS_GV));
        const bf16_t* AA = (const bf16_t*)(a.ws + (d ? WS_AA1 : WS_AA0));
        const float* mu = a.in[16] + l * 3488;
        const float mur = mu[ch], muk = mu[1024 + ch], muv = mu[2048 + ch], kkg = a.in[22][l * 1024 + ch], kag = a.in[23][l * 1024 + ch];
        LAS unsigned char* buf = L + p * BUFB;
        LAS bf16_t* AR = (LAS bf16_t*)(buf + O_AR); LAS bf16_t* BK = (LAS bf16_t*)(buf + O_BK); LAS bf16_t* BKT = (LAS bf16_t*)(buf + O_BKT); LAS bf16_t* VTT = (LAS bf16_t*)(buf + O_VTT);
        LAS float* PC = (LAS float*)(buf + O_PC);
        constexpr int NSTEP = (NCH / RING) * 4;
        unsigned nxt[4][11], cur[4][11];
#define SC2_LOAD(k) do { const int C_ = p + RING * ((k) >> 2); SC2_CHUNK(C_, base_, Tn_, cc_, wy_); (void)wy_; _Pragma("unroll") for (int i4 = 0; i4 < 4; ++i4) { \
            const int tok = SC2_TOK(Tn_, cc_, 4 * ((k) & 3) + i4); const size_t row = (size_t)(base_ + tok); \
            const gcptr_t rb = uniptr(RW + row * RWP + hh * 64 + 1024);     \
            const gcptr_t rp = rb + (tok > 0 ? -RWP : 0); const gcptr_t rn = rb + (tok < Tn_ - 1 ? RWP : 0); \
            nxt[i4][0] = (unsigned)rp[lane - 1024]; nxt[i4][3] = (unsigned)rp[lane]; nxt[i4][6] = (unsigned)rp[lane + 1024]; \
            nxt[i4][1] = (unsigned)rb[lane - 1024]; nxt[i4][4] = (unsigned)rb[lane]; nxt[i4][7] = (unsigned)rb[lane + 1024]; \
            nxt[i4][2] = (unsigned)rn[lane - 1024]; nxt[i4][5] = (unsigned)rn[lane]; nxt[i4][8] = (unsigned)rn[lane + 1024]; \
            nxt[i4][9] = (unsigned)uniptr(DEC + row * 1024 + hh * 64)[lane]; nxt[i4][10] = (unsigned)uniptr(AA + row * 1024 + hh * 64)[lane]; } } while (0)
        SC2_LOAD(0);
        float Lsum = 0.f, ePprev = 1.f;
        for (int n = 0; n < NCH + RING; ++n) {
            const int e = n - p - 1;
            if (e >= 0 && (e % RING) < 4 && e / RING < NCH / RING) {
                const int k = 4 * (e / RING) + (e % RING);
#pragma unroll
                for (int i4 = 0; i4 < 4; ++i4)
#pragma unroll
                    for (int x = 0; x < 11; ++x) cur[i4][x] = nxt[i4][x];
                if (k + 1 < NSTEP) SC2_LOAD(k + 1);
                const int C_ = p + RING * (k >> 2); SC2_CHUNK(C_, base_, Tn_, cc_, wy_); (void)wy_; (void)base_;
#pragma unroll
                for (int i4 = 0; i4 < 4; ++i4) {
                    const int t = 4 * (k & 3) + i4; const int tok = SC2_TOK(Tn_, cc_, t);
                    Lsum = (t == 0) ? 0.f : Lsum; ePprev = (t == 0) ? 1.f : ePprev;
                    const float mp_ = tok > 0 ? 0.5f : 0.f, mn_ = tok < Tn_ - 1 ? 0.5f : 0.f;
                    const float xr = bf2f(cur[i4][1]), xk = bf2f(cur[i4][4]), xv = bf2f(cur[i4][7]);
                    const float zr = xr + mur * ((mp_ * bf2f(cur[i4][0]) + mn_ * bf2f(cur[i4][2])) - xr);
                    const float zk = xk + muk * ((mp_ * bf2f(cur[i4][3]) + mn_ * bf2f(cur[i4][5])) - xk);
                    const float zv = xv + muv * ((mp_ * bf2f(cur[i4][6]) + mn_ * bf2f(cur[i4][8])) - xv);
                    const float kkv = zk * kkg; const float ssq = wave_sum(kkv * kkv); const float kkn = kkv * rsqrtf(fmaxf(ssq, 1e-24f));
                    const float ad = bf2f(cur[i4][10]); const float kd = zk * (1.f + (ad - 1.f) * kag);
                    Lsum += bf2f(cur[i4][9]);
                    const float eP = __expf(Lsum), eI = __expf(-Lsum);
                    AR[t * 72 + lane] = f2bf(-kkn * ePprev); AR[(16 + t) * 72 + lane] = f2bf(zr * eP);
                    const bf16_t bt = f2bf(kkn * ad * eI), kt = f2bf(kd * eI);
                    BK[t * 72 + lane] = bt; BK[(16 + t) * 72 + lane] = kt;
                    BKT[lane * 40 + t] = bt; BKT[lane * 40 + 16 + t] = kt;
                    VTT[lane * 24 + t] = f2bf(zv);
                    PC[lane] = eP;
                    ePprev = eP;
                }
            } else if (e >= 0 && (e % RING) == 4 && e / RING < NCH / RING) {
                const int r = lane & 31, h = lane >> 5, thr = (r & 15) + (r >> 4);
                f32x16 X;
#pragma unroll
                for (int i = 0; i < 16; ++i) X[i] = 0.f;
#pragma unroll
                for (int ks = 0; ks < 4; ++ks) {
                    const bf16x8 af = *(LAS const bf16x8*)(buf + O_BK + r * 144 + (16 * ks + 8 * h) * 2);
                    const bf16x8 bfr = *(LAS const bf16x8*)(buf + O_AR + r * 144 + (16 * ks + 8 * h) * 2);
                    X = MFMA32(af, bfr, X);
                }
#pragma unroll
                for (int rg = 0; rg < 16; ++rg) { const int s = (rg & 3) + 8 * ((rg >> 2) & 1) + 4 * h; X[rg] = (s < thr) ? X[rg] : 0.f; }
                if (r < 16) {
                    LAS float* NS = (LAS float*)(buf + O_NS);
#pragma unroll
                    for (int rg = 0; rg < 8; ++rg) NS[((rg & 3) + 8 * (rg >> 2) + 4 * h) * 16 + r] = X[rg];
                }
                *(LAS bf16x8*)(buf + O_XF + lane * 16) = pk8f(X[0], X[1], X[2], X[3], X[4], X[5], X[6], X[7]);
                *(LAS bf16x8*)(buf + O_XF + 1024 + lane * 16) = pk8f(X[8], X[9], X[10], X[11], X[12], X[13], X[14], X[15]);
            }
            __syncthreads();
        }
#undef SC2_LOAD
    }
    __syncthreads();
#undef SC2_CHUNK
#undef SC2_TOK
}

__device__ __forceinline__ void attn_unit(const TI ti, CArgs& a, int b, int hd, int qrow0, int st_lo, int st_hi, float mfix, float lam, float lam_init, const float* subg, unsigned char* ldsg) {
    const int tid = ti.tid, lane = tid & 63, w = tid >> 6, r = lane & 31, h = lane >> 5, qt = w >> 1, c = w & 1;
    bf16_t* Qb = (bf16_t*)(a.ws + WS_Q); const bf16_t* Kb = (const bf16_t*)(a.ws + WS_K); const bf16_t* Vb = (const bf16_t*)(a.ws + WS_V);
    LAS unsigned char* L = (LAS unsigned char*)ldsg;
    constexpr int KOFF = 0, VOFF = 17408, BUFB = 35840;
    bf16x8 qf[4];
    { const bf16_t* qp = Qb + (size_t)(qrow0 + qt * 32 + r) * 1024 + hd * 128 + c * 64 + 8 * h;
#pragma unroll
      for (int ks = 0; ks < 4; ++ks) qf[ks] = *(const bf16x8*)(qp + 16 * ks); }
    f32x16 O[4];
#pragma unroll
    for (int e = 0; e < 4; ++e)
#pragma unroll
        for (int i = 0; i < 16; ++i) O[e][i] = 0.f;
    float lsum = 0.f;
    u32x4 kreg[2], vreg[2];
    typedef const __attribute__((address_space(1))) u32x4* gc16_t;
    const int koff0 = (tid >> 4) * 1024 + (tid & 15) * 8, koff1 = koff0 + 32 * 1024, voff = lane * 1024 + w * 16;
#define ATT_LOAD(st) do { const int rb_ = (st) < 32 ? b * 2048 + (st) * 64 : ML + b * 256 + ((st) - 32) * 64; \
        const gcptr_t kb_ = uniptr(Kb + (size_t)rb_ * 1024 + hd * 128); const gcptr_t vb_ = uniptr(Vb + (size_t)rb_ * 1024 + hd * 128); \
        kreg[0] = *(gc16_t)(kb_ + koff0); kreg[1] = *(gc16_t)(kb_ + koff1); vreg[0] = *(gc16_t)(vb_ + voff); vreg[1] = *(gc16_t)(vb_ + voff + 8); } while (0)
#define ATT_STORE(bufi) do { LAS unsigned char* Bb = L + (bufi) * BUFB; _Pragma("unroll") for (int i = 0; i < 2; ++i) { const int p = tid + 512 * i, key = p >> 4, dc = p & 15; *(LAS u32x4*)(Bb + KOFF + key * 272 + dc * 16) = kreg[i]; } \
        LAS bf16_t* vt = (LAS bf16_t*)(Bb + VOFF) + (w * 16) * 72 + ((lane & 48) + 8 * ((lane >> 2) & 1) + 4 * ((lane >> 3) & 1) + (lane & 3));   \
        _Pragma("unroll") for (int e = 0; e < 4; ++e) { vt[(2 * e) * 72] = (bf16_t)(vreg[0][e] & 0xffffu); vt[(2 * e + 1) * 72] = (bf16_t)(vreg[0][e] >> 16); \
            vt[(8 + 2 * e) * 72] = (bf16_t)(vreg[1][e] & 0xffffu); vt[(8 + 2 * e + 1) * 72] = (bf16_t)(vreg[1][e] >> 16); } } while (0)
    ATT_LOAD(st_lo); ATT_STORE(0);
    __syncthreads();
    for (int st = st_lo; st < st_hi; ++st) {
        const int bi = (st - st_lo) & 1;
        if (st + 1 < st_hi) ATT_LOAD(st + 1);
        LAS const unsigned char* Bb = L + bi * BUFB;
        f32x16 Sx0, Sx1; bf16x8 pa0, pa1, pc0, pc1;
#pragma unroll
        for (int i = 0; i < 16; ++i) { Sx0[i] = -mfix; Sx1[i] = -mfix; }
#define ATT_QK(SX, sub) do { __builtin_amdgcn_s_setprio(1); _Pragma("unroll") for (int ks = 0; ks < 4; ++ks) { \
            const bf16x8 kf = *(LAS const bf16x8*)(Bb + KOFF + ((sub) * 32 + r) * 272 + (c * 64 + 16 * ks + 8 * h) * 2); SX = MFMA32(kf, qf[ks], SX); } __builtin_amdgcn_s_setprio(0); } while (0)
#define ATT_SOFT(SX, P0, P1) do { float p[16]; _Pragma("unroll") for (int i = 0; i < 16; ++i) { p[i] = __builtin_amdgcn_exp2f(SX[i]); lsum += p[i]; } \
            P0 = pk8f(p[0], p[1], p[2], p[3], p[4], p[5], p[6], p[7]); P1 = pk8f(p[8], p[9], p[10], p[11], p[12], p[13], p[14], p[15]); } while (0)
#define ATT_PV(sub, P0, P1) do { __builtin_amdgcn_s_setprio(1); _Pragma("unroll") for (int et = 0; et < 4; ++et) { _Pragma("unroll") for (int s = 0; s < 2; ++s) { \
            const bf16x8 vf = *(LAS const bf16x8*)(Bb + VOFF + (et * 32 + r) * 144 + ((sub) * 32 + 16 * s + 8 * h) * 2); O[et] = MFMA32(vf, s ? P1 : P0, O[et]); } } __builtin_amdgcn_s_setprio(0); } while (0)
        if (w < 4) {
            ATT_QK(Sx0, 0); ATT_QK(Sx1, 1);
            __builtin_amdgcn_sched_barrier(0);
            ATT_SOFT(Sx0, pa0, pa1); ATT_PV(0, pa0, pa1);
            ATT_SOFT(Sx1, pc0, pc1); ATT_PV(1, pc0, pc1);
        } else {
            ATT_QK(Sx0, 0);
            __builtin_amdgcn_sched_barrier(0);
            ATT_SOFT(Sx0, pa0, pa1);
            __builtin_amdgcn_sched_barrier(0);
            ATT_QK(Sx1, 1); ATT_PV(0, pa0, pa1);
            __builtin_amdgcn_sched_barrier(0);
            ATT_SOFT(Sx1, pc0, pc1); ATT_PV(1, pc0, pc1);
        }
#undef ATT_QK
#undef ATT_SOFT
#undef ATT_PV
        if (st + 1 < st_hi) ATT_STORE(bi ^ 1);
        __syncthreads();
    }
#undef ATT_LOAD
#undef ATT_STORE
    const float ltot = lsum + __shfl_xor(lsum, 32);
    const float linv = 1.f / ltot;
    LAS float* X = (LAS float*)L + qt * 4096;
    if (c == 1) {
#pragma unroll
        for (int e = 0; e < 4; ++e)
#pragma unroll
            for (int i = 0; i < 16; ++i) X[(e * 16 + i) * 64 + lane] = O[e][i] * linv;
    }
    __syncthreads();
    if (c == 0) {
        float ssq = 0.f;
#pragma unroll
        for (int e = 0; e < 4; ++e)
#pragma unroll
            for (int i = 0; i < 16; ++i) { const float o = O[e][i] * linv - lam * X[(e * 16 + i) * 64 + lane]; O[e][i] = o; ssq += o * o; }
        ssq += __shfl_xor(ssq, 32);
        const float sc = rsqrtf(ssq * (1.f / 128.f) + 1e-6f) * (1.f - lam_init);
        bf16_t* op = Qb + (size_t)(qrow0 + qt * 32 + r) * 1024 + hd * 128;
#pragma unroll
        for (int e = 0; e < 4; ++e)
#pragma unroll
            for (int g4 = 0; g4 < 4; ++g4) {
                const int e0 = e * 32 + 8 * g4 + 4 * h; const f32x4 sg = *(const f32x4*)(subg + e0);
                u32x2 o; o.x = pkbf(O[e][4 * g4 + 0] * sc * sg.x, O[e][4 * g4 + 1] * sc * sg.y); o.y = pkbf(O[e][4 * g4 + 2] * sc * sg.z, O[e][4 * g4 + 3] * sc * sg.w);
                *(u32x2*)(op + e0) = o;
            }
    }
    __syncthreads();
}
__device__ __forceinline__ void ph_attn(const TI ti, CArgs& a, int l, bool ctx_out, unsigned char* ldsg) {
    const int lane = ti.tid & 63;
    const float gqm = fabsf(a.in[12][l * 64 + lane]), gkm = fabsf(a.in[13][l * 64 + lane]);
    float mq = gqm, mk = gkm;
#pragma unroll
    for (int o = 1; o < 64; o <<= 1) { mq = fmaxf(mq, __shfl_xor(mq, o)); mk = fmaxf(mk, __shfl_xor(mk, o)); }
    const float mfix = 8.f * mq * mk * 1.4426950408889634f * 1.03f;
    const float* lp = a.in[14] + l * 256;
    const float s1 = wave_sum(lp[lane] * lp[64 + lane]), s2 = wave_sum(lp[128 + lane] * lp[192 + lane]);
    const float lam_init = 0.8f - 0.6f * expf(-0.3f * (float)l);
    const float lam = expf(s1) - expf(s2) + lam_init;
    const float* subg = a.in[15] + l * 128;
    const int nun = 1024 + (ctx_out ? 128 : 0);
    for (int u = ti.bid; u < nun; u += ti.nblk) {
        if (u < 1024) { const int bh = u >> 4, qb = u & 15; attn_unit(ti, a, bh >> 3, bh & 7, (bh >> 3) * 2048 + qb * 128, 0, 36, mfix, lam, lam_init, subg, ldsg); }
        else { const int v = u - 1024, bh = v >> 1, qb = v & 1; attn_unit(ti, a, bh >> 3, bh & 7, ML + (bh >> 3) * 256 + qb * 128, 32, 36, mfix, lam, lam_init, subg, ldsg); }
    }
}

__device__ __forceinline__ void up8(const bf16_t* p, float (&x)[8]) { const u32x4 v = *(const u32x4*)p;
#pragma unroll
    for (int i = 0; i < 4; ++i) { x[2 * i] = bf2f(v[i] & 0xffffu); x[2 * i + 1] = bf2f(v[i] >> 16); } }
__device__ __forceinline__ void ld8f(const float* p, float (&x)[8]) { const f32x4 u = *(const f32x4*)p, v = *(const f32x4*)(p + 4); x[0] = u.x; x[1] = u.y; x[2] = u.z; x[3] = u.w; x[4] = v.x; x[5] = v.y; x[6] = v.z; x[7] = v.w; }
__device__ __forceinline__ void shift8(const bf16_t* p, const float* mu, bool hp, bool hn, float (&z)[8]) {
    float x[8], xp[8], xn[8], m[8];
#pragma unroll
    for (int j = 0; j < 8; ++j) { xp[j] = 0.f; xn[j] = 0.f; }
    up8(p, x); if (hp) up8(p - RWP, xp); if (hn) up8(p + RWP, xn); ld8f(mu, m);
#pragma unroll
    for (int j = 0; j < 8; ++j) z[j] = x[j] + m[j] * (0.5f * (xp[j] + xn[j]) - x[j]);
}
__device__ __forceinline__ void un8(const u32x4 v, float (&x)[8]) {
#pragma unroll
    for (int i = 0; i < 4; ++i) { x[2 * i] = bf2f(v[i] & 0xffffu); x[2 * i + 1] = bf2f(v[i] >> 16); } }
__device__ __forceinline__ void rwkv_out_rows(CArgs& a, int l, int nrows, int gw, int ngw, int lane) {
    const bf16_t* RW = (const bf16_t*)(a.ws + WS_RW); const bf16_t* Y0 = (const bf16_t*)(a.ws + WS_H); bf16_t* Y1 = (bf16_t*)(a.ws + WS_Y1);
    const bf16_t* A0 = (const bf16_t*)(a.ws + WS_AA0); const bf16_t* A1 = (const bf16_t*)(a.ws + WS_AA1); const bf16_t* G = (const bf16_t*)(a.ws + WS_G);
    const float* mu = a.in[16] + l * 3488;
#define RO_LOAD(R, it_) do { const int row_ = (it_) >> 1, c0_ = ((it_) & 1) * 512 + 8 * lane; int t_, Tn_; if (row_ < ML) { t_ = row_ & 2047; Tn_ = 2048; } else { t_ = (row_ - ML) & 255; Tn_ = 256; } \
        const size_t idx_ = (size_t)row_ * 1024 + c0_; const bf16_t* p_ = RW + (size_t)row_ * RWP + c0_; const int op_ = t_ > 0 ? -RWP : 0, on_ = t_ < Tn_ - 1 ? RWP : 0; \
        R[0] = *(const u32x4*)(Y0 + idx_); R[1] = *(const u32x4*)(Y1 + idx_); R[2] = *(const u32x4*)(G + idx_); R[3] = *(const u32x4*)(A0 + idx_); R[4] = *(const u32x4*)(A1 + idx_); \
        _Pragma("unroll") for (int X = 0; X < 3; ++X) { R[5 + 3 * X] = *(const u32x4*)(p_ + X * 1024 + op_); R[6 + 3 * X] = *(const u32x4*)(p_ + X * 1024); R[7 + 3 * X] = *(const u32x4*)(p_ + X * 1024 + on_); } } while (0)
    u32x4 R[14], N[14];
#pragma unroll
    for (int i = 0; i < 14; ++i) { R[i] = (u32x4){0u, 0u, 0u, 0u}; N[i] = R[i]; }
    int it = gw;
    if (it < 2 * nrows) RO_LOAD(R, it);
    for (; it < 2 * nrows; it += ngw) {
        const int nit = it + ngw;
        if (nit < 2 * nrows) RO_LOAD(N, nit);
        const int row = it >> 1, c0 = (it & 1) * 512 + 8 * lane;
        int t, Tn; if (row < ML) { t = row & 2047; Tn = 2048; } else { t = (row - ML) & 255; Tn = 256; }
        const float mp = t > 0 ? 0.5f : 0.f, mn = t < Tn - 1 ? 0.5f : 0.f;
        float y[8], y1[8], g[8], a0[8], a1[8], z[3][8], lnw[8], lnb[8], ka[8], rk[8];
        un8(R[0], y); un8(R[1], y1); un8(R[2], g); un8(R[3], a0); un8(R[4], a1);
#pragma unroll
        for (int X = 0; X < 3; ++X) {
            float xp[8], x[8], xn[8], m[8]; un8(R[5 + 3 * X], xp); un8(R[6 + 3 * X], x); un8(R[7 + 3 * X], xn); ld8f(mu + X * 1024 + c0, m);
#pragma unroll
            for (int j = 0; j < 8; ++j) z[X][j] = x[j] + m[j] * ((mp * xp[j] + mn * xn[j]) - x[j]);
        }
        ld8f(a.in[25] + l * 1024 + c0, lnw); ld8f(a.in[26] + l * 1024 + c0, lnb); ld8f(a.in[23] + l * 1024 + c0, ka); ld8f(a.in[24] + l * 1024 + c0, rk);
        float sm = 0.f;
#pragma unroll
        for (int j = 0; j < 8; ++j) { y[j] += y1[j]; sm += y[j]; }
        const float mean = dpp_sum8(sm) * (1.f / 64.f);
        float sv = 0.f, sb = 0.f;
#pragma unroll
        for (int j = 0; j < 8; ++j) { y[j] -= mean; sv += y[j] * y[j]; const float kds = z[1][j] * ((1.f + (a0[j] - 1.f) * ka[j]) + (1.f + (a1[j] - 1.f) * ka[j])); sb += z[0][j] * kds * rk[j]; }
        const float rstd = rsqrtf(dpp_sum8(sv) * (1.f / 64.f) + 64e-5f), bsum = dpp_sum8(sb);
        u32x4 o;
#pragma unroll
        for (int j = 0; j < 4; ++j) o[j] = pkbf(((y[2 * j] * rstd * lnw[2 * j] + lnb[2 * j]) + bsum * z[2][2 * j]) * g[2 * j], ((y[2 * j + 1] * rstd * lnw[2 * j + 1] + lnb[2 * j + 1]) + bsum * z[2][2 * j + 1]) * g[2 * j + 1]);
        *(u32x4*)(Y1 + (size_t)row * 1024 + c0) = o;
#pragma unroll
        for (int i = 0; i < 14; ++i) R[i] = N[i];
    }
#undef RO_LOAD
}

#define XB_TMO      128
#define XB_XCNT(j)  (256  + 64 * (j))
#define XB_XSUB(j)  (1280 + 64 * (j))
#define XB_XGEN(j)  (2304 + 64 * (j))
#define XB_TOP      3328
#define XB_TOPGEN   3392
#define XCD_BAR_WORDS 3456
#define XB_SPIN_CAP (1u << 20)

__device__ __forceinline__ unsigned xb_ld(unsigned* p)              { return __hip_atomic_load(p, __ATOMIC_RELAXED, __HIP_MEMORY_SCOPE_AGENT); }
__device__ __forceinline__ unsigned xb_add(unsigned* p, unsigned v) { return __hip_atomic_fetch_add(p, v, __ATOMIC_RELAXED, __HIP_MEMORY_SCOPE_AGENT); }
__device__ __forceinline__ unsigned xb_xcc_id() { return (unsigned)__builtin_amdgcn_s_getreg((3 << 11) | 20) & 0xFu; }
#define XB_SPIN(cond, bar) do { unsigned _sp = 0; while (cond) { __builtin_amdgcn_s_sleep(1); \
    if ((++_sp & 255u) == 0u) { if (xb_ld(&(bar)[XB_TMO])) break; if (_sp > XB_SPIN_CAP) { atomicAdd(&(bar)[XB_TMO], 1u); break; } } } } while (0)

struct XcdBarrier {
    unsigned* bar; unsigned x;
    volatile LAS unsigned* st;
};

__device__ __forceinline__ XcdBarrier xcd_barrier_post(unsigned* bar, volatile LAS unsigned* st) {
    XcdBarrier b; b.bar = bar; b.x = xb_xcc_id(); b.st = st;
    if (threadIdx.x == 0) (void)xb_add(&bar[XB_XCNT(b.x)], 1u);
    return b;
}
__device__ __forceinline__ void xcd_barrier_complete(unsigned* bar, unsigned x, unsigned& nloc, unsigned& nx) {
    const unsigned G = gridDim.x * gridDim.y * gridDim.z;
    unsigned sum, cnt, mine, sp = 0u;
    for (;;) {
        sum = 0u; cnt = 0u; mine = 0u;
#pragma unroll
        for (unsigned j = 0; j < 16; ++j) { const unsigned c = xb_ld(&bar[XB_XCNT(j)]); sum += c; cnt += (c > 0u) ? 1u : 0u; mine = (j == x) ? c : mine; }
        if (sum == G) break;
        __builtin_amdgcn_s_sleep(1);
        if ((++sp & 255u) == 0u) { if (xb_ld(&bar[XB_TMO])) break; if (sp > XB_SPIN_CAP) { atomicAdd(&bar[XB_TMO], 1u); break; } }
    }
    nloc = mine > 0u ? mine : 1u; nx = cnt > 0u ? cnt : 1u;
}

__device__ __forceinline__ void xcd_barrier(const XcdBarrier& b) {
    asm volatile("s_waitcnt vmcnt(0)" ::: "memory");
    __syncthreads();
    if (threadIdx.x == 0) {
        unsigned* bar = b.bar;
        __builtin_amdgcn_s_waitcnt(0);
        unsigned nloc = b.st[0], nx = b.st[1];
        if (nloc == 0u) { xcd_barrier_complete(bar, b.x, nloc, nx); b.st[0] = nloc; b.st[1] = nx; }
        const unsigned old = xb_add(&bar[XB_XSUB(b.x)], 1u);
        const unsigned gen = old / nloc;
        if (old + 1u == (gen + 1u) * nloc) {
            __builtin_amdgcn_fence(__ATOMIC_RELEASE, "agent");
            asm volatile("s_waitcnt vmcnt(0)" ::: "memory");
            const unsigned og = xb_add(&bar[XB_TOP], 1u);
            const unsigned tg = og / nx;
            if (og + 1u == (tg + 1u) * nx) xb_add(&bar[XB_TOPGEN], 1u);
            else XB_SPIN(xb_ld(&bar[XB_TOPGEN]) == tg, bar);
            __builtin_amdgcn_fence(__ATOMIC_ACQUIRE, "agent");
            xb_add(&bar[XB_XGEN(b.x)], 1u);
            asm volatile("s_waitcnt vmcnt(0)" ::: "memory");
        } else {
            XB_SPIN(xb_ld(&bar[XB_XGEN(b.x)]) == gen, bar);
            __builtin_amdgcn_fence(__ATOMIC_ACQUIRE, "agent");
            asm volatile("s_waitcnt vmcnt(0)" ::: "memory");
        }
    }
    __syncthreads();
}

#ifndef ONLY_PH
#define ONLY_PH -1
#endif
#ifndef SKIP_PH
#define SKIP_PH -2
#endif
#define PH_ON(k) ((ONLY_PH < 0 || ONLY_PH == (k)) && (k) != SKIP_PH)
__global__ void __launch_bounds__(512, 2) mega_fwd(Args a_) {
    extern __shared__ __attribute__((aligned(16))) unsigned char lds[];
    cg::grid_group grid = cg::this_grid();
    const int ph_lo = a_.lo, ph_hi = a_.hi;
    volatile LAS unsigned* bst = (volatile LAS unsigned*)((LAS unsigned char*)lds + 131072);
    if (threadIdx.x < 2) bst[threadIdx.x] = 0u;
    __syncthreads();
    const XcdBarrier xbar = xcd_barrier_post((unsigned*)(a_.ws + WS_BAR), bst);
    const int wave_s = __builtin_amdgcn_readfirstlane((int)threadIdx.x >> 6);
#pragma nounroll
    for (int ph = ph_lo; ph < ph_hi; ++ph) {
        CArgs* ap = (CArgs*)__builtin_amdgcn_kernarg_segment_ptr(); asm volatile("" : "+s"(ap));
        CArgs& a = *ap;
        unsigned char* ws = a.ws;
        float* XC = (float*)(ws + WS_XC);
        int wsv = wave_s; asm volatile("" : "+s"(wsv));
        TI ti; ti.tid = wsv * 64 + (int)__builtin_amdgcn_mbcnt_hi(~0u, __builtin_amdgcn_mbcnt_lo(~0u, 0u)); ti.bid = blockIdx.x; ti.nblk = gridDim.x;
        asm volatile("" : "+v"(ti.tid)); asm volatile("" : "+s"(ti.bid)); asm volatile("" : "+s"(ti.nblk));
        const int tid = ti.tid, lane = tid & 63, wv = __builtin_amdgcn_readfirstlane(tid >> 6);
        const int gw = ti.bid * 8 + wv, ngw = ti.nblk * 8;
        if (ph == 0) { if constexpr (PH_ON(100)) ph_mods(ti, a, lds); }
        else {
            const int l = (ph - 1) / NPH, k = (ph - 1) % NPH;
            const bool ctx_out = l < DEPTH - 1;
            const int Mr = ctx_out ? M : ML;
            const float* modl = (const float*)(ws + WS_MOD) + (size_t)l * 9 * 6144;
            const float* xl_in = l == 0 ? a.in[0] : a.out; const float* xc_in = l == 0 ? a.in[2] : XC;
            bf16_t* H = (bf16_t*)(ws + WS_H);
            switch (k) {
            case 0: if constexpr (PH_ON(0)) {
                norm_rows(xl_in, xc_in, a.in[6] + l * 1024, modl, 0, 1, H, M, gw, ngw, lane);
                ph_wconv(a, l, lds, gw, ngw, lane, wv, l == 0 ? 31 : 16);
                } break;
            case 1: if constexpr (PH_ON(1)) {
                OpIn op{(bf16_t*)(ws + WS_GU), (bf16_t*)(ws + WS_GV), (bf16_t*)(ws + WS_Q), (bf16_t*)(ws + WS_RW), (bf16_t*)(ws + WS_GT)};
                run_gemm(ti, lds, H, (const bf16_t*)(ws + WS_WIN), M, PPAD, 1024, op);
            } break;
            case 2: if constexpr (PH_ON(2)) {
                for (int u = ti.bid; u < Mr / 128; u += ti.nblk) gmlp_unit(ti, a, l, u, lds);
                qk_rows(a, l, gw, ngw, lane);
                lora_in_rows(a, l, gw, ngw, lane);
                } break;
            case 3: if constexpr (PH_ON(3)) {
                OpDec o1{(bf16_t*)(ws + WS_GV), (bf16_t*)(ws + WS_DEC1), a.in[17] + l * 2048};
                run_gemm(ti, lds, (const bf16_t*)(ws + WS_LIW), (const bf16_t*)(ws + WS_LWT), M, 2048, 128, o1);
                OpAA o2{(bf16_t*)(ws + WS_AA0), (bf16_t*)(ws + WS_AA1), a.in[19] + l * 2048};
                run_gemm(ti, lds, (const bf16_t*)(ws + WS_LIA), (const bf16_t*)(ws + WS_LAT), M, 2048, 128, o2);
                OpG o3{(bf16_t*)(ws + WS_G)};
                run_gemm(ti, lds, (const bf16_t*)(ws + WS_LIG), (const bf16_t*)(ws + WS_LGT), M, 1024, 256, o3);
            } break;
            case 4:
                if constexpr (PH_ON(4)) { for (int u = ti.bid; u < 256; u += ti.nblk) scan_unit_mfma(ti, a, l, u, ctx_out, lds); }
                if constexpr (PH_ON(40)) ph_attn(ti, a, l, ctx_out, lds);
                break;
            case 5: if constexpr (PH_ON(5)) {
                rwkv_out_rows(a, l, Mr, gw, ngw, lane);
                } break;
            case 6: if constexpr (PH_ON(6)) {
                const bf16_t* GT = (const bf16_t*)(ws + WS_GT); float* MF = (float*)(ws + WS_K);
                OpMerge<0> o0{GT, MF, H}; run_gemm(ti, lds, (const bf16_t*)(ws + WS_GU), (const bf16_t*)(ws + WS_WA), Mr, 1024, 1024, o0);
                OpMerge<1> o1{GT, MF, H}; run_gemm(ti, lds, (const bf16_t*)(ws + WS_Q), (const bf16_t*)(ws + WS_WB), Mr, 1024, 1024, o1);
                OpMerge<2> o2{GT, MF, H}; run_gemm(ti, lds, (const bf16_t*)(ws + WS_Y1), (const bf16_t*)(ws + WS_WC), Mr, 1024, 1024, o2);
                if (ctx_out && ti.nblk > 64 && ti.bid >= 32) ph_wconv(a, l + 1, lds, (ti.bid - 32) * 8 + wv, (ti.nblk - 32) * 8, lane, wv, 1);
                else if (ctx_out && ti.nblk <= 64) ph_wconv(a, l + 1, lds, gw, ngw, lane, wv, 1);
            } break;
            case 7: if constexpr (PH_ON(7)) {
                OpResid op{xl_in, xc_in, a.out, XC, modl, 2};
                run_gemm(ti, lds, H, (const bf16_t*)(ws + WS_WO), Mr, 1024, 1024, op);
                if (ctx_out && ti.nblk > 64 && ti.bid >= 32) ph_wconv(a, l + 1, lds, (ti.bid - 32) * 8 + wv, (ti.nblk - 32) * 8, lane, wv, 2);
                else if (ctx_out && ti.nblk <= 64) ph_wconv(a, l + 1, lds, gw, ngw, lane, wv, 2);
            } break;
            case 8: if constexpr (PH_ON(8)) {
                norm_rows(a.out, XC, a.in[7] + l * 1024, modl, 3, 4, H, Mr, gw, ngw, lane);
                } break;
            case 9: if constexpr (PH_ON(9)) {
                OpSwiglu op{(bf16_t*)(ws + WS_RW)};
                run_gemm(ti, lds, H, (const bf16_t*)(ws + WS_WI), Mr, 2 * DFF, 1024, op);
            } break;
            default: if constexpr (PH_ON(10)) {
                OpResid op{a.out, XC, a.out, XC, modl, 5};
                run_gemm(ti, lds, (const bf16_t*)(ws + WS_RW), (const bf16_t*)(ws + WS_WO2), Mr, 1024, DFF, op);
                if (ctx_out && ti.nblk > 64 && ti.bid >= 32) ph_wconv(a, l + 1, lds, (ti.bid - 32) * 8 + wv, (ti.nblk - 32) * 8, lane, wv, 12);
                else if (ctx_out && ti.nblk <= 64) ph_wconv(a, l + 1, lds, gw, ngw, lane, wv, 12);
            } break;
            }
        }
        if (ph + 1 < ph_hi) { if (ph == ph_lo) grid.sync(); else xcd_barrier(xbar); }
    }
}

extern "C" void kernel_launch(void* const* d_in, const int* in_sizes, int n_in, void* d_out, int out_size, void* d_ws, size_t ws_size, hipStream_t stream) {
    static int grid = 0;
    if (grid == 0) {
        if (n_in != 33 || out_size != ML * D || ws_size < WS_END) { fprintf(stderr, "kernel_launch: unexpected shapes / workspace (%d inputs, out %d, ws %zu, need %zu)\n", n_in, out_size, ws_size, (size_t)WS_END); grid = -1; return; }
        int dev = 0, cus = 0, per_cu = 0;
        hipGetDevice(&dev); hipDeviceGetAttribute(&cus, hipDeviceAttributeMultiprocessorCount, dev);
        if (hipFuncSetAttribute((const void*)mega_fwd, hipFuncAttributeMaxDynamicSharedMemorySize, LDS_BYTES) != hipSuccess) { fprintf(stderr, "kernel_launch: hipFuncSetAttribute failed\n"); grid = -1; return; }
        if (hipOccupancyMaxActiveBlocksPerMultiprocessor(&per_cu, (const void*)mega_fwd, 512, LDS_BYTES) != hipSuccess || per_cu < 1) per_cu = 1;
        (void)hipGetLastError();
        grid = cus * 1;
    }
    if (grid < 0) return;
    Args a{};
    for (int i = 0; i < 33; ++i) a.in[i] = (const float*)d_in[i];
    a.out = (float*)d_out; a.ws = (unsigned char*)d_ws; a.lo = 0; a.hi = NPHASES;
    void* args[] = {&a};
    if (hipMemsetAsync((char*)d_ws + WS_BAR, 0, BAR_BYTES, stream) != hipSuccess) { fprintf(stderr, "kernel_launch: memset of barrier words failed\n"); return; }
    hipError_t e = hipLaunchCooperativeKernel((const void*)mega_fwd, dim3(grid), dim3(512), args, LDS_BYTES, stream);
    if (e != hipSuccess) fprintf(stderr, "kernel_launch: cooperative launch failed: %s (grid %d)\n", hipGetErrorString(e), grid);
}
```
